# Optimizing an MI355X kernel written in HIP

```python
import math
import jax, jax.numpy as jnp
from jax import lax
import numpy as np

D_MODEL = 1024
BATCH = 16
SEQ = 4096
DEPTH = 2

EPS = 1e-6
QBLK = 128
A_HEADS = 4
A_DIM = 64
A_VDIM = 2 * A_DIM
B_HEADS = 8
B_NOPE = 64
B_ROPE = 32
B_VDIM = 64
B_Q_LORA = 384
B_KV_LORA = 256
ROPE_THETA = 10000.0
C_HEADS = 8
C_KV_HEADS = 2
C_DIM = 64
WINDOW = 128
A_OUT = A_HEADS * A_VDIM
B_OUT = B_HEADS * B_VDIM
C_OUT = C_HEADS * C_DIM
N_BRANCH = 3
IN_SPLITS = (
    2 * A_HEADS * A_DIM,
    2 * A_HEADS * A_DIM,
    A_HEADS * A_VDIM,
    B_Q_LORA,
    B_KV_LORA,
    B_ROPE,
    C_HEADS * C_DIM,
    C_KV_HEADS * C_DIM,
    C_KV_HEADS * C_DIM,
    N_BRANCH * D_MODEL,
)
IN_COLS = 6048
N_EXPERTS = 16
EC_CAPACITY = 2
D_FF_EXPERT = 1024

kernel_name = "hybrid_gated_diff_mla_swa_ec_moe"


def rms_norm(x, g):
    xf = x.astype(jnp.float32)
    y = xf * lax.rsqrt(jnp.mean(xf * xf, axis=-1, keepdims=True) + EPS)
    return (y * g.astype(jnp.float32)).astype(x.dtype)


def alibi_slopes(n):
    return 2.0 ** (-8.0 * jnp.arange(1, n + 1, dtype=jnp.float32) / n)


def rope_tables(positions):
    inv = 1.0 / (ROPE_THETA ** (jnp.arange(0, B_ROPE, 2, dtype=jnp.float32) / B_ROPE))
    ang = positions.astype(jnp.float32)[..., None] * inv
    return jnp.cos(ang), jnp.sin(ang)


def apply_rope(x, cos, sin):
    x1, x2 = jnp.split(x.astype(jnp.float32), 2, axis=-1)
    out = jnp.concatenate([x1 * cos - x2 * sin, x1 * sin + x2 * cos], axis=-1)
    return out.astype(x.dtype)


def sweep_query_blocks(fn, *qs):
    b, s = qs[0].shape[:2]
    nb = s // QBLK
    split = lambda a: jnp.moveaxis(a.reshape((b, nb, QBLK) + a.shape[2:]), 1, 0)
    out = lax.map(lambda args: fn(*args), tuple(split(a) for a in qs))
    out = jnp.moveaxis(out, 0, 1)
    return out.reshape((b, s) + out.shape[3:])


def band_blocks(a):
    b, s = a.shape[:2]
    nb = s // WINDOW
    pad = [(0, 0), (WINDOW, WINDOW)] + [(0, 0)] * (a.ndim - 2)
    ap = jnp.pad(a, pad).reshape((b, nb + 2, WINDOW) + a.shape[2:])
    return jnp.concatenate([ap[:, :-2], ap[:, 1:-1], ap[:, 2:]], axis=2)


def diff_attention(qa, ka, va, positions, qk_g, lam_params, out_g, layer_idx):
    b, s = qa.shape[:2]
    qa = rms_norm(qa.reshape(b, s, 2, A_HEADS, A_DIM), qk_g[0])
    ka = rms_norm(ka.reshape(b, s, 2, A_HEADS, A_DIM), qk_g[1])
    va = va.reshape(b, s, A_HEADS, A_VDIM)
    lam_init = 0.8 - 0.6 * math.exp(-0.3 * layer_idx)
    lp = lam_params.astype(jnp.float32)
    lam = jnp.exp(jnp.sum(lp[0] * lp[1])) - jnp.exp(jnp.sum(lp[2] * lp[3])) + lam_init
    slopes = alibi_slopes(A_HEADS)
    scale = A_DIM ** -0.5

    def block(qb, pb):
        sc = jnp.einsum('bqmhd,bkmhd->bmhqk', qb, ka).astype(jnp.float32) * scale
        dist = jnp.abs(pb[:, :, None] - positions[:, None, :]).astype(jnp.float32)
        sc = sc - (slopes[None, :, None, None] * dist[:, None])[:, None]
        p = jax.nn.softmax(sc, axis=-1)
        attn = p[:, 0] - lam * p[:, 1]
        return jnp.einsum('bhqk,bkhe->bqhe', attn.astype(va.dtype), va)

    oa = sweep_query_blocks(block, qa, positions)
    oa = rms_norm(oa, out_g) * (1.0 - lam_init)
    return oa.reshape(b, s, A_OUT)


def latent_attention(cq, ckv, kr, positions, cq_g, w_uq, ckv_g, w_ukv, qk_g):
    b, s = cq.shape[:2]
    q = (rms_norm(cq, cq_g) @ w_uq).reshape(b, s, B_HEADS, B_NOPE + B_ROPE)
    kv = (rms_norm(ckv, ckv_g) @ w_ukv).reshape(b, s, B_HEADS, B_NOPE + B_VDIM)
    cos, sin = rope_tables(positions)
    q_nope, q_rope = q[..., :B_NOPE], q[..., B_NOPE:]
    q_rope = apply_rope(q_rope, cos[:, :, None], sin[:, :, None])
    k_nope, v = kv[..., :B_NOPE], kv[..., B_NOPE:]
    k_rope = apply_rope(kr, cos, sin)[:, :, None]
    q = rms_norm(jnp.concatenate([q_nope, q_rope], axis=-1), qk_g[0])
    k = jnp.concatenate([k_nope, jnp.broadcast_to(k_rope, (b, s, B_HEADS, B_ROPE))], axis=-1)
    k = rms_norm(k, qk_g[1])
    scale = (B_NOPE + B_ROPE) ** -0.5

    def block(qb):
        sc = jnp.einsum('bqhd,bkhd->bhqk', qb, k).astype(jnp.float32) * scale
        p = jax.nn.softmax(sc, axis=-1)
        return jnp.einsum('bhqk,bkhe->bqhe', p.astype(v.dtype), v)

    ob = sweep_query_blocks(block, q)
    return ob.reshape(b, s, B_OUT)


def window_gqa(qc, kc, vc, qk_g, sink):
    b, s = qc.shape[:2]
    nb = s // WINDOW
    rep = C_HEADS // C_KV_HEADS
    q = rms_norm(qc.reshape(b, s, C_KV_HEADS, rep, C_DIM), qk_g[0])
    k = rms_norm(kc.reshape(b, s, C_KV_HEADS, C_DIM), qk_g[1])
    v = vc.reshape(b, s, C_KV_HEADS, C_DIM)
    qb = q.reshape(b, nb, WINDOW, C_KV_HEADS, rep, C_DIM)
    kb = band_blocks(k)
    vb = band_blocks(v)
    r = jnp.arange(WINDOW)[None, :, None]
    c = jnp.arange(3 * WINDOW)[None, None, :]
    blk = jnp.arange(nb)[:, None, None]
    rel = c - WINDOW - r
    kidx = (blk - 1) * WINDOW + c
    mask = (jnp.abs(rel) <= WINDOW) & (kidx >= 0) & (kidx < s)
    slopes = alibi_slopes(C_HEADS).reshape(C_KV_HEADS, rep)
    bias = -slopes[:, :, None, None] * jnp.abs(rel[0]).astype(jnp.float32)
    sc = jnp.einsum('bnqgrd,bnkgd->bgrnqk', qb, kb).astype(jnp.float32) * (C_DIM ** -0.5)
    sc = jnp.where(mask[None, None, None], sc + bias[None, :, :, None], -1e30)
    sk = sink.astype(jnp.float32).reshape(C_KV_HEADS, rep)[None, :, :, None, None, None]
    m = jnp.maximum(jnp.max(sc, axis=-1, keepdims=True), sk)
    e = jnp.exp(sc - m)
    p = e / (jnp.sum(e, axis=-1, keepdims=True) + jnp.exp(sk - m))
    oc = jnp.einsum('bgrnqk,bnkgd->bnqgrd', p.astype(vb.dtype), vb)
    return oc.reshape(b, s, C_OUT)


def hybrid_mixer(h, positions, layer_idx, w_in, diff_qk_g, diff_lambda, diff_out_g,
                 mla_cq_g, w_uq, mla_ckv_g, w_ukv, mla_qk_g, swa_qk_g, swa_sink,
                 w_branch_a, w_branch_b, w_branch_c, w_o):
    b, s, d = h.shape
    offsets = []
    acc = 0
    for width in IN_SPLITS[:-1]:
        acc += width
        offsets.append(acc)
    proj = h @ w_in
    qa, ka, va, cq, ckv, kr, qc, kc, vc, gates = jnp.split(proj, offsets, axis=-1)
    oa = diff_attention(qa, ka, va, positions, diff_qk_g, diff_lambda, diff_out_g, layer_idx)
    ob = latent_attention(cq, ckv, kr, positions, mla_cq_g, w_uq, mla_ckv_g, w_ukv, mla_qk_g)
    oc = window_gqa(qc, kc, vc, swa_qk_g, swa_sink)
    g = jax.nn.sigmoid(gates.astype(jnp.float32)).reshape(b, s, N_BRANCH, d).astype(h.dtype)
    merged = g[:, :, 0] * (oa @ w_branch_a) + g[:, :, 1] * (ob @ w_branch_b) + g[:, :, 2] * (oc @ w_branch_c)
    return merged @ w_o


def expert_choice_ffn(h, w_router, w_gate, w_up, w_down):
    b, s, d = h.shape
    cap = max(1, EC_CAPACITY * s // N_EXPERTS)
    aff = jax.nn.softmax((h @ w_router).astype(jnp.float32), axis=-1)
    top_aff, top_idx = lax.top_k(jnp.swapaxes(aff, 1, 2), cap)
    xin = jax.vmap(lambda hb, ib: hb[ib])(h, top_idx)
    hid = jax.nn.silu(jnp.einsum('becd,edf->becf', xin, w_gate)) * jnp.einsum('becd,edf->becf', xin, w_up)
    y = jnp.einsum('becf,efd->becd', hid, w_down) * top_aff[..., None].astype(h.dtype)
    flat = (top_idx + (jnp.arange(b, dtype=jnp.int32) * s)[:, None, None]).reshape(-1)
    out = jax.ops.segment_sum(y.reshape(-1, d), flat, num_segments=b * s)
    return out.reshape(b, s, d)


def setup_inputs(seed: int = 0) -> dict:
    key = jax.random.key(seed)
    ks = jax.random.split(key, 24)
    f32 = jnp.float32
    nrm = lambda k, shape, fan_in: jax.random.normal(k, shape, f32) * (fan_in ** -0.5)
    gain = lambda k, shape: 1.0 + 0.1 * jax.random.normal(k, shape, f32)
    x = jax.random.normal(ks[0], (BATCH, SEQ, D_MODEL), f32)
    offs = jax.random.randint(ks[1], (BATCH, 1), 0, 1024, dtype=jnp.int32)
    positions = offs + jnp.arange(SEQ, dtype=jnp.int32)[None, :]
    return {
        "x": x,
        "positions": positions,
        "norm_mix_g": gain(ks[2], (DEPTH, D_MODEL)),
        "w_in": nrm(ks[3], (DEPTH, D_MODEL, IN_COLS), D_MODEL),
        "diff_qk_g": gain(ks[4], (DEPTH, 2, A_DIM)),
        "diff_lambda": 0.1 * jax.random.normal(ks[5], (DEPTH, 4, A_DIM), f32),
        "diff_out_g": gain(ks[6], (DEPTH, A_VDIM)),
        "mla_cq_g": gain(ks[7], (DEPTH, B_Q_LORA)),
        "w_uq": nrm(ks[8], (DEPTH, B_Q_LORA, B_HEADS * (B_NOPE + B_ROPE)), B_Q_LORA),
        "mla_ckv_g": gain(ks[9], (DEPTH, B_KV_LORA)),
        "w_ukv": nrm(ks[10], (DEPTH, B_KV_LORA, B_HEADS * (B_NOPE + B_VDIM)), B_KV_LORA),
        "mla_qk_g": gain(ks[11], (DEPTH, 2, B_NOPE + B_ROPE)),
        "swa_qk_g": gain(ks[12], (DEPTH, 2, C_DIM)),
        "swa_sink": 0.5 * jax.random.normal(ks[13], (DEPTH, C_HEADS), f32),
        "w_branch_a": nrm(ks[14], (DEPTH, A_OUT, D_MODEL), A_OUT),
        "w_branch_b": nrm(ks[15], (DEPTH, B_OUT, D_MODEL), B_OUT),
        "w_branch_c": nrm(ks[16], (DEPTH, C_OUT, D_MODEL), C_OUT),
        "w_o": nrm(ks[17], (DEPTH, D_MODEL, D_MODEL), D_MODEL),
        "norm_ffn_g": gain(ks[18], (DEPTH, D_MODEL)),
        "w_router": nrm(ks[19], (DEPTH, D_MODEL, N_EXPERTS), D_MODEL),
        "w_exp_gate": nrm(ks[20], (DEPTH, N_EXPERTS, D_MODEL, D_FF_EXPERT), D_MODEL),
        "w_exp_up": nrm(ks[21], (DEPTH, N_EXPERTS, D_MODEL, D_FF_EXPERT), D_MODEL),
        "w_exp_down": nrm(ks[22], (DEPTH, N_EXPERTS, D_FF_EXPERT, D_MODEL), D_FF_EXPERT),
    }


def reference(x, positions, norm_mix_g, w_in, diff_qk_g, diff_lambda, diff_out_g,
              mla_cq_g, w_uq, mla_ckv_g, w_ukv, mla_qk_g, swa_qk_g, swa_sink,
              w_branch_a, w_branch_b, w_branch_c, w_o, norm_ffn_g, w_router,
              w_exp_gate, w_exp_up, w_exp_down):
    for l in range(DEPTH):
        h = rms_norm(x, norm_mix_g[l])
        x = x + hybrid_mixer(h, positions, l, w_in[l], diff_qk_g[l], diff_lambda[l], diff_out_g[l],
                             mla_cq_g[l], w_uq[l], mla_ckv_g[l], w_ukv[l], mla_qk_g[l],
                             swa_qk_g[l], swa_sink[l], w_branch_a[l], w_branch_b[l],
                             w_branch_c[l], w_o[l])
        h = rms_norm(x, norm_ffn_g[l])
        x = x + expert_choice_ffn(h, w_router[l], w_exp_gate[l], w_exp_up[l], w_exp_down[l])
    return x
```

```cpp
#include <hip/hip_runtime.h>
#include <cstdio>
#include <cstdint>

#ifndef MK_MULTI
#define MK_MULTI 0
#endif

namespace pg8 {
#define PG8_LAS __attribute__((address_space(3)))
typedef unsigned short bf16_t;
typedef short bf16x8 __attribute__((ext_vector_type(8)));
typedef float f32x4 __attribute__((ext_vector_type(4)));
typedef unsigned u32x4 __attribute__((ext_vector_type(4)));
typedef unsigned u32x2 __attribute__((ext_vector_type(2)));
typedef float f32x2 __attribute__((ext_vector_type(2)));
constexpr int BM = 256, BK = 64, HALF = 128, HTB = HALF * BK * 2  , STAGE_BYTES = 8 * HTB, NXCD = 8, WGM = 8;

__host__ __device__ __forceinline__ int lds_byte(int r, int c) { const int st = (r >> 4) * 2 + (c >> 5), rr = r & 15, cc = c & 31, ob = rr * 64 + cc * 2; return st * 1024 + (ob ^ (((ob >> 9) & 1) << 5)); }
__host__ __device__ __forceinline__ void stage_rc(int b, int& R, int& C) { const int st = b / 1024, sb = b % 1024, swz = sb ^ (((sb >> 9) & 1) << 5); R = (st >> 1) * 16 + swz / 64; C = (st & 1) * 32 + (swz % 64) / 2; }
__host__ __device__ __forceinline__ int perm32(int rho) { const int n = rho >> 4, i = rho & 15; return 8 * (i >> 2) + 4 * n + (i & 3); }

struct Unit { int pm, pn; };
struct Gemm { const bf16_t* A; const bf16_t* Bt; int M, N, K, lda; int pm_per_grp, ngrp; size_t grp_bytes; int sc_w, sc_x;
    __device__ __forceinline__ size_t grp_off(int pm) const { return ngrp > 1 ? (size_t)((pm / pm_per_grp) % ngrp) * grp_bytes : (size_t)0; } };

typedef int v8i_t __attribute__((ext_vector_type(8))); typedef int v4i_t __attribute__((ext_vector_type(4)));
__device__ __forceinline__ v8i_t cat8(bf16x8 lo, bf16x8 hi) { return __builtin_shufflevector(__builtin_bit_cast(v4i_t, lo), __builtin_bit_cast(v4i_t, hi), 0, 1, 2, 3, 4, 5, 6, 7); }
struct StaticOrder {
    int nM, nN, nwg, G, c;
    __host__ __device__ void init(int M, int N, int G_, int c_) { nM = M / BM; nN = N / BM; nwg = nM * nN; G = G_; c = c_; }
    __host__ __device__ bool next(int i, Unit& u) const {
        const long L = (long)i * G + c; if (L >= nwg) return false;
        int wgid = (int)L; { const int q = nwg / NXCD, r = nwg % NXCD, xcd = wgid % NXCD, off = wgid / NXCD; wgid = (xcd < r ? xcd * (q + 1) : r * (q + 1) + (xcd - r) * q) + off; }
        const int nig = WGM * nN, gid = wgid / nig, fm = gid * WGM, gsz = (nM - fm) < WGM ? (nM - fm) : WGM;
        u.pm = fm + ((wgid % nig) % gsz); u.pn = (wgid % nig) / gsz; return true;
    }
    __device__ __forceinline__ void a_ready(const Unit&) const {}
    __device__ __forceinline__ void done(const Unit&) const {}
};

typedef float f32x2_t __attribute__((ext_vector_type(2))); typedef __bf16 bf16x2_t __attribute__((ext_vector_type(2)));
__device__ __forceinline__ unsigned cvt_pk_bf16(float lo, float hi) { f32x2_t v = {lo, hi}; bf16x2_t b = __builtin_convertvector(v, bf16x2_t); return __builtin_bit_cast(unsigned, b); }
__device__ __forceinline__ float bf_lo(unsigned w) { return __uint_as_float(w << 16); }
__device__ __forceinline__ float bf_hi(unsigned w) { return __uint_as_float(w & 0xffff0000u); }

#define PG8_EPI_LOOP(...) \
    _Pragma("unroll") for (int ai = 0; ai < 2; ++ai) _Pragma("unroll") for (int m = 0; m < 4; ++m) _Pragma("unroll") for (int bj = 0; bj < 2; ++bj) { \
        const int row = u.pm * BM + ai * HALF + wr * 64 + m * 16 + fr; const int ct = bj * HALF + wc * 32 + 8 * fq;   \
        f32x4 v0 = acc[ai][bj][m][0], v1 = acc[ai][bj][m][1]; __VA_ARGS__ }
__device__ __forceinline__ u32x4 pack8(f32x4 v0, f32x4 v1) { u32x4 w; w.x = cvt_pk_bf16(v0[0], v0[1]); w.y = cvt_pk_bf16(v0[2], v0[3]); w.z = cvt_pk_bf16(v1[0], v1[1]); w.w = cvt_pk_bf16(v1[2], v1[3]); return w; }

struct EpiPlain { static constexpr bool PERM = true, AFTER_DRAIN = false; bf16_t* O; int ldc;
    __device__ __forceinline__ void operator()(const f32x4 (&acc)[2][2][4][2], const Unit& u, int wr, int wc, int fr, int fq) const {
        PG8_EPI_LOOP({ *(u32x4*)(O + (size_t)row * ldc + u.pn * BM + ct) = pack8(v0, v1); }) } };
struct EpiRoute { static constexpr bool PERM = true, AFTER_DRAIN = false; bf16_t* five; size_t five_stride; bf16_t* tail; size_t tail_stride;
    __device__ __forceinline__ void operator()(const f32x4 (&acc)[2][2][4][2], const Unit& u, int wr, int wc, int fr, int fq) const {
        bf16_t* base; int ldc, c0;
        if (u.pn < 10) { base = five + (size_t)(u.pn >> 1) * five_stride; ldc = 512; c0 = (u.pn & 1) * 256; } else { base = tail + (size_t)(u.pn - 10) * tail_stride; ldc = 256; c0 = 0; }
        PG8_EPI_LOOP({ *(u32x4*)(base + (size_t)row * ldc + c0 + ct) = pack8(v0, v1); }) } };
struct EpiRouteNorm { static constexpr bool PERM = true, AFTER_DRAIN = false; bf16_t* five; size_t five_stride; bf16_t* tail; size_t tail_stride; const float* gt; float* ssp; float eps;
    __device__ __forceinline__ void operator()(const f32x4 (&acc)[2][2][4][2], const Unit& u, int wr, int wc, int fr, int fq) const {
        bf16_t* base; int ldc, c0;
        if (u.pn < 10) { base = five + (size_t)(u.pn >> 1) * five_stride; ldc = 512; c0 = (u.pn & 1) * 256; } else { base = tail + (size_t)(u.pn - 10) * tail_stride; ldc = 256; c0 = 0; }
        const bool nrm = (u.pn < 6) || (u.pn == 9 && wc >= 2);
        const bool part = (u.pn == 8) || (u.pn == 9 && wc < 2) || (u.pn == 10);
        const int gi = u.pn < 2 ? 0 : (u.pn < 4 ? 1 : (u.pn < 6 ? 2 : 3));
        const int slot = u.pn == 8 ? wc : (u.pn == 9 ? 4 + wc : 8 + wc);
        f32x4 g00 = {1.f, 1.f, 1.f, 1.f}, g01 = g00, g10 = g00, g11 = g00;
        if (nrm) { const float* gp = gt + gi * 64 + 8 * fq; g00 = *(const f32x4*)gp; g01 = *(const f32x4*)(gp + 4); g10 = *(const f32x4*)(gp + 32); g11 = *(const f32x4*)(gp + 36); }
#pragma unroll
        for (int ai = 0; ai < 2; ++ai)
#pragma unroll
            for (int m = 0; m < 4; ++m) { const int row = u.pm * BM + ai * HALF + wr * 64 + m * 16 + fr;
                f32x4 v00 = acc[ai][0][m][0], v01 = acc[ai][0][m][1], v10 = acc[ai][1][m][0], v11 = acc[ai][1][m][1];
                if (nrm || part) {
                    float ss = 0.f;
#pragma unroll
                    for (int i = 0; i < 4; ++i) ss += (v00[i] * v00[i] + v01[i] * v01[i]) + (v10[i] * v10[i] + v11[i] * v11[i]);
                    { auto r_ = __builtin_amdgcn_permlane16_swap(__float_as_uint(ss), __float_as_uint(ss), false, false); ss = __uint_as_float(r_[0]) + __uint_as_float(r_[1]); }
                    { auto r_ = __builtin_amdgcn_permlane32_swap(__float_as_uint(ss), __float_as_uint(ss), false, false); ss = __uint_as_float(r_[0]) + __uint_as_float(r_[1]); }
                    if (nrm) { const float rs = 1.0f / sqrtf(ss * (1.0f / 64) + eps); v00 = v00 * rs * g00; v01 = v01 * rs * g01; v10 = v10 * rs * g10; v11 = v11 * rs * g11; }
                    if (part && fq == 0) ssp[(size_t)row * 16 + slot] = ss;
                }
                bf16_t* rp = base + (size_t)row * ldc + c0 + wc * 64 + 8 * fq;
                *(u32x4*)rp = pack8(v00, v01); *(u32x4*)(rp + 32) = pack8(v10, v11); } } };
struct EpiPlainRS { static constexpr bool PERM = true, AFTER_DRAIN = false; bf16_t* O; int ldc; const float* ssp; int s0, ns; float inv_n, eps;
    __device__ __forceinline__ void operator()(const f32x4 (&acc)[2][2][4][2], const Unit& u, int wr, int wc, int fr, int fq) const {
#pragma unroll
        for (int ai = 0; ai < 2; ++ai)
#pragma unroll
            for (int m = 0; m < 4; ++m) { const int row = u.pm * BM + ai * HALF + wr * 64 + m * 16 + fr;
                const float* sp = ssp + (size_t)row * 16 + s0; const f32x4 a = *(const f32x4*)sp; float ss = (a[0] + a[1]) + (a[2] + a[3]);
                if (ns > 4) { const f32x2 b = *(const f32x2*)(sp + 4); ss += b[0] + b[1]; }
                const float rs = 1.0f / sqrtf(ss * inv_n + eps);
#pragma unroll
                for (int bj = 0; bj < 2; ++bj) { const int ct = bj * HALF + wc * 32 + 8 * fq;
                    *(u32x4*)(O + (size_t)row * ldc + u.pn * BM + ct) = pack8(acc[ai][bj][m][0] * rs, acc[ai][bj][m][1] * rs); } } } };
struct EpiGate { static constexpr bool PERM = true, AFTER_DRAIN = false; bf16_t* g0; size_t gstride, gextra; float zs;
    __device__ __forceinline__ void operator()(const f32x4 (&acc)[2][2][4][2], const Unit& u, int wr, int wc, int fr, int fq) const {
        const int gi = u.pn >> 2; bf16_t* base = g0 + (size_t)gi * gstride + (size_t)(gi >> 1) * gextra; const int c0 = (u.pn & 3) * 256;
        PG8_EPI_LOOP({
            _Pragma("unroll") for (int i = 0; i < 4; ++i) { v0[i] = __builtin_amdgcn_rcpf(1.0f + __builtin_amdgcn_exp2f(zs * v0[i])); v1[i] = __builtin_amdgcn_rcpf(1.0f + __builtin_amdgcn_exp2f(zs * v1[i])); }
            *(u32x4*)(base + (size_t)row * 1024 + c0 + ct) = pack8(v0, v1); }) } };
struct EpiMerge { static constexpr bool PERM = true, AFTER_DRAIN = false; const bf16_t* gate; bf16_t* mg; int first;
    __device__ __forceinline__ void operator()(const f32x4 (&acc)[2][2][4][2], const Unit& u, int wr, int wc, int fr, int fq) const {
        PG8_EPI_LOOP({
            const size_t off = (size_t)row * 1024 + u.pn * BM + ct;
            const u32x4 gw = *(const u32x4*)(gate + off);
            f32x4 p0 = {0.f, 0.f, 0.f, 0.f}, p1 = {0.f, 0.f, 0.f, 0.f};
            if (!first) { const u32x4 pw = *(const u32x4*)(mg + off); p0 = (f32x4){bf_lo(pw.x), bf_hi(pw.x), bf_lo(pw.y), bf_hi(pw.y)}; p1 = (f32x4){bf_lo(pw.z), bf_hi(pw.z), bf_lo(pw.w), bf_hi(pw.w)}; }
            const f32x4 g0v = (f32x4){bf_lo(gw.x), bf_hi(gw.x), bf_lo(gw.y), bf_hi(gw.y)}, g1v = (f32x4){bf_lo(gw.z), bf_hi(gw.z), bf_lo(gw.w), bf_hi(gw.w)};
            v0 = p0 + g0v * v0; v1 = p1 + g1v * v1;
            *(u32x4*)(mg + off) = pack8(v0, v1); }) } };
struct EpiResid { static constexpr bool PERM = true, AFTER_DRAIN = false; const float* xi; float* xo;
    __device__ __forceinline__ void operator()(const f32x4 (&acc)[2][2][4][2], const Unit& u, int wr, int wc, int fr, int fq) const {
        PG8_EPI_LOOP({
            const size_t off = (size_t)row * 1024 + u.pn * BM + ct;
            const f32x4 a = *(const f32x4*)(xi + off), b = *(const f32x4*)(xi + off + 4);
            *(f32x4*)(xo + off) = a + v0; *(f32x4*)(xo + off + 4) = b + v1; }) } };
__device__ __forceinline__ u32x2 pack8_fp8(f32x4 v0, f32x4 v1) {
    _Pragma("unroll") for (int i = 0; i < 4; ++i) { v0[i] = fminf(fmaxf(v0[i], -448.f), 448.f); v1[i] = fminf(fmaxf(v1[i], -448.f), 448.f); }
    int a = 0, b = 0; a = __builtin_amdgcn_cvt_pk_fp8_f32(v0[0], v0[1], a, false); a = __builtin_amdgcn_cvt_pk_fp8_f32(v0[2], v0[3], a, true);
    b = __builtin_amdgcn_cvt_pk_fp8_f32(v1[0], v1[1], b, false); b = __builtin_amdgcn_cvt_pk_fp8_f32(v1[2], v1[3], b, true); u32x2 w; w.x = (unsigned)a; w.y = (unsigned)b; return w; }
struct EpiSwiglu { static constexpr bool PERM = true, AFTER_DRAIN = false; unsigned char* hid; float iscale, oscale;
    __device__ __forceinline__ void operator()(const f32x4 (&acc)[2][2][4][2], const Unit& u, int wr, int wc, int fr, int fq) const {
#pragma unroll
        for (int ai = 0; ai < 2; ++ai)
#pragma unroll
            for (int m = 0; m < 4; ++m) { const int row = u.pm * BM + ai * HALF + wr * 64 + m * 16 + fr; const int col = u.pn * 128 + wc * 32 + 8 * fq;
                f32x4 o0, o1;
#pragma unroll
                for (int i = 0; i < 4; ++i) { const float g0 = acc[ai][0][m][0][i] * iscale, g1 = acc[ai][0][m][1][i] * iscale;
                    o0[i] = g0 * __builtin_amdgcn_rcpf(1.0f + __builtin_amdgcn_exp2f(-1.4426950408889634f * g0)) * (acc[ai][1][m][0][i] * iscale);
                    o1[i] = g1 * __builtin_amdgcn_rcpf(1.0f + __builtin_amdgcn_exp2f(-1.4426950408889634f * g1)) * (acc[ai][1][m][1][i] * iscale); }
                *(u32x2*)(hid + (size_t)row * 1024 + col) = pack8_fp8(o0 * oscale, o1 * oscale); } } };
struct EpiDown { static constexpr bool PERM = true, AFTER_DRAIN = false; bf16_t* Y; const float* aff; float iscale;
    __device__ __forceinline__ void operator()(const f32x4 (&acc)[2][2][4][2], const Unit& u, int wr, int wc, int fr, int fq) const {
        PG8_EPI_LOOP({ const float a = aff[row] * iscale; v0 = v0 * a; v1 = v1 * a; *(u32x4*)(Y + (size_t)row * 1024 + u.pn * BM + ct) = pack8(v0, v1); }) } };

template <class Epi, class Sched, bool ALIGN_EPI = false, bool SP2 = false, bool F8 = false>
__device__ __forceinline__ void gemm_phase(PG8_LAS unsigned char* lds, const Gemm g, const Sched& S, const Epi& E) {
    int tid_ = threadIdx.x; asm volatile("" : "+v"(tid_));
    const int tid = tid_, wid = __builtin_amdgcn_readfirstlane(tid >> 6), lane = tid & 63, wr = wid >> 2, wc = wid & 3, fr = lane & 15, fq = lane >> 4;
    const int K = g.K, nt = K / BK, lda = g.lda;
    unsigned voffA[2], voffB[2];
#pragma unroll
    for (int i = 0; i < 2; ++i) { int R, C; stage_rc(tid * 16 + i * 8192, R, C); const int Rb = Epi::PERM ? ((R & ~31) + perm32(R & 31)) : R;
        voffA[i] = (unsigned)(R * lda + C) * 2u; voffB[i] = (unsigned)(Rb * K + C) * 2u; }
    const size_t kstep = (size_t)(BK * 2);
    const size_t hstepA = (size_t)HALF * lda * 2, hstepB = (size_t)HALF * K * 2;
    const size_t tstepA = 2 * hstepA, tstepB = 2 * hstepB;
    const unsigned ldsw = (unsigned)wid * 1024u;
    const int aoff = lds_byte(wr * 64 + fr, fq * 8), boff = lds_byte(wc * 32 + fr, fq * 8);
#define PG8_SA(b, h) (((b) * 2 + (h)) * HTB)
#define PG8_SB(b, h) ((4 + (b) * 2 + (h)) * HTB)
#define PG8_STAGE(bufoff, gbase, voff) do { _Pragma("unroll") for (int _i = 0; _i < 2; ++_i) \
        __builtin_amdgcn_global_load_lds((const unsigned*)((const char*)(gbase) + (voff)[_i]), (PG8_LAS unsigned*)(lds + (bufoff) + ldsw + _i * 8192), 16, 0, 0); } while (0)
#define PG8_LDA(dst, b, h) do { _Pragma("unroll") for (int m = 0; m < 4; ++m) { if constexpr (F8) { dst##8[m] = cat8(*(const PG8_LAS bf16x8*)(lds + PG8_SA(b, h) + aoff + m * 2048), *(const PG8_LAS bf16x8*)(lds + PG8_SA(b, h) + aoff + m * 2048 + 1024)); } \
        else { _Pragma("unroll") for (int k = 0; k < 2; ++k) dst[m][k] = *(const PG8_LAS bf16x8*)(lds + PG8_SA(b, h) + aoff + m * 2048 + k * 1024); } } } while (0)
#define PG8_LDB(dst, b, h) do { _Pragma("unroll") for (int n = 0; n < 2; ++n) { if constexpr (F8) { dst##8[n] = cat8(*(const PG8_LAS bf16x8*)(lds + PG8_SB(b, h) + boff + n * 2048), *(const PG8_LAS bf16x8*)(lds + PG8_SB(b, h) + boff + n * 2048 + 1024)); } \
        else { _Pragma("unroll") for (int k = 0; k < 2; ++k) dst[n][k] = *(const PG8_LAS bf16x8*)(lds + PG8_SB(b, h) + boff + n * 2048 + k * 1024); } } } while (0)
#define PG8_MMA(ai, bj, At, Bt) do { __builtin_amdgcn_s_setprio(1); _Pragma("unroll") for (int m = 0; m < 4; ++m) _Pragma("unroll") for (int n = 0; n < 2; ++n) { \
        if constexpr (F8) { asm volatile("v_mfma_f32_16x16x128_f8f6f4 %0, %1, %2, %0" : "+v"(acc[ai][bj][m][n]) : "v"(Bt##8[n]), "v"(At##8[m])); }     \
        else { _Pragma("unroll") for (int k = 0; k < 2; ++k) acc[ai][bj][m][n] = __builtin_amdgcn_mfma_f32_16x16x32_bf16(Bt[n][k], At[m][k], acc[ai][bj][m][n], 0, 0, 0); } } \
        __builtin_amdgcn_s_setprio(0); } while (0)
#define PG8_WAIT_V(n) asm volatile("s_waitcnt vmcnt(" #n ")" ::: "memory")
#define PG8_WAIT_L(n) asm volatile("s_waitcnt lgkmcnt(" #n ")" ::: "memory")
#define PG8_BAR __builtin_amdgcn_s_barrier()
#define PG8_SCHED __builtin_amdgcn_sched_barrier(0)
    Unit cur, nxt; int ui = 0;
    if (!S.next(0, cur)) return;
    f32x4 acc[2][2][4][2];
#define PG8_Z z0_
    { float z0_ = 0.f; asm volatile("" : "+v"(z0_));
#pragma unroll
    for (int a = 0; a < 2; ++a)
#pragma unroll
        for (int b = 0; b < 2; ++b)
#pragma unroll
            for (int m = 0; m < 4; ++m)
#pragma unroll
                for (int n = 0; n < 2; ++n) acc[a][b][m][n] = (f32x4){PG8_Z, PG8_Z, PG8_Z, PG8_Z}; }
    bf16x8 At[4][2], B0[2][2], B1[2][2]; v8i_t At8[4], B08[2], B18[2]; (void)At; (void)B0; (void)B1; (void)At8; (void)B08; (void)B18;
    const char* cA = (const char*)g.A + (size_t)cur.pm * tstepA; const char* cB = (const char*)g.Bt + g.grp_off(cur.pm) + (size_t)cur.pn * tstepB;
    S.a_ready(cur);
    if constexpr (SP2) {
        PG8_STAGE(PG8_SB(0, 0), cB, voffB); PG8_STAGE(PG8_SB(0, 1), cB + hstepB, voffB); PG8_STAGE(PG8_SA(0, 0), cA, voffA); PG8_STAGE(PG8_SA(0, 1), cA + hstepA, voffA);
        if (wr == 1) PG8_BAR;
        PG8_WAIT_V(2); PG8_BAR;
        PG8_STAGE(PG8_SB(1, 0), cB + kstep, voffB); PG8_STAGE(PG8_SA(1, 0), cA + kstep, voffA); PG8_STAGE(PG8_SB(1, 1), cB + hstepB + kstep, voffB);
        PG8_WAIT_V(6); PG8_BAR;
    } else {
        PG8_STAGE(PG8_SB(0, 0), cB, voffB); PG8_STAGE(PG8_SA(0, 0), cA, voffA); PG8_STAGE(PG8_SB(0, 1), cB + hstepB, voffB); PG8_STAGE(PG8_SA(0, 1), cA + hstepA, voffA);
        if (wr == 1) PG8_BAR;
        PG8_WAIT_V(4); PG8_BAR;
        PG8_STAGE(PG8_SB(1, 0), cB + kstep, voffB); PG8_STAGE(PG8_SA(1, 0), cA + kstep, voffA); PG8_STAGE(PG8_SB(1, 1), cB + hstepB + kstep, voffB);
        PG8_WAIT_V(6); PG8_BAR;
    }
    for (;;) {
        const bool has_next = S.next(ui + 1, nxt);
        const char* nA = has_next ? (const char*)g.A + (size_t)nxt.pm * tstepA : cA; const char* nB = has_next ? (const char*)g.Bt + g.grp_off(nxt.pm) + (size_t)nxt.pn * tstepB : cB;
#pragma unroll 1
        for (int t = 0; t < nt; t += 2) {
            const bool last = (t == nt - 2);
            const char* a1 = cA + (size_t)(t + 1) * kstep;
            const char* a2 = last ? nA : cA + (size_t)(t + 2) * kstep; const char* b2 = last ? nB : cB + (size_t)(t + 2) * kstep;
            const char* a3 = a2 + kstep; const char* b3 = b2 + kstep;
            if (last && has_next) S.a_ready(nxt);
            if constexpr (SP2) {
            PG8_LDB(B0, 0, 0); PG8_LDB(B1, 0, 1); PG8_SCHED; PG8_LDA(At, 0, 0); PG8_STAGE(PG8_SA(1, 1), a1 + hstepA, voffA);
            PG8_WAIT_V(8); PG8_WAIT_L(0); PG8_BAR; PG8_MMA(0, 0, At, B0); PG8_MMA(0, 1, At, B1); PG8_BAR; PG8_SCHED;
            PG8_LDA(At, 0, 1); PG8_STAGE(PG8_SB(0, 0), b2, voffB); PG8_STAGE(PG8_SB(0, 1), b2 + hstepB, voffB); PG8_STAGE(PG8_SA(0, 0), a2, voffA);
            PG8_WAIT_V(8); PG8_WAIT_L(0); PG8_BAR; PG8_MMA(1, 0, At, B0); PG8_MMA(1, 1, At, B1); PG8_BAR; PG8_SCHED;
            PG8_LDB(B0, 1, 0); PG8_LDB(B1, 1, 1); PG8_SCHED; PG8_LDA(At, 1, 0); PG8_STAGE(PG8_SA(0, 1), a2 + hstepA, voffA);
            PG8_WAIT_V(8); PG8_WAIT_L(0); PG8_BAR; PG8_MMA(0, 0, At, B0); PG8_MMA(0, 1, At, B1); PG8_BAR; PG8_SCHED;
            PG8_LDA(At, 1, 1); PG8_STAGE(PG8_SB(1, 0), b3, voffB); PG8_STAGE(PG8_SB(1, 1), b3 + hstepB, voffB); PG8_STAGE(PG8_SA(1, 0), a3, voffA);
            PG8_WAIT_V(8); PG8_WAIT_L(0); PG8_BAR; PG8_MMA(1, 0, At, B0); PG8_MMA(1, 1, At, B1); PG8_BAR; PG8_SCHED;
            } else {
            PG8_LDB(B0, 0, 0); PG8_SCHED; PG8_LDA(At, 0, 0); PG8_STAGE(PG8_SA(1, 1), a1 + hstepA, voffA);
            PG8_WAIT_L(8); PG8_BAR; PG8_WAIT_L(0); PG8_MMA(0, 0, At, B0); PG8_BAR; PG8_SCHED;
            PG8_LDB(B1, 0, 1); PG8_STAGE(PG8_SB(0, 0), b2, voffB);
            PG8_BAR; PG8_WAIT_L(0); PG8_MMA(0, 1, At, B1); PG8_BAR;
            PG8_LDA(At, 0, 1); PG8_STAGE(PG8_SA(0, 0), a2, voffA);
            PG8_BAR; PG8_WAIT_L(0); PG8_MMA(1, 0, At, B0); PG8_BAR; PG8_SCHED;
            PG8_STAGE(PG8_SB(0, 1), b2 + hstepB, voffB);
            PG8_WAIT_V(6); PG8_BAR; PG8_MMA(1, 1, At, B1); PG8_BAR;
            PG8_LDB(B0, 1, 0); PG8_SCHED; PG8_LDA(At, 1, 0); PG8_STAGE(PG8_SA(0, 1), a2 + hstepA, voffA);
            PG8_WAIT_L(8); PG8_BAR; PG8_WAIT_L(0); PG8_MMA(0, 0, At, B0); PG8_BAR; PG8_SCHED;
            PG8_LDB(B1, 1, 1); PG8_STAGE(PG8_SB(1, 0), b3, voffB);
            PG8_BAR; PG8_WAIT_L(0); PG8_MMA(0, 1, At, B1); PG8_BAR;
            PG8_LDA(At, 1, 1); PG8_STAGE(PG8_SA(1, 0), a3, voffA);
            PG8_BAR; PG8_WAIT_L(0); PG8_MMA(1, 0, At, B0); PG8_BAR; PG8_SCHED;
            PG8_STAGE(PG8_SB(1, 1), b3 + hstepB, voffB);
            PG8_WAIT_V(6); PG8_BAR; PG8_MMA(1, 1, At, B1); PG8_BAR;
            }
        }
        if constexpr (F8) { asm volatile("s_nop 15\n\ts_nop 15" ::: "memory"); }
        if constexpr (ALIGN_EPI) { if (wr == 0) PG8_BAR; }
        if constexpr (!Epi::AFTER_DRAIN) { E(acc, cur, wr, wc, fr, fq); S.done(cur); }
        if (!has_next) break;
        { float z0_ = 0.f; asm volatile("" : "+v"(z0_));
#pragma unroll
        for (int a = 0; a < 2; ++a)
#pragma unroll
            for (int b = 0; b < 2; ++b)
#pragma unroll
                for (int m = 0; m < 4; ++m)
#pragma unroll
                    for (int n = 0; n < 2; ++n) acc[a][b][m][n] = (f32x4){PG8_Z, PG8_Z, PG8_Z, PG8_Z}; }
        cur = nxt; cA = nA; cB = nB; ++ui;
        if constexpr (ALIGN_EPI) { if (wr == 1) PG8_BAR; }
    }
    PG8_WAIT_V(0);
    if constexpr (!ALIGN_EPI) { if (wr == 0) PG8_BAR; }
    PG8_BAR;
    if constexpr (Epi::AFTER_DRAIN) { E.fused(acc, cur, wr, wc, fr, fq, lds, wid, lane); S.done(cur); }
#undef PG8_Z
#undef PG8_SA
#undef PG8_SB
#undef PG8_STAGE
#undef PG8_LDA
#undef PG8_LDB
#undef PG8_MMA
#undef PG8_WAIT_V
#undef PG8_WAIT_L
#undef PG8_BAR
#undef PG8_SCHED
}
}

constexpr int NB = 16, SEQ = 4096, DM = 1024, T = NB * SEQ, DEPTH = 2;
constexpr int NEXP = 16, CAP = 512, TE = NB * NEXP * CAP;
constexpr int IN_COLS = 6048;
constexpr float EPS = 1e-6f;
constexpr float LOG2E = 1.4426950408889634f;
constexpr int NWAVES = 8;
constexpr int PH_PER_LAYER = 16, NPHASE = DEPTH * PH_PER_LAYER;

constexpr size_t MiB = 1u << 20;
constexpr size_t WS_CTL = 0, CTL_ZERO_BYTES = 1 * MiB;
constexpr size_t WS_AFFT = 2 * MiB;
constexpr size_t WS_INV = 6 * MiB;
constexpr size_t WS_IDX = 10 * MiB;
constexpr size_t WS_AFFSEL = 10 * MiB + 512 * 1024;
constexpr size_t WS_TMM = 11 * MiB;
constexpr size_t WS_GT = 11 * MiB + 16 * 1024;
constexpr size_t WS_SSP = 2 * MiB;
constexpr size_t WS_WIN = 12 * MiB;
constexpr size_t WS_WUQ = 24 * MiB;
constexpr size_t WS_WUKV = 25 * MiB;
constexpr size_t WS_WBA = 26 * MiB, WS_WBB = 27 * MiB, WS_WBC = 28 * MiB;
constexpr size_t WS_WO = 29 * MiB;
constexpr size_t WS_WGU = 32 * MiB;
constexpr size_t WS_WD = 64 * MiB;
constexpr size_t WS_WG8 = 80 * MiB;
constexpr size_t WS_H8 = 864 * MiB;
constexpr float W8_SCALE = 64.0f, HID_SCALE = 4.0f;
constexpr int W8_E8M0 = 127 - 6, HID_E8M0 = 127 - 2, ONE_E8M0 = 127;
constexpr size_t WS_H = 128 * MiB;
constexpr size_t WS_QA = 256 * MiB, WS_QC = 320 * MiB, WS_KA = 384 * MiB, WS_VA = 448 * MiB, WS_CQKC = 512 * MiB;
constexpr size_t WS_CKV = 576 * MiB, WS_VCKR = 608 * MiB;
constexpr size_t WS_G0 = 384 * MiB, WS_G1 = 512 * MiB;
constexpr size_t WS_QB = 640 * MiB;
constexpr size_t WS_KVR = 736 * MiB;
constexpr size_t WS_G2 = 736 * MiB;
constexpr size_t WS_KB = 864 * MiB;
constexpr size_t WS_OB = 960 * MiB;
constexpr size_t WS_XG = 256 * MiB;
constexpr size_t WS_HID = 512 * MiB;
constexpr size_t WS_END = 1024 * MiB;

constexpr int RING_OFF = 0, RING_BYTES = 131072;
constexpr int LDS_BYTES = 163840;
constexpr int LDSCTL_OFF = LDS_BYTES - 1024, MISC_OFF = LDSCTL_OFF + 320;
constexpr int ATT_NXT_OFF = LDSCTL_OFF - 64;
constexpr int ATT_STASH_OFF = 86528;

#define LAS __attribute__((address_space(3)))
typedef unsigned short bf16;
typedef unsigned v4u __attribute__((ext_vector_type(4)));
typedef unsigned v2u __attribute__((ext_vector_type(2)));
typedef float f32x4 __attribute__((ext_vector_type(4)));
typedef float f32x2 __attribute__((ext_vector_type(2)));
typedef float f32x16 __attribute__((ext_vector_type(16)));
typedef short bf16x8 __attribute__((ext_vector_type(8)));
typedef short s16x4 __attribute__((ext_vector_type(4)));
#define LDS_WAIT() asm volatile("s_waitcnt lgkmcnt(0)" ::: "memory")
#define VM_WAIT() asm volatile("s_waitcnt vmcnt(0)" ::: "memory")
__device__ __forceinline__ unsigned pk2(float lo, float hi) { return pg8::cvt_pk_bf16(lo, hi); }
__device__ __forceinline__ float bflo(unsigned w) { return __uint_as_float(w << 16); }
__device__ __forceinline__ float bfhi(unsigned w) { return __uint_as_float(w & 0xffff0000u); }
template <int M> __device__ __forceinline__ float xor_add(float v) {
    if constexpr (M < 32) return v + __int_as_float(__builtin_amdgcn_ds_swizzle(__float_as_int(v), (M << 10) | 0x1f));
    else { auto r = __builtin_amdgcn_permlane32_swap(__float_as_uint(v), __float_as_uint(v), false, false); return __uint_as_float(r[0]) + __uint_as_float(r[1]); } }
template <int M> __device__ __forceinline__ float xor_max(float v) {
    if constexpr (M < 32) return fmaxf(v, __int_as_float(__builtin_amdgcn_ds_swizzle(__float_as_int(v), (M << 10) | 0x1f)));
    else { auto r = __builtin_amdgcn_permlane32_swap(__float_as_uint(v), __float_as_uint(v), false, false); return fmaxf(__uint_as_float(r[0]), __uint_as_float(r[1])); } }
template <int M> __device__ __forceinline__ int xor_geti(int v) { static_assert(M < 32, "xor_geti: masks below 32"); return __builtin_amdgcn_ds_swizzle(v, (M << 10) | 0x1f); }
template <int M> __device__ __forceinline__ float xor_getf(float v) { return __int_as_float(xor_geti<M>(__float_as_int(v))); }
__device__ __forceinline__ unsigned wave_sum_u(unsigned c) {
    c += (unsigned)xor_geti<1>((int)c); c += (unsigned)xor_geti<2>((int)c); c += (unsigned)xor_geti<4>((int)c); c += (unsigned)xor_geti<8>((int)c); c += (unsigned)xor_geti<16>((int)c);
    auto r = __builtin_amdgcn_permlane32_swap(c, c, false, false); return r[0] + r[1]; }
__device__ __forceinline__ float wave_sum(float v) { v = xor_add<1>(v); v = xor_add<2>(v); v = xor_add<4>(v); v = xor_add<8>(v); v = xor_add<16>(v); return xor_add<32>(v); }

#define XB_TMO      128
#define XB_XCNT(j)  (256  + 64 * (j))
#define XB_XSUB(j)  (1280 + 64 * (j))
#define XB_XGEN(j)  (2304 + 64 * (j))
#define XB_TOP      3328
#define XB_TOPGEN   3392
#define XCD_BAR_WORDS 3456
#define XB_SPIN_CAP (1u << 23)

__device__ __forceinline__ unsigned xb_ld(unsigned* p)              { return __hip_atomic_load(p, __ATOMIC_RELAXED, __HIP_MEMORY_SCOPE_AGENT); }
__device__ __forceinline__ unsigned xb_add(unsigned* p, unsigned v) { return __hip_atomic_fetch_add(p, v, __ATOMIC_RELAXED, __HIP_MEMORY_SCOPE_AGENT); }
__device__ __forceinline__ unsigned xb_xcc_id() { return (unsigned)__builtin_amdgcn_s_getreg((3 << 11) | 20) & 0xFu; }
#define XB_SPIN(cond, bar) do { unsigned _sp = 0; while (cond) { __builtin_amdgcn_s_sleep(1); \
    if ((++_sp & 255u) == 0u) { if (xb_ld(&(bar)[XB_TMO])) break; if (_sp > XB_SPIN_CAP) { atomicAdd(&(bar)[XB_TMO], 1u); break; } } } } while (0)

struct XcdBarrier { unsigned* bar; unsigned x; volatile LAS unsigned* st; };

__device__ __forceinline__ XcdBarrier xcd_barrier_post(unsigned* bar, volatile LAS unsigned* st) {
    XcdBarrier b; b.bar = bar; b.x = xb_xcc_id(); b.st = st;
    if (threadIdx.x == 0) (void)xb_add(&bar[XB_XCNT(b.x)], 1u);
    return b;
}
__device__ __forceinline__ void xcd_barrier_complete(unsigned* bar, unsigned x, unsigned& nloc, unsigned& nx) {
    const unsigned G = gridDim.x * gridDim.y * gridDim.z;
    unsigned sum, cnt, mine, sp = 0u;
    for (;;) {
        sum = 0u; cnt = 0u; mine = 0u;
#pragma unroll
        for (unsigned j = 0; j < 16; ++j) { const unsigned c = xb_ld(&bar[XB_XCNT(j)]); sum += c; cnt += (c > 0u) ? 1u : 0u; mine = (j == x) ? c : mine; }
        if (sum == G) break;
        __builtin_amdgcn_s_sleep(1);
        if ((++sp & 255u) == 0u) { if (xb_ld(&bar[XB_TMO])) break; if (sp > XB_SPIN_CAP) { atomicAdd(&bar[XB_TMO], 1u); break; } }
    }
    nloc = mine > 0u ? mine : 1u; nx = cnt > 0u ? cnt : 1u;
}
__device__ __forceinline__ void xcd_barrier(const XcdBarrier& b) {
    asm volatile("s_waitcnt vmcnt(0)" ::: "memory");
    __syncthreads();
    if (threadIdx.x == 0) {
        unsigned* bar = b.bar;
        __builtin_amdgcn_s_waitcnt(0);
        unsigned nloc = b.st[0], nx = b.st[1];
        if (nloc == 0u) { xcd_barrier_complete(bar, b.x, nloc, nx); b.st[0] = nloc; b.st[1] = nx; }
        const unsigned old = xb_add(&bar[XB_XSUB(b.x)], 1u);
        const unsigned gen = old / nloc;
        if (old + 1u == (gen + 1u) * nloc) {
            __builtin_amdgcn_fence(__ATOMIC_RELEASE, "agent");
            asm volatile("s_waitcnt vmcnt(0)" ::: "memory");
            const unsigned og = xb_add(&bar[XB_TOP], 1u);
            const unsigned tg = og / nx;
            if (og + 1u == (tg + 1u) * nx) xb_add(&bar[XB_TOPGEN], 1u);
            else XB_SPIN(xb_ld(&bar[XB_TOPGEN]) == tg, bar);
            __builtin_amdgcn_fence(__ATOMIC_ACQUIRE, "agent");
            xb_add(&bar[XB_XGEN(b.x)], 1u);
            asm volatile("s_waitcnt vmcnt(0)" ::: "memory");
        } else {
            XB_SPIN(xb_ld(&bar[XB_XGEN(b.x)]) == gen, bar);
            __builtin_amdgcn_fence(__ATOMIC_ACQUIRE, "agent");
            asm volatile("s_waitcnt vmcnt(0)" ::: "memory");
        }
    }
    __syncthreads();
}

struct Frame {
    LAS unsigned char* lds;
    int wave, vcu, G;
};

__device__ __forceinline__ void cvt_block(const float* W, int K, int Nsrc, int k0, int n0, bf16* WT, int drow0, LAS float* scr, int lane, const float* kscale = nullptr) {
    float wv_[32];
#pragma unroll
    for (int i = 0; i < 32; ++i) wv_[i] = W[(size_t)(k0 + 2 * i + (lane >> 5)) * Nsrc + n0 + (lane & 31)];
    if (kscale) {
#pragma unroll
        for (int i = 0; i < 32; ++i) wv_[i] *= kscale[k0 + 2 * i + (lane >> 5)]; }
#pragma unroll
    for (int i = 0; i < 32; ++i) scr[(2 * i + (lane >> 5)) * 33 + (lane & 31)] = wv_[i];
    LDS_WAIT(); asm volatile("" ::: "memory");
    const int c = lane & 7;
#pragma unroll
    for (int j = 0; j < 4; ++j) { const int n = (lane >> 3) + 8 * j; const LAS float* s = scr + (8 * c) * 33 + n;
        v4u o; o.x = pk2(s[0 * 33], s[1 * 33]); o.y = pk2(s[2 * 33], s[3 * 33]); o.z = pk2(s[4 * 33], s[5 * 33]); o.w = pk2(s[6 * 33], s[7 * 33]);
        *(v4u*)(WT + (size_t)(drow0 + n) * K + k0 + 8 * c) = o; }
    LDS_WAIT(); asm volatile("" ::: "memory");
}
__device__ __forceinline__ void cvt_block8(const float* W, int K, int Nsrc, int k0, int n0, unsigned char* WT8, int drow0, float scale, LAS float* scr, int lane) {
    float wv_[32];
#pragma unroll
    for (int i = 0; i < 32; ++i) wv_[i] = W[(size_t)(k0 + 2 * i + (lane >> 5)) * Nsrc + n0 + (lane & 31)];
#pragma unroll
    for (int i = 0; i < 32; ++i) scr[(2 * i + (lane >> 5)) * 33 + (lane & 31)] = wv_[i];
    LDS_WAIT(); asm volatile("" ::: "memory");
    const int c = lane & 7;
#pragma unroll
    for (int j = 0; j < 4; ++j) { const int n = (lane >> 3) + 8 * j; const LAS float* s = scr + (8 * c) * 33 + n;
        const f32x4 a = {s[0 * 33] * scale, s[1 * 33] * scale, s[2 * 33] * scale, s[3 * 33] * scale}, b = {s[4 * 33] * scale, s[5 * 33] * scale, s[6 * 33] * scale, s[7 * 33] * scale};
        const pg8::u32x2 w = pg8::pack8_fp8(a, b); v2u o; o.x = w.x; o.y = w.y;
        *(v2u*)(WT8 + (size_t)(drow0 + n) * K + k0 + 8 * c) = o; }
    LDS_WAIT(); asm volatile("" ::: "memory");
}
__device__ __forceinline__ int win_row(int n0) {
    if (n0 < 512) { const int m = n0 >> 8, h = (n0 & 255) >> 6, d = n0 & 63; return h * 128 + m * 64 + d; }
    if (n0 < 1024) return 1024 + (n0 - 512);
    if (n0 < 1536) return 1536 + (n0 - 1024);
    if (n0 < 1920) return 2048 + (n0 - 1536);
    if (n0 < 2176) return 2560 + (n0 - 1920);
    if (n0 < 2208) return 2944 + (n0 - 2176);
    if (n0 < 2720) return 512 + (n0 - 2208);
    if (n0 < 2848) return 2432 + (n0 - 2720);
    if (n0 < 2976) return 2816 + (n0 - 2848);
    return 3072 + (n0 - 2976);
}
__device__ __forceinline__ int win_row_p(int n0) { const int r = win_row(n0), c = r & 255; return (r & ~255) + (((c >> 5) & 1) << 7) + ((c >> 6) << 5) + (c & 31); }
struct LayerW {
    const float *norm_mix_g, *w_in, *diff_qk_g, *diff_lambda, *diff_out_g, *mla_cq_g, *w_uq, *mla_ckv_g, *w_ukv, *mla_qk_g, *swa_qk_g, *swa_sink,
                *w_ba, *w_bb, *w_bc, *w_o, *norm_ffn_g, *w_router, *w_eg, *w_eu, *w_ed;
};
__device__ __forceinline__ void p_convert(const Frame& F, const LayerW& L, unsigned char* ws) {
    int tid_ = threadIdx.x; asm volatile("" : "+v"(tid_)); const int tid = tid_, lane = tid & 63; (void)tid; (void)lane;
    LAS float* scr = (LAS float*)(F.lds + RING_OFF + F.wave * 16384);
    const int gw = F.vcu * NWAVES + F.wave, NGW = F.G * NWAVES;
    constexpr int I_IN = 16 * 189, I_UQ = 6 * 24, I_UKV = 4 * 32, I_BR = 8 * 32, I_O = 16 * 32, I_E = 16 * 512;
    constexpr int NITEMS = I_IN + I_UQ + I_UKV + 3 * I_BR + I_O + 3 * I_E;
    bf16* win = (bf16*)(ws + WS_WIN);
    for (int it = gw; it < NITEMS; it += NGW) {
        int r = it;
        if (r < I_IN) { const int kb = r / 189, nb = r % 189;
            if (nb < 93) cvt_block(L.w_in, 1024, IN_COLS, kb * 64, nb * 32, win, win_row_p(nb * 32), scr, lane);
            else cvt_block8(L.w_in, 1024, IN_COLS, kb * 64, nb * 32, ws + WS_WG8, nb * 32 - 2976, W8_SCALE, scr, lane);
            continue; } r -= I_IN;
        if (r < I_UQ) { const int kb = r / 24, nb = r % 24; cvt_block(L.w_uq, 384, 768, kb * 64, nb * 32, (bf16*)(ws + WS_WUQ), nb * 32, scr, lane, L.mla_cq_g); continue; } r -= I_UQ;
        if (r < I_UKV) { const int kb = r / 32, nb = r % 32, n0 = nb * 32, h = n0 >> 7, jj = n0 & 127; const int dr = jj < 64 ? h * 64 + jj : 512 + h * 64 + (jj - 64);
            cvt_block(L.w_ukv, 256, 1024, kb * 64, n0, (bf16*)(ws + WS_WUKV), dr, scr, lane, L.mla_ckv_g); continue; } r -= I_UKV;
        if (r < I_BR) { const int kb = r / 32, nb = r % 32; cvt_block(L.w_ba, 512, 1024, kb * 64, nb * 32, (bf16*)(ws + WS_WBA), nb * 32, scr, lane); continue; } r -= I_BR;
        if (r < I_BR) { const int kb = r / 32, nb = r % 32; cvt_block(L.w_bb, 512, 1024, kb * 64, nb * 32, (bf16*)(ws + WS_WBB), nb * 32, scr, lane); continue; } r -= I_BR;
        if (r < I_BR) { const int kb = r / 32, nb = r % 32; cvt_block(L.w_bc, 512, 1024, kb * 64, nb * 32, (bf16*)(ws + WS_WBC), nb * 32, scr, lane); continue; } r -= I_BR;
        if (r < I_O) { const int kb = r / 32, nb = r % 32; cvt_block(L.w_o, 1024, 1024, kb * 64, nb * 32, (bf16*)(ws + WS_WO), nb * 32, scr, lane); continue; } r -= I_O;
        { const int w = r / I_E, q = r % I_E, e = q / 512, qq = q % 512, kb = qq / 32, nb = qq % 32, n0 = nb * 32;
          const int dr = (n0 >> 7) * 256 + (n0 & 127);
          if (w == 0) cvt_block8(L.w_eg + (size_t)e * 1024 * 1024, 1024, 1024, kb * 64, n0, ws + WS_WGU + (size_t)e * 2048 * 1024, dr, W8_SCALE, scr, lane);
          else if (w == 1) cvt_block8(L.w_eu + (size_t)e * 1024 * 1024, 1024, 1024, kb * 64, n0, ws + WS_WGU + (size_t)e * 2048 * 1024, dr + 128, W8_SCALE, scr, lane);
          else cvt_block8(L.w_ed + (size_t)e * 1024 * 1024, 1024, 1024, kb * 64, n0, ws + WS_WD + (size_t)e * 1024 * 1024, n0, W8_SCALE, scr, lane); }
    }
    { const int gt = (F.vcu * NWAVES + F.wave) * 64 + lane, NGT = NGW * 64;
      unsigned z_ = 0u; asm volatile("" : "+v"(z_));
      for (int i = gt; i < 96 * 1024 / 8; i += NGT) { const int blk = i / (32 * 1024 / 8), off = i % (32 * 1024 / 8); const int r0 = 2816 + (blk == 0 ? 192 : (blk == 1 ? 96 : 224));
          *(v4u*)(win + (size_t)r0 * 1024 + (size_t)off * 8) = (v4u){z_, z_, z_, z_}; }
      if (gt < 256) { const int gi = gt >> 6, d = gt & 63; const float QS_ = 0.125f * LOG2E;
          const float v = gi == 0 ? L.diff_qk_g[d] * QS_ : (gi == 1 ? L.swa_qk_g[d] * QS_ : (gi == 2 ? L.diff_qk_g[64 + d] : L.swa_qk_g[64 + d]));
          ((float*)(ws + WS_GT))[gt] = v; } }
}

__device__ __forceinline__ void p_norm1(const Frame& F, const float* x, const float* g, bf16* h) {
    int tid_ = threadIdx.x; asm volatile("" : "+v"(tid_)); const int tid = tid_, lane = tid & 63; (void)tid; (void)lane;
    const int gw = F.vcu * NWAVES + F.wave, NGW = F.G * NWAVES;
    f32x4 gv[4];
#pragma unroll
    for (int j = 0; j < 4; ++j) gv[j] = *((const f32x4*)g + lane + 64 * j);
    for (int row0 = gw * 2; row0 < T; row0 += NGW * 2) {
        f32x4 v[2][4];
#pragma unroll
        for (int rr = 0; rr < 2; ++rr) { const f32x4* xr = (const f32x4*)(x + (size_t)(row0 + rr) * DM) + lane;
#pragma unroll
            for (int j = 0; j < 4; ++j) v[rr][j] = xr[64 * j]; }
#pragma unroll
        for (int rr = 0; rr < 2; ++rr) { float s = 0.f;
#pragma unroll
            for (int j = 0; j < 4; ++j) s += (v[rr][j].x * v[rr][j].x + v[rr][j].y * v[rr][j].y) + (v[rr][j].z * v[rr][j].z + v[rr][j].w * v[rr][j].w);
            const float rs = 1.0f / sqrtf(wave_sum(s) * (1.0f / DM) + EPS);
            v2u* o8 = (v2u*)(h + (size_t)(row0 + rr) * DM) + lane;
#pragma unroll
            for (int j = 0; j < 4; ++j) { v2u o; o.x = pk2(v[rr][j].x * rs * gv[j].x, v[rr][j].y * rs * gv[j].y); o.y = pk2(v[rr][j].z * rs * gv[j].z, v[rr][j].w * rs * gv[j].w); o8[64 * j] = o; } }
    }
}

__device__ __forceinline__ float grp8_sum(float v) { v = xor_add<1>(v); v = xor_add<2>(v); v = xor_add<4>(v); return v; }
struct U8 { float f[8]; };
__device__ __forceinline__ U8 ld8bf(const bf16* p) { const v4u w = *(const v4u*)p; U8 r; r.f[0] = bflo(w.x); r.f[1] = bfhi(w.x); r.f[2] = bflo(w.y); r.f[3] = bfhi(w.y); r.f[4] = bflo(w.z); r.f[5] = bfhi(w.z); r.f[6] = bflo(w.w); r.f[7] = bfhi(w.w); return r; }
__device__ __forceinline__ void st8bf(bf16* p, const U8& r) { v4u w; w.x = pk2(r.f[0], r.f[1]); w.y = pk2(r.f[2], r.f[3]); w.z = pk2(r.f[4], r.f[5]); w.w = pk2(r.f[6], r.f[7]); *(v4u*)p = w; }
__device__ __forceinline__ float ss8(const U8& r) { float s = 0.f;
#pragma unroll
    for (int i = 0; i < 8; ++i) s += r.f[i] * r.f[i];
    return s; }
__device__ __forceinline__ void p_prep1(const Frame& F, const LayerW& L, unsigned char* ws) {
    int tid_ = threadIdx.x; asm volatile("" : "+v"(tid_)); const int tid = tid_, lane = tid & 63; (void)tid; (void)lane;
    const int gw = F.vcu * NWAVES + F.wave, NGW = F.G * NWAVES;
    const float QS = 0.125f * LOG2E;
    float gqa[8], gka[8], gqc[8], gkc[8], gcq[8], gckv[8];
#pragma unroll
    for (int i = 0; i < 8; ++i) { const int d = (lane & 7) * 8 + i;
        gqa[i] = L.diff_qk_g[d] * QS; gka[i] = L.diff_qk_g[64 + d]; gqc[i] = L.swa_qk_g[d] * QS; gkc[i] = L.swa_qk_g[64 + d];
        gcq[i] = lane < 48 ? L.mla_cq_g[lane * 8 + i] : 0.f; gckv[i] = lane < 32 ? L.mla_ckv_g[lane * 8 + i] : 0.f; }
    bf16* QA = (bf16*)(ws + WS_QA); bf16* KA = (bf16*)(ws + WS_KA); bf16* QC = (bf16*)(ws + WS_QC); bf16* CQKC = (bf16*)(ws + WS_CQKC); bf16* CKV = (bf16*)(ws + WS_CKV);
    for (int row0 = gw * 2; row0 < T; row0 += NGW * 2) {
        U8 a[2], b[2], c[2], d[2], e[2];
#pragma unroll
        for (int rr = 0; rr < 2; ++rr) { const int row = row0 + rr; const size_t o512 = (size_t)row * 512 + lane * 8;
            a[rr] = ld8bf(QA + o512); b[rr] = ld8bf(KA + o512); c[rr] = ld8bf(QC + o512); d[rr] = ld8bf(CQKC + o512);
            if (lane < 32) e[rr] = ld8bf(CKV + (size_t)row * 256 + lane * 8); else {
#pragma unroll
                for (int i = 0; i < 8; ++i) e[rr].f[i] = 0.f; } }
#pragma unroll
        for (int rr = 0; rr < 2; ++rr) { const int row = row0 + rr; const size_t o512 = (size_t)row * 512 + lane * 8;
            const float ra = 1.0f / sqrtf(grp8_sum(ss8(a[rr])) * (1.0f / 64) + EPS);
            const float rb = 1.0f / sqrtf(grp8_sum(ss8(b[rr])) * (1.0f / 64) + EPS);
            const float rc = 1.0f / sqrtf(grp8_sum(ss8(c[rr])) * (1.0f / 64) + EPS);
            const float sd = grp8_sum(ss8(d[rr]));
            float tot = lane < 48 ? sd : 0.f; tot = xor_add<8>(tot); tot = xor_add<16>(tot); tot = xor_add<32>(tot);
            const float rd = lane < 48 ? 1.0f / sqrtf(tot * (1.0f / 384) + EPS) : 1.0f / sqrtf(sd * (1.0f / 64) + EPS);
            float se = grp8_sum(ss8(e[rr])); se = xor_add<8>(se); se = xor_add<16>(se);
            const float re = 1.0f / sqrtf(se * (1.0f / 256) + EPS);
#pragma unroll
            for (int i = 0; i < 8; ++i) { a[rr].f[i] *= ra * gqa[i]; b[rr].f[i] *= rb * gka[i]; c[rr].f[i] *= rc * gqc[i]; d[rr].f[i] *= rd * (lane < 48 ? gcq[i] : gkc[i]); e[rr].f[i] *= re * gckv[i]; }
            st8bf(QA + o512, a[rr]); st8bf(KA + o512, b[rr]); st8bf(QC + o512, c[rr]); st8bf(CQKC + o512, d[rr]);
            if (lane < 32) st8bf(CKV + (size_t)row * 256 + lane * 8, e[rr]); }
    }
}

__device__ __forceinline__ void p_prep2(const Frame& F, const LayerW& L, unsigned char* ws, const int* positions) {
    int tid_ = threadIdx.x; asm volatile("" : "+v"(tid_)); const int tid = tid_, lane = tid & 63; (void)tid; (void)lane;
    const int gw = F.vcu * NWAVES + F.wave, NGW = F.G * NWAVES, h = lane >> 3, j = lane & 7;
    const float QS = 0.10206207261596575f * LOG2E;
    float gqn[8], gkn[8], gqr[4], gkr[4], invf[4];
#pragma unroll
    for (int i = 0; i < 8; ++i) { gqn[i] = L.mla_qk_g[8 * j + i] * QS; gkn[i] = L.mla_qk_g[96 + 8 * j + i]; }
#pragma unroll
    for (int i = 0; i < 4; ++i) { gqr[i] = L.mla_qk_g[64 + 4 * j + i] * QS; gkr[i] = L.mla_qk_g[96 + 64 + 4 * j + i];
        const int fi = 4 * (j & 3) + i; invf[i] = (float)(exp2(-(double)fi * (13.287712379549449 / 16.0)) * 0.15915494309189535); }
    bf16* QB = (bf16*)(ws + WS_QB); const bf16* KVR = (const bf16*)(ws + WS_KVR); const bf16* VCKR = (const bf16*)(ws + WS_VCKR); bf16* KB = (bf16*)(ws + WS_KB);
    for (int row0 = gw * 2; row0 < T; row0 += NGW * 2) {
        float posf[2]; U8 qn[2], kn[2]; v2u qw[2], kw[2];
#pragma unroll
        for (int rr = 0; rr < 2; ++rr) { const int row = row0 + rr; posf[rr] = (float)positions[row];
            const bf16* qrow = QB + (size_t)row * 768 + h * 96;
            qn[rr] = ld8bf(qrow + 8 * j); qw[rr] = *(const v2u*)(qrow + 64 + 4 * j);
            kn[rr] = ld8bf(KVR + (size_t)row * 1024 + h * 64 + 8 * j); kw[rr] = *(const v2u*)(VCKR + (size_t)row * 256 + 128 + 4 * j); }
#pragma unroll
        for (int rr = 0; rr < 2; ++rr) { const int row = row0 + rr;
            float cs[4], sn[4];
#pragma unroll
            for (int i = 0; i < 4; ++i) { const double tr = (double)posf[rr] * (double)invf[i]; const float fr = (float)(tr - floor(tr)); cs[i] = __builtin_amdgcn_cosf(fr); sn[i] = __builtin_amdgcn_sinf(fr); }
            bf16* qrow = QB + (size_t)row * 768 + h * 96;
            float qr_[4] = {bflo(qw[rr].x), bfhi(qw[rr].x), bflo(qw[rr].y), bfhi(qw[rr].y)}, qo[4];
#pragma unroll
            for (int i = 0; i < 4; ++i) { const float other = xor_getf<4>(qr_[i]); qo[i] = (j < 4) ? (qr_[i] * cs[i] - other * sn[i]) : (other * sn[i] + qr_[i] * cs[i]); }
            const float sq = ss8(qn[rr]) + (qo[0] * qo[0] + qo[1] * qo[1]) + (qo[2] * qo[2] + qo[3] * qo[3]);
            const float rq = 1.0f / sqrtf(grp8_sum(sq) * (1.0f / 96) + EPS);
#pragma unroll
            for (int i = 0; i < 8; ++i) qn[rr].f[i] *= rq * gqn[i];
            st8bf(qrow + 8 * j, qn[rr]);
            { v2u w; w.x = pk2(qo[0] * rq * gqr[0], qo[1] * rq * gqr[1]); w.y = pk2(qo[2] * rq * gqr[2], qo[3] * rq * gqr[3]); *(v2u*)(qrow + 64 + 4 * j) = w; }
            float kr_[4] = {bflo(kw[rr].x), bfhi(kw[rr].x), bflo(kw[rr].y), bfhi(kw[rr].y)}, ko[4];
#pragma unroll
            for (int i = 0; i < 4; ++i) { const float other = xor_getf<4>(kr_[i]); ko[i] = (j < 4) ? (kr_[i] * cs[i] - other * sn[i]) : (other * sn[i] + kr_[i] * cs[i]); }
            const float sk = ss8(kn[rr]) + (ko[0] * ko[0] + ko[1] * ko[1]) + (ko[2] * ko[2] + ko[3] * ko[3]);
            const float rk = 1.0f / sqrtf(grp8_sum(sk) * (1.0f / 96) + EPS);
#pragma unroll
            for (int i = 0; i < 8; ++i) kn[rr].f[i] *= rk * gkn[i];
            bf16* krow = KB + (size_t)row * 768 + h * 96;
            st8bf(krow + 8 * j, kn[rr]);
            { v2u w; w.x = pk2(ko[0] * rk * gkr[0], ko[1] * rk * gkr[1]); w.y = pk2(ko[2] * rk * gkr[2], ko[3] * rk * gkr[3]); *(v2u*)(krow + 64 + 4 * j) = w; } }
    }
}

__device__ __forceinline__ void p_tile_minmax(const Frame& F, unsigned char* ws, const int* positions) {
    int tid_ = threadIdx.x; asm volatile("" : "+v"(tid_)); const int lane = tid_ & 63;
    const int gw = F.vcu * NWAVES + F.wave, NGW = F.G * NWAVES;
    float* tmm = (float*)(ws + WS_TMM);
    for (int tl = gw; tl < T / 64; tl += NGW) {
        const float p = (float)positions[tl * 64 + lane];
        float hi = p, lo = -p;
        hi = xor_max<1>(hi); hi = xor_max<2>(hi); hi = xor_max<4>(hi); hi = xor_max<8>(hi); hi = xor_max<16>(hi); hi = xor_max<32>(hi);
        lo = xor_max<1>(lo); lo = xor_max<2>(lo); lo = xor_max<4>(lo); lo = xor_max<8>(lo); lo = xor_max<16>(lo); lo = xor_max<32>(lo);
        if (lane == 0) { tmm[tl * 2] = -lo; tmm[tl * 2 + 1] = hi; }
    }
}

__device__ __forceinline__ void p_h_to_fp8(const Frame& F, unsigned char* ws) {
    int tid_ = threadIdx.x; asm volatile("" : "+v"(tid_));
    const size_t gt = (size_t)(F.vcu * NWAVES * 64) + tid_, NGT = (size_t)F.G * NWAVES * 64;
    const v4u* src = (const v4u*)(ws + WS_H); v2u* dst = (v2u*)(ws + WS_H8);
    for (size_t i = gt; i < (size_t)T * DM / 8; i += NGT * 4) {
        v4u x[4];
#pragma unroll
        for (int k = 0; k < 4; ++k) if (i + k * NGT < (size_t)T * DM / 8) x[k] = src[i + k * NGT];
#pragma unroll
        for (int k = 0; k < 4; ++k) if (i + k * NGT < (size_t)T * DM / 8) {
            const f32x4 a0 = {bflo(x[k].x), bfhi(x[k].x), bflo(x[k].y), bfhi(x[k].y)}, a1 = {bflo(x[k].z), bfhi(x[k].z), bflo(x[k].w), bfhi(x[k].w)};
            const pg8::u32x2 w = pg8::pack8_fp8(a0, a1); v2u o; o.x = w.x; o.y = w.y; dst[i + k * NGT] = o; }
    }
}

namespace att {
__device__ __forceinline__ int crow(int r, int hi) { return (r & 3) + 8 * (r >> 2) + 4 * hi; }
#define ATT_SBAR() __builtin_amdgcn_sched_barrier(0)
typedef float f32x2_t __attribute__((ext_vector_type(2))); typedef __bf16 bf16x2_t __attribute__((ext_vector_type(2)));
__device__ __forceinline__ unsigned cvtpk(float lo, float hi) { f32x2_t v = {lo, hi}; bf16x2_t b = __builtin_convertvector(v, bf16x2_t); return __builtin_bit_cast(unsigned, b); }

struct Args {
    const bf16* Q; const bf16* K; const bf16* V;
    int pq, pk, pv;
    const int* pos;
    float slope2, sink2;
    float mfix;
};
typedef short v4i16_t __attribute__((ext_vector_type(4)));
__device__ __forceinline__ s16x4 vtr(const LAS unsigned char* p) { return __builtin_bit_cast(s16x4, __builtin_amdgcn_ds_read_tr16_b64_v4i16((LAS v4i16_t*)p)); }
__device__ __forceinline__ float max3f(float a, float b, float c) { return __builtin_fmaxf(__builtin_fmaxf(a, b), c); }
template <int DQK, int DV, int MODE, int ABL = 0>
__device__ __forceinline__ void attn_core(const Args& A, int q0, unsigned long long tmask, LAS unsigned char* lds, float (&res)[DV / 32][16]) {
    constexpr int KSTR = DQK * 2 + 16, KBYTES = 64 * KSTR, VBYTES = 64 * DV * 2, PBYTES = 256;
    constexpr int BUF = KBYTES + VBYTES + PBYTES;
    constexpr int CPR = DQK / 8, NKP = 64 * CPR, KP = (NKP + 511) / 512, VP = (64 * DV / 8) / 512, ND0 = DV / 32, NKS = DQK / 16;
    constexpr float THR = 6.0f;
    static_assert(2 * BUF + 8 * 256 <= ATT_STASH_OFF, "attention LDS");
    int tid_ = threadIdx.x; asm volatile("" : "+v"(tid_));
    const int tid = tid_, lane = tid & 63, wid = __builtin_amdgcn_readfirstlane(tid >> 6), r32 = lane & 31, hi = lane >> 5;
    LAS float* wsf = (LAS float*)(lds + 2 * BUF) + wid * 64;

    bf16x8 qr[NKS];
#pragma unroll
    for (int d0 = 0; d0 < NKS; ++d0) qr[d0] = *(const bf16x8*)(A.Q + (size_t)(q0 + wid * 32 + r32) * A.pq + d0 * 16 + hi * 8);
    float pqf = 0.f;
    if (MODE == 1) pqf = (float)A.pos[q0 + wid * 32 + r32];
    if (MODE == 2) pqf = (float)(q0 + wid * 32 + r32);

    f32x16 o[ND0];
#pragma unroll
    for (int d = 0; d < ND0; ++d)
#pragma unroll
        for (int r = 0; r < 16; ++r) o[d][r] = 0.f;
    float l_reg = (MODE == 2 && hi == 0) ? __builtin_amdgcn_exp2f(A.sink2 - A.mfix) : 0.f;
    f32x16 negm;
#pragma unroll
    for (int r = 0; r < 16; ++r) negm[r] = -A.mfix;

    bf16x8 sk[KP], sv[VP]; float spos = 0.f;
    unsigned gk_off[KP], lk_off[KP], gv_off[VP], lv_off[VP];
#pragma unroll
    for (int i = 0; i < KP; ++i) { const int p = tid + 512 * i, row = p / CPR, ch = p % CPR; gk_off[i] = (unsigned)(row * A.pk + ch * 8) * 2u; lk_off[i] = (unsigned)(row * KSTR + ch * 16); }
#pragma unroll
    for (int i = 0; i < VP; ++i) { const int p = tid + 512 * i, db = p >> 8, row = (p & 255) >> 2, c4 = p & 3; gv_off[i] = (unsigned)(row * A.pv + db * 32 + c4 * 8) * 2u;
        lv_off[i] = (unsigned)(KBYTES + db * 4096 + (row >> 4) * 1024 + (row & 15) * 64 + c4 * 16); }
#define ATT_SLOAD(t) do { const int k0_ = (t) * 64; const char* kb_ = (const char*)(A.K + (size_t)k0_ * A.pk); const char* vb_ = (const char*)(A.V + (size_t)k0_ * A.pv); \
    _Pragma("unroll") for (int i = 0; i < KP; ++i) { if (tid + 512 * i < NKP) sk[i] = *(const bf16x8*)(kb_ + gk_off[i]); } \
    _Pragma("unroll") for (int i = 0; i < VP; ++i) sv[i] = *(const bf16x8*)(vb_ + gv_off[i]); \
    if (MODE == 1) { if (tid < 64) spos = (float)A.pos[k0_ + tid]; } if (MODE == 2) { spos = (float)(k0_ + tid); } } while (0)
#define ATT_SWRITE(b) do { LAS unsigned char* base_ = lds + (b) * BUF; \
    _Pragma("unroll") for (int i = 0; i < KP; ++i) { if (tid + 512 * i < NKP) *(LAS bf16x8*)(base_ + lk_off[i]) = sk[i]; } \
    _Pragma("unroll") for (int i = 0; i < VP; ++i) *(LAS bf16x8*)(base_ + lv_off[i]) = sv[i]; \
    if (MODE != 0) { if (tid < 64) *(LAS float*)(base_ + KBYTES + VBYTES + tid * 4) = spos; } } while (0)
#define ATT_VRD(VF, d) do { const LAS unsigned char* vp_ = vbase + (d) * 4096; \
    _Pragma("unroll") for (int ks = 0; ks < 4; ++ks) { VF[2 * ks] = vtr(vp_ + ks * 1024); VF[2 * ks + 1] = vtr(vp_ + ks * 1024 + 512); } } while (0)
#define ATT_PK(L, H) (bf16x8){L[0], L[1], L[2], L[3], H[0], H[1], H[2], H[3]}
#define ATT_MMA(VF, d) do { _Pragma("unroll") for (int ks = 0; ks < 4; ++ks) { if (ABL == 2) o[d][ks] += __builtin_bit_cast(float, (int)pa[ks][0]) + __builtin_bit_cast(float, (int)VF[2 * ks][0] + (int)VF[2 * ks + 1][0]); else o[d] = __builtin_amdgcn_mfma_f32_32x32x16_bf16(pa[ks], ATT_PK(VF[2 * ks], VF[2 * ks + 1]), o[d], 0, 0, 0); } } while (0)

    int t = __builtin_ctzll(tmask); tmask &= tmask - 1;
    ATT_SLOAD(t); ATT_SWRITE(0); __syncthreads();
    for (int cur = 0;; cur ^= 1) {
        const bool more = tmask != 0ull; const int tn = more ? __builtin_ctzll(tmask) : 0; tmask &= tmask - 1;
        LAS unsigned char* bufp = lds + cur * BUF;
        if (more && ABL != 4) ATT_SLOAD(tn);
        f32x16 p0, p1;
        const LAS unsigned char* kb = bufp + r32 * KSTR + hi * 16;
#pragma unroll
        for (int d0 = 0; d0 < NKS; ++d0) {
            const bf16x8 b0 = *(const LAS bf16x8*)(kb + d0 * 32);
            const bf16x8 b1 = *(const LAS bf16x8*)(kb + 32 * KSTR + d0 * 32);
            if (ABL == 2) { if (d0 == 0) { p0 = negm; p1 = negm; } p0[d0] += __builtin_bit_cast(float, (int)b0[0]); p1[d0] += __builtin_bit_cast(float, (int)b1[0]); }
            else if (d0 == 0) { p0 = __builtin_amdgcn_mfma_f32_32x32x16_bf16(b0, qr[0], negm, 0, 0, 0); p1 = __builtin_amdgcn_mfma_f32_32x32x16_bf16(b1, qr[0], negm, 0, 0, 0); }
            else { p0 = __builtin_amdgcn_mfma_f32_32x32x16_bf16(b0, qr[d0], p0, 0, 0, 0); p1 = __builtin_amdgcn_mfma_f32_32x32x16_bf16(b1, qr[d0], p1, 0, 0, 0); }
        }
        const LAS unsigned char* vbase = bufp + KBYTES + ((lane >> 4) & 1) * 32 + (lane & 3) * 8 + (4 * hi + ((lane & 15) >> 2)) * 64;
        s16x4 vfa[8], vfb[8];
        ATT_VRD(vfa, 0);
        if (MODE != 0) {
            const LAS float* pk = (const LAS float*)(bufp + KBYTES + VBYTES);
#pragma unroll
            for (int g = 0; g < 4; ++g) {
                const f32x4 k0v = *(const LAS f32x4*)(pk + 8 * g + 4 * hi), k1v = *(const LAS f32x4*)(pk + 32 + 8 * g + 4 * hi);
#pragma unroll
                for (int i = 0; i < 4; ++i) {
                    const float d0f = fabsf(pqf - k0v[i]), d1f = fabsf(pqf - k1v[i]);
                    float s0 = fmaf(-A.slope2, d0f, p0[4 * g + i]), s1 = fmaf(-A.slope2, d1f, p1[4 * g + i]);
                    if (MODE == 2) { s0 = d0f <= 128.0f ? s0 : -1e30f; s1 = d1f <= 128.0f ? s1 : -1e30f; }
                    p0[4 * g + i] = s0; p1[4 * g + i] = s1;
                }
            }
        }
        float ps0 = 0.f, ps1 = 0.f, ps2 = 0.f, ps3 = 0.f;
#pragma unroll
        for (int r = 0; r < 16; r += 4) {
            if (ABL != 1) { p0[r] = __builtin_amdgcn_exp2f(p0[r]); p0[r + 1] = __builtin_amdgcn_exp2f(p0[r + 1]); p0[r + 2] = __builtin_amdgcn_exp2f(p0[r + 2]); p0[r + 3] = __builtin_amdgcn_exp2f(p0[r + 3]);
            p1[r] = __builtin_amdgcn_exp2f(p1[r]); p1[r + 1] = __builtin_amdgcn_exp2f(p1[r + 1]); p1[r + 2] = __builtin_amdgcn_exp2f(p1[r + 2]); p1[r + 3] = __builtin_amdgcn_exp2f(p1[r + 3]); }
            ps0 += p0[r] + p1[r]; ps1 += p0[r + 1] + p1[r + 1]; ps2 += p0[r + 2] + p1[r + 2]; ps3 += p0[r + 3] + p1[r + 3];
        }
        l_reg += (ps0 + ps1) + (ps2 + ps3);
        bf16x8 pa[4];
#pragma unroll
        for (int s = 0; s < 2; ++s) {
            v4u w0 = {cvtpk(p0[8 * s + 0], p0[8 * s + 1]), cvtpk(p0[8 * s + 2], p0[8 * s + 3]), cvtpk(p0[8 * s + 4], p0[8 * s + 5]), cvtpk(p0[8 * s + 6], p0[8 * s + 7])};
            v4u w1 = {cvtpk(p1[8 * s + 0], p1[8 * s + 1]), cvtpk(p1[8 * s + 2], p1[8 * s + 3]), cvtpk(p1[8 * s + 4], p1[8 * s + 5]), cvtpk(p1[8 * s + 6], p1[8 * s + 7])};
            pa[s] = __builtin_bit_cast(bf16x8, w0); pa[2 + s] = __builtin_bit_cast(bf16x8, w1);
        }
        if (ND0 == 2) { ATT_VRD(vfb, 1); ATT_MMA(vfa, 0); ATT_MMA(vfb, 1); }
        else { ATT_VRD(vfb, 1); ATT_MMA(vfa, 0); ATT_VRD(vfa, 2); ATT_MMA(vfb, 1); ATT_VRD(vfb, 3); ATT_MMA(vfa, 2); ATT_MMA(vfb, 3); }
        if (more && ABL != 4) ATT_SWRITE(cur ^ 1);
        if (ABL != 3) __syncthreads();
        if (!more) break;
        t = tn;
    }
#undef ATT_SLOAD
#undef ATT_SWRITE
#undef ATT_VRD
#undef ATT_PK
#undef ATT_MMA
    { const float lt = xor_add<32>(l_reg); if (hi == 0) wsf[32 + r32] = 1.0f / lt; }
    LDS_WAIT();
#pragma unroll
    for (int g = 0; g < 4; ++g) {
        const f32x4 l0 = *(const LAS f32x4*)(wsf + 32 + 8 * g + 4 * hi);
#pragma unroll
        for (int d = 0; d < ND0; ++d)
#pragma unroll
            for (int i = 0; i < 4; ++i) res[d][4 * g + i] = o[d][4 * g + i] * l0[i];
    }
    LDS_WAIT();
    __syncthreads();
}
template <int DQK, int DV, int ABL = 0>
__device__ __forceinline__ void attn_core_p(const Args& A, int q0, unsigned long long tmask, LAS unsigned char* lds, float (&res)[DV / 32][16]) {
    constexpr int KSTR = DQK * 2 + 16, KBYTES = 64 * KSTR, VBYTES = 64 * DV * 2;
    constexpr int CPR = DQK / 8, NKP = 64 * CPR, KP = (NKP + 511) / 512, VP = (64 * DV / 8) / 512, ND0 = DV / 32, NKS = DQK / 16;
    constexpr int KOFF = 0, VOFF = 2 * KBYTES, WOFF = VOFF + 3 * VBYTES;
    static_assert(WOFF + 8 * 256 <= ATT_STASH_OFF, "attention LDS");
    int tid_ = threadIdx.x; asm volatile("" : "+v"(tid_));
    const int tid = tid_, lane = tid & 63, wid = __builtin_amdgcn_readfirstlane(tid >> 6), r32 = lane & 31, hi = lane >> 5;
    LAS float* wsf = (LAS float*)(lds + WOFF) + wid * 64;
    bf16x8 qr[NKS];
#pragma unroll
    for (int d0 = 0; d0 < NKS; ++d0) qr[d0] = *(const bf16x8*)(A.Q + (size_t)(q0 + wid * 32 + r32) * A.pq + d0 * 16 + hi * 8);
    f32x16 o[ND0];
#pragma unroll
    for (int d = 0; d < ND0; ++d)
#pragma unroll
        for (int r = 0; r < 16; ++r) o[d][r] = 0.f;
    float l_reg = 0.f;
    f32x16 negm;
#pragma unroll
    for (int r = 0; r < 16; ++r) negm[r] = -A.mfix;
    bf16x8 sk[KP], sv[VP];
    unsigned gk_off[KP], lk_off[KP], gv_off[VP], lv_off[VP];
#pragma unroll
    for (int i = 0; i < KP; ++i) { const int p = tid + 512 * i, row = p / CPR, ch = p % CPR; gk_off[i] = (unsigned)(row * A.pk + ch * 8) * 2u; lk_off[i] = (unsigned)(row * KSTR + ch * 16); }
#pragma unroll
    for (int i = 0; i < VP; ++i) { const int p = tid + 512 * i, db = p >> 8, row = (p & 255) >> 2, c4 = p & 3; gv_off[i] = (unsigned)(row * A.pv + db * 32 + c4 * 8) * 2u;
        lv_off[i] = (unsigned)(db * 4096 + (row >> 4) * 1024 + (row & 15) * 64 + c4 * 16); }
#define ATP_SLOAD(t) do { const int k0_ = (t) * 64; const char* kb_ = (const char*)(A.K + (size_t)k0_ * A.pk); const char* vb_ = (const char*)(A.V + (size_t)k0_ * A.pv); \
    _Pragma("unroll") for (int i = 0; i < KP; ++i) { if (tid + 512 * i < NKP) sk[i] = *(const bf16x8*)(kb_ + gk_off[i]); } \
    _Pragma("unroll") for (int i = 0; i < VP; ++i) sv[i] = *(const bf16x8*)(vb_ + gv_off[i]); } while (0)
#define ATP_SWRITE(kslot, vslot) do { LAS unsigned char* kb_ = lds + KOFF + (kslot) * KBYTES; LAS unsigned char* vb_ = lds + VOFF + (vslot) * VBYTES; \
    _Pragma("unroll") for (int i = 0; i < KP; ++i) { if (tid + 512 * i < NKP) *(LAS bf16x8*)(kb_ + lk_off[i]) = sk[i]; } \
    _Pragma("unroll") for (int i = 0; i < VP; ++i) *(LAS bf16x8*)(vb_ + lv_off[i]) = sv[i]; } while (0)
#define ATP_QKT(P0, P1, kslot) do { const LAS unsigned char* kb_ = lds + KOFF + (kslot) * KBYTES + r32 * KSTR + hi * 16; \
    _Pragma("unroll") for (int d0 = 0; d0 < NKS; ++d0) { const bf16x8 b0_ = (ABL == 5 || ABL == 7) ? qr[d0] : *(const LAS bf16x8*)(kb_ + d0 * 32); const bf16x8 b1_ = (ABL == 5 || ABL == 7) ? qr[NKS - 1 - d0] : *(const LAS bf16x8*)(kb_ + 32 * KSTR + d0 * 32); \
        if (ABL == 2) { if (d0 == 0) { P0 = negm; P1 = negm; } P0[d0] += __builtin_bit_cast(float, (int)b0_[0]); P1[d0] += __builtin_bit_cast(float, (int)b1_[0]); } \
        else if (d0 == 0) { P0 = __builtin_amdgcn_mfma_f32_32x32x16_bf16(b0_, qr[0], negm, 0, 0, 0); P1 = __builtin_amdgcn_mfma_f32_32x32x16_bf16(b1_, qr[0], negm, 0, 0, 0); } \
        else { P0 = __builtin_amdgcn_mfma_f32_32x32x16_bf16(b0_, qr[d0], P0, 0, 0, 0); P1 = __builtin_amdgcn_mfma_f32_32x32x16_bf16(b1_, qr[d0], P1, 0, 0, 0); } } } while (0)
#define ATP_SOFT(P0, P1) do { \
    if (ABL != 1) { _Pragma("unroll") for (int r = 0; r < 16; ++r) { P0[r] = __builtin_amdgcn_exp2f(P0[r]); P1[r] = __builtin_amdgcn_exp2f(P1[r]); } } \
    _Pragma("unroll") for (int s_ = 0; s_ < 2; ++s_) { \
        v4u w0_ = {cvtpk(P0[8 * s_ + 0], P0[8 * s_ + 1]), cvtpk(P0[8 * s_ + 2], P0[8 * s_ + 3]), cvtpk(P0[8 * s_ + 4], P0[8 * s_ + 5]), cvtpk(P0[8 * s_ + 6], P0[8 * s_ + 7])}; \
        v4u w1_ = {cvtpk(P1[8 * s_ + 0], P1[8 * s_ + 1]), cvtpk(P1[8 * s_ + 2], P1[8 * s_ + 3]), cvtpk(P1[8 * s_ + 4], P1[8 * s_ + 5]), cvtpk(P1[8 * s_ + 6], P1[8 * s_ + 7])}; \
        pa[s_] = __builtin_bit_cast(bf16x8, w0_); pa[2 + s_] = __builtin_bit_cast(bf16x8, w1_); } } while (0)
#define ATP_SUM(P0, P1) do { float ps0 = 0.f, ps1 = 0.f, ps2 = 0.f, ps3 = 0.f; \
    _Pragma("unroll") for (int r = 0; r < 16; r += 4) { ps0 += P0[r] + P1[r]; ps1 += P0[r + 1] + P1[r + 1]; ps2 += P0[r + 2] + P1[r + 2]; ps3 += P0[r + 3] + P1[r + 3]; } \
    l_reg += (ps0 + ps1) + (ps2 + ps3); } while (0)
#define ATP_VRD(VF, vslot, d) do { const LAS unsigned char* vp_ = lds + VOFF + (vslot) * VBYTES + vlane + (d) * 4096; \
    _Pragma("unroll") for (int ks = 0; ks < 4; ++ks) { if (ABL == 6 || ABL == 7) { VF[2 * ks] = __builtin_bit_cast(s16x4, (unsigned long long)(uintptr_t)vp_ * (ks + 1)); VF[2 * ks + 1] = __builtin_bit_cast(s16x4, (unsigned long long)(uintptr_t)vp_ * (ks + 5)); } else { VF[2 * ks] = vtr(vp_ + ks * 1024); VF[2 * ks + 1] = vtr(vp_ + ks * 1024 + 512); } } } while (0)
#define ATP_PK(L, H) (bf16x8){L[0], L[1], L[2], L[3], H[0], H[1], H[2], H[3]}
#define ATP_MMA(VF, d) do { _Pragma("unroll") for (int ks = 0; ks < 4; ++ks) { if (ABL == 2) o[d][ks] += __builtin_bit_cast(float, (int)pa[ks][0]) + __builtin_bit_cast(float, (int)VF[2 * ks][0] + (int)VF[2 * ks + 1][0]); else o[d] = __builtin_amdgcn_mfma_f32_32x32x16_bf16(pa[ks], ATP_PK(VF[2 * ks], VF[2 * ks + 1]), o[d], 0, 0, 0); } } while (0)
#define ATP_STEP(PC0, PC1, PN0, PN1) do { \
    const bool more1_ = have_next; const int tn1_ = t_next; \
    const bool more2_ = tmask != 0ull; const int tn2_ = more2_ ? __builtin_ctzll(tmask) : 0; tmask &= tmask - 1; \
    if (more2_ && ABL != 4) ATP_SLOAD(tn2_); \
    s16x4 vfa[8], vfb[8]; ATP_VRD(vfa, vc, 0); \
    ATP_QKT(PN0, PN1, more1_ ? (kc ^ 1) : kc);     \
    ATP_SOFT(PC0, PC1); ATT_SBAR();        \
    static_assert(ND0 == 2, "pipelined core: DV = 64"); \
    ATP_VRD(vfb, vc, 1); ATP_SUM(PC0, PC1); ATP_MMA(vfa, 0); ATP_MMA(vfb, 1); ATT_SBAR();     \
    if (more2_ && ABL != 4) ATP_SWRITE(kc, vc == 0 ? 2 : vc - 1); \
    if (ABL != 3) __syncthreads(); \
    kc ^= 1; vc = (vc == 2) ? 0 : vc + 1; have_next = more2_; t_next = tn2_; (void)tn1_; \
    if (!more1_) goto atp_done; } while (0)

    const int vlane = ((lane >> 4) & 1) * 32 + (lane & 3) * 8 + (4 * hi + ((lane & 15) >> 2)) * 64;
    f32x16 pA0, pA1, pB0, pB1; bf16x8 pa[4];
    int kc = 0, vc = 0;
    { const int t_a = __builtin_ctzll(tmask); tmask &= tmask - 1; ATP_SLOAD(t_a); ATP_SWRITE(0, 0); }
    bool have_next = tmask != 0ull; int t_next = have_next ? __builtin_ctzll(tmask) : 0; tmask &= tmask - 1;
    __syncthreads();
    if (have_next) ATP_SLOAD(t_next);
    ATP_QKT(pA0, pA1, 0);
    if (have_next) ATP_SWRITE(1, 1);
    __syncthreads();
    for (;;) { ATP_STEP(pA0, pA1, pB0, pB1); ATP_STEP(pB0, pB1, pA0, pA1); }
atp_done:
#undef ATP_SLOAD
#undef ATP_SWRITE
#undef ATP_QKT
#undef ATP_SOFT
#undef ATP_SUM
#undef ATP_VRD
#undef ATP_PK
#undef ATP_MMA
#undef ATP_STEP
    { const float lt = xor_add<32>(l_reg); if (hi == 0) wsf[32 + r32] = 1.0f / lt; }
    LDS_WAIT();
#pragma unroll
    for (int g = 0; g < 4; ++g) {
        const f32x4 l0 = *(const LAS f32x4*)(wsf + 32 + 8 * g + 4 * hi);
#pragma unroll
        for (int d = 0; d < ND0; ++d)
#pragma unroll
            for (int i = 0; i < 4; ++i) res[d][4 * g + i] = o[d][4 * g + i] * l0[i];
    }
    LDS_WAIT();
    __syncthreads();
}
template <int DQK, int DV, int MODE, int RB, bool QL = false>
__device__ __forceinline__ void attn_core_rb(const Args& A, int q0, unsigned long long tmask, LAS unsigned char* lds, float (&res)[RB][DV / 32][16]) {
    constexpr int KSTR = DQK * 2 + 16, KBYTES = 64 * KSTR, VBYTES = 64 * DV * 2, PBYTES = 256;
    constexpr int BUF = KBYTES + VBYTES + PBYTES;
    constexpr int CPR = DQK / 8, NKP = 64 * CPR, KP = (NKP + 511) / 512, VP = (64 * DV / 8) / 512, ND0 = DV / 32, NKS = DQK / 16;
    static_assert(2 * BUF + 8 * 256 + (QL ? 8 * RB * NKS * 1024 : 0) <= (QL ? ATT_NXT_OFF : ATT_STASH_OFF), "attention LDS");
    int tid_ = threadIdx.x; asm volatile("" : "+v"(tid_));
    const int tid = tid_, lane = tid & 63, wid = __builtin_amdgcn_readfirstlane(tid >> 6), r32 = lane & 31, hi = lane >> 5;
    LAS float* wsf = (LAS float*)(lds + 2 * BUF) + wid * 64;
    LAS bf16x8* qlds = (LAS bf16x8*)(lds + 2 * BUF + 8 * 256) + wid * (RB * NKS * 64) + lane;
    const int wrow = q0 + wid * (32 * RB);

    bf16x8 qr[RB][NKS]; float pqf[RB];
#pragma unroll
    for (int rb = 0; rb < RB; ++rb) {
#pragma unroll
        for (int d0 = 0; d0 < NKS; ++d0) { qr[rb][d0] = *(const bf16x8*)(A.Q + (size_t)(wrow + rb * 32 + r32) * A.pq + d0 * 16 + hi * 8); if (QL) qlds[(rb * NKS + d0) * 64] = qr[rb][d0]; }
        pqf[rb] = 0.f;
        if (MODE == 1) pqf[rb] = (float)A.pos[wrow + rb * 32 + r32];
        if (MODE == 2) pqf[rb] = (float)(wrow + rb * 32 + r32);
    }
    f32x16 o[RB][ND0]; float l_reg[RB];
#pragma unroll
    for (int rb = 0; rb < RB; ++rb) { l_reg[rb] = (MODE == 2 && hi == 0) ? __builtin_amdgcn_exp2f(A.sink2) : 0.f;
#pragma unroll
        for (int d = 0; d < ND0; ++d)
#pragma unroll
            for (int r = 0; r < 16; ++r) o[rb][d][r] = 0.f; }

    bf16x8 sk[KP], sv[VP]; float spos = 0.f;
    unsigned gk_off[KP], lk_off[KP], gv_off[VP], lv_off[VP];
#pragma unroll
    for (int i = 0; i < KP; ++i) { const int p = tid + 512 * i, row = p / CPR, ch = p % CPR; gk_off[i] = (unsigned)(row * A.pk + ch * 8) * 2u; lk_off[i] = (unsigned)(row * KSTR + ch * 16); }
#pragma unroll
    for (int i = 0; i < VP; ++i) { const int p = tid + 512 * i, db = p >> 8, row = (p & 255) >> 2, c4 = p & 3; gv_off[i] = (unsigned)(row * A.pv + db * 32 + c4 * 8) * 2u;
        lv_off[i] = (unsigned)(KBYTES + db * 4096 + (row >> 4) * 1024 + (row & 15) * 64 + c4 * 16); }
#define ATR_SLOAD(t) do { const int k0_ = (t) * 64; const char* kb_ = (const char*)(A.K + (size_t)k0_ * A.pk); const char* vb_ = (const char*)(A.V + (size_t)k0_ * A.pv); \
    _Pragma("unroll") for (int i = 0; i < KP; ++i) { if (tid + 512 * i < NKP) sk[i] = *(const bf16x8*)(kb_ + gk_off[i]); } \
    _Pragma("unroll") for (int i = 0; i < VP; ++i) sv[i] = *(const bf16x8*)(vb_ + gv_off[i]); \
    if (MODE == 1) { if (tid < 64) spos = (float)A.pos[k0_ + tid]; } if (MODE == 2) { spos = (float)(k0_ + tid); } } while (0)
#define ATR_SWRITE(b) do { LAS unsigned char* base_ = lds + (b) * BUF; \
    _Pragma("unroll") for (int i = 0; i < KP; ++i) { if (tid + 512 * i < NKP) *(LAS bf16x8*)(base_ + lk_off[i]) = sk[i]; } \
    _Pragma("unroll") for (int i = 0; i < VP; ++i) *(LAS bf16x8*)(base_ + lv_off[i]) = sv[i]; \
    if (MODE != 0) { if (tid < 64) *(LAS float*)(base_ + KBYTES + VBYTES + tid * 4) = spos; } } while (0)
#define ATR_VRD(VF, d) do { const LAS unsigned char* vp_ = vbase + (d) * 4096; \
    _Pragma("unroll") for (int ks = 0; ks < 4; ++ks) { VF[2 * ks] = vtr(vp_ + ks * 1024); VF[2 * ks + 1] = vtr(vp_ + ks * 1024 + 512); } } while (0)
#define ATR_PK(L, H) (bf16x8){L[0], L[1], L[2], L[3], H[0], H[1], H[2], H[3]}
#define ATR_MMA(VF, d) do { _Pragma("unroll") for (int rb = 0; rb < RB; ++rb) _Pragma("unroll") for (int ks = 0; ks < 4; ++ks) \
        o[rb][d] = __builtin_amdgcn_mfma_f32_32x32x16_bf16(pa[rb][ks], ATR_PK(VF[2 * ks], VF[2 * ks + 1]), o[rb][d], 0, 0, 0); } while (0)

    int t = __builtin_ctzll(tmask); tmask &= tmask - 1;
    ATR_SLOAD(t); ATR_SWRITE(0); __syncthreads();
    for (int cur = 0;; cur ^= 1) {
        const bool more = tmask != 0ull; const int tn = more ? __builtin_ctzll(tmask) : 0; tmask &= tmask - 1;
        LAS unsigned char* bufp = lds + cur * BUF;
        if (more) ATR_SLOAD(tn);
        const LAS unsigned char* vbase = bufp + KBYTES + ((lane >> 4) & 1) * 32 + (lane & 3) * 8 + (4 * hi + ((lane & 15) >> 2)) * 64;
        s16x4 vfa[8], vfb[8];
        if (RB == 1) ATR_VRD(vfa, 0);
        bf16x8 pa[RB][4];
        f32x16 pp[RB][2];
        {
            const f32x16 zero = {0.f, 0.f, 0.f, 0.f, 0.f, 0.f, 0.f, 0.f, 0.f, 0.f, 0.f, 0.f, 0.f, 0.f, 0.f, 0.f};
            const LAS unsigned char* kb = bufp + r32 * KSTR + hi * 16;
#pragma unroll
            for (int d0 = 0; d0 < NKS; ++d0) {
                const bf16x8 b0 = *(const LAS bf16x8*)(kb + d0 * 32);
                const bf16x8 b1 = *(const LAS bf16x8*)(kb + 32 * KSTR + d0 * 32);
#pragma unroll
                for (int rb = 0; rb < RB; ++rb) {
                    const bf16x8 qf = QL ? qlds[(rb * NKS + d0) * 64] : qr[rb][d0];
                    if (d0 == 0) { pp[rb][0] = __builtin_amdgcn_mfma_f32_32x32x16_bf16(b0, qf, zero, 0, 0, 0); pp[rb][1] = __builtin_amdgcn_mfma_f32_32x32x16_bf16(b1, qf, zero, 0, 0, 0); }
                    else { pp[rb][0] = __builtin_amdgcn_mfma_f32_32x32x16_bf16(b0, qf, pp[rb][0], 0, 0, 0); pp[rb][1] = __builtin_amdgcn_mfma_f32_32x32x16_bf16(b1, qf, pp[rb][1], 0, 0, 0); }
                }
            }
        }
#pragma unroll
        for (int rb = 0; rb < RB; ++rb) {
            f32x16 p0 = pp[rb][0], p1 = pp[rb][1];
            if (MODE != 0) {
                const LAS float* pk = (const LAS float*)(bufp + KBYTES + VBYTES);
#pragma unroll
                for (int g = 0; g < 4; ++g) {
                    const f32x4 k0v = *(const LAS f32x4*)(pk + 8 * g + 4 * hi), k1v = *(const LAS f32x4*)(pk + 32 + 8 * g + 4 * hi);
#pragma unroll
                    for (int i = 0; i < 4; ++i) {
                        const float d0f = fabsf(pqf[rb] - k0v[i]), d1f = fabsf(pqf[rb] - k1v[i]);
                        float s0 = fmaf(-A.slope2, d0f, p0[4 * g + i]), s1 = fmaf(-A.slope2, d1f, p1[4 * g + i]);
                        if (MODE == 2) { s0 = d0f <= 128.0f ? s0 : -1e30f; s1 = d1f <= 128.0f ? s1 : -1e30f; }
                        p0[4 * g + i] = s0; p1[4 * g + i] = s1;
                    }
                }
            }
#pragma unroll
            for (int r = 0; r < 16; ++r) { p0[r] = __builtin_amdgcn_exp2f(p0[r]); p1[r] = __builtin_amdgcn_exp2f(p1[r]); }
            float ps0 = p0[0] + p1[0], ps1 = p0[1] + p1[1], ps2 = p0[2] + p1[2], ps3 = p0[3] + p1[3];
#pragma unroll
            for (int r = 4; r < 16; r += 4) { ps0 += p0[r] + p1[r]; ps1 += p0[r + 1] + p1[r + 1]; ps2 += p0[r + 2] + p1[r + 2]; ps3 += p0[r + 3] + p1[r + 3]; }
            l_reg[rb] += (ps0 + ps1) + (ps2 + ps3);
#pragma unroll
            for (int s = 0; s < 2; ++s) {
                v4u w0 = {cvtpk(p0[8 * s + 0], p0[8 * s + 1]), cvtpk(p0[8 * s + 2], p0[8 * s + 3]), cvtpk(p0[8 * s + 4], p0[8 * s + 5]), cvtpk(p0[8 * s + 6], p0[8 * s + 7])};
                v4u w1 = {cvtpk(p1[8 * s + 0], p1[8 * s + 1]), cvtpk(p1[8 * s + 2], p1[8 * s + 3]), cvtpk(p1[8 * s + 4], p1[8 * s + 5]), cvtpk(p1[8 * s + 6], p1[8 * s + 7])};
                pa[rb][s] = __builtin_bit_cast(bf16x8, w0); pa[rb][2 + s] = __builtin_bit_cast(bf16x8, w1);
            }
        }
        if (RB == 2) { _Pragma("unroll") for (int d = 0; d < ND0; ++d) { ATR_VRD(vfa, d); ATR_MMA(vfa, d); } (void)vfb; }
        else if (ND0 == 2) { ATR_VRD(vfb, 1); ATR_MMA(vfa, 0); ATR_MMA(vfb, 1); }
        else { ATR_VRD(vfb, 1); ATR_MMA(vfa, 0); ATR_VRD(vfa, 2); ATR_MMA(vfb, 1); ATR_VRD(vfb, 3); ATR_MMA(vfa, 2); ATR_MMA(vfb, 3); }
        if (more) ATR_SWRITE(cur ^ 1);
        __syncthreads();
        if (!more) break;
        t = tn;
    }
#undef ATR_SLOAD
#undef ATR_SWRITE
#undef ATR_VRD
#undef ATR_PK
#undef ATR_MMA
#pragma unroll
    for (int rb = 0; rb < RB; ++rb) { const float lt = xor_add<32>(l_reg[rb]); if (hi == 0) wsf[rb * 32 + r32] = 1.0f / lt; }
    LDS_WAIT();
#pragma unroll
    for (int rb = 0; rb < RB; ++rb)
#pragma unroll
        for (int g = 0; g < 4; ++g) {
            const f32x4 l0 = *(const LAS f32x4*)(wsf + rb * 32 + 8 * g + 4 * hi);
#pragma unroll
            for (int d = 0; d < ND0; ++d)
#pragma unroll
                for (int i = 0; i < 4; ++i) res[rb][d][4 * g + i] = o[rb][d][4 * g + i] * l0[i];
        }
    LDS_WAIT();
    __syncthreads();
}
template <int ND0> __device__ __forceinline__ void store_rows(const float (&res)[ND0][16], bf16* O, int po, int row0, int lane) {
    asm volatile("" : "+v"(lane));
    const int r32 = lane & 31, hi = lane >> 5;
    bf16* Ow = O + (size_t)row0 * po + r32;
#pragma unroll
    for (int r = 0; r < 16; ++r) { const int orow = crow(r, hi);
#pragma unroll
        for (int d = 0; d < ND0; ++d) Ow[(size_t)orow * po + d * 32] = (bf16)(cvtpk(res[d][r], 0.f) & 0xffffu); }
}
template <int ND0> __device__ __forceinline__ void store_res(const float (&res)[ND0][16], bf16* O, int po, int q0) {
    const int tid = threadIdx.x, lane = tid & 63, wid = __builtin_amdgcn_readfirstlane(tid >> 6), r32 = lane & 31, hi = lane >> 5;
    bf16* Ow = O + (size_t)(q0 + wid * 32) * po + r32;
#pragma unroll
    for (int r = 0; r < 16; ++r) { const int orow = crow(r, hi);
#pragma unroll
        for (int d = 0; d < ND0; ++d) Ow[(size_t)orow * po + d * 32] = (bf16)(cvtpk(res[d][r], 0.f) & 0xffffu); }
}
}

__device__ __forceinline__ float lam_init_of(int layer) { return layer == 0 ? 0.2f : 0.35550906759096184f; }
template <bool DRY> __device__ __forceinline__ void att_sec_A(const Frame& F, const float* diff_qk_g, const float* diff_lambda, const float* diff_out_g, unsigned char* ws, const int* positions, int layer) {
    int tid_ = threadIdx.x; asm volatile("" : "+v"(tid_)); const int lane = tid_ & 63, r32 = lane & 31;
    LAS unsigned char* lds = F.lds + RING_OFF;
    const float* lp = diff_lambda;
    const float s1 = wave_sum(lp[lane] * lp[64 + lane]), s2 = wave_sum(lp[128 + lane] * lp[192 + lane]);
    const float li = lam_init_of(layer);
    const float lam = __expf(s1) - __expf(s2) + li;
    const float osc = 1.0f - li;
    float gq = fabsf(diff_qk_g[lane]), gk = fabsf(diff_qk_g[64 + lane]);
    gq = xor_max<1>(gq); gq = xor_max<2>(gq); gq = xor_max<4>(gq); gq = xor_max<8>(gq); gq = xor_max<16>(gq); gq = xor_max<32>(gq);
    gk = xor_max<1>(gk); gk = xor_max<2>(gk); gk = xor_max<4>(gk); gk = xor_max<8>(gk); gk = xor_max<16>(gk); gk = xor_max<32>(gk);
    const float reach = 2.0f * (8.0f * gq * gk * 1.01f) + 30.0f;
    const float* tmm = (const float*)(ws + WS_TMM);
    constexpr int NU = NB * 16 * 4; const int per = (NU + F.G - 1) / F.G;
    for (int u = F.vcu * per; u < (F.vcu + 1) * per && u < NU; ++u) {
        const int h = u & 3, bq = u >> 2, b = bq >> 4, qb = bq & 15;
        const size_t rb = (size_t)b * SEQ;
        const float slope = exp2f(-2.0f * (float)(h + 1));
        unsigned long long tmask;
        { const float* tq = tmm + (size_t)(b * 64 + qb * 4) * 2;
          const float qlo = fminf(fminf(tq[0], tq[2]), fminf(tq[4], tq[6])), qhi = fmaxf(fmaxf(tq[1], tq[3]), fmaxf(tq[5], tq[7]));
          const float klo = tmm[(size_t)(b * 64 + lane) * 2], khi = tmm[(size_t)(b * 64 + lane) * 2 + 1];
          const float gap = fmaxf(fmaxf(klo - qhi, qlo - khi), 0.f);
          tmask = __ballot(gap * slope <= reach); }
        att::Args A;
        A.pq = 512; A.pk = 512; A.pv = 512; A.pos = positions + rb; A.slope2 = slope * LOG2E; A.sink2 = 0.f;
        A.V = (const bf16*)(ws + WS_VA) + rb * 512 + h * 128;
        LAS unsigned* stash = (LAS unsigned*)(lds + ATT_STASH_OFF) + F.wave * 2048 + lane;
        {
            A.Q = (const bf16*)(ws + WS_QA) + rb * 512 + h * 128; A.K = (const bf16*)(ws + WS_KA) + rb * 512 + h * 64;
            float r0[1][4][16];
            att::attn_core_rb<64, 128, 1, 1>(A, qb * 256, tmask, lds, r0);
#pragma unroll
            for (int d = 0; d < 4; ++d)
#pragma unroll
                for (int r = 0; r < 8; ++r) stash[(d * 8 + r) * 64] = att::cvtpk(r0[0][d][2 * r], r0[0][d][2 * r + 1]);
        }
        float res[1][4][16];
        A.Q = (const bf16*)(ws + WS_QA) + rb * 512 + h * 128 + 64; A.K = (const bf16*)(ws + WS_KA) + rb * 512 + (4 + h) * 64;
        att::attn_core_rb<64, 128, 1, 1>(A, qb * 256, tmask, lds, res);
        float gcol[4];
#pragma unroll
        for (int d = 0; d < 4; ++d) gcol[d] = diff_out_g[d * 32 + r32] * osc;
#pragma unroll
        for (int r = 0; r < 16; ++r) {
            float s = 0.f;
#pragma unroll
            for (int d = 0; d < 4; ++d) { const unsigned w = stash[(d * 8 + (r >> 1)) * 64]; const float a0 = (r & 1) ? bfhi(w) : bflo(w); const float v = a0 - lam * res[0][d][r]; res[0][d][r] = v; s += v * v; }
            s = xor_add<1>(s); s = xor_add<2>(s); s = xor_add<4>(s); s = xor_add<8>(s); s = xor_add<16>(s);
            const float rs = 1.0f / sqrtf(s * (1.0f / 128) + EPS);
#pragma unroll
            for (int d = 0; d < 4; ++d) res[0][d][r] *= rs * gcol[d];
        }
        att::store_rows<4>(res[0], (bf16*)(ws + (DRY ? WS_OB : WS_QA)) + rb * 512 + h * 128, 512, qb * 256 + F.wave * 32, lane);
    }
}
template <bool DRY> __device__ __forceinline__ void att_sec_C(const Frame& F, const float* swa_sink, unsigned char* ws) {
    int tid_ = threadIdx.x; asm volatile("" : "+v"(tid_)); const int lane = tid_ & 63;
    LAS unsigned char* lds = F.lds + RING_OFF;
    constexpr int NU = NB * 8 * 8; const int per = (NU + F.G - 1) / F.G;
    for (int u = F.vcu * per; u < (F.vcu + 1) * per && u < NU; ++u) {
        const int b = u >> 6, hh = (u >> 3) & 7, qb = u & 7, g = hh >> 2;
        const size_t rb = (size_t)b * SEQ;
        att::Args A;
        A.Q = (const bf16*)(ws + WS_QC) + rb * 512 + hh * 64; A.pq = 512;
        A.K = (const bf16*)(ws + WS_CQKC) + rb * 512 + 384 + g * 64; A.pk = 512;
        A.V = (const bf16*)(ws + WS_VCKR) + rb * 256 + g * 64; A.pv = 256;
        A.pos = nullptr; A.slope2 = exp2f(-(float)(hh + 1)) * LOG2E; A.sink2 = swa_sink[hh] * LOG2E;
        const int q0 = qb * 512; const int k_lo = q0 - 128 < 0 ? 0 : q0 - 128, k_hi = q0 + 512 + 128 > SEQ ? SEQ : q0 + 512 + 128;
        const int tl = k_lo / 64, th = k_hi / 64;
        const unsigned long long tmask = (th >= 64 ? ~0ull : ((1ull << th) - 1ull)) & ~((1ull << tl) - 1ull);
        float res[2][2][16];
        att::attn_core_rb<64, 64, 2, 2, true>(A, q0, tmask, lds, res);
        bf16* O = (bf16*)(ws + (DRY ? WS_OB : WS_QC)) + rb * 512 + hh * 64;
        att::store_rows<2>(res[0], O, 512, q0 + F.wave * 64, lane); att::store_rows<2>(res[1], O, 512, q0 + F.wave * 64 + 32, lane);
    }
}
template <bool DRY> __device__ __forceinline__ void att_sec_B(const Frame& F, unsigned char* ws, int layer) {
    int tid_ = threadIdx.x; asm volatile("" : "+v"(tid_)); const int tid = tid_, lane = tid & 63;
    LAS unsigned char* lds = F.lds + RING_OFF;
    constexpr int NU = NB * 8 * 8;
    unsigned* qbase = (unsigned*)(ws + WS_CTL) + 65536 + (layer * 2 + (DRY ? 1 : 0)) * 8 * 64;
    LAS int* nxt = (LAS int*)(F.lds + ATT_NXT_OFF);
    const int ngrp = 8, per_grp = NU / 8, myq = (F.vcu * 8) / F.G;
    int qi = 0;
    for (;;) {
        if (tid == 0) { int u_ = -1;
            while (qi < ngrp) { const int q = (myq + qi) % ngrp; const unsigned v = __hip_atomic_fetch_add(qbase + q * 64, 1u, __ATOMIC_RELAXED, __HIP_MEMORY_SCOPE_AGENT);
                if (v < (unsigned)per_grp) { u_ = q * per_grp + (int)v; break; } ++qi; }
            nxt[0] = u_; nxt[1] = qi; }
        __syncthreads();
        const int u = __builtin_amdgcn_readfirstlane(nxt[0]); qi = __builtin_amdgcn_readfirstlane(nxt[1]);
        __syncthreads();
        if (u < 0) break;
        const int b = u >> 6, h = (u >> 3) & 7, qb = u & 7;
        const size_t rb = (size_t)b * SEQ;
        att::Args A;
        A.Q = (const bf16*)(ws + WS_QB) + rb * 768 + h * 96; A.pq = 768;
        A.K = (const bf16*)(ws + WS_KB) + rb * 768 + h * 96; A.pk = 768;
        A.V = (const bf16*)(ws + WS_KVR) + rb * 1024 + 512 + h * 64; A.pv = 1024;
        A.pos = nullptr; A.slope2 = 0.f; A.sink2 = 0.f;
        float res[2][2][16];
        att::attn_core_rb<96, 64, 0, 2, true>(A, qb * 512, ~0ull, lds, res);
        bf16* O = (bf16*)(ws + WS_OB) + rb * 512 + h * 64;
        att::store_rows<2>(res[0], O, 512, qb * 512 + F.wave * 64, lane); att::store_rows<2>(res[1], O, 512, qb * 512 + F.wave * 64 + 32, lane);
    }
}
__device__ __forceinline__ void p_attention(const Frame& F, const float* diff_qk_g, const float* diff_lambda, const float* diff_out_g, const float* swa_sink, unsigned char* ws, const int* positions, int layer) {
#if defined(PROBE_SEC_A)
    att_sec_A<true>(F, diff_qk_g, diff_lambda, diff_out_g, ws, positions, layer);
#elif defined(PROBE_SEC_B)
    att_sec_B<true>(F, ws, layer);
#elif defined(PROBE_SEC_C)
    att_sec_C<true>(F, swa_sink, ws);
#endif
#ifndef SKIP_A
    att_sec_A<false>(F, diff_qk_g, diff_lambda, diff_out_g, ws, positions, layer);
#endif
#ifndef SKIP_C
    att_sec_C<false>(F, swa_sink, ws);
#endif
#ifndef SKIP_B
    att_sec_B<false>(F, ws, layer);
#endif
}

#ifdef NAIVE_ATTN
template <int DQK, int DV, int MODE>
__device__ __forceinline__ void naive_row(const bf16* Q, const bf16* K, int pk, const bf16* V, int pv, const int* pos, int t, float slope2, float sink2, int lane, float (&out)[DV / 64]) {
    float m = -1e30f, l = 0.f, acc[DV];
#pragma unroll
    for (int d = 0; d < DV; ++d) acc[d] = 0.f;
    if (MODE == 2 && lane == 0) { m = sink2; l = 1.f; }
    const float pqf = MODE == 1 ? (float)pos[t] : (float)t;
    int k_lo = 0, k_hi = SEQ;
    if (MODE == 2) { k_lo = t - 128 < 0 ? 0 : t - 128; k_hi = t + 129 > SEQ ? SEQ : t + 129; }
    for (int k = k_lo + lane; k < k_hi; k += 64) {
        const bf16* kr = K + (size_t)k * pk; float s = 0.f;
#pragma unroll
        for (int d = 0; d < DQK; d += 2) { const unsigned w = *(const unsigned*)(kr + d); const unsigned qw = *(const volatile unsigned*)(Q + d); s = fmaf(bflo(qw), bflo(w), s); s = fmaf(bfhi(qw), bfhi(w), s); }
        if (MODE == 1) s -= slope2 * fabsf(pqf - (float)pos[k]);
        if (MODE == 2) s -= slope2 * fabsf(pqf - (float)k);
        const float mn = fmaxf(m, s), a = exp2f(m - mn), p = exp2f(s - mn);
        l = l * a + p; m = mn;
        const bf16* vr = V + (size_t)k * pv;
#pragma unroll
        for (int d = 0; d < DV; d += 2) { const unsigned w = *(const unsigned*)(vr + d); acc[d] = fmaf(p, bflo(w), acc[d] * a); acc[d + 1] = fmaf(p, bfhi(w), acc[d + 1] * a); }
    }
    float M = m;
#pragma unroll
    for (int o = 1; o < 64; o <<= 1) M = fmaxf(M, __shfl_xor(M, o));
    const float sc = exp2f(m - M);
    const float L = wave_sum(l * sc);
#pragma unroll
    for (int d = 0; d < DV; ++d) { const float v = wave_sum(acc[d] * sc) / L; if ((d & 63) == lane) out[d >> 6] = v; }
}
__device__ __forceinline__ void p_attention_naive(int vcu, int wave, int G, const float* diff_lambda, const float* diff_out_g, const float* swa_sink, unsigned char* ws, const int* positions, int layer) {
    int tid_ = threadIdx.x; asm volatile("" : "+v"(tid_)); const int lane = tid_ & 63;
    const int gw = vcu * NWAVES + wave, NGW = G * NWAVES;
    const float* lp = diff_lambda;
    const float s1 = wave_sum(lp[lane] * lp[64 + lane]), s2 = wave_sum(lp[128 + lane] * lp[192 + lane]);
    const float li = layer == 0 ? 0.2f : 0.35550906759096184f;
    const float lam = __expf(s1) - __expf(s2) + li, osc = 1.0f - li;
    for (int it = gw; it < T * 4; it += NGW) {
        const int row = it >> 2, h = it & 3, b = row >> 12, t = row & 4095; const size_t rb = (size_t)b * SEQ;
        bf16* Qr = (bf16*)(ws + WS_QA) + (size_t)row * 512 + h * 128;
        float o0[2], o1[2];
        naive_row<64, 128, 1>(Qr, (const bf16*)(ws + WS_KA) + rb * 512 + h * 64, 512, (const bf16*)(ws + WS_VA) + rb * 512 + h * 128, 512, positions + rb, t, exp2f(-2.0f * (float)(h + 1)) * LOG2E, 0.f, lane, o0);
        naive_row<64, 128, 1>(Qr + 64, (const bf16*)(ws + WS_KA) + rb * 512 + (4 + h) * 64, 512, (const bf16*)(ws + WS_VA) + rb * 512 + h * 128, 512, positions + rb, t, exp2f(-2.0f * (float)(h + 1)) * LOG2E, 0.f, lane, o1);
        const float v0 = o0[0] - lam * o1[0], v1 = o0[1] - lam * o1[1];
        const float rs = 1.0f / sqrtf(wave_sum(v0 * v0 + v1 * v1) * (1.0f / 128) + EPS);
        Qr[lane] = (bf16)(pk2(v0 * rs * diff_out_g[lane] * osc, 0.f) & 0xffffu); Qr[64 + lane] = (bf16)(pk2(v1 * rs * diff_out_g[64 + lane] * osc, 0.f) & 0xffffu);
    }
    for (int it = gw; it < T * 8; it += NGW) {
        const int row = it >> 3, h = it & 7, b = row >> 12, t = row & 4095; const size_t rb = (size_t)b * SEQ;
        float o[1];
        naive_row<96, 64, 0>((const bf16*)(ws + WS_QB) + (size_t)row * 768 + h * 96, (const bf16*)(ws + WS_KB) + rb * 768 + h * 96, 768, (const bf16*)(ws + WS_KVR) + rb * 1024 + 512 + h * 64, 1024, nullptr, t, 0.f, 0.f, lane, o);
        ((bf16*)(ws + WS_OB))[(size_t)row * 512 + h * 64 + lane] = (bf16)(pk2(o[0], 0.f) & 0xffffu);
    }
    for (int it = gw; it < T * 8; it += NGW) {
        const int row = it >> 3, hh = it & 7, g = hh >> 2, b = row >> 12, t = row & 4095; const size_t rb = (size_t)b * SEQ;
        bf16* Qr = (bf16*)(ws + WS_QC) + (size_t)row * 512 + hh * 64;
        float o[1];
        naive_row<64, 64, 2>(Qr, (const bf16*)(ws + WS_CQKC) + rb * 512 + 384 + g * 64, 512, (const bf16*)(ws + WS_VCKR) + rb * 256 + g * 64, 256, nullptr, t, exp2f(-(float)(hh + 1)) * LOG2E, swa_sink[hh] * LOG2E, lane, o);
        Qr[lane] = (bf16)(pk2(o[0], 0.f) & 0xffffu);
    }
}
#endif

__device__ __forceinline__ void p_norm2_router(const Frame& F, const float* x, const float* g, const float* w_router, bf16* h2, float* affT) {
    int tid_ = threadIdx.x; asm volatile("" : "+v"(tid_)); const int tid = tid_, lane = tid & 63; (void)tid; (void)lane;
    LAS float* wl = (LAS float*)(F.lds + RING_OFF);
    for (int i = tid; i < 1024 * 16; i += NWAVES * 64) { const int d = i >> 4, e = i & 15; const int j = d >> 8, l = (d & 255) >> 2, c = d & 3, k = e >> 2, ee = e & 3;
        wl[((((j * 4 + c) * 4 + k) * 64 + l) << 2) + ee] = w_router[i]; }
    __syncthreads();
    const int gw = F.vcu * NWAVES + F.wave, NGW = F.G * NWAVES;
    f32x4 gv[4];
#pragma unroll
    for (int j = 0; j < 4; ++j) gv[j] = *((const f32x4*)g + lane + 64 * j);
    for (int row0 = gw * 2; row0 < T; row0 += NGW * 2) {
        f32x4 vv[2][4];
#pragma unroll
        for (int rr = 0; rr < 2; ++rr) { const f32x4* xr = (const f32x4*)(x + (size_t)(row0 + rr) * DM) + lane;
#pragma unroll
            for (int j = 0; j < 4; ++j) vv[rr][j] = xr[64 * j]; }
#pragma unroll
        for (int rr = 0; rr < 2; ++rr) { const int row = row0 + rr;
        f32x4 v[4]; float s = 0.f;
#pragma unroll
        for (int j = 0; j < 4; ++j) { v[j] = vv[rr][j]; s += (v[j].x * v[j].x + v[j].y * v[j].y) + (v[j].z * v[j].z + v[j].w * v[j].w); }
        const float rs = 1.0f / sqrtf(wave_sum(s) * (1.0f / DM) + EPS);
        v2u* o8 = (v2u*)(h2 + (size_t)row * DM) + lane;
        float lg[16];
#pragma unroll
        for (int e = 0; e < 16; ++e) lg[e] = 0.f;
#pragma unroll
        for (int j = 0; j < 4; ++j) {
            v[j] = v[j] * rs * gv[j];
            v2u o; o.x = pk2(v[j].x, v[j].y); o.y = pk2(v[j].z, v[j].w); o8[64 * j] = o;
#pragma unroll
            for (int c = 0; c < 4; ++c) {
#pragma unroll
                for (int k = 0; k < 4; ++k) { const f32x4 w = *(const LAS f32x4*)(wl + ((((j * 4 + c) * 4 + k) * 64 + lane) << 2));
                    lg[4 * k + 0] = fmaf(v[j][c], w.x, lg[4 * k + 0]); lg[4 * k + 1] = fmaf(v[j][c], w.y, lg[4 * k + 1]); lg[4 * k + 2] = fmaf(v[j][c], w.z, lg[4 * k + 2]); lg[4 * k + 3] = fmaf(v[j][c], w.w, lg[4 * k + 3]); }
                __builtin_amdgcn_sched_barrier(0);
            }
        }
        float s8[8], s4[4];
#pragma unroll
        for (int e = 0; e < 8; ++e) { auto r_ = __builtin_amdgcn_permlane32_swap(__float_as_uint(lg[e]), __float_as_uint(lg[e + 8]), false, false); s8[e] = __uint_as_float(r_[0]) + __uint_as_float(r_[1]); }
#pragma unroll
        for (int e = 0; e < 4; ++e) { auto r_ = __builtin_amdgcn_permlane16_swap(__float_as_uint(s8[e]), __float_as_uint(s8[e + 4]), false, false); s4[e] = __uint_as_float(r_[0]) + __uint_as_float(r_[1]); }
#pragma unroll
        for (int e = 0; e < 4; ++e) {
            s4[e] += __int_as_float(__builtin_amdgcn_update_dpp(0, __float_as_int(s4[e]), 0x128, 0xf, 0xf, false));
            s4[e] += __int_as_float(__builtin_amdgcn_update_dpp(0, __float_as_int(s4[e]), 0x124, 0xf, 0xf, false));
            s4[e] += __int_as_float(__builtin_amdgcn_update_dpp(0, __float_as_int(s4[e]), 0x122, 0xf, 0xf, false));
            s4[e] += __int_as_float(__builtin_amdgcn_update_dpp(0, __float_as_int(s4[e]), 0x121, 0xf, 0xf, false));
        }
        float mx = fmaxf(fmaxf(s4[0], s4[1]), fmaxf(s4[2], s4[3]));
        { auto r_ = __builtin_amdgcn_permlane16_swap(__float_as_uint(mx), __float_as_uint(mx), false, false); mx = fmaxf(__uint_as_float(r_[0]), __uint_as_float(r_[1])); }
        mx = xor_max<32>(mx);
        float den = 0.f;
#pragma unroll
        for (int e = 0; e < 4; ++e) { s4[e] = __expf(s4[e] - mx); den += s4[e]; }
        { auto r_ = __builtin_amdgcn_permlane16_swap(__float_as_uint(den), __float_as_uint(den), false, false); den = __uint_as_float(r_[0]) + __uint_as_float(r_[1]); }
        den = xor_add<32>(den);
        const float inv = 1.0f / den;
        const int b = row >> 12, t = row & 4095;
        if ((lane & 15) == 0) { const int e0 = 8 * (lane >> 5) + 4 * ((lane >> 4) & 1);
#pragma unroll
            for (int e = 0; e < 4; ++e) affT[((size_t)(b * NEXP + e0 + e) << 12) + t] = s4[e] * inv; }
        }
    }
    __syncthreads();
}

__device__ __forceinline__ void p_topk_gather(const Frame& F, unsigned char* ws) {
    int tid_ = threadIdx.x; asm volatile("" : "+v"(tid_)); const int tid = tid_, lane = tid & 63; (void)tid; (void)lane;
    LAS unsigned* red = (LAS unsigned*)(F.lds + RING_OFF);
    LAS unsigned* wtot = red + 16;
    LAS int* lidx = (LAS int*)(F.lds + RING_OFF + 256);
    const float* affT = (const float*)(ws + WS_AFFT); int* inv = (int*)(ws + WS_INV); int* idx = (int*)(ws + WS_IDX); float* affsel = (float*)(ws + WS_AFFSEL);
    const bf16* h2 = (const bf16*)(ws + WS_H); unsigned char* xg = ws + WS_XG;
    const int wid = F.wave;
    for (int u = F.vcu; u < NB * NEXP; u += F.G) {
        const int e = u >> 4, b = u & 15;
        const float* src = affT + ((size_t)(b * NEXP + e) << 12) + tid * 8;
        const f32x4 a0 = *(const f32x4*)src, a1 = *(const f32x4*)(src + 4);
        float v[8] = {a0.x, a0.y, a0.z, a0.w, a1.x, a1.y, a1.z, a1.w};
        unsigned long long key[8];
#pragma unroll
        for (int i = 0; i < 8; ++i) key[i] = ((unsigned long long)__float_as_uint(v[i]) << 12) | (unsigned long long)(4095 - (tid * 8 + i));
        unsigned long long Kth = 0ull;
        for (int bit = 43; bit >= 0; --bit) {
            const unsigned long long cand = Kth | (1ull << bit);
            unsigned c = 0;
#pragma unroll
            for (int i = 0; i < 8; ++i) c += (key[i] >= cand) ? 1u : 0u;
            c = wave_sum_u(c);
            LAS unsigned* rb = red + (bit & 1) * 8;
            if (lane == 0) rb[wid] = c;
            __syncthreads();
            unsigned tot = 0;
#pragma unroll
            for (int w = 0; w < 8; ++w) tot += rb[w];
            if (tot >= (unsigned)CAP) Kth = cand;
        }
        unsigned cnt = 0;
#pragma unroll
        for (int i = 0; i < 8; ++i) cnt += (key[i] >= Kth) ? 1u : 0u;
        unsigned incl = cnt;
#pragma unroll
        for (int o = 1; o < 64; o <<= 1) { const unsigned y = (unsigned)__builtin_amdgcn_ds_bpermute(((lane - o) & 63) << 2, (int)incl); if (lane >= o) incl += y; }
        __syncthreads();
        if (lane == 63) wtot[wid] = incl;
        __syncthreads();
        unsigned base = 0;
#pragma unroll
        for (int w = 0; w < 8; ++w) base += (w < wid) ? wtot[w] : 0u;
        unsigned slot = base + incl - cnt;
#pragma unroll
        for (int i = 0; i < 8; ++i) {
            const int t = tid * 8 + i; const bool sel = key[i] >= Kth;
            inv[((size_t)(b * SEQ + t) << 4) + e] = sel ? (int)slot : -1;
            if (sel) { if (slot < (unsigned)CAP) { lidx[slot] = t; idx[u * CAP + slot] = t; affsel[u * CAP + slot] = v[i]; } ++slot; }
        }
        __syncthreads();
        for (int s0 = wid * 4; s0 < CAP; s0 += NWAVES * 4) {
            v4u x0[4], x1[4];
#pragma unroll
            for (int rr = 0; rr < 4; ++rr) { const int t = lidx[s0 + rr]; const v4u* srow = (const v4u*)(h2 + ((size_t)(b * SEQ + t) << 10)) + lane; x0[rr] = srow[0]; x1[rr] = srow[64]; }
#pragma unroll
            for (int rr = 0; rr < 4; ++rr) { v2u* drow = (v2u*)(xg + ((size_t)(u * CAP + s0 + rr) << 10)) + lane;
                const f32x4 a0 = {bflo(x0[rr].x), bfhi(x0[rr].x), bflo(x0[rr].y), bfhi(x0[rr].y)}, a1 = {bflo(x0[rr].z), bfhi(x0[rr].z), bflo(x0[rr].w), bfhi(x0[rr].w)};
                const f32x4 b0 = {bflo(x1[rr].x), bfhi(x1[rr].x), bflo(x1[rr].y), bfhi(x1[rr].y)}, b1 = {bflo(x1[rr].z), bfhi(x1[rr].z), bflo(x1[rr].w), bfhi(x1[rr].w)};
                const pg8::u32x2 wa = pg8::pack8_fp8(a0, a1), wb = pg8::pack8_fp8(b0, b1); v2u oa; oa.x = wa.x; oa.y = wa.y; v2u ob; ob.x = wb.x; ob.y = wb.y;
                drow[0] = oa; drow[64] = ob; }
        }
        __syncthreads();
    }
}

template <bool NORM> __device__ __forceinline__ void p_combine(const Frame& F, unsigned char* ws, float* x, const float* g, bf16* hout) {
    int tid_ = threadIdx.x; asm volatile("" : "+v"(tid_)); const int tid = tid_, lane = tid & 63; (void)tid; (void)lane;
    const int gw = F.vcu * NWAVES + F.wave, NGW = F.G * NWAVES;
    const int* inv = (const int*)(ws + WS_INV); const bf16* Y = (const bf16*)(ws + WS_XG);
    f32x4 gv[4];
#pragma unroll
    for (int j = 0; j < 4; ++j) { if (NORM) gv[j] = *((const f32x4*)g + lane + 64 * j); else gv[j] = (f32x4){0.f, 0.f, 0.f, 0.f}; }
    for (int row0 = gw * 2; row0 < T; row0 += NGW * 2) {
        int sl[2]; f32x4 v[2][4];
#pragma unroll
        for (int rr = 0; rr < 2; ++rr) { sl[rr] = (lane < 16) ? inv[((size_t)(row0 + rr) << 4) + lane] : -1;
            const f32x4* xr = (const f32x4*)(x + (size_t)(row0 + rr) * DM) + lane;
#pragma unroll
            for (int j = 0; j < 4; ++j) v[rr][j] = xr[64 * j]; }
#pragma unroll
        for (int rr = 0; rr < 2; ++rr) { const int b = (row0 + rr) >> 12;
            unsigned long long mask = __ballot(sl[rr] >= 0);
            while (mask) {
                const int e = __builtin_ctzll(mask); mask &= mask - 1;
                const int s = __builtin_amdgcn_readlane(sl[rr], e);
                const v2u* yr = (const v2u*)(Y + ((size_t)(((e << 4) + b) * CAP + s) << 10)) + lane;
#pragma unroll
                for (int j = 0; j < 4; ++j) { const v2u w = yr[64 * j]; v[rr][j].x += bflo(w.x); v[rr][j].y += bfhi(w.x); v[rr][j].z += bflo(w.y); v[rr][j].w += bfhi(w.y); }
            }
            f32x4* xw = (f32x4*)(x + (size_t)(row0 + rr) * DM) + lane;
#pragma unroll
            for (int j = 0; j < 4; ++j) xw[64 * j] = v[rr][j];
            if (NORM) { float s = 0.f;
#pragma unroll
                for (int j = 0; j < 4; ++j) s += (v[rr][j].x * v[rr][j].x + v[rr][j].y * v[rr][j].y) + (v[rr][j].z * v[rr][j].z + v[rr][j].w * v[rr][j].w);
                const float rs = 1.0f / sqrtf(wave_sum(s) * (1.0f / DM) + EPS);
                v2u* o8 = (v2u*)(hout + (size_t)(row0 + rr) * DM) + lane;
#pragma unroll
                for (int j = 0; j < 4; ++j) { v2u o; o.x = pk2(v[rr][j].x * rs * gv[j].x, v[rr][j].y * rs * gv[j].y); o.y = pk2(v[rr][j].z * rs * gv[j].z, v[rr][j].w * rs * gv[j].w); o8[64 * j] = o; } } }
    }
}

struct KArgs { const float* in[23]; const int* positions; float* out; unsigned char* ws; int ph_lo, ph_hi; };
static_assert(sizeof(KArgs) == 23 * 8 + 8 + 8 + 8 + 8, "KArgs has no padding");
__device__ __forceinline__ unsigned long long karg_u64(int off) {
    unsigned long long v; auto kp = __builtin_amdgcn_kernarg_segment_ptr();
    asm volatile("s_load_dwordx2 %0, %1, %2\n\ts_waitcnt lgkmcnt(0)" : "=&s"(v) : "s"(kp), "i"(off) : "memory"); return v; }
#define GASP __attribute__((address_space(1)))
#define KIN(k) ((const float*)(const GASP float*)karg_u64(8 * (k)))
#define KPOS() ((const int*)(const GASP int*)karg_u64(184))
#define KOUT() ((float*)(GASP float*)karg_u64(192))
#define KWS() ((unsigned char*)(GASP unsigned char*)karg_u64(200))
__device__ __forceinline__ LayerW layer_w(int layer) {
    LayerW L;
    L.norm_mix_g = KIN(2) + (size_t)layer * 1024; L.w_in = KIN(3) + (size_t)layer * 1024 * IN_COLS; L.diff_qk_g = KIN(4) + layer * 128; L.diff_lambda = KIN(5) + layer * 256;
    L.diff_out_g = KIN(6) + layer * 128; L.mla_cq_g = KIN(7) + layer * 384; L.w_uq = KIN(8) + (size_t)layer * 384 * 768; L.mla_ckv_g = KIN(9) + layer * 256;
    L.w_ukv = KIN(10) + (size_t)layer * 256 * 1024; L.mla_qk_g = KIN(11) + layer * 192; L.swa_qk_g = KIN(12) + layer * 128; L.swa_sink = KIN(13) + layer * 8;
    L.w_ba = KIN(14) + (size_t)layer * 512 * 1024; L.w_bb = KIN(15) + (size_t)layer * 512 * 1024; L.w_bc = KIN(16) + (size_t)layer * 512 * 1024; L.w_o = KIN(17) + (size_t)layer * 1024 * 1024;
    L.norm_ffn_g = KIN(18) + (size_t)layer * 1024; L.w_router = KIN(19) + (size_t)layer * 1024 * 16;
    L.w_eg = KIN(20) + (size_t)layer * 16 * 1024 * 1024; L.w_eu = KIN(21) + (size_t)layer * 16 * 1024 * 1024; L.w_ed = KIN(22) + (size_t)layer * 16 * 1024 * 1024;
    return L;
}


#ifdef DBG_CHECK
__device__ __forceinline__ unsigned hash_u(unsigned x) { x ^= x >> 16; x *= 0x7feb352du; x ^= x >> 15; x *= 0x846ca68bu; x ^= x >> 16; return x; }
__device__ __forceinline__ float bf2f(bf16 v) { return __uint_as_float((unsigned)v << 16); }
__device__ __forceinline__ void chk_report(unsigned* word, float a, float b, int lane) {
    const float err = fabsf(a - b) / (fabsf(b) + 0.1f);
    if (lane == 0) atomicMax(word, __float_as_uint(err));
}
__device__ __forceinline__ const bf16* proj_loc(unsigned char* ws, int row, int col) {
    const int r = win_row(col), pn = r >> 8, c = r & 255;
    if (pn < 10) return (const bf16*)(ws + WS_QA + (size_t)(pn >> 1) * 64 * MiB) + (size_t)row * 512 + (pn & 1) * 256 + c;
    return (const bf16*)(ws + WS_CKV + (size_t)(pn - 10) * 32 * MiB) + (size_t)row * 256 + c;
}
__device__ __forceinline__ float naive_proj(const bf16* h, const float* w_in, int row, int col, int lane) {
    float s = 0.f;
    for (int k = lane; k < 1024; k += 64) s = fmaf(bf2f(h[(size_t)row * 1024 + k]), w_in[(size_t)k * IN_COLS + col], s);
    return wave_sum(s);
}
__device__ __forceinline__ void p_check(int which, int gw, int NGW, int lane, unsigned char* ws, const float* const* dummy, const float* x_in, const float* xout, const LayerW& L, const int* positions) {
    unsigned* word = (unsigned*)(ws + WS_CTL) + 32768 + which * 64;
    const bf16* h = (const bf16*)(ws + WS_H);
    if (which == 0) {
        for (int s = gw; s < 2048; s += NGW) { const int row = hash_u(s * 2 + 1) % T, col = hash_u(s * 2 + 2) % 2976;
            chk_report(word, bf2f(*proj_loc(ws, row, col)), naive_proj(h, L.w_in, row, col, lane), lane); }
    } else if (which == 1) {
        for (int s = gw; s < 1536; s += NGW) { const int row = hash_u(s * 3 + 5) % T, type = s % 6; const unsigned hg = hash_u(s * 3 + 7);
            if (type < 4) { int c0; const float* g; float qs = 1.f;
                if (type == 0) { c0 = (hg % 8) * 64; g = L.diff_qk_g; qs = 0.125f * LOG2E; } else if (type == 1) { c0 = 512 + (hg % 8) * 64; g = L.diff_qk_g + 64; }
                else if (type == 2) { c0 = 2208 + (hg % 8) * 64; g = L.swa_qk_g; qs = 0.125f * LOG2E; } else { c0 = 2720 + (hg % 2) * 64; g = L.swa_qk_g + 64; }
                float v = 0.f; for (int k = 0; k < 1024; ++k) v = fmaf(bf2f(h[(size_t)row * 1024 + k]), L.w_in[(size_t)k * IN_COLS + c0 + lane], v);
                v = bf2f((bf16)(pk2(v, 0.f) & 0xffffu));
                const float rs = 1.0f / sqrtf(wave_sum(v * v) * (1.0f / 64) + EPS);
                chk_report(word, bf2f(*proj_loc(ws, row, c0 + lane)), v * rs * g[lane] * qs, lane);
                const float e2 = fabsf(bf2f(*proj_loc(ws, row, c0 + lane)) - v * rs * g[lane] * qs) / (fabsf(v * rs * g[lane] * qs) + 0.1f); float m = e2;
                for (int o = 1; o < 64; o <<= 1) m = fmaxf(m, __shfl_xor(m, o)); if (lane == 0) atomicMax(word, __float_as_uint(m));
            } else { const int ng = type == 4 ? 6 : 4, cb = type == 4 ? 1536 : 1920; const float* g = type == 4 ? L.mla_cq_g : L.mla_ckv_g;
                float v[6]; float ss = 0.f;
                _Pragma("unroll") for (int q = 0; q < 6; ++q) { float a = 0.f; if (q < ng) { for (int k = 0; k < 1024; ++k) a = fmaf(bf2f(h[(size_t)row * 1024 + k]), L.w_in[(size_t)k * IN_COLS + cb + q * 64 + lane], a); }
                    a = bf2f((bf16)(pk2(a, 0.f) & 0xffffu)); v[q] = a; ss += a * a; }
                const float rs = 1.0f / sqrtf(wave_sum(ss) / (float)(ng * 64) + EPS); float m = 0.f;
                _Pragma("unroll") for (int q = 0; q < 6; ++q) { if (q < ng) { const float want = v[q] * rs * g[q * 64 + lane]; m = fmaxf(m, fabsf(bf2f(*proj_loc(ws, row, cb + q * 64 + lane)) - want) / (fabsf(want) + 0.1f)); } }
                for (int o = 1; o < 64; o <<= 1) m = fmaxf(m, __shfl_xor(m, o)); if (lane == 0) atomicMax(word, __float_as_uint(m));
            } }
    } else if (which == 2) {
        const bf16* CQ = (const bf16*)(ws + WS_CQKC); const bf16* CKVn = (const bf16*)(ws + WS_CKV); const bf16* VCKR = (const bf16*)(ws + WS_VCKR);
        const bf16* QB = (const bf16*)(ws + WS_QB); const bf16* KB = (const bf16*)(ws + WS_KB);
        for (int s = gw; s < 1024; s += NGW) { const int row = hash_u(s * 5 + 11) % T, hd = hash_u(s * 5 + 13) % 8; const bool isq = s & 1;
            float nope = 0.f, rp = 0.f;
            if (isq) { for (int k = 0; k < 384; ++k) { const float a = bf2f(CQ[(size_t)row * 512 + k]); nope = fmaf(a, L.w_uq[(size_t)k * 768 + hd * 96 + lane], nope); rp = fmaf(a, L.w_uq[(size_t)k * 768 + hd * 96 + 64 + (lane & 31)], rp); } }
            else { for (int k = 0; k < 256; ++k) nope = fmaf(bf2f(CKVn[(size_t)row * 256 + k]), L.w_ukv[(size_t)k * 1024 + hd * 128 + lane], nope); rp = bf2f(VCKR[(size_t)row * 256 + 128 + (lane & 31)]); }
            nope = bf2f((bf16)(pk2(nope, 0.f) & 0xffffu)); if (isq) rp = bf2f((bf16)(pk2(rp, 0.f) & 0xffffu));
            const int i = lane & 15; const float ang = (float)positions[row] * (1.0f / powf(10000.0f, (float)i / 16.0f));
            const float cs = cosf(ang), sn = sinf(ang), other = __shfl_xor(rp, 16);
            float ro = (lane & 16) ? (other * sn + rp * cs) : (rp * cs - other * sn); if (lane >= 32) ro = 0.f;
            const float rs = 1.0f / sqrtf(wave_sum(nope * nope + ro * ro) * (1.0f / 96) + EPS);
            const float* g = L.mla_qk_g + (isq ? 0 : 96); const float qs = isq ? 0.10206207261596575f * LOG2E : 1.f;
            const bf16* dst = (isq ? QB : KB) + (size_t)row * 768 + hd * 96;
            const float w1 = nope * rs * g[lane] * qs; float m = fabsf(bf2f(dst[lane]) - w1) / (fabsf(w1) + 0.1f);
            if (lane < 32) { const float w2 = ro * rs * g[64 + lane] * qs; m = fmaxf(m, fabsf(bf2f(dst[64 + lane]) - w2) / (fabsf(w2) + 0.1f)); }
            for (int o = 1; o < 64; o <<= 1) m = fmaxf(m, __shfl_xor(m, o)); if (lane == 0) atomicMax(word, __float_as_uint(m)); }
    } else if (which == 3) {
        for (int s = gw; s < 2048; s += NGW) { const int row = hash_u(s * 2 + 21) % T, col = hash_u(s * 2 + 22) % 3072;
            const float z = naive_proj(h, L.w_in, row, 2976 + col, lane); const float want = 1.0f / (1.0f + __expf(-z));
            const int gi = col >> 10; const bf16* G = (const bf16*)(ws + (gi == 0 ? WS_G0 : (gi == 1 ? WS_G1 : WS_G2)));
            const float got = bf2f(G[(size_t)row * 1024 + (col & 1023)]);
            chk_report(word, got, want, lane);
            if (lane == 0) { atomicAdd(word + 1024 + gi * 64, 1u); if (fabsf(got - want) / (fabsf(want) + 0.1f) > 0.06f) atomicAdd(word + 2048 + gi * 64, 1u); } }
    } else if (which == 4) {
        for (int s = gw; s < 2048; s += NGW) { const int row = hash_u(s * 2 + 31) % T, c = hash_u(s * 2 + 32) % 1024; float want = 0.f;
            for (int i = 0; i < 3; ++i) { const bf16* O = (const bf16*)(ws + (i == 0 ? WS_QA : (i == 1 ? WS_OB : WS_QC))); const float* Wb = i == 0 ? L.w_ba : (i == 1 ? L.w_bb : L.w_bc);
                const bf16* G = (const bf16*)(ws + (i == 0 ? WS_G0 : (i == 1 ? WS_G1 : WS_G2)));
                float a = 0.f; for (int k = lane; k < 512; k += 64) a = fmaf(bf2f(O[(size_t)row * 512 + k]), Wb[(size_t)k * 1024 + c], a);
                want += bf2f(G[(size_t)row * 1024 + c]) * wave_sum(a); }
            chk_report(word, bf2f(h[(size_t)row * 1024 + c]), want, lane); }
    } else if (which == 6) {
        for (int s = gw; s < 2048; s += NGW) { const int row = hash_u(s * 2 + 51) % T; float ss = 0.f;
            for (int k = lane; k < 1024; k += 64) { const float v = x_in[(size_t)row * 1024 + k]; ss += v * v; }
            const float rs = 1.0f / sqrtf(wave_sum(ss) * (1.0f / 1024) + EPS); float m = 0.f;
            for (int k = lane; k < 1024; k += 64) { const float want = x_in[(size_t)row * 1024 + k] * rs * L.norm_mix_g[k]; m = fmaxf(m, fabsf(bf2f(h[(size_t)row * 1024 + k]) - want) / (fabsf(want) + 0.1f)); }
            for (int o = 1; o < 64; o <<= 1) m = fmaxf(m, __shfl_xor(m, o)); if (lane == 0) atomicMax(word, __float_as_uint(m)); }
    } else if (which == 7 || which == 8) {
        const bf16* wt = (const bf16*)(ws + WS_WIN);
        for (int s = gw; s < 4096; s += NGW) { const int col = which == 7 ? 2976 + (int)(hash_u(s * 2 + 61) % 3072) : (int)(hash_u(s * 2 + 61) % 2976); const int r = win_row(col); float m = 0.f;
            for (int k = lane; k < 1024; k += 64) { const float want = L.w_in[(size_t)k * IN_COLS + col]; m = fmaxf(m, fabsf(bf2f(wt[(size_t)r * 1024 + k]) - want) / (fabsf(want) + 0.01f)); }
            for (int o = 1; o < 64; o <<= 1) m = fmaxf(m, __shfl_xor(m, o)); if (lane == 0) atomicMax(word, __float_as_uint(m)); }
    } else if (which == 9) {
        const bf16* wt = (const bf16*)(ws + WS_WIN);
        for (int s = gw; s < 2048; s += NGW) { const int row = hash_u(s * 2 + 21) % T, col = hash_u(s * 2 + 22) % 3072; float a = 0.f;
            for (int k = lane; k < 1024; k += 64) a = fmaf(bf2f(h[(size_t)row * 1024 + k]), bf2f(wt[(size_t)(3072 + col) * 1024 + k]), a);
            const float z = wave_sum(a), want = 1.0f / (1.0f + __expf(-z));
            const int gi = col >> 10; const bf16* G = (const bf16*)(ws + (gi == 0 ? WS_G0 : (gi == 1 ? WS_G1 : WS_G2)));
            chk_report(word, bf2f(G[(size_t)row * 1024 + (col & 1023)]), want, lane); }
    } else {
        for (int s = gw; s < 2048; s += NGW) { const int row = hash_u(s * 2 + 41) % T, c = hash_u(s * 2 + 42) % 1024;
            float a = 0.f; for (int k = lane; k < 1024; k += 64) a = fmaf(bf2f(h[(size_t)row * 1024 + k]), L.w_o[(size_t)k * 1024 + c], a);
            const float d = wave_sum(a), got = xout[(size_t)row * 1024 + c] - x_in[(size_t)row * 1024 + c];
            chk_report(word, got, d, lane); }
    }
}
__device__ __forceinline__ void p_check_emit(int vcu, int G, unsigned char* ws, float* out) {
    int t_ = threadIdx.x; asm volatile("" : "+v"(t_));
    const unsigned* words = (const unsigned*)(ws + WS_CTL) + 32768;
    int code = 0;
#ifdef DBG_CHECK2
    { const int map_[5] = {6, 7, 8, 9, 3};
      if (__uint_as_float(words[6 * 64]) > 0.06f) code |= 1; if (__uint_as_float(words[7 * 64]) > 0.06f) code |= 2; if (__uint_as_float(words[8 * 64]) > 0.06f) code |= 4;
      if (__uint_as_float(words[9 * 64]) > 0.06f) code |= 8; if (__uint_as_float(words[3 * 64]) > 0.06f) code |= 16; (void)map_; }
#elif defined(DBG_GATEFRAC)
    { const unsigned* w3 = words + 3 * 64;
      for (int gi = 0; gi < 3; ++gi) { const unsigned n = w3[1024 + gi * 64], bad = w3[2048 + gi * 64]; const int f = bad == 0 ? 0 : (bad * 10 < n ? 1 : (bad * 2 < n ? 2 : 3)); code |= f << (2 * gi); } }
#else
    for (int i = 0; i < 6; ++i) if (__uint_as_float(words[i * 64]) > 0.06f) code |= 1 << i;
#endif
    for (size_t i = (size_t)vcu * 512 + t_; i < (size_t)T * DM; i += (size_t)G * 512) out[i] = 0.f;
    __syncthreads();
    if (vcu == 0 && t_ == 0) out[0] = exp2f((float)(code + 20));
}
#endif

__global__ void __launch_bounds__(NWAVES * 64, 2) fwd_kernel(KArgs args) {
    extern __shared__ __attribute__((aligned(16))) unsigned char lds_raw[];
    Frame F;
    F.lds = (LAS unsigned char*)lds_raw;
    F.wave = __builtin_amdgcn_readfirstlane((int)threadIdx.x >> 6);
    F.G = gridDim.x; { const int bx = blockIdx.x; F.vcu = (F.G % 8 == 0) ? (bx % 8) * (F.G / 8) + bx / 8 : bx; }
    volatile LAS unsigned* MISC = (volatile LAS unsigned*)(F.lds + MISC_OFF);
    for (int u = threadIdx.x; u < (LDS_BYTES - LDSCTL_OFF) / 4; u += NWAVES * 64) ((LAS unsigned*)(F.lds + LDSCTL_OFF))[u] = 0u;
    __syncthreads();
#define GRID_BARRIER() do { XcdBarrier b_; b_.bar = (unsigned*)(KWS() + WS_CTL) + 4096; b_.x = xb_xcc_id(); b_.st = (volatile LAS unsigned*)(F.lds + MISC_OFF) + 8; xcd_barrier(b_); } while (0)
#if !MK_MULTI
    (void)xcd_barrier_post((unsigned*)(KWS() + WS_CTL) + 4096, MISC + 8);
#endif
    const int lo = args.ph_lo, hi = args.ph_hi;
#ifdef DBG_CHECK
    if (lo >= 2000) { p_check_emit(F.vcu, F.G, KWS(), KOUT()); return; }
#ifdef DBG_CHECK2
    if (lo >= 1000 && lo < 2000) { const int ph = lo - 1000;
        for (int which = 6; which <= 9; ++which) { const bool run = (ph == 5 && which <= 8) || (ph == 6 && which == 9);
            if (run) { int t_ = threadIdx.x; asm volatile("" : "+v"(t_)); unsigned char* ws = KWS(); const LayerW L = layer_w(0);
                p_check(which, F.vcu * NWAVES + F.wave, F.G * NWAVES, t_ & 63, ws, nullptr, KIN(0), KOUT(), L, KPOS()); } }
    }
#endif
    if (lo >= 1000) { const int ph = lo - 1000; const int which = ph == 1 ? 0 : ph == 2 ? 1 : ph == 4 ? 2 : ph == 6 ? 3 : ph == 9 ? 4 : ph == 10 ? 5 : -1;
        if (which >= 0) { int t_ = threadIdx.x; asm volatile("" : "+v"(t_)); unsigned char* ws = KWS(); const LayerW L = layer_w(0);
            p_check(which, F.vcu * NWAVES + F.wave, F.G * NWAVES, t_ & 63, ws, nullptr, KIN(0), KOUT(), L, KPOS()); }
        return; }
#endif
#ifdef ONLY_PHASE
#define IN(k) ((((k) % PH_PER_LAYER) == ONLY_PHASE) && lo <= (k) && (k) < hi)
#else
#ifdef SKIP_FFN
#define IN(k) ((((k) % PH_PER_LAYER) < 11) && lo <= (k) && (k) < hi)
#else
#define IN(k) (lo <= (k) && (k) < hi)
#endif
#endif
#if MK_MULTI
#define SEAM(k) do { } while (0)
#else
#define SEAM(k) do { if (IN((k) + 1)) { GRID_BARRIER(); } } while (0)
#endif
#define CHK(ph, which) do { } while (0)
#define GEMM_RUN(EPI, g, E) do { pg8::StaticOrder S_; S_.init((g).M, (g).N, F.G, (int)blockIdx.x); pg8::gemm_phase<EPI, pg8::StaticOrder, true, true>(F.lds + RING_OFF, g, S_, E); } while (0)
#define GEMM_RUN_F8(EPI, g, E) do { pg8::StaticOrder S_; S_.init((g).M, (g).N, F.G, (int)blockIdx.x); pg8::gemm_phase<EPI, pg8::StaticOrder, true, true, true>(F.lds + RING_OFF, g, S_, E); } while (0)
#ifdef DUP_SMALL
#define GEMM_RUN3(EPI, g, E) do { GEMM_RUN(EPI, g, E); GRID_BARRIER(); GEMM_RUN(EPI, g, E); } while (0)
#else
#define GEMM_RUN3(EPI, g, E) GEMM_RUN(EPI, g, E)
#endif
#ifdef DUP_GEMM
#define GEMM_RUN2(EPI, g, E) do { GEMM_RUN(EPI, g, E); GRID_BARRIER(); GEMM_RUN(EPI, g, E); } while (0)
#else
#define GEMM_RUN2(EPI, g, E) GEMM_RUN(EPI, g, E)
#endif
    for (int layer = 0; layer < DEPTH; ++layer) {
        const int P = layer * PH_PER_LAYER;
#ifdef DUP_P0
        if (IN(P + 0)) { unsigned char* ws = KWS(); const LayerW L = layer_w(layer); p_convert(F, L, ws); if (layer == 0) p_norm1(F, KIN(0), L.norm_mix_g, (bf16*)(ws + WS_H));     GRID_BARRIER(); }
#endif
        if (IN(P + 0)) { unsigned char* ws = KWS(); const LayerW L = layer_w(layer); p_convert(F, L, ws); if (layer == 0) p_norm1(F, KIN(0), L.norm_mix_g, (bf16*)(ws + WS_H));     SEAM(P + 0); }
        if (IN(P + 1)) {
            unsigned char* ws = KWS();
            pg8::Gemm g{(const bf16*)(ws + WS_H), (const bf16*)(ws + WS_WIN), T, 3072, 1024, 1024, 1, 1, 0};
            pg8::EpiRouteNorm E{(bf16*)(ws + WS_QA), (size_t)(64 * MiB / 2), (bf16*)(ws + WS_CKV), (size_t)(32 * MiB / 2), (const float*)(ws + WS_GT), (float*)(ws + WS_SSP), EPS};
            GEMM_RUN2(pg8::EpiRouteNorm, g, E); SEAM(P + 1); }
        CHK(1, 0);
#ifdef DUP_BAR
        if (IN(P + 2)) { for (int i_ = 0; i_ < 10; ++i_) GRID_BARRIER(); }
#endif
        CHK(2, 1);
        if (IN(P + 3)) {
            unsigned char* ws = KWS();
            pg8::Gemm g{(const bf16*)(ws + WS_CQKC), (const bf16*)(ws + WS_WUQ), T, 768, 384, 512, 1, 1, 0};
            pg8::EpiPlainRS E{(bf16*)(ws + WS_QB), 768, (const float*)(ws + WS_SSP), 0, 6, 1.0f / 384, EPS}; GEMM_RUN3(pg8::EpiPlainRS, g, E); }
        if (IN(P + 3)) {
            unsigned char* ws = KWS();
            pg8::Gemm g{(const bf16*)(ws + WS_CKV), (const bf16*)(ws + WS_WUKV), T, 1024, 256, 256, 1, 1, 0};
            pg8::EpiPlainRS E{(bf16*)(ws + WS_KVR), 1024, (const float*)(ws + WS_SSP), 8, 4, 1.0f / 256, EPS}; GEMM_RUN3(pg8::EpiPlainRS, g, E); SEAM(P + 3); }
        if (IN(P + 4)) { unsigned char* ws = KWS(); const LayerW L = layer_w(layer); p_prep2(F, L, ws, KPOS()); p_tile_minmax(F, ws, KPOS()); SEAM(P + 4); }
        CHK(4, 2);
#ifdef NAIVE_ATTN
        if (IN(P + 5)) { unsigned char* ws = KWS(); p_attention_naive(F.vcu, F.wave, F.G, KIN(5) + layer * 256, KIN(6) + layer * 128, KIN(13) + layer * 8, ws, KPOS(), layer); SEAM(P + 5); }
#else
        if (IN(P + 5)) { unsigned char* ws = KWS(); p_attention(F, KIN(4) + layer * 128, KIN(5) + layer * 256, KIN(6) + layer * 128, KIN(13) + layer * 8, ws, KPOS(), layer); SEAM(P + 5); }
#endif
        if (IN(P + 6)) {
            { unsigned char* ws = KWS(); p_h_to_fp8(F, ws); }
#ifdef DUP_H8
            { unsigned char* ws = KWS(); for (int i_ = 0; i_ < 4; ++i_) p_h_to_fp8(F, ws); }
#endif
#if !MK_MULTI
            GRID_BARRIER();
#endif
            unsigned char* ws = KWS();
            pg8::Gemm g{(const bf16*)(ws + WS_H8), (const bf16*)(ws + WS_WG8), T, 3072, 512, 512, 1, 1, 0, 0, 0};
            pg8::EpiGate E{(bf16*)(ws + WS_G0), (size_t)(128 * MiB / 2), (size_t)(96 * MiB / 2), -LOG2E / W8_SCALE};
            GEMM_RUN_F8(pg8::EpiGate, g, E); SEAM(P + 6); }
        if (IN(P + 7)) {
            unsigned char* ws = KWS();
            pg8::Gemm g{(const bf16*)(ws + WS_QA), (const bf16*)(ws + WS_WBA), T, 1024, 512, 512, 1, 1, 0};
            pg8::EpiMerge E{(const bf16*)(ws + WS_G0), (bf16*)(ws + WS_H), 1}; GEMM_RUN3(pg8::EpiMerge, g, E); SEAM(P + 7); }
        if (IN(P + 8)) {
            unsigned char* ws = KWS();
            pg8::Gemm g{(const bf16*)(ws + WS_OB), (const bf16*)(ws + WS_WBB), T, 1024, 512, 512, 1, 1, 0};
            pg8::EpiMerge E{(const bf16*)(ws + WS_G1), (bf16*)(ws + WS_H), 0}; GEMM_RUN(pg8::EpiMerge, g, E); SEAM(P + 8); }
        if (IN(P + 9)) {
            unsigned char* ws = KWS();
            pg8::Gemm g{(const bf16*)(ws + WS_QC), (const bf16*)(ws + WS_WBC), T, 1024, 512, 512, 1, 1, 0};
            pg8::EpiMerge E{(const bf16*)(ws + WS_G2), (bf16*)(ws + WS_H), 0}; GEMM_RUN(pg8::EpiMerge, g, E); SEAM(P + 9); }
        CHK(9, 4);
        if (IN(P + 10)) {
            unsigned char* ws = KWS(); float* xo = KOUT();
            pg8::Gemm g{(const bf16*)(ws + WS_H), (const bf16*)(ws + WS_WO), T, 1024, 1024, 1024, 1, 1, 0};
            pg8::EpiResid E{layer == 0 ? KIN(0) : (const float*)xo, xo}; GEMM_RUN(pg8::EpiResid, g, E); SEAM(P + 10); }
        CHK(10, 5);
#ifdef DUP_P11
        if (IN(P + 11)) { unsigned char* ws = KWS(); p_norm2_router(F, KOUT(), KIN(18) + (size_t)layer * 1024, KIN(19) + (size_t)layer * 1024 * 16, (bf16*)(ws + WS_H), (float*)(ws + WS_AFFT)); GRID_BARRIER(); }
#endif
        if (IN(P + 11)) { unsigned char* ws = KWS(); p_norm2_router(F, KOUT(), KIN(18) + (size_t)layer * 1024, KIN(19) + (size_t)layer * 1024 * 16, (bf16*)(ws + WS_H), (float*)(ws + WS_AFFT)); SEAM(P + 11); }
#ifdef DUP_P12
        if (IN(P + 12)) { unsigned char* ws = KWS(); p_topk_gather(F, ws); GRID_BARRIER(); }
#endif
        if (IN(P + 12)) { unsigned char* ws = KWS(); p_topk_gather(F, ws); SEAM(P + 12); }
        if (IN(P + 13)) {
            unsigned char* ws = KWS();
            pg8::Gemm g{(const bf16*)(ws + WS_XG), (const bf16*)(ws + WS_WGU), TE, 2048, 512, 512, 32, 16, (size_t)2048 * 1024, W8_E8M0, ONE_E8M0};
            pg8::EpiSwiglu E{ws + WS_HID, 1.0f / W8_SCALE, HID_SCALE}; GEMM_RUN_F8(pg8::EpiSwiglu, g, E); SEAM(P + 13); }
        if (IN(P + 14)) {
            unsigned char* ws = KWS();
            pg8::Gemm g{(const bf16*)(ws + WS_HID), (const bf16*)(ws + WS_WD), TE, 1024, 512, 512, 32, 16, (size_t)1024 * 1024, W8_E8M0, HID_E8M0};
            pg8::EpiDown E{(bf16*)(ws + WS_XG), (const float*)(ws + WS_AFFSEL), 1.0f / (W8_SCALE * HID_SCALE)}; GEMM_RUN_F8(pg8::EpiDown, g, E); SEAM(P + 14); }
        if (IN(P + 15)) { unsigned char* ws = KWS(); if (layer + 1 < DEPTH) p_combine<true>(F, ws, KOUT(), KIN(2) + (size_t)(layer + 1) * 1024, (bf16*)(ws + WS_H)); else p_combine<false>(F, ws, KOUT(), nullptr, nullptr); SEAM(P + 15); }
    }
#undef IN
#undef SEAM
}

extern "C" void kernel_launch(void* const* d_in, const int* in_sizes, int n_in, void* d_out, int out_size, void* d_ws, size_t ws_size, hipStream_t stream) {
    static int grid = 0;
    if (grid == 0) {
        if (n_in != 23 || in_sizes[0] != T * DM || out_size != T * DM || ws_size < WS_END) { fprintf(stderr, "kernel_launch: shape/workspace mismatch (n_in %d, ws %zu < %zu)\n", n_in, ws_size, (size_t)WS_END); grid = -1; return; }
        int dev = 0, cus = 0, per_cu = 0;
        if (hipGetDevice(&dev) != hipSuccess || hipDeviceGetAttribute(&cus, hipDeviceAttributeMultiprocessorCount, dev) != hipSuccess) { grid = -1; return; }
        if (hipFuncSetAttribute((const void*)fwd_kernel, hipFuncAttributeMaxDynamicSharedMemorySize, LDS_BYTES) != hipSuccess) { fprintf(stderr, "kernel_launch: hipFuncSetAttribute failed\n"); grid = -1; return; }
        if (hipOccupancyMaxActiveBlocksPerMultiprocessor(&per_cu, (const void*)fwd_kernel, NWAVES * 64, LDS_BYTES) != hipSuccess || per_cu < 1) { fprintf(stderr, "kernel_launch: occupancy query reports %d\n", per_cu); }
        (void)hipGetLastError();
        grid = cus;
    }
    if (grid < 0) return;
    if (hipMemsetAsync((char*)d_ws + WS_CTL, 0, CTL_ZERO_BYTES, stream) != hipSuccess) return;
    KArgs a{};
    for (int i = 0; i < 23; ++i) a.in[i] = (const float*)d_in[i];
    a.positions = (const int*)d_in[1]; a.out = (float*)d_out; a.ws = (unsigned char*)d_ws;
#if MK_MULTI
#ifdef DBG_CHECK
    for (int p = 0; p <= 10; ++p) { a.ph_lo = p; a.ph_hi = p + 1; hipLaunchKernelGGL(fwd_kernel, dim3(grid), dim3(NWAVES * 64), LDS_BYTES, stream, a);
        a.ph_lo = 1000 + p; a.ph_hi = 1001 + p; hipLaunchKernelGGL(fwd_kernel, dim3(grid), dim3(NWAVES * 64), LDS_BYTES, stream, a); }
    a.ph_lo = 2000; a.ph_hi = 2001; hipLaunchKernelGGL(fwd_kernel, dim3(grid), dim3(NWAVES * 64), LDS_BYTES, stream, a);
#else
    for (int p = 0; p < NPHASE; ++p) { a.ph_lo = p; a.ph_hi = p + 1; hipLaunchKernelGGL(fwd_kernel, dim3(grid), dim3(NWAVES * 64), LDS_BYTES, stream, a); }
#endif
#else
    a.ph_lo = 0; a.ph_hi = NPHASE;
    hipLaunchKernelGGL(fwd_kernel, dim3(grid), dim3(NWAVES * 64), LDS_BYTES, stream, a);
#endif
    const hipError_t le = hipPeekAtLastError();
    if (le != hipSuccess) fprintf(stderr, "kernel_launch: launch failed: %s\n", hipGetErrorName(le));
}
```

```cpp
#include <hip/hip_runtime.h>
#include <cstdio>
#include <cstdint>

#ifndef MK_MULTI
#define MK_MULTI 0
#endif

namespace pg8 {
#define PG8_LAS __attribute__((address_space(3)))
typedef unsigned short bf16_t;
typedef short bf16x8 __attribute__((ext_vector_type(8)));
typedef float f32x4 __attribute__((ext_vector_type(4)));
typedef unsigned u32x4 __attribute__((ext_vector_type(4)));
typedef unsigned u32x2 __attribute__((ext_vector_type(2)));
typedef float f32x2 __attribute__((ext_vector_type(2)));
constexpr int BM = 256, BK = 64, HALF = 128, HTB = HALF * BK * 2  , STAGE_BYTES = 8 * HTB, NXCD = 8, WGM = 8;

__host__ __device__ __forceinline__ int lds_byte(int r, int c) { const int st = (r >> 4) * 2 + (c >> 5), rr = r & 15, cc = c & 31, ob = rr * 64 + cc * 2; return st * 1024 + (ob ^ (((ob >> 9) & 1) << 5)); }
__host__ __device__ __forceinline__ void stage_rc(int b, int& R, int& C) { const int st = b / 1024, sb = b % 1024, swz = sb ^ (((sb >> 9) & 1) << 5); R = (st >> 1) * 16 + swz / 64; C = (st & 1) * 32 + (swz % 64) / 2; }
__host__ __device__ __forceinline__ int perm32(int rho) { const int n = rho >> 4, i = rho & 15; return 8 * (i >> 2) + 4 * n + (i & 3); }

struct Unit { int pm, pn; };
struct Gemm { const bf16_t* A; const bf16_t* Bt; int M, N, K, lda; int pm_per_grp, ngrp; size_t grp_bytes; int sc_w, sc_x;
    __device__ __forceinline__ size_t grp_off(int pm) const { return ngrp > 1 ? (size_t)((pm / pm_per_grp) % ngrp) * grp_bytes : (size_t)0; } };

typedef int v8i_t __attribute__((ext_vector_type(8))); typedef int v4i_t __attribute__((ext_vector_type(4)));
__device__ __forceinline__ v8i_t cat8(bf16x8 lo, bf16x8 hi) { return __builtin_shufflevector(__builtin_bit_cast(v4i_t, lo), __builtin_bit_cast(v4i_t, hi), 0, 1, 2, 3, 4, 5, 6, 7); }
struct StaticOrder {
    int nM, nN, nwg, G, c;
    __host__ __device__ void init(int M, int N, int G_, int c_) { nM = M / BM; nN = N / BM; nwg = nM * nN; G = G_; c = c_; }
    __host__ __device__ bool next(int i, Unit& u) const {
        const long L = (long)i * G + c; if (L >= nwg) return false;
        int wgid = (int)L; { const int q = nwg / NXCD, r = nwg % NXCD, xcd = wgid % NXCD, off = wgid / NXCD; wgid = (xcd < r ? xcd * (q + 1) : r * (q + 1) + (xcd - r) * q) + off; }
        const int nig = WGM * nN, gid = wgid / nig, fm = gid * WGM, gsz = (nM - fm) < WGM ? (nM - fm) : WGM;
        u.pm = fm + ((wgid % nig) % gsz); u.pn = (wgid % nig) / gsz; return true;
    }
    __device__ __forceinline__ void a_ready(const Unit&) const {}
    __device__ __forceinline__ void done(const Unit&) const {}
};

typedef float f32x2_t __attribute__((ext_vector_type(2))); typedef __bf16 bf16x2_t __attribute__((ext_vector_type(2)));
__device__ __forceinline__ unsigned cvt_pk_bf16(float lo, float hi) { f32x2_t v = {lo, hi}; bf16x2_t b = __builtin_convertvector(v, bf16x2_t); return __builtin_bit_cast(unsigned, b); }
__device__ __forceinline__ float bf_lo(unsigned w) { return __uint_as_float(w << 16); }
__device__ __forceinline__ float bf_hi(unsigned w) { return __uint_as_float(w & 0xffff0000u); }

#define PG8_EPI_LOOP(...) \
    _Pragma("unroll") for (int ai = 0; ai < 2; ++ai) _Pragma("unroll") for (int m = 0; m < 4; ++m) _Pragma("unroll") for (int bj = 0; bj < 2; ++bj) { \
        const int row = u.pm * BM + ai * HALF + wr * 64 + m * 16 + fr; const int ct = bj * HALF + wc * 32 + 8 * fq;   \
        f32x4 v0 = acc[ai][bj][m][0], v1 = acc[ai][bj][m][1]; __VA_ARGS__ }
__device__ __forceinline__ u32x4 pack8(f32x4 v0, f32x4 v1) { u32x4 w; w.x = cvt_pk_bf16(v0[0], v0[1]); w.y = cvt_pk_bf16(v0[2], v0[3]); w.z = cvt_pk_bf16(v1[0], v1[1]); w.w = cvt_pk_bf16(v1[2], v1[3]); return w; }

struct EpiPlain { static constexpr bool PERM = true, AFTER_DRAIN = false; bf16_t* O; int ldc;
    __device__ __forceinline__ void operator()(const f32x4 (&acc)[2][2][4][2], const Unit& u, int wr, int wc, int fr, int fq) const {
        PG8_EPI_LOOP({ *(u32x4*)(O + (size_t)row * ldc + u.pn * BM + ct) = pack8(v0, v1); }) } };
struct EpiRoute { static constexpr bool PERM = true, AFTER_DRAIN = false; bf16_t* five; size_t five_stride; bf16_t* tail; size_t tail_stride;
    __device__ __forceinline__ void operator()(const f32x4 (&acc)[2][2][4][2], const Unit& u, int wr, int wc, int fr, int fq) const {
        bf16_t* base; int ldc, c0;
        if (u.pn < 10) { base = five + (size_t)(u.pn >> 1) * five_stride; ldc = 512; c0 = (u.pn & 1) * 256; } else { base = tail + (size_t)(u.pn - 10) * tail_stride; ldc = 256; c0 = 0; }
        PG8_EPI_LOOP({ *(u32x4*)(base + (size_t)row * ldc + c0 + ct) = pack8(v0, v1); }) } };
struct EpiRouteNorm { static constexpr bool PERM = true, AFTER_DRAIN = false; bf16_t* five; size_t five_stride; bf16_t* tail; size_t tail_stride; const float* gt; float* ssp; float eps;
    __device__ __forceinline__ void operator()(const f32x4 (&acc)[2][2][4][2], const Unit& u, int wr, int wc, int fr, int fq) const {
        bf16_t* base; int ldc, c0;
        if (u.pn < 10) { base = five + (size_t)(u.pn >> 1) * five_stride; ldc = 512; c0 = (u.pn & 1) * 256; } else { base = tail + (size_t)(u.pn - 10) * tail_stride; ldc = 256; c0 = 0; }
        const bool nrm = (u.pn < 6) || (u.pn == 9 && wc >= 2);
        const bool part = (u.pn == 8) || (u.pn == 9 && wc < 2) || (u.pn == 10);
        const int gi = u.pn < 2 ? 0 : (u.pn < 4 ? 1 : (u.pn < 6 ? 2 : 3));
        const int slot = u.pn == 8 ? wc : (u.pn == 9 ? 4 + wc : 8 + wc);
        f32x4 g00 = {1.f, 1.f, 1.f, 1.f}, g01 = g00, g10 = g00, g11 = g00;
        if (nrm) { const float* gp = gt + gi * 64 + 8 * fq; g00 = *(const f32x4*)gp; g01 = *(const f32x4*)(gp + 4); g10 = *(const f32x4*)(gp + 32); g11 = *(const f32x4*)(gp + 36); }
#pragma unroll
        for (int ai = 0; ai < 2; ++ai)
#pragma unroll
            for (int m = 0; m < 4; ++m) { const int row = u.pm * BM + ai * HALF + wr * 64 + m * 16 + fr;
                f32x4 v00 = acc[ai][0][m][0], v01 = acc[ai][0][m][1], v10 = acc[ai][1][m][0], v11 = acc[ai][1][m][1];
                if (nrm || part) {
                    float ss = 0.f;
#pragma unroll
                    for (int i = 0; i < 4; ++i) ss += (v00[i] * v00[i] + v01[i] * v01[i]) + (v10[i] * v10[i] + v11[i] * v11[i]);
                    { auto r_ = __builtin_amdgcn_permlane16_swap(__float_as_uint(ss), __float_as_uint(ss), false, false); ss = __uint_as_float(r_[0]) + __uint_as_float(r_[1]); }
                    { auto r_ = __builtin_amdgcn_permlane32_swap(__float_as_uint(ss), __float_as_uint(ss), false, false); ss = __uint_as_float(r_[0]) + __uint_as_float(r_[1]); }
                    if (nrm) { const float rs = 1.0f / sqrtf(ss * (1.0f / 64) + eps); v00 = v00 * rs * g00; v01 = v01 * rs * g01; v10 = v10 * rs * g10; v11 = v11 * rs * g11; }
                    if (part && fq == 0) ssp[(size_t)row * 16 + slot] = ss;
                }
                bf16_t* rp = base + (size_t)row * ldc + c0 + wc * 64 + 8 * fq;
                *(u32x4*)rp = pack8(v00, v01); *(u32x4*)(rp + 32) = pack8(v10, v11); } } };
struct EpiPlainRS { static constexpr bool PERM = true, AFTER_DRAIN = false; bf16_t* O; int ldc; const float* ssp; int s0, ns; float inv_n, eps;
    __device__ __forceinline__ void operator()(const f32x4 (&acc)[2][2][4][2], const Unit& u, int wr, int wc, int fr, int fq) const {
#pragma unroll
        for (int ai = 0; ai < 2; ++ai)
#pragma unroll
            for (int m = 0; m < 4; ++m) { const int row = u.pm * BM + ai * HALF + wr * 64 + m * 16 + fr;
                const float* sp = ssp + (size_t)row * 16 + s0; const f32x4 a = *(const f32x4*)sp; float ss = (a[0] + a[1]) + (a[2] + a[3]);
                if (ns > 4) { const f32x2 b = *(const f32x2*)(sp + 4); ss += b[0] + b[1]; }
                const float rs = 1.0f / sqrtf(ss * inv_n + eps);
#pragma unroll
                for (int bj = 0; bj < 2; ++bj) { const int ct = bj * HALF + wc * 32 + 8 * fq;
                    *(u32x4*)(O + (size_t)row * ldc + u.pn * BM + ct) = pack8(acc[ai][bj][m][0] * rs, acc[ai][bj][m][1] * rs); } } } };
struct EpiGate { static constexpr bool PERM = true, AFTER_DRAIN = false; bf16_t* g0; size_t gstride, gextra; float zs;
    __device__ __forceinline__ void operator()(const f32x4 (&acc)[2][2][4][2], const Unit& u, int wr, int wc, int fr, int fq) const {
        const int gi = u.pn >> 2; bf16_t* base = g0 + (size_t)gi * gstride + (size_t)(gi >> 1) * gextra; const int c0 = (u.pn & 3) * 256;
        PG8_EPI_LOOP({
            _Pragma("unroll") for (int i = 0; i < 4; ++i) { v0[i] = __builtin_amdgcn_rcpf(1.0f + __builtin_amdgcn_exp2f(zs * v0[i])); v1[i] = __builtin_amdgcn_rcpf(1.0f + __builtin_amdgcn_exp2f(zs * v1[i])); }
            *(u32x4*)(base + (size_t)row * 1024 + c0 + ct) = pack8(v0, v1); }) } };
struct EpiMerge { static constexpr bool PERM = true, AFTER_DRAIN = false; const bf16_t* gate; bf16_t* mg; int first;
    __device__ __forceinline__ void operator()(const f32x4 (&acc)[2][2][4][2], const Unit& u, int wr, int wc, int fr, int fq) const {
        PG8_EPI_LOOP({
            const size_t off = (size_t)row * 1024 + u.pn * BM + ct;
            const u32x4 gw = *(const u32x4*)(gate + off);
            f32x4 p0 = {0.f, 0.f, 0.f, 0.f}, p1 = {0.f, 0.f, 0.f, 0.f};
            if (!first) { const u32x4 pw = *(const u32x4*)(mg + off); p0 = (f32x4){bf_lo(pw.x), bf_hi(pw.x), bf_lo(pw.y), bf_hi(pw.y)}; p1 = (f32x4){bf_lo(pw.z), bf_hi(pw.z), bf_lo(pw.w), bf_hi(pw.w)}; }
            const f32x4 g0v = (f32x4){bf_lo(gw.x), bf_hi(gw.x), bf_lo(gw.y), bf_hi(gw.y)}, g1v = (f32x4){bf_lo(gw.z), bf_hi(gw.z), bf_lo(gw.w), bf_hi(gw.w)};
            v0 = p0 + g0v * v0; v1 = p1 + g1v * v1;
            *(u32x4*)(mg + off) = pack8(v0, v1); }) } };
struct EpiResid { static constexpr bool PERM = true, AFTER_DRAIN = false; const void* xi; int in_bf16; bf16_t* xo;
    __device__ __forceinline__ void operator()(const f32x4 (&acc)[2][2][4][2], const Unit& u, int wr, int wc, int fr, int fq) const {
        if (in_bf16) {
            PG8_EPI_LOOP({
                const size_t off = (size_t)row * 1024 + u.pn * BM + ct;
                const u32x4 w = *(const u32x4*)((const bf16_t*)xi + off);
                const f32x4 a = {__uint_as_float(w.x << 16), __uint_as_float(w.x & 0xffff0000u), __uint_as_float(w.y << 16), __uint_as_float(w.y & 0xffff0000u)};
                const f32x4 b = {__uint_as_float(w.z << 16), __uint_as_float(w.z & 0xffff0000u), __uint_as_float(w.w << 16), __uint_as_float(w.w & 0xffff0000u)};
                *(u32x4*)(xo + off) = pack8(a + v0, b + v1); })
        } else {
            PG8_EPI_LOOP({
                const size_t off = (size_t)row * 1024 + u.pn * BM + ct;
                const f32x4 a = *(const f32x4*)((const float*)xi + off), b = *(const f32x4*)((const float*)xi + off + 4);
                *(u32x4*)(xo + off) = pack8(a + v0, b + v1); })
        } } };
__device__ __forceinline__ u32x2 pack8_fp8(f32x4 v0, f32x4 v1) {
    _Pragma("unroll") for (int i = 0; i < 4; ++i) { v0[i] = fminf(fmaxf(v0[i], -448.f), 448.f); v1[i] = fminf(fmaxf(v1[i], -448.f), 448.f); }
    int a = 0, b = 0; a = __builtin_amdgcn_cvt_pk_fp8_f32(v0[0], v0[1], a, false); a = __builtin_amdgcn_cvt_pk_fp8_f32(v0[2], v0[3], a, true);
    b = __builtin_amdgcn_cvt_pk_fp8_f32(v1[0], v1[1], b, false); b = __builtin_amdgcn_cvt_pk_fp8_f32(v1[2], v1[3], b, true); u32x2 w; w.x = (unsigned)a; w.y = (unsigned)b; return w; }
struct EpiSwiglu { static constexpr bool PERM = true, AFTER_DRAIN = false; unsigned char* hid; float iscale, oscale;
    __device__ __forceinline__ void operator()(const f32x4 (&acc)[2][2][4][2], const Unit& u, int wr, int wc, int fr, int fq) const {
#pragma unroll
        for (int ai = 0; ai < 2; ++ai)
#pragma unroll
            for (int m = 0; m < 4; ++m) { const int row = u.pm * BM + ai * HALF + wr * 64 + m * 16 + fr; const int col = u.pn * 128 + wc * 32 + 8 * fq;
                f32x4 o0, o1;
#pragma unroll
                for (int i = 0; i < 4; ++i) { const float g0 = acc[ai][0][m][0][i] * iscale, g1 = acc[ai][0][m][1][i] * iscale;
                    o0[i] = g0 * __builtin_amdgcn_rcpf(1.0f + __builtin_amdgcn_exp2f(-1.4426950408889634f * g0)) * (acc[ai][1][m][0][i] * iscale);
                    o1[i] = g1 * __builtin_amdgcn_rcpf(1.0f + __builtin_amdgcn_exp2f(-1.4426950408889634f * g1)) * (acc[ai][1][m][1][i] * iscale); }
                *(u32x2*)(hid + (size_t)row * 1024 + col) = pack8_fp8(o0 * oscale, o1 * oscale); } } };
struct EpiDown { static constexpr bool PERM = true, AFTER_DRAIN = false; bf16_t* Y; const float* aff; float iscale;
    __device__ __forceinline__ void operator()(const f32x4 (&acc)[2][2][4][2], const Unit& u, int wr, int wc, int fr, int fq) const {
        PG8_EPI_LOOP({ const float a = aff[row] * iscale; v0 = v0 * a; v1 = v1 * a; *(u32x4*)(Y + (size_t)row * 1024 + u.pn * BM + ct) = pack8(v0, v1); }) } };

template <class Epi, class Sched, bool ALIGN_EPI = false, bool SP2 = false, bool F8 = false>
__device__ __forceinline__ void gemm_phase(PG8_LAS unsigned char* lds, const Gemm g, const Sched& S, const Epi& E) {
    int tid_ = threadIdx.x; asm volatile("" : "+v"(tid_));
    const int tid = tid_, wid = __builtin_amdgcn_readfirstlane(tid >> 6), lane = tid & 63, wr = wid >> 2, wc = wid & 3, fr = lane & 15, fq = lane >> 4;
    const int K = g.K, nt = K / BK, lda = g.lda;
    unsigned voffA[2], voffB[2];
#pragma unroll
    for (int i = 0; i < 2; ++i) { int R, C; stage_rc(tid * 16 + i * 8192, R, C); const int Rb = Epi::PERM ? ((R & ~31) + perm32(R & 31)) : R;
        voffA[i] = (unsigned)(R * lda + C) * 2u; voffB[i] = (unsigned)(Rb * K + C) * 2u; }
    const size_t kstep = (size_t)(BK * 2);
    const size_t hstepA = (size_t)HALF * lda * 2, hstepB = (size_t)HALF * K * 2;
    const size_t tstepA = 2 * hstepA, tstepB = 2 * hstepB;
    const unsigned ldsw = (unsigned)wid * 1024u;
    const int aoff = lds_byte(wr * 64 + fr, fq * 8), boff = lds_byte(wc * 32 + fr, fq * 8);
#define PG8_SA(b, h) (((b) * 2 + (h)) * HTB)
#define PG8_SB(b, h) ((4 + (b) * 2 + (h)) * HTB)
#define PG8_STAGE(bufoff, gbase, voff) do { _Pragma("unroll") for (int _i = 0; _i < 2; ++_i) \
        __builtin_amdgcn_global_load_lds((const unsigned*)((const char*)(gbase) + (voff)[_i]), (PG8_LAS unsigned*)(lds + (bufoff) + ldsw + _i * 8192), 16, 0, 0); } while (0)
#define PG8_LDA(dst, b, h) do { _Pragma("unroll") for (int m = 0; m < 4; ++m) { if constexpr (F8) { dst##8[m] = cat8(*(const PG8_LAS bf16x8*)(lds + PG8_SA(b, h) + aoff + m * 2048), *(const PG8_LAS bf16x8*)(lds + PG8_SA(b, h) + aoff + m * 2048 + 1024)); } \
        else { _Pragma("unroll") for (int k = 0; k < 2; ++k) dst[m][k] = *(const PG8_LAS bf16x8*)(lds + PG8_SA(b, h) + aoff + m * 2048 + k * 1024); } } } while (0)
#define PG8_LDB(dst, b, h) do { _Pragma("unroll") for (int n = 0; n < 2; ++n) { if constexpr (F8) { dst##8[n] = cat8(*(const PG8_LAS bf16x8*)(lds + PG8_SB(b, h) + boff + n * 2048), *(const PG8_LAS bf16x8*)(lds + PG8_SB(b, h) + boff + n * 2048 + 1024)); } \
        else { _Pragma("unroll") for (int k = 0; k < 2; ++k) dst[n][k] = *(const PG8_LAS bf16x8*)(lds + PG8_SB(b, h) + boff + n * 2048 + k * 1024); } } } while (0)
#define PG8_MMA(ai, bj, At, Bt) do { __builtin_amdgcn_s_setprio(1); _Pragma("unroll") for (int m = 0; m < 4; ++m) _Pragma("unroll") for (int n = 0; n < 2; ++n) { \
        if constexpr (F8) { asm volatile("v_mfma_f32_16x16x128_f8f6f4 %0, %1, %2, %0" : "+v"(acc[ai][bj][m][n]) : "v"(Bt##8[n]), "v"(At##8[m])); }     \
        else { _Pragma("unroll") for (int k = 0; k < 2; ++k) acc[ai][bj][m][n] = __builtin_amdgcn_mfma_f32_16x16x32_bf16(Bt[n][k], At[m][k], acc[ai][bj][m][n], 0, 0, 0); } } \
        __builtin_amdgcn_s_setprio(0); } while (0)
#define PG8_WAIT_V(n) asm volatile("s_waitcnt vmcnt(" #n ")" ::: "memory")
#define PG8_WAIT_L(n) asm volatile("s_waitcnt lgkmcnt(" #n ")" ::: "memory")
#define PG8_BAR __builtin_amdgcn_s_barrier()
#define PG8_SCHED __builtin_amdgcn_sched_barrier(0)
    Unit cur, nxt; int ui = 0;
    if (!S.next(0, cur)) return;
    f32x4 acc[2][2][4][2];
#define PG8_Z z0_
    { float z0_ = 0.f; asm volatile("" : "+v"(z0_));
#pragma unroll
    for (int a = 0; a < 2; ++a)
#pragma unroll
        for (int b = 0; b < 2; ++b)
#pragma unroll
            for (int m = 0; m < 4; ++m)
#pragma unroll
                for (int n = 0; n < 2; ++n) acc[a][b][m][n] = (f32x4){PG8_Z, PG8_Z, PG8_Z, PG8_Z}; }
    bf16x8 At[4][2], B0[2][2], B1[2][2]; v8i_t At8[4], B08[2], B18[2]; (void)At; (void)B0; (void)B1; (void)At8; (void)B08; (void)B18;
    const char* cA = (const char*)g.A + (size_t)cur.pm * tstepA; const char* cB = (const char*)g.Bt + g.grp_off(cur.pm) + (size_t)cur.pn * tstepB;
    S.a_ready(cur);
    if constexpr (SP2) {
        PG8_STAGE(PG8_SB(0, 0), cB, voffB); PG8_STAGE(PG8_SB(0, 1), cB + hstepB, voffB); PG8_STAGE(PG8_SA(0, 0), cA, voffA); PG8_STAGE(PG8_SA(0, 1), cA + hstepA, voffA);
        if (wr == 1) PG8_BAR;
        PG8_WAIT_V(2); PG8_BAR;
        PG8_STAGE(PG8_SB(1, 0), cB + kstep, voffB); PG8_STAGE(PG8_SA(1, 0), cA + kstep, voffA); PG8_STAGE(PG8_SB(1, 1), cB + hstepB + kstep, voffB);
        PG8_WAIT_V(6); PG8_BAR;
    } else {
        PG8_STAGE(PG8_SB(0, 0), cB, voffB); PG8_STAGE(PG8_SA(0, 0), cA, voffA); PG8_STAGE(PG8_SB(0, 1), cB + hstepB, voffB); PG8_STAGE(PG8_SA(0, 1), cA + hstepA, voffA);
        if (wr == 1) PG8_BAR;
        PG8_WAIT_V(4); PG8_BAR;
        PG8_STAGE(PG8_SB(1, 0), cB + kstep, voffB); PG8_STAGE(PG8_SA(1, 0), cA + kstep, voffA); PG8_STAGE(PG8_SB(1, 1), cB + hstepB + kstep, voffB);
        PG8_WAIT_V(6); PG8_BAR;
    }
    for (;;) {
        const bool has_next = S.next(ui + 1, nxt);
        const char* nA = has_next ? (const char*)g.A + (size_t)nxt.pm * tstepA : cA; const char* nB = has_next ? (const char*)g.Bt + g.grp_off(nxt.pm) + (size_t)nxt.pn * tstepB : cB;
#pragma unroll 1
        for (int t = 0; t < nt; t += 2) {
            const bool last = (t == nt - 2);
            const char* a1 = cA + (size_t)(t + 1) * kstep;
            const char* a2 = last ? nA : cA + (size_t)(t + 2) * kstep; const char* b2 = last ? nB : cB + (size_t)(t + 2) * kstep;
            const char* a3 = a2 + kstep; const char* b3 = b2 + kstep;
            if (last && has_next) S.a_ready(nxt);
            if constexpr (SP2) {
            PG8_LDB(B0, 0, 0); PG8_LDB(B1, 0, 1); PG8_SCHED; PG8_LDA(At, 0, 0); PG8_STAGE(PG8_SA(1, 1), a1 + hstepA, voffA);
            PG8_WAIT_V(8); PG8_WAIT_L(0); PG8_BAR; PG8_MMA(0, 0, At, B0); PG8_MMA(0, 1, At, B1); PG8_BAR; PG8_SCHED;
            PG8_LDA(At, 0, 1); PG8_STAGE(PG8_SB(0, 0), b2, voffB); PG8_STAGE(PG8_SB(0, 1), b2 + hstepB, voffB); PG8_STAGE(PG8_SA(0, 0), a2, voffA);
            PG8_WAIT_V(8); PG8_WAIT_L(0); PG8_BAR; PG8_MMA(1, 0, At, B0); PG8_MMA(1, 1, At, B1); PG8_BAR; PG8_SCHED;
            PG8_LDB(B0, 1, 0); PG8_LDB(B1, 1, 1); PG8_SCHED; PG8_LDA(At, 1, 0); PG8_STAGE(PG8_SA(0, 1), a2 + hstepA, voffA);
            PG8_WAIT_V(8); PG8_WAIT_L(0); PG8_BAR; PG8_MMA(0, 0, At, B0); PG8_MMA(0, 1, At, B1); PG8_BAR; PG8_SCHED;
            PG8_LDA(At, 1, 1); PG8_STAGE(PG8_SB(1, 0), b3, voffB); PG8_STAGE(PG8_SB(1, 1), b3 + hstepB, voffB); PG8_STAGE(PG8_SA(1, 0), a3, voffA);
            PG8_WAIT_V(8); PG8_WAIT_L(0); PG8_BAR; PG8_MMA(1, 0, At, B0); PG8_MMA(1, 1, At, B1); PG8_BAR; PG8_SCHED;
            } else {
            PG8_LDB(B0, 0, 0); PG8_SCHED; PG8_LDA(At, 0, 0); PG8_STAGE(PG8_SA(1, 1), a1 + hstepA, voffA);
            PG8_WAIT_L(8); PG8_BAR; PG8_WAIT_L(0); PG8_MMA(0, 0, At, B0); PG8_BAR; PG8_SCHED;
            PG8_LDB(B1, 0, 1); PG8_STAGE(PG8_SB(0, 0), b2, voffB);
            PG8_BAR; PG8_WAIT_L(0); PG8_MMA(0, 1, At, B1); PG8_BAR;
            PG8_LDA(At, 0, 1); PG8_STAGE(PG8_SA(0, 0), a2, voffA);
            PG8_BAR; PG8_WAIT_L(0); PG8_MMA(1, 0, At, B0); PG8_BAR; PG8_SCHED;
            PG8_STAGE(PG8_SB(0, 1), b2 + hstepB, voffB);
            PG8_WAIT_V(6); PG8_BAR; PG8_MMA(1, 1, At, B1); PG8_BAR;
            PG8_LDB(B0, 1, 0); PG8_SCHED; PG8_LDA(At, 1, 0); PG8_STAGE(PG8_SA(0, 1), a2 + hstepA, voffA);
            PG8_WAIT_L(8); PG8_BAR; PG8_WAIT_L(0); PG8_MMA(0, 0, At, B0); PG8_BAR; PG8_SCHED;
            PG8_LDB(B1, 1, 1); PG8_STAGE(PG8_SB(1, 0), b3, voffB);
            PG8_BAR; PG8_WAIT_L(0); PG8_MMA(0, 1, At, B1); PG8_BAR;
            PG8_LDA(At, 1, 1); PG8_STAGE(PG8_SA(1, 0), a3, voffA);
            PG8_BAR; PG8_WAIT_L(0); PG8_MMA(1, 0, At, B0); PG8_BAR; PG8_SCHED;
            PG8_STAGE(PG8_SB(1, 1), b3 + hstepB, voffB);
            PG8_WAIT_V(6); PG8_BAR; PG8_MMA(1, 1, At, B1); PG8_BAR;
            }
        }
        if constexpr (F8) { asm volatile("s_nop 15\n\ts_nop 15" ::: "memory"); }
        if constexpr (ALIGN_EPI) { if (wr == 0) PG8_BAR; }
        if constexpr (!Epi::AFTER_DRAIN) { E(acc, cur, wr, wc, fr, fq); S.done(cur); }
        if (!has_next) break;
        { float z0_ = 0.f; asm volatile("" : "+v"(z0_));
#pragma unroll
        for (int a = 0; a < 2; ++a)
#pragma unroll
            for (int b = 0; b < 2; ++b)
#pragma unroll
                for (int m = 0; m < 4; ++m)
#pragma unroll
                    for (int n = 0; n < 2; ++n) acc[a][b][m][n] = (f32x4){PG8_Z, PG8_Z, PG8_Z, PG8_Z}; }
        cur = nxt; cA = nA; cB = nB; ++ui;
        if constexpr (ALIGN_EPI) { if (wr == 1) PG8_BAR; }
    }
    PG8_WAIT_V(0);
    if constexpr (!ALIGN_EPI) { if (wr == 0) PG8_BAR; }
    PG8_BAR;
    if constexpr (Epi::AFTER_DRAIN) { E.fused(acc, cur, wr, wc, fr, fq, lds, wid, lane); S.done(cur); }
#undef PG8_Z
#undef PG8_SA
#undef PG8_SB
#undef PG8_STAGE
#undef PG8_LDA
#undef PG8_LDB
#undef PG8_MMA
#undef PG8_WAIT_V
#undef PG8_WAIT_L
#undef PG8_BAR
#undef PG8_SCHED
}
}

constexpr int NB = 16, SEQ = 4096, DM = 1024, T = NB * SEQ, DEPTH = 2;
constexpr int NEXP = 16, CAP = 512, TE = NB * NEXP * CAP;
constexpr int IN_COLS = 6048;
constexpr float EPS = 1e-6f;
constexpr float LOG2E = 1.4426950408889634f;
constexpr int NWAVES = 8;
constexpr int PH_PER_LAYER = 16, NPHASE = DEPTH * PH_PER_LAYER;

constexpr size_t MiB = 1u << 20;
constexpr size_t WS_CTL = 0, CTL_ZERO_BYTES = 1 * MiB;
constexpr size_t WS_AFFT = 2 * MiB;
constexpr size_t WS_INV = 6 * MiB;
constexpr size_t WS_IDX = 10 * MiB;
constexpr size_t WS_AFFSEL = 10 * MiB + 512 * 1024;
constexpr size_t WS_TMM = 11 * MiB;
constexpr size_t WS_GT = 11 * MiB + 16 * 1024;
constexpr size_t WS_SSP = 2 * MiB;
constexpr size_t WS_WIN = 12 * MiB;
constexpr size_t WS_WUQ = 24 * MiB;
constexpr size_t WS_WUKV = 25 * MiB;
constexpr size_t WS_WBA = 26 * MiB, WS_WBB = 27 * MiB, WS_WBC = 28 * MiB;
constexpr size_t WS_WO = 29 * MiB;
constexpr size_t WS_WGU = 32 * MiB;
constexpr size_t WS_WD = 64 * MiB;
constexpr size_t WS_WG8 = 80 * MiB;
constexpr size_t WS_H8 = 864 * MiB;
constexpr float W8_SCALE = 64.0f, HID_SCALE = 4.0f;
constexpr int W8_E8M0 = 127 - 6, HID_E8M0 = 127 - 2, ONE_E8M0 = 127;
constexpr size_t WS_H = 128 * MiB;
constexpr size_t WS_QA = 256 * MiB, WS_QC = 320 * MiB, WS_KA = 384 * MiB, WS_VA = 448 * MiB, WS_CQKC = 512 * MiB;
constexpr size_t WS_CKV = 576 * MiB, WS_VCKR = 608 * MiB;
constexpr size_t WS_G0 = 384 * MiB, WS_G1 = 512 * MiB;
constexpr size_t WS_QB = 640 * MiB;
constexpr size_t WS_KVR = 736 * MiB;
constexpr size_t WS_G2 = 736 * MiB;
constexpr size_t WS_KB = 864 * MiB;
constexpr size_t WS_OB = 960 * MiB;
constexpr size_t WS_XG = 256 * MiB;
constexpr size_t WS_HID = 512 * MiB;
constexpr size_t WS_XB = 768 * MiB;
constexpr size_t WS_END = 1024 * MiB;

constexpr int RING_OFF = 0, RING_BYTES = 131072;
constexpr int LDS_BYTES = 163840;
constexpr int LDSCTL_OFF = LDS_BYTES - 1024, MISC_OFF = LDSCTL_OFF + 320;
constexpr int ATT_NXT_OFF = LDSCTL_OFF - 64;
constexpr int ATT_STASH_OFF = 86528;

#define LAS __attribute__((address_space(3)))
typedef unsigned short bf16;
typedef unsigned v4u __attribute__((ext_vector_type(4)));
typedef unsigned v2u __attribute__((ext_vector_type(2)));
typedef float f32x4 __attribute__((ext_vector_type(4)));
typedef float f32x2 __attribute__((ext_vector_type(2)));
typedef float f32x16 __attribute__((ext_vector_type(16)));
typedef short bf16x8 __attribute__((ext_vector_type(8)));
typedef short s16x4 __attribute__((ext_vector_type(4)));
#define LDS_WAIT() asm volatile("s_waitcnt lgkmcnt(0)" ::: "memory")
#define VM_WAIT() asm volatile("s_waitcnt vmcnt(0)" ::: "memory")
__device__ __forceinline__ unsigned pk2(float lo, float hi) { return pg8::cvt_pk_bf16(lo, hi); }
__device__ __forceinline__ float bflo(unsigned w) { return __uint_as_float(w << 16); }
__device__ __forceinline__ float bfhi(unsigned w) { return __uint_as_float(w & 0xffff0000u); }
template <int M> __device__ __forceinline__ float xor_add(float v) {
    if constexpr (M < 32) return v + __int_as_float(__builtin_amdgcn_ds_swizzle(__float_as_int(v), (M << 10) | 0x1f));
    else { auto r = __builtin_amdgcn_permlane32_swap(__float_as_uint(v), __float_as_uint(v), false, false); return __uint_as_float(r[0]) + __uint_as_float(r[1]); } }
template <int M> __device__ __forceinline__ float xor_max(float v) {
    if constexpr (M < 32) return fmaxf(v, __int_as_float(__builtin_amdgcn_ds_swizzle(__float_as_int(v), (M << 10) | 0x1f)));
    else { auto r = __builtin_amdgcn_permlane32_swap(__float_as_uint(v), __float_as_uint(v), false, false); return fmaxf(__uint_as_float(r[0]), __uint_as_float(r[1])); } }
template <int M> __device__ __forceinline__ int xor_geti(int v) { static_assert(M < 32, "xor_geti: masks below 32"); return __builtin_amdgcn_ds_swizzle(v, (M << 10) | 0x1f); }
template <int M> __device__ __forceinline__ float xor_getf(float v) { return __int_as_float(xor_geti<M>(__float_as_int(v))); }
__device__ __forceinline__ unsigned wave_sum_u(unsigned c) {
    c += (unsigned)xor_geti<1>((int)c); c += (unsigned)xor_geti<2>((int)c); c += (unsigned)xor_geti<4>((int)c); c += (unsigned)xor_geti<8>((int)c); c += (unsigned)xor_geti<16>((int)c);
    auto r = __builtin_amdgcn_permlane32_swap(c, c, false, false); return r[0] + r[1]; }
__device__ __forceinline__ float wave_sum(float v) { v = xor_add<1>(v); v = xor_add<2>(v); v = xor_add<4>(v); v = xor_add<8>(v); v = xor_add<16>(v); return xor_add<32>(v); }

#define XB_TMO      128
#define XB_XCNT(j)  (256  + 64 * (j))
#define XB_XSUB(j)  (1280 + 64 * (j))
#define XB_XGEN(j)  (2304 + 64 * (j))
#define XB_TOP      3328
#define XB_TOPGEN   3392
#define XCD_BAR_WORDS 3456
#define XB_SPIN_CAP (1u << 23)

__device__ __forceinline__ unsigned xb_ld(unsigned* p)              { return __hip_atomic_load(p, __ATOMIC_RELAXED, __HIP_MEMORY_SCOPE_AGENT); }
__device__ __forceinline__ unsigned xb_add(unsigned* p, unsigned v) { return __hip_atomic_fetch_add(p, v, __ATOMIC_RELAXED, __HIP_MEMORY_SCOPE_AGENT); }
__device__ __forceinline__ unsigned xb_xcc_id() { return (unsigned)__builtin_amdgcn_s_getreg((3 << 11) | 20) & 0xFu; }
#define XB_SPIN(cond, bar) do { unsigned _sp = 0; while (cond) { __builtin_amdgcn_s_sleep(1); \
    if ((++_sp & 255u) == 0u) { if (xb_ld(&(bar)[XB_TMO])) break; if (_sp > XB_SPIN_CAP) { atomicAdd(&(bar)[XB_TMO], 1u); break; } } } } while (0)

struct XcdBarrier { unsigned* bar; unsigned x; volatile LAS unsigned* st; };

__device__ __forceinline__ XcdBarrier xcd_barrier_post(unsigned* bar, volatile LAS unsigned* st) {
    XcdBarrier b; b.bar = bar; b.x = xb_xcc_id(); b.st = st;
    if (threadIdx.x == 0) (void)xb_add(&bar[XB_XCNT(b.x)], 1u);
    return b;
}
__device__ __forceinline__ void xcd_barrier_complete(unsigned* bar, unsigned x, unsigned& nloc, unsigned& nx) {
    const unsigned G = gridDim.x * gridDim.y * gridDim.z;
    unsigned sum, cnt, mine, sp = 0u;
    for (;;) {
        sum = 0u; cnt = 0u; mine = 0u;
#pragma unroll
        for (unsigned j = 0; j < 16; ++j) { const unsigned c = xb_ld(&bar[XB_XCNT(j)]); sum += c; cnt += (c > 0u) ? 1u : 0u; mine = (j == x) ? c : mine; }
        if (sum == G) break;
        __builtin_amdgcn_s_sleep(1);
        if ((++sp & 255u) == 0u) { if (xb_ld(&bar[XB_TMO])) break; if (sp > XB_SPIN_CAP) { atomicAdd(&bar[XB_TMO], 1u); break; } }
    }
    nloc = mine > 0u ? mine : 1u; nx = cnt > 0u ? cnt : 1u;
}
__device__ __forceinline__ void xcd_barrier(const XcdBarrier& b) {
    asm volatile("s_waitcnt vmcnt(0)" ::: "memory");
    __syncthreads();
    if (threadIdx.x == 0) {
        unsigned* bar = b.bar;
        __builtin_amdgcn_s_waitcnt(0);
        unsigned nloc = b.st[0], nx = b.st[1];
        if (nloc == 0u) { xcd_barrier_complete(bar, b.x, nloc, nx); b.st[0] = nloc; b.st[1] = nx; }
        const unsigned old = xb_add(&bar[XB_XSUB(b.x)], 1u);
        const unsigned gen = old / nloc;
        if (old + 1u == (gen + 1u) * nloc) {
            __builtin_amdgcn_fence(__ATOMIC_RELEASE, "agent");
            asm volatile("s_waitcnt vmcnt(0)" ::: "memory");
            const unsigned og = xb_add(&bar[XB_TOP], 1u);
            const unsigned tg = og / nx;
            if (og + 1u == (tg + 1u) * nx) xb_add(&bar[XB_TOPGEN], 1u);
            else XB_SPIN(xb_ld(&bar[XB_TOPGEN]) == tg, bar);
            __builtin_amdgcn_fence(__ATOMIC_ACQUIRE, "agent");
            xb_add(&bar[XB_XGEN(b.x)], 1u);
            asm volatile("s_waitcnt vmcnt(0)" ::: "memory");
        } else {
            XB_SPIN(xb_ld(&bar[XB_XGEN(b.x)]) == gen, bar);
            __builtin_amdgcn_fence(__ATOMIC_ACQUIRE, "agent");
            asm volatile("s_waitcnt vmcnt(0)" ::: "memory");
        }
    }
    __syncthreads();
}

struct Frame {
    LAS unsigned char* lds;
    int wave, vcu, G;
};

__device__ __forceinline__ void cvt_block(const float* W, int K, int Nsrc, int k0, int n0, bf16* WT, int drow0, LAS float* scr, int lane, const float* kscale = nullptr) {
    float wv_[32];
#pragma unroll
    for (int i = 0; i < 32; ++i) wv_[i] = W[(size_t)(k0 + 2 * i + (lane >> 5)) * Nsrc + n0 + (lane & 31)];
    if (kscale) {
#pragma unroll
        for (int i = 0; i < 32; ++i) wv_[i] *= kscale[k0 + 2 * i + (lane >> 5)]; }
#pragma unroll
    for (int i = 0; i < 32; ++i) scr[(2 * i + (lane >> 5)) * 33 + (lane & 31)] = wv_[i];
    LDS_WAIT(); asm volatile("" ::: "memory");
    const int c = lane & 7;
#pragma unroll
    for (int j = 0; j < 4; ++j) { const int n = (lane >> 3) + 8 * j; const LAS float* s = scr + (8 * c) * 33 + n;
        v4u o; o.x = pk2(s[0 * 33], s[1 * 33]); o.y = pk2(s[2 * 33], s[3 * 33]); o.z = pk2(s[4 * 33], s[5 * 33]); o.w = pk2(s[6 * 33], s[7 * 33]);
        *(v4u*)(WT + (size_t)(drow0 + n) * K + k0 + 8 * c) = o; }
    LDS_WAIT(); asm volatile("" ::: "memory");
}
__device__ __forceinline__ void cvt_block8(const float* W, int K, int Nsrc, int k0, int n0, unsigned char* WT8, int drow0, float scale, LAS float* scr, int lane) {
    float wv_[32];
#pragma unroll
    for (int i = 0; i < 32; ++i) wv_[i] = W[(size_t)(k0 + 2 * i + (lane >> 5)) * Nsrc + n0 + (lane & 31)];
#pragma unroll
    for (int i = 0; i < 32; ++i) scr[(2 * i + (lane >> 5)) * 33 + (lane & 31)] = wv_[i];
    LDS_WAIT(); asm volatile("" ::: "memory");
    const int c = lane & 7;
#pragma unroll
    for (int j = 0; j < 4; ++j) { const int n = (lane >> 3) + 8 * j; const LAS float* s = scr + (8 * c) * 33 + n;
        const f32x4 a = {s[0 * 33] * scale, s[1 * 33] * scale, s[2 * 33] * scale, s[3 * 33] * scale}, b = {s[4 * 33] * scale, s[5 * 33] * scale, s[6 * 33] * scale, s[7 * 33] * scale};
        const pg8::u32x2 w = pg8::pack8_fp8(a, b); v2u o; o.x = w.x; o.y = w.y;
        *(v2u*)(WT8 + (size_t)(drow0 + n) * K + k0 + 8 * c) = o; }
    LDS_WAIT(); asm volatile("" ::: "memory");
}
__device__ __forceinline__ int win_row(int n0) {
    if (n0 < 512) { const int m = n0 >> 8, h = (n0 & 255) >> 6, d = n0 & 63; return h * 128 + m * 64 + d; }
    if (n0 < 1024) return 1024 + (n0 - 512);
    if (n0 < 1536) return 1536 + (n0 - 1024);
    if (n0 < 1920) return 2048 + (n0 - 1536);
    if (n0 < 2176) return 2560 + (n0 - 1920);
    if (n0 < 2208) return 2944 + (n0 - 2176);
    if (n0 < 2720) return 512 + (n0 - 2208);
    if (n0 < 2848) return 2432 + (n0 - 2720);
    if (n0 < 2976) return 2816 + (n0 - 2848);
    return 3072 + (n0 - 2976);
}
__device__ __forceinline__ int win_row_p(int n0) { const int r = win_row(n0), c = r & 255; return (r & ~255) + (((c >> 5) & 1) << 7) + ((c >> 6) << 5) + (c & 31); }
struct LayerW {
    const float *norm_mix_g, *w_in, *diff_qk_g, *diff_lambda, *diff_out_g, *mla_cq_g, *w_uq, *mla_ckv_g, *w_ukv, *mla_qk_g, *swa_qk_g, *swa_sink,
                *w_ba, *w_bb, *w_bc, *w_o, *norm_ffn_g, *w_router, *w_eg, *w_eu, *w_ed;
};
__device__ __forceinline__ void p_convert(const Frame& F, const LayerW& L, unsigned char* ws) {
    int tid_ = threadIdx.x; asm volatile("" : "+v"(tid_)); const int tid = tid_, lane = tid & 63; (void)tid; (void)lane;
    LAS float* scr = (LAS float*)(F.lds + RING_OFF + F.wave * 16384);
    const int gw = F.vcu * NWAVES + F.wave, NGW = F.G * NWAVES;
    constexpr int I_IN = 16 * 189, I_UQ = 6 * 24, I_UKV = 4 * 32, I_BR = 8 * 32, I_O = 16 * 32, I_E = 16 * 512;
    constexpr int NITEMS = I_IN + I_UQ + I_UKV + 3 * I_BR + I_O + 3 * I_E;
    bf16* win = (bf16*)(ws + WS_WIN);
    for (int it = gw; it < NITEMS; it += NGW) {
        int r = it;
        if (r < I_IN) { const int kb = r / 189, nb = r % 189;
            if (nb < 93) cvt_block(L.w_in, 1024, IN_COLS, kb * 64, nb * 32, win, win_row_p(nb * 32), scr, lane);
            else cvt_block8(L.w_in, 1024, IN_COLS, kb * 64, nb * 32, ws + WS_WG8, nb * 32 - 2976, W8_SCALE, scr, lane);
            continue; } r -= I_IN;
        if (r < I_UQ) { const int kb = r / 24, nb = r % 24; cvt_block(L.w_uq, 384, 768, kb * 64, nb * 32, (bf16*)(ws + WS_WUQ), nb * 32, scr, lane, L.mla_cq_g); continue; } r -= I_UQ;
        if (r < I_UKV) { const int kb = r / 32, nb = r % 32, n0 = nb * 32, h = n0 >> 7, jj = n0 & 127; const int dr = jj < 64 ? h * 64 + jj : 512 + h * 64 + (jj - 64);
            cvt_block(L.w_ukv, 256, 1024, kb * 64, n0, (bf16*)(ws + WS_WUKV), dr, scr, lane, L.mla_ckv_g); continue; } r -= I_UKV;
        if (r < I_BR) { const int kb = r / 32, nb = r % 32; cvt_block(L.w_ba, 512, 1024, kb * 64, nb * 32, (bf16*)(ws + WS_WBA), nb * 32, scr, lane); continue; } r -= I_BR;
        if (r < I_BR) { const int kb = r / 32, nb = r % 32; cvt_block(L.w_bb, 512, 1024, kb * 64, nb * 32, (bf16*)(ws + WS_WBB), nb * 32, scr, lane); continue; } r -= I_BR;
        if (r < I_BR) { const int kb = r / 32, nb = r % 32; cvt_block(L.w_bc, 512, 1024, kb * 64, nb * 32, (bf16*)(ws + WS_WBC), nb * 32, scr, lane); continue; } r -= I_BR;
        if (r < I_O) { const int kb = r / 32, nb = r % 32; cvt_block(L.w_o, 1024, 1024, kb * 64, nb * 32, (bf16*)(ws + WS_WO), nb * 32, scr, lane); continue; } r -= I_O;
        { const int w = r / I_E, q = r % I_E, e = q / 512, qq = q % 512, kb = qq / 32, nb = qq % 32, n0 = nb * 32;
          const int dr = (n0 >> 7) * 256 + (n0 & 127);
          if (w == 0) cvt_block8(L.w_eg + (size_t)e * 1024 * 1024, 1024, 1024, kb * 64, n0, ws + WS_WGU + (size_t)e * 2048 * 1024, dr, W8_SCALE, scr, lane);
          else if (w == 1) cvt_block8(L.w_eu + (size_t)e * 1024 * 1024, 1024, 1024, kb * 64, n0, ws + WS_WGU + (size_t)e * 2048 * 1024, dr + 128, W8_SCALE, scr, lane);
          else cvt_block8(L.w_ed + (size_t)e * 1024 * 1024, 1024, 1024, kb * 64, n0, ws + WS_WD + (size_t)e * 1024 * 1024, n0, W8_SCALE, scr, lane); }
    }
    { const int gt = (F.vcu * NWAVES + F.wave) * 64 + lane, NGT = NGW * 64;
      unsigned z_ = 0u; asm volatile("" : "+v"(z_));
      for (int i = gt; i < 96 * 1024 / 8; i += NGT) { const int blk = i / (32 * 1024 / 8), off = i % (32 * 1024 / 8); const int r0 = 2816 + (blk == 0 ? 192 : (blk == 1 ? 96 : 224));
          *(v4u*)(win + (size_t)r0 * 1024 + (size_t)off * 8) = (v4u){z_, z_, z_, z_}; }
      if (gt < 256) { const int gi = gt >> 6, d = gt & 63; const float QS_ = 0.125f * LOG2E;
          const float v = gi == 0 ? L.diff_qk_g[d] * QS_ : (gi == 1 ? L.swa_qk_g[d] * QS_ : (gi == 2 ? L.diff_qk_g[64 + d] : L.swa_qk_g[64 + d]));
          ((float*)(ws + WS_GT))[gt] = v; } }
}

__device__ __forceinline__ void p_norm1(const Frame& F, const float* x, const float* g, bf16* h) {
    int tid_ = threadIdx.x; asm volatile("" : "+v"(tid_)); const int tid = tid_, lane = tid & 63; (void)tid; (void)lane;
    const int gw = F.vcu * NWAVES + F.wave, NGW = F.G * NWAVES;
    f32x4 gv[4];
#pragma unroll
    for (int j = 0; j < 4; ++j) gv[j] = *((const f32x4*)g + lane + 64 * j);
    for (int row0 = gw * 2; row0 < T; row0 += NGW * 2) {
        f32x4 v[2][4];
#pragma unroll
        for (int rr = 0; rr < 2; ++rr) { const f32x4* xr = (const f32x4*)(x + (size_t)(row0 + rr) * DM) + lane;
#pragma unroll
            for (int j = 0; j < 4; ++j) v[rr][j] = xr[64 * j]; }
#pragma unroll
        for (int rr = 0; rr < 2; ++rr) { float s = 0.f;
#pragma unroll
            for (int j = 0; j < 4; ++j) s += (v[rr][j].x * v[rr][j].x + v[rr][j].y * v[rr][j].y) + (v[rr][j].z * v[rr][j].z + v[rr][j].w * v[rr][j].w);
            const float rs = 1.0f / sqrtf(wave_sum(s) * (1.0f / DM) + EPS);
            v2u* o8 = (v2u*)(h + (size_t)(row0 + rr) * DM) + lane;
#pragma unroll
            for (int j = 0; j < 4; ++j) { v2u o; o.x = pk2(v[rr][j].x * rs * gv[j].x, v[rr][j].y * rs * gv[j].y); o.y = pk2(v[rr][j].z * rs * gv[j].z, v[rr][j].w * rs * gv[j].w); o8[64 * j] = o; } }
    }
}

__device__ __forceinline__ float grp8_sum(float v) { v = xor_add<1>(v); v = xor_add<2>(v); v = xor_add<4>(v); return v; }
struct U8 { float f[8]; };
__device__ __forceinline__ U8 ld8bf(const bf16* p) { const v4u w = *(const v4u*)p; U8 r; r.f[0] = bflo(w.x); r.f[1] = bfhi(w.x); r.f[2] = bflo(w.y); r.f[3] = bfhi(w.y); r.f[4] = bflo(w.z); r.f[5] = bfhi(w.z); r.f[6] = bflo(w.w); r.f[7] = bfhi(w.w); return r; }
__device__ __forceinline__ void st8bf(bf16* p, const U8& r) { v4u w; w.x = pk2(r.f[0], r.f[1]); w.y = pk2(r.f[2], r.f[3]); w.z = pk2(r.f[4], r.f[5]); w.w = pk2(r.f[6], r.f[7]); *(v4u*)p = w; }
__device__ __forceinline__ float ss8(const U8& r) { float s = 0.f;
#pragma unroll
    for (int i = 0; i < 8; ++i) s += r.f[i] * r.f[i];
    return s; }
__device__ __forceinline__ void p_prep1(const Frame& F, const LayerW& L, unsigned char* ws) {
    int tid_ = threadIdx.x; asm volatile("" : "+v"(tid_)); const int tid = tid_, lane = tid & 63; (void)tid; (void)lane;
    const int gw = F.vcu * NWAVES + F.wave, NGW = F.G * NWAVES;
    const float QS = 0.125f * LOG2E;
    float gqa[8], gka[8], gqc[8], gkc[8], gcq[8], gckv[8];
#pragma unroll
    for (int i = 0; i < 8; ++i) { const int d = (lane & 7) * 8 + i;
        gqa[i] = L.diff_qk_g[d] * QS; gka[i] = L.diff_qk_g[64 + d]; gqc[i] = L.swa_qk_g[d] * QS; gkc[i] = L.swa_qk_g[64 + d];
        gcq[i] = lane < 48 ? L.mla_cq_g[lane * 8 + i] : 0.f; gckv[i] = lane < 32 ? L.mla_ckv_g[lane * 8 + i] : 0.f; }
    bf16* QA = (bf16*)(ws + WS_QA); bf16* KA = (bf16*)(ws + WS_KA); bf16* QC = (bf16*)(ws + WS_QC); bf16* CQKC = (bf16*)(ws + WS_CQKC); bf16* CKV = (bf16*)(ws + WS_CKV);
    for (int row0 = gw * 2; row0 < T; row0 += NGW * 2) {
        U8 a[2], b[2], c[2], d[2], e[2];
#pragma unroll
        for (int rr = 0; rr < 2; ++rr) { const int row = row0 + rr; const size_t o512 = (size_t)row * 512 + lane * 8;
            a[rr] = ld8bf(QA + o512); b[rr] = ld8bf(KA + o512); c[rr] = ld8bf(QC + o512); d[rr] = ld8bf(CQKC + o512);
            if (lane < 32) e[rr] = ld8bf(CKV + (size_t)row * 256 + lane * 8); else {
#pragma unroll
                for (int i = 0; i < 8; ++i) e[rr].f[i] = 0.f; } }
#pragma unroll
        for (int rr = 0; rr < 2; ++rr) { const int row = row0 + rr; const size_t o512 = (size_t)row * 512 + lane * 8;
            const float ra = 1.0f / sqrtf(grp8_sum(ss8(a[rr])) * (1.0f / 64) + EPS);
            const float rb = 1.0f / sqrtf(grp8_sum(ss8(b[rr])) * (1.0f / 64) + EPS);
            const float rc = 1.0f / sqrtf(grp8_sum(ss8(c[rr])) * (1.0f / 64) + EPS);
            const float sd = grp8_sum(ss8(d[rr]));
            float tot = lane < 48 ? sd : 0.f; tot = xor_add<8>(tot); tot = xor_add<16>(tot); tot = xor_add<32>(tot);
            const float rd = lane < 48 ? 1.0f / sqrtf(tot * (1.0f / 384) + EPS) : 1.0f / sqrtf(sd * (1.0f / 64) + EPS);
            float se = grp8_sum(ss8(e[rr])); se = xor_add<8>(se); se = xor_add<16>(se);
            const float re = 1.0f / sqrtf(se * (1.0f / 256) + EPS);
#pragma unroll
            for (int i = 0; i < 8; ++i) { a[rr].f[i] *= ra * gqa[i]; b[rr].f[i] *= rb * gka[i]; c[rr].f[i] *= rc * gqc[i]; d[rr].f[i] *= rd * (lane < 48 ? gcq[i] : gkc[i]); e[rr].f[i] *= re * gckv[i]; }
            st8bf(QA + o512, a[rr]); st8bf(KA + o512, b[rr]); st8bf(QC + o512, c[rr]); st8bf(CQKC + o512, d[rr]);
            if (lane < 32) st8bf(CKV + (size_t)row * 256 + lane * 8, e[rr]); }
    }
}

__device__ __forceinline__ void p_prep2(const Frame& F, const LayerW& L, unsigned char* ws, const int* positions) {
    int tid_ = threadIdx.x; asm volatile("" : "+v"(tid_)); const int tid = tid_, lane = tid & 63; (void)tid; (void)lane;
    const int gw = F.vcu * NWAVES + F.wave, NGW = F.G * NWAVES, h = lane >> 3, j = lane & 7;
    const float QS = 0.10206207261596575f * LOG2E;
    float gqn[8], gkn[8], gqr[4], gkr[4], invf[4];
#pragma unroll
    for (int i = 0; i < 8; ++i) { gqn[i] = L.mla_qk_g[8 * j + i] * QS; gkn[i] = L.mla_qk_g[96 + 8 * j + i]; }
#pragma unroll
    for (int i = 0; i < 4; ++i) { gqr[i] = L.mla_qk_g[64 + 4 * j + i] * QS; gkr[i] = L.mla_qk_g[96 + 64 + 4 * j + i];
        const int fi = 4 * (j & 3) + i; invf[i] = (float)(exp2(-(double)fi * (13.287712379549449 / 16.0)) * 0.15915494309189535); }
    bf16* QB = (bf16*)(ws + WS_QB); const bf16* KVR = (const bf16*)(ws + WS_KVR); const bf16* VCKR = (const bf16*)(ws + WS_VCKR); bf16* KB = (bf16*)(ws + WS_KB);
    for (int row0 = gw * 2; row0 < T; row0 += NGW * 2) {
        float posf[2]; U8 qn[2], kn[2]; v2u qw[2], kw[2];
#pragma unroll
        for (int rr = 0; rr < 2; ++rr) { const int row = row0 + rr; posf[rr] = (float)positions[row];
            const bf16* qrow = QB + (size_t)row * 768 + h * 96;
            qn[rr] = ld8bf(qrow + 8 * j); qw[rr] = *(const v2u*)(qrow + 64 + 4 * j);
            kn[rr] = ld8bf(KVR + (size_t)row * 1024 + h * 64 + 8 * j); kw[rr] = *(const v2u*)(VCKR + (size_t)row * 256 + 128 + 4 * j); }
#pragma unroll
        for (int rr = 0; rr < 2; ++rr) { const int row = row0 + rr;
            float cs[4], sn[4];
#pragma unroll
            for (int i = 0; i < 4; ++i) { const double tr = (double)posf[rr] * (double)invf[i]; const float fr = (float)(tr - floor(tr)); cs[i] = __builtin_amdgcn_cosf(fr); sn[i] = __builtin_amdgcn_sinf(fr); }
            bf16* qrow = QB + (size_t)row * 768 + h * 96;
            float qr_[4] = {bflo(qw[rr].x), bfhi(qw[rr].x), bflo(qw[rr].y), bfhi(qw[rr].y)}, qo[4];
#pragma unroll
            for (int i = 0; i < 4; ++i) { const float other = xor_getf<4>(qr_[i]); qo[i] = (j < 4) ? (qr_[i] * cs[i] - other * sn[i]) : (other * sn[i] + qr_[i] * cs[i]); }
            const float sq = ss8(qn[rr]) + (qo[0] * qo[0] + qo[1] * qo[1]) + (qo[2] * qo[2] + qo[3] * qo[3]);
            const float rq = 1.0f / sqrtf(grp8_sum(sq) * (1.0f / 96) + EPS);
#pragma unroll
            for (int i = 0; i < 8; ++i) qn[rr].f[i] *= rq * gqn[i];
            st8bf(qrow + 8 * j, qn[rr]);
            { v2u w; w.x = pk2(qo[0] * rq * gqr[0], qo[1] * rq * gqr[1]); w.y = pk2(qo[2] * rq * gqr[2], qo[3] * rq * gqr[3]); *(v2u*)(qrow + 64 + 4 * j) = w; }
            float kr_[4] = {bflo(kw[rr].x), bfhi(kw[rr].x), bflo(kw[rr].y), bfhi(kw[rr].y)}, ko[4];
#pragma unroll
            for (int i = 0; i < 4; ++i) { const float other = xor_getf<4>(kr_[i]); ko[i] = (j < 4) ? (kr_[i] * cs[i] - other * sn[i]) : (other * sn[i] + kr_[i] * cs[i]); }
            const float sk = ss8(kn[rr]) + (ko[0] * ko[0] + ko[1] * ko[1]) + (ko[2] * ko[2] + ko[3] * ko[3]);
            const float rk = 1.0f / sqrtf(grp8_sum(sk) * (1.0f / 96) + EPS);
#pragma unroll
            for (int i = 0; i < 8; ++i) kn[rr].f[i] *= rk * gkn[i];
            bf16* krow = KB + (size_t)row * 768 + h * 96;
            st8bf(krow + 8 * j, kn[rr]);
            { v2u w; w.x = pk2(ko[0] * rk * gkr[0], ko[1] * rk * gkr[1]); w.y = pk2(ko[2] * rk * gkr[2], ko[3] * rk * gkr[3]); *(v2u*)(krow + 64 + 4 * j) = w; } }
    }
}

__device__ __forceinline__ void p_tile_minmax(const Frame& F, unsigned char* ws, const int* positions) {
    int tid_ = threadIdx.x; asm volatile("" : "+v"(tid_)); const int lane = tid_ & 63;
    const int gw = F.vcu * NWAVES + F.wave, NGW = F.G * NWAVES;
    float* tmm = (float*)(ws + WS_TMM);
    for (int tl = gw; tl < T / 64; tl += NGW) {
        const float p = (float)positions[tl * 64 + lane];
        float hi = p, lo = -p;
        hi = xor_max<1>(hi); hi = xor_max<2>(hi); hi = xor_max<4>(hi); hi = xor_max<8>(hi); hi = xor_max<16>(hi); hi = xor_max<32>(hi);
        lo = xor_max<1>(lo); lo = xor_max<2>(lo); lo = xor_max<4>(lo); lo = xor_max<8>(lo); lo = xor_max<16>(lo); lo = xor_max<32>(lo);
        if (lane == 0) { tmm[tl * 2] = -lo; tmm[tl * 2 + 1] = hi; }
    }
}

__device__ __forceinline__ void p_h_to_fp8(const Frame& F, unsigned char* ws) {
    int tid_ = threadIdx.x; asm volatile("" : "+v"(tid_));
    const size_t gt = (size_t)(F.vcu * NWAVES * 64) + tid_, NGT = (size_t)F.G * NWAVES * 64;
    const v4u* src = (const v4u*)(ws + WS_H); v2u* dst = (v2u*)(ws + WS_H8);
    for (size_t i = gt; i < (size_t)T * DM / 8; i += NGT * 4) {
        v4u x[4];
#pragma unroll
        for (int k = 0; k < 4; ++k) if (i + k * NGT < (size_t)T * DM / 8) x[k] = src[i + k * NGT];
#pragma unroll
        for (int k = 0; k < 4; ++k) if (i + k * NGT < (size_t)T * DM / 8) {
            const f32x4 a0 = {bflo(x[k].x), bfhi(x[k].x), bflo(x[k].y), bfhi(x[k].y)}, a1 = {bflo(x[k].z), bfhi(x[k].z), bflo(x[k].w), bfhi(x[k].w)};
            const pg8::u32x2 w = pg8::pack8_fp8(a0, a1); v2u o; o.x = w.x; o.y = w.y; dst[i + k * NGT] = o; }
    }
}

namespace att {
__device__ __forceinline__ int crow(int r, int hi) { return (r & 3) + 8 * (r >> 2) + 4 * hi; }
#define ATT_SBAR() __builtin_amdgcn_sched_barrier(0)
typedef float f32x2_t __attribute__((ext_vector_type(2))); typedef __bf16 bf16x2_t __attribute__((ext_vector_type(2)));
__device__ __forceinline__ unsigned cvtpk(float lo, float hi) { f32x2_t v = {lo, hi}; bf16x2_t b = __builtin_convertvector(v, bf16x2_t); return __builtin_bit_cast(unsigned, b); }

struct Args {
    const bf16* Q; const bf16* K; const bf16* V;
    int pq, pk, pv;
    const int* pos;
    float slope2, sink2;
    float mfix;
};
typedef short v4i16_t __attribute__((ext_vector_type(4)));
__device__ __forceinline__ s16x4 vtr(const LAS unsigned char* p) { return __builtin_bit_cast(s16x4, __builtin_amdgcn_ds_read_tr16_b64_v4i16((LAS v4i16_t*)p)); }
__device__ __forceinline__ float max3f(float a, float b, float c) { return __builtin_fmaxf(__builtin_fmaxf(a, b), c); }
template <int DQK, int DV, int MODE, int ABL = 0>
__device__ __forceinline__ void attn_core(const Args& A, int q0, unsigned long long tmask, LAS unsigned char* lds, float (&res)[DV / 32][16]) {
    constexpr int KSTR = DQK * 2 + 16, KBYTES = 64 * KSTR, VBYTES = 64 * DV * 2, PBYTES = 256;
    constexpr int BUF = KBYTES + VBYTES + PBYTES;
    constexpr int CPR = DQK / 8, NKP = 64 * CPR, KP = (NKP + 511) / 512, VP = (64 * DV / 8) / 512, ND0 = DV / 32, NKS = DQK / 16;
    constexpr float THR = 6.0f;
    static_assert(2 * BUF + 8 * 256 <= ATT_STASH_OFF, "attention LDS");
    int tid_ = threadIdx.x; asm volatile("" : "+v"(tid_));
    const int tid = tid_, lane = tid & 63, wid = __builtin_amdgcn_readfirstlane(tid >> 6), r32 = lane & 31, hi = lane >> 5;
    LAS float* wsf = (LAS float*)(lds + 2 * BUF) + wid * 64;

    bf16x8 qr[NKS];
#pragma unroll
    for (int d0 = 0; d0 < NKS; ++d0) qr[d0] = *(const bf16x8*)(A.Q + (size_t)(q0 + wid * 32 + r32) * A.pq + d0 * 16 + hi * 8);
    float pqf = 0.f;
    if (MODE == 1) pqf = (float)A.pos[q0 + wid * 32 + r32];
    if (MODE == 2) pqf = (float)(q0 + wid * 32 + r32);

    f32x16 o[ND0];
#pragma unroll
    for (int d = 0; d < ND0; ++d)
#pragma unroll
        for (int r = 0; r < 16; ++r) o[d][r] = 0.f;
    float l_reg = (MODE == 2 && hi == 0) ? __builtin_amdgcn_exp2f(A.sink2 - A.mfix) : 0.f;
    f32x16 negm;
#pragma unroll
    for (int r = 0; r < 16; ++r) negm[r] = -A.mfix;

    bf16x8 sk[KP], sv[VP]; float spos = 0.f;
    unsigned gk_off[KP], lk_off[KP], gv_off[VP], lv_off[VP];
#pragma unroll
    for (int i = 0; i < KP; ++i) { const int p = tid + 512 * i, row = p / CPR, ch = p % CPR; gk_off[i] = (unsigned)(row * A.pk + ch * 8) * 2u; lk_off[i] = (unsigned)(row * KSTR + ch * 16); }
#pragma unroll
    for (int i = 0; i < VP; ++i) { const int p = tid + 512 * i, db = p >> 8, row = (p & 255) >> 2, c4 = p & 3; gv_off[i] = (unsigned)(row * A.pv + db * 32 + c4 * 8) * 2u;
        lv_off[i] = (unsigned)(KBYTES + db * 4096 + (row >> 4) * 1024 + (row & 15) * 64 + c4 * 16); }
#define ATT_SLOAD(t) do { const int k0_ = (t) * 64; const char* kb_ = (const char*)(A.K + (size_t)k0_ * A.pk); const char* vb_ = (const char*)(A.V + (size_t)k0_ * A.pv); \
    _Pragma("unroll") for (int i = 0; i < KP; ++i) { if (tid + 512 * i < NKP) sk[i] = *(const bf16x8*)(kb_ + gk_off[i]); } \
    _Pragma("unroll") for (int i = 0; i < VP; ++i) sv[i] = *(const bf16x8*)(vb_ + gv_off[i]); \
    if (MODE == 1) { if (tid < 64) spos = (float)A.pos[k0_ + tid]; } if (MODE == 2) { spos = (float)(k0_ + tid); } } while (0)
#define ATT_SWRITE(b) do { LAS unsigned char* base_ = lds + (b) * BUF; \
    _Pragma("unroll") for (int i = 0; i < KP; ++i) { if (tid + 512 * i < NKP) *(LAS bf16x8*)(base_ + lk_off[i]) = sk[i]; } \
    _Pragma("unroll") for (int i = 0; i < VP; ++i) *(LAS bf16x8*)(base_ + lv_off[i]) = sv[i]; \
    if (MODE != 0) { if (tid < 64) *(LAS float*)(base_ + KBYTES + VBYTES + tid * 4) = spos; } } while (0)
#define ATT_VRD(VF, d) do { const LAS unsigned char* vp_ = vbase + (d) * 4096; \
    _Pragma("unroll") for (int ks = 0; ks < 4; ++ks) { VF[2 * ks] = vtr(vp_ + ks * 1024); VF[2 * ks + 1] = vtr(vp_ + ks * 1024 + 512); } } while (0)
#define ATT_PK(L, H) (bf16x8){L[0], L[1], L[2], L[3], H[0], H[1], H[2], H[3]}
#define ATT_MMA(VF, d) do { _Pragma("unroll") for (int ks = 0; ks < 4; ++ks) { if (ABL == 2) o[d][ks] += __builtin_bit_cast(float, (int)pa[ks][0]) + __builtin_bit_cast(float, (int)VF[2 * ks][0] + (int)VF[2 * ks + 1][0]); else o[d] = __builtin_amdgcn_mfma_f32_32x32x16_bf16(pa[ks], ATT_PK(VF[2 * ks], VF[2 * ks + 1]), o[d], 0, 0, 0); } } while (0)

    int t = __builtin_ctzll(tmask); tmask &= tmask - 1;
    ATT_SLOAD(t); ATT_SWRITE(0); __syncthreads();
    for (int cur = 0;; cur ^= 1) {
        const bool more = tmask != 0ull; const int tn = more ? __builtin_ctzll(tmask) : 0; tmask &= tmask - 1;
        LAS unsigned char* bufp = lds + cur * BUF;
        if (more && ABL != 4) ATT_SLOAD(tn);
        f32x16 p0, p1;
        const LAS unsigned char* kb = bufp + r32 * KSTR + hi * 16;
#pragma unroll
        for (int d0 = 0; d0 < NKS; ++d0) {
            const bf16x8 b0 = *(const LAS bf16x8*)(kb + d0 * 32);
            const bf16x8 b1 = *(const LAS bf16x8*)(kb + 32 * KSTR + d0 * 32);
            if (ABL == 2) { if (d0 == 0) { p0 = negm; p1 = negm; } p0[d0] += __builtin_bit_cast(float, (int)b0[0]); p1[d0] += __builtin_bit_cast(float, (int)b1[0]); }
            else if (d0 == 0) { p0 = __builtin_amdgcn_mfma_f32_32x32x16_bf16(b0, qr[0], negm, 0, 0, 0); p1 = __builtin_amdgcn_mfma_f32_32x32x16_bf16(b1, qr[0], negm, 0, 0, 0); }
            else { p0 = __builtin_amdgcn_mfma_f32_32x32x16_bf16(b0, qr[d0], p0, 0, 0, 0); p1 = __builtin_amdgcn_mfma_f32_32x32x16_bf16(b1, qr[d0], p1, 0, 0, 0); }
        }
        const LAS unsigned char* vbase = bufp + KBYTES + ((lane >> 4) & 1) * 32 + (lane & 3) * 8 + (4 * hi + ((lane & 15) >> 2)) * 64;
        s16x4 vfa[8], vfb[8];
        ATT_VRD(vfa, 0);
        if (MODE != 0) {
            const LAS float* pk = (const LAS float*)(bufp + KBYTES + VBYTES);
#pragma unroll
            for (int g = 0; g < 4; ++g) {
                const f32x4 k0v = *(const LAS f32x4*)(pk + 8 * g + 4 * hi), k1v = *(const LAS f32x4*)(pk + 32 + 8 * g + 4 * hi);
#pragma unroll
                for (int i = 0; i < 4; ++i) {
                    const float d0f = fabsf(pqf - k0v[i]), d1f = fabsf(pqf - k1v[i]);
                    float s0 = fmaf(-A.slope2, d0f, p0[4 * g + i]), s1 = fmaf(-A.slope2, d1f, p1[4 * g + i]);
                    if (MODE == 2) { s0 = d0f <= 128.0f ? s0 : -1e30f; s1 = d1f <= 128.0f ? s1 : -1e30f; }
                    p0[4 * g + i] = s0; p1[4 * g + i] = s1;
                }
            }
        }
        float ps0 = 0.f, ps1 = 0.f, ps2 = 0.f, ps3 = 0.f;
#pragma unroll
        for (int r = 0; r < 16; r += 4) {
            if (ABL != 1) { p0[r] = __builtin_amdgcn_exp2f(p0[r]); p0[r + 1] = __builtin_amdgcn_exp2f(p0[r + 1]); p0[r + 2] = __builtin_amdgcn_exp2f(p0[r + 2]); p0[r + 3] = __builtin_amdgcn_exp2f(p0[r + 3]);
            p1[r] = __builtin_amdgcn_exp2f(p1[r]); p1[r + 1] = __builtin_amdgcn_exp2f(p1[r + 1]); p1[r + 2] = __builtin_amdgcn_exp2f(p1[r + 2]); p1[r + 3] = __builtin_amdgcn_exp2f(p1[r + 3]); }
            ps0 += p0[r] + p1[r]; ps1 += p0[r + 1] + p1[r + 1]; ps2 += p0[r + 2] + p1[r + 2]; ps3 += p0[r + 3] + p1[r + 3];
        }
        l_reg += (ps0 + ps1) + (ps2 + ps3);
        bf16x8 pa[4];
#pragma unroll
        for (int s = 0; s < 2; ++s) {
            v4u w0 = {cvtpk(p0[8 * s + 0], p0[8 * s + 1]), cvtpk(p0[8 * s + 2], p0[8 * s + 3]), cvtpk(p0[8 * s + 4], p0[8 * s + 5]), cvtpk(p0[8 * s + 6], p0[8 * s + 7])};
            v4u w1 = {cvtpk(p1[8 * s + 0], p1[8 * s + 1]), cvtpk(p1[8 * s + 2], p1[8 * s + 3]), cvtpk(p1[8 * s + 4], p1[8 * s + 5]), cvtpk(p1[8 * s + 6], p1[8 * s + 7])};
            pa[s] = __builtin_bit_cast(bf16x8, w0); pa[2 + s] = __builtin_bit_cast(bf16x8, w1);
        }
        if (ND0 == 2) { ATT_VRD(vfb, 1); ATT_MMA(vfa, 0); ATT_MMA(vfb, 1); }
        else { ATT_VRD(vfb, 1); ATT_MMA(vfa, 0); ATT_VRD(vfa, 2); ATT_MMA(vfb, 1); ATT_VRD(vfb, 3); ATT_MMA(vfa, 2); ATT_MMA(vfb, 3); }
        if (more && ABL != 4) ATT_SWRITE(cur ^ 1);
        if (ABL != 3) __syncthreads();
        if (!more) break;
        t = tn;
    }
#undef ATT_SLOAD
#undef ATT_SWRITE
#undef ATT_VRD
#undef ATT_PK
#undef ATT_MMA
    { const float lt = xor_add<32>(l_reg); if (hi == 0) wsf[32 + r32] = 1.0f / lt; }
    LDS_WAIT();
#pragma unroll
    for (int g = 0; g < 4; ++g) {
        const f32x4 l0 = *(const LAS f32x4*)(wsf + 32 + 8 * g + 4 * hi);
#pragma unroll
        for (int d = 0; d < ND0; ++d)
#pragma unroll
            for (int i = 0; i < 4; ++i) res[d][4 * g + i] = o[d][4 * g + i] * l0[i];
    }
    LDS_WAIT();
    __syncthreads();
}
template <int DQK, int DV, int ABL = 0>
__device__ __forceinline__ void attn_core_p(const Args& A, int q0, unsigned long long tmask, LAS unsigned char* lds, float (&res)[DV / 32][16]) {
    constexpr int KSTR = DQK * 2 + 16, KBYTES = 64 * KSTR, VBYTES = 64 * DV * 2;
    constexpr int CPR = DQK / 8, NKP = 64 * CPR, KP = (NKP + 511) / 512, VP = (64 * DV / 8) / 512, ND0 = DV / 32, NKS = DQK / 16;
    constexpr int KOFF = 0, VOFF = 2 * KBYTES, WOFF = VOFF + 3 * VBYTES;
    static_assert(WOFF + 8 * 256 <= ATT_STASH_OFF, "attention LDS");
    int tid_ = threadIdx.x; asm volatile("" : "+v"(tid_));
    const int tid = tid_, lane = tid & 63, wid = __builtin_amdgcn_readfirstlane(tid >> 6), r32 = lane & 31, hi = lane >> 5;
    LAS float* wsf = (LAS float*)(lds + WOFF) + wid * 64;
    bf16x8 qr[NKS];
#pragma unroll
    for (int d0 = 0; d0 < NKS; ++d0) qr[d0] = *(const bf16x8*)(A.Q + (size_t)(q0 + wid * 32 + r32) * A.pq + d0 * 16 + hi * 8);
    f32x16 o[ND0];
#pragma unroll
    for (int d = 0; d < ND0; ++d)
#pragma unroll
        for (int r = 0; r < 16; ++r) o[d][r] = 0.f;
    float l_reg = 0.f;
    f32x16 negm;
#pragma unroll
    for (int r = 0; r < 16; ++r) negm[r] = -A.mfix;
    bf16x8 sk[KP], sv[VP];
    unsigned gk_off[KP], lk_off[KP], gv_off[VP], lv_off[VP];
#pragma unroll
    for (int i = 0; i < KP; ++i) { const int p = tid + 512 * i, row = p / CPR, ch = p % CPR; gk_off[i] = (unsigned)(row * A.pk + ch * 8) * 2u; lk_off[i] = (unsigned)(row * KSTR + ch * 16); }
#pragma unroll
    for (int i = 0; i < VP; ++i) { const int p = tid + 512 * i, db = p >> 8, row = (p & 255) >> 2, c4 = p & 3; gv_off[i] = (unsigned)(row * A.pv + db * 32 + c4 * 8) * 2u;
        lv_off[i] = (unsigned)(db * 4096 + (row >> 4) * 1024 + (row & 15) * 64 + c4 * 16); }
#define ATP_SLOAD(t) do { const int k0_ = (t) * 64; const char* kb_ = (const char*)(A.K + (size_t)k0_ * A.pk); const char* vb_ = (const char*)(A.V + (size_t)k0_ * A.pv); \
    _Pragma("unroll") for (int i = 0; i < KP; ++i) { if (tid + 512 * i < NKP) sk[i] = *(const bf16x8*)(kb_ + gk_off[i]); } \
    _Pragma("unroll") for (int i = 0; i < VP; ++i) sv[i] = *(const bf16x8*)(vb_ + gv_off[i]); } while (0)
#define ATP_SWRITE(kslot, vslot) do { LAS unsigned char* kb_ = lds + KOFF + (kslot) * KBYTES; LAS unsigned char* vb_ = lds + VOFF + (vslot) * VBYTES; \
    _Pragma("unroll") for (int i = 0; i < KP; ++i) { if (tid + 512 * i < NKP) *(LAS bf16x8*)(kb_ + lk_off[i]) = sk[i]; } \
    _Pragma("unroll") for (int i = 0; i < VP; ++i) *(LAS bf16x8*)(vb_ + lv_off[i]) = sv[i]; } while (0)
#define ATP_QKT(P0, P1, kslot) do { const LAS unsigned char* kb_ = lds + KOFF + (kslot) * KBYTES + r32 * KSTR + hi * 16; \
    _Pragma("unroll") for (int d0 = 0; d0 < NKS; ++d0) { const bf16x8 b0_ = (ABL == 5 || ABL == 7) ? qr[d0] : *(const LAS bf16x8*)(kb_ + d0 * 32); const bf16x8 b1_ = (ABL == 5 || ABL == 7) ? qr[NKS - 1 - d0] : *(const LAS bf16x8*)(kb_ + 32 * KSTR + d0 * 32); \
        if (ABL == 2) { if (d0 == 0) { P0 = negm; P1 = negm; } P0[d0] += __builtin_bit_cast(float, (int)b0_[0]); P1[d0] += __builtin_bit_cast(float, (int)b1_[0]); } \
        else if (d0 == 0) { P0 = __builtin_amdgcn_mfma_f32_32x32x16_bf16(b0_, qr[0], negm, 0, 0, 0); P1 = __builtin_amdgcn_mfma_f32_32x32x16_bf16(b1_, qr[0], negm, 0, 0, 0); } \
        else { P0 = __builtin_amdgcn_mfma_f32_32x32x16_bf16(b0_, qr[d0], P0, 0, 0, 0); P1 = __builtin_amdgcn_mfma_f32_32x32x16_bf16(b1_, qr[d0], P1, 0, 0, 0); } } } while (0)
#define ATP_SOFT(P0, P1) do { \
    if (ABL != 1) { _Pragma("unroll") for (int r = 0; r < 16; ++r) { P0[r] = __builtin_amdgcn_exp2f(P0[r]); P1[r] = __builtin_amdgcn_exp2f(P1[r]); } } \
    _Pragma("unroll") for (int s_ = 0; s_ < 2; ++s_) { \
        v4u w0_ = {cvtpk(P0[8 * s_ + 0], P0[8 * s_ + 1]), cvtpk(P0[8 * s_ + 2], P0[8 * s_ + 3]), cvtpk(P0[8 * s_ + 4], P0[8 * s_ + 5]), cvtpk(P0[8 * s_ + 6], P0[8 * s_ + 7])}; \
        v4u w1_ = {cvtpk(P1[8 * s_ + 0], P1[8 * s_ + 1]), cvtpk(P1[8 * s_ + 2], P1[8 * s_ + 3]), cvtpk(P1[8 * s_ + 4], P1[8 * s_ + 5]), cvtpk(P1[8 * s_ + 6], P1[8 * s_ + 7])}; \
        pa[s_] = __builtin_bit_cast(bf16x8, w0_); pa[2 + s_] = __builtin_bit_cast(bf16x8, w1_); } } while (0)
#define ATP_SUM(P0, P1) do { float ps0 = 0.f, ps1 = 0.f, ps2 = 0.f, ps3 = 0.f; \
    _Pragma("unroll") for (int r = 0; r < 16; r += 4) { ps0 += P0[r] + P1[r]; ps1 += P0[r + 1] + P1[r + 1]; ps2 += P0[r + 2] + P1[r + 2]; ps3 += P0[r + 3] + P1[r + 3]; } \
    l_reg += (ps0 + ps1) + (ps2 + ps3); } while (0)
#define ATP_VRD(VF, vslot, d) do { const LAS unsigned char* vp_ = lds + VOFF + (vslot) * VBYTES + vlane + (d) * 4096; \
    _Pragma("unroll") for (int ks = 0; ks < 4; ++ks) { if (ABL == 6 || ABL == 7) { VF[2 * ks] = __builtin_bit_cast(s16x4, (unsigned long long)(uintptr_t)vp_ * (ks + 1)); VF[2 * ks + 1] = __builtin_bit_cast(s16x4, (unsigned long long)(uintptr_t)vp_ * (ks + 5)); } else { VF[2 * ks] = vtr(vp_ + ks * 1024); VF[2 * ks + 1] = vtr(vp_ + ks * 1024 + 512); } } } while (0)
#define ATP_PK(L, H) (bf16x8){L[0], L[1], L[2], L[3], H[0], H[1], H[2], H[3]}
#define ATP_MMA(VF, d) do { _Pragma("unroll") for (int ks = 0; ks < 4; ++ks) { if (ABL == 2) o[d][ks] += __builtin_bit_cast(float, (int)pa[ks][0]) + __builtin_bit_cast(float, (int)VF[2 * ks][0] + (int)VF[2 * ks + 1][0]); else o[d] = __builtin_amdgcn_mfma_f32_32x32x16_bf16(pa[ks], ATP_PK(VF[2 * ks], VF[2 * ks + 1]), o[d], 0, 0, 0); } } while (0)
#define ATP_STEP(PC0, PC1, PN0, PN1) do { \
    const bool more1_ = have_next; const int tn1_ = t_next; \
    const bool more2_ = tmask != 0ull; const int tn2_ = more2_ ? __builtin_ctzll(tmask) : 0; tmask &= tmask - 1; \
    if (more2_ && ABL != 4) ATP_SLOAD(tn2_); \
    s16x4 vfa[8], vfb[8]; ATP_VRD(vfa, vc, 0); \
    ATP_QKT(PN0, PN1, more1_ ? (kc ^ 1) : kc);     \
    ATP_SOFT(PC0, PC1); ATT_SBAR();        \
    static_assert(ND0 == 2, "pipelined core: DV = 64"); \
    ATP_VRD(vfb, vc, 1); ATP_SUM(PC0, PC1); ATP_MMA(vfa, 0); ATP_MMA(vfb, 1); ATT_SBAR();     \
    if (more2_ && ABL != 4) ATP_SWRITE(kc, vc == 0 ? 2 : vc - 1); \
    if (ABL != 3) __syncthreads(); \
    kc ^= 1; vc = (vc == 2) ? 0 : vc + 1; have_next = more2_; t_next = tn2_; (void)tn1_; \
    if (!more1_) goto atp_done; } while (0)

    const int vlane = ((lane >> 4) & 1) * 32 + (lane & 3) * 8 + (4 * hi + ((lane & 15) >> 2)) * 64;
    f32x16 pA0, pA1, pB0, pB1; bf16x8 pa[4];
    int kc = 0, vc = 0;
    { const int t_a = __builtin_ctzll(tmask); tmask &= tmask - 1; ATP_SLOAD(t_a); ATP_SWRITE(0, 0); }
    bool have_next = tmask != 0ull; int t_next = have_next ? __builtin_ctzll(tmask) : 0; tmask &= tmask - 1;
    __syncthreads();
    if (have_next) ATP_SLOAD(t_next);
    ATP_QKT(pA0, pA1, 0);
    if (have_next) ATP_SWRITE(1, 1);
    __syncthreads();
    for (;;) { ATP_STEP(pA0, pA1, pB0, pB1); ATP_STEP(pB0, pB1, pA0, pA1); }
atp_done:
#undef ATP_SLOAD
#undef ATP_SWRITE
#undef ATP_QKT
#undef ATP_SOFT
#undef ATP_SUM
#undef ATP_VRD
#undef ATP_PK
#undef ATP_MMA
#undef ATP_STEP
    { const float lt = xor_add<32>(l_reg); if (hi == 0) wsf[32 + r32] = 1.0f / lt; }
    LDS_WAIT();
#pragma unroll
    for (int g = 0; g < 4; ++g) {
        const f32x4 l0 = *(const LAS f32x4*)(wsf + 32 + 8 * g + 4 * hi);
#pragma unroll
        for (int d = 0; d < ND0; ++d)
#pragma unroll
            for (int i = 0; i < 4; ++i) res[d][4 * g + i] = o[d][4 * g + i] * l0[i];
    }
    LDS_WAIT();
    __syncthreads();
}
template <int DQK, int DV, int MODE, int RB, bool QL = false>
__device__ __forceinline__ void attn_core_rb(const Args& A, int q0, unsigned long long tmask, LAS unsigned char* lds, float (&res)[RB][DV / 32][16]) {
    constexpr int KSTR = DQK * 2 + 16, KBYTES = 64 * KSTR, VBYTES = 64 * DV * 2, PBYTES = 256;
    constexpr int BUF = KBYTES + VBYTES + PBYTES;
    constexpr int CPR = DQK / 8, NKP = 64 * CPR, KP = (NKP + 511) / 512, VP = (64 * DV / 8) / 512, ND0 = DV / 32, NKS = DQK / 16;
    static_assert(2 * BUF + 8 * 256 + (QL ? 8 * RB * NKS * 1024 : 0) <= (QL ? ATT_NXT_OFF : ATT_STASH_OFF), "attention LDS");
    int tid_ = threadIdx.x; asm volatile("" : "+v"(tid_));
    const int tid = tid_, lane = tid & 63, wid = __builtin_amdgcn_readfirstlane(tid >> 6), r32 = lane & 31, hi = lane >> 5;
    LAS float* wsf = (LAS float*)(lds + 2 * BUF) + wid * 64;
    LAS bf16x8* qlds = (LAS bf16x8*)(lds + 2 * BUF + 8 * 256) + wid * (RB * NKS * 64) + lane;
    const int wrow = q0 + wid * (32 * RB);

    bf16x8 qr[RB][NKS]; float pqf[RB];
#pragma unroll
    for (int rb = 0; rb < RB; ++rb) {
#pragma unroll
        for (int d0 = 0; d0 < NKS; ++d0) { qr[rb][d0] = *(const bf16x8*)(A.Q + (size_t)(wrow + rb * 32 + r32) * A.pq + d0 * 16 + hi * 8); if (QL) qlds[(rb * NKS + d0) * 64] = qr[rb][d0]; }
        pqf[rb] = 0.f;
        if (MODE == 1) pqf[rb] = (float)A.pos[wrow + rb * 32 + r32];
        if (MODE == 2) pqf[rb] = (float)(wrow + rb * 32 + r32);
    }
    f32x16 o[RB][ND0]; float l_reg[RB];
#pragma unroll
    for (int rb = 0; rb < RB; ++rb) { l_reg[rb] = (MODE == 2 && hi == 0) ? __builtin_amdgcn_exp2f(A.sink2) : 0.f;
#pragma unroll
        for (int d = 0; d < ND0; ++d)
#pragma unroll
            for (int r = 0; r < 16; ++r) o[rb][d][r] = 0.f; }

    bf16x8 sk[KP], sv[VP]; float spos = 0.f;
    unsigned gk_off[KP], lk_off[KP], gv_off[VP], lv_off[VP];
#pragma unroll
    for (int i = 0; i < KP; ++i) { const int p = tid + 512 * i, row = p / CPR, ch = p % CPR; gk_off[i] = (unsigned)(row * A.pk + ch * 8) * 2u; lk_off[i] = (unsigned)(row * KSTR + ch * 16); }
#pragma unroll
    for (int i = 0; i < VP; ++i) { const int p = tid + 512 * i, db = p >> 8, row = (p & 255) >> 2, c4 = p & 3; gv_off[i] = (unsigned)(row * A.pv + db * 32 + c4 * 8) * 2u;
        lv_off[i] = (unsigned)(KBYTES + db * 4096 + (row >> 4) * 1024 + (row & 15) * 64 + c4 * 16); }
#define ATR_SLOAD(t) do { const int k0_ = (t) * 64; const char* kb_ = (const char*)(A.K + (size_t)k0_ * A.pk); const char* vb_ = (const char*)(A.V + (size_t)k0_ * A.pv); \
    _Pragma("unroll") for (int i = 0; i < KP; ++i) { if (tid + 512 * i < NKP) sk[i] = *(const bf16x8*)(kb_ + gk_off[i]); } \
    _Pragma("unroll") for (int i = 0; i < VP; ++i) sv[i] = *(const bf16x8*)(vb_ + gv_off[i]); \
    if (MODE == 1) { if (tid < 64) spos = (float)A.pos[k0_ + tid]; } if (MODE == 2) { spos = (float)(k0_ + tid); } } while (0)
#define ATR_SWRITE(b) do { LAS unsigned char* base_ = lds + (b) * BUF; \
    _Pragma("unroll") for (int i = 0; i < KP; ++i) { if (tid + 512 * i < NKP) *(LAS bf16x8*)(base_ + lk_off[i]) = sk[i]; } \
    _Pragma("unroll") for (int i = 0; i < VP; ++i) *(LAS bf16x8*)(base_ + lv_off[i]) = sv[i]; \
    if (MODE != 0) { if (tid < 64) *(LAS float*)(base_ + KBYTES + VBYTES + tid * 4) = spos; } } while (0)
#define ATR_VRD(VF, d) do { const LAS unsigned char* vp_ = vbase + (d) * 4096; \
    _Pragma("unroll") for (int ks = 0; ks < 4; ++ks) { VF[2 * ks] = vtr(vp_ + ks * 1024); VF[2 * ks + 1] = vtr(vp_ + ks * 1024 + 512); } } while (0)
#define ATR_PK(L, H) (bf16x8){L[0], L[1], L[2], L[3], H[0], H[1], H[2], H[3]}
#define ATR_MMA(VF, d) do { _Pragma("unroll") for (int rb = 0; rb < RB; ++rb) _Pragma("unroll") for (int ks = 0; ks < 4; ++ks) \
        o[rb][d] = __builtin_amdgcn_mfma_f32_32x32x16_bf16(pa[rb][ks], ATR_PK(VF[2 * ks], VF[2 * ks + 1]), o[rb][d], 0, 0, 0); } while (0)

    int t = __builtin_ctzll(tmask); tmask &= tmask - 1;
    ATR_SLOAD(t); ATR_SWRITE(0); __syncthreads();
    for (int cur = 0;; cur ^= 1) {
        const bool more = tmask != 0ull; const int tn = more ? __builtin_ctzll(tmask) : 0; tmask &= tmask - 1;
        LAS unsigned char* bufp = lds + cur * BUF;
        if (more) ATR_SLOAD(tn);
        const LAS unsigned char* vbase = bufp + KBYTES + ((lane >> 4) & 1) * 32 + (lane & 3) * 8 + (4 * hi + ((lane & 15) >> 2)) * 64;
        s16x4 vfa[8], vfb[8];
        if (RB == 1) ATR_VRD(vfa, 0);
        bf16x8 pa[RB][4];
        f32x16 pp[RB][2];
        {
            const f32x16 zero = {0.f, 0.f, 0.f, 0.f, 0.f, 0.f, 0.f, 0.f, 0.f, 0.f, 0.f, 0.f, 0.f, 0.f, 0.f, 0.f};
            const LAS unsigned char* kb = bufp + r32 * KSTR + hi * 16;
#pragma unroll
            for (int d0 = 0; d0 < NKS; ++d0) {
                const bf16x8 b0 = *(const LAS bf16x8*)(kb + d0 * 32);
                const bf16x8 b1 = *(const LAS bf16x8*)(kb + 32 * KSTR + d0 * 32);
#pragma unroll
                for (int rb = 0; rb < RB; ++rb) {
                    const bf16x8 qf = QL ? qlds[(rb * NKS + d0) * 64] : qr[rb][d0];
                    if (d0 == 0) { pp[rb][0] = __builtin_amdgcn_mfma_f32_32x32x16_bf16(b0, qf, zero, 0, 0, 0); pp[rb][1] = __builtin_amdgcn_mfma_f32_32x32x16_bf16(b1, qf, zero, 0, 0, 0); }
                    else { pp[rb][0] = __builtin_amdgcn_mfma_f32_32x32x16_bf16(b0, qf, pp[rb][0], 0, 0, 0); pp[rb][1] = __builtin_amdgcn_mfma_f32_32x32x16_bf16(b1, qf, pp[rb][1], 0, 0, 0); }
                }
            }
        }
#pragma unroll
        for (int rb = 0; rb < RB; ++rb) {
            f32x16 p0 = pp[rb][0], p1 = pp[rb][1];
            if (MODE != 0) {
                const LAS float* pk = (const LAS float*)(bufp + KBYTES + VBYTES);
#pragma unroll
                for (int g = 0; g < 4; ++g) {
                    const f32x4 k0v = *(const LAS f32x4*)(pk + 8 * g + 4 * hi), k1v = *(const LAS f32x4*)(pk + 32 + 8 * g + 4 * hi);
#pragma unroll
                    for (int i = 0; i < 4; ++i) {
                        const float d0f = fabsf(pqf[rb] - k0v[i]), d1f = fabsf(pqf[rb] - k1v[i]);
                        float s0 = fmaf(-A.slope2, d0f, p0[4 * g + i]), s1 = fmaf(-A.slope2, d1f, p1[4 * g + i]);
                        if (MODE == 2) { s0 = d0f <= 128.0f ? s0 : -1e30f; s1 = d1f <= 128.0f ? s1 : -1e30f; }
                        p0[4 * g + i] = s0; p1[4 * g + i] = s1;
                    }
                }
            }
#pragma unroll
            for (int r = 0; r < 16; ++r) { p0[r] = __builtin_amdgcn_exp2f(p0[r]); p1[r] = __builtin_amdgcn_exp2f(p1[r]); }
            {
                float ls = l_reg[rb];
#pragma unroll
                for (int r = 0; r < 16; ++r) { ls += p0[r]; ls += p1[r]; }
                l_reg[rb] = ls;
            }
#pragma unroll
            for (int s = 0; s < 2; ++s) {
                v4u w0 = {cvtpk(p0[8 * s + 0], p0[8 * s + 1]), cvtpk(p0[8 * s + 2], p0[8 * s + 3]), cvtpk(p0[8 * s + 4], p0[8 * s + 5]), cvtpk(p0[8 * s + 6], p0[8 * s + 7])};
                v4u w1 = {cvtpk(p1[8 * s + 0], p1[8 * s + 1]), cvtpk(p1[8 * s + 2], p1[8 * s + 3]), cvtpk(p1[8 * s + 4], p1[8 * s + 5]), cvtpk(p1[8 * s + 6], p1[8 * s + 7])};
                pa[rb][s] = __builtin_bit_cast(bf16x8, w0); pa[rb][2 + s] = __builtin_bit_cast(bf16x8, w1);
            }
        }
        if (RB == 2) { _Pragma("unroll") for (int d = 0; d < ND0; ++d) { ATR_VRD(vfa, d); ATR_MMA(vfa, d); } (void)vfb; }
        else if (ND0 == 2) { ATR_VRD(vfb, 1); ATR_MMA(vfa, 0); ATR_MMA(vfb, 1); }
        else { ATR_VRD(vfb, 1); ATR_MMA(vfa, 0); ATR_VRD(vfa, 2); ATR_MMA(vfb, 1); ATR_VRD(vfb, 3); ATR_MMA(vfa, 2); ATR_MMA(vfb, 3); }
        if (more) ATR_SWRITE(cur ^ 1);
        __syncthreads();
        if (!more) break;
        t = tn;
    }
#undef ATR_SLOAD
#undef ATR_SWRITE
#undef ATR_VRD
#undef ATR_PK
#undef ATR_MMA
#pragma unroll
    for (int rb = 0; rb < RB; ++rb) { const float lt = xor_add<32>(l_reg[rb]); if (hi == 0) wsf[rb * 32 + r32] = 1.0f / lt; }
    LDS_WAIT();
#pragma unroll
    for (int rb = 0; rb < RB; ++rb)
#pragma unroll
        for (int g = 0; g < 4; ++g) {
            const f32x4 l0 = *(const LAS f32x4*)(wsf + rb * 32 + 8 * g + 4 * hi);
#pragma unroll
            for (int d = 0; d < ND0; ++d)
#pragma unroll
                for (int i = 0; i < 4; ++i) res[rb][d][4 * g + i] = o[rb][d][4 * g + i] * l0[i];
        }
    LDS_WAIT();
    __syncthreads();
}
template <int DQK, int DV, int MODE, int RB, bool QL = false>
__device__ __forceinline__ void attn_core_pd2(const Args& A, int q0, unsigned long long tmask, LAS unsigned char* lds, float (&res)[RB][DV / 32][16]) {
    constexpr int KSTR = DQK * 2 + 16, KBYTES = 64 * KSTR, VBYTES = 64 * DV * 2, PBYTES = 256;
    constexpr int BUF = KBYTES + VBYTES + PBYTES;
    constexpr int CPR = DQK / 8, NKP = 64 * CPR, KP = (NKP + 511) / 512, VP = (64 * DV / 8) / 512, ND0 = DV / 32, NKS = DQK / 16;
    static_assert(2 * BUF + 8 * 256 + (QL ? 8 * RB * NKS * 1024 : 0) <= (QL ? ATT_NXT_OFF : ATT_STASH_OFF), "attention LDS");
    int tid_ = threadIdx.x; asm volatile("" : "+v"(tid_));
    const int tid = tid_, lane = tid & 63, wid = __builtin_amdgcn_readfirstlane(tid >> 6), r32 = lane & 31, hi = lane >> 5;
    LAS float* wsf = (LAS float*)(lds + 2 * BUF) + wid * 64;
    LAS bf16x8* qlds = (LAS bf16x8*)(lds + 2 * BUF + 8 * 256) + wid * (RB * NKS * 64) + lane;
    const int wrow = q0 + wid * (32 * RB);

    bf16x8 qr[RB][NKS]; float pqf[RB];
#pragma unroll
    for (int rb = 0; rb < RB; ++rb) {
#pragma unroll
        for (int d0 = 0; d0 < NKS; ++d0) { qr[rb][d0] = *(const bf16x8*)(A.Q + (size_t)(wrow + rb * 32 + r32) * A.pq + d0 * 16 + hi * 8); if (QL) qlds[(rb * NKS + d0) * 64] = qr[rb][d0]; }
        pqf[rb] = 0.f;
        if (MODE == 1) pqf[rb] = (float)A.pos[wrow + rb * 32 + r32];
        if (MODE == 2) pqf[rb] = (float)(wrow + rb * 32 + r32);
    }
    f32x16 o[RB][ND0]; float l_reg[RB];
#pragma unroll
    for (int rb = 0; rb < RB; ++rb) { l_reg[rb] = (MODE == 2 && hi == 0) ? __builtin_amdgcn_exp2f(A.sink2) : 0.f;
#pragma unroll
        for (int d = 0; d < ND0; ++d)
#pragma unroll
            for (int r = 0; r < 16; ++r) o[rb][d][r] = 0.f; }

    bf16x8 skA[KP], svA[VP], skB[KP], svB[VP]; float sposA = 0.f, sposB = 0.f;
    unsigned gk_off[KP], lk_off[KP], gv_off[VP], lv_off[VP];
#pragma unroll
    for (int i = 0; i < KP; ++i) { const int p = tid + 512 * i, row = p / CPR, ch = p % CPR; gk_off[i] = (unsigned)(row * A.pk + ch * 8) * 2u; lk_off[i] = (unsigned)(row * KSTR + ch * 16); }
#pragma unroll
    for (int i = 0; i < VP; ++i) { const int p = tid + 512 * i, db = p >> 8, row = (p & 255) >> 2, c4 = p & 3; gv_off[i] = (unsigned)(row * A.pv + db * 32 + c4 * 8) * 2u;
        lv_off[i] = (unsigned)(KBYTES + db * 4096 + (row >> 4) * 1024 + (row & 15) * 64 + c4 * 16); }
#define ATR_SLOAD(t, sk, sv, spos) do { const int k0_ = (t) * 64; const char* kb_ = (const char*)(A.K + (size_t)k0_ * A.pk); const char* vb_ = (const char*)(A.V + (size_t)k0_ * A.pv); \
    _Pragma("unroll") for (int i = 0; i < KP; ++i) { if (tid + 512 * i < NKP) sk[i] = *(const bf16x8*)(kb_ + gk_off[i]); } \
    _Pragma("unroll") for (int i = 0; i < VP; ++i) sv[i] = *(const bf16x8*)(vb_ + gv_off[i]); \
    if (MODE == 1) { if (tid < 64) spos = (float)A.pos[k0_ + tid]; } if (MODE == 2) { spos = (float)(k0_ + tid); } } while (0)
#define ATR_SWRITE(b, sk, sv, spos) do { LAS unsigned char* base_ = lds + (b) * BUF; \
    _Pragma("unroll") for (int i = 0; i < KP; ++i) { if (tid + 512 * i < NKP) *(LAS bf16x8*)(base_ + lk_off[i]) = sk[i]; } \
    _Pragma("unroll") for (int i = 0; i < VP; ++i) *(LAS bf16x8*)(base_ + lv_off[i]) = sv[i]; \
    if (MODE != 0) { if (tid < 64) *(LAS float*)(base_ + KBYTES + VBYTES + tid * 4) = spos; } } while (0)
#define ATR_VRD(VF, d) do { const LAS unsigned char* vp_ = vbase + (d) * 4096; \
    _Pragma("unroll") for (int ks = 0; ks < 4; ++ks) { VF[2 * ks] = vtr(vp_ + ks * 1024); VF[2 * ks + 1] = vtr(vp_ + ks * 1024 + 512); } } while (0)
#define ATR_PK(L, H) (bf16x8){L[0], L[1], L[2], L[3], H[0], H[1], H[2], H[3]}
#define ATR_MMA(VF, d) do { _Pragma("unroll") for (int rb = 0; rb < RB; ++rb) _Pragma("unroll") for (int ks = 0; ks < 4; ++ks) \
        o[rb][d] = __builtin_amdgcn_mfma_f32_32x32x16_bf16(pa[rb][ks], ATR_PK(VF[2 * ks], VF[2 * ks + 1]), o[rb][d], 0, 0, 0); } while (0)

    int cur = 0;
    const int t0 = __builtin_ctzll(tmask); tmask &= tmask - 1;
    bool more1 = tmask != 0ull; const int t1 = more1 ? __builtin_ctzll(tmask) : 0; tmask &= tmask - 1;
    bool more2 = tmask != 0ull; int t2 = more2 ? __builtin_ctzll(tmask) : 0; tmask &= tmask - 1;
    ATR_SLOAD(t0, skA, svA, sposA); ATR_SWRITE(0, skA, svA, sposA);
    if (more1) ATR_SLOAD(t1, skB, svB, sposB);
    __syncthreads();
    for (;;) {
        {
        LAS unsigned char* bufp = lds + cur * BUF;
        if (more2) ATR_SLOAD(t2, skA, svA, sposA);
        const LAS unsigned char* vbase = bufp + KBYTES + ((lane >> 4) & 1) * 32 + (lane & 3) * 8 + (4 * hi + ((lane & 15) >> 2)) * 64;
        s16x4 vfa[8], vfb[8];
        if (RB == 1) ATR_VRD(vfa, 0);
        bf16x8 pa[RB][4];
        f32x16 pp[RB][2];
        {
            const f32x16 zero = {0.f, 0.f, 0.f, 0.f, 0.f, 0.f, 0.f, 0.f, 0.f, 0.f, 0.f, 0.f, 0.f, 0.f, 0.f, 0.f};
            const LAS unsigned char* kb = bufp + r32 * KSTR + hi * 16;
#pragma unroll
            for (int d0 = 0; d0 < NKS; ++d0) {
                const bf16x8 b0 = *(const LAS bf16x8*)(kb + d0 * 32);
                const bf16x8 b1 = *(const LAS bf16x8*)(kb + 32 * KSTR + d0 * 32);
#pragma unroll
                for (int rb = 0; rb < RB; ++rb) {
                    const bf16x8 qf = QL ? qlds[(rb * NKS + d0) * 64] : qr[rb][d0];
                    if (d0 == 0) { pp[rb][0] = __builtin_amdgcn_mfma_f32_32x32x16_bf16(b0, qf, zero, 0, 0, 0); pp[rb][1] = __builtin_amdgcn_mfma_f32_32x32x16_bf16(b1, qf, zero, 0, 0, 0); }
                    else { pp[rb][0] = __builtin_amdgcn_mfma_f32_32x32x16_bf16(b0, qf, pp[rb][0], 0, 0, 0); pp[rb][1] = __builtin_amdgcn_mfma_f32_32x32x16_bf16(b1, qf, pp[rb][1], 0, 0, 0); }
                }
            }
        }
#pragma unroll
        for (int rb = 0; rb < RB; ++rb) {
            f32x16 p0 = pp[rb][0], p1 = pp[rb][1];
            if (MODE != 0) {
                const LAS float* pk = (const LAS float*)(bufp + KBYTES + VBYTES);
#pragma unroll
                for (int g = 0; g < 4; ++g) {
                    const f32x4 k0v = *(const LAS f32x4*)(pk + 8 * g + 4 * hi), k1v = *(const LAS f32x4*)(pk + 32 + 8 * g + 4 * hi);
#pragma unroll
                    for (int i = 0; i < 4; ++i) {
                        const float d0f = fabsf(pqf[rb] - k0v[i]), d1f = fabsf(pqf[rb] - k1v[i]);
                        float s0 = fmaf(-A.slope2, d0f, p0[4 * g + i]), s1 = fmaf(-A.slope2, d1f, p1[4 * g + i]);
                        if (MODE == 2) { s0 = d0f <= 128.0f ? s0 : -1e30f; s1 = d1f <= 128.0f ? s1 : -1e30f; }
                        p0[4 * g + i] = s0; p1[4 * g + i] = s1;
                    }
                }
            }
#pragma unroll
            for (int r = 0; r < 16; ++r) { p0[r] = __builtin_amdgcn_exp2f(p0[r]); p1[r] = __builtin_amdgcn_exp2f(p1[r]); }
            {
                float ls = l_reg[rb];
#pragma unroll
                for (int r = 0; r < 16; ++r) { ls += p0[r]; ls += p1[r]; }
                l_reg[rb] = ls;
            }
#pragma unroll
            for (int s = 0; s < 2; ++s) {
                v4u w0 = {cvtpk(p0[8 * s + 0], p0[8 * s + 1]), cvtpk(p0[8 * s + 2], p0[8 * s + 3]), cvtpk(p0[8 * s + 4], p0[8 * s + 5]), cvtpk(p0[8 * s + 6], p0[8 * s + 7])};
                v4u w1 = {cvtpk(p1[8 * s + 0], p1[8 * s + 1]), cvtpk(p1[8 * s + 2], p1[8 * s + 3]), cvtpk(p1[8 * s + 4], p1[8 * s + 5]), cvtpk(p1[8 * s + 6], p1[8 * s + 7])};
                pa[rb][s] = __builtin_bit_cast(bf16x8, w0); pa[rb][2 + s] = __builtin_bit_cast(bf16x8, w1);
            }
        }
        if (RB == 2) { _Pragma("unroll") for (int d = 0; d < ND0; ++d) { ATR_VRD(vfa, d); ATR_MMA(vfa, d); } (void)vfb; }
        else if (ND0 == 2) { ATR_VRD(vfb, 1); ATR_MMA(vfa, 0); ATR_MMA(vfb, 1); }
        else { ATR_VRD(vfb, 1); ATR_MMA(vfa, 0); ATR_VRD(vfa, 2); ATR_MMA(vfb, 1); ATR_VRD(vfb, 3); ATR_MMA(vfa, 2); ATR_MMA(vfb, 3); }
        if (more1) ATR_SWRITE(cur ^ 1, skB, svB, sposB);
        __syncthreads();
        if (!more1) break;
        cur ^= 1; more1 = more2; more2 = tmask != 0ull; t2 = more2 ? __builtin_ctzll(tmask) : 0; tmask &= tmask - 1;
        }
        {
        LAS unsigned char* bufp = lds + cur * BUF;
        if (more2) ATR_SLOAD(t2, skB, svB, sposB);
        const LAS unsigned char* vbase = bufp + KBYTES + ((lane >> 4) & 1) * 32 + (lane & 3) * 8 + (4 * hi + ((lane & 15) >> 2)) * 64;
        s16x4 vfa[8], vfb[8];
        if (RB == 1) ATR_VRD(vfa, 0);
        bf16x8 pa[RB][4];
        f32x16 pp[RB][2];
        {
            const f32x16 zero = {0.f, 0.f, 0.f, 0.f, 0.f, 0.f, 0.f, 0.f, 0.f, 0.f, 0.f, 0.f, 0.f, 0.f, 0.f, 0.f};
            const LAS unsigned char* kb = bufp + r32 * KSTR + hi * 16;
#pragma unroll
            for (int d0 = 0; d0 < NKS; ++d0) {
                const bf16x8 b0 = *(const LAS bf16x8*)(kb + d0 * 32);
                const bf16x8 b1 = *(const LAS bf16x8*)(kb + 32 * KSTR + d0 * 32);
#pragma unroll
                for (int rb = 0; rb < RB; ++rb) {
                    const bf16x8 qf = QL ? qlds[(rb * NKS + d0) * 64] : qr[rb][d0];
                    if (d0 == 0) { pp[rb][0] = __builtin_amdgcn_mfma_f32_32x32x16_bf16(b0, qf, zero, 0, 0, 0); pp[rb][1] = __builtin_amdgcn_mfma_f32_32x32x16_bf16(b1, qf, zero, 0, 0, 0); }
                    else { pp[rb][0] = __builtin_amdgcn_mfma_f32_32x32x16_bf16(b0, qf, pp[rb][0], 0, 0, 0); pp[rb][1] = __builtin_amdgcn_mfma_f32_32x32x16_bf16(b1, qf, pp[rb][1], 0, 0, 0); }
                }
            }
        }
#pragma unroll
        for (int rb = 0; rb < RB; ++rb) {
            f32x16 p0 = pp[rb][0], p1 = pp[rb][1];
            if (MODE != 0) {
                const LAS float* pk = (const LAS float*)(bufp + KBYTES + VBYTES);
#pragma unroll
                for (int g = 0; g < 4; ++g) {
                    const f32x4 k0v = *(const LAS f32x4*)(pk + 8 * g + 4 * hi), k1v = *(const LAS f32x4*)(pk + 32 + 8 * g + 4 * hi);
#pragma unroll
                    for (int i = 0; i < 4; ++i) {
                        const float d0f = fabsf(pqf[rb] - k0v[i]), d1f = fabsf(pqf[rb] - k1v[i]);
                        float s0 = fmaf(-A.slope2, d0f, p0[4 * g + i]), s1 = fmaf(-A.slope2, d1f, p1[4 * g + i]);
                        if (MODE == 2) { s0 = d0f <= 128.0f ? s0 : -1e30f; s1 = d1f <= 128.0f ? s1 : -1e30f; }
                        p0[4 * g + i] = s0; p1[4 * g + i] = s1;
                    }
                }
            }
#pragma unroll
            for (int r = 0; r < 16; ++r) { p0[r] = __builtin_amdgcn_exp2f(p0[r]); p1[r] = __builtin_amdgcn_exp2f(p1[r]); }
            {
                float ls = l_reg[rb];
#pragma unroll
                for (int r = 0; r < 16; ++r) { ls += p0[r]; ls += p1[r]; }
                l_reg[rb] = ls;
            }
#pragma unroll
            for (int s = 0; s < 2; ++s) {
                v4u w0 = {cvtpk(p0[8 * s + 0], p0[8 * s + 1]), cvtpk(p0[8 * s + 2], p0[8 * s + 3]), cvtpk(p0[8 * s + 4], p0[8 * s + 5]), cvtpk(p0[8 * s + 6], p0[8 * s + 7])};
                v4u w1 = {cvtpk(p1[8 * s + 0], p1[8 * s + 1]), cvtpk(p1[8 * s + 2], p1[8 * s + 3]), cvtpk(p1[8 * s + 4], p1[8 * s + 5]), cvtpk(p1[8 * s + 6], p1[8 * s + 7])};
                pa[rb][s] = __builtin_bit_cast(bf16x8, w0); pa[rb][2 + s] = __builtin_bit_cast(bf16x8, w1);
            }
        }
        if (RB == 2) { _Pragma("unroll") for (int d = 0; d < ND0; ++d) { ATR_VRD(vfa, d); ATR_MMA(vfa, d); } (void)vfb; }
        else if (ND0 == 2) { ATR_VRD(vfb, 1); ATR_MMA(vfa, 0); ATR_MMA(vfb, 1); }
        else { ATR_VRD(vfb, 1); ATR_MMA(vfa, 0); ATR_VRD(vfa, 2); ATR_MMA(vfb, 1); ATR_VRD(vfb, 3); ATR_MMA(vfa, 2); ATR_MMA(vfb, 3); }
        if (more1) ATR_SWRITE(cur ^ 1, skA, svA, sposA);
        __syncthreads();
        if (!more1) break;
        cur ^= 1; more1 = more2; more2 = tmask != 0ull; t2 = more2 ? __builtin_ctzll(tmask) : 0; tmask &= tmask - 1;
        }
    }
#undef ATR_SLOAD
#undef ATR_SWRITE
#undef ATR_VRD
#undef ATR_PK
#undef ATR_MMA
#pragma unroll
    for (int rb = 0; rb < RB; ++rb) { const float lt = xor_add<32>(l_reg[rb]); if (hi == 0) wsf[rb * 32 + r32] = 1.0f / lt; }
    LDS_WAIT();
#pragma unroll
    for (int rb = 0; rb < RB; ++rb)
#pragma unroll
        for (int g = 0; g < 4; ++g) {
            const f32x4 l0 = *(const LAS f32x4*)(wsf + rb * 32 + 8 * g + 4 * hi);
#pragma unroll
            for (int d = 0; d < ND0; ++d)
#pragma unroll
                for (int i = 0; i < 4; ++i) res[rb][d][4 * g + i] = o[rb][d][4 * g + i] * l0[i];
        }
    LDS_WAIT();
    __syncthreads();
}
template <int DQK, int DV, int MODE, int RB, bool QL = false>
__device__ __forceinline__ void attn_core_pp(const Args& A, int q0, unsigned long long tmask, LAS unsigned char* lds, float (&res)[RB][DV / 32][16]) {
    constexpr int KSTR = DQK * 2 + 16, KBYTES = 64 * KSTR, VBYTES = 64 * DV * 2;
    constexpr int OFF_V = 2 * KBYTES, OFF_PK = OFF_V + 2 * VBYTES, OFF_WS = OFF_PK + 4 * 256, OFF_Q = OFF_WS + 8 * 256;
    constexpr int CPR = DQK / 8, NKP = 64 * CPR, KP = (NKP + 511) / 512, VP = (64 * DV / 8) / 512, ND0 = DV / 32, NKS = DQK / 16;
    static_assert(OFF_Q + (QL ? 8 * RB * NKS * 1024 : 0) <= (QL ? ATT_NXT_OFF : ATT_STASH_OFF), "attention LDS");
    int tid_ = threadIdx.x; asm volatile("" : "+v"(tid_));
    const int tid = tid_, lane = tid & 63, wid = __builtin_amdgcn_readfirstlane(tid >> 6), r32 = lane & 31, hi = lane >> 5;
    LAS float* wsf = (LAS float*)(lds + OFF_WS) + wid * 64;
    LAS bf16x8* qlds = (LAS bf16x8*)(lds + OFF_Q) + wid * (RB * NKS * 64) + lane;
    const int wrow = q0 + wid * (32 * RB);

    bf16x8 qr[RB][NKS]; float pqf[RB];
#pragma unroll
    for (int rb = 0; rb < RB; ++rb) {
#pragma unroll
        for (int d0 = 0; d0 < NKS; ++d0) { qr[rb][d0] = *(const bf16x8*)(A.Q + (size_t)(wrow + rb * 32 + r32) * A.pq + d0 * 16 + hi * 8); if (QL) qlds[(rb * NKS + d0) * 64] = qr[rb][d0]; }
        pqf[rb] = 0.f;
        if (MODE == 1) pqf[rb] = (float)A.pos[wrow + rb * 32 + r32];
        if (MODE == 2) pqf[rb] = (float)(wrow + rb * 32 + r32);
    }
    f32x16 o[RB][ND0]; float l_reg[RB];
#pragma unroll
    for (int rb = 0; rb < RB; ++rb) { l_reg[rb] = (MODE == 2 && hi == 0) ? __builtin_amdgcn_exp2f(A.sink2) : 0.f;
#pragma unroll
        for (int d = 0; d < ND0; ++d)
#pragma unroll
            for (int r = 0; r < 16; ++r) o[rb][d][r] = 0.f; }

    bf16x8 sk[KP], sv[VP]; float spos = 0.f;
    unsigned gk_off[KP], lk_off[KP], gv_off[VP], lv_off[VP];
#pragma unroll
    for (int i = 0; i < KP; ++i) { const int p = tid + 512 * i, row = p / CPR, ch = p % CPR; gk_off[i] = (unsigned)(row * A.pk + ch * 8) * 2u; lk_off[i] = (unsigned)(row * KSTR + ch * 16); }
#pragma unroll
    for (int i = 0; i < VP; ++i) { const int p = tid + 512 * i, db = p >> 8, row = (p & 255) >> 2, c4 = p & 3; gv_off[i] = (unsigned)(row * A.pv + db * 32 + c4 * 8) * 2u;
        lv_off[i] = (unsigned)(OFF_V + db * 4096 + (row >> 4) * 1024 + (row & 15) * 64 + c4 * 16); }
#define APP_LOADK(t) do { const int k0_ = (t) * 64; const char* kb_ = (const char*)(A.K + (size_t)k0_ * A.pk); \
    _Pragma("unroll") for (int i = 0; i < KP; ++i) { if (tid + 512 * i < NKP) sk[i] = *(const bf16x8*)(kb_ + gk_off[i]); } \
    if (MODE == 1) { if (tid < 64) spos = (float)A.pos[k0_ + tid]; } if (MODE == 2) { spos = (float)(k0_ + tid); } } while (0)
#define APP_LOADV(t) do { const char* vb_ = (const char*)(A.V + (size_t)((t) * 64) * A.pv); \
    _Pragma("unroll") for (int i = 0; i < VP; ++i) sv[i] = *(const bf16x8*)(vb_ + gv_off[i]); } while (0)
#define APP_WRITEK(kb, pr) do { LAS unsigned char* base_ = lds + (kb) * KBYTES; \
    _Pragma("unroll") for (int i = 0; i < KP; ++i) { if (tid + 512 * i < NKP) *(LAS bf16x8*)(base_ + lk_off[i]) = sk[i]; } \
    if (MODE != 0) { if (tid < 64) *(LAS float*)(lds + OFF_PK + (pr) * 256 + tid * 4) = spos; } } while (0)
#define APP_WRITEV(vb) do { LAS unsigned char* base_ = lds + (vb) * VBYTES; \
    _Pragma("unroll") for (int i = 0; i < VP; ++i) *(LAS bf16x8*)(base_ + lv_off[i]) = sv[i]; } while (0)
#define APP_BAR() do { ATT_SBAR(); __builtin_amdgcn_s_barrier(); ATT_SBAR(); } while (0)
#define APP_VRD(VF, d) do { const LAS unsigned char* vp_ = vbase + (d) * 4096; \
    _Pragma("unroll") for (int ks = 0; ks < 4; ++ks) { VF[2 * ks] = vtr(vp_ + ks * 1024); VF[2 * ks + 1] = vtr(vp_ + ks * 1024 + 512); } } while (0)
#define APP_PK(L, H) (bf16x8){L[0], L[1], L[2], L[3], H[0], H[1], H[2], H[3]}
#define APP_MMA(VF, d) do { _Pragma("unroll") for (int rb = 0; rb < RB; ++rb) _Pragma("unroll") for (int ks = 0; ks < 4; ++ks) \
        o[rb][d] = __builtin_amdgcn_mfma_f32_32x32x16_bf16(pa[rb][ks], APP_PK(VF[2 * ks], VF[2 * ks + 1]), o[rb][d], 0, 0, 0); } while (0)
#define APP_QKT(kbuf) do { const f32x16 zero = {0.f, 0.f, 0.f, 0.f, 0.f, 0.f, 0.f, 0.f, 0.f, 0.f, 0.f, 0.f, 0.f, 0.f, 0.f, 0.f}; \
    const LAS unsigned char* kb = lds + (kbuf) * KBYTES + r32 * KSTR + hi * 16; \
    _Pragma("unroll") for (int d0 = 0; d0 < NKS; ++d0) { \
        const bf16x8 b0 = *(const LAS bf16x8*)(kb + d0 * 32); const bf16x8 b1 = *(const LAS bf16x8*)(kb + 32 * KSTR + d0 * 32); \
        _Pragma("unroll") for (int rb = 0; rb < RB; ++rb) { const bf16x8 qf = QL ? qlds[(rb * NKS + d0) * 64] : qr[rb][d0]; \
            if (d0 == 0) { pp[rb][0] = __builtin_amdgcn_mfma_f32_32x32x16_bf16(b0, qf, zero, 0, 0, 0); pp[rb][1] = __builtin_amdgcn_mfma_f32_32x32x16_bf16(b1, qf, zero, 0, 0, 0); } \
            else { pp[rb][0] = __builtin_amdgcn_mfma_f32_32x32x16_bf16(b0, qf, pp[rb][0], 0, 0, 0); pp[rb][1] = __builtin_amdgcn_mfma_f32_32x32x16_bf16(b1, qf, pp[rb][1], 0, 0, 0); } } } } while (0)
#define APP_POP(tv, hv) do { hv = tmask != 0ull; tv = hv ? __builtin_ctzll(tmask) : 0; tmask &= tmask - 1ull; } while (0)

    int ta, tb, tc; bool ha, hb, hc;
    APP_POP(ta, ha); APP_POP(tb, hb); APP_POP(tc, hc); (void)ha;
    APP_LOADK(ta); APP_WRITEK(0, 0);
    if (hb) APP_LOADK(tb);
    APP_LOADV(ta);
    LDS_WAIT();
    if (wid >= 4) APP_BAR();
    APP_BAR();
    f32x16 pp[RB][2]; bf16x8 pa[RB][4];
    __builtin_amdgcn_s_setprio(1);
    APP_QKT(0);
    if (hb) APP_WRITEK(1, 1);
    APP_WRITEV(0);
    __builtin_amdgcn_s_setprio(0);
    for (int j = 0;; ++j) {
        LDS_WAIT(); APP_BAR();
        if (hc) APP_LOADK(tc);
        if (hb) APP_LOADV(tb);
#pragma unroll
        for (int rb = 0; rb < RB; ++rb) {
            f32x16 p0 = pp[rb][0], p1 = pp[rb][1];
            if (MODE != 0) {
                const LAS float* pk = (const LAS float*)(lds + OFF_PK + (j & 3) * 256);
#pragma unroll
                for (int g = 0; g < 4; ++g) {
                    const f32x4 k0v = *(const LAS f32x4*)(pk + 8 * g + 4 * hi), k1v = *(const LAS f32x4*)(pk + 32 + 8 * g + 4 * hi);
#pragma unroll
                    for (int i = 0; i < 4; ++i) {
                        const float d0f = fabsf(pqf[rb] - k0v[i]), d1f = fabsf(pqf[rb] - k1v[i]);
                        float s0 = fmaf(-A.slope2, d0f, p0[4 * g + i]), s1 = fmaf(-A.slope2, d1f, p1[4 * g + i]);
                        if (MODE == 2) { s0 = d0f <= 128.0f ? s0 : -1e30f; s1 = d1f <= 128.0f ? s1 : -1e30f; }
                        p0[4 * g + i] = s0; p1[4 * g + i] = s1;
                    }
                }
            }
#pragma unroll
            for (int r = 0; r < 16; ++r) { p0[r] = __builtin_amdgcn_exp2f(p0[r]); p1[r] = __builtin_amdgcn_exp2f(p1[r]); }
            {
                float ls = l_reg[rb];
#pragma unroll
                for (int r = 0; r < 16; ++r) { ls += p0[r]; ls += p1[r]; }
                l_reg[rb] = ls;
            }
#pragma unroll
            for (int s = 0; s < 2; ++s) {
                v4u w0 = {cvtpk(p0[8 * s + 0], p0[8 * s + 1]), cvtpk(p0[8 * s + 2], p0[8 * s + 3]), cvtpk(p0[8 * s + 4], p0[8 * s + 5]), cvtpk(p0[8 * s + 6], p0[8 * s + 7])};
                v4u w1 = {cvtpk(p1[8 * s + 0], p1[8 * s + 1]), cvtpk(p1[8 * s + 2], p1[8 * s + 3]), cvtpk(p1[8 * s + 4], p1[8 * s + 5]), cvtpk(p1[8 * s + 6], p1[8 * s + 7])};
                pa[rb][s] = __builtin_bit_cast(bf16x8, w0); pa[rb][2 + s] = __builtin_bit_cast(bf16x8, w1);
            }
        }
        asm volatile("" ::: "memory"); APP_BAR();
        __builtin_amdgcn_s_setprio(1);
        {
            const LAS unsigned char* vbase = lds + OFF_V + (j & 1) * VBYTES + ((lane >> 4) & 1) * 32 + (lane & 3) * 8 + (4 * hi + ((lane & 15) >> 2)) * 64;
            s16x4 vfa[8], vfb[8];
            if (RB == 2) { _Pragma("unroll") for (int d = 0; d < ND0; ++d) { APP_VRD(vfa, d); APP_MMA(vfa, d); } (void)vfb; }
            else if (ND0 == 2) { APP_VRD(vfa, 0); APP_VRD(vfb, 1); APP_MMA(vfa, 0); APP_MMA(vfb, 1); }
            else { APP_VRD(vfa, 0); APP_VRD(vfb, 1); APP_MMA(vfa, 0); APP_VRD(vfa, 2); APP_MMA(vfb, 1); APP_VRD(vfb, 3); APP_MMA(vfa, 2); APP_MMA(vfb, 3); }
        }
        if (!hb) break;
        APP_QKT((j + 1) & 1);
        if (hc) APP_WRITEK(j & 1, (j + 2) & 3);
        APP_WRITEV((j + 1) & 1);
        __builtin_amdgcn_s_setprio(0);
        hb = hc; tb = tc; APP_POP(tc, hc);
    }
    __builtin_amdgcn_s_setprio(0);
    if (wid < 4) APP_BAR();
#undef APP_LOADK
#undef APP_LOADV
#undef APP_WRITEK
#undef APP_WRITEV
#undef APP_BAR
#undef APP_VRD
#undef APP_PK
#undef APP_MMA
#undef APP_QKT
#undef APP_POP
#pragma unroll
    for (int rb = 0; rb < RB; ++rb) { const float lt = xor_add<32>(l_reg[rb]); if (hi == 0) wsf[rb * 32 + r32] = 1.0f / lt; }
    LDS_WAIT();
#pragma unroll
    for (int rb = 0; rb < RB; ++rb)
#pragma unroll
        for (int g = 0; g < 4; ++g) {
            const f32x4 l0 = *(const LAS f32x4*)(wsf + rb * 32 + 8 * g + 4 * hi);
#pragma unroll
            for (int d = 0; d < ND0; ++d)
#pragma unroll
                for (int i = 0; i < 4; ++i) res[rb][d][4 * g + i] = o[rb][d][4 * g + i] * l0[i];
        }
    LDS_WAIT();
    __syncthreads();
}
template <int ND0> __device__ __forceinline__ void store_rows(const float (&res)[ND0][16], bf16* O, int po, int row0, int lane) {
    asm volatile("" : "+v"(lane));
    const int r32 = lane & 31, hi = lane >> 5;
    bf16* Ow = O + (size_t)row0 * po + r32;
#pragma unroll
    for (int r = 0; r < 16; ++r) { const int orow = crow(r, hi);
#pragma unroll
        for (int d = 0; d < ND0; ++d) Ow[(size_t)orow * po + d * 32] = (bf16)(cvtpk(res[d][r], 0.f) & 0xffffu); }
}
template <int ND0> __device__ __forceinline__ void store_res(const float (&res)[ND0][16], bf16* O, int po, int q0) {
    const int tid = threadIdx.x, lane = tid & 63, wid = __builtin_amdgcn_readfirstlane(tid >> 6), r32 = lane & 31, hi = lane >> 5;
    bf16* Ow = O + (size_t)(q0 + wid * 32) * po + r32;
#pragma unroll
    for (int r = 0; r < 16; ++r) { const int orow = crow(r, hi);
#pragma unroll
        for (int d = 0; d < ND0; ++d) Ow[(size_t)orow * po + d * 32] = (bf16)(cvtpk(res[d][r], 0.f) & 0xffffu); }
}
}

#ifndef ATT_CORE
#define ATT_CORE attn_core_rb
#endif
#ifndef ATT_CORE_A
#define ATT_CORE_A attn_core_rb
#endif

__device__ __forceinline__ float lam_init_of(int layer) { return layer == 0 ? 0.2f : 0.35550906759096184f; }
template <bool DRY> __device__ __forceinline__ void att_sec_A(const Frame& F, const float* diff_qk_g, const float* diff_lambda, const float* diff_out_g, unsigned char* ws, const int* positions, int layer) {
    int tid_ = threadIdx.x; asm volatile("" : "+v"(tid_)); const int lane = tid_ & 63, r32 = lane & 31;
    LAS unsigned char* lds = F.lds + RING_OFF;
    const float* lp = diff_lambda;
    const float s1 = wave_sum(lp[lane] * lp[64 + lane]), s2 = wave_sum(lp[128 + lane] * lp[192 + lane]);
    const float li = lam_init_of(layer);
    const float lam = __expf(s1) - __expf(s2) + li;
    const float osc = 1.0f - li;
    float gq = fabsf(diff_qk_g[lane]), gk = fabsf(diff_qk_g[64 + lane]);
    gq = xor_max<1>(gq); gq = xor_max<2>(gq); gq = xor_max<4>(gq); gq = xor_max<8>(gq); gq = xor_max<16>(gq); gq = xor_max<32>(gq);
    gk = xor_max<1>(gk); gk = xor_max<2>(gk); gk = xor_max<4>(gk); gk = xor_max<8>(gk); gk = xor_max<16>(gk); gk = xor_max<32>(gk);
    const float reach = 2.0f * (8.0f * gq * gk * 1.01f) + 30.0f;
    const float* tmm = (const float*)(ws + WS_TMM);
    constexpr int NU = NB * 16 * 4; const int per = (NU + F.G - 1) / F.G;
    for (int u = F.vcu * per; u < (F.vcu + 1) * per && u < NU; ++u) {
        const int h = u & 3, bq = u >> 2, b = bq >> 4, qb = bq & 15;
        const size_t rb = (size_t)b * SEQ;
        const float slope = exp2f(-2.0f * (float)(h + 1));
        unsigned long long tmask;
        { const float* tq = tmm + (size_t)(b * 64 + qb * 4) * 2;
          const float qlo = fminf(fminf(tq[0], tq[2]), fminf(tq[4], tq[6])), qhi = fmaxf(fmaxf(tq[1], tq[3]), fmaxf(tq[5], tq[7]));
          const float klo = tmm[(size_t)(b * 64 + lane) * 2], khi = tmm[(size_t)(b * 64 + lane) * 2 + 1];
          const float gap = fmaxf(fmaxf(klo - qhi, qlo - khi), 0.f);
          tmask = __ballot(gap * slope <= reach); }
        att::Args A;
        A.pq = 512; A.pk = 512; A.pv = 512; A.pos = positions + rb; A.slope2 = slope * LOG2E; A.sink2 = 0.f;
        A.V = (const bf16*)(ws + WS_VA) + rb * 512 + h * 128;
        LAS unsigned* stash = (LAS unsigned*)(lds + ATT_STASH_OFF) + F.wave * 2048 + lane;
        {
            A.Q = (const bf16*)(ws + WS_QA) + rb * 512 + h * 128; A.K = (const bf16*)(ws + WS_KA) + rb * 512 + h * 64;
            float r0[1][4][16];
            att::ATT_CORE_A<64, 128, 1, 1>(A, qb * 256, tmask, lds, r0);
#pragma unroll
            for (int d = 0; d < 4; ++d)
#pragma unroll
                for (int r = 0; r < 8; ++r) stash[(d * 8 + r) * 64] = att::cvtpk(r0[0][d][2 * r], r0[0][d][2 * r + 1]);
        }
        float res[1][4][16];
        A.Q = (const bf16*)(ws + WS_QA) + rb * 512 + h * 128 + 64; A.K = (const bf16*)(ws + WS_KA) + rb * 512 + (4 + h) * 64;
        att::ATT_CORE_A<64, 128, 1, 1>(A, qb * 256, tmask, lds, res);
        float gcol[4];
#pragma unroll
        for (int d = 0; d < 4; ++d) gcol[d] = diff_out_g[d * 32 + r32] * osc;
#pragma unroll
        for (int r = 0; r < 16; ++r) {
            float s = 0.f;
#pragma unroll
            for (int d = 0; d < 4; ++d) { const unsigned w = stash[(d * 8 + (r >> 1)) * 64]; const float a0 = (r & 1) ? bfhi(w) : bflo(w); const float v = a0 - lam * res[0][d][r]; res[0][d][r] = v; s += v * v; }
            s = xor_add<1>(s); s = xor_add<2>(s); s = xor_add<4>(s); s = xor_add<8>(s); s = xor_add<16>(s);
            const float rs = 1.0f / sqrtf(s * (1.0f / 128) + EPS);
#pragma unroll
            for (int d = 0; d < 4; ++d) res[0][d][r] *= rs * gcol[d];
        }
        att::store_rows<4>(res[0], (bf16*)(ws + (DRY ? WS_OB : WS_QA)) + rb * 512 + h * 128, 512, qb * 256 + F.wave * 32, lane);
    }
}
template <bool DRY> __device__ __forceinline__ void att_sec_C(const Frame& F, const float* swa_sink, unsigned char* ws) {
    int tid_ = threadIdx.x; asm volatile("" : "+v"(tid_)); const int lane = tid_ & 63;
    LAS unsigned char* lds = F.lds + RING_OFF;
    constexpr int NU = NB * 8 * 8; const int per = (NU + F.G - 1) / F.G;
    for (int u = F.vcu * per; u < (F.vcu + 1) * per && u < NU; ++u) {
        const int b = u >> 6, hh = (u >> 3) & 7, qb = u & 7, g = hh >> 2;
        const size_t rb = (size_t)b * SEQ;
        att::Args A;
        A.Q = (const bf16*)(ws + WS_QC) + rb * 512 + hh * 64; A.pq = 512;
        A.K = (const bf16*)(ws + WS_CQKC) + rb * 512 + 384 + g * 64; A.pk = 512;
        A.V = (const bf16*)(ws + WS_VCKR) + rb * 256 + g * 64; A.pv = 256;
        A.pos = nullptr; A.slope2 = exp2f(-(float)(hh + 1)) * LOG2E; A.sink2 = swa_sink[hh] * LOG2E;
        const int q0 = qb * 512; const int k_lo = q0 - 128 < 0 ? 0 : q0 - 128, k_hi = q0 + 512 + 128 > SEQ ? SEQ : q0 + 512 + 128;
        const int tl = k_lo / 64, th = k_hi / 64;
        const unsigned long long tmask = (th >= 64 ? ~0ull : ((1ull << th) - 1ull)) & ~((1ull << tl) - 1ull);
        float res[2][2][16];
        att::ATT_CORE<64, 64, 2, 2, true>(A, q0, tmask, lds, res);
        bf16* O = (bf16*)(ws + (DRY ? WS_OB : WS_QC)) + rb * 512 + hh * 64;
        att::store_rows<2>(res[0], O, 512, q0 + F.wave * 64, lane); att::store_rows<2>(res[1], O, 512, q0 + F.wave * 64 + 32, lane);
    }
}
template <bool DRY> __device__ __forceinline__ void att_sec_B(const Frame& F, unsigned char* ws, int layer) {
    int tid_ = threadIdx.x; asm volatile("" : "+v"(tid_)); const int tid = tid_, lane = tid & 63;
    LAS unsigned char* lds = F.lds + RING_OFF;
    constexpr int NU = NB * 8 * 8;
    unsigned* qbase = (unsigned*)(ws + WS_CTL) + 65536 + (layer * 2 + (DRY ? 1 : 0)) * 8 * 64;
    LAS int* nxt = (LAS int*)(F.lds + ATT_NXT_OFF);
    const int ngrp = 8, per_grp = NU / 8, myq = (F.vcu * 8) / F.G;
    int qi = 0;
    for (;;) {
        if (tid == 0) { int u_ = -1;
            while (qi < ngrp) { const int q = (myq + qi) % ngrp; const unsigned v = __hip_atomic_fetch_add(qbase + q * 64, 1u, __ATOMIC_RELAXED, __HIP_MEMORY_SCOPE_AGENT);
                if (v < (unsigned)per_grp) { u_ = q * per_grp + (int)v; break; } ++qi; }
            nxt[0] = u_; nxt[1] = qi; }
        __syncthreads();
        const int u = __builtin_amdgcn_readfirstlane(nxt[0]); qi = __builtin_amdgcn_readfirstlane(nxt[1]);
        __syncthreads();
        if (u < 0) break;
        const int b = u >> 6, h = (u >> 3) & 7, qb = u & 7;
        const size_t rb = (size_t)b * SEQ;
        att::Args A;
        A.Q = (const bf16*)(ws + WS_QB) + rb * 768 + h * 96; A.pq = 768;
        A.K = (const bf16*)(ws + WS_KB) + rb * 768 + h * 96; A.pk = 768;
        A.V = (const bf16*)(ws + WS_KVR) + rb * 1024 + 512 + h * 64; A.pv = 1024;
        A.pos = nullptr; A.slope2 = 0.f; A.sink2 = 0.f;
        float res[2][2][16];
        att::ATT_CORE<96, 64, 0, 2, true>(A, qb * 512, ~0ull, lds, res);
        bf16* O = (bf16*)(ws + WS_OB) + rb * 512 + h * 64;
        att::store_rows<2>(res[0], O, 512, qb * 512 + F.wave * 64, lane); att::store_rows<2>(res[1], O, 512, qb * 512 + F.wave * 64 + 32, lane);
    }
}
__device__ __forceinline__ void p_attention(const Frame& F, const float* diff_qk_g, const float* diff_lambda, const float* diff_out_g, const float* swa_sink, unsigned char* ws, const int* positions, int layer) {
#if defined(PROBE_SEC_A)
    att_sec_A<true>(F, diff_qk_g, diff_lambda, diff_out_g, ws, positions, layer);
#elif defined(PROBE_SEC_B)
    att_sec_B<true>(F, ws, layer);
#elif defined(PROBE_SEC_C)
    att_sec_C<true>(F, swa_sink, ws);
#endif
#ifndef SKIP_A
    att_sec_A<false>(F, diff_qk_g, diff_lambda, diff_out_g, ws, positions, layer);
#endif
#ifndef SKIP_C
    att_sec_C<false>(F, swa_sink, ws);
#endif
#ifndef SKIP_B
    att_sec_B<false>(F, ws, layer);
#endif
}

#ifdef NAIVE_ATTN
template <int DQK, int DV, int MODE>
__device__ __forceinline__ void naive_row(const bf16* Q, const bf16* K, int pk, const bf16* V, int pv, const int* pos, int t, float slope2, float sink2, int lane, float (&out)[DV / 64]) {
    float m = -1e30f, l = 0.f, acc[DV];
#pragma unroll
    for (int d = 0; d < DV; ++d) acc[d] = 0.f;
    if (MODE == 2 && lane == 0) { m = sink2; l = 1.f; }
    const float pqf = MODE == 1 ? (float)pos[t] : (float)t;
    int k_lo = 0, k_hi = SEQ;
    if (MODE == 2) { k_lo = t - 128 < 0 ? 0 : t - 128; k_hi = t + 129 > SEQ ? SEQ : t + 129; }
    for (int k = k_lo + lane; k < k_hi; k += 64) {
        const bf16* kr = K + (size_t)k * pk; float s = 0.f;
#pragma unroll
        for (int d = 0; d < DQK; d += 2) { const unsigned w = *(const unsigned*)(kr + d); const unsigned qw = *(const volatile unsigned*)(Q + d); s = fmaf(bflo(qw), bflo(w), s); s = fmaf(bfhi(qw), bfhi(w), s); }
        if (MODE == 1) s -= slope2 * fabsf(pqf - (float)pos[k]);
        if (MODE == 2) s -= slope2 * fabsf(pqf - (float)k);
        const float mn = fmaxf(m, s), a = exp2f(m - mn), p = exp2f(s - mn);
        l = l * a + p; m = mn;
        const bf16* vr = V + (size_t)k * pv;
#pragma unroll
        for (int d = 0; d < DV; d += 2) { const unsigned w = *(const unsigned*)(vr + d); acc[d] = fmaf(p, bflo(w), acc[d] * a); acc[d + 1] = fmaf(p, bfhi(w), acc[d + 1] * a); }
    }
    float M = m;
#pragma unroll
    for (int o = 1; o < 64; o <<= 1) M = fmaxf(M, __shfl_xor(M, o));
    const float sc = exp2f(m - M);
    const float L = wave_sum(l * sc);
#pragma unroll
    for (int d = 0; d < DV; ++d) { const float v = wave_sum(acc[d] * sc) / L; if ((d & 63) == lane) out[d >> 6] = v; }
}
__device__ __forceinline__ void p_attention_naive(int vcu, int wave, int G, const float* diff_lambda, const float* diff_out_g, const float* swa_sink, unsigned char* ws, const int* positions, int layer) {
    int tid_ = threadIdx.x; asm volatile("" : "+v"(tid_)); const int lane = tid_ & 63;
    const int gw = vcu * NWAVES + wave, NGW = G * NWAVES;
    const float* lp = diff_lambda;
    const float s1 = wave_sum(lp[lane] * lp[64 + lane]), s2 = wave_sum(lp[128 + lane] * lp[192 + lane]);
    const float li = layer == 0 ? 0.2f : 0.35550906759096184f;
    const float lam = __expf(s1) - __expf(s2) + li, osc = 1.0f - li;
    for (int it = gw; it < T * 4; it += NGW) {
        const int row = it >> 2, h = it & 3, b = row >> 12, t = row & 4095; const size_t rb = (size_t)b * SEQ;
        bf16* Qr = (bf16*)(ws + WS_QA) + (size_t)row * 512 + h * 128;
        float o0[2], o1[2];
        naive_row<64, 128, 1>(Qr, (const bf16*)(ws + WS_KA) + rb * 512 + h * 64, 512, (const bf16*)(ws + WS_VA) + rb * 512 + h * 128, 512, positions + rb, t, exp2f(-2.0f * (float)(h + 1)) * LOG2E, 0.f, lane, o0);
        naive_row<64, 128, 1>(Qr + 64, (const bf16*)(ws + WS_KA) + rb * 512 + (4 + h) * 64, 512, (const bf16*)(ws + WS_VA) + rb * 512 + h * 128, 512, positions + rb, t, exp2f(-2.0f * (float)(h + 1)) * LOG2E, 0.f, lane, o1);
        const float v0 = o0[0] - lam * o1[0], v1 = o0[1] - lam * o1[1];
        const float rs = 1.0f / sqrtf(wave_sum(v0 * v0 + v1 * v1) * (1.0f / 128) + EPS);
        Qr[lane] = (bf16)(pk2(v0 * rs * diff_out_g[lane] * osc, 0.f) & 0xffffu); Qr[64 + lane] = (bf16)(pk2(v1 * rs * diff_out_g[64 + lane] * osc, 0.f) & 0xffffu);
    }
    for (int it = gw; it < T * 8; it += NGW) {
        const int row = it >> 3, h = it & 7, b = row >> 12, t = row & 4095; const size_t rb = (size_t)b * SEQ;
        float o[1];
        naive_row<96, 64, 0>((const bf16*)(ws + WS_QB) + (size_t)row * 768 + h * 96, (const bf16*)(ws + WS_KB) + rb * 768 + h * 96, 768, (const bf16*)(ws + WS_KVR) + rb * 1024 + 512 + h * 64, 1024, nullptr, t, 0.f, 0.f, lane, o);
        ((bf16*)(ws + WS_OB))[(size_t)row * 512 + h * 64 + lane] = (bf16)(pk2(o[0], 0.f) & 0xffffu);
    }
    for (int it = gw; it < T * 8; it += NGW) {
        const int row = it >> 3, hh = it & 7, g = hh >> 2, b = row >> 12, t = row & 4095; const size_t rb = (size_t)b * SEQ;
        bf16* Qr = (bf16*)(ws + WS_QC) + (size_t)row * 512 + hh * 64;
        float o[1];
        naive_row<64, 64, 2>(Qr, (const bf16*)(ws + WS_CQKC) + rb * 512 + 384 + g * 64, 512, (const bf16*)(ws + WS_VCKR) + rb * 256 + g * 64, 256, nullptr, t, exp2f(-(float)(hh + 1)) * LOG2E, swa_sink[hh] * LOG2E, lane, o);
        Qr[lane] = (bf16)(pk2(o[0], 0.f) & 0xffffu);
    }
}
#endif

__device__ __forceinline__ void p_norm2_router(const Frame& F, const bf16* x, const float* g, const float* w_router, bf16* h2, float* affT) {
    int tid_ = threadIdx.x; asm volatile("" : "+v"(tid_)); const int tid = tid_, lane = tid & 63; (void)tid; (void)lane;
    LAS float* wl = (LAS float*)(F.lds + RING_OFF);
    for (int i = tid; i < 1024 * 16; i += NWAVES * 64) { const int d = i >> 4, e = i & 15; const int j = d >> 8, l = (d & 255) >> 2, c = d & 3, k = e >> 2, ee = e & 3;
        wl[((((j * 4 + c) * 4 + k) * 64 + l) << 2) + ee] = w_router[i]; }
    __syncthreads();
    const int gw = F.vcu * NWAVES + F.wave, NGW = F.G * NWAVES;
    f32x4 gv[4];
#pragma unroll
    for (int j = 0; j < 4; ++j) gv[j] = *((const f32x4*)g + lane + 64 * j);
    for (int row0 = gw * 2; row0 < T; row0 += NGW * 2) {
        v2u vv[2][4];
#pragma unroll
        for (int rr = 0; rr < 2; ++rr) { const v2u* xr = (const v2u*)(x + (size_t)(row0 + rr) * DM) + lane;
#pragma unroll
            for (int j = 0; j < 4; ++j) vv[rr][j] = xr[64 * j]; }
#pragma unroll
        for (int rr = 0; rr < 2; ++rr) { const int row = row0 + rr;
        f32x4 v[4]; float s = 0.f;
#pragma unroll
        for (int j = 0; j < 4; ++j) { v[j] = (f32x4){bflo(vv[rr][j].x), bfhi(vv[rr][j].x), bflo(vv[rr][j].y), bfhi(vv[rr][j].y)}; s += (v[j].x * v[j].x + v[j].y * v[j].y) + (v[j].z * v[j].z + v[j].w * v[j].w); }
        const float rs = 1.0f / sqrtf(wave_sum(s) * (1.0f / DM) + EPS);
        v2u* o8 = (v2u*)(h2 + (size_t)row * DM) + lane;
        float lg[16];
#pragma unroll
        for (int e = 0; e < 16; ++e) lg[e] = 0.f;
#pragma unroll
        for (int j = 0; j < 4; ++j) {
            v[j] = v[j] * rs * gv[j];
            v2u o; o.x = pk2(v[j].x, v[j].y); o.y = pk2(v[j].z, v[j].w); o8[64 * j] = o;
#pragma unroll
            for (int c = 0; c < 4; ++c) {
#pragma unroll
                for (int k = 0; k < 4; ++k) { const f32x4 w = *(const LAS f32x4*)(wl + ((((j * 4 + c) * 4 + k) * 64 + lane) << 2));
                    lg[4 * k + 0] = fmaf(v[j][c], w.x, lg[4 * k + 0]); lg[4 * k + 1] = fmaf(v[j][c], w.y, lg[4 * k + 1]); lg[4 * k + 2] = fmaf(v[j][c], w.z, lg[4 * k + 2]); lg[4 * k + 3] = fmaf(v[j][c], w.w, lg[4 * k + 3]); }
                __builtin_amdgcn_sched_barrier(0);
            }
        }
        float s8[8], s4[4];
#pragma unroll
        for (int e = 0; e < 8; ++e) { auto r_ = __builtin_amdgcn_permlane32_swap(__float_as_uint(lg[e]), __float_as_uint(lg[e + 8]), false, false); s8[e] = __uint_as_float(r_[0]) + __uint_as_float(r_[1]); }
#pragma unroll
        for (int e = 0; e < 4; ++e) { auto r_ = __builtin_amdgcn_permlane16_swap(__float_as_uint(s8[e]), __float_as_uint(s8[e + 4]), false, false); s4[e] = __uint_as_float(r_[0]) + __uint_as_float(r_[1]); }
#pragma unroll
        for (int e = 0; e < 4; ++e) {
            s4[e] += __int_as_float(__builtin_amdgcn_update_dpp(0, __float_as_int(s4[e]), 0x128, 0xf, 0xf, false));
            s4[e] += __int_as_float(__builtin_amdgcn_update_dpp(0, __float_as_int(s4[e]), 0x124, 0xf, 0xf, false));
            s4[e] += __int_as_float(__builtin_amdgcn_update_dpp(0, __float_as_int(s4[e]), 0x122, 0xf, 0xf, false));
            s4[e] += __int_as_float(__builtin_amdgcn_update_dpp(0, __float_as_int(s4[e]), 0x121, 0xf, 0xf, false));
        }
        float mx = fmaxf(fmaxf(s4[0], s4[1]), fmaxf(s4[2], s4[3]));
        { auto r_ = __builtin_amdgcn_permlane16_swap(__float_as_uint(mx), __float_as_uint(mx), false, false); mx = fmaxf(__uint_as_float(r_[0]), __uint_as_float(r_[1])); }
        mx = xor_max<32>(mx);
        float den = 0.f;
#pragma unroll
        for (int e = 0; e < 4; ++e) { s4[e] = __expf(s4[e] - mx); den += s4[e]; }
        { auto r_ = __builtin_amdgcn_permlane16_swap(__float_as_uint(den), __float_as_uint(den), false, false); den = __uint_as_float(r_[0]) + __uint_as_float(r_[1]); }
        den = xor_add<32>(den);
        const float inv = 1.0f / den;
        const int b = row >> 12, t = row & 4095;
        if ((lane & 15) == 0) { const int e0 = 8 * (lane >> 5) + 4 * ((lane >> 4) & 1);
#pragma unroll
            for (int e = 0; e < 4; ++e) affT[((size_t)(b * NEXP + e0 + e) << 12) + t] = s4[e] * inv; }
        }
    }
    __syncthreads();
}

__device__ __forceinline__ void p_topk_gather(const Frame& F, unsigned char* ws) {
    int tid_ = threadIdx.x; asm volatile("" : "+v"(tid_)); const int tid = tid_, lane = tid & 63; (void)tid; (void)lane;
    LAS unsigned* red = (LAS unsigned*)(F.lds + RING_OFF);
    LAS unsigned* wtot = red + 16;
    LAS int* lidx = (LAS int*)(F.lds + RING_OFF + 256);
    const float* affT = (const float*)(ws + WS_AFFT); int* inv = (int*)(ws + WS_INV); int* idx = (int*)(ws + WS_IDX); float* affsel = (float*)(ws + WS_AFFSEL);
    const bf16* h2 = (const bf16*)(ws + WS_H); unsigned char* xg = ws + WS_XG;
    const int wid = F.wave;
    for (int u = F.vcu; u < NB * NEXP; u += F.G) {
        const int e = u >> 4, b = u & 15;
        const float* src = affT + ((size_t)(b * NEXP + e) << 12) + tid * 8;
        const f32x4 a0 = *(const f32x4*)src, a1 = *(const f32x4*)(src + 4);
        float v[8] = {a0.x, a0.y, a0.z, a0.w, a1.x, a1.y, a1.z, a1.w};
        unsigned long long key[8];
#pragma unroll
        for (int i = 0; i < 8; ++i) key[i] = ((unsigned long long)__float_as_uint(v[i]) << 12) | (unsigned long long)(4095 - (tid * 8 + i));
        unsigned long long Kth = 0ull;
        for (int bit = 43; bit >= 0; --bit) {
            const unsigned long long cand = Kth | (1ull << bit);
            unsigned c = 0;
#pragma unroll
            for (int i = 0; i < 8; ++i) c += (key[i] >= cand) ? 1u : 0u;
            c = wave_sum_u(c);
            LAS unsigned* rb = red + (bit & 1) * 8;
            if (lane == 0) rb[wid] = c;
            __syncthreads();
            unsigned tot = 0;
#pragma unroll
            for (int w = 0; w < 8; ++w) tot += rb[w];
            if (tot >= (unsigned)CAP) Kth = cand;
        }
        unsigned cnt = 0;
#pragma unroll
        for (int i = 0; i < 8; ++i) cnt += (key[i] >= Kth) ? 1u : 0u;
        unsigned incl = cnt;
#pragma unroll
        for (int o = 1; o < 64; o <<= 1) { const unsigned y = (unsigned)__builtin_amdgcn_ds_bpermute(((lane - o) & 63) << 2, (int)incl); if (lane >= o) incl += y; }
        __syncthreads();
        if (lane == 63) wtot[wid] = incl;
        __syncthreads();
        unsigned base = 0;
#pragma unroll
        for (int w = 0; w < 8; ++w) base += (w < wid) ? wtot[w] : 0u;
        unsigned slot = base + incl - cnt;
#pragma unroll
        for (int i = 0; i < 8; ++i) {
            const int t = tid * 8 + i; const bool sel = key[i] >= Kth;
            inv[((size_t)(b * SEQ + t) << 4) + e] = sel ? (int)slot : -1;
            if (sel) { if (slot < (unsigned)CAP) { lidx[slot] = t; idx[u * CAP + slot] = t; affsel[u * CAP + slot] = v[i]; } ++slot; }
        }
        __syncthreads();
        for (int s0 = wid * 4; s0 < CAP; s0 += NWAVES * 4) {
            v4u x0[4], x1[4];
#pragma unroll
            for (int rr = 0; rr < 4; ++rr) { const int t = lidx[s0 + rr]; const v4u* srow = (const v4u*)(h2 + ((size_t)(b * SEQ + t) << 10)) + lane; x0[rr] = srow[0]; x1[rr] = srow[64]; }
#pragma unroll
            for (int rr = 0; rr < 4; ++rr) { v2u* drow = (v2u*)(xg + ((size_t)(u * CAP + s0 + rr) << 10)) + lane;
                const f32x4 a0 = {bflo(x0[rr].x), bfhi(x0[rr].x), bflo(x0[rr].y), bfhi(x0[rr].y)}, a1 = {bflo(x0[rr].z), bfhi(x0[rr].z), bflo(x0[rr].w), bfhi(x0[rr].w)};
                const f32x4 b0 = {bflo(x1[rr].x), bfhi(x1[rr].x), bflo(x1[rr].y), bfhi(x1[rr].y)}, b1 = {bflo(x1[rr].z), bfhi(x1[rr].z), bflo(x1[rr].w), bfhi(x1[rr].w)};
                const pg8::u32x2 wa = pg8::pack8_fp8(a0, a1), wb = pg8::pack8_fp8(b0, b1); v2u oa; oa.x = wa.x; oa.y = wa.y; v2u ob; ob.x = wb.x; ob.y = wb.y;
                drow[0] = oa; drow[64] = ob; }
        }
        __syncthreads();
    }
}

template <bool NORM> __device__ __forceinline__ void p_combine(const Frame& F, unsigned char* ws, const bf16* xin, void* xout, const float* g, bf16* hout) {
    int tid_ = threadIdx.x; asm volatile("" : "+v"(tid_)); const int tid = tid_, lane = tid & 63; (void)tid; (void)lane;
    const int gw = F.vcu * NWAVES + F.wave, NGW = F.G * NWAVES;
    const int* inv = (const int*)(ws + WS_INV); const bf16* Y = (const bf16*)(ws + WS_XG);
    f32x4 gv[4];
#pragma unroll
    for (int j = 0; j < 4; ++j) { if (NORM) gv[j] = *((const f32x4*)g + lane + 64 * j); else gv[j] = (f32x4){0.f, 0.f, 0.f, 0.f}; }
    for (int row0 = gw * 2; row0 < T; row0 += NGW * 2) {
        int sl[2]; f32x4 v[2][4];
#pragma unroll
        for (int rr = 0; rr < 2; ++rr) { sl[rr] = (lane < 16) ? inv[((size_t)(row0 + rr) << 4) + lane] : -1;
            const v2u* xr = (const v2u*)(xin + (size_t)(row0 + rr) * DM) + lane;
#pragma unroll
            for (int j = 0; j < 4; ++j) { const v2u w = xr[64 * j]; v[rr][j] = (f32x4){bflo(w.x), bfhi(w.x), bflo(w.y), bfhi(w.y)}; } }
#pragma unroll
        for (int rr = 0; rr < 2; ++rr) { const int b = (row0 + rr) >> 12;
            unsigned long long mask = __ballot(sl[rr] >= 0);
            while (mask) {
                const int e = __builtin_ctzll(mask); mask &= mask - 1;
                const int s = __builtin_amdgcn_readlane(sl[rr], e);
                const v2u* yr = (const v2u*)(Y + ((size_t)(((e << 4) + b) * CAP + s) << 10)) + lane;
#pragma unroll
                for (int j = 0; j < 4; ++j) { const v2u w = yr[64 * j]; v[rr][j].x += bflo(w.x); v[rr][j].y += bfhi(w.x); v[rr][j].z += bflo(w.y); v[rr][j].w += bfhi(w.y); }
            }
            if (NORM) { v2u* xw = (v2u*)((bf16*)xout + (size_t)(row0 + rr) * DM) + lane;
#pragma unroll
                for (int j = 0; j < 4; ++j) { v2u o; o.x = pk2(v[rr][j].x, v[rr][j].y); o.y = pk2(v[rr][j].z, v[rr][j].w); xw[64 * j] = o; } }
            else { f32x4* xw = (f32x4*)((float*)xout + (size_t)(row0 + rr) * DM) + lane;
#pragma unroll
                for (int j = 0; j < 4; ++j) xw[64 * j] = v[rr][j]; }
            if (NORM) { float s = 0.f;
#pragma unroll
                for (int j = 0; j < 4; ++j) s += (v[rr][j].x * v[rr][j].x + v[rr][j].y * v[rr][j].y) + (v[rr][j].z * v[rr][j].z + v[rr][j].w * v[rr][j].w);
                const float rs = 1.0f / sqrtf(wave_sum(s) * (1.0f / DM) + EPS);
                v2u* o8 = (v2u*)(hout + (size_t)(row0 + rr) * DM) + lane;
#pragma unroll
                for (int j = 0; j < 4; ++j) { v2u o; o.x = pk2(v[rr][j].x * rs * gv[j].x, v[rr][j].y * rs * gv[j].y); o.y = pk2(v[rr][j].z * rs * gv[j].z, v[rr][j].w * rs * gv[j].w); o8[64 * j] = o; } } }
    }
}

struct KArgs { const float* in[23]; const int* positions; float* out; unsigned char* ws; int ph_lo, ph_hi; };
static_assert(sizeof(KArgs) == 23 * 8 + 8 + 8 + 8 + 8, "KArgs has no padding");
__device__ __forceinline__ unsigned long long karg_u64(int off) {
    unsigned long long v; auto kp = __builtin_amdgcn_kernarg_segment_ptr();
    asm volatile("s_load_dwordx2 %0, %1, %2\n\ts_waitcnt lgkmcnt(0)" : "=&s"(v) : "s"(kp), "i"(off) : "memory"); return v; }
#define GASP __attribute__((address_space(1)))
#define KIN(k) ((const float*)(const GASP float*)karg_u64(8 * (k)))
#define KPOS() ((const int*)(const GASP int*)karg_u64(184))
#define KOUT() ((float*)(GASP float*)karg_u64(192))
#define KWS() ((unsigned char*)(GASP unsigned char*)karg_u64(200))
__device__ __forceinline__ LayerW layer_w(int layer) {
    LayerW L;
    L.norm_mix_g = KIN(2) + (size_t)layer * 1024; L.w_in = KIN(3) + (size_t)layer * 1024 * IN_COLS; L.diff_qk_g = KIN(4) + layer * 128; L.diff_lambda = KIN(5) + layer * 256;
    L.diff_out_g = KIN(6) + layer * 128; L.mla_cq_g = KIN(7) + layer * 384; L.w_uq = KIN(8) + (size_t)layer * 384 * 768; L.mla_ckv_g = KIN(9) + layer * 256;
    L.w_ukv = KIN(10) + (size_t)layer * 256 * 1024; L.mla_qk_g = KIN(11) + layer * 192; L.swa_qk_g = KIN(12) + layer * 128; L.swa_sink = KIN(13) + layer * 8;
    L.w_ba = KIN(14) + (size_t)layer * 512 * 1024; L.w_bb = KIN(15) + (size_t)layer * 512 * 1024; L.w_bc = KIN(16) + (size_t)layer * 512 * 1024; L.w_o = KIN(17) + (size_t)layer * 1024 * 1024;
    L.norm_ffn_g = KIN(18) + (size_t)layer * 1024; L.w_router = KIN(19) + (size_t)layer * 1024 * 16;
    L.w_eg = KIN(20) + (size_t)layer * 16 * 1024 * 1024; L.w_eu = KIN(21) + (size_t)layer * 16 * 1024 * 1024; L.w_ed = KIN(22) + (size_t)layer * 16 * 1024 * 1024;
    return L;
}


#ifdef DBG_CHECK
__device__ __forceinline__ unsigned hash_u(unsigned x) { x ^= x >> 16; x *= 0x7feb352du; x ^= x >> 15; x *= 0x846ca68bu; x ^= x >> 16; return x; }
__device__ __forceinline__ float bf2f(bf16 v) { return __uint_as_float((unsigned)v << 16); }
__device__ __forceinline__ void chk_report(unsigned* word, float a, float b, int lane) {
    const float err = fabsf(a - b) / (fabsf(b) + 0.1f);
    if (lane == 0) atomicMax(word, __float_as_uint(err));
}
__device__ __forceinline__ const bf16* proj_loc(unsigned char* ws, int row, int col) {
    const int r = win_row(col), pn = r >> 8, c = r & 255;
    if (pn < 10) return (const bf16*)(ws + WS_QA + (size_t)(pn >> 1) * 64 * MiB) + (size_t)row * 512 + (pn & 1) * 256 + c;
    return (const bf16*)(ws + WS_CKV + (size_t)(pn - 10) * 32 * MiB) + (size_t)row * 256 + c;
}
__device__ __forceinline__ float naive_proj(const bf16* h, const float* w_in, int row, int col, int lane) {
    float s = 0.f;
    for (int k = lane; k < 1024; k += 64) s = fmaf(bf2f(h[(size_t)row * 1024 + k]), w_in[(size_t)k * IN_COLS + col], s);
    return wave_sum(s);
}
__device__ __forceinline__ void p_check(int which, int gw, int NGW, int lane, unsigned char* ws, const float* const* dummy, const float* x_in, const float* xout, const LayerW& L, const int* positions) {
    unsigned* word = (unsigned*)(ws + WS_CTL) + 32768 + which * 64;
    const bf16* h = (const bf16*)(ws + WS_H);
    if (which == 0) {
        for (int s = gw; s < 2048; s += NGW) { const int row = hash_u(s * 2 + 1) % T, col = hash_u(s * 2 + 2) % 2976;
            chk_report(word, bf2f(*proj_loc(ws, row, col)), naive_proj(h, L.w_in, row, col, lane), lane); }
    } else if (which == 1) {
        for (int s = gw; s < 1536; s += NGW) { const int row = hash_u(s * 3 + 5) % T, type = s % 6; const unsigned hg = hash_u(s * 3 + 7);
            if (type < 4) { int c0; const float* g; float qs = 1.f;
                if (type == 0) { c0 = (hg % 8) * 64; g = L.diff_qk_g; qs = 0.125f * LOG2E; } else if (type == 1) { c0 = 512 + (hg % 8) * 64; g = L.diff_qk_g + 64; }
                else if (type == 2) { c0 = 2208 + (hg % 8) * 64; g = L.swa_qk_g; qs = 0.125f * LOG2E; } else { c0 = 2720 + (hg % 2) * 64; g = L.swa_qk_g + 64; }
                float v = 0.f; for (int k = 0; k < 1024; ++k) v = fmaf(bf2f(h[(size_t)row * 1024 + k]), L.w_in[(size_t)k * IN_COLS + c0 + lane], v);
                v = bf2f((bf16)(pk2(v, 0.f) & 0xffffu));
                const float rs = 1.0f / sqrtf(wave_sum(v * v) * (1.0f / 64) + EPS);
                chk_report(word, bf2f(*proj_loc(ws, row, c0 + lane)), v * rs * g[lane] * qs, lane);
                const float e2 = fabsf(bf2f(*proj_loc(ws, row, c0 + lane)) - v * rs * g[lane] * qs) / (fabsf(v * rs * g[lane] * qs) + 0.1f); float m = e2;
                for (int o = 1; o < 64; o <<= 1) m = fmaxf(m, __shfl_xor(m, o)); if (lane == 0) atomicMax(word, __float_as_uint(m));
            } else { const int ng = type == 4 ? 6 : 4, cb = type == 4 ? 1536 : 1920; const float* g = type == 4 ? L.mla_cq_g : L.mla_ckv_g;
                float v[6]; float ss = 0.f;
                _Pragma("unroll") for (int q = 0; q < 6; ++q) { float a = 0.f; if (q < ng) { for (int k = 0; k < 1024; ++k) a = fmaf(bf2f(h[(size_t)row * 1024 + k]), L.w_in[(size_t)k * IN_COLS + cb + q * 64 + lane], a); }
                    a = bf2f((bf16)(pk2(a, 0.f) & 0xffffu)); v[q] = a; ss += a * a; }
                const float rs = 1.0f / sqrtf(wave_sum(ss) / (float)(ng * 64) + EPS); float m = 0.f;
                _Pragma("unroll") for (int q = 0; q < 6; ++q) { if (q < ng) { const float want = v[q] * rs * g[q * 64 + lane]; m = fmaxf(m, fabsf(bf2f(*proj_loc(ws, row, cb + q * 64 + lane)) - want) / (fabsf(want) + 0.1f)); } }
                for (int o = 1; o < 64; o <<= 1) m = fmaxf(m, __shfl_xor(m, o)); if (lane == 0) atomicMax(word, __float_as_uint(m));
            } }
    } else if (which == 2) {
        const bf16* CQ = (const bf16*)(ws + WS_CQKC); const bf16* CKVn = (const bf16*)(ws + WS_CKV); const bf16* VCKR = (const bf16*)(ws + WS_VCKR);
        const bf16* QB = (const bf16*)(ws + WS_QB); const bf16* KB = (const bf16*)(ws + WS_KB);
        for (int s = gw; s < 1024; s += NGW) { const int row = hash_u(s * 5 + 11) % T, hd = hash_u(s * 5 + 13) % 8; const bool isq = s & 1;
            float nope = 0.f, rp = 0.f;
            if (isq) { for (int k = 0; k < 384; ++k) { const float a = bf2f(CQ[(size_t)row * 512 + k]); nope = fmaf(a, L.w_uq[(size_t)k * 768 + hd * 96 + lane], nope); rp = fmaf(a, L.w_uq[(size_t)k * 768 + hd * 96 + 64 + (lane & 31)], rp); } }
            else { for (int k = 0; k < 256; ++k) nope = fmaf(bf2f(CKVn[(size_t)row * 256 + k]), L.w_ukv[(size_t)k * 1024 + hd * 128 + lane], nope); rp = bf2f(VCKR[(size_t)row * 256 + 128 + (lane & 31)]); }
            nope = bf2f((bf16)(pk2(nope, 0.f) & 0xffffu)); if (isq) rp = bf2f((bf16)(pk2(rp, 0.f) & 0xffffu));
            const int i = lane & 15; const float ang = (float)positions[row] * (1.0f / powf(10000.0f, (float)i / 16.0f));
            const float cs = cosf(ang), sn = sinf(ang), other = __shfl_xor(rp, 16);
            float ro = (lane & 16) ? (other * sn + rp * cs) : (rp * cs - other * sn); if (lane >= 32) ro = 0.f;
            const float rs = 1.0f / sqrtf(wave_sum(nope * nope + ro * ro) * (1.0f / 96) + EPS);
            const float* g = L.mla_qk_g + (isq ? 0 : 96); const float qs = isq ? 0.10206207261596575f * LOG2E : 1.f;
            const bf16* dst = (isq ? QB : KB) + (size_t)row * 768 + hd * 96;
            const float w1 = nope * rs * g[lane] * qs; float m = fabsf(bf2f(dst[lane]) - w1) / (fabsf(w1) + 0.1f);
            if (lane < 32) { const float w2 = ro * rs * g[64 + lane] * qs; m = fmaxf(m, fabsf(bf2f(dst[64 + lane]) - w2) / (fabsf(w2) + 0.1f)); }
            for (int o = 1; o < 64; o <<= 1) m = fmaxf(m, __shfl_xor(m, o)); if (lane == 0) atomicMax(word, __float_as_uint(m)); }
    } else if (which == 3) {
        for (int s = gw; s < 2048; s += NGW) { const int row = hash_u(s * 2 + 21) % T, col = hash_u(s * 2 + 22) % 3072;
            const float z = naive_proj(h, L.w_in, row, 2976 + col, lane); const float want = 1.0f / (1.0f + __expf(-z));
            const int gi = col >> 10; const bf16* G = (const bf16*)(ws + (gi == 0 ? WS_G0 : (gi == 1 ? WS_G1 : WS_G2)));
            const float got = bf2f(G[(size_t)row * 1024 + (col & 1023)]);
            chk_report(word, got, want, lane);
            if (lane == 0) { atomicAdd(word + 1024 + gi * 64, 1u); if (fabsf(got - want) / (fabsf(want) + 0.1f) > 0.06f) atomicAdd(word + 2048 + gi * 64, 1u); } }
    } else if (which == 4) {
        for (int s = gw; s < 2048; s += NGW) { const int row = hash_u(s * 2 + 31) % T, c = hash_u(s * 2 + 32) % 1024; float want = 0.f;
            for (int i = 0; i < 3; ++i) { const bf16* O = (const bf16*)(ws + (i == 0 ? WS_QA : (i == 1 ? WS_OB : WS_QC))); const float* Wb = i == 0 ? L.w_ba : (i == 1 ? L.w_bb : L.w_bc);
                const bf16* G = (const bf16*)(ws + (i == 0 ? WS_G0 : (i == 1 ? WS_G1 : WS_G2)));
                float a = 0.f; for (int k = lane; k < 512; k += 64) a = fmaf(bf2f(O[(size_t)row * 512 + k]), Wb[(size_t)k * 1024 + c], a);
                want += bf2f(G[(size_t)row * 1024 + c]) * wave_sum(a); }
            chk_report(word, bf2f(h[(size_t)row * 1024 + c]), want, lane); }
    } else if (which == 6) {
        for (int s = gw; s < 2048; s += NGW) { const int row = hash_u(s * 2 + 51) % T; float ss = 0.f;
            for (int k = lane; k < 1024; k += 64) { const float v = x_in[(size_t)row * 1024 + k]; ss += v * v; }
            const float rs = 1.0f / sqrtf(wave_sum(ss) * (1.0f / 1024) + EPS); float m = 0.f;
            for (int k = lane; k < 1024; k += 64) { const float want = x_in[(size_t)row * 1024 + k] * rs * L.norm_mix_g[k]; m = fmaxf(m, fabsf(bf2f(h[(size_t)row * 1024 + k]) - want) / (fabsf(want) + 0.1f)); }
            for (int o = 1; o < 64; o <<= 1) m = fmaxf(m, __shfl_xor(m, o)); if (lane == 0) atomicMax(word, __float_as_uint(m)); }
    } else if (which == 7 || which == 8) {
        const bf16* wt = (const bf16*)(ws + WS_WIN);
        for (int s = gw; s < 4096; s += NGW) { const int col = which == 7 ? 2976 + (int)(hash_u(s * 2 + 61) % 3072) : (int)(hash_u(s * 2 + 61) % 2976); const int r = win_row(col); float m = 0.f;
            for (int k = lane; k < 1024; k += 64) { const float want = L.w_in[(size_t)k * IN_COLS + col]; m = fmaxf(m, fabsf(bf2f(wt[(size_t)r * 1024 + k]) - want) / (fabsf(want) + 0.01f)); }
            for (int o = 1; o < 64; o <<= 1) m = fmaxf(m, __shfl_xor(m, o)); if (lane == 0) atomicMax(word, __float_as_uint(m)); }
    } else if (which == 9) {
        const bf16* wt = (const bf16*)(ws + WS_WIN);
        for (int s = gw; s < 2048; s += NGW) { const int row = hash_u(s * 2 + 21) % T, col = hash_u(s * 2 + 22) % 3072; float a = 0.f;
            for (int k = lane; k < 1024; k += 64) a = fmaf(bf2f(h[(size_t)row * 1024 + k]), bf2f(wt[(size_t)(3072 + col) * 1024 + k]), a);
            const float z = wave_sum(a), want = 1.0f / (1.0f + __expf(-z));
            const int gi = col >> 10; const bf16* G = (const bf16*)(ws + (gi == 0 ? WS_G0 : (gi == 1 ? WS_G1 : WS_G2)));
            chk_report(word, bf2f(G[(size_t)row * 1024 + (col & 1023)]), want, lane); }
    } else {
        for (int s = gw; s < 2048; s += NGW) { const int row = hash_u(s * 2 + 41) % T, c = hash_u(s * 2 + 42) % 1024;
            float a = 0.f; for (int k = lane; k < 1024; k += 64) a = fmaf(bf2f(h[(size_t)row * 1024 + k]), L.w_o[(size_t)k * 1024 + c], a);
            const float d = wave_sum(a), got = xout[(size_t)row * 1024 + c] - x_in[(size_t)row * 1024 + c];
            chk_report(word, got, d, lane); }
    }
}
__device__ __forceinline__ void p_check_emit(int vcu, int G, unsigned char* ws, float* out) {
    int t_ = threadIdx.x; asm volatile("" : "+v"(t_));
    const unsigned* words = (const unsigned*)(ws + WS_CTL) + 32768;
    int code = 0;
#ifdef DBG_CHECK2
    { const int map_[5] = {6, 7, 8, 9, 3};
      if (__uint_as_float(words[6 * 64]) > 0.06f) code |= 1; if (__uint_as_float(words[7 * 64]) > 0.06f) code |= 2; if (__uint_as_float(words[8 * 64]) > 0.06f) code |= 4;
      if (__uint_as_float(words[9 * 64]) > 0.06f) code |= 8; if (__uint_as_float(words[3 * 64]) > 0.06f) code |= 16; (void)map_; }
#elif defined(DBG_GATEFRAC)
    { const unsigned* w3 = words + 3 * 64;
      for (int gi = 0; gi < 3; ++gi) { const unsigned n = w3[1024 + gi * 64], bad = w3[2048 + gi * 64]; const int f = bad == 0 ? 0 : (bad * 10 < n ? 1 : (bad * 2 < n ? 2 : 3)); code |= f << (2 * gi); } }
#else
    for (int i = 0; i < 6; ++i) if (__uint_as_float(words[i * 64]) > 0.06f) code |= 1 << i;
#endif
    for (size_t i = (size_t)vcu * 512 + t_; i < (size_t)T * DM; i += (size_t)G * 512) out[i] = 0.f;
    __syncthreads();
    if (vcu == 0 && t_ == 0) out[0] = exp2f((float)(code + 20));
}
#endif

__global__ void __launch_bounds__(NWAVES * 64, 2) fwd_kernel(KArgs args) {
    extern __shared__ __attribute__((aligned(16))) unsigned char lds_raw[];
    Frame F;
    F.lds = (LAS unsigned char*)lds_raw;
    F.wave = __builtin_amdgcn_readfirstlane((int)threadIdx.x >> 6);
    F.G = gridDim.x; { const int bx = blockIdx.x; F.vcu = (F.G % 8 == 0) ? (bx % 8) * (F.G / 8) + bx / 8 : bx; }
    volatile LAS unsigned* MISC = (volatile LAS unsigned*)(F.lds + MISC_OFF);
    for (int u = threadIdx.x; u < (LDS_BYTES - LDSCTL_OFF) / 4; u += NWAVES * 64) ((LAS unsigned*)(F.lds + LDSCTL_OFF))[u] = 0u;
    __syncthreads();
#define GRID_BARRIER() do { XcdBarrier b_; b_.bar = (unsigned*)(KWS() + WS_CTL) + 4096; b_.x = xb_xcc_id(); b_.st = (volatile LAS unsigned*)(F.lds + MISC_OFF) + 8; xcd_barrier(b_); } while (0)
#if !MK_MULTI
    (void)xcd_barrier_post((unsigned*)(KWS() + WS_CTL) + 4096, MISC + 8);
#endif
    const int lo = args.ph_lo, hi = args.ph_hi;
#ifdef DBG_CHECK
    if (lo >= 2000) { p_check_emit(F.vcu, F.G, KWS(), KOUT()); return; }
#ifdef DBG_CHECK2
    if (lo >= 1000 && lo < 2000) { const int ph = lo - 1000;
        for (int which = 6; which <= 9; ++which) { const bool run = (ph == 5 && which <= 8) || (ph == 6 && which == 9);
            if (run) { int t_ = threadIdx.x; asm volatile("" : "+v"(t_)); unsigned char* ws = KWS(); const LayerW L = layer_w(0);
                p_check(which, F.vcu * NWAVES + F.wave, F.G * NWAVES, t_ & 63, ws, nullptr, KIN(0), KOUT(), L, KPOS()); } }
    }
#endif
    if (lo >= 1000) { const int ph = lo - 1000; const int which = ph == 1 ? 0 : ph == 2 ? 1 : ph == 4 ? 2 : ph == 6 ? 3 : ph == 9 ? 4 : ph == 10 ? 5 : -1;
        if (which >= 0) { int t_ = threadIdx.x; asm volatile("" : "+v"(t_)); unsigned char* ws = KWS(); const LayerW L = layer_w(0);
            p_check(which, F.vcu * NWAVES + F.wave, F.G * NWAVES, t_ & 63, ws, nullptr, KIN(0), KOUT(), L, KPOS()); }
        return; }
#endif
#ifdef ONLY_PHASE
#define IN(k) ((((k) % PH_PER_LAYER) == ONLY_PHASE) && lo <= (k) && (k) < hi)
#else
#ifdef SKIP_FFN
#define IN(k) ((((k) % PH_PER_LAYER) < 11) && lo <= (k) && (k) < hi)
#else
#define IN(k) (lo <= (k) && (k) < hi)
#endif
#endif
#if MK_MULTI
#define SEAM(k) do { } while (0)
#else
#define SEAM(k) do { if (IN((k) + 1)) { GRID_BARRIER(); } } while (0)
#endif
#define CHK(ph, which) do { } while (0)
#define GEMM_RUN(EPI, g, E) do { pg8::StaticOrder S_; S_.init((g).M, (g).N, F.G, (int)blockIdx.x); pg8::gemm_phase<EPI, pg8::StaticOrder, true, true>(F.lds + RING_OFF, g, S_, E); } while (0)
#define GEMM_RUN_F8(EPI, g, E) do { pg8::StaticOrder S_; S_.init((g).M, (g).N, F.G, (int)blockIdx.x); pg8::gemm_phase<EPI, pg8::StaticOrder, true, true, true>(F.lds + RING_OFF, g, S_, E); } while (0)
#ifdef DUP_SMALL
#define GEMM_RUN3(EPI, g, E) do { GEMM_RUN(EPI, g, E); GRID_BARRIER(); GEMM_RUN(EPI, g, E); } while (0)
#else
#define GEMM_RUN3(EPI, g, E) GEMM_RUN(EPI, g, E)
#endif
#ifdef DUP_GEMM
#define GEMM_RUN2(EPI, g, E) do { GEMM_RUN(EPI, g, E); GRID_BARRIER(); GEMM_RUN(EPI, g, E); } while (0)
#else
#define GEMM_RUN2(EPI, g, E) GEMM_RUN(EPI, g, E)
#endif
    for (int layer = 0; layer < DEPTH; ++layer) {
        const int P = layer * PH_PER_LAYER;
#ifdef DUP_P0
        if (IN(P + 0)) { unsigned char* ws = KWS(); const LayerW L = layer_w(layer); p_convert(F, L, ws); if (layer == 0) p_norm1(F, KIN(0), L.norm_mix_g, (bf16*)(ws + WS_H));     GRID_BARRIER(); }
#endif
        if (IN(P + 0)) { unsigned char* ws = KWS(); const LayerW L = layer_w(layer); p_convert(F, L, ws); if (layer == 0) p_norm1(F, KIN(0), L.norm_mix_g, (bf16*)(ws + WS_H));     SEAM(P + 0); }
        if (IN(P + 1)) {
            unsigned char* ws = KWS();
            pg8::Gemm g{(const bf16*)(ws + WS_H), (const bf16*)(ws + WS_WIN), T, 3072, 1024, 1024, 1, 1, 0};
            pg8::EpiRouteNorm E{(bf16*)(ws + WS_QA), (size_t)(64 * MiB / 2), (bf16*)(ws + WS_CKV), (size_t)(32 * MiB / 2), (const float*)(ws + WS_GT), (float*)(ws + WS_SSP), EPS};
            GEMM_RUN2(pg8::EpiRouteNorm, g, E); SEAM(P + 1); }
        CHK(1, 0);
#ifdef DUP_BAR
        if (IN(P + 2)) { for (int i_ = 0; i_ < 10; ++i_) GRID_BARRIER(); }
#endif
        CHK(2, 1);
        if (IN(P + 3)) {
            unsigned char* ws = KWS();
            pg8::Gemm g{(const bf16*)(ws + WS_CQKC), (const bf16*)(ws + WS_WUQ), T, 768, 384, 512, 1, 1, 0};
            pg8::EpiPlainRS E{(bf16*)(ws + WS_QB), 768, (const float*)(ws + WS_SSP), 0, 6, 1.0f / 384, EPS}; GEMM_RUN3(pg8::EpiPlainRS, g, E); }
        if (IN(P + 3)) {
            unsigned char* ws = KWS();
            pg8::Gemm g{(const bf16*)(ws + WS_CKV), (const bf16*)(ws + WS_WUKV), T, 1024, 256, 256, 1, 1, 0};
            pg8::EpiPlainRS E{(bf16*)(ws + WS_KVR), 1024, (const float*)(ws + WS_SSP), 8, 4, 1.0f / 256, EPS}; GEMM_RUN3(pg8::EpiPlainRS, g, E); SEAM(P + 3); }
        if (IN(P + 4)) { unsigned char* ws = KWS(); const LayerW L = layer_w(layer); p_prep2(F, L, ws, KPOS()); p_tile_minmax(F, ws, KPOS()); SEAM(P + 4); }
        CHK(4, 2);
#ifdef NAIVE_ATTN
        if (IN(P + 5)) { unsigned char* ws = KWS(); p_attention_naive(F.vcu, F.wave, F.G, KIN(5) + layer * 256, KIN(6) + layer * 128, KIN(13) + layer * 8, ws, KPOS(), layer); SEAM(P + 5); }
#else
        if (IN(P + 5)) { unsigned char* ws = KWS(); p_attention(F, KIN(4) + layer * 128, KIN(5) + layer * 256, KIN(6) + layer * 128, KIN(13) + layer * 8, ws, KPOS(), layer); SEAM(P + 5); }
#endif
        if (IN(P + 6)) {
            { unsigned char* ws = KWS(); p_h_to_fp8(F, ws); }
#ifdef DUP_H8
            { unsigned char* ws = KWS(); for (int i_ = 0; i_ < 4; ++i_) p_h_to_fp8(F, ws); }
#endif
#if !MK_MULTI
            GRID_BARRIER();
#endif
            unsigned char* ws = KWS();
            pg8::Gemm g{(const bf16*)(ws + WS_H8), (const bf16*)(ws + WS_WG8), T, 3072, 512, 512, 1, 1, 0, 0, 0};
            pg8::EpiGate E{(bf16*)(ws + WS_G0), (size_t)(128 * MiB / 2), (size_t)(96 * MiB / 2), -LOG2E / W8_SCALE};
            GEMM_RUN_F8(pg8::EpiGate, g, E); SEAM(P + 6); }
        if (IN(P + 7)) {
            unsigned char* ws = KWS();
            pg8::Gemm g{(const bf16*)(ws + WS_QA), (const bf16*)(ws + WS_WBA), T, 1024, 512, 512, 1, 1, 0};
            pg8::EpiMerge E{(const bf16*)(ws + WS_G0), (bf16*)(ws + WS_H), 1}; GEMM_RUN3(pg8::EpiMerge, g, E); SEAM(P + 7); }
        if (IN(P + 8)) {
            unsigned char* ws = KWS();
            pg8::Gemm g{(const bf16*)(ws + WS_OB), (const bf16*)(ws + WS_WBB), T, 1024, 512, 512, 1, 1, 0};
            pg8::EpiMerge E{(const bf16*)(ws + WS_G1), (bf16*)(ws + WS_H), 0}; GEMM_RUN(pg8::EpiMerge, g, E); SEAM(P + 8); }
        if (IN(P + 9)) {
            unsigned char* ws = KWS();
            pg8::Gemm g{(const bf16*)(ws + WS_QC), (const bf16*)(ws + WS_WBC), T, 1024, 512, 512, 1, 1, 0};
            pg8::EpiMerge E{(const bf16*)(ws + WS_G2), (bf16*)(ws + WS_H), 0}; GEMM_RUN(pg8::EpiMerge, g, E); SEAM(P + 9); }
        CHK(9, 4);
        if (IN(P + 10)) {
            unsigned char* ws = KWS(); float* xo = KOUT();
            pg8::Gemm g{(const bf16*)(ws + WS_H), (const bf16*)(ws + WS_WO), T, 1024, 1024, 1024, 1, 1, 0};
            pg8::EpiResid E{layer == 0 ? (const void*)KIN(0) : (const void*)xo, layer != 0, (bf16*)(ws + WS_XB)}; GEMM_RUN(pg8::EpiResid, g, E); SEAM(P + 10); }
        CHK(10, 5);
#ifdef DUP_P11
        if (IN(P + 11)) { unsigned char* ws = KWS(); p_norm2_router(F, (const bf16*)(ws + WS_XB), KIN(18) + (size_t)layer * 1024, KIN(19) + (size_t)layer * 1024 * 16, (bf16*)(ws + WS_H), (float*)(ws + WS_AFFT)); GRID_BARRIER(); }
#endif
        if (IN(P + 11)) { unsigned char* ws = KWS(); p_norm2_router(F, (const bf16*)(ws + WS_XB), KIN(18) + (size_t)layer * 1024, KIN(19) + (size_t)layer * 1024 * 16, (bf16*)(ws + WS_H), (float*)(ws + WS_AFFT)); SEAM(P + 11); }
#ifdef DUP_P12
        if (IN(P + 12)) { unsigned char* ws = KWS(); p_topk_gather(F, ws); GRID_BARRIER(); }
#endif
        if (IN(P + 12)) { unsigned char* ws = KWS(); p_topk_gather(F, ws); SEAM(P + 12); }
        if (IN(P + 13)) {
            unsigned char* ws = KWS();
            pg8::Gemm g{(const bf16*)(ws + WS_XG), (const bf16*)(ws + WS_WGU), TE, 2048, 512, 512, 32, 16, (size_t)2048 * 1024, W8_E8M0, ONE_E8M0};
            pg8::EpiSwiglu E{ws + WS_HID, 1.0f / W8_SCALE, HID_SCALE}; GEMM_RUN_F8(pg8::EpiSwiglu, g, E); SEAM(P + 13); }
        if (IN(P + 14)) {
            unsigned char* ws = KWS();
            pg8::Gemm g{(const bf16*)(ws + WS_HID), (const bf16*)(ws + WS_WD), TE, 1024, 512, 512, 32, 16, (size_t)1024 * 1024, W8_E8M0, HID_E8M0};
            pg8::EpiDown E{(bf16*)(ws + WS_XG), (const float*)(ws + WS_AFFSEL), 1.0f / (W8_SCALE * HID_SCALE)}; GEMM_RUN_F8(pg8::EpiDown, g, E); SEAM(P + 14); }
        if (IN(P + 15)) { unsigned char* ws = KWS(); if (layer + 1 < DEPTH) p_combine<true>(F, ws, (const bf16*)(ws + WS_XB), KOUT(), KIN(2) + (size_t)(layer + 1) * 1024, (bf16*)(ws + WS_H)); else p_combine<false>(F, ws, (const bf16*)(ws + WS_XB), KOUT(), nullptr, nullptr); SEAM(P + 15); }
    }
#undef IN
#undef SEAM
}

extern "C" void kernel_launch(void* const* d_in, const int* in_sizes, int n_in, void* d_out, int out_size, void* d_ws, size_t ws_size, hipStream_t stream) {
    static int grid = 0;
    if (grid == 0) {
        if (n_in != 23 || in_sizes[0] != T * DM || out_size != T * DM || ws_size < WS_END) { fprintf(stderr, "kernel_launch: shape/workspace mismatch (n_in %d, ws %zu < %zu)\n", n_in, ws_size, (size_t)WS_END); grid = -1; return; }
        int dev = 0, cus = 0, per_cu = 0;
        if (hipGetDevice(&dev) != hipSuccess || hipDeviceGetAttribute(&cus, hipDeviceAttributeMultiprocessorCount, dev) != hipSuccess) { grid = -1; return; }
        if (hipFuncSetAttribute((const void*)fwd_kernel, hipFuncAttributeMaxDynamicSharedMemorySize, LDS_BYTES) != hipSuccess) { fprintf(stderr, "kernel_launch: hipFuncSetAttribute failed\n"); grid = -1; return; }
        if (hipOccupancyMaxActiveBlocksPerMultiprocessor(&per_cu, (const void*)fwd_kernel, NWAVES * 64, LDS_BYTES) != hipSuccess || per_cu < 1) { fprintf(stderr, "kernel_launch: occupancy query reports %d\n", per_cu); }
        (void)hipGetLastError();
        grid = cus;
    }
    if (grid < 0) return;
    if (hipMemsetAsync((char*)d_ws + WS_CTL, 0, CTL_ZERO_BYTES, stream) != hipSuccess) return;
    KArgs a{};
    for (int i = 0; i < 23; ++i) a.in[i] = (const float*)d_in[i];
    a.positions = (const int*)d_in[1]; a.out = (float*)d_out; a.ws = (unsigned char*)d_ws;
#if MK_MULTI
#ifdef DBG_CHECK
    for (int p = 0; p <= 10; ++p) { a.ph_lo = p; a.ph_hi = p + 1; hipLaunchKernelGGL(fwd_kernel, dim3(grid), dim3(NWAVES * 64), LDS_BYTES, stream, a);
        a.ph_lo = 1000 + p; a.ph_hi = 1001 + p; hipLaunchKernelGGL(fwd_kernel, dim3(grid), dim3(NWAVES * 64), LDS_BYTES, stream, a); }
    a.ph_lo = 2000; a.ph_hi = 2001; hipLaunchKernelGGL(fwd_kernel, dim3(grid), dim3(NWAVES * 64), LDS_BYTES, stream, a);
#else
    for (int p = 0; p < NPHASE; ++p) { a.ph_lo = p; a.ph_hi = p + 1; hipLaunchKernelGGL(fwd_kernel, dim3(grid), dim3(NWAVES * 64), LDS_BYTES, stream, a); }
#endif
#else
    a.ph_lo = 0; a.ph_hi = NPHASE;
    hipLaunchKernelGGL(fwd_kernel, dim3(grid), dim3(NWAVES * 64), LDS_BYTES, stream, a);
#endif
    const hipError_t le = hipPeekAtLastError();
    if (le != hipSuccess) fprintf(stderr, "kernel_launch: launch failed: %s\n", hipGetErrorName(le));
}
```

```cpp
#include <hip/hip_runtime.h>
#include <cstdio>
#include <cstdint>

#ifndef MK_MULTI
#define MK_MULTI 0
#endif

namespace pg8 {
#define PG8_LAS __attribute__((address_space(3)))
typedef unsigned short bf16_t;
typedef short bf16x8 __attribute__((ext_vector_type(8)));
typedef float f32x4 __attribute__((ext_vector_type(4)));
typedef unsigned u32x4 __attribute__((ext_vector_type(4)));
typedef unsigned u32x2 __attribute__((ext_vector_type(2)));
typedef float f32x2 __attribute__((ext_vector_type(2)));
constexpr int BM = 256, BK = 64, HALF = 128, HTB = HALF * BK * 2  , STAGE_BYTES = 8 * HTB, NXCD = 8, WGM = 8;

__host__ __device__ __forceinline__ int lds_byte(int r, int c) { const int st = (r >> 4) * 2 + (c >> 5), rr = r & 15, cc = c & 31, ob = rr * 64 + cc * 2; return st * 1024 + (ob ^ (((ob >> 9) & 1) << 5)); }
__host__ __device__ __forceinline__ void stage_rc(int b, int& R, int& C) { const int st = b / 1024, sb = b % 1024, swz = sb ^ (((sb >> 9) & 1) << 5); R = (st >> 1) * 16 + swz / 64; C = (st & 1) * 32 + (swz % 64) / 2; }
__host__ __device__ __forceinline__ int perm32(int rho) { const int n = rho >> 4, i = rho & 15; return 8 * (i >> 2) + 4 * n + (i & 3); }

struct Unit { int pm, pn; };
struct Gemm { const bf16_t* A; const bf16_t* Bt; int M, N, K, lda; int pm_per_grp, ngrp; size_t grp_bytes; int sc_w, sc_x;
    __device__ __forceinline__ size_t grp_off(int pm) const { return ngrp > 1 ? (size_t)((pm / pm_per_grp) % ngrp) * grp_bytes : (size_t)0; } };

typedef int v8i_t __attribute__((ext_vector_type(8))); typedef int v4i_t __attribute__((ext_vector_type(4)));
__device__ __forceinline__ v8i_t cat8(bf16x8 lo, bf16x8 hi) { return __builtin_shufflevector(__builtin_bit_cast(v4i_t, lo), __builtin_bit_cast(v4i_t, hi), 0, 1, 2, 3, 4, 5, 6, 7); }
struct StaticOrder {
    int nM, nN, nwg, G, c;
    __host__ __device__ void init(int M, int N, int G_, int c_) { nM = M / BM; nN = N / BM; nwg = nM * nN; G = G_; c = c_; }
    __host__ __device__ bool next(int i, Unit& u) const {
        const long L = (long)i * G + c; if (L >= nwg) return false;
        int wgid = (int)L; { const int q = nwg / NXCD, r = nwg % NXCD, xcd = wgid % NXCD, off = wgid / NXCD; wgid = (xcd < r ? xcd * (q + 1) : r * (q + 1) + (xcd - r) * q) + off; }
        const int nig = WGM * nN, gid = wgid / nig, fm = gid * WGM, gsz = (nM - fm) < WGM ? (nM - fm) : WGM;
        u.pm = fm + ((wgid % nig) % gsz); u.pn = (wgid % nig) / gsz; return true;
    }
    __device__ __forceinline__ void a_ready(const Unit&) const {}
    __device__ __forceinline__ void done(const Unit&) const {}
};

typedef float f32x2_t __attribute__((ext_vector_type(2))); typedef __bf16 bf16x2_t __attribute__((ext_vector_type(2)));
__device__ __forceinline__ unsigned cvt_pk_bf16(float lo, float hi) { f32x2_t v = {lo, hi}; bf16x2_t b = __builtin_convertvector(v, bf16x2_t); return __builtin_bit_cast(unsigned, b); }
__device__ __forceinline__ float bf_lo(unsigned w) { return __uint_as_float(w << 16); }
__device__ __forceinline__ float bf_hi(unsigned w) { return __uint_as_float(w & 0xffff0000u); }

#define PG8_EPI_LOOP(...) \
    _Pragma("unroll") for (int ai = 0; ai < 2; ++ai) _Pragma("unroll") for (int m = 0; m < 4; ++m) _Pragma("unroll") for (int bj = 0; bj < 2; ++bj) { \
        const int row = u.pm * BM + ai * HALF + wr * 64 + m * 16 + fr; const int ct = bj * HALF + wc * 32 + 8 * fq;   \
        f32x4 v0 = acc[ai][bj][m][0], v1 = acc[ai][bj][m][1]; __VA_ARGS__ }
__device__ __forceinline__ u32x4 pack8(f32x4 v0, f32x4 v1) { u32x4 w; w.x = cvt_pk_bf16(v0[0], v0[1]); w.y = cvt_pk_bf16(v0[2], v0[3]); w.z = cvt_pk_bf16(v1[0], v1[1]); w.w = cvt_pk_bf16(v1[2], v1[3]); return w; }

struct EpiPlain { static constexpr bool PERM = true, AFTER_DRAIN = false; bf16_t* O; int ldc;
    __device__ __forceinline__ void operator()(const f32x4 (&acc)[2][2][4][2], const Unit& u, int wr, int wc, int fr, int fq) const {
        PG8_EPI_LOOP({ *(u32x4*)(O + (size_t)row * ldc + u.pn * BM + ct) = pack8(v0, v1); }) } };
struct EpiRoute { static constexpr bool PERM = true, AFTER_DRAIN = false; bf16_t* five; size_t five_stride; bf16_t* tail; size_t tail_stride;
    __device__ __forceinline__ void operator()(const f32x4 (&acc)[2][2][4][2], const Unit& u, int wr, int wc, int fr, int fq) const {
        bf16_t* base; int ldc, c0;
        if (u.pn < 10) { base = five + (size_t)(u.pn >> 1) * five_stride; ldc = 512; c0 = (u.pn & 1) * 256; } else { base = tail + (size_t)(u.pn - 10) * tail_stride; ldc = 256; c0 = 0; }
        PG8_EPI_LOOP({ *(u32x4*)(base + (size_t)row * ldc + c0 + ct) = pack8(v0, v1); }) } };
struct EpiRouteNorm { static constexpr bool PERM = true, AFTER_DRAIN = false; bf16_t* five; size_t five_stride; bf16_t* tail; size_t tail_stride; const float* gt; float* ssp; float eps;
    __device__ __forceinline__ void operator()(const f32x4 (&acc)[2][2][4][2], const Unit& u, int wr, int wc, int fr, int fq) const {
        bf16_t* base; int ldc, c0;
        if (u.pn < 10) { base = five + (size_t)(u.pn >> 1) * five_stride; ldc = 512; c0 = (u.pn & 1) * 256; } else { base = tail + (size_t)(u.pn - 10) * tail_stride; ldc = 256; c0 = 0; }
        const bool nrm = (u.pn < 6) || (u.pn == 9 && wc >= 2);
        const bool part = (u.pn == 8) || (u.pn == 9 && wc < 2) || (u.pn == 10);
        const int gi = u.pn < 2 ? 0 : (u.pn < 4 ? 1 : (u.pn < 6 ? 2 : 3));
        const int slot = u.pn == 8 ? wc : (u.pn == 9 ? 4 + wc : 8 + wc);
        f32x4 g00 = {1.f, 1.f, 1.f, 1.f}, g01 = g00, g10 = g00, g11 = g00;
        if (nrm) { const float* gp = gt + gi * 64 + 8 * fq; g00 = *(const f32x4*)gp; g01 = *(const f32x4*)(gp + 4); g10 = *(const f32x4*)(gp + 32); g11 = *(const f32x4*)(gp + 36); }
#pragma unroll
        for (int ai = 0; ai < 2; ++ai)
#pragma unroll
            for (int m = 0; m < 4; ++m) { const int row = u.pm * BM + ai * HALF + wr * 64 + m * 16 + fr;
                f32x4 v00 = acc[ai][0][m][0], v01 = acc[ai][0][m][1], v10 = acc[ai][1][m][0], v11 = acc[ai][1][m][1];
                if (nrm || part) {
                    float ss = 0.f;
#pragma unroll
                    for (int i = 0; i < 4; ++i) ss += (v00[i] * v00[i] + v01[i] * v01[i]) + (v10[i] * v10[i] + v11[i] * v11[i]);
                    { auto r_ = __builtin_amdgcn_permlane16_swap(__float_as_uint(ss), __float_as_uint(ss), false, false); ss = __uint_as_float(r_[0]) + __uint_as_float(r_[1]); }
                    { auto r_ = __builtin_amdgcn_permlane32_swap(__float_as_uint(ss), __float_as_uint(ss), false, false); ss = __uint_as_float(r_[0]) + __uint_as_float(r_[1]); }
                    if (nrm) { const float rs = 1.0f / sqrtf(ss * (1.0f / 64) + eps); v00 = v00 * rs * g00; v01 = v01 * rs * g01; v10 = v10 * rs * g10; v11 = v11 * rs * g11; }
                    if (part && fq == 0) ssp[(size_t)row * 16 + slot] = ss;
                }
                bf16_t* rp = base + (size_t)row * ldc + c0 + wc * 64 + 8 * fq;
                *(u32x4*)rp = pack8(v00, v01); *(u32x4*)(rp + 32) = pack8(v10, v11); } } };
struct EpiPlainRS { static constexpr bool PERM = true, AFTER_DRAIN = false; bf16_t* O; int ldc; const float* ssp; int s0, ns; float inv_n, eps;
    __device__ __forceinline__ void operator()(const f32x4 (&acc)[2][2][4][2], const Unit& u, int wr, int wc, int fr, int fq) const {
#pragma unroll
        for (int ai = 0; ai < 2; ++ai)
#pragma unroll
            for (int m = 0; m < 4; ++m) { const int row = u.pm * BM + ai * HALF + wr * 64 + m * 16 + fr;
                const float* sp = ssp + (size_t)row * 16 + s0; const f32x4 a = *(const f32x4*)sp; float ss = (a[0] + a[1]) + (a[2] + a[3]);
                if (ns > 4) { const f32x2 b = *(const f32x2*)(sp + 4); ss += b[0] + b[1]; }
                const float rs = 1.0f / sqrtf(ss * inv_n + eps);
#pragma unroll
                for (int bj = 0; bj < 2; ++bj) { const int ct = bj * HALF + wc * 32 + 8 * fq;
                    *(u32x4*)(O + (size_t)row * ldc + u.pn * BM + ct) = pack8(acc[ai][bj][m][0] * rs, acc[ai][bj][m][1] * rs); } } } };
struct EpiGate { static constexpr bool PERM = true, AFTER_DRAIN = false; bf16_t* g0; size_t gstride, gextra; float zs;
    __device__ __forceinline__ void operator()(const f32x4 (&acc)[2][2][4][2], const Unit& u, int wr, int wc, int fr, int fq) const {
        const int gi = u.pn >> 2; bf16_t* base = g0 + (size_t)gi * gstride + (size_t)(gi >> 1) * gextra; const int c0 = (u.pn & 3) * 256;
        PG8_EPI_LOOP({
            _Pragma("unroll") for (int i = 0; i < 4; ++i) { v0[i] = __builtin_amdgcn_rcpf(1.0f + __builtin_amdgcn_exp2f(zs * v0[i])); v1[i] = __builtin_amdgcn_rcpf(1.0f + __builtin_amdgcn_exp2f(zs * v1[i])); }
            *(u32x4*)(base + (size_t)row * 1024 + c0 + ct) = pack8(v0, v1); }) } };
struct EpiMerge { static constexpr bool PERM = true, AFTER_DRAIN = false; const bf16_t* gate; bf16_t* mg; int first;
    __device__ __forceinline__ void operator()(const f32x4 (&acc)[2][2][4][2], const Unit& u, int wr, int wc, int fr, int fq) const {
        PG8_EPI_LOOP({
            const size_t off = (size_t)row * 1024 + u.pn * BM + ct;
            const u32x4 gw = *(const u32x4*)(gate + off);
            f32x4 p0 = {0.f, 0.f, 0.f, 0.f}, p1 = {0.f, 0.f, 0.f, 0.f};
            if (!first) { const u32x4 pw = *(const u32x4*)(mg + off); p0 = (f32x4){bf_lo(pw.x), bf_hi(pw.x), bf_lo(pw.y), bf_hi(pw.y)}; p1 = (f32x4){bf_lo(pw.z), bf_hi(pw.z), bf_lo(pw.w), bf_hi(pw.w)}; }
            const f32x4 g0v = (f32x4){bf_lo(gw.x), bf_hi(gw.x), bf_lo(gw.y), bf_hi(gw.y)}, g1v = (f32x4){bf_lo(gw.z), bf_hi(gw.z), bf_lo(gw.w), bf_hi(gw.w)};
            v0 = p0 + g0v * v0; v1 = p1 + g1v * v1;
            *(u32x4*)(mg + off) = pack8(v0, v1); }) } };
struct EpiResid { static constexpr bool PERM = true, AFTER_DRAIN = false; const void* xi; int in_bf16; bf16_t* xo;
    __device__ __forceinline__ void operator()(const f32x4 (&acc)[2][2][4][2], const Unit& u, int wr, int wc, int fr, int fq) const {
        if (in_bf16) {
            PG8_EPI_LOOP({
                const size_t off = (size_t)row * 1024 + u.pn * BM + ct;
                const u32x4 w = *(const u32x4*)((const bf16_t*)xi + off);
                const f32x4 a = {__uint_as_float(w.x << 16), __uint_as_float(w.x & 0xffff0000u), __uint_as_float(w.y << 16), __uint_as_float(w.y & 0xffff0000u)};
                const f32x4 b = {__uint_as_float(w.z << 16), __uint_as_float(w.z & 0xffff0000u), __uint_as_float(w.w << 16), __uint_as_float(w.w & 0xffff0000u)};
                *(u32x4*)(xo + off) = pack8(a + v0, b + v1); })
        } else {
            PG8_EPI_LOOP({
                const size_t off = (size_t)row * 1024 + u.pn * BM + ct;
                const f32x4 a = *(const f32x4*)((const float*)xi + off), b = *(const f32x4*)((const float*)xi + off + 4);
                *(u32x4*)(xo + off) = pack8(a + v0, b + v1); })
        } } };
__device__ __forceinline__ u32x2 pack8_fp8(f32x4 v0, f32x4 v1) {
    _Pragma("unroll") for (int i = 0; i < 4; ++i) { v0[i] = fminf(fmaxf(v0[i], -448.f), 448.f); v1[i] = fminf(fmaxf(v1[i], -448.f), 448.f); }
    int a = 0, b = 0; a = __builtin_amdgcn_cvt_pk_fp8_f32(v0[0], v0[1], a, false); a = __builtin_amdgcn_cvt_pk_fp8_f32(v0[2], v0[3], a, true);
    b = __builtin_amdgcn_cvt_pk_fp8_f32(v1[0], v1[1], b, false); b = __builtin_amdgcn_cvt_pk_fp8_f32(v1[2], v1[3], b, true); u32x2 w; w.x = (unsigned)a; w.y = (unsigned)b; return w; }
struct EpiSwiglu { static constexpr bool PERM = true, AFTER_DRAIN = false; unsigned char* hid; float iscale, oscale;
    __device__ __forceinline__ void operator()(const f32x4 (&acc)[2][2][4][2], const Unit& u, int wr, int wc, int fr, int fq) const {
#pragma unroll
        for (int ai = 0; ai < 2; ++ai)
#pragma unroll
            for (int m = 0; m < 4; ++m) { const int row = u.pm * BM + ai * HALF + wr * 64 + m * 16 + fr; const int col = u.pn * 128 + wc * 32 + 8 * fq;
                f32x4 o0, o1;
#pragma unroll
                for (int i = 0; i < 4; ++i) { const float g0 = acc[ai][0][m][0][i] * iscale, g1 = acc[ai][0][m][1][i] * iscale;
                    o0[i] = g0 * __builtin_amdgcn_rcpf(1.0f + __builtin_amdgcn_exp2f(-1.4426950408889634f * g0)) * (acc[ai][1][m][0][i] * iscale);
                    o1[i] = g1 * __builtin_amdgcn_rcpf(1.0f + __builtin_amdgcn_exp2f(-1.4426950408889634f * g1)) * (acc[ai][1][m][1][i] * iscale); }
                *(u32x2*)(hid + (size_t)row * 1024 + col) = pack8_fp8(o0 * oscale, o1 * oscale); } } };
struct EpiDown { static constexpr bool PERM = true, AFTER_DRAIN = false; bf16_t* Y; const float* aff; float iscale;
    __device__ __forceinline__ void operator()(const f32x4 (&acc)[2][2][4][2], const Unit& u, int wr, int wc, int fr, int fq) const {
        PG8_EPI_LOOP({ const float a = aff[row] * iscale; v0 = v0 * a; v1 = v1 * a; *(u32x4*)(Y + (size_t)row * 1024 + u.pn * BM + ct) = pack8(v0, v1); }) } };

template <class Epi, class Sched, bool ALIGN_EPI = false, bool SP2 = false, bool F8 = false>
__device__ __forceinline__ void gemm_phase(PG8_LAS unsigned char* lds, const Gemm g, const Sched& S, const Epi& E) {
    int tid_ = threadIdx.x; asm volatile("" : "+v"(tid_));
    const int tid = tid_, wid = __builtin_amdgcn_readfirstlane(tid >> 6), lane = tid & 63, wr = wid >> 2, wc = wid & 3, fr = lane & 15, fq = lane >> 4;
    const int K = g.K, nt = K / BK, lda = g.lda;
    unsigned voffA[2], voffB[2];
#pragma unroll
    for (int i = 0; i < 2; ++i) { int R, C; stage_rc(tid * 16 + i * 8192, R, C); const int Rb = Epi::PERM ? ((R & ~31) + perm32(R & 31)) : R;
        voffA[i] = (unsigned)(R * lda + C) * 2u; voffB[i] = (unsigned)(Rb * K + C) * 2u; }
    const size_t kstep = (size_t)(BK * 2);
    const size_t hstepA = (size_t)HALF * lda * 2, hstepB = (size_t)HALF * K * 2;
    const size_t tstepA = 2 * hstepA, tstepB = 2 * hstepB;
    const unsigned ldsw = (unsigned)wid * 1024u;
    const int aoff = lds_byte(wr * 64 + fr, fq * 8), boff = lds_byte(wc * 32 + fr, fq * 8);
#define PG8_SA(b, h) (((b) * 2 + (h)) * HTB)
#define PG8_SB(b, h) ((4 + (b) * 2 + (h)) * HTB)
#define PG8_STAGE(bufoff, gbase, voff) do { _Pragma("unroll") for (int _i = 0; _i < 2; ++_i) \
        __builtin_amdgcn_global_load_lds((const unsigned*)((const char*)(gbase) + (voff)[_i]), (PG8_LAS unsigned*)(lds + (bufoff) + ldsw + _i * 8192), 16, 0, 0); } while (0)
#define PG8_LDA(dst, b, h) do { _Pragma("unroll") for (int m = 0; m < 4; ++m) { if constexpr (F8) { dst##8[m] = cat8(*(const PG8_LAS bf16x8*)(lds + PG8_SA(b, h) + aoff + m * 2048), *(const PG8_LAS bf16x8*)(lds + PG8_SA(b, h) + aoff + m * 2048 + 1024)); } \
        else { _Pragma("unroll") for (int k = 0; k < 2; ++k) dst[m][k] = *(const PG8_LAS bf16x8*)(lds + PG8_SA(b, h) + aoff + m * 2048 + k * 1024); } } } while (0)
#define PG8_LDB(dst, b, h) do { _Pragma("unroll") for (int n = 0; n < 2; ++n) { if constexpr (F8) { dst##8[n] = cat8(*(const PG8_LAS bf16x8*)(lds + PG8_SB(b, h) + boff + n * 2048), *(const PG8_LAS bf16x8*)(lds + PG8_SB(b, h) + boff + n * 2048 + 1024)); } \
        else { _Pragma("unroll") for (int k = 0; k < 2; ++k) dst[n][k] = *(const PG8_LAS bf16x8*)(lds + PG8_SB(b, h) + boff + n * 2048 + k * 1024); } } } while (0)
#define PG8_MMA(ai, bj, At, Bt) do { __builtin_amdgcn_s_setprio(1); _Pragma("unroll") for (int m = 0; m < 4; ++m) _Pragma("unroll") for (int n = 0; n < 2; ++n) { \
        if constexpr (F8) { asm volatile("v_mfma_f32_16x16x128_f8f6f4 %0, %1, %2, %0" : "+v"(acc[ai][bj][m][n]) : "v"(Bt##8[n]), "v"(At##8[m])); }     \
        else { _Pragma("unroll") for (int k = 0; k < 2; ++k) acc[ai][bj][m][n] = __builtin_amdgcn_mfma_f32_16x16x32_bf16(Bt[n][k], At[m][k], acc[ai][bj][m][n], 0, 0, 0); } } \
        __builtin_amdgcn_s_setprio(0); } while (0)
#define PG8_WAIT_V(n) asm volatile("s_waitcnt vmcnt(" #n ")" ::: "memory")
#define PG8_WAIT_L(n) asm volatile("s_waitcnt lgkmcnt(" #n ")" ::: "memory")
#define PG8_BAR __builtin_amdgcn_s_barrier()
#define PG8_SCHED __builtin_amdgcn_sched_barrier(0)
    Unit cur, nxt; int ui = 0;
    if (!S.next(0, cur)) return;
    f32x4 acc[2][2][4][2];
#define PG8_Z z0_
    { float z0_ = 0.f; asm volatile("" : "+v"(z0_));
#pragma unroll
    for (int a = 0; a < 2; ++a)
#pragma unroll
        for (int b = 0; b < 2; ++b)
#pragma unroll
            for (int m = 0; m < 4; ++m)
#pragma unroll
                for (int n = 0; n < 2; ++n) acc[a][b][m][n] = (f32x4){PG8_Z, PG8_Z, PG8_Z, PG8_Z}; }
    bf16x8 At[4][2], B0[2][2], B1[2][2]; v8i_t At8[4], B08[2], B18[2]; (void)At; (void)B0; (void)B1; (void)At8; (void)B08; (void)B18;
    const char* cA = (const char*)g.A + (size_t)cur.pm * tstepA; const char* cB = (const char*)g.Bt + g.grp_off(cur.pm) + (size_t)cur.pn * tstepB;
    S.a_ready(cur);
    if constexpr (SP2) {
        PG8_STAGE(PG8_SB(0, 0), cB, voffB); PG8_STAGE(PG8_SB(0, 1), cB + hstepB, voffB); PG8_STAGE(PG8_SA(0, 0), cA, voffA); PG8_STAGE(PG8_SA(0, 1), cA + hstepA, voffA);
        if (wr == 1) PG8_BAR;
        PG8_WAIT_V(2); PG8_BAR;
        PG8_STAGE(PG8_SB(1, 0), cB + kstep, voffB); PG8_STAGE(PG8_SA(1, 0), cA + kstep, voffA); PG8_STAGE(PG8_SB(1, 1), cB + hstepB + kstep, voffB);
        PG8_WAIT_V(6); PG8_BAR;
    } else {
        PG8_STAGE(PG8_SB(0, 0), cB, voffB); PG8_STAGE(PG8_SA(0, 0), cA, voffA); PG8_STAGE(PG8_SB(0, 1), cB + hstepB, voffB); PG8_STAGE(PG8_SA(0, 1), cA + hstepA, voffA);
        if (wr == 1) PG8_BAR;
        PG8_WAIT_V(4); PG8_BAR;
        PG8_STAGE(PG8_SB(1, 0), cB + kstep, voffB); PG8_STAGE(PG8_SA(1, 0), cA + kstep, voffA); PG8_STAGE(PG8_SB(1, 1), cB + hstepB + kstep, voffB);
        PG8_WAIT_V(6); PG8_BAR;
    }
    for (;;) {
        const bool has_next = S.next(ui + 1, nxt);
        const char* nA = has_next ? (const char*)g.A + (size_t)nxt.pm * tstepA : cA; const char* nB = has_next ? (const char*)g.Bt + g.grp_off(nxt.pm) + (size_t)nxt.pn * tstepB : cB;
#pragma unroll 1
        for (int t = 0; t < nt; t += 2) {
            const bool last = (t == nt - 2);
            const char* a1 = cA + (size_t)(t + 1) * kstep;
            const char* a2 = last ? nA : cA + (size_t)(t + 2) * kstep; const char* b2 = last ? nB : cB + (size_t)(t + 2) * kstep;
            const char* a3 = a2 + kstep; const char* b3 = b2 + kstep;
            if (last && has_next) S.a_ready(nxt);
            if constexpr (SP2) {
            PG8_LDB(B0, 0, 0); PG8_LDB(B1, 0, 1); PG8_SCHED; PG8_LDA(At, 0, 0); PG8_STAGE(PG8_SA(1, 1), a1 + hstepA, voffA);
            PG8_WAIT_V(8); PG8_WAIT_L(0); PG8_BAR; PG8_MMA(0, 0, At, B0); PG8_MMA(0, 1, At, B1); PG8_BAR; PG8_SCHED;
            PG8_LDA(At, 0, 1); PG8_STAGE(PG8_SB(0, 0), b2, voffB); PG8_STAGE(PG8_SB(0, 1), b2 + hstepB, voffB); PG8_STAGE(PG8_SA(0, 0), a2, voffA);
            PG8_WAIT_V(8); PG8_WAIT_L(0); PG8_BAR; PG8_MMA(1, 0, At, B0); PG8_MMA(1, 1, At, B1); PG8_BAR; PG8_SCHED;
            PG8_LDB(B0, 1, 0); PG8_LDB(B1, 1, 1); PG8_SCHED; PG8_LDA(At, 1, 0); PG8_STAGE(PG8_SA(0, 1), a2 + hstepA, voffA);
            PG8_WAIT_V(8); PG8_WAIT_L(0); PG8_BAR; PG8_MMA(0, 0, At, B0); PG8_MMA(0, 1, At, B1); PG8_BAR; PG8_SCHED;
            PG8_LDA(At, 1, 1); PG8_STAGE(PG8_SB(1, 0), b3, voffB); PG8_STAGE(PG8_SB(1, 1), b3 + hstepB, voffB); PG8_STAGE(PG8_SA(1, 0), a3, voffA);
            PG8_WAIT_V(8); PG8_WAIT_L(0); PG8_BAR; PG8_MMA(1, 0, At, B0); PG8_MMA(1, 1, At, B1); PG8_BAR; PG8_SCHED;
            } else {
            PG8_LDB(B0, 0, 0); PG8_SCHED; PG8_LDA(At, 0, 0); PG8_STAGE(PG8_SA(1, 1), a1 + hstepA, voffA);
            PG8_WAIT_L(8); PG8_BAR; PG8_WAIT_L(0); PG8_MMA(0, 0, At, B0); PG8_BAR; PG8_SCHED;
            PG8_LDB(B1, 0, 1); PG8_STAGE(PG8_SB(0, 0), b2, voffB);
            PG8_BAR; PG8_WAIT_L(0); PG8_MMA(0, 1, At, B1); PG8_BAR;
            PG8_LDA(At, 0, 1); PG8_STAGE(PG8_SA(0, 0), a2, voffA);
            PG8_BAR; PG8_WAIT_L(0); PG8_MMA(1, 0, At, B0); PG8_BAR; PG8_SCHED;
            PG8_STAGE(PG8_SB(0, 1), b2 + hstepB, voffB);
            PG8_WAIT_V(6); PG8_BAR; PG8_MMA(1, 1, At, B1); PG8_BAR;
            PG8_LDB(B0, 1, 0); PG8_SCHED; PG8_LDA(At, 1, 0); PG8_STAGE(PG8_SA(0, 1), a2 + hstepA, voffA);
            PG8_WAIT_L(8); PG8_BAR; PG8_WAIT_L(0); PG8_MMA(0, 0, At, B0); PG8_BAR; PG8_SCHED;
            PG8_LDB(B1, 1, 1); PG8_STAGE(PG8_SB(1, 0), b3, voffB);
            PG8_BAR; PG8_WAIT_L(0); PG8_MMA(0, 1, At, B1); PG8_BAR;
            PG8_LDA(At, 1, 1); PG8_STAGE(PG8_SA(1, 0), a3, voffA);
            PG8_BAR; PG8_WAIT_L(0); PG8_MMA(1, 0, At, B0); PG8_BAR; PG8_SCHED;
            PG8_STAGE(PG8_SB(1, 1), b3 + hstepB, voffB);
            PG8_WAIT_V(6); PG8_BAR; PG8_MMA(1, 1, At, B1); PG8_BAR;
            }
        }
        if constexpr (F8) { asm volatile("s_nop 15\n\ts_nop 15" ::: "memory"); }
        if constexpr (ALIGN_EPI) { if (wr == 0) PG8_BAR; }
        if constexpr (!Epi::AFTER_DRAIN) { E(acc, cur, wr, wc, fr, fq); S.done(cur); }
        if (!has_next) break;
        { float z0_ = 0.f; asm volatile("" : "+v"(z0_));
#pragma unroll
        for (int a = 0; a < 2; ++a)
#pragma unroll
            for (int b = 0; b < 2; ++b)
#pragma unroll
                for (int m = 0; m < 4; ++m)
#pragma unroll
                    for (int n = 0; n < 2; ++n) acc[a][b][m][n] = (f32x4){PG8_Z, PG8_Z, PG8_Z, PG8_Z}; }
        cur = nxt; cA = nA; cB = nB; ++ui;
        if constexpr (ALIGN_EPI) { if (wr == 1) PG8_BAR; }
    }
    PG8_WAIT_V(0);
    if constexpr (!ALIGN_EPI) { if (wr == 0) PG8_BAR; }
    PG8_BAR;
    if constexpr (Epi::AFTER_DRAIN) { E.fused(acc, cur, wr, wc, fr, fq, lds, wid, lane); S.done(cur); }
#undef PG8_Z
#undef PG8_SA
#undef PG8_SB
#undef PG8_STAGE
#undef PG8_LDA
#undef PG8_LDB
#undef PG8_MMA
#undef PG8_WAIT_V
#undef PG8_WAIT_L
#undef PG8_BAR
#undef PG8_SCHED
}
}

constexpr int NB = 16, SEQ = 4096, DM = 1024, T = NB * SEQ, DEPTH = 2;
constexpr int NEXP = 16, CAP = 512, TE = NB * NEXP * CAP;
constexpr int IN_COLS = 6048;
constexpr float EPS = 1e-6f;
constexpr float LOG2E = 1.4426950408889634f;
constexpr int NWAVES = 8;
constexpr int PH_PER_LAYER = 16, NPHASE = DEPTH * PH_PER_LAYER;

constexpr size_t MiB = 1u << 20;
constexpr size_t WS_CTL = 0, CTL_ZERO_BYTES = 1 * MiB;
constexpr size_t WS_AFFT = 2 * MiB;
constexpr size_t WS_INV = 6 * MiB;
constexpr size_t WS_IDX = 10 * MiB;
constexpr size_t WS_AFFSEL = 10 * MiB + 512 * 1024;
constexpr size_t WS_TMM = 11 * MiB;
constexpr size_t WS_GT = 11 * MiB + 16 * 1024;
constexpr size_t WS_SSP = 2 * MiB;
constexpr size_t WS_WIN = 12 * MiB;
constexpr size_t WS_WUQ = 24 * MiB;
constexpr size_t WS_WUKV = 25 * MiB;
constexpr size_t WS_WBA = 26 * MiB, WS_WBB = 27 * MiB, WS_WBC = 28 * MiB;
constexpr size_t WS_WO = 29 * MiB;
constexpr size_t WS_WGU = 32 * MiB;
constexpr size_t WS_WD = 64 * MiB;
constexpr size_t WS_WG8 = 80 * MiB;
constexpr size_t WS_H8 = 864 * MiB;
constexpr float W8_SCALE = 64.0f, HID_SCALE = 4.0f;
constexpr int W8_E8M0 = 127 - 6, HID_E8M0 = 127 - 2, ONE_E8M0 = 127;
constexpr size_t WS_H = 128 * MiB;
constexpr size_t WS_QA = 256 * MiB, WS_QC = 320 * MiB, WS_KA = 384 * MiB, WS_VA = 448 * MiB, WS_CQKC = 512 * MiB;
constexpr size_t WS_CKV = 576 * MiB, WS_VCKR = 608 * MiB;
constexpr size_t WS_G0 = 384 * MiB, WS_G1 = 512 * MiB;
constexpr size_t WS_QB = 640 * MiB;
constexpr size_t WS_KVR = 736 * MiB;
constexpr size_t WS_G2 = 736 * MiB;
constexpr size_t WS_KB = 864 * MiB;
constexpr size_t WS_OB = 960 * MiB;
constexpr size_t WS_XG = 256 * MiB;
constexpr size_t WS_HID = 512 * MiB;
constexpr size_t WS_XB = 768 * MiB;
constexpr size_t WS_END = 1024 * MiB;

constexpr int RING_OFF = 0, RING_BYTES = 131072;
constexpr int LDS_BYTES = 163840;
constexpr int LDSCTL_OFF = LDS_BYTES - 1024, MISC_OFF = LDSCTL_OFF + 320;
constexpr int ATT_NXT_OFF = LDSCTL_OFF - 64;
constexpr int ATT_STASH_OFF = 86528;

#define LAS __attribute__((address_space(3)))
typedef unsigned short bf16;
typedef unsigned v4u __attribute__((ext_vector_type(4)));
typedef unsigned v2u __attribute__((ext_vector_type(2)));
typedef float f32x4 __attribute__((ext_vector_type(4)));
typedef float f32x2 __attribute__((ext_vector_type(2)));
typedef float f32x16 __attribute__((ext_vector_type(16)));
typedef short bf16x8 __attribute__((ext_vector_type(8)));
typedef short s16x4 __attribute__((ext_vector_type(4)));
#define LDS_WAIT() asm volatile("s_waitcnt lgkmcnt(0)" ::: "memory")
#define VM_WAIT() asm volatile("s_waitcnt vmcnt(0)" ::: "memory")
__device__ __forceinline__ unsigned pk2(float lo, float hi) { return pg8::cvt_pk_bf16(lo, hi); }
__device__ __forceinline__ float bflo(unsigned w) { return __uint_as_float(w << 16); }
__device__ __forceinline__ float bfhi(unsigned w) { return __uint_as_float(w & 0xffff0000u); }
template <int M> __device__ __forceinline__ float xor_add(float v) {
    if constexpr (M < 32) return v + __int_as_float(__builtin_amdgcn_ds_swizzle(__float_as_int(v), (M << 10) | 0x1f));
    else { auto r = __builtin_amdgcn_permlane32_swap(__float_as_uint(v), __float_as_uint(v), false, false); return __uint_as_float(r[0]) + __uint_as_float(r[1]); } }
template <int M> __device__ __forceinline__ float xor_max(float v) {
    if constexpr (M < 32) return fmaxf(v, __int_as_float(__builtin_amdgcn_ds_swizzle(__float_as_int(v), (M << 10) | 0x1f)));
    else { auto r = __builtin_amdgcn_permlane32_swap(__float_as_uint(v), __float_as_uint(v), false, false); return fmaxf(__uint_as_float(r[0]), __uint_as_float(r[1])); } }
template <int M> __device__ __forceinline__ int xor_geti(int v) { static_assert(M < 32, "xor_geti: masks below 32"); return __builtin_amdgcn_ds_swizzle(v, (M << 10) | 0x1f); }
template <int M> __device__ __forceinline__ float xor_getf(float v) { return __int_as_float(xor_geti<M>(__float_as_int(v))); }
__device__ __forceinline__ unsigned wave_sum_u(unsigned c) {
    c += (unsigned)xor_geti<1>((int)c); c += (unsigned)xor_geti<2>((int)c); c += (unsigned)xor_geti<4>((int)c); c += (unsigned)xor_geti<8>((int)c); c += (unsigned)xor_geti<16>((int)c);
    auto r = __builtin_amdgcn_permlane32_swap(c, c, false, false); return r[0] + r[1]; }
__device__ __forceinline__ float wave_sum(float v) { v = xor_add<1>(v); v = xor_add<2>(v); v = xor_add<4>(v); v = xor_add<8>(v); v = xor_add<16>(v); return xor_add<32>(v); }

#define XB_TMO      128
#define XB_XCNT(j)  (256  + 64 * (j))
#define XB_XSUB(j)  (1280 + 64 * (j))
#define XB_XGEN(j)  (2304 + 64 * (j))
#define XB_TOP      3328
#define XB_TOPGEN   3392
#define XCD_BAR_WORDS 3456
#define XB_SPIN_CAP (1u << 23)

__device__ __forceinline__ unsigned xb_ld(unsigned* p)              { return __hip_atomic_load(p, __ATOMIC_RELAXED, __HIP_MEMORY_SCOPE_AGENT); }
__device__ __forceinline__ unsigned xb_add(unsigned* p, unsigned v) { return __hip_atomic_fetch_add(p, v, __ATOMIC_RELAXED, __HIP_MEMORY_SCOPE_AGENT); }
__device__ __forceinline__ unsigned xb_xcc_id() { return (unsigned)__builtin_amdgcn_s_getreg((3 << 11) | 20) & 0xFu; }
#define XB_SPIN(cond, bar) do { unsigned _sp = 0; while (cond) { __builtin_amdgcn_s_sleep(1); \
    if ((++_sp & 255u) == 0u) { if (xb_ld(&(bar)[XB_TMO])) break; if (_sp > XB_SPIN_CAP) { atomicAdd(&(bar)[XB_TMO], 1u); break; } } } } while (0)

struct XcdBarrier { unsigned* bar; unsigned x; volatile LAS unsigned* st; };

__device__ __forceinline__ XcdBarrier xcd_barrier_post(unsigned* bar, volatile LAS unsigned* st) {
    XcdBarrier b; b.bar = bar; b.x = xb_xcc_id(); b.st = st;
    if (threadIdx.x == 0) (void)xb_add(&bar[XB_XCNT(b.x)], 1u);
    return b;
}
__device__ __forceinline__ void xcd_barrier_complete(unsigned* bar, unsigned x, unsigned& nloc, unsigned& nx) {
    const unsigned G = gridDim.x * gridDim.y * gridDim.z;
    unsigned sum, cnt, mine, sp = 0u;
    for (;;) {
        sum = 0u; cnt = 0u; mine = 0u;
#pragma unroll
        for (unsigned j = 0; j < 16; ++j) { const unsigned c = xb_ld(&bar[XB_XCNT(j)]); sum += c; cnt += (c > 0u) ? 1u : 0u; mine = (j == x) ? c : mine; }
        if (sum == G) break;
        __builtin_amdgcn_s_sleep(1);
        if ((++sp & 255u) == 0u) { if (xb_ld(&bar[XB_TMO])) break; if (sp > XB_SPIN_CAP) { atomicAdd(&bar[XB_TMO], 1u); break; } }
    }
    nloc = mine > 0u ? mine : 1u; nx = cnt > 0u ? cnt : 1u;
}
__device__ __forceinline__ void xcd_barrier(const XcdBarrier& b) {
    asm volatile("s_waitcnt vmcnt(0)" ::: "memory");
    __syncthreads();
    if (threadIdx.x == 0) {
        unsigned* bar = b.bar;
        __builtin_amdgcn_s_waitcnt(0);
        unsigned nloc = b.st[0], nx = b.st[1];
        if (nloc == 0u) { xcd_barrier_complete(bar, b.x, nloc, nx); b.st[0] = nloc; b.st[1] = nx; }
        const unsigned old = xb_add(&bar[XB_XSUB(b.x)], 1u);
        const unsigned gen = old / nloc;
        if (old + 1u == (gen + 1u) * nloc) {
            __builtin_amdgcn_fence(__ATOMIC_RELEASE, "agent");
            asm volatile("s_waitcnt vmcnt(0)" ::: "memory");
            const unsigned og = xb_add(&bar[XB_TOP], 1u);
            const unsigned tg = og / nx;
            if (og + 1u == (tg + 1u) * nx) xb_add(&bar[XB_TOPGEN], 1u);
            else XB_SPIN(xb_ld(&bar[XB_TOPGEN]) == tg, bar);
            __builtin_amdgcn_fence(__ATOMIC_ACQUIRE, "agent");
            xb_add(&bar[XB_XGEN(b.x)], 1u);
            asm volatile("s_waitcnt vmcnt(0)" ::: "memory");
        } else {
            XB_SPIN(xb_ld(&bar[XB_XGEN(b.x)]) == gen, bar);
            __builtin_amdgcn_fence(__ATOMIC_ACQUIRE, "agent");
            asm volatile("s_waitcnt vmcnt(0)" ::: "memory");
        }
    }
    __syncthreads();
}

struct Frame {
    LAS unsigned char* lds;
    int wave, vcu, G;
};

__device__ __forceinline__ void cvt_block(const float* W, int K, int Nsrc, int k0, int n0, bf16* WT, int drow0, LAS float* scr, int lane, const float* kscale = nullptr) {
    float wv_[32];
#pragma unroll
    for (int i = 0; i < 32; ++i) wv_[i] = W[(size_t)(k0 + 2 * i + (lane >> 5)) * Nsrc + n0 + (lane & 31)];
    if (kscale) {
#pragma unroll
        for (int i = 0; i < 32; ++i) wv_[i] *= kscale[k0 + 2 * i + (lane >> 5)]; }
#pragma unroll
    for (int i = 0; i < 32; ++i) scr[(2 * i + (lane >> 5)) * 33 + (lane & 31)] = wv_[i];
    LDS_WAIT(); asm volatile("" ::: "memory");
    const int c = lane & 7;
#pragma unroll
    for (int j = 0; j < 4; ++j) { const int n = (lane >> 3) + 8 * j; const LAS float* s = scr + (8 * c) * 33 + n;
        v4u o; o.x = pk2(s[0 * 33], s[1 * 33]); o.y = pk2(s[2 * 33], s[3 * 33]); o.z = pk2(s[4 * 33], s[5 * 33]); o.w = pk2(s[6 * 33], s[7 * 33]);
        *(v4u*)(WT + (size_t)(drow0 + n) * K + k0 + 8 * c) = o; }
    LDS_WAIT(); asm volatile("" ::: "memory");
}
__device__ __forceinline__ void cvt_block8(const float* W, int K, int Nsrc, int k0, int n0, unsigned char* WT8, int drow0, float scale, LAS float* scr, int lane) {
    float wv_[32];
#pragma unroll
    for (int i = 0; i < 32; ++i) wv_[i] = W[(size_t)(k0 + 2 * i + (lane >> 5)) * Nsrc + n0 + (lane & 31)];
#pragma unroll
    for (int i = 0; i < 32; ++i) scr[(2 * i + (lane >> 5)) * 33 + (lane & 31)] = wv_[i];
    LDS_WAIT(); asm volatile("" ::: "memory");
    const int c = lane & 7;
#pragma unroll
    for (int j = 0; j < 4; ++j) { const int n = (lane >> 3) + 8 * j; const LAS float* s = scr + (8 * c) * 33 + n;
        const f32x4 a = {s[0 * 33] * scale, s[1 * 33] * scale, s[2 * 33] * scale, s[3 * 33] * scale}, b = {s[4 * 33] * scale, s[5 * 33] * scale, s[6 * 33] * scale, s[7 * 33] * scale};
        const pg8::u32x2 w = pg8::pack8_fp8(a, b); v2u o; o.x = w.x; o.y = w.y;
        *(v2u*)(WT8 + (size_t)(drow0 + n) * K + k0 + 8 * c) = o; }
    LDS_WAIT(); asm volatile("" ::: "memory");
}
__device__ __forceinline__ int win_row(int n0) {
    if (n0 < 512) { const int m = n0 >> 8, h = (n0 & 255) >> 6, d = n0 & 63; return h * 128 + m * 64 + d; }
    if (n0 < 1024) return 1024 + (n0 - 512);
    if (n0 < 1536) return 1536 + (n0 - 1024);
    if (n0 < 1920) return 2048 + (n0 - 1536);
    if (n0 < 2176) return 2560 + (n0 - 1920);
    if (n0 < 2208) return 2944 + (n0 - 2176);
    if (n0 < 2720) return 512 + (n0 - 2208);
    if (n0 < 2848) return 2432 + (n0 - 2720);
    if (n0 < 2976) return 2816 + (n0 - 2848);
    return 3072 + (n0 - 2976);
}
__device__ __forceinline__ int win_row_p(int n0) { const int r = win_row(n0), c = r & 255; return (r & ~255) + (((c >> 5) & 1) << 7) + ((c >> 6) << 5) + (c & 31); }
struct LayerW {
    const float *norm_mix_g, *w_in, *diff_qk_g, *diff_lambda, *diff_out_g, *mla_cq_g, *w_uq, *mla_ckv_g, *w_ukv, *mla_qk_g, *swa_qk_g, *swa_sink,
                *w_ba, *w_bb, *w_bc, *w_o, *norm_ffn_g, *w_router, *w_eg, *w_eu, *w_ed;
};
__device__ __forceinline__ void p_convert(const Frame& F, const LayerW& L, unsigned char* ws) {
    int tid_ = threadIdx.x; asm volatile("" : "+v"(tid_)); const int tid = tid_, lane = tid & 63; (void)tid; (void)lane;
    LAS float* scr = (LAS float*)(F.lds + RING_OFF + F.wave * 16384);
    const int gw = F.vcu * NWAVES + F.wave, NGW = F.G * NWAVES;
    constexpr int I_IN = 16 * 189, I_UQ = 6 * 24, I_UKV = 4 * 32, I_BR = 8 * 32, I_O = 16 * 32, I_E = 16 * 512;
    constexpr int NITEMS = I_IN + I_UQ + I_UKV + 3 * I_BR + I_O + 3 * I_E;
    bf16* win = (bf16*)(ws + WS_WIN);
    for (int it = gw; it < NITEMS; it += NGW) {
        int r = it;
        if (r < I_IN) { const int kb = r / 189, nb = r % 189;
            if (nb < 93) cvt_block(L.w_in, 1024, IN_COLS, kb * 64, nb * 32, win, win_row_p(nb * 32), scr, lane);
            else cvt_block8(L.w_in, 1024, IN_COLS, kb * 64, nb * 32, ws + WS_WG8, nb * 32 - 2976, W8_SCALE, scr, lane);
            continue; } r -= I_IN;
        if (r < I_UQ) { const int kb = r / 24, nb = r % 24; cvt_block(L.w_uq, 384, 768, kb * 64, nb * 32, (bf16*)(ws + WS_WUQ), nb * 32, scr, lane, L.mla_cq_g); continue; } r -= I_UQ;
        if (r < I_UKV) { const int kb = r / 32, nb = r % 32, n0 = nb * 32, h = n0 >> 7, jj = n0 & 127; const int dr = jj < 64 ? h * 64 + jj : 512 + h * 64 + (jj - 64);
            cvt_block(L.w_ukv, 256, 1024, kb * 64, n0, (bf16*)(ws + WS_WUKV), dr, scr, lane, L.mla_ckv_g); continue; } r -= I_UKV;
        if (r < I_BR) { const int kb = r / 32, nb = r % 32; cvt_block(L.w_ba, 512, 1024, kb * 64, nb * 32, (bf16*)(ws + WS_WBA), nb * 32, scr, lane); continue; } r -= I_BR;
        if (r < I_BR) { const int kb = r / 32, nb = r % 32; cvt_block(L.w_bb, 512, 1024, kb * 64, nb * 32, (bf16*)(ws + WS_WBB), nb * 32, scr, lane); continue; } r -= I_BR;
        if (r < I_BR) { const int kb = r / 32, nb = r % 32; cvt_block(L.w_bc, 512, 1024, kb * 64, nb * 32, (bf16*)(ws + WS_WBC), nb * 32, scr, lane); continue; } r -= I_BR;
        if (r < I_O) { const int kb = r / 32, nb = r % 32; cvt_block(L.w_o, 1024, 1024, kb * 64, nb * 32, (bf16*)(ws + WS_WO), nb * 32, scr, lane); continue; } r -= I_O;
        { const int w = r / I_E, q = r % I_E, e = q / 512, qq = q % 512, kb = qq / 32, nb = qq % 32, n0 = nb * 32;
          const int dr = (n0 >> 7) * 256 + (n0 & 127);
          if (w == 0) cvt_block8(L.w_eg + (size_t)e * 1024 * 1024, 1024, 1024, kb * 64, n0, ws + WS_WGU + (size_t)e * 2048 * 1024, dr, W8_SCALE, scr, lane);
          else if (w == 1) cvt_block8(L.w_eu + (size_t)e * 1024 * 1024, 1024, 1024, kb * 64, n0, ws + WS_WGU + (size_t)e * 2048 * 1024, dr + 128, W8_SCALE, scr, lane);
          else cvt_block8(L.w_ed + (size_t)e * 1024 * 1024, 1024, 1024, kb * 64, n0, ws + WS_WD + (size_t)e * 1024 * 1024, n0, W8_SCALE, scr, lane); }
    }
    { const int gt = (F.vcu * NWAVES + F.wave) * 64 + lane, NGT = NGW * 64;
      unsigned z_ = 0u; asm volatile("" : "+v"(z_));
      for (int i = gt; i < 96 * 1024 / 8; i += NGT) { const int blk = i / (32 * 1024 / 8), off = i % (32 * 1024 / 8); const int r0 = 2816 + (blk == 0 ? 192 : (blk == 1 ? 96 : 224));
          *(v4u*)(win + (size_t)r0 * 1024 + (size_t)off * 8) = (v4u){z_, z_, z_, z_}; }
      if (gt < 256) { const int gi = gt >> 6, d = gt & 63; const float QS_ = 0.125f * LOG2E;
          const float v = gi == 0 ? L.diff_qk_g[d] * QS_ : (gi == 1 ? L.swa_qk_g[d] * QS_ : (gi == 2 ? L.diff_qk_g[64 + d] : L.swa_qk_g[64 + d]));
          ((float*)(ws + WS_GT))[gt] = v; } }
}

__device__ __forceinline__ void p_norm1(const Frame& F, const float* x, const float* g, bf16* h) {
    int tid_ = threadIdx.x; asm volatile("" : "+v"(tid_)); const int tid = tid_, lane = tid & 63; (void)tid; (void)lane;
    const int gw = F.vcu * NWAVES + F.wave, NGW = F.G * NWAVES;
    f32x4 gv[4];
#pragma unroll
    for (int j = 0; j < 4; ++j) gv[j] = *((const f32x4*)g + lane + 64 * j);
    for (int row0 = gw * 2; row0 < T; row0 += NGW * 2) {
        f32x4 v[2][4];
#pragma unroll
        for (int rr = 0; rr < 2; ++rr) { const f32x4* xr = (const f32x4*)(x + (size_t)(row0 + rr) * DM) + lane;
#pragma unroll
            for (int j = 0; j < 4; ++j) v[rr][j] = xr[64 * j]; }
#pragma unroll
        for (int rr = 0; rr < 2; ++rr) { float s = 0.f;
#pragma unroll
            for (int j = 0; j < 4; ++j) s += (v[rr][j].x * v[rr][j].x + v[rr][j].y * v[rr][j].y) + (v[rr][j].z * v[rr][j].z + v[rr][j].w * v[rr][j].w);
            const float rs = 1.0f / sqrtf(wave_sum(s) * (1.0f / DM) + EPS);
            v2u* o8 = (v2u*)(h + (size_t)(row0 + rr) * DM) + lane;
#pragma unroll
            for (int j = 0; j < 4; ++j) { v2u o; o.x = pk2(v[rr][j].x * rs * gv[j].x, v[rr][j].y * rs * gv[j].y); o.y = pk2(v[rr][j].z * rs * gv[j].z, v[rr][j].w * rs * gv[j].w); o8[64 * j] = o; } }
    }
}

__device__ __forceinline__ float grp8_sum(float v) { v = xor_add<1>(v); v = xor_add<2>(v); v = xor_add<4>(v); return v; }
struct U8 { float f[8]; };
__device__ __forceinline__ U8 ld8bf(const bf16* p) { const v4u w = *(const v4u*)p; U8 r; r.f[0] = bflo(w.x); r.f[1] = bfhi(w.x); r.f[2] = bflo(w.y); r.f[3] = bfhi(w.y); r.f[4] = bflo(w.z); r.f[5] = bfhi(w.z); r.f[6] = bflo(w.w); r.f[7] = bfhi(w.w); return r; }
__device__ __forceinline__ void st8bf(bf16* p, const U8& r) { v4u w; w.x = pk2(r.f[0], r.f[1]); w.y = pk2(r.f[2], r.f[3]); w.z = pk2(r.f[4], r.f[5]); w.w = pk2(r.f[6], r.f[7]); *(v4u*)p = w; }
__device__ __forceinline__ float ss8(const U8& r) { float s = 0.f;
#pragma unroll
    for (int i = 0; i < 8; ++i) s += r.f[i] * r.f[i];
    return s; }
__device__ __forceinline__ void p_prep1(const Frame& F, const LayerW& L, unsigned char* ws) {
    int tid_ = threadIdx.x; asm volatile("" : "+v"(tid_)); const int tid = tid_, lane = tid & 63; (void)tid; (void)lane;
    const int gw = F.vcu * NWAVES + F.wave, NGW = F.G * NWAVES;
    const float QS = 0.125f * LOG2E;
    float gqa[8], gka[8], gqc[8], gkc[8], gcq[8], gckv[8];
#pragma unroll
    for (int i = 0; i < 8; ++i) { const int d = (lane & 7) * 8 + i;
        gqa[i] = L.diff_qk_g[d] * QS; gka[i] = L.diff_qk_g[64 + d]; gqc[i] = L.swa_qk_g[d] * QS; gkc[i] = L.swa_qk_g[64 + d];
        gcq[i] = lane < 48 ? L.mla_cq_g[lane * 8 + i] : 0.f; gckv[i] = lane < 32 ? L.mla_ckv_g[lane * 8 + i] : 0.f; }
    bf16* QA = (bf16*)(ws + WS_QA); bf16* KA = (bf16*)(ws + WS_KA); bf16* QC = (bf16*)(ws + WS_QC); bf16* CQKC = (bf16*)(ws + WS_CQKC); bf16* CKV = (bf16*)(ws + WS_CKV);
    for (int row0 = gw * 2; row0 < T; row0 += NGW * 2) {
        U8 a[2], b[2], c[2], d[2], e[2];
#pragma unroll
        for (int rr = 0; rr < 2; ++rr) { const int row = row0 + rr; const size_t o512 = (size_t)row * 512 + lane * 8;
            a[rr] = ld8bf(QA + o512); b[rr] = ld8bf(KA + o512); c[rr] = ld8bf(QC + o512); d[rr] = ld8bf(CQKC + o512);
            if (lane < 32) e[rr] = ld8bf(CKV + (size_t)row * 256 + lane * 8); else {
#pragma unroll
                for (int i = 0; i < 8; ++i) e[rr].f[i] = 0.f; } }
#pragma unroll
        for (int rr = 0; rr < 2; ++rr) { const int row = row0 + rr; const size_t o512 = (size_t)row * 512 + lane * 8;
            const float ra = 1.0f / sqrtf(grp8_sum(ss8(a[rr])) * (1.0f / 64) + EPS);
            const float rb = 1.0f / sqrtf(grp8_sum(ss8(b[rr])) * (1.0f / 64) + EPS);
            const float rc = 1.0f / sqrtf(grp8_sum(ss8(c[rr])) * (1.0f / 64) + EPS);
            const float sd = grp8_sum(ss8(d[rr]));
            float tot = lane < 48 ? sd : 0.f; tot = xor_add<8>(tot); tot = xor_add<16>(tot); tot = xor_add<32>(tot);
            const float rd = lane < 48 ? 1.0f / sqrtf(tot * (1.0f / 384) + EPS) : 1.0f / sqrtf(sd * (1.0f / 64) + EPS);
            float se = grp8_sum(ss8(e[rr])); se = xor_add<8>(se); se = xor_add<16>(se);
            const float re = 1.0f / sqrtf(se * (1.0f / 256) + EPS);
#pragma unroll
            for (int i = 0; i < 8; ++i) { a[rr].f[i] *= ra * gqa[i]; b[rr].f[i] *= rb * gka[i]; c[rr].f[i] *= rc * gqc[i]; d[rr].f[i] *= rd * (lane < 48 ? gcq[i] : gkc[i]); e[rr].f[i] *= re * gckv[i]; }
            st8bf(QA + o512, a[rr]); st8bf(KA + o512, b[rr]); st8bf(QC + o512, c[rr]); st8bf(CQKC + o512, d[rr]);
            if (lane < 32) st8bf(CKV + (size_t)row * 256 + lane * 8, e[rr]); }
    }
}

__device__ __forceinline__ void p_prep2(const Frame& F, const LayerW& L, unsigned char* ws, const int* positions) {
    int tid_ = threadIdx.x; asm volatile("" : "+v"(tid_)); const int tid = tid_, lane = tid & 63; (void)tid; (void)lane;
    const int gw = F.vcu * NWAVES + F.wave, NGW = F.G * NWAVES, h = lane >> 3, j = lane & 7;
    const float QS = 0.10206207261596575f * LOG2E;
    float gqn[8], gkn[8], gqr[4], gkr[4], invf[4];
#pragma unroll
    for (int i = 0; i < 8; ++i) { gqn[i] = L.mla_qk_g[8 * j + i] * QS; gkn[i] = L.mla_qk_g[96 + 8 * j + i]; }
#pragma unroll
    for (int i = 0; i < 4; ++i) { gqr[i] = L.mla_qk_g[64 + 4 * j + i] * QS; gkr[i] = L.mla_qk_g[96 + 64 + 4 * j + i];
        const int fi = 4 * (j & 3) + i; invf[i] = (float)(exp2(-(double)fi * (13.287712379549449 / 16.0)) * 0.15915494309189535); }
    bf16* QB = (bf16*)(ws + WS_QB); const bf16* KVR = (const bf16*)(ws + WS_KVR); const bf16* VCKR = (const bf16*)(ws + WS_VCKR); bf16* KB = (bf16*)(ws + WS_KB);
    for (int row0 = gw * 2; row0 < T; row0 += NGW * 2) {
        float posf[2]; U8 qn[2], kn[2]; v2u qw[2], kw[2];
#pragma unroll
        for (int rr = 0; rr < 2; ++rr) { const int row = row0 + rr; posf[rr] = (float)positions[row];
            const bf16* qrow = QB + (size_t)row * 768 + h * 96;
            qn[rr] = ld8bf(qrow + 8 * j); qw[rr] = *(const v2u*)(qrow + 64 + 4 * j);
            kn[rr] = ld8bf(KVR + (size_t)row * 1024 + h * 64 + 8 * j); kw[rr] = *(const v2u*)(VCKR + (size_t)row * 256 + 128 + 4 * j); }
#pragma unroll
        for (int rr = 0; rr < 2; ++rr) { const int row = row0 + rr;
            float cs[4], sn[4];
#pragma unroll
            for (int i = 0; i < 4; ++i) { const double tr = (double)posf[rr] * (double)invf[i]; const float fr = (float)(tr - floor(tr)); cs[i] = __builtin_amdgcn_cosf(fr); sn[i] = __builtin_amdgcn_sinf(fr); }
            bf16* qrow = QB + (size_t)row * 768 + h * 96;
            float qr_[4] = {bflo(qw[rr].x), bfhi(qw[rr].x), bflo(qw[rr].y), bfhi(qw[rr].y)}, qo[4];
#pragma unroll
            for (int i = 0; i < 4; ++i) { const float other = xor_getf<4>(qr_[i]); qo[i] = (j < 4) ? (qr_[i] * cs[i] - other * sn[i]) : (other * sn[i] + qr_[i] * cs[i]); }
            const float sq = ss8(qn[rr]) + (qo[0] * qo[0] + qo[1] * qo[1]) + (qo[2] * qo[2] + qo[3] * qo[3]);
            const float rq = 1.0f / sqrtf(grp8_sum(sq) * (1.0f / 96) + EPS);
#pragma unroll
            for (int i = 0; i < 8; ++i) qn[rr].f[i] *= rq * gqn[i];
            st8bf(qrow + 8 * j, qn[rr]);
            { v2u w; w.x = pk2(qo[0] * rq * gqr[0], qo[1] * rq * gqr[1]); w.y = pk2(qo[2] * rq * gqr[2], qo[3] * rq * gqr[3]); *(v2u*)(qrow + 64 + 4 * j) = w; }
            float kr_[4] = {bflo(kw[rr].x), bfhi(kw[rr].x), bflo(kw[rr].y), bfhi(kw[rr].y)}, ko[4];
#pragma unroll
            for (int i = 0; i < 4; ++i) { const float other = xor_getf<4>(kr_[i]); ko[i] = (j < 4) ? (kr_[i] * cs[i] - other * sn[i]) : (other * sn[i] + kr_[i] * cs[i]); }
            const float sk = ss8(kn[rr]) + (ko[0] * ko[0] + ko[1] * ko[1]) + (ko[2] * ko[2] + ko[3] * ko[3]);
            const float rk = 1.0f / sqrtf(grp8_sum(sk) * (1.0f / 96) + EPS);
#pragma unroll
            for (int i = 0; i < 8; ++i) kn[rr].f[i] *= rk * gkn[i];
            bf16* krow = KB + (size_t)row * 768 + h * 96;
            st8bf(krow + 8 * j, kn[rr]);
            { v2u w; w.x = pk2(ko[0] * rk * gkr[0], ko[1] * rk * gkr[1]); w.y = pk2(ko[2] * rk * gkr[2], ko[3] * rk * gkr[3]); *(v2u*)(krow + 64 + 4 * j) = w; } }
    }
}

__device__ __forceinline__ void p_tile_minmax(const Frame& F, unsigned char* ws, const int* positions) {
    int tid_ = threadIdx.x; asm volatile("" : "+v"(tid_)); const int lane = tid_ & 63;
    const int gw = F.vcu * NWAVES + F.wave, NGW = F.G * NWAVES;
    float* tmm = (float*)(ws + WS_TMM);
    for (int tl = gw; tl < T / 64; tl += NGW) {
        const float p = (float)positions[tl * 64 + lane];
        float hi = p, lo = -p;
        hi = xor_max<1>(hi); hi = xor_max<2>(hi); hi = xor_max<4>(hi); hi = xor_max<8>(hi); hi = xor_max<16>(hi); hi = xor_max<32>(hi);
        lo = xor_max<1>(lo); lo = xor_max<2>(lo); lo = xor_max<4>(lo); lo = xor_max<8>(lo); lo = xor_max<16>(lo); lo = xor_max<32>(lo);
        if (lane == 0) { tmm[tl * 2] = -lo; tmm[tl * 2 + 1] = hi; }
    }
}

__device__ __forceinline__ void p_h_to_fp8(const Frame& F, unsigned char* ws) {
    int tid_ = threadIdx.x; asm volatile("" : "+v"(tid_));
    const size_t gt = (size_t)(F.vcu * NWAVES * 64) + tid_, NGT = (size_t)F.G * NWAVES * 64;
    const v4u* src = (const v4u*)(ws + WS_H); v2u* dst = (v2u*)(ws + WS_H8);
    for (size_t i = gt; i < (size_t)T * DM / 8; i += NGT * 4) {
        v4u x[4];
#pragma unroll
        for (int k = 0; k < 4; ++k) if (i + k * NGT < (size_t)T * DM / 8) x[k] = src[i + k * NGT];
#pragma unroll
        for (int k = 0; k < 4; ++k) if (i + k * NGT < (size_t)T * DM / 8) {
            const f32x4 a0 = {bflo(x[k].x), bfhi(x[k].x), bflo(x[k].y), bfhi(x[k].y)}, a1 = {bflo(x[k].z), bfhi(x[k].z), bflo(x[k].w), bfhi(x[k].w)};
            const pg8::u32x2 w = pg8::pack8_fp8(a0, a1); v2u o; o.x = w.x; o.y = w.y; dst[i + k * NGT] = o; }
    }
}

namespace att {
__device__ __forceinline__ int crow(int r, int hi) { return (r & 3) + 8 * (r >> 2) + 4 * hi; }
#define ATT_SBAR() __builtin_amdgcn_sched_barrier(0)
typedef float f32x2_t __attribute__((ext_vector_type(2))); typedef __bf16 bf16x2_t __attribute__((ext_vector_type(2)));
__device__ __forceinline__ unsigned cvtpk(float lo, float hi) { f32x2_t v = {lo, hi}; bf16x2_t b = __builtin_convertvector(v, bf16x2_t); return __builtin_bit_cast(unsigned, b); }

struct Args {
    const bf16* Q; const bf16* K; const bf16* V;
    int pq, pk, pv;
    const int* pos;
    float slope2, sink2;
    float mfix;
};
typedef short v4i16_t __attribute__((ext_vector_type(4)));
__device__ __forceinline__ s16x4 vtr(const LAS unsigned char* p) { return __builtin_bit_cast(s16x4, __builtin_amdgcn_ds_read_tr16_b64_v4i16((LAS v4i16_t*)p)); }
__device__ __forceinline__ float max3f(float a, float b, float c) { return __builtin_fmaxf(__builtin_fmaxf(a, b), c); }
template <int DQK, int DV, int MODE, int ABL = 0>
__device__ __forceinline__ void attn_core(const Args& A, int q0, unsigned long long tmask, LAS unsigned char* lds, float (&res)[DV / 32][16]) {
    constexpr int KSTR = DQK * 2 + 16, KBYTES = 64 * KSTR, VBYTES = 64 * DV * 2, PBYTES = 256;
    constexpr int BUF = KBYTES + VBYTES + PBYTES;
    constexpr int CPR = DQK / 8, NKP = 64 * CPR, KP = (NKP + 511) / 512, VP = (64 * DV / 8) / 512, ND0 = DV / 32, NKS = DQK / 16;
    constexpr float THR = 6.0f;
    static_assert(2 * BUF + 8 * 256 <= ATT_STASH_OFF, "attention LDS");
    int tid_ = threadIdx.x; asm volatile("" : "+v"(tid_));
    const int tid = tid_, lane = tid & 63, wid = __builtin_amdgcn_readfirstlane(tid >> 6), r32 = lane & 31, hi = lane >> 5;
    LAS float* wsf = (LAS float*)(lds + 2 * BUF) + wid * 64;

    bf16x8 qr[NKS];
#pragma unroll
    for (int d0 = 0; d0 < NKS; ++d0) qr[d0] = *(const bf16x8*)(A.Q + (size_t)(q0 + wid * 32 + r32) * A.pq + d0 * 16 + hi * 8);
    float pqf = 0.f;
    if (MODE == 1) pqf = (float)A.pos[q0 + wid * 32 + r32];
    if (MODE == 2) pqf = (float)(q0 + wid * 32 + r32);

    f32x16 o[ND0];
#pragma unroll
    for (int d = 0; d < ND0; ++d)
#pragma unroll
        for (int r = 0; r < 16; ++r) o[d][r] = 0.f;
    float l_reg = (MODE == 2 && hi == 0) ? __builtin_amdgcn_exp2f(A.sink2 - A.mfix) : 0.f;
    f32x16 negm;
#pragma unroll
    for (int r = 0; r < 16; ++r) negm[r] = -A.mfix;

    bf16x8 sk[KP], sv[VP]; float spos = 0.f;
    unsigned gk_off[KP], lk_off[KP], gv_off[VP], lv_off[VP];
#pragma unroll
    for (int i = 0; i < KP; ++i) { const int p = tid + 512 * i, row = p / CPR, ch = p % CPR; gk_off[i] = (unsigned)(row * A.pk + ch * 8) * 2u; lk_off[i] = (unsigned)(row * KSTR + ch * 16); }
#pragma unroll
    for (int i = 0; i < VP; ++i) { const int p = tid + 512 * i, db = p >> 8, row = (p & 255) >> 2, c4 = p & 3; gv_off[i] = (unsigned)(row * A.pv + db * 32 + c4 * 8) * 2u;
        lv_off[i] = (unsigned)(KBYTES + db * 4096 + (row >> 4) * 1024 + (row & 15) * 64 + c4 * 16); }
#define ATT_SLOAD(t) do { const int k0_ = (t) * 64; const char* kb_ = (const char*)(A.K + (size_t)k0_ * A.pk); const char* vb_ = (const char*)(A.V + (size_t)k0_ * A.pv); \
    _Pragma("unroll") for (int i = 0; i < KP; ++i) { if (tid + 512 * i < NKP) sk[i] = *(const bf16x8*)(kb_ + gk_off[i]); } \
    _Pragma("unroll") for (int i = 0; i < VP; ++i) sv[i] = *(const bf16x8*)(vb_ + gv_off[i]); \
    if (MODE == 1) { if (tid < 64) spos = (float)A.pos[k0_ + tid]; } if (MODE == 2) { spos = (float)(k0_ + tid); } } while (0)
#define ATT_SWRITE(b) do { LAS unsigned char* base_ = lds + (b) * BUF; \
    _Pragma("unroll") for (int i = 0; i < KP; ++i) { if (tid + 512 * i < NKP) *(LAS bf16x8*)(base_ + lk_off[i]) = sk[i]; } \
    _Pragma("unroll") for (int i = 0; i < VP; ++i) *(LAS bf16x8*)(base_ + lv_off[i]) = sv[i]; \
    if (MODE != 0) { if (tid < 64) *(LAS float*)(base_ + KBYTES + VBYTES + tid * 4) = spos; } } while (0)
#define ATT_VRD(VF, d) do { const LAS unsigned char* vp_ = vbase + (d) * 4096; \
    _Pragma("unroll") for (int ks = 0; ks < 4; ++ks) { VF[2 * ks] = vtr(vp_ + ks * 1024); VF[2 * ks + 1] = vtr(vp_ + ks * 1024 + 512); } } while (0)
#define ATT_PK(L, H) (bf16x8){L[0], L[1], L[2], L[3], H[0], H[1], H[2], H[3]}
#define ATT_MMA(VF, d) do { _Pragma("unroll") for (int ks = 0; ks < 4; ++ks) { if (ABL == 2) o[d][ks] += __builtin_bit_cast(float, (int)pa[ks][0]) + __builtin_bit_cast(float, (int)VF[2 * ks][0] + (int)VF[2 * ks + 1][0]); else o[d] = __builtin_amdgcn_mfma_f32_32x32x16_bf16(pa[ks], ATT_PK(VF[2 * ks], VF[2 * ks + 1]), o[d], 0, 0, 0); } } while (0)

    int t = __builtin_ctzll(tmask); tmask &= tmask - 1;
    ATT_SLOAD(t); ATT_SWRITE(0); __syncthreads();
    for (int cur = 0;; cur ^= 1) {
        const bool more = tmask != 0ull; const int tn = more ? __builtin_ctzll(tmask) : 0; tmask &= tmask - 1;
        LAS unsigned char* bufp = lds + cur * BUF;
        if (more && ABL != 4) ATT_SLOAD(tn);
        f32x16 p0, p1;
        const LAS unsigned char* kb = bufp + r32 * KSTR + hi * 16;
#pragma unroll
        for (int d0 = 0; d0 < NKS; ++d0) {
            const bf16x8 b0 = *(const LAS bf16x8*)(kb + d0 * 32);
            const bf16x8 b1 = *(const LAS bf16x8*)(kb + 32 * KSTR + d0 * 32);
            if (ABL == 2) { if (d0 == 0) { p0 = negm; p1 = negm; } p0[d0] += __builtin_bit_cast(float, (int)b0[0]); p1[d0] += __builtin_bit_cast(float, (int)b1[0]); }
            else if (d0 == 0) { p0 = __builtin_amdgcn_mfma_f32_32x32x16_bf16(b0, qr[0], negm, 0, 0, 0); p1 = __builtin_amdgcn_mfma_f32_32x32x16_bf16(b1, qr[0], negm, 0, 0, 0); }
            else { p0 = __builtin_amdgcn_mfma_f32_32x32x16_bf16(b0, qr[d0], p0, 0, 0, 0); p1 = __builtin_amdgcn_mfma_f32_32x32x16_bf16(b1, qr[d0], p1, 0, 0, 0); }
        }
        const LAS unsigned char* vbase = bufp + KBYTES + ((lane >> 4) & 1) * 32 + (lane & 3) * 8 + (4 * hi + ((lane & 15) >> 2)) * 64;
        s16x4 vfa[8], vfb[8];
        ATT_VRD(vfa, 0);
        if (MODE != 0) {
            const LAS float* pk = (const LAS float*)(bufp + KBYTES + VBYTES);
#pragma unroll
            for (int g = 0; g < 4; ++g) {
                const f32x4 k0v = *(const LAS f32x4*)(pk + 8 * g + 4 * hi), k1v = *(const LAS f32x4*)(pk + 32 + 8 * g + 4 * hi);
#pragma unroll
                for (int i = 0; i < 4; ++i) {
                    const float d0f = fabsf(pqf - k0v[i]), d1f = fabsf(pqf - k1v[i]);
                    float s0 = fmaf(-A.slope2, d0f, p0[4 * g + i]), s1 = fmaf(-A.slope2, d1f, p1[4 * g + i]);
                    if (MODE == 2) { s0 = d0f <= 128.0f ? s0 : -1e30f; s1 = d1f <= 128.0f ? s1 : -1e30f; }
                    p0[4 * g + i] = s0; p1[4 * g + i] = s1;
                }
            }
        }
        float ps0 = 0.f, ps1 = 0.f, ps2 = 0.f, ps3 = 0.f;
#pragma unroll
        for (int r = 0; r < 16; r += 4) {
            if (ABL != 1) { p0[r] = __builtin_amdgcn_exp2f(p0[r]); p0[r + 1] = __builtin_amdgcn_exp2f(p0[r + 1]); p0[r + 2] = __builtin_amdgcn_exp2f(p0[r + 2]); p0[r + 3] = __builtin_amdgcn_exp2f(p0[r + 3]);
            p1[r] = __builtin_amdgcn_exp2f(p1[r]); p1[r + 1] = __builtin_amdgcn_exp2f(p1[r + 1]); p1[r + 2] = __builtin_amdgcn_exp2f(p1[r + 2]); p1[r + 3] = __builtin_amdgcn_exp2f(p1[r + 3]); }
            ps0 += p0[r] + p1[r]; ps1 += p0[r + 1] + p1[r + 1]; ps2 += p0[r + 2] + p1[r + 2]; ps3 += p0[r + 3] + p1[r + 3];
        }
        l_reg += (ps0 + ps1) + (ps2 + ps3);
        bf16x8 pa[4];
#pragma unroll
        for (int s = 0; s < 2; ++s) {
            v4u w0 = {cvtpk(p0[8 * s + 0], p0[8 * s + 1]), cvtpk(p0[8 * s + 2], p0[8 * s + 3]), cvtpk(p0[8 * s + 4], p0[8 * s + 5]), cvtpk(p0[8 * s + 6], p0[8 * s + 7])};
            v4u w1 = {cvtpk(p1[8 * s + 0], p1[8 * s + 1]), cvtpk(p1[8 * s + 2], p1[8 * s + 3]), cvtpk(p1[8 * s + 4], p1[8 * s + 5]), cvtpk(p1[8 * s + 6], p1[8 * s + 7])};
            pa[s] = __builtin_bit_cast(bf16x8, w0); pa[2 + s] = __builtin_bit_cast(bf16x8, w1);
        }
        if (ND0 == 2) { ATT_VRD(vfb, 1); ATT_MMA(vfa, 0); ATT_MMA(vfb, 1); }
        else { ATT_VRD(vfb, 1); ATT_MMA(vfa, 0); ATT_VRD(vfa, 2); ATT_MMA(vfb, 1); ATT_VRD(vfb, 3); ATT_MMA(vfa, 2); ATT_MMA(vfb, 3); }
        if (more && ABL != 4) ATT_SWRITE(cur ^ 1);
        if (ABL != 3) __syncthreads();
        if (!more) break;
        t = tn;
    }
#undef ATT_SLOAD
#undef ATT_SWRITE
#undef ATT_VRD
#undef ATT_PK
#undef ATT_MMA
    { const float lt = xor_add<32>(l_reg); if (hi == 0) wsf[32 + r32] = 1.0f / lt; }
    LDS_WAIT();
#pragma unroll
    for (int g = 0; g < 4; ++g) {
        const f32x4 l0 = *(const LAS f32x4*)(wsf + 32 + 8 * g + 4 * hi);
#pragma unroll
        for (int d = 0; d < ND0; ++d)
#pragma unroll
            for (int i = 0; i < 4; ++i) res[d][4 * g + i] = o[d][4 * g + i] * l0[i];
    }
    LDS_WAIT();
    __syncthreads();
}
template <int DQK, int DV, int ABL = 0>
__device__ __forceinline__ void attn_core_p(const Args& A, int q0, unsigned long long tmask, LAS unsigned char* lds, float (&res)[DV / 32][16]) {
    constexpr int KSTR = DQK * 2 + 16, KBYTES = 64 * KSTR, VBYTES = 64 * DV * 2;
    constexpr int CPR = DQK / 8, NKP = 64 * CPR, KP = (NKP + 511) / 512, VP = (64 * DV / 8) / 512, ND0 = DV / 32, NKS = DQK / 16;
    constexpr int KOFF = 0, VOFF = 2 * KBYTES, WOFF = VOFF + 3 * VBYTES;
    static_assert(WOFF + 8 * 256 <= ATT_STASH_OFF, "attention LDS");
    int tid_ = threadIdx.x; asm volatile("" : "+v"(tid_));
    const int tid = tid_, lane = tid & 63, wid = __builtin_amdgcn_readfirstlane(tid >> 6), r32 = lane & 31, hi = lane >> 5;
    LAS float* wsf = (LAS float*)(lds + WOFF) + wid * 64;
    bf16x8 qr[NKS];
#pragma unroll
    for (int d0 = 0; d0 < NKS; ++d0) qr[d0] = *(const bf16x8*)(A.Q + (size_t)(q0 + wid * 32 + r32) * A.pq + d0 * 16 + hi * 8);
    f32x16 o[ND0];
#pragma unroll
    for (int d = 0; d < ND0; ++d)
#pragma unroll
        for (int r = 0; r < 16; ++r) o[d][r] = 0.f;
    float l_reg = 0.f;
    f32x16 negm;
#pragma unroll
    for (int r = 0; r < 16; ++r) negm[r] = -A.mfix;
    bf16x8 sk[KP], sv[VP];
    unsigned gk_off[KP], lk_off[KP], gv_off[VP], lv_off[VP];
#pragma unroll
    for (int i = 0; i < KP; ++i) { const int p = tid + 512 * i, row = p / CPR, ch = p % CPR; gk_off[i] = (unsigned)(row * A.pk + ch * 8) * 2u; lk_off[i] = (unsigned)(row * KSTR + ch * 16); }
#pragma unroll
    for (int i = 0; i < VP; ++i) { const int p = tid + 512 * i, db = p >> 8, row = (p & 255) >> 2, c4 = p & 3; gv_off[i] = (unsigned)(row * A.pv + db * 32 + c4 * 8) * 2u;
        lv_off[i] = (unsigned)(db * 4096 + (row >> 4) * 1024 + (row & 15) * 64 + c4 * 16); }
#define ATP_SLOAD(t) do { const int k0_ = (t) * 64; const char* kb_ = (const char*)(A.K + (size_t)k0_ * A.pk); const char* vb_ = (const char*)(A.V + (size_t)k0_ * A.pv); \
    _Pragma("unroll") for (int i = 0; i < KP; ++i) { if (tid + 512 * i < NKP) sk[i] = *(const bf16x8*)(kb_ + gk_off[i]); } \
    _Pragma("unroll") for (int i = 0; i < VP; ++i) sv[i] = *(const bf16x8*)(vb_ + gv_off[i]); } while (0)
#define ATP_SWRITE(kslot, vslot) do { LAS unsigned char* kb_ = lds + KOFF + (kslot) * KBYTES; LAS unsigned char* vb_ = lds + VOFF + (vslot) * VBYTES; \
    _Pragma("unroll") for (int i = 0; i < KP; ++i) { if (tid + 512 * i < NKP) *(LAS bf16x8*)(kb_ + lk_off[i]) = sk[i]; } \
    _Pragma("unroll") for (int i = 0; i < VP; ++i) *(LAS bf16x8*)(vb_ + lv_off[i]) = sv[i]; } while (0)
#define ATP_QKT(P0, P1, kslot) do { const LAS unsigned char* kb_ = lds + KOFF + (kslot) * KBYTES + r32 * KSTR + hi * 16; \
    _Pragma("unroll") for (int d0 = 0; d0 < NKS; ++d0) { const bf16x8 b0_ = (ABL == 5 || ABL == 7) ? qr[d0] : *(const LAS bf16x8*)(kb_ + d0 * 32); const bf16x8 b1_ = (ABL == 5 || ABL == 7) ? qr[NKS - 1 - d0] : *(const LAS bf16x8*)(kb_ + 32 * KSTR + d0 * 32); \
        if (ABL == 2) { if (d0 == 0) { P0 = negm; P1 = negm; } P0[d0] += __builtin_bit_cast(float, (int)b0_[0]); P1[d0] += __builtin_bit_cast(float, (int)b1_[0]); } \
        else if (d0 == 0) { P0 = __builtin_amdgcn_mfma_f32_32x32x16_bf16(b0_, qr[0], negm, 0, 0, 0); P1 = __builtin_amdgcn_mfma_f32_32x32x16_bf16(b1_, qr[0], negm, 0, 0, 0); } \
        else { P0 = __builtin_amdgcn_mfma_f32_32x32x16_bf16(b0_, qr[d0], P0, 0, 0, 0); P1 = __builtin_amdgcn_mfma_f32_32x32x16_bf16(b1_, qr[d0], P1, 0, 0, 0); } } } while (0)
#define ATP_SOFT(P0, P1) do { \
    if (ABL != 1) { _Pragma("unroll") for (int r = 0; r < 16; ++r) { P0[r] = __builtin_amdgcn_exp2f(P0[r]); P1[r] = __builtin_amdgcn_exp2f(P1[r]); } } \
    _Pragma("unroll") for (int s_ = 0; s_ < 2; ++s_) { \
        v4u w0_ = {cvtpk(P0[8 * s_ + 0], P0[8 * s_ + 1]), cvtpk(P0[8 * s_ + 2], P0[8 * s_ + 3]), cvtpk(P0[8 * s_ + 4], P0[8 * s_ + 5]), cvtpk(P0[8 * s_ + 6], P0[8 * s_ + 7])}; \
        v4u w1_ = {cvtpk(P1[8 * s_ + 0], P1[8 * s_ + 1]), cvtpk(P1[8 * s_ + 2], P1[8 * s_ + 3]), cvtpk(P1[8 * s_ + 4], P1[8 * s_ + 5]), cvtpk(P1[8 * s_ + 6], P1[8 * s_ + 7])}; \
        pa[s_] = __builtin_bit_cast(bf16x8, w0_); pa[2 + s_] = __builtin_bit_cast(bf16x8, w1_); } } while (0)
#define ATP_SUM(P0, P1) do { float ps0 = 0.f, ps1 = 0.f, ps2 = 0.f, ps3 = 0.f; \
    _Pragma("unroll") for (int r = 0; r < 16; r += 4) { ps0 += P0[r] + P1[r]; ps1 += P0[r + 1] + P1[r + 1]; ps2 += P0[r + 2] + P1[r + 2]; ps3 += P0[r + 3] + P1[r + 3]; } \
    l_reg += (ps0 + ps1) + (ps2 + ps3); } while (0)
#define ATP_VRD(VF, vslot, d) do { const LAS unsigned char* vp_ = lds + VOFF + (vslot) * VBYTES + vlane + (d) * 4096; \
    _Pragma("unroll") for (int ks = 0; ks < 4; ++ks) { if (ABL == 6 || ABL == 7) { VF[2 * ks] = __builtin_bit_cast(s16x4, (unsigned long long)(uintptr_t)vp_ * (ks + 1)); VF[2 * ks + 1] = __builtin_bit_cast(s16x4, (unsigned long long)(uintptr_t)vp_ * (ks + 5)); } else { VF[2 * ks] = vtr(vp_ + ks * 1024); VF[2 * ks + 1] = vtr(vp_ + ks * 1024 + 512); } } } while (0)
#define ATP_PK(L, H) (bf16x8){L[0], L[1], L[2], L[3], H[0], H[1], H[2], H[3]}
#define ATP_MMA(VF, d) do { _Pragma("unroll") for (int ks = 0; ks < 4; ++ks) { if (ABL == 2) o[d][ks] += __builtin_bit_cast(float, (int)pa[ks][0]) + __builtin_bit_cast(float, (int)VF[2 * ks][0] + (int)VF[2 * ks + 1][0]); else o[d] = __builtin_amdgcn_mfma_f32_32x32x16_bf16(pa[ks], ATP_PK(VF[2 * ks], VF[2 * ks + 1]), o[d], 0, 0, 0); } } while (0)
#define ATP_STEP(PC0, PC1, PN0, PN1) do { \
    const bool more1_ = have_next; const int tn1_ = t_next; \
    const bool more2_ = tmask != 0ull; const int tn2_ = more2_ ? __builtin_ctzll(tmask) : 0; tmask &= tmask - 1; \
    if (more2_ && ABL != 4) ATP_SLOAD(tn2_); \
    s16x4 vfa[8], vfb[8]; ATP_VRD(vfa, vc, 0); \
    ATP_QKT(PN0, PN1, more1_ ? (kc ^ 1) : kc);     \
    ATP_SOFT(PC0, PC1); ATT_SBAR();        \
    static_assert(ND0 == 2, "pipelined core: DV = 64"); \
    ATP_VRD(vfb, vc, 1); ATP_SUM(PC0, PC1); ATP_MMA(vfa, 0); ATP_MMA(vfb, 1); ATT_SBAR();     \
    if (more2_ && ABL != 4) ATP_SWRITE(kc, vc == 0 ? 2 : vc - 1); \
    if (ABL != 3) __syncthreads(); \
    kc ^= 1; vc = (vc == 2) ? 0 : vc + 1; have_next = more2_; t_next = tn2_; (void)tn1_; \
    if (!more1_) goto atp_done; } while (0)

    const int vlane = ((lane >> 4) & 1) * 32 + (lane & 3) * 8 + (4 * hi + ((lane & 15) >> 2)) * 64;
    f32x16 pA0, pA1, pB0, pB1; bf16x8 pa[4];
    int kc = 0, vc = 0;
    { const int t_a = __builtin_ctzll(tmask); tmask &= tmask - 1; ATP_SLOAD(t_a); ATP_SWRITE(0, 0); }
    bool have_next = tmask != 0ull; int t_next = have_next ? __builtin_ctzll(tmask) : 0; tmask &= tmask - 1;
    __syncthreads();
    if (have_next) ATP_SLOAD(t_next);
    ATP_QKT(pA0, pA1, 0);
    if (have_next) ATP_SWRITE(1, 1);
    __syncthreads();
    for (;;) { ATP_STEP(pA0, pA1, pB0, pB1); ATP_STEP(pB0, pB1, pA0, pA1); }
atp_done:
#undef ATP_SLOAD
#undef ATP_SWRITE
#undef ATP_QKT
#undef ATP_SOFT
#undef ATP_SUM
#undef ATP_VRD
#undef ATP_PK
#undef ATP_MMA
#undef ATP_STEP
    { const float lt = xor_add<32>(l_reg); if (hi == 0) wsf[32 + r32] = 1.0f / lt; }
    LDS_WAIT();
#pragma unroll
    for (int g = 0; g < 4; ++g) {
        const f32x4 l0 = *(const LAS f32x4*)(wsf + 32 + 8 * g + 4 * hi);
#pragma unroll
        for (int d = 0; d < ND0; ++d)
#pragma unroll
            for (int i = 0; i < 4; ++i) res[d][4 * g + i] = o[d][4 * g + i] * l0[i];
    }
    LDS_WAIT();
    __syncthreads();
}
template <int DQK, int DV, int MODE, int RB, bool QL = false>
__device__ __forceinline__ void attn_core_rb(const Args& A, int q0, unsigned long long tmask, LAS unsigned char* lds, float (&res)[RB][DV / 32][16]) {
    constexpr int KSTR = DQK * 2 + 16, KBYTES = 64 * KSTR, VBYTES = 64 * DV * 2, PBYTES = 256;
    constexpr int BUF = KBYTES + VBYTES + PBYTES;
    constexpr int CPR = DQK / 8, NKP = 64 * CPR, KP = (NKP + 511) / 512, VP = (64 * DV / 8) / 512, ND0 = DV / 32, NKS = DQK / 16;
    static_assert(2 * BUF + 8 * 256 + (QL ? 8 * RB * NKS * 1024 : 0) <= (QL ? ATT_NXT_OFF : ATT_STASH_OFF), "attention LDS");
    int tid_ = threadIdx.x; asm volatile("" : "+v"(tid_));
    const int tid = tid_, lane = tid & 63, wid = __builtin_amdgcn_readfirstlane(tid >> 6), r32 = lane & 31, hi = lane >> 5;
    LAS float* wsf = (LAS float*)(lds + 2 * BUF) + wid * 64;
    LAS bf16x8* qlds = (LAS bf16x8*)(lds + 2 * BUF + 8 * 256) + wid * (RB * NKS * 64) + lane;
    const int wrow = q0 + wid * (32 * RB);

    bf16x8 qr[RB][NKS]; float pqf[RB];
#pragma unroll
    for (int rb = 0; rb < RB; ++rb) {
#pragma unroll
        for (int d0 = 0; d0 < NKS; ++d0) { qr[rb][d0] = *(const bf16x8*)(A.Q + (size_t)(wrow + rb * 32 + r32) * A.pq + d0 * 16 + hi * 8); if (QL) qlds[(rb * NKS + d0) * 64] = qr[rb][d0]; }
        pqf[rb] = 0.f;
        if (MODE == 1) pqf[rb] = (float)A.pos[wrow + rb * 32 + r32];
        if (MODE == 2) pqf[rb] = (float)(wrow + rb * 32 + r32);
    }
    f32x16 o[RB][ND0]; float l_reg[RB];
#pragma unroll
    for (int rb = 0; rb < RB; ++rb) { l_reg[rb] = (MODE == 2 && hi == 0) ? __builtin_amdgcn_exp2f(A.sink2) : 0.f;
#pragma unroll
        for (int d = 0; d < ND0; ++d)
#pragma unroll
            for (int r = 0; r < 16; ++r) o[rb][d][r] = 0.f; }

    bf16x8 sk[KP], sv[VP]; float spos = 0.f;
    unsigned gk_off[KP], lk_off[KP], gv_off[VP], lv_off[VP];
#pragma unroll
    for (int i = 0; i < KP; ++i) { const int p = tid + 512 * i, row = p / CPR, ch = p % CPR; gk_off[i] = (unsigned)(row * A.pk + ch * 8) * 2u; lk_off[i] = (unsigned)(row * KSTR + ch * 16); }
#pragma unroll
    for (int i = 0; i < VP; ++i) { const int p = tid + 512 * i, db = p >> 8, row = (p & 255) >> 2, c4 = p & 3; gv_off[i] = (unsigned)(row * A.pv + db * 32 + c4 * 8) * 2u;
        lv_off[i] = (unsigned)(KBYTES + db * 4096 + (row >> 4) * 1024 + (row & 15) * 64 + c4 * 16); }
#define ATR_SLOAD(t) do { const int k0_ = (t) * 64; const char* kb_ = (const char*)(A.K + (size_t)k0_ * A.pk); const char* vb_ = (const char*)(A.V + (size_t)k0_ * A.pv); \
    _Pragma("unroll") for (int i = 0; i < KP; ++i) { if (tid + 512 * i < NKP) sk[i] = *(const bf16x8*)(kb_ + gk_off[i]); } \
    _Pragma("unroll") for (int i = 0; i < VP; ++i) sv[i] = *(const bf16x8*)(vb_ + gv_off[i]); \
    if (MODE == 1) { if (tid < 64) spos = (float)A.pos[k0_ + tid]; } if (MODE == 2) { spos = (float)(k0_ + tid); } } while (0)
#define ATR_SWRITE(b) do { LAS unsigned char* base_ = lds + (b) * BUF; \
    _Pragma("unroll") for (int i = 0; i < KP; ++i) { if (tid + 512 * i < NKP) *(LAS bf16x8*)(base_ + lk_off[i]) = sk[i]; } \
    _Pragma("unroll") for (int i = 0; i < VP; ++i) *(LAS bf16x8*)(base_ + lv_off[i]) = sv[i]; \
    if (MODE != 0) { if (tid < 64) *(LAS float*)(base_ + KBYTES + VBYTES + tid * 4) = spos; } } while (0)
#define ATR_VRD(VF, d) do { const LAS unsigned char* vp_ = vbase + (d) * 4096; \
    _Pragma("unroll") for (int ks = 0; ks < 4; ++ks) { VF[2 * ks] = vtr(vp_ + ks * 1024); VF[2 * ks + 1] = vtr(vp_ + ks * 1024 + 512); } } while (0)
#define ATR_PK(L, H) (bf16x8){L[0], L[1], L[2], L[3], H[0], H[1], H[2], H[3]}
#define ATR_MMA(VF, d) do { _Pragma("unroll") for (int rb = 0; rb < RB; ++rb) _Pragma("unroll") for (int ks = 0; ks < 4; ++ks) \
        o[rb][d] = __builtin_amdgcn_mfma_f32_32x32x16_bf16(pa[rb][ks], ATR_PK(VF[2 * ks], VF[2 * ks + 1]), o[rb][d], 0, 0, 0); } while (0)

    int t = __builtin_ctzll(tmask); tmask &= tmask - 1;
    ATR_SLOAD(t); ATR_SWRITE(0); __syncthreads();
    for (int cur = 0;; cur ^= 1) {
        const bool more = tmask != 0ull; const int tn = more ? __builtin_ctzll(tmask) : 0; tmask &= tmask - 1;
        LAS unsigned char* bufp = lds + cur * BUF;
        if (more) ATR_SLOAD(tn);
        const LAS unsigned char* vbase = bufp + KBYTES + ((lane >> 4) & 1) * 32 + (lane & 3) * 8 + (4 * hi + ((lane & 15) >> 2)) * 64;
        s16x4 vfa[8], vfb[8];
        if (RB == 1) ATR_VRD(vfa, 0);
        bf16x8 pa[RB][4];
        f32x16 pp[RB][2];
        {
            const f32x16 zero = {0.f, 0.f, 0.f, 0.f, 0.f, 0.f, 0.f, 0.f, 0.f, 0.f, 0.f, 0.f, 0.f, 0.f, 0.f, 0.f};
            const LAS unsigned char* kb = bufp + r32 * KSTR + hi * 16;
#pragma unroll
            for (int d0 = 0; d0 < NKS; ++d0) {
                const bf16x8 b0 = *(const LAS bf16x8*)(kb + d0 * 32);
                const bf16x8 b1 = *(const LAS bf16x8*)(kb + 32 * KSTR + d0 * 32);
#pragma unroll
                for (int rb = 0; rb < RB; ++rb) {
                    const bf16x8 qf = QL ? qlds[(rb * NKS + d0) * 64] : qr[rb][d0];
                    if (d0 == 0) { pp[rb][0] = __builtin_amdgcn_mfma_f32_32x32x16_bf16(b0, qf, zero, 0, 0, 0); pp[rb][1] = __builtin_amdgcn_mfma_f32_32x32x16_bf16(b1, qf, zero, 0, 0, 0); }
                    else { pp[rb][0] = __builtin_amdgcn_mfma_f32_32x32x16_bf16(b0, qf, pp[rb][0], 0, 0, 0); pp[rb][1] = __builtin_amdgcn_mfma_f32_32x32x16_bf16(b1, qf, pp[rb][1], 0, 0, 0); }
                }
            }
        }
#pragma unroll
        for (int rb = 0; rb < RB; ++rb) {
            f32x16 p0 = pp[rb][0], p1 = pp[rb][1];
            if (MODE != 0) {
                const LAS float* pk = (const LAS float*)(bufp + KBYTES + VBYTES);
#pragma unroll
                for (int g = 0; g < 4; ++g) {
                    const f32x4 k0v = *(const LAS f32x4*)(pk + 8 * g + 4 * hi), k1v = *(const LAS f32x4*)(pk + 32 + 8 * g + 4 * hi);
#pragma unroll
                    for (int i = 0; i < 4; ++i) {
                        const float d0f = fabsf(pqf[rb] - k0v[i]), d1f = fabsf(pqf[rb] - k1v[i]);
                        float s0 = fmaf(-A.slope2, d0f, p0[4 * g + i]), s1 = fmaf(-A.slope2, d1f, p1[4 * g + i]);
                        if (MODE == 2) { s0 = d0f <= 128.0f ? s0 : -1e30f; s1 = d1f <= 128.0f ? s1 : -1e30f; }
                        p0[4 * g + i] = s0; p1[4 * g + i] = s1;
                    }
                }
            }
#pragma unroll
            for (int r = 0; r < 16; ++r) { p0[r] = __builtin_amdgcn_exp2f(p0[r]); p1[r] = __builtin_amdgcn_exp2f(p1[r]); }
            float ps0 = p0[0] + p1[0], ps1 = p0[1] + p1[1], ps2 = p0[2] + p1[2], ps3 = p0[3] + p1[3];
#pragma unroll
            for (int r = 4; r < 16; r += 4) { ps0 += p0[r] + p1[r]; ps1 += p0[r + 1] + p1[r + 1]; ps2 += p0[r + 2] + p1[r + 2]; ps3 += p0[r + 3] + p1[r + 3]; }
            l_reg[rb] += (ps0 + ps1) + (ps2 + ps3);
#pragma unroll
            for (int s = 0; s < 2; ++s) {
                v4u w0 = {cvtpk(p0[8 * s + 0], p0[8 * s + 1]), cvtpk(p0[8 * s + 2], p0[8 * s + 3]), cvtpk(p0[8 * s + 4], p0[8 * s + 5]), cvtpk(p0[8 * s + 6], p0[8 * s + 7])};
                v4u w1 = {cvtpk(p1[8 * s + 0], p1[8 * s + 1]), cvtpk(p1[8 * s + 2], p1[8 * s + 3]), cvtpk(p1[8 * s + 4], p1[8 * s + 5]), cvtpk(p1[8 * s + 6], p1[8 * s + 7])};
                pa[rb][s] = __builtin_bit_cast(bf16x8, w0); pa[rb][2 + s] = __builtin_bit_cast(bf16x8, w1);
            }
        }
        if (RB == 2) { _Pragma("unroll") for (int d = 0; d < ND0; ++d) { ATR_VRD(vfa, d); ATR_MMA(vfa, d); } (void)vfb; }
        else if (ND0 == 2) { ATR_VRD(vfb, 1); ATR_MMA(vfa, 0); ATR_MMA(vfb, 1); }
        else { ATR_VRD(vfb, 1); ATR_MMA(vfa, 0); ATR_VRD(vfa, 2); ATR_MMA(vfb, 1); ATR_VRD(vfb, 3); ATR_MMA(vfa, 2); ATR_MMA(vfb, 3); }
        if (more) ATR_SWRITE(cur ^ 1);
        __syncthreads();
        if (!more) break;
        t = tn;
    }
#undef ATR_SLOAD
#undef ATR_SWRITE
#undef ATR_VRD
#undef ATR_PK
#undef ATR_MMA
#pragma unroll
    for (int rb = 0; rb < RB; ++rb) { const float lt = xor_add<32>(l_reg[rb]); if (hi == 0) wsf[rb * 32 + r32] = 1.0f / lt; }
    LDS_WAIT();
#pragma unroll
    for (int rb = 0; rb < RB; ++rb)
#pragma unroll
        for (int g = 0; g < 4; ++g) {
            const f32x4 l0 = *(const LAS f32x4*)(wsf + rb * 32 + 8 * g + 4 * hi);
#pragma unroll
            for (int d = 0; d < ND0; ++d)
#pragma unroll
                for (int i = 0; i < 4; ++i) res[rb][d][4 * g + i] = o[rb][d][4 * g + i] * l0[i];
        }
    LDS_WAIT();
    __syncthreads();
}
template <int DQK, int DV, int MODE, int RB, bool QL = false>
__device__ __forceinline__ void attn_core_pd2(const Args& A, int q0, unsigned long long tmask, LAS unsigned char* lds, float (&res)[RB][DV / 32][16]) {
    constexpr int KSTR = DQK * 2 + 16, KBYTES = 64 * KSTR, VBYTES = 64 * DV * 2, PBYTES = 256;
    constexpr int BUF = KBYTES + VBYTES + PBYTES;
    constexpr int CPR = DQK / 8, NKP = 64 * CPR, KP = (NKP + 511) / 512, VP = (64 * DV / 8) / 512, ND0 = DV / 32, NKS = DQK / 16;
    static_assert(2 * BUF + 8 * 256 + (QL ? 8 * RB * NKS * 1024 : 0) <= (QL ? ATT_NXT_OFF : ATT_STASH_OFF), "attention LDS");
    int tid_ = threadIdx.x; asm volatile("" : "+v"(tid_));
    const int tid = tid_, lane = tid & 63, wid = __builtin_amdgcn_readfirstlane(tid >> 6), r32 = lane & 31, hi = lane >> 5;
    LAS float* wsf = (LAS float*)(lds + 2 * BUF) + wid * 64;
    LAS bf16x8* qlds = (LAS bf16x8*)(lds + 2 * BUF + 8 * 256) + wid * (RB * NKS * 64) + lane;
    const int wrow = q0 + wid * (32 * RB);

    bf16x8 qr[RB][NKS]; float pqf[RB];
#pragma unroll
    for (int rb = 0; rb < RB; ++rb) {
#pragma unroll
        for (int d0 = 0; d0 < NKS; ++d0) { qr[rb][d0] = *(const bf16x8*)(A.Q + (size_t)(wrow + rb * 32 + r32) * A.pq + d0 * 16 + hi * 8); if (QL) qlds[(rb * NKS + d0) * 64] = qr[rb][d0]; }
        pqf[rb] = 0.f;
        if (MODE == 1) pqf[rb] = (float)A.pos[wrow + rb * 32 + r32];
        if (MODE == 2) pqf[rb] = (float)(wrow + rb * 32 + r32);
    }
    f32x16 o[RB][ND0]; float l_reg[RB];
#pragma unroll
    for (int rb = 0; rb < RB; ++rb) { l_reg[rb] = (MODE == 2 && hi == 0) ? __builtin_amdgcn_exp2f(A.sink2) : 0.f;
#pragma unroll
        for (int d = 0; d < ND0; ++d)
#pragma unroll
            for (int r = 0; r < 16; ++r) o[rb][d][r] = 0.f; }

    bf16x8 skA[KP], svA[VP], skB[KP], svB[VP]; float sposA = 0.f, sposB = 0.f;
    unsigned gk_off[KP], lk_off[KP], gv_off[VP], lv_off[VP];
#pragma unroll
    for (int i = 0; i < KP; ++i) { const int p = tid + 512 * i, row = p / CPR, ch = p % CPR; gk_off[i] = (unsigned)(row * A.pk + ch * 8) * 2u; lk_off[i] = (unsigned)(row * KSTR + ch * 16); }
#pragma unroll
    for (int i = 0; i < VP; ++i) { const int p = tid + 512 * i, db = p >> 8, row = (p & 255) >> 2, c4 = p & 3; gv_off[i] = (unsigned)(row * A.pv + db * 32 + c4 * 8) * 2u;
        lv_off[i] = (unsigned)(KBYTES + db * 4096 + (row >> 4) * 1024 + (row & 15) * 64 + c4 * 16); }
#define ATR_SLOAD(t, sk, sv, spos) do { const int k0_ = (t) * 64; const char* kb_ = (const char*)(A.K + (size_t)k0_ * A.pk); const char* vb_ = (const char*)(A.V + (size_t)k0_ * A.pv); \
    _Pragma("unroll") for (int i = 0; i < KP; ++i) { if (tid + 512 * i < NKP) sk[i] = *(const bf16x8*)(kb_ + gk_off[i]); } \
    _Pragma("unroll") for (int i = 0; i < VP; ++i) sv[i] = *(const bf16x8*)(vb_ + gv_off[i]); \
    if (MODE == 1) { if (tid < 64) spos = (float)A.pos[k0_ + tid]; } if (MODE == 2) { spos = (float)(k0_ + tid); } } while (0)
#define ATR_SWRITE(b, sk, sv, spos) do { LAS unsigned char* base_ = lds + (b) * BUF; \
    _Pragma("unroll") for (int i = 0; i < KP; ++i) { if (tid + 512 * i < NKP) *(LAS bf16x8*)(base_ + lk_off[i]) = sk[i]; } \
    _Pragma("unroll") for (int i = 0; i < VP; ++i) *(LAS bf16x8*)(base_ + lv_off[i]) = sv[i]; \
    if (MODE != 0) { if (tid < 64) *(LAS float*)(base_ + KBYTES + VBYTES + tid * 4) = spos; } } while (0)
#define ATR_VRD(VF, d) do { const LAS unsigned char* vp_ = vbase + (d) * 4096; \
    _Pragma("unroll") for (int ks = 0; ks < 4; ++ks) { VF[2 * ks] = vtr(vp_ + ks * 1024); VF[2 * ks + 1] = vtr(vp_ + ks * 1024 + 512); } } while (0)
#define ATR_PK(L, H) (bf16x8){L[0], L[1], L[2], L[3], H[0], H[1], H[2], H[3]}
#define ATR_MMA(VF, d) do { _Pragma("unroll") for (int rb = 0; rb < RB; ++rb) _Pragma("unroll") for (int ks = 0; ks < 4; ++ks) \
        o[rb][d] = __builtin_amdgcn_mfma_f32_32x32x16_bf16(pa[rb][ks], ATR_PK(VF[2 * ks], VF[2 * ks + 1]), o[rb][d], 0, 0, 0); } while (0)

    int cur = 0;
    const int t0 = __builtin_ctzll(tmask); tmask &= tmask - 1;
    bool more1 = tmask != 0ull; const int t1 = more1 ? __builtin_ctzll(tmask) : 0; tmask &= tmask - 1;
    bool more2 = tmask != 0ull; int t2 = more2 ? __builtin_ctzll(tmask) : 0; tmask &= tmask - 1;
    ATR_SLOAD(t0, skA, svA, sposA); ATR_SWRITE(0, skA, svA, sposA);
    if (more1) ATR_SLOAD(t1, skB, svB, sposB);
    __syncthreads();
    for (;;) {
        {
        LAS unsigned char* bufp = lds + cur * BUF;
        if (more2) ATR_SLOAD(t2, skA, svA, sposA);
        const LAS unsigned char* vbase = bufp + KBYTES + ((lane >> 4) & 1) * 32 + (lane & 3) * 8 + (4 * hi + ((lane & 15) >> 2)) * 64;
        s16x4 vfa[8], vfb[8];
        if (RB == 1) ATR_VRD(vfa, 0);
        bf16x8 pa[RB][4];
        f32x16 pp[RB][2];
        {
            const f32x16 zero = {0.f, 0.f, 0.f, 0.f, 0.f, 0.f, 0.f, 0.f, 0.f, 0.f, 0.f, 0.f, 0.f, 0.f, 0.f, 0.f};
            const LAS unsigned char* kb = bufp + r32 * KSTR + hi * 16;
#pragma unroll
            for (int d0 = 0; d0 < NKS; ++d0) {
                const bf16x8 b0 = *(const LAS bf16x8*)(kb + d0 * 32);
                const bf16x8 b1 = *(const LAS bf16x8*)(kb + 32 * KSTR + d0 * 32);
#pragma unroll
                for (int rb = 0; rb < RB; ++rb) {
                    const bf16x8 qf = QL ? qlds[(rb * NKS + d0) * 64] : qr[rb][d0];
                    if (d0 == 0) { pp[rb][0] = __builtin_amdgcn_mfma_f32_32x32x16_bf16(b0, qf, zero, 0, 0, 0); pp[rb][1] = __builtin_amdgcn_mfma_f32_32x32x16_bf16(b1, qf, zero, 0, 0, 0); }
                    else { pp[rb][0] = __builtin_amdgcn_mfma_f32_32x32x16_bf16(b0, qf, pp[rb][0], 0, 0, 0); pp[rb][1] = __builtin_amdgcn_mfma_f32_32x32x16_bf16(b1, qf, pp[rb][1], 0, 0, 0); }
                }
            }
        }
#pragma unroll
        for (int rb = 0; rb < RB; ++rb) {
            f32x16 p0 = pp[rb][0], p1 = pp[rb][1];
            if (MODE != 0) {
                const LAS float* pk = (const LAS float*)(bufp + KBYTES + VBYTES);
#pragma unroll
                for (int g = 0; g < 4; ++g) {
                    const f32x4 k0v = *(const LAS f32x4*)(pk + 8 * g + 4 * hi), k1v = *(const LAS f32x4*)(pk + 32 + 8 * g + 4 * hi);
#pragma unroll
                    for (int i = 0; i < 4; ++i) {
                        const float d0f = fabsf(pqf[rb] - k0v[i]), d1f = fabsf(pqf[rb] - k1v[i]);
                        float s0 = fmaf(-A.slope2, d0f, p0[4 * g + i]), s1 = fmaf(-A.slope2, d1f, p1[4 * g + i]);
                        if (MODE == 2) { s0 = d0f <= 128.0f ? s0 : -1e30f; s1 = d1f <= 128.0f ? s1 : -1e30f; }
                        p0[4 * g + i] = s0; p1[4 * g + i] = s1;
                    }
                }
            }
#pragma unroll
            for (int r = 0; r < 16; ++r) { p0[r] = __builtin_amdgcn_exp2f(p0[r]); p1[r] = __builtin_amdgcn_exp2f(p1[r]); }
            float ps0 = p0[0] + p1[0], ps1 = p0[1] + p1[1], ps2 = p0[2] + p1[2], ps3 = p0[3] + p1[3];
#pragma unroll
            for (int r = 4; r < 16; r += 4) { ps0 += p0[r] + p1[r]; ps1 += p0[r + 1] + p1[r + 1]; ps2 += p0[r + 2] + p1[r + 2]; ps3 += p0[r + 3] + p1[r + 3]; }
            l_reg[rb] += (ps0 + ps1) + (ps2 + ps3);
#pragma unroll
            for (int s = 0; s < 2; ++s) {
                v4u w0 = {cvtpk(p0[8 * s + 0], p0[8 * s + 1]), cvtpk(p0[8 * s + 2], p0[8 * s + 3]), cvtpk(p0[8 * s + 4], p0[8 * s + 5]), cvtpk(p0[8 * s + 6], p0[8 * s + 7])};
                v4u w1 = {cvtpk(p1[8 * s + 0], p1[8 * s + 1]), cvtpk(p1[8 * s + 2], p1[8 * s + 3]), cvtpk(p1[8 * s + 4], p1[8 * s + 5]), cvtpk(p1[8 * s + 6], p1[8 * s + 7])};
                pa[rb][s] = __builtin_bit_cast(bf16x8, w0); pa[rb][2 + s] = __builtin_bit_cast(bf16x8, w1);
            }
        }
        if (RB == 2) { _Pragma("unroll") for (int d = 0; d < ND0; ++d) { ATR_VRD(vfa, d); ATR_MMA(vfa, d); } (void)vfb; }
        else if (ND0 == 2) { ATR_VRD(vfb, 1); ATR_MMA(vfa, 0); ATR_MMA(vfb, 1); }
        else { ATR_VRD(vfb, 1); ATR_MMA(vfa, 0); ATR_VRD(vfa, 2); ATR_MMA(vfb, 1); ATR_VRD(vfb, 3); ATR_MMA(vfa, 2); ATR_MMA(vfb, 3); }
        if (more1) ATR_SWRITE(cur ^ 1, skB, svB, sposB);
        __syncthreads();
        if (!more1) break;
        cur ^= 1; more1 = more2; more2 = tmask != 0ull; t2 = more2 ? __builtin_ctzll(tmask) : 0; tmask &= tmask - 1;
        }
        {
        LAS unsigned char* bufp = lds + cur * BUF;
        if (more2) ATR_SLOAD(t2, skB, svB, sposB);
        const LAS unsigned char* vbase = bufp + KBYTES + ((lane >> 4) & 1) * 32 + (lane & 3) * 8 + (4 * hi + ((lane & 15) >> 2)) * 64;
        s16x4 vfa[8], vfb[8];
        if (RB == 1) ATR_VRD(vfa, 0);
        bf16x8 pa[RB][4];
        f32x16 pp[RB][2];
        {
            const f32x16 zero = {0.f, 0.f, 0.f, 0.f, 0.f, 0.f, 0.f, 0.f, 0.f, 0.f, 0.f, 0.f, 0.f, 0.f, 0.f, 0.f};
            const LAS unsigned char* kb = bufp + r32 * KSTR + hi * 16;
#pragma unroll
            for (int d0 = 0; d0 < NKS; ++d0) {
                const bf16x8 b0 = *(const LAS bf16x8*)(kb + d0 * 32);
                const bf16x8 b1 = *(const LAS bf16x8*)(kb + 32 * KSTR + d0 * 32);
#pragma unroll
                for (int rb = 0; rb < RB; ++rb) {
                    const bf16x8 qf = QL ? qlds[(rb * NKS + d0) * 64] : qr[rb][d0];
                    if (d0 == 0) { pp[rb][0] = __builtin_amdgcn_mfma_f32_32x32x16_bf16(b0, qf, zero, 0, 0, 0); pp[rb][1] = __builtin_amdgcn_mfma_f32_32x32x16_bf16(b1, qf, zero, 0, 0, 0); }
                    else { pp[rb][0] = __builtin_amdgcn_mfma_f32_32x32x16_bf16(b0, qf, pp[rb][0], 0, 0, 0); pp[rb][1] = __builtin_amdgcn_mfma_f32_32x32x16_bf16(b1, qf, pp[rb][1], 0, 0, 0); }
                }
            }
        }
#pragma unroll
        for (int rb = 0; rb < RB; ++rb) {
            f32x16 p0 = pp[rb][0], p1 = pp[rb][1];
            if (MODE != 0) {
                const LAS float* pk = (const LAS float*)(bufp + KBYTES + VBYTES);
#pragma unroll
                for (int g = 0; g < 4; ++g) {
                    const f32x4 k0v = *(const LAS f32x4*)(pk + 8 * g + 4 * hi), k1v = *(const LAS f32x4*)(pk + 32 + 8 * g + 4 * hi);
#pragma unroll
                    for (int i = 0; i < 4; ++i) {
                        const float d0f = fabsf(pqf[rb] - k0v[i]), d1f = fabsf(pqf[rb] - k1v[i]);
                        float s0 = fmaf(-A.slope2, d0f, p0[4 * g + i]), s1 = fmaf(-A.slope2, d1f, p1[4 * g + i]);
                        if (MODE == 2) { s0 = d0f <= 128.0f ? s0 : -1e30f; s1 = d1f <= 128.0f ? s1 : -1e30f; }
                        p0[4 * g + i] = s0; p1[4 * g + i] = s1;
                    }
                }
            }
#pragma unroll
            for (int r = 0; r < 16; ++r) { p0[r] = __builtin_amdgcn_exp2f(p0[r]); p1[r] = __builtin_amdgcn_exp2f(p1[r]); }
            float ps0 = p0[0] + p1[0], ps1 = p0[1] + p1[1], ps2 = p0[2] + p1[2], ps3 = p0[3] + p1[3];
#pragma unroll
            for (int r = 4; r < 16; r += 4) { ps0 += p0[r] + p1[r]; ps1 += p0[r + 1] + p1[r + 1]; ps2 += p0[r + 2] + p1[r + 2]; ps3 += p0[r + 3] + p1[r + 3]; }
            l_reg[rb] += (ps0 + ps1) + (ps2 + ps3);
#pragma unroll
            for (int s = 0; s < 2; ++s) {
                v4u w0 = {cvtpk(p0[8 * s + 0], p0[8 * s + 1]), cvtpk(p0[8 * s + 2], p0[8 * s + 3]), cvtpk(p0[8 * s + 4], p0[8 * s + 5]), cvtpk(p0[8 * s + 6], p0[8 * s + 7])};
                v4u w1 = {cvtpk(p1[8 * s + 0], p1[8 * s + 1]), cvtpk(p1[8 * s + 2], p1[8 * s + 3]), cvtpk(p1[8 * s + 4], p1[8 * s + 5]), cvtpk(p1[8 * s + 6], p1[8 * s + 7])};
                pa[rb][s] = __builtin_bit_cast(bf16x8, w0); pa[rb][2 + s] = __builtin_bit_cast(bf16x8, w1);
            }
        }
        if (RB == 2) { _Pragma("unroll") for (int d = 0; d < ND0; ++d) { ATR_VRD(vfa, d); ATR_MMA(vfa, d); } (void)vfb; }
        else if (ND0 == 2) { ATR_VRD(vfb, 1); ATR_MMA(vfa, 0); ATR_MMA(vfb, 1); }
        else { ATR_VRD(vfb, 1); ATR_MMA(vfa, 0); ATR_VRD(vfa, 2); ATR_MMA(vfb, 1); ATR_VRD(vfb, 3); ATR_MMA(vfa, 2); ATR_MMA(vfb, 3); }
        if (more1) ATR_SWRITE(cur ^ 1, skA, svA, sposA);
        __syncthreads();
        if (!more1) break;
        cur ^= 1; more1 = more2; more2 = tmask != 0ull; t2 = more2 ? __builtin_ctzll(tmask) : 0; tmask &= tmask - 1;
        }
    }
#undef ATR_SLOAD
#undef ATR_SWRITE
#undef ATR_VRD
#undef ATR_PK
#undef ATR_MMA
#pragma unroll
    for (int rb = 0; rb < RB; ++rb) { const float lt = xor_add<32>(l_reg[rb]); if (hi == 0) wsf[rb * 32 + r32] = 1.0f / lt; }
    LDS_WAIT();
#pragma unroll
    for (int rb = 0; rb < RB; ++rb)
#pragma unroll
        for (int g = 0; g < 4; ++g) {
            const f32x4 l0 = *(const LAS f32x4*)(wsf + rb * 32 + 8 * g + 4 * hi);
#pragma unroll
            for (int d = 0; d < ND0; ++d)
#pragma unroll
                for (int i = 0; i < 4; ++i) res[rb][d][4 * g + i] = o[rb][d][4 * g + i] * l0[i];
        }
    LDS_WAIT();
    __syncthreads();
}
template <int DQK, int DV, int MODE, int RB, bool QL = false>
__device__ __forceinline__ void attn_core_pp(const Args& A, int q0, unsigned long long tmask, LAS unsigned char* lds, float (&res)[RB][DV / 32][16]) {
    constexpr int KSTR = DQK * 2 + 16, KBYTES = 64 * KSTR, VBYTES = 64 * DV * 2;
    constexpr int OFF_V = 2 * KBYTES, OFF_PK = OFF_V + 2 * VBYTES, OFF_WS = OFF_PK + 4 * 256, OFF_Q = OFF_WS + 8 * 256;
    constexpr int CPR = DQK / 8, NKP = 64 * CPR, KP = (NKP + 511) / 512, VP = (64 * DV / 8) / 512, ND0 = DV / 32, NKS = DQK / 16;
    static_assert(OFF_Q + (QL ? 8 * RB * NKS * 1024 : 0) <= (QL ? ATT_NXT_OFF : ATT_STASH_OFF), "attention LDS");
    int tid_ = threadIdx.x; asm volatile("" : "+v"(tid_));
    const int tid = tid_, lane = tid & 63, wid = __builtin_amdgcn_readfirstlane(tid >> 6), r32 = lane & 31, hi = lane >> 5;
    LAS float* wsf = (LAS float*)(lds + OFF_WS) + wid * 64;
    LAS bf16x8* qlds = (LAS bf16x8*)(lds + OFF_Q) + wid * (RB * NKS * 64) + lane;
    const int wrow = q0 + wid * (32 * RB);

    bf16x8 qr[RB][NKS]; float pqf[RB];
#pragma unroll
    for (int rb = 0; rb < RB; ++rb) {
#pragma unroll
        for (int d0 = 0; d0 < NKS; ++d0) { qr[rb][d0] = *(const bf16x8*)(A.Q + (size_t)(wrow + rb * 32 + r32) * A.pq + d0 * 16 + hi * 8); if (QL) qlds[(rb * NKS + d0) * 64] = qr[rb][d0]; }
        pqf[rb] = 0.f;
        if (MODE == 1) pqf[rb] = (float)A.pos[wrow + rb * 32 + r32];
        if (MODE == 2) pqf[rb] = (float)(wrow + rb * 32 + r32);
    }
    f32x16 o[RB][ND0]; float l_reg[RB];
#pragma unroll
    for (int rb = 0; rb < RB; ++rb) { l_reg[rb] = (MODE == 2 && hi == 0) ? __builtin_amdgcn_exp2f(A.sink2) : 0.f;
#pragma unroll
        for (int d = 0; d < ND0; ++d)
#pragma unroll
            for (int r = 0; r < 16; ++r) o[rb][d][r] = 0.f; }

    bf16x8 sk[KP], sv[VP]; float spos = 0.f;
    unsigned gk_off[KP], lk_off[KP], gv_off[VP], lv_off[VP];
#pragma unroll
    for (int i = 0; i < KP; ++i) { const int p = tid + 512 * i, row = p / CPR, ch = p % CPR; gk_off[i] = (unsigned)(row * A.pk + ch * 8) * 2u; lk_off[i] = (unsigned)(row * KSTR + ch * 16); }
#pragma unroll
    for (int i = 0; i < VP; ++i) { const int p = tid + 512 * i, db = p >> 8, row = (p & 255) >> 2, c4 = p & 3; gv_off[i] = (unsigned)(row * A.pv + db * 32 + c4 * 8) * 2u;
        lv_off[i] = (unsigned)(OFF_V + db * 4096 + (row >> 4) * 1024 + (row & 15) * 64 + c4 * 16); }
#define APP_LOADK(t) do { const int k0_ = (t) * 64; const char* kb_ = (const char*)(A.K + (size_t)k0_ * A.pk); \
    _Pragma("unroll") for (int i = 0; i < KP; ++i) { if (tid + 512 * i < NKP) sk[i] = *(const bf16x8*)(kb_ + gk_off[i]); } \
    if (MODE == 1) { if (tid < 64) spos = (float)A.pos[k0_ + tid]; } if (MODE == 2) { spos = (float)(k0_ + tid); } } while (0)
#define APP_LOADV(t) do { const char* vb_ = (const char*)(A.V + (size_t)((t) * 64) * A.pv); \
    _Pragma("unroll") for (int i = 0; i < VP; ++i) sv[i] = *(const bf16x8*)(vb_ + gv_off[i]); } while (0)
#define APP_WRITEK(kb, pr) do { LAS unsigned char* base_ = lds + (kb) * KBYTES; \
    _Pragma("unroll") for (int i = 0; i < KP; ++i) { if (tid + 512 * i < NKP) *(LAS bf16x8*)(base_ + lk_off[i]) = sk[i]; } \
    if (MODE != 0) { if (tid < 64) *(LAS float*)(lds + OFF_PK + (pr) * 256 + tid * 4) = spos; } } while (0)
#define APP_WRITEV(vb) do { LAS unsigned char* base_ = lds + (vb) * VBYTES; \
    _Pragma("unroll") for (int i = 0; i < VP; ++i) *(LAS bf16x8*)(base_ + lv_off[i]) = sv[i]; } while (0)
#define APP_BAR() do { ATT_SBAR(); __builtin_amdgcn_s_barrier(); ATT_SBAR(); } while (0)
#define APP_VRD(VF, d) do { const LAS unsigned char* vp_ = vbase + (d) * 4096; \
    _Pragma("unroll") for (int ks = 0; ks < 4; ++ks) { VF[2 * ks] = vtr(vp_ + ks * 1024); VF[2 * ks + 1] = vtr(vp_ + ks * 1024 + 512); } } while (0)
#define APP_PK(L, H) (bf16x8){L[0], L[1], L[2], L[3], H[0], H[1], H[2], H[3]}
#define APP_MMA(VF, d) do { _Pragma("unroll") for (int rb = 0; rb < RB; ++rb) _Pragma("unroll") for (int ks = 0; ks < 4; ++ks) \
        o[rb][d] = __builtin_amdgcn_mfma_f32_32x32x16_bf16(pa[rb][ks], APP_PK(VF[2 * ks], VF[2 * ks + 1]), o[rb][d], 0, 0, 0); } while (0)
#define APP_QKT(kbuf) do { const f32x16 zero = {0.f, 0.f, 0.f, 0.f, 0.f, 0.f, 0.f, 0.f, 0.f, 0.f, 0.f, 0.f, 0.f, 0.f, 0.f, 0.f}; \
    const LAS unsigned char* kb = lds + (kbuf) * KBYTES + r32 * KSTR + hi * 16; \
    _Pragma("unroll") for (int d0 = 0; d0 < NKS; ++d0) { \
        const bf16x8 b0 = *(const LAS bf16x8*)(kb + d0 * 32); const bf16x8 b1 = *(const LAS bf16x8*)(kb + 32 * KSTR + d0 * 32); \
        _Pragma("unroll") for (int rb = 0; rb < RB; ++rb) { const bf16x8 qf = QL ? qlds[(rb * NKS + d0) * 64] : qr[rb][d0]; \
            if (d0 == 0) { pp[rb][0] = __builtin_amdgcn_mfma_f32_32x32x16_bf16(b0, qf, zero, 0, 0, 0); pp[rb][1] = __builtin_amdgcn_mfma_f32_32x32x16_bf16(b1, qf, zero, 0, 0, 0); } \
            else { pp[rb][0] = __builtin_amdgcn_mfma_f32_32x32x16_bf16(b0, qf, pp[rb][0], 0, 0, 0); pp[rb][1] = __builtin_amdgcn_mfma_f32_32x32x16_bf16(b1, qf, pp[rb][1], 0, 0, 0); } } } } while (0)
#define APP_POP(tv, hv) do { hv = tmask != 0ull; tv = hv ? __builtin_ctzll(tmask) : 0; tmask &= tmask - 1ull; } while (0)

    int ta, tb, tc; bool ha, hb, hc;
    APP_POP(ta, ha); APP_POP(tb, hb); APP_POP(tc, hc); (void)ha;
    APP_LOADK(ta); APP_WRITEK(0, 0);
    if (hb) APP_LOADK(tb);
    APP_LOADV(ta);
    LDS_WAIT();
    if (wid >= 4) APP_BAR();
    APP_BAR();
    f32x16 pp[RB][2]; bf16x8 pa[RB][4];
    __builtin_amdgcn_s_setprio(1);
    APP_QKT(0);
    if (hb) APP_WRITEK(1, 1);
    APP_WRITEV(0);
    __builtin_amdgcn_s_setprio(0);
    for (int j = 0;; ++j) {
        LDS_WAIT(); APP_BAR();
        if (hc) APP_LOADK(tc);
        if (hb) APP_LOADV(tb);
#pragma unroll
        for (int rb = 0; rb < RB; ++rb) {
            f32x16 p0 = pp[rb][0], p1 = pp[rb][1];
            if (MODE != 0) {
                const LAS float* pk = (const LAS float*)(lds + OFF_PK + (j & 3) * 256);
#pragma unroll
                for (int g = 0; g < 4; ++g) {
                    const f32x4 k0v = *(const LAS f32x4*)(pk + 8 * g + 4 * hi), k1v = *(const LAS f32x4*)(pk + 32 + 8 * g + 4 * hi);
#pragma unroll
                    for (int i = 0; i < 4; ++i) {
                        const float d0f = fabsf(pqf[rb] - k0v[i]), d1f = fabsf(pqf[rb] - k1v[i]);
                        float s0 = fmaf(-A.slope2, d0f, p0[4 * g + i]), s1 = fmaf(-A.slope2, d1f, p1[4 * g + i]);
                        if (MODE == 2) { s0 = d0f <= 128.0f ? s0 : -1e30f; s1 = d1f <= 128.0f ? s1 : -1e30f; }
                        p0[4 * g + i] = s0; p1[4 * g + i] = s1;
                    }
                }
            }
#pragma unroll
            for (int r = 0; r < 16; ++r) { p0[r] = __builtin_amdgcn_exp2f(p0[r]); p1[r] = __builtin_amdgcn_exp2f(p1[r]); }
            float ps0 = p0[0] + p1[0], ps1 = p0[1] + p1[1], ps2 = p0[2] + p1[2], ps3 = p0[3] + p1[3];
#pragma unroll
            for (int r = 4; r < 16; r += 4) { ps0 += p0[r] + p1[r]; ps1 += p0[r + 1] + p1[r + 1]; ps2 += p0[r + 2] + p1[r + 2]; ps3 += p0[r + 3] + p1[r + 3]; }
            l_reg[rb] += (ps0 + ps1) + (ps2 + ps3);
#pragma unroll
            for (int s = 0; s < 2; ++s) {
                v4u w0 = {cvtpk(p0[8 * s + 0], p0[8 * s + 1]), cvtpk(p0[8 * s + 2], p0[8 * s + 3]), cvtpk(p0[8 * s + 4], p0[8 * s + 5]), cvtpk(p0[8 * s + 6], p0[8 * s + 7])};
                v4u w1 = {cvtpk(p1[8 * s + 0], p1[8 * s + 1]), cvtpk(p1[8 * s + 2], p1[8 * s + 3]), cvtpk(p1[8 * s + 4], p1[8 * s + 5]), cvtpk(p1[8 * s + 6], p1[8 * s + 7])};
                pa[rb][s] = __builtin_bit_cast(bf16x8, w0); pa[rb][2 + s] = __builtin_bit_cast(bf16x8, w1);
            }
        }
        asm volatile("" ::: "memory"); APP_BAR();
        __builtin_amdgcn_s_setprio(1);
        {
            const LAS unsigned char* vbase = lds + OFF_V + (j & 1) * VBYTES + ((lane >> 4) & 1) * 32 + (lane & 3) * 8 + (4 * hi + ((lane & 15) >> 2)) * 64;
            s16x4 vfa[8], vfb[8];
            if (RB == 2) { _Pragma("unroll") for (int d = 0; d < ND0; ++d) { APP_VRD(vfa, d); APP_MMA(vfa, d); } (void)vfb; }
            else if (ND0 == 2) { APP_VRD(vfa, 0); APP_VRD(vfb, 1); APP_MMA(vfa, 0); APP_MMA(vfb, 1); }
            else { APP_VRD(vfa, 0); APP_VRD(vfb, 1); APP_MMA(vfa, 0); APP_VRD(vfa, 2); APP_MMA(vfb, 1); APP_VRD(vfb, 3); APP_MMA(vfa, 2); APP_MMA(vfb, 3); }
        }
        if (!hb) break;
        APP_QKT((j + 1) & 1);
        if (hc) APP_WRITEK(j & 1, (j + 2) & 3);
        APP_WRITEV((j + 1) & 1);
        __builtin_amdgcn_s_setprio(0);
        hb = hc; tb = tc; APP_POP(tc, hc);
    }
    __builtin_amdgcn_s_setprio(0);
    if (wid < 4) APP_BAR();
#undef APP_LOADK
#undef APP_LOADV
#undef APP_WRITEK
#undef APP_WRITEV
#undef APP_BAR
#undef APP_VRD
#undef APP_PK
#undef APP_MMA
#undef APP_QKT
#undef APP_POP
#pragma unroll
    for (int rb = 0; rb < RB; ++rb) { const float lt = xor_add<32>(l_reg[rb]); if (hi == 0) wsf[rb * 32 + r32] = 1.0f / lt; }
    LDS_WAIT();
#pragma unroll
    for (int rb = 0; rb < RB; ++rb)
#pragma unroll
        for (int g = 0; g < 4; ++g) {
            const f32x4 l0 = *(const LAS f32x4*)(wsf + rb * 32 + 8 * g + 4 * hi);
#pragma unroll
            for (int d = 0; d < ND0; ++d)
#pragma unroll
                for (int i = 0; i < 4; ++i) res[rb][d][4 * g + i] = o[rb][d][4 * g + i] * l0[i];
        }
    LDS_WAIT();
    __syncthreads();
}
template <int ND0> __device__ __forceinline__ void store_rows(const float (&res)[ND0][16], bf16* O, int po, int row0, int lane) {
    asm volatile("" : "+v"(lane));
    const int r32 = lane & 31, hi = lane >> 5;
    bf16* Ow = O + (size_t)row0 * po + r32;
#pragma unroll
    for (int r = 0; r < 16; ++r) { const int orow = crow(r, hi);
#pragma unroll
        for (int d = 0; d < ND0; ++d) Ow[(size_t)orow * po + d * 32] = (bf16)(cvtpk(res[d][r], 0.f) & 0xffffu); }
}
template <int ND0> __device__ __forceinline__ void store_res(const float (&res)[ND0][16], bf16* O, int po, int q0) {
    const int tid = threadIdx.x, lane = tid & 63, wid = __builtin_amdgcn_readfirstlane(tid >> 6), r32 = lane & 31, hi = lane >> 5;
    bf16* Ow = O + (size_t)(q0 + wid * 32) * po + r32;
#pragma unroll
    for (int r = 0; r < 16; ++r) { const int orow = crow(r, hi);
#pragma unroll
        for (int d = 0; d < ND0; ++d) Ow[(size_t)orow * po + d * 32] = (bf16)(cvtpk(res[d][r], 0.f) & 0xffffu); }
}
}

#ifndef ATT_CORE
#define ATT_CORE attn_core_rb
#endif
#ifndef ATT_CORE_A
#define ATT_CORE_A attn_core_rb
#endif

__device__ __forceinline__ float lam_init_of(int layer) { return layer == 0 ? 0.2f : 0.35550906759096184f; }
template <bool DRY> __device__ __forceinline__ void att_sec_A(const Frame& F, const float* diff_qk_g, const float* diff_lambda, const float* diff_out_g, unsigned char* ws, const int* positions, int layer) {
    int tid_ = threadIdx.x; asm volatile("" : "+v"(tid_)); const int lane = tid_ & 63, r32 = lane & 31;
    LAS unsigned char* lds = F.lds + RING_OFF;
    const float* lp = diff_lambda;
    const float s1 = wave_sum(lp[lane] * lp[64 + lane]), s2 = wave_sum(lp[128 + lane] * lp[192 + lane]);
    const float li = lam_init_of(layer);
    const float lam = __expf(s1) - __expf(s2) + li;
    const float osc = 1.0f - li;
    float gq = fabsf(diff_qk_g[lane]), gk = fabsf(diff_qk_g[64 + lane]);
    gq = xor_max<1>(gq); gq = xor_max<2>(gq); gq = xor_max<4>(gq); gq = xor_max<8>(gq); gq = xor_max<16>(gq); gq = xor_max<32>(gq);
    gk = xor_max<1>(gk); gk = xor_max<2>(gk); gk = xor_max<4>(gk); gk = xor_max<8>(gk); gk = xor_max<16>(gk); gk = xor_max<32>(gk);
    const float reach = 2.0f * (8.0f * gq * gk * 1.01f) + 30.0f;
    const float* tmm = (const float*)(ws + WS_TMM);
    constexpr int NU = NB * 16 * 4; const int per = (NU + F.G - 1) / F.G;
    for (int u = F.vcu * per; u < (F.vcu + 1) * per && u < NU; ++u) {
        const int h = u & 3, bq = u >> 2, b = bq >> 4, qb = bq & 15;
        const size_t rb = (size_t)b * SEQ;
        const float slope = exp2f(-2.0f * (float)(h + 1));
        unsigned long long tmask;
        { const float* tq = tmm + (size_t)(b * 64 + qb * 4) * 2;
          const float qlo = fminf(fminf(tq[0], tq[2]), fminf(tq[4], tq[6])), qhi = fmaxf(fmaxf(tq[1], tq[3]), fmaxf(tq[5], tq[7]));
          const float klo = tmm[(size_t)(b * 64 + lane) * 2], khi = tmm[(size_t)(b * 64 + lane) * 2 + 1];
          const float gap = fmaxf(fmaxf(klo - qhi, qlo - khi), 0.f);
          tmask = __ballot(gap * slope <= reach); }
        att::Args A;
        A.pq = 512; A.pk = 512; A.pv = 512; A.pos = positions + rb; A.slope2 = slope * LOG2E; A.sink2 = 0.f;
        A.V = (const bf16*)(ws + WS_VA) + rb * 512 + h * 128;
        LAS unsigned* stash = (LAS unsigned*)(lds + ATT_STASH_OFF) + F.wave * 2048 + lane;
        {
            A.Q = (const bf16*)(ws + WS_QA) + rb * 512 + h * 128; A.K = (const bf16*)(ws + WS_KA) + rb * 512 + h * 64;
            float r0[1][4][16];
            att::ATT_CORE_A<64, 128, 1, 1>(A, qb * 256, tmask, lds, r0);
#pragma unroll
            for (int d = 0; d < 4; ++d)
#pragma unroll
                for (int r = 0; r < 8; ++r) stash[(d * 8 + r) * 64] = att::cvtpk(r0[0][d][2 * r], r0[0][d][2 * r + 1]);
        }
        float res[1][4][16];
        A.Q = (const bf16*)(ws + WS_QA) + rb * 512 + h * 128 + 64; A.K = (const bf16*)(ws + WS_KA) + rb * 512 + (4 + h) * 64;
        att::ATT_CORE_A<64, 128, 1, 1>(A, qb * 256, tmask, lds, res);
        float gcol[4];
#pragma unroll
        for (int d = 0; d < 4; ++d) gcol[d] = diff_out_g[d * 32 + r32] * osc;
#pragma unroll
        for (int r = 0; r < 16; ++r) {
            float s = 0.f;
#pragma unroll
            for (int d = 0; d < 4; ++d) { const unsigned w = stash[(d * 8 + (r >> 1)) * 64]; const float a0 = (r & 1) ? bfhi(w) : bflo(w); const float v = a0 - lam * res[0][d][r]; res[0][d][r] = v; s += v * v; }
            s = xor_add<1>(s); s = xor_add<2>(s); s = xor_add<4>(s); s = xor_add<8>(s); s = xor_add<16>(s);
            const float rs = 1.0f / sqrtf(s * (1.0f / 128) + EPS);
#pragma unroll
            for (int d = 0; d < 4; ++d) res[0][d][r] *= rs * gcol[d];
        }
        att::store_rows<4>(res[0], (bf16*)(ws + (DRY ? WS_OB : WS_QA)) + rb * 512 + h * 128, 512, qb * 256 + F.wave * 32, lane);
    }
}
template <bool DRY> __device__ __forceinline__ void att_sec_C(const Frame& F, const float* swa_sink, unsigned char* ws) {
    int tid_ = threadIdx.x; asm volatile("" : "+v"(tid_)); const int lane = tid_ & 63;
    LAS unsigned char* lds = F.lds + RING_OFF;
    constexpr int NU = NB * 8 * 8; const int per = (NU + F.G - 1) / F.G;
    for (int u = F.vcu * per; u < (F.vcu + 1) * per && u < NU; ++u) {
        const int b = u >> 6, hh = (u >> 3) & 7, qb = u & 7, g = hh >> 2;
        const size_t rb = (size_t)b * SEQ;
        att::Args A;
        A.Q = (const bf16*)(ws + WS_QC) + rb * 512 + hh * 64; A.pq = 512;
        A.K = (const bf16*)(ws + WS_CQKC) + rb * 512 + 384 + g * 64; A.pk = 512;
        A.V = (const bf16*)(ws + WS_VCKR) + rb * 256 + g * 64; A.pv = 256;
        A.pos = nullptr; A.slope2 = exp2f(-(float)(hh + 1)) * LOG2E; A.sink2 = swa_sink[hh] * LOG2E;
        const int q0 = qb * 512; const int k_lo = q0 - 128 < 0 ? 0 : q0 - 128, k_hi = q0 + 512 + 128 > SEQ ? SEQ : q0 + 512 + 128;
        const int tl = k_lo / 64, th = k_hi / 64;
        const unsigned long long tmask = (th >= 64 ? ~0ull : ((1ull << th) - 1ull)) & ~((1ull << tl) - 1ull);
        float res[2][2][16];
        att::ATT_CORE<64, 64, 2, 2, true>(A, q0, tmask, lds, res);
        bf16* O = (bf16*)(ws + (DRY ? WS_OB : WS_QC)) + rb * 512 + hh * 64;
        att::store_rows<2>(res[0], O, 512, q0 + F.wave * 64, lane); att::store_rows<2>(res[1], O, 512, q0 + F.wave * 64 + 32, lane);
    }
}
template <bool DRY> __device__ __forceinline__ void att_sec_B(const Frame& F, unsigned char* ws, int layer) {
    int tid_ = threadIdx.x; asm volatile("" : "+v"(tid_)); const int tid = tid_, lane = tid & 63;
    LAS unsigned char* lds = F.lds + RING_OFF;
    constexpr int NU = NB * 8 * 8;
    unsigned* qbase = (unsigned*)(ws + WS_CTL) + 65536 + (layer * 2 + (DRY ? 1 : 0)) * 8 * 64;
    LAS int* nxt = (LAS int*)(F.lds + ATT_NXT_OFF);
    const int ngrp = 8, per_grp = NU / 8, myq = (F.vcu * 8) / F.G;
    int qi = 0;
    for (;;) {
        if (tid == 0) { int u_ = -1;
            while (qi < ngrp) { const int q = (myq + qi) % ngrp; const unsigned v = __hip_atomic_fetch_add(qbase + q * 64, 1u, __ATOMIC_RELAXED, __HIP_MEMORY_SCOPE_AGENT);
                if (v < (unsigned)per_grp) { u_ = q * per_grp + (int)v; break; } ++qi; }
            nxt[0] = u_; nxt[1] = qi; }
        __syncthreads();
        const int u = __builtin_amdgcn_readfirstlane(nxt[0]); qi = __builtin_amdgcn_readfirstlane(nxt[1]);
        __syncthreads();
        if (u < 0) break;
        const int b = u >> 6, h = (u >> 3) & 7, qb = u & 7;
        const size_t rb = (size_t)b * SEQ;
        att::Args A;
        A.Q = (const bf16*)(ws + WS_QB) + rb * 768 + h * 96; A.pq = 768;
        A.K = (const bf16*)(ws + WS_KB) + rb * 768 + h * 96; A.pk = 768;
        A.V = (const bf16*)(ws + WS_KVR) + rb * 1024 + 512 + h * 64; A.pv = 1024;
        A.pos = nullptr; A.slope2 = 0.f; A.sink2 = 0.f;
        float res[2][2][16];
        att::ATT_CORE<96, 64, 0, 2, true>(A, qb * 512, ~0ull, lds, res);
        bf16* O = (bf16*)(ws + WS_OB) + rb * 512 + h * 64;
        att::store_rows<2>(res[0], O, 512, qb * 512 + F.wave * 64, lane); att::store_rows<2>(res[1], O, 512, qb * 512 + F.wave * 64 + 32, lane);
    }
}
__device__ __forceinline__ void p_attention(const Frame& F, const float* diff_qk_g, const float* diff_lambda, const float* diff_out_g, const float* swa_sink, unsigned char* ws, const int* positions, int layer) {
#if defined(PROBE_SEC_A)
    att_sec_A<true>(F, diff_qk_g, diff_lambda, diff_out_g, ws, positions, layer);
#elif defined(PROBE_SEC_B)
    att_sec_B<true>(F, ws, layer);
#elif defined(PROBE_SEC_C)
    att_sec_C<true>(F, swa_sink, ws);
#endif
#ifndef SKIP_A
    att_sec_A<false>(F, diff_qk_g, diff_lambda, diff_out_g, ws, positions, layer);
#endif
#ifndef SKIP_C
    att_sec_C<false>(F, swa_sink, ws);
#endif
#ifndef SKIP_B
    att_sec_B<false>(F, ws, layer);
#endif
}

#ifdef NAIVE_ATTN
template <int DQK, int DV, int MODE>
__device__ __forceinline__ void naive_row(const bf16* Q, const bf16* K, int pk, const bf16* V, int pv, const int* pos, int t, float slope2, float sink2, int lane, float (&out)[DV / 64]) {
    float m = -1e30f, l = 0.f, acc[DV];
#pragma unroll
    for (int d = 0; d < DV; ++d) acc[d] = 0.f;
    if (MODE == 2 && lane == 0) { m = sink2; l = 1.f; }
    const float pqf = MODE == 1 ? (float)pos[t] : (float)t;
    int k_lo = 0, k_hi = SEQ;
    if (MODE == 2) { k_lo = t - 128 < 0 ? 0 : t - 128; k_hi = t + 129 > SEQ ? SEQ : t + 129; }
    for (int k = k_lo + lane; k < k_hi; k += 64) {
        const bf16* kr = K + (size_t)k * pk; float s = 0.f;
#pragma unroll
        for (int d = 0; d < DQK; d += 2) { const unsigned w = *(const unsigned*)(kr + d); const unsigned qw = *(const volatile unsigned*)(Q + d); s = fmaf(bflo(qw), bflo(w), s); s = fmaf(bfhi(qw), bfhi(w), s); }
        if (MODE == 1) s -= slope2 * fabsf(pqf - (float)pos[k]);
        if (MODE == 2) s -= slope2 * fabsf(pqf - (float)k);
        const float mn = fmaxf(m, s), a = exp2f(m - mn), p = exp2f(s - mn);
        l = l * a + p; m = mn;
        const bf16* vr = V + (size_t)k * pv;
#pragma unroll
        for (int d = 0; d < DV; d += 2) { const unsigned w = *(const unsigned*)(vr + d); acc[d] = fmaf(p, bflo(w), acc[d] * a); acc[d + 1] = fmaf(p, bfhi(w), acc[d + 1] * a); }
    }
    float M = m;
#pragma unroll
    for (int o = 1; o < 64; o <<= 1) M = fmaxf(M, __shfl_xor(M, o));
    const float sc = exp2f(m - M);
    const float L = wave_sum(l * sc);
#pragma unroll
    for (int d = 0; d < DV; ++d) { const float v = wave_sum(acc[d] * sc) / L; if ((d & 63) == lane) out[d >> 6] = v; }
}
__device__ __forceinline__ void p_attention_naive(int vcu, int wave, int G, const float* diff_lambda, const float* diff_out_g, const float* swa_sink, unsigned char* ws, const int* positions, int layer) {
    int tid_ = threadIdx.x; asm volatile("" : "+v"(tid_)); const int lane = tid_ & 63;
    const int gw = vcu * NWAVES + wave, NGW = G * NWAVES;
    const float* lp = diff_lambda;
    const float s1 = wave_sum(lp[lane] * lp[64 + lane]), s2 = wave_sum(lp[128 + lane] * lp[192 + lane]);
    const float li = layer == 0 ? 0.2f : 0.35550906759096184f;
    const float lam = __expf(s1) - __expf(s2) + li, osc = 1.0f - li;
    for (int it = gw; it < T * 4; it += NGW) {
        const int row = it >> 2, h = it & 3, b = row >> 12, t = row & 4095; const size_t rb = (size_t)b * SEQ;
        bf16* Qr = (bf16*)(ws + WS_QA) + (size_t)row * 512 + h * 128;
        float o0[2], o1[2];
        naive_row<64, 128, 1>(Qr, (const bf16*)(ws + WS_KA) + rb * 512 + h * 64, 512, (const bf16*)(ws + WS_VA) + rb * 512 + h * 128, 512, positions + rb, t, exp2f(-2.0f * (float)(h + 1)) * LOG2E, 0.f, lane, o0);
        naive_row<64, 128, 1>(Qr + 64, (const bf16*)(ws + WS_KA) + rb * 512 + (4 + h) * 64, 512, (const bf16*)(ws + WS_VA) + rb * 512 + h * 128, 512, positions + rb, t, exp2f(-2.0f * (float)(h + 1)) * LOG2E, 0.f, lane, o1);
        const float v0 = o0[0] - lam * o1[0], v1 = o0[1] - lam * o1[1];
        const float rs = 1.0f / sqrtf(wave_sum(v0 * v0 + v1 * v1) * (1.0f / 128) + EPS);
        Qr[lane] = (bf16)(pk2(v0 * rs * diff_out_g[lane] * osc, 0.f) & 0xffffu); Qr[64 + lane] = (bf16)(pk2(v1 * rs * diff_out_g[64 + lane] * osc, 0.f) & 0xffffu);
    }
    for (int it = gw; it < T * 8; it += NGW) {
        const int row = it >> 3, h = it & 7, b = row >> 12, t = row & 4095; const size_t rb = (size_t)b * SEQ;
        float o[1];
        naive_row<96, 64, 0>((const bf16*)(ws + WS_QB) + (size_t)row * 768 + h * 96, (const bf16*)(ws + WS_KB) + rb * 768 + h * 96, 768, (const bf16*)(ws + WS_KVR) + rb * 1024 + 512 + h * 64, 1024, nullptr, t, 0.f, 0.f, lane, o);
        ((bf16*)(ws + WS_OB))[(size_t)row * 512 + h * 64 + lane] = (bf16)(pk2(o[0], 0.f) & 0xffffu);
    }
    for (int it = gw; it < T * 8; it += NGW) {
        const int row = it >> 3, hh = it & 7, g = hh >> 2, b = row >> 12, t = row & 4095; const size_t rb = (size_t)b * SEQ;
        bf16* Qr = (bf16*)(ws + WS_QC) + (size_t)row * 512 + hh * 64;
        float o[1];
        naive_row<64, 64, 2>(Qr, (const bf16*)(ws + WS_CQKC) + rb * 512 + 384 + g * 64, 512, (const bf16*)(ws + WS_VCKR) + rb * 256 + g * 64, 256, nullptr, t, exp2f(-(float)(hh + 1)) * LOG2E, swa_sink[hh] * LOG2E, lane, o);
        Qr[lane] = (bf16)(pk2(o[0], 0.f) & 0xffffu);
    }
}
#endif

__device__ __forceinline__ void p_norm2_router(const Frame& F, const bf16* x, const float* g, const float* w_router, bf16* h2, float* affT) {
    int tid_ = threadIdx.x; asm volatile("" : "+v"(tid_)); const int tid = tid_, lane = tid & 63; (void)tid; (void)lane;
    LAS float* wl = (LAS float*)(F.lds + RING_OFF);
    for (int i = tid; i < 1024 * 16; i += NWAVES * 64) { const int d = i >> 4, e = i & 15; const int j = d >> 8, l = (d & 255) >> 2, c = d & 3, k = e >> 2, ee = e & 3;
        wl[((((j * 4 + c) * 4 + k) * 64 + l) << 2) + ee] = w_router[i]; }
    __syncthreads();
    const int gw = F.vcu * NWAVES + F.wave, NGW = F.G * NWAVES;
    f32x4 gv[4];
#pragma unroll
    for (int j = 0; j < 4; ++j) gv[j] = *((const f32x4*)g + lane + 64 * j);
    for (int row0 = gw * 2; row0 < T; row0 += NGW * 2) {
        v2u vv[2][4];
#pragma unroll
        for (int rr = 0; rr < 2; ++rr) { const v2u* xr = (const v2u*)(x + (size_t)(row0 + rr) * DM) + lane;
#pragma unroll
            for (int j = 0; j < 4; ++j) vv[rr][j] = xr[64 * j]; }
#pragma unroll
        for (int rr = 0; rr < 2; ++rr) { const int row = row0 + rr;
        f32x4 v[4]; float s = 0.f;
#pragma unroll
        for (int j = 0; j < 4; ++j) { v[j] = (f32x4){bflo(vv[rr][j].x), bfhi(vv[rr][j].x), bflo(vv[rr][j].y), bfhi(vv[rr][j].y)}; s += (v[j].x * v[j].x + v[j].y * v[j].y) + (v[j].z * v[j].z + v[j].w * v[j].w); }
        const float rs = 1.0f / sqrtf(wave_sum(s) * (1.0f / DM) + EPS);
        v2u* o8 = (v2u*)(h2 + (size_t)row * DM) + lane;
        float lg[16];
#pragma unroll
        for (int e = 0; e < 16; ++e) lg[e] = 0.f;
#pragma unroll
        for (int j = 0; j < 4; ++j) {
            v[j] = v[j] * rs * gv[j];
            v2u o; o.x = pk2(v[j].x, v[j].y); o.y = pk2(v[j].z, v[j].w); o8[64 * j] = o;
#pragma unroll
            for (int c = 0; c < 4; ++c) {
#pragma unroll
                for (int k = 0; k < 4; ++k) { const f32x4 w = *(const LAS f32x4*)(wl + ((((j * 4 + c) * 4 + k) * 64 + lane) << 2));
                    lg[4 * k + 0] = fmaf(v[j][c], w.x, lg[4 * k + 0]); lg[4 * k + 1] = fmaf(v[j][c], w.y, lg[4 * k + 1]); lg[4 * k + 2] = fmaf(v[j][c], w.z, lg[4 * k + 2]); lg[4 * k + 3] = fmaf(v[j][c], w.w, lg[4 * k + 3]); }
                __builtin_amdgcn_sched_barrier(0);
            }
        }
        float s8[8], s4[4];
#pragma unroll
        for (int e = 0; e < 8; ++e) { auto r_ = __builtin_amdgcn_permlane32_swap(__float_as_uint(lg[e]), __float_as_uint(lg[e + 8]), false, false); s8[e] = __uint_as_float(r_[0]) + __uint_as_float(r_[1]); }
#pragma unroll
        for (int e = 0; e < 4; ++e) { auto r_ = __builtin_amdgcn_permlane16_swap(__float_as_uint(s8[e]), __float_as_uint(s8[e + 4]), false, false); s4[e] = __uint_as_float(r_[0]) + __uint_as_float(r_[1]); }
#pragma unroll
        for (int e = 0; e < 4; ++e) {
            s4[e] += __int_as_float(__builtin_amdgcn_update_dpp(0, __float_as_int(s4[e]), 0x128, 0xf, 0xf, false));
            s4[e] += __int_as_float(__builtin_amdgcn_update_dpp(0, __float_as_int(s4[e]), 0x124, 0xf, 0xf, false));
            s4[e] += __int_as_float(__builtin_amdgcn_update_dpp(0, __float_as_int(s4[e]), 0x122, 0xf, 0xf, false));
            s4[e] += __int_as_float(__builtin_amdgcn_update_dpp(0, __float_as_int(s4[e]), 0x121, 0xf, 0xf, false));
        }
        float mx = fmaxf(fmaxf(s4[0], s4[1]), fmaxf(s4[2], s4[3]));
        { auto r_ = __builtin_amdgcn_permlane16_swap(__float_as_uint(mx), __float_as_uint(mx), false, false); mx = fmaxf(__uint_as_float(r_[0]), __uint_as_float(r_[1])); }
        mx = xor_max<32>(mx);
        float den = 0.f;
#pragma unroll
        for (int e = 0; e < 4; ++e) { s4[e] = __expf(s4[e] - mx); den += s4[e]; }
        { auto r_ = __builtin_amdgcn_permlane16_swap(__float_as_uint(den), __float_as_uint(den), false, false); den = __uint_as_float(r_[0]) + __uint_as_float(r_[1]); }
        den = xor_add<32>(den);
        const float inv = 1.0f / den;
        const int b = row >> 12, t = row & 4095;
        if ((lane & 15) == 0) { const int e0 = 8 * (lane >> 5) + 4 * ((lane >> 4) & 1);
#pragma unroll
            for (int e = 0; e < 4; ++e) affT[((size_t)(b * NEXP + e0 + e) << 12) + t] = s4[e] * inv; }
        }
    }
    __syncthreads();
}

__device__ __forceinline__ void p_topk_gather(const Frame& F, unsigned char* ws) {
    int tid_ = threadIdx.x; asm volatile("" : "+v"(tid_)); const int tid = tid_, lane = tid & 63; (void)tid; (void)lane;
    LAS unsigned* red = (LAS unsigned*)(F.lds + RING_OFF);
    LAS unsigned* wtot = red + 16;
    LAS int* lidx = (LAS int*)(F.lds + RING_OFF + 256);
    const float* affT = (const float*)(ws + WS_AFFT); int* inv = (int*)(ws + WS_INV); int* idx = (int*)(ws + WS_IDX); float* affsel = (float*)(ws + WS_AFFSEL);
    const bf16* h2 = (const bf16*)(ws + WS_H); unsigned char* xg = ws + WS_XG;
    const int wid = F.wave;
    for (int u = F.vcu; u < NB * NEXP; u += F.G) {
        const int e = u >> 4, b = u & 15;
        const float* src = affT + ((size_t)(b * NEXP + e) << 12) + tid * 8;
        const f32x4 a0 = *(const f32x4*)src, a1 = *(const f32x4*)(src + 4);
        float v[8] = {a0.x, a0.y, a0.z, a0.w, a1.x, a1.y, a1.z, a1.w};
        unsigned long long key[8];
#pragma unroll
        for (int i = 0; i < 8; ++i) key[i] = ((unsigned long long)__float_as_uint(v[i]) << 12) | (unsigned long long)(4095 - (tid * 8 + i));
        unsigned long long Kth = 0ull;
        for (int bit = 43; bit >= 0; --bit) {
            const unsigned long long cand = Kth | (1ull << bit);
            unsigned c = 0;
#pragma unroll
            for (int i = 0; i < 8; ++i) c += (key[i] >= cand) ? 1u : 0u;
            c = wave_sum_u(c);
            LAS unsigned* rb = red + (bit & 1) * 8;
            if (lane == 0) rb[wid] = c;
            __syncthreads();
            unsigned tot = 0;
#pragma unroll
            for (int w = 0; w < 8; ++w) tot += rb[w];
            if (tot >= (unsigned)CAP) Kth = cand;
        }
        unsigned cnt = 0;
#pragma unroll
        for (int i = 0; i < 8; ++i) cnt += (key[i] >= Kth) ? 1u : 0u;
        unsigned incl = cnt;
#pragma unroll
        for (int o = 1; o < 64; o <<= 1) { const unsigned y = (unsigned)__builtin_amdgcn_ds_bpermute(((lane - o) & 63) << 2, (int)incl); if (lane >= o) incl += y; }
        __syncthreads();
        if (lane == 63) wtot[wid] = incl;
        __syncthreads();
        unsigned base = 0;
#pragma unroll
        for (int w = 0; w < 8; ++w) base += (w < wid) ? wtot[w] : 0u;
        unsigned slot = base + incl - cnt;
#pragma unroll
        for (int i = 0; i < 8; ++i) {
            const int t = tid * 8 + i; const bool sel = key[i] >= Kth;
            inv[((size_t)(b * SEQ + t) << 4) + e] = sel ? (int)slot : -1;
            if (sel) { if (slot < (unsigned)CAP) { lidx[slot] = t; idx[u * CAP + slot] = t; affsel[u * CAP + slot] = v[i]; } ++slot; }
        }
        __syncthreads();
        for (int s0 = wid * 4; s0 < CAP; s0 += NWAVES * 4) {
            v4u x0[4], x1[4];
#pragma unroll
            for (int rr = 0; rr < 4; ++rr) { const int t = lidx[s0 + rr]; const v4u* srow = (const v4u*)(h2 + ((size_t)(b * SEQ + t) << 10)) + lane; x0[rr] = srow[0]; x1[rr] = srow[64]; }
#pragma unroll
            for (int rr = 0; rr < 4; ++rr) { v2u* drow = (v2u*)(xg + ((size_t)(u * CAP + s0 + rr) << 10)) + lane;
                const f32x4 a0 = {bflo(x0[rr].x), bfhi(x0[rr].x), bflo(x0[rr].y), bfhi(x0[rr].y)}, a1 = {bflo(x0[rr].z), bfhi(x0[rr].z), bflo(x0[rr].w), bfhi(x0[rr].w)};
                const f32x4 b0 = {bflo(x1[rr].x), bfhi(x1[rr].x), bflo(x1[rr].y), bfhi(x1[rr].y)}, b1 = {bflo(x1[rr].z), bfhi(x1[rr].z), bflo(x1[rr].w), bfhi(x1[rr].w)};
                const pg8::u32x2 wa = pg8::pack8_fp8(a0, a1), wb = pg8::pack8_fp8(b0, b1); v2u oa; oa.x = wa.x; oa.y = wa.y; v2u ob; ob.x = wb.x; ob.y = wb.y;
                drow[0] = oa; drow[64] = ob; }
        }
        __syncthreads();
    }
}

template <bool NORM> __device__ __forceinline__ void p_combine(const Frame& F, unsigned char* ws, const bf16* xin, void* xout, const float* g, bf16* hout) {
    int tid_ = threadIdx.x; asm volatile("" : "+v"(tid_)); const int tid = tid_, lane = tid & 63; (void)tid; (void)lane;
    const int gw = F.vcu * NWAVES + F.wave, NGW = F.G * NWAVES;
    const int* inv = (const int*)(ws + WS_INV); const bf16* Y = (const bf16*)(ws + WS_XG);
    f32x4 gv[4];
#pragma unroll
    for (int j = 0; j < 4; ++j) { if (NORM) gv[j] = *((const f32x4*)g + lane + 64 * j); else gv[j] = (f32x4){0.f, 0.f, 0.f, 0.f}; }
    for (int row0 = gw * 2; row0 < T; row0 += NGW * 2) {
        int sl[2]; f32x4 v[2][4];
#pragma unroll
        for (int rr = 0; rr < 2; ++rr) { sl[rr] = (lane < 16) ? inv[((size_t)(row0 + rr) << 4) + lane] : -1;
            const v2u* xr = (const v2u*)(xin + (size_t)(row0 + rr) * DM) + lane;
#pragma unroll
            for (int j = 0; j < 4; ++j) { const v2u w = xr[64 * j]; v[rr][j] = (f32x4){bflo(w.x), bfhi(w.x), bflo(w.y), bfhi(w.y)}; } }
#pragma unroll
        for (int rr = 0; rr < 2; ++rr) { const int b = (row0 + rr) >> 12;
            unsigned long long mask = __ballot(sl[rr] >= 0);
            while (mask) {
                const int e = __builtin_ctzll(mask); mask &= mask - 1;
                const int s = __builtin_amdgcn_readlane(sl[rr], e);
                const v2u* yr = (const v2u*)(Y + ((size_t)(((e << 4) + b) * CAP + s) << 10)) + lane;
#pragma unroll
                for (int j = 0; j < 4; ++j) { const v2u w = yr[64 * j]; v[rr][j].x += bflo(w.x); v[rr][j].y += bfhi(w.x); v[rr][j].z += bflo(w.y); v[rr][j].w += bfhi(w.y); }
            }
            if (NORM) { v2u* xw = (v2u*)((bf16*)xout + (size_t)(row0 + rr) * DM) + lane;
#pragma unroll
                for (int j = 0; j < 4; ++j) { v2u o; o.x = pk2(v[rr][j].x, v[rr][j].y); o.y = pk2(v[rr][j].z, v[rr][j].w); xw[64 * j] = o; } }
            else { f32x4* xw = (f32x4*)((float*)xout + (size_t)(row0 + rr) * DM) + lane;
#pragma unroll
                for (int j = 0; j < 4; ++j) xw[64 * j] = v[rr][j]; }
            if (NORM) { float s = 0.f;
#pragma unroll
                for (int j = 0; j < 4; ++j) s += (v[rr][j].x * v[rr][j].x + v[rr][j].y * v[rr][j].y) + (v[rr][j].z * v[rr][j].z + v[rr][j].w * v[rr][j].w);
                const float rs = 1.0f / sqrtf(wave_sum(s) * (1.0f / DM) + EPS);
                v2u* o8 = (v2u*)(hout + (size_t)(row0 + rr) * DM) + lane;
#pragma unroll
                for (int j = 0; j < 4; ++j) { v2u o; o.x = pk2(v[rr][j].x * rs * gv[j].x, v[rr][j].y * rs * gv[j].y); o.y = pk2(v[rr][j].z * rs * gv[j].z, v[rr][j].w * rs * gv[j].w); o8[64 * j] = o; } } }
    }
}

struct KArgs { const float* in[23]; const int* positions; float* out; unsigned char* ws; int ph_lo, ph_hi; };
static_assert(sizeof(KArgs) == 23 * 8 + 8 + 8 + 8 + 8, "KArgs has no padding");
__device__ __forceinline__ unsigned long long karg_u64(int off) {
    unsigned long long v; auto kp = __builtin_amdgcn_kernarg_segment_ptr();
    asm volatile("s_load_dwordx2 %0, %1, %2\n\ts_waitcnt lgkmcnt(0)" : "=&s"(v) : "s"(kp), "i"(off) : "memory"); return v; }
#define GASP __attribute__((address_space(1)))
#define KIN(k) ((const float*)(const GASP float*)karg_u64(8 * (k)))
#define KPOS() ((const int*)(const GASP int*)karg_u64(184))
#define KOUT() ((float*)(GASP float*)karg_u64(192))
#define KWS() ((unsigned char*)(GASP unsigned char*)karg_u64(200))
__device__ __forceinline__ LayerW layer_w(int layer) {
    LayerW L;
    L.norm_mix_g = KIN(2) + (size_t)layer * 1024; L.w_in = KIN(3) + (size_t)layer * 1024 * IN_COLS; L.diff_qk_g = KIN(4) + layer * 128; L.diff_lambda = KIN(5) + layer * 256;
    L.diff_out_g = KIN(6) + layer * 128; L.mla_cq_g = KIN(7) + layer * 384; L.w_uq = KIN(8) + (size_t)layer * 384 * 768; L.mla_ckv_g = KIN(9) + layer * 256;
    L.w_ukv = KIN(10) + (size_t)layer * 256 * 1024; L.mla_qk_g = KIN(11) + layer * 192; L.swa_qk_g = KIN(12) + layer * 128; L.swa_sink = KIN(13) + layer * 8;
    L.w_ba = KIN(14) + (size_t)layer * 512 * 1024; L.w_bb = KIN(15) + (size_t)layer * 512 * 1024; L.w_bc = KIN(16) + (size_t)layer * 512 * 1024; L.w_o = KIN(17) + (size_t)layer * 1024 * 1024;
    L.norm_ffn_g = KIN(18) + (size_t)layer * 1024; L.w_router = KIN(19) + (size_t)layer * 1024 * 16;
    L.w_eg = KIN(20) + (size_t)layer * 16 * 1024 * 1024; L.w_eu = KIN(21) + (size_t)layer * 16 * 1024 * 1024; L.w_ed = KIN(22) + (size_t)layer * 16 * 1024 * 1024;
    return L;
}


#ifdef DBG_CHECK
__device__ __forceinline__ unsigned hash_u(unsigned x) { x ^= x >> 16; x *= 0x7feb352du; x ^= x >> 15; x *= 0x846ca68bu; x ^= x >> 16; return x; }
__device__ __forceinline__ float bf2f(bf16 v) { return __uint_as_float((unsigned)v << 16); }
__device__ __forceinline__ void chk_report(unsigned* word, float a, float b, int lane) {
    const float err = fabsf(a - b) / (fabsf(b) + 0.1f);
    if (lane == 0) atomicMax(word, __float_as_uint(err));
}
__device__ __forceinline__ const bf16* proj_loc(unsigned char* ws, int row, int col) {
    const int r = win_row(col), pn = r >> 8, c = r & 255;
    if (pn < 10) return (const bf16*)(ws + WS_QA + (size_t)(pn >> 1) * 64 * MiB) + (size_t)row * 512 + (pn & 1) * 256 + c;
    return (const bf16*)(ws + WS_CKV + (size_t)(pn - 10) * 32 * MiB) + (size_t)row * 256 + c;
}
__device__ __forceinline__ float naive_proj(const bf16* h, const float* w_in, int row, int col, int lane) {
    float s = 0.f;
    for (int k = lane; k < 1024; k += 64) s = fmaf(bf2f(h[(size_t)row * 1024 + k]), w_in[(size_t)k * IN_COLS + col], s);
    return wave_sum(s);
}
__device__ __forceinline__ void p_check(int which, int gw, int NGW, int lane, unsigned char* ws, const float* const* dummy, const float* x_in, const float* xout, const LayerW& L, const int* positions) {
    unsigned* word = (unsigned*)(ws + WS_CTL) + 32768 + which * 64;
    const bf16* h = (const bf16*)(ws + WS_H);
    if (which == 0) {
        for (int s = gw; s < 2048; s += NGW) { const int row = hash_u(s * 2 + 1) % T, col = hash_u(s * 2 + 2) % 2976;
            chk_report(word, bf2f(*proj_loc(ws, row, col)), naive_proj(h, L.w_in, row, col, lane), lane); }
    } else if (which == 1) {
        for (int s = gw; s < 1536; s += NGW) { const int row = hash_u(s * 3 + 5) % T, type = s % 6; const unsigned hg = hash_u(s * 3 + 7);
            if (type < 4) { int c0; const float* g; float qs = 1.f;
                if (type == 0) { c0 = (hg % 8) * 64; g = L.diff_qk_g; qs = 0.125f * LOG2E; } else if (type == 1) { c0 = 512 + (hg % 8) * 64; g = L.diff_qk_g + 64; }
                else if (type == 2) { c0 = 2208 + (hg % 8) * 64; g = L.swa_qk_g; qs = 0.125f * LOG2E; } else { c0 = 2720 + (hg % 2) * 64; g = L.swa_qk_g + 64; }
                float v = 0.f; for (int k = 0; k < 1024; ++k) v = fmaf(bf2f(h[(size_t)row * 1024 + k]), L.w_in[(size_t)k * IN_COLS + c0 + lane], v);
                v = bf2f((bf16)(pk2(v, 0.f) & 0xffffu));
                const float rs = 1.0f / sqrtf(wave_sum(v * v) * (1.0f / 64) + EPS);
                chk_report(word, bf2f(*proj_loc(ws, row, c0 + lane)), v * rs * g[lane] * qs, lane);
                const float e2 = fabsf(bf2f(*proj_loc(ws, row, c0 + lane)) - v * rs * g[lane] * qs) / (fabsf(v * rs * g[lane] * qs) + 0.1f); float m = e2;
                for (int o = 1; o < 64; o <<= 1) m = fmaxf(m, __shfl_xor(m, o)); if (lane == 0) atomicMax(word, __float_as_uint(m));
            } else { const int ng = type == 4 ? 6 : 4, cb = type == 4 ? 1536 : 1920; const float* g = type == 4 ? L.mla_cq_g : L.mla_ckv_g;
                float v[6]; float ss = 0.f;
                _Pragma("unroll") for (int q = 0; q < 6; ++q) { float a = 0.f; if (q < ng) { for (int k = 0; k < 1024; ++k) a = fmaf(bf2f(h[(size_t)row * 1024 + k]), L.w_in[(size_t)k * IN_COLS + cb + q * 64 + lane], a); }
                    a = bf2f((bf16)(pk2(a, 0.f) & 0xffffu)); v[q] = a; ss += a * a; }
                const float rs = 1.0f / sqrtf(wave_sum(ss) / (float)(ng * 64) + EPS); float m = 0.f;
                _Pragma("unroll") for (int q = 0; q < 6; ++q) { if (q < ng) { const float want = v[q] * rs * g[q * 64 + lane]; m = fmaxf(m, fabsf(bf2f(*proj_loc(ws, row, cb + q * 64 + lane)) - want) / (fabsf(want) + 0.1f)); } }
                for (int o = 1; o < 64; o <<= 1) m = fmaxf(m, __shfl_xor(m, o)); if (lane == 0) atomicMax(word, __float_as_uint(m));
            } }
    } else if (which == 2) {
        const bf16* CQ = (const bf16*)(ws + WS_CQKC); const bf16* CKVn = (const bf16*)(ws + WS_CKV); const bf16* VCKR = (const bf16*)(ws + WS_VCKR);
        const bf16* QB = (const bf16*)(ws + WS_QB); const bf16* KB = (const bf16*)(ws + WS_KB);
        for (int s = gw; s < 1024; s += NGW) { const int row = hash_u(s * 5 + 11) % T, hd = hash_u(s * 5 + 13) % 8; const bool isq = s & 1;
            float nope = 0.f, rp = 0.f;
            if (isq) { for (int k = 0; k < 384; ++k) { const float a = bf2f(CQ[(size_t)row * 512 + k]); nope = fmaf(a, L.w_uq[(size_t)k * 768 + hd * 96 + lane], nope); rp = fmaf(a, L.w_uq[(size_t)k * 768 + hd * 96 + 64 + (lane & 31)], rp); } }
            else { for (int k = 0; k < 256; ++k) nope = fmaf(bf2f(CKVn[(size_t)row * 256 + k]), L.w_ukv[(size_t)k * 1024 + hd * 128 + lane], nope); rp = bf2f(VCKR[(size_t)row * 256 + 128 + (lane & 31)]); }
            nope = bf2f((bf16)(pk2(nope, 0.f) & 0xffffu)); if (isq) rp = bf2f((bf16)(pk2(rp, 0.f) & 0xffffu));
            const int i = lane & 15; const float ang = (float)positions[row] * (1.0f / powf(10000.0f, (float)i / 16.0f));
            const float cs = cosf(ang), sn = sinf(ang), other = __shfl_xor(rp, 16);
            float ro = (lane & 16) ? (other * sn + rp * cs) : (rp * cs - other * sn); if (lane >= 32) ro = 0.f;
            const float rs = 1.0f / sqrtf(wave_sum(nope * nope + ro * ro) * (1.0f / 96) + EPS);
            const float* g = L.mla_qk_g + (isq ? 0 : 96); const float qs = isq ? 0.10206207261596575f * LOG2E : 1.f;
            const bf16* dst = (isq ? QB : KB) + (size_t)row * 768 + hd * 96;
            const float w1 = nope * rs * g[lane] * qs; float m = fabsf(bf2f(dst[lane]) - w1) / (fabsf(w1) + 0.1f);
            if (lane < 32) { const float w2 = ro * rs * g[64 + lane] * qs; m = fmaxf(m, fabsf(bf2f(dst[64 + lane]) - w2) / (fabsf(w2) + 0.1f)); }
            for (int o = 1; o < 64; o <<= 1) m = fmaxf(m, __shfl_xor(m, o)); if (lane == 0) atomicMax(word, __float_as_uint(m)); }
    } else if (which == 3) {
        for (int s = gw; s < 2048; s += NGW) { const int row = hash_u(s * 2 + 21) % T, col = hash_u(s * 2 + 22) % 3072;
            const float z = naive_proj(h, L.w_in, row, 2976 + col, lane); const float want = 1.0f / (1.0f + __expf(-z));
            const int gi = col >> 10; const bf16* G = (const bf16*)(ws + (gi == 0 ? WS_G0 : (gi == 1 ? WS_G1 : WS_G2)));
            const float got = bf2f(G[(size_t)row * 1024 + (col & 1023)]);
            chk_report(word, got, want, lane);
            if (lane == 0) { atomicAdd(word + 1024 + gi * 64, 1u); if (fabsf(got - want) / (fabsf(want) + 0.1f) > 0.06f) atomicAdd(word + 2048 + gi * 64, 1u); } }
    } else if (which == 4) {
        for (int s = gw; s < 2048; s += NGW) { const int row = hash_u(s * 2 + 31) % T, c = hash_u(s * 2 + 32) % 1024; float want = 0.f;
            for (int i = 0; i < 3; ++i) { const bf16* O = (const bf16*)(ws + (i == 0 ? WS_QA : (i == 1 ? WS_OB : WS_QC))); const float* Wb = i == 0 ? L.w_ba : (i == 1 ? L.w_bb : L.w_bc);
                const bf16* G = (const bf16*)(ws + (i == 0 ? WS_G0 : (i == 1 ? WS_G1 : WS_G2)));
                float a = 0.f; for (int k = lane; k < 512; k += 64) a = fmaf(bf2f(O[(size_t)row * 512 + k]), Wb[(size_t)k * 1024 + c], a);
                want += bf2f(G[(size_t)row * 1024 + c]) * wave_sum(a); }
            chk_report(word, bf2f(h[(size_t)row * 1024 + c]), want, lane); }
    } else if (which == 6) {
        for (int s = gw; s < 2048; s += NGW) { const int row = hash_u(s * 2 + 51) % T; float ss = 0.f;
            for (int k = lane; k < 1024; k += 64) { const float v = x_in[(size_t)row * 1024 + k]; ss += v * v; }
            const float rs = 1.0f / sqrtf(wave_sum(ss) * (1.0f / 1024) + EPS); float m = 0.f;
            for (int k = lane; k < 1024; k += 64) { const float want = x_in[(size_t)row * 1024 + k] * rs * L.norm_mix_g[k]; m = fmaxf(m, fabsf(bf2f(h[(size_t)row * 1024 + k]) - want) / (fabsf(want) + 0.1f)); }
            for (int o = 1; o < 64; o <<= 1) m = fmaxf(m, __shfl_xor(m, o)); if (lane == 0) atomicMax(word, __float_as_uint(m)); }
    } else if (which == 7 || which == 8) {
        const bf16* wt = (const bf16*)(ws + WS_WIN);
        for (int s = gw; s < 4096; s += NGW) { const int col = which == 7 ? 2976 + (int)(hash_u(s * 2 + 61) % 3072) : (int)(hash_u(s * 2 + 61) % 2976); const int r = win_row(col); float m = 0.f;
            for (int k = lane; k < 1024; k += 64) { const float want = L.w_in[(size_t)k * IN_COLS + col]; m = fmaxf(m, fabsf(bf2f(wt[(size_t)r * 1024 + k]) - want) / (fabsf(want) + 0.01f)); }
            for (int o = 1; o < 64; o <<= 1) m = fmaxf(m, __shfl_xor(m, o)); if (lane == 0) atomicMax(word, __float_as_uint(m)); }
    } else if (which == 9) {
        const bf16* wt = (const bf16*)(ws + WS_WIN);
        for (int s = gw; s < 2048; s += NGW) { const int row = hash_u(s * 2 + 21) % T, col = hash_u(s * 2 + 22) % 3072; float a = 0.f;
            for (int k = lane; k < 1024; k += 64) a = fmaf(bf2f(h[(size_t)row * 1024 + k]), bf2f(wt[(size_t)(3072 + col) * 1024 + k]), a);
            const float z = wave_sum(a), want = 1.0f / (1.0f + __expf(-z));
            const int gi = col >> 10; const bf16* G = (const bf16*)(ws + (gi == 0 ? WS_G0 : (gi == 1 ? WS_G1 : WS_G2)));
            chk_report(word, bf2f(G[(size_t)row * 1024 + (col & 1023)]), want, lane); }
    } else {
        for (int s = gw; s < 2048; s += NGW) { const int row = hash_u(s * 2 + 41) % T, c = hash_u(s * 2 + 42) % 1024;
            float a = 0.f; for (int k = lane; k < 1024; k += 64) a = fmaf(bf2f(h[(size_t)row * 1024 + k]), L.w_o[(size_t)k * 1024 + c], a);
            const float d = wave_sum(a), got = xout[(size_t)row * 1024 + c] - x_in[(size_t)row * 1024 + c];
            chk_report(word, got, d, lane); }
    }
}
__device__ __forceinline__ void p_check_emit(int vcu, int G, unsigned char* ws, float* out) {
    int t_ = threadIdx.x; asm volatile("" : "+v"(t_));
    const unsigned* words = (const unsigned*)(ws + WS_CTL) + 32768;
    int code = 0;
#ifdef DBG_CHECK2
    { const int map_[5] = {6, 7, 8, 9, 3};
      if (__uint_as_float(words[6 * 64]) > 0.06f) code |= 1; if (__uint_as_float(words[7 * 64]) > 0.06f) code |= 2; if (__uint_as_float(words[8 * 64]) > 0.06f) code |= 4;
      if (__uint_as_float(words[9 * 64]) > 0.06f) code |= 8; if (__uint_as_float(words[3 * 64]) > 0.06f) code |= 16; (void)map_; }
#elif defined(DBG_GATEFRAC)
    { const unsigned* w3 = words + 3 * 64;
      for (int gi = 0; gi < 3; ++gi) { const unsigned n = w3[1024 + gi * 64], bad = w3[2048 + gi * 64]; const int f = bad == 0 ? 0 : (bad * 10 < n ? 1 : (bad * 2 < n ? 2 : 3)); code |= f << (2 * gi); } }
#else
    for (int i = 0; i < 6; ++i) if (__uint_as_float(words[i * 64]) > 0.06f) code |= 1 << i;
#endif
    for (size_t i = (size_t)vcu * 512 + t_; i < (size_t)T * DM; i += (size_t)G * 512) out[i] = 0.f;
    __syncthreads();
    if (vcu == 0 && t_ == 0) out[0] = exp2f((float)(code + 20));
}
#endif

__global__ void __launch_bounds__(NWAVES * 64, 2) fwd_kernel(KArgs args) {
    extern __shared__ __attribute__((aligned(16))) unsigned char lds_raw[];
    Frame F;
    F.lds = (LAS unsigned char*)lds_raw;
    F.wave = __builtin_amdgcn_readfirstlane((int)threadIdx.x >> 6);
    F.G = gridDim.x; { const int bx = blockIdx.x; F.vcu = (F.G % 8 == 0) ? (bx % 8) * (F.G / 8) + bx / 8 : bx; }
    volatile LAS unsigned* MISC = (volatile LAS unsigned*)(F.lds + MISC_OFF);
    for (int u = threadIdx.x; u < (LDS_BYTES - LDSCTL_OFF) / 4; u += NWAVES * 64) ((LAS unsigned*)(F.lds + LDSCTL_OFF))[u] = 0u;
    __syncthreads();
#define GRID_BARRIER() do { XcdBarrier b_; b_.bar = (unsigned*)(KWS() + WS_CTL) + 4096; b_.x = xb_xcc_id(); b_.st = (volatile LAS unsigned*)(F.lds + MISC_OFF) + 8; xcd_barrier(b_); } while (0)
#if !MK_MULTI
    (void)xcd_barrier_post((unsigned*)(KWS() + WS_CTL) + 4096, MISC + 8);
#endif
    const int lo = args.ph_lo, hi = args.ph_hi;
#ifdef DBG_CHECK
    if (lo >= 2000) { p_check_emit(F.vcu, F.G, KWS(), KOUT()); return; }
#ifdef DBG_CHECK2
    if (lo >= 1000 && lo < 2000) { const int ph = lo - 1000;
        for (int which = 6; which <= 9; ++which) { const bool run = (ph == 5 && which <= 8) || (ph == 6 && which == 9);
            if (run) { int t_ = threadIdx.x; asm volatile("" : "+v"(t_)); unsigned char* ws = KWS(); const LayerW L = layer_w(0);
                p_check(which, F.vcu * NWAVES + F.wave, F.G * NWAVES, t_ & 63, ws, nullptr, KIN(0), KOUT(), L, KPOS()); } }
    }
#endif
    if (lo >= 1000) { const int ph = lo - 1000; const int which = ph == 1 ? 0 : ph == 2 ? 1 : ph == 4 ? 2 : ph == 6 ? 3 : ph == 9 ? 4 : ph == 10 ? 5 : -1;
        if (which >= 0) { int t_ = threadIdx.x; asm volatile("" : "+v"(t_)); unsigned char* ws = KWS(); const LayerW L = layer_w(0);
            p_check(which, F.vcu * NWAVES + F.wave, F.G * NWAVES, t_ & 63, ws, nullptr, KIN(0), KOUT(), L, KPOS()); }
        return; }
#endif
#ifdef ONLY_PHASE
#define IN(k) ((((k) % PH_PER_LAYER) == ONLY_PHASE) && lo <= (k) && (k) < hi)
#else
#ifdef SKIP_FFN
#define IN(k) ((((k) % PH_PER_LAYER) < 11) && lo <= (k) && (k) < hi)
#else
#define IN(k) (lo <= (k) && (k) < hi)
#endif
#endif
#if MK_MULTI
#define SEAM(k) do { } while (0)
#else
#define SEAM(k) do { if (IN((k) + 1)) { GRID_BARRIER(); } } while (0)
#endif
#define CHK(ph, which) do { } while (0)
#define GEMM_RUN(EPI, g, E) do { pg8::StaticOrder S_; S_.init((g).M, (g).N, F.G, (int)blockIdx.x); pg8::gemm_phase<EPI, pg8::StaticOrder, true, true>(F.lds + RING_OFF, g, S_, E); } while (0)
#define GEMM_RUN_F8(EPI, g, E) do { pg8::StaticOrder S_; S_.init((g).M, (g).N, F.G, (int)blockIdx.x); pg8::gemm_phase<EPI, pg8::StaticOrder, true, true, true>(F.lds + RING_OFF, g, S_, E); } while (0)
#ifdef DUP_SMALL
#define GEMM_RUN3(EPI, g, E) do { GEMM_RUN(EPI, g, E); GRID_BARRIER(); GEMM_RUN(EPI, g, E); } while (0)
#else
#define GEMM_RUN3(EPI, g, E) GEMM_RUN(EPI, g, E)
#endif
#ifdef DUP_GEMM
#define GEMM_RUN2(EPI, g, E) do { GEMM_RUN(EPI, g, E); GRID_BARRIER(); GEMM_RUN(EPI, g, E); } while (0)
#else
#define GEMM_RUN2(EPI, g, E) GEMM_RUN(EPI, g, E)
#endif
    for (int layer = 0; layer < DEPTH; ++layer) {
        const int P = layer * PH_PER_LAYER;
#ifdef DUP_P0
        if (IN(P + 0)) { unsigned char* ws = KWS(); const LayerW L = layer_w(layer); p_convert(F, L, ws); if (layer == 0) p_norm1(F, KIN(0), L.norm_mix_g, (bf16*)(ws + WS_H));     GRID_BARRIER(); }
#endif
        if (IN(P + 0)) { unsigned char* ws = KWS(); const LayerW L = layer_w(layer); p_convert(F, L, ws); if (layer == 0) p_norm1(F, KIN(0), L.norm_mix_g, (bf16*)(ws + WS_H));     SEAM(P + 0); }
        if (IN(P + 1)) {
            unsigned char* ws = KWS();
            pg8::Gemm g{(const bf16*)(ws + WS_H), (const bf16*)(ws + WS_WIN), T, 3072, 1024, 1024, 1, 1, 0};
            pg8::EpiRouteNorm E{(bf16*)(ws + WS_QA), (size_t)(64 * MiB / 2), (bf16*)(ws + WS_CKV), (size_t)(32 * MiB / 2), (const float*)(ws + WS_GT), (float*)(ws + WS_SSP), EPS};
            GEMM_RUN2(pg8::EpiRouteNorm, g, E); SEAM(P + 1); }
        CHK(1, 0);
#ifdef DUP_BAR
        if (IN(P + 2)) { for (int i_ = 0; i_ < 10; ++i_) GRID_BARRIER(); }
#endif
        CHK(2, 1);
        if (IN(P + 3)) {
            unsigned char* ws = KWS();
            pg8::Gemm g{(const bf16*)(ws + WS_CQKC), (const bf16*)(ws + WS_WUQ), T, 768, 384, 512, 1, 1, 0};
            pg8::EpiPlainRS E{(bf16*)(ws + WS_QB), 768, (const float*)(ws + WS_SSP), 0, 6, 1.0f / 384, EPS}; GEMM_RUN3(pg8::EpiPlainRS, g, E); }
        if (IN(P + 3)) {
            unsigned char* ws = KWS();
            pg8::Gemm g{(const bf16*)(ws + WS_CKV), (const bf16*)(ws + WS_WUKV), T, 1024, 256, 256, 1, 1, 0};
            pg8::EpiPlainRS E{(bf16*)(ws + WS_KVR), 1024, (const float*)(ws + WS_SSP), 8, 4, 1.0f / 256, EPS}; GEMM_RUN3(pg8::EpiPlainRS, g, E); SEAM(P + 3); }
        if (IN(P + 4)) { unsigned char* ws = KWS(); const LayerW L = layer_w(layer); p_prep2(F, L, ws, KPOS()); p_tile_minmax(F, ws, KPOS()); SEAM(P + 4); }
        CHK(4, 2);
#ifdef NAIVE_ATTN
        if (IN(P + 5)) { unsigned char* ws = KWS(); p_attention_naive(F.vcu, F.wave, F.G, KIN(5) + layer * 256, KIN(6) + layer * 128, KIN(13) + layer * 8, ws, KPOS(), layer); SEAM(P + 5); }
#else
        if (IN(P + 5)) { unsigned char* ws = KWS(); p_attention(F, KIN(4) + layer * 128, KIN(5) + layer * 256, KIN(6) + layer * 128, KIN(13) + layer * 8, ws, KPOS(), layer); SEAM(P + 5); }
#endif
        if (IN(P + 6)) {
            { unsigned char* ws = KWS(); p_h_to_fp8(F, ws); }
#ifdef DUP_H8
            { unsigned char* ws = KWS(); for (int i_ = 0; i_ < 4; ++i_) p_h_to_fp8(F, ws); }
#endif
#if !MK_MULTI
            GRID_BARRIER();
#endif
            unsigned char* ws = KWS();
            pg8::Gemm g{(const bf16*)(ws + WS_H8), (const bf16*)(ws + WS_WG8), T, 3072, 512, 512, 1, 1, 0, 0, 0};
            pg8::EpiGate E{(bf16*)(ws + WS_G0), (size_t)(128 * MiB / 2), (size_t)(96 * MiB / 2), -LOG2E / W8_SCALE};
            GEMM_RUN_F8(pg8::EpiGate, g, E); SEAM(P + 6); }
        if (IN(P + 7)) {
            unsigned char* ws = KWS();
            pg8::Gemm g{(const bf16*)(ws + WS_QA), (const bf16*)(ws + WS_WBA), T, 1024, 512, 512, 1, 1, 0};
            pg8::EpiMerge E{(const bf16*)(ws + WS_G0), (bf16*)(ws + WS_H), 1}; GEMM_RUN3(pg8::EpiMerge, g, E); SEAM(P + 7); }
        if (IN(P + 8)) {
            unsigned char* ws = KWS();
            pg8::Gemm g{(const bf16*)(ws + WS_OB), (const bf16*)(ws + WS_WBB), T, 1024, 512, 512, 1, 1, 0};
            pg8::EpiMerge E{(const bf16*)(ws + WS_G1), (bf16*)(ws + WS_H), 0}; GEMM_RUN(pg8::EpiMerge, g, E); SEAM(P + 8); }
        if (IN(P + 9)) {
            unsigned char* ws = KWS();
            pg8::Gemm g{(const bf16*)(ws + WS_QC), (const bf16*)(ws + WS_WBC), T, 1024, 512, 512, 1, 1, 0};
            pg8::EpiMerge E{(const bf16*)(ws + WS_G2), (bf16*)(ws + WS_H), 0}; GEMM_RUN(pg8::EpiMerge, g, E); SEAM(P + 9); }
        CHK(9, 4);
        if (IN(P + 10)) {
            unsigned char* ws = KWS(); float* xo = KOUT();
            pg8::Gemm g{(const bf16*)(ws + WS_H), (const bf16*)(ws + WS_WO), T, 1024, 1024, 1024, 1, 1, 0};
            pg8::EpiResid E{layer == 0 ? (const void*)KIN(0) : (const void*)xo, layer != 0, (bf16*)(ws + WS_XB)}; GEMM_RUN(pg8::EpiResid, g, E); SEAM(P + 10); }
        CHK(10, 5);
#ifdef DUP_P11
        if (IN(P + 11)) { unsigned char* ws = KWS(); p_norm2_router(F, (const bf16*)(ws + WS_XB), KIN(18) + (size_t)layer * 1024, KIN(19) + (size_t)layer * 1024 * 16, (bf16*)(ws + WS_H), (float*)(ws + WS_AFFT)); GRID_BARRIER(); }
#endif
        if (IN(P + 11)) { unsigned char* ws = KWS(); p_norm2_router(F, (const bf16*)(ws + WS_XB), KIN(18) + (size_t)layer * 1024, KIN(19) + (size_t)layer * 1024 * 16, (bf16*)(ws + WS_H), (float*)(ws + WS_AFFT)); SEAM(P + 11); }
#ifdef DUP_P12
        if (IN(P + 12)) { unsigned char* ws = KWS(); p_topk_gather(F, ws); GRID_BARRIER(); }
#endif
        if (IN(P + 12)) { unsigned char* ws = KWS(); p_topk_gather(F, ws); SEAM(P + 12); }
        if (IN(P + 13)) {
            unsigned char* ws = KWS();
            pg8::Gemm g{(const bf16*)(ws + WS_XG), (const bf16*)(ws + WS_WGU), TE, 2048, 512, 512, 32, 16, (size_t)2048 * 1024, W8_E8M0, ONE_E8M0};
            pg8::EpiSwiglu E{ws + WS_HID, 1.0f / W8_SCALE, HID_SCALE}; GEMM_RUN_F8(pg8::EpiSwiglu, g, E); SEAM(P + 13); }
        if (IN(P + 14)) {
            unsigned char* ws = KWS();
            pg8::Gemm g{(const bf16*)(ws + WS_HID), (const bf16*)(ws + WS_WD), TE, 1024, 512, 512, 32, 16, (size_t)1024 * 1024, W8_E8M0, HID_E8M0};
            pg8::EpiDown E{(bf16*)(ws + WS_XG), (const float*)(ws + WS_AFFSEL), 1.0f / (W8_SCALE * HID_SCALE)}; GEMM_RUN_F8(pg8::EpiDown, g, E); SEAM(P + 14); }
        if (IN(P + 15)) { unsigned char* ws = KWS(); if (layer + 1 < DEPTH) p_combine<true>(F, ws, (const bf16*)(ws + WS_XB), KOUT(), KIN(2) + (size_t)(layer + 1) * 1024, (bf16*)(ws + WS_H)); else p_combine<false>(F, ws, (const bf16*)(ws + WS_XB), KOUT(), nullptr, nullptr); SEAM(P + 15); }
    }
#undef IN
#undef SEAM
}

extern "C" void kernel_launch(void* const* d_in, const int* in_sizes, int n_in, void* d_out, int out_size, void* d_ws, size_t ws_size, hipStream_t stream) {
    static int grid = 0;
    if (grid == 0) {
        if (n_in != 23 || in_sizes[0] != T * DM || out_size != T * DM || ws_size < WS_END) { fprintf(stderr, "kernel_launch: shape/workspace mismatch (n_in %d, ws %zu < %zu)\n", n_in, ws_size, (size_t)WS_END); grid = -1; return; }
        int dev = 0, cus = 0, per_cu = 0;
        if (hipGetDevice(&dev) != hipSuccess || hipDeviceGetAttribute(&cus, hipDeviceAttributeMultiprocessorCount, dev) != hipSuccess) { grid = -1; return; }
        if (hipFuncSetAttribute((const void*)fwd_kernel, hipFuncAttributeMaxDynamicSharedMemorySize, LDS_BYTES) != hipSuccess) { fprintf(stderr, "kernel_launch: hipFuncSetAttribute failed\n"); grid = -1; return; }
        if (hipOccupancyMaxActiveBlocksPerMultiprocessor(&per_cu, (const void*)fwd_kernel, NWAVES * 64, LDS_BYTES) != hipSuccess || per_cu < 1) { fprintf(stderr, "kernel_launch: occupancy query reports %d\n", per_cu); }
        (void)hipGetLastError();
        grid = cus;
    }
    if (grid < 0) return;
    if (hipMemsetAsync((char*)d_ws + WS_CTL, 0, CTL_ZERO_BYTES, stream) != hipSuccess) return;
    KArgs a{};
    for (int i = 0; i < 23; ++i) a.in[i] = (const float*)d_in[i];
    a.positions = (const int*)d_in[1]; a.out = (float*)d_out; a.ws = (unsigned char*)d_ws;
#if MK_MULTI
#ifdef DBG_CHECK
    for (int p = 0; p <= 10; ++p) { a.ph_lo = p; a.ph_hi = p + 1; hipLaunchKernelGGL(fwd_kernel, dim3(grid), dim3(NWAVES * 64), LDS_BYTES, stream, a);
        a.ph_lo = 1000 + p; a.ph_hi = 1001 + p; hipLaunchKernelGGL(fwd_kernel, dim3(grid), dim3(NWAVES * 64), LDS_BYTES, stream, a); }
    a.ph_lo = 2000; a.ph_hi = 2001; hipLaunchKernelGGL(fwd_kernel, dim3(grid), dim3(NWAVES * 64), LDS_BYTES, stream, a);
#else
    for (int p = 0; p < NPHASE; ++p) { a.ph_lo = p; a.ph_hi = p + 1; hipLaunchKernelGGL(fwd_kernel, dim3(grid), dim3(NWAVES * 64), LDS_BYTES, stream, a); }
#endif
#else
    a.ph_lo = 0; a.ph_hi = NPHASE;
    hipLaunchKernelGGL(fwd_kernel, dim3(grid), dim3(NWAVES * 64), LDS_BYTES, stream, a);
#endif
    const hipError_t le = hipPeekAtLastError();
    if (le != hipSuccess) fprintf(stderr, "kernel_launch: launch failed: %s\n", hipGetErrorName(le));
}
```

```cpp
#include <hip/hip_runtime.h>
#include <cstdio>
#include <cstdint>

#ifndef MK_MULTI
#define MK_MULTI 0
#endif

namespace pg8 {
#define PG8_LAS __attribute__((address_space(3)))
typedef unsigned short bf16_t;
typedef short bf16x8 __attribute__((ext_vector_type(8)));
typedef float f32x4 __attribute__((ext_vector_type(4)));
typedef unsigned u32x4 __attribute__((ext_vector_type(4)));
typedef unsigned u32x2 __attribute__((ext_vector_type(2)));
typedef float f32x2 __attribute__((ext_vector_type(2)));
constexpr int BM = 256, BK = 64, HALF = 128, HTB = HALF * BK * 2  , STAGE_BYTES = 8 * HTB, NXCD = 8, WGM = 8;

__host__ __device__ __forceinline__ int lds_byte(int r, int c) { const int st = (r >> 4) * 2 + (c >> 5), rr = r & 15, cc = c & 31, ob = rr * 64 + cc * 2; return st * 1024 + (ob ^ (((ob >> 9) & 1) << 5)); }
__host__ __device__ __forceinline__ void stage_rc(int b, int& R, int& C) { const int st = b / 1024, sb = b % 1024, swz = sb ^ (((sb >> 9) & 1) << 5); R = (st >> 1) * 16 + swz / 64; C = (st & 1) * 32 + (swz % 64) / 2; }
__host__ __device__ __forceinline__ int perm32(int rho) { const int n = rho >> 4, i = rho & 15; return 8 * (i >> 2) + 4 * n + (i & 3); }

struct Unit { int pm, pn; };
struct Gemm { const bf16_t* A; const bf16_t* Bt; int M, N, K, lda; int pm_per_grp, ngrp; size_t grp_bytes; int sc_w, sc_x; size_t a_extra; const int* rowmap;
    __device__ __forceinline__ size_t grp_off(int pm) const { return ngrp > 1 ? (size_t)((pm / pm_per_grp) % ngrp) * grp_bytes : (size_t)0; } };

typedef int v8i_t __attribute__((ext_vector_type(8))); typedef int v4i_t __attribute__((ext_vector_type(4)));
__device__ __forceinline__ v8i_t cat8(bf16x8 lo, bf16x8 hi) { return __builtin_shufflevector(__builtin_bit_cast(v4i_t, lo), __builtin_bit_cast(v4i_t, hi), 0, 1, 2, 3, 4, 5, 6, 7); }
struct StaticOrder {
    int nM, nN, nwg, G, c;
    __host__ __device__ void init(int M, int N, int G_, int c_) { nM = M / BM; nN = N / BM; nwg = nM * nN; G = G_; c = c_; }
    __host__ __device__ bool next(int i, Unit& u) const {
        const long L = (long)i * G + c; if (L >= nwg) return false;
        int wgid = (int)L; { const int q = nwg / NXCD, r = nwg % NXCD, xcd = wgid % NXCD, off = wgid / NXCD; wgid = (xcd < r ? xcd * (q + 1) : r * (q + 1) + (xcd - r) * q) + off; }
        const int nig = WGM * nN, gid = wgid / nig, fm = gid * WGM, gsz = (nM - fm) < WGM ? (nM - fm) : WGM;
        u.pm = fm + ((wgid % nig) % gsz); u.pn = (wgid % nig) / gsz; return true;
    }
    __device__ __forceinline__ void a_ready(const Unit&) const {}
    __device__ __forceinline__ void done(const Unit&) const {}
};

struct MergeOrder { StaticOrder S;
    __device__ __forceinline__ bool next(int i, Unit& u) const { const int t = i / 3, seg = i - 3 * t; if (!S.next(t, u)) return false; u.pm += seg * 256; return true; }
    __device__ __forceinline__ void a_ready(const Unit&) const {}
    __device__ __forceinline__ void done(const Unit&) const {}
};

typedef float f32x2_t __attribute__((ext_vector_type(2))); typedef __bf16 bf16x2_t __attribute__((ext_vector_type(2)));
__device__ __forceinline__ unsigned cvt_pk_bf16(float lo, float hi) { f32x2_t v = {lo, hi}; bf16x2_t b = __builtin_convertvector(v, bf16x2_t); return __builtin_bit_cast(unsigned, b); }
__device__ __forceinline__ float bf_lo(unsigned w) { return __uint_as_float(w << 16); }
__device__ __forceinline__ float bf_hi(unsigned w) { return __uint_as_float(w & 0xffff0000u); }

__device__ __forceinline__ float lane_xor32(float v) { const unsigned b_ = __float_as_uint(v); auto r_ = __builtin_amdgcn_permlane32_swap(b_, b_, false, false); return __uint_as_float(r_[0] ^ r_[1] ^ b_); }
#define PG8_EPI_LOOP(...) \
    _Pragma("unroll") for (int ai = 0; ai < 2; ++ai) _Pragma("unroll") for (int m = 0; m < 4; ++m) _Pragma("unroll") for (int bj = 0; bj < 2; ++bj) { \
        const int row = u.pm * BM + ai * HALF + wr * 64 + m * 16 + fr; const int ct = bj * HALF + wc * 32 + 8 * fq;   \
        f32x4 v0 = acc[ai][bj][m][0], v1 = acc[ai][bj][m][1]; __VA_ARGS__ }
__device__ __forceinline__ u32x4 pack8(f32x4 v0, f32x4 v1) { u32x4 w; w.x = cvt_pk_bf16(v0[0], v0[1]); w.y = cvt_pk_bf16(v0[2], v0[3]); w.z = cvt_pk_bf16(v1[0], v1[1]); w.w = cvt_pk_bf16(v1[2], v1[3]); return w; }

struct EpiPlain { static constexpr bool PERM = true, AFTER_DRAIN = false, SEG3 = false; bf16_t* O; int ldc;
    __device__ __forceinline__ void operator()(const f32x4 (&acc)[2][2][4][2], const Unit& u, int wr, int wc, int fr, int fq) const {
        PG8_EPI_LOOP({ *(u32x4*)(O + (size_t)row * ldc + u.pn * BM + ct) = pack8(v0, v1); }) } };
struct EpiRoute { static constexpr bool PERM = true, AFTER_DRAIN = false, SEG3 = false; bf16_t* five; size_t five_stride; bf16_t* tail; size_t tail_stride;
    __device__ __forceinline__ void operator()(const f32x4 (&acc)[2][2][4][2], const Unit& u, int wr, int wc, int fr, int fq) const {
        bf16_t* base; int ldc, c0;
        if (u.pn < 10) { base = five + (size_t)(u.pn >> 1) * five_stride; ldc = 512; c0 = (u.pn & 1) * 256; } else { base = tail + (size_t)(u.pn - 10) * tail_stride; ldc = 256; c0 = 0; }
        PG8_EPI_LOOP({ *(u32x4*)(base + (size_t)row * ldc + c0 + ct) = pack8(v0, v1); }) } };
struct EpiRouteNorm { static constexpr bool PERM = true, AFTER_DRAIN = false, SEG3 = false; bf16_t* five; size_t five_stride; bf16_t* tail; size_t tail_stride; const float* gt; float* ssp; float eps; const int* pos; const float* gkr;
    __device__ __forceinline__ void operator()(const f32x4 (&acc)[2][2][4][2], const Unit& u, int wr, int wc, int fr, int fq) const {
        bf16_t* base; int ldc, c0;
        if (u.pn < 10) { base = five + (size_t)(u.pn >> 1) * five_stride; ldc = 512; c0 = (u.pn & 1) * 256; } else { base = tail + (size_t)(u.pn - 10) * tail_stride; ldc = 256; c0 = 0; }
        const bool nrm = (u.pn < 6) || (u.pn == 9 && wc >= 2);
        const bool krw = (u.pn == 11 && wc == 2);
        const bool part = (u.pn == 8) || (u.pn == 9 && wc < 2) || (u.pn == 10) || krw;
        const int gi = u.pn < 2 ? 0 : (u.pn < 4 ? 1 : (u.pn < 6 ? 2 : 3));
        const int slot = u.pn == 8 ? wc : (u.pn == 9 ? 4 + wc : (u.pn == 10 ? 8 + wc : 12));
        float kc_[8], kg_[8];
        if (krw) {
#pragma unroll
            for (int j = 0; j < 8; ++j) { kc_[j] = __builtin_amdgcn_exp2f(-(float)(8 * (fq & 1) + j) * 0.83048202372184f) * 0.15915494309189535f; kg_[j] = gkr[8 * fq + j]; } }
        f32x4 g00 = {1.f, 1.f, 1.f, 1.f}, g01 = g00, g10 = g00, g11 = g00;
        if (nrm) { const float* gp = gt + gi * 64 + 8 * fq; g00 = *(const f32x4*)gp; g01 = *(const f32x4*)(gp + 4); g10 = *(const f32x4*)(gp + 32); g11 = *(const f32x4*)(gp + 36); }
#pragma unroll
        for (int ai = 0; ai < 2; ++ai)
#pragma unroll
            for (int m = 0; m < 4; ++m) { const int row = u.pm * BM + ai * HALF + wr * 64 + m * 16 + fr;
                f32x4 v00 = acc[ai][0][m][0], v01 = acc[ai][0][m][1], v10 = acc[ai][1][m][0], v11 = acc[ai][1][m][1];
                if (nrm || part) {
                    float ss = 0.f;
#pragma unroll
                    for (int i = 0; i < 4; ++i) ss += (v00[i] * v00[i] + v01[i] * v01[i]) + (v10[i] * v10[i] + v11[i] * v11[i]);
                    { auto r_ = __builtin_amdgcn_permlane16_swap(__float_as_uint(ss), __float_as_uint(ss), false, false); ss = __uint_as_float(r_[0]) + __uint_as_float(r_[1]); }
                    { auto r_ = __builtin_amdgcn_permlane32_swap(__float_as_uint(ss), __float_as_uint(ss), false, false); ss = __uint_as_float(r_[0]) + __uint_as_float(r_[1]); }
                    if (nrm) { const float rs = __builtin_amdgcn_rsqf(ss * (1.0f / 64) + eps); v00 = v00 * rs * g00; v01 = v01 * rs * g01; v10 = v10 * rs * g10; v11 = v11 * rs * g11; }
                    if (part && fq == 0) ssp[(size_t)row * 16 + slot] = ss;
                }
                if (krw) {
                    const float posf = (float)pos[row];
#pragma unroll
                    for (int j = 0; j < 8; ++j) { const float own = j < 4 ? v00[j & 3] : v01[j & 3]; const float other = lane_xor32(own);
                        const float fr_ = __builtin_amdgcn_fractf(posf * kc_[j]); const float cs = __builtin_amdgcn_cosf(fr_), sn = __builtin_amdgcn_sinf(fr_);
                        const float o_ = (fq < 2 ? (own * cs - other * sn) : (other * sn + own * cs)) * kg_[j];
                        if (j < 4) v00[j & 3] = o_; else v01[j & 3] = o_; }
                }
                bf16_t* rp = base + (size_t)row * ldc + c0 + wc * 64 + 8 * fq;
                *(u32x4*)rp = pack8(v00, v01); *(u32x4*)(rp + 32) = pack8(v10, v11); } } };
struct EpiPlainRS { static constexpr bool PERM = true, AFTER_DRAIN = false, SEG3 = false; bf16_t* O; int ldc; const float* ssp; int s0, ns; float inv_n, eps;
    __device__ __forceinline__ void operator()(const f32x4 (&acc)[2][2][4][2], const Unit& u, int wr, int wc, int fr, int fq) const {
        float rs[2][4];
#pragma unroll
        for (int ai = 0; ai < 2; ++ai)
#pragma unroll
            for (int m = 0; m < 4; ++m) { const int row = u.pm * BM + ai * HALF + wr * 64 + m * 16 + fr;
                const float* sp = ssp + (size_t)row * 16 + s0; const f32x4 a = *(const f32x4*)sp; float ss = (a[0] + a[1]) + (a[2] + a[3]);
                if (ns > 4) { const f32x2 b = *(const f32x2*)(sp + 4); ss += b[0] + b[1]; }
                rs[ai][m] = __builtin_amdgcn_rsqf(ss * inv_n + eps); }
        __builtin_amdgcn_sched_barrier(0);
#pragma unroll
        for (int ai = 0; ai < 2; ++ai)
#pragma unroll
            for (int m = 0; m < 4; ++m) { const int row = u.pm * BM + ai * HALF + wr * 64 + m * 16 + fr;
#pragma unroll
                for (int bj = 0; bj < 2; ++bj) { const int ct = bj * HALF + wc * 32 + 8 * fq;
                    *(u32x4*)(O + (size_t)row * ldc + u.pn * BM + ct) = pack8(acc[ai][bj][m][0] * rs[ai][m], acc[ai][bj][m][1] * rs[ai][m]); } } } };
struct EpiKV { static constexpr bool PERM = true, AFTER_DRAIN = false, SEG3 = false; bf16_t* KB; bf16_t* KVR; const bf16_t* KR; const float* ssp; const float* gkn; float eps;
    __device__ __forceinline__ void operator()(const f32x4 (&acc)[2][2][4][2], const Unit& u, int wr, int wc, int fr, int fq) const {
        const bool kw = wc < 2; const int hd = 2 * u.pn + (wc & 1);
        f32x4 g00 = {1.f, 1.f, 1.f, 1.f}, g01 = g00, g10 = g00, g11 = g00;
        if (kw) { const float* gp = gkn + 8 * fq; g00 = *(const f32x4*)gp; g01 = *(const f32x4*)(gp + 4); g10 = *(const f32x4*)(gp + 32); g11 = *(const f32x4*)(gp + 36); }
#pragma unroll
        for (int ai = 0; ai < 2; ++ai) {
            float rs[4], ssr[4]; u32x4 krv[4];
#pragma unroll
            for (int m = 0; m < 4; ++m) { const int row = u.pm * BM + ai * HALF + wr * 64 + m * 16 + fr; const float* sp = ssp + (size_t)row * 16;
                const f32x4 a = *(const f32x4*)(sp + 8); rs[m] = __builtin_amdgcn_rsqf(((a[0] + a[1]) + (a[2] + a[3])) * (1.0f / 256) + eps); ssr[m] = sp[12];
                if (kw) krv[m] = *(const u32x4*)(KR + (size_t)row * 256 + 8 * fq); else krv[m] = (u32x4){0u, 0u, 0u, 0u}; }
            __builtin_amdgcn_sched_barrier(0);
#pragma unroll
            for (int m = 0; m < 4; ++m) { const int row = u.pm * BM + ai * HALF + wr * 64 + m * 16 + fr; const float r_ = rs[m];
                f32x4 v00 = acc[ai][0][m][0] * r_, v01 = acc[ai][0][m][1] * r_, v10 = acc[ai][1][m][0] * r_, v11 = acc[ai][1][m][1] * r_;
                if (kw) {
                    float ss = 0.f;
#pragma unroll
                    for (int i = 0; i < 4; ++i) ss += (v00[i] * v00[i] + v01[i] * v01[i]) + (v10[i] * v10[i] + v11[i] * v11[i]);
                    { auto q_ = __builtin_amdgcn_permlane16_swap(__float_as_uint(ss), __float_as_uint(ss), false, false); ss = __uint_as_float(q_[0]) + __uint_as_float(q_[1]); }
                    { auto q_ = __builtin_amdgcn_permlane32_swap(__float_as_uint(ss), __float_as_uint(ss), false, false); ss = __uint_as_float(q_[0]) + __uint_as_float(q_[1]); }
                    const float rk = __builtin_amdgcn_rsqf((ss + ssr[m]) * (1.0f / 96) + eps);
                    bf16_t* kp = KB + (size_t)row * 768 + hd * 96 + 8 * fq;
                    *(u32x4*)kp = pack8(v00 * rk * g00, v01 * rk * g01); *(u32x4*)(kp + 32) = pack8(v10 * rk * g10, v11 * rk * g11);
                    const u32x4 w = krv[m];
                    const f32x4 r0 = {bf_lo(w.x) * rk, bf_hi(w.x) * rk, bf_lo(w.y) * rk, bf_hi(w.y) * rk}, r1 = {bf_lo(w.z) * rk, bf_hi(w.z) * rk, bf_lo(w.w) * rk, bf_hi(w.w) * rk};
                    *(u32x4*)(kp + 64) = pack8(r0, r1);
                } else {
                    bf16_t* vp = KVR + (size_t)row * 1024 + 512 + hd * 64 + 8 * fq;
                    *(u32x4*)vp = pack8(v00, v01); *(u32x4*)(vp + 32) = pack8(v10, v11);
                } }
            __builtin_amdgcn_sched_barrier(0);
        } } };
struct EpiGate { static constexpr bool PERM = true, AFTER_DRAIN = false, SEG3 = false; unsigned char* g0; size_t gstride, gextra; float zs;
    __device__ __forceinline__ void operator()(const f32x4 (&acc)[2][2][4][2], const Unit& u, int wr, int wc, int fr, int fq) const {
        const int gi = u.pn >> 2; unsigned char* base = g0 + (size_t)((gi * 2) % 3) * gstride; const int c0 = (u.pn & 3) * 256;
        PG8_EPI_LOOP({
            _Pragma("unroll") for (int i = 0; i < 4; ++i) { v0[i] = 255.0f * __builtin_amdgcn_rcpf(1.0f + __builtin_amdgcn_exp2f(zs * v0[i])); v1[i] = 255.0f * __builtin_amdgcn_rcpf(1.0f + __builtin_amdgcn_exp2f(zs * v1[i])); }
            u32x2 w; w.x = 0u; w.y = 0u;
            w.x = __builtin_amdgcn_cvt_pk_u8_f32(v0[0], 0, w.x); w.x = __builtin_amdgcn_cvt_pk_u8_f32(v0[1], 1, w.x); w.x = __builtin_amdgcn_cvt_pk_u8_f32(v0[2], 2, w.x); w.x = __builtin_amdgcn_cvt_pk_u8_f32(v0[3], 3, w.x);
            w.y = __builtin_amdgcn_cvt_pk_u8_f32(v1[0], 0, w.y); w.y = __builtin_amdgcn_cvt_pk_u8_f32(v1[1], 1, w.y); w.y = __builtin_amdgcn_cvt_pk_u8_f32(v1[2], 2, w.y); w.y = __builtin_amdgcn_cvt_pk_u8_f32(v1[3], 3, w.y);
            *(u32x2*)(base + (size_t)row * 1024 + c0 + ct) = w; }) } };
struct EpiMerge { static constexpr bool PERM = true, AFTER_DRAIN = false, SEG3 = false; const unsigned char* gate; bf16_t* mg; int first;
    __device__ __forceinline__ void operator()(const f32x4 (&acc)[2][2][4][2], const Unit& u, int wr, int wc, int fr, int fq) const {
#pragma unroll
        for (int ai = 0; ai < 2; ++ai) {
            u32x2 gw[4][2]; u32x4 pw[4][2];
#pragma unroll
            for (int m = 0; m < 4; ++m)
#pragma unroll
                for (int bj = 0; bj < 2; ++bj) { const int row = u.pm * BM + ai * HALF + wr * 64 + m * 16 + fr; const int ct = bj * HALF + wc * 32 + 8 * fq;
                    const size_t off = (size_t)row * 1024 + u.pn * BM + ct;
                    gw[m][bj] = *(const u32x2*)(gate + off);
                    if (!first) pw[m][bj] = *(const u32x4*)(mg + off); else pw[m][bj] = (u32x4){0u, 0u, 0u, 0u}; }
            __builtin_amdgcn_sched_barrier(0);
#pragma unroll
            for (int m = 0; m < 4; ++m)
#pragma unroll
                for (int bj = 0; bj < 2; ++bj) { const int row = u.pm * BM + ai * HALF + wr * 64 + m * 16 + fr; const int ct = bj * HALF + wc * 32 + 8 * fq;
                    const size_t off = (size_t)row * 1024 + u.pn * BM + ct;
                    const u32x2 g = gw[m][bj]; const u32x4 p = pw[m][bj];
                    const f32x4 p0 = (f32x4){bf_lo(p.x), bf_hi(p.x), bf_lo(p.y), bf_hi(p.y)}, p1 = (f32x4){bf_lo(p.z), bf_hi(p.z), bf_lo(p.w), bf_hi(p.w)};
                    const float q8 = 1.0f / 255.0f;
                    const f32x4 g0v = (f32x4){(float)(g.x & 0xffu) * q8, (float)((g.x >> 8) & 0xffu) * q8, (float)((g.x >> 16) & 0xffu) * q8, (float)(g.x >> 24) * q8};
                    const f32x4 g1v = (f32x4){(float)(g.y & 0xffu) * q8, (float)((g.y >> 8) & 0xffu) * q8, (float)((g.y >> 16) & 0xffu) * q8, (float)(g.y >> 24) * q8};
                    *(u32x4*)(mg + off) = pack8(p0 + g0v * acc[ai][bj][m][0], p1 + g1v * acc[ai][bj][m][1]); }
        } } };
struct EpiMerge3 { static constexpr bool PERM = true, AFTER_DRAIN = false, SEG3 = true; const unsigned char* g; bf16_t* mg;
    static __device__ __forceinline__ f32x4 lo4(unsigned w) { return (f32x4){fmaxf((float)(w & 0xffu), 0.5f), fmaxf((float)((w >> 8) & 0xffu), 0.5f), fmaxf((float)((w >> 16) & 0xffu), 0.5f), fmaxf((float)(w >> 24), 0.5f)}; }
    __device__ __forceinline__ void operator()(f32x4 (&acc)[2][2][4][2], const Unit& u, int wr, int wc, int fr, int fq) const {
        const int seg = u.pm >> 8, pm = u.pm & 255;
        const unsigned char* gc = g + ((size_t)seg << 26);
        if (seg < 2) {
#pragma unroll
            for (int ai = 0; ai < 2; ++ai) {
                u32x2 ga[4][2], gb[4][2];
#pragma unroll
                for (int m = 0; m < 4; ++m)
#pragma unroll
                    for (int bj = 0; bj < 2; ++bj) { const int row = pm * BM + ai * HALF + wr * 64 + m * 16 + fr; const int ct = bj * HALF + wc * 32 + 8 * fq;
                        const size_t off = (size_t)row * 1024 + u.pn * BM + ct;
                        ga[m][bj] = *(const u32x2*)(gc + off); gb[m][bj] = *(const u32x2*)(gc + ((size_t)1 << 26) + off); }
                __builtin_amdgcn_sched_barrier(0);
#pragma unroll
                for (int m = 0; m < 4; ++m)
#pragma unroll
                    for (int bj = 0; bj < 2; ++bj) {
                        const f32x4 a0 = lo4(ga[m][bj].x), a1 = lo4(ga[m][bj].y), b0 = lo4(gb[m][bj].x), b1 = lo4(gb[m][bj].y);
#pragma unroll
                        for (int i = 0; i < 4; ++i) { acc[ai][bj][m][0][i] *= a0[i] * __builtin_amdgcn_rcpf(b0[i]); acc[ai][bj][m][1][i] *= a1[i] * __builtin_amdgcn_rcpf(b1[i]); } }
            }
        } else {
#pragma unroll
            for (int ai = 0; ai < 2; ++ai) {
                u32x2 ga[4][2];
#pragma unroll
                for (int m = 0; m < 4; ++m)
#pragma unroll
                    for (int bj = 0; bj < 2; ++bj) { const int row = pm * BM + ai * HALF + wr * 64 + m * 16 + fr; const int ct = bj * HALF + wc * 32 + 8 * fq;
                        ga[m][bj] = *(const u32x2*)(gc + (size_t)row * 1024 + u.pn * BM + ct); }
                __builtin_amdgcn_sched_barrier(0);
#pragma unroll
                for (int m = 0; m < 4; ++m)
#pragma unroll
                    for (int bj = 0; bj < 2; ++bj) { const int row = pm * BM + ai * HALF + wr * 64 + m * 16 + fr; const int ct = bj * HALF + wc * 32 + 8 * fq;
                        const float q8 = 1.0f / 255.0f;
                        const f32x4 a0 = lo4(ga[m][bj].x) * q8, a1 = lo4(ga[m][bj].y) * q8;
                        *(u32x4*)(mg + (size_t)row * 1024 + u.pn * BM + ct) = pack8(acc[ai][bj][m][0] * a0, acc[ai][bj][m][1] * a1); }
            }
        } } };
struct EpiResid { static constexpr bool PERM = true, AFTER_DRAIN = false, SEG3 = false; const void* xi; int in_bf16; bf16_t* xo;
    __device__ __forceinline__ void operator()(const f32x4 (&acc)[2][2][4][2], const Unit& u, int wr, int wc, int fr, int fq) const {
#pragma unroll
        for (int ai = 0; ai < 2; ++ai) {
            f32x4 xa[4][2], xb[4][2];
#pragma unroll
            for (int m = 0; m < 4; ++m)
#pragma unroll
                for (int bj = 0; bj < 2; ++bj) { const int row = u.pm * BM + ai * HALF + wr * 64 + m * 16 + fr; const int ct = bj * HALF + wc * 32 + 8 * fq;
                    const size_t off = (size_t)row * 1024 + u.pn * BM + ct;
                    if (in_bf16) { const u32x4 w = *(const u32x4*)((const bf16_t*)xi + off);
                        xa[m][bj] = (f32x4){__uint_as_float(w.x << 16), __uint_as_float(w.x & 0xffff0000u), __uint_as_float(w.y << 16), __uint_as_float(w.y & 0xffff0000u)};
                        xb[m][bj] = (f32x4){__uint_as_float(w.z << 16), __uint_as_float(w.z & 0xffff0000u), __uint_as_float(w.w << 16), __uint_as_float(w.w & 0xffff0000u)}; }
                    else { xa[m][bj] = *(const f32x4*)((const float*)xi + off); xb[m][bj] = *(const f32x4*)((const float*)xi + off + 4); } }
            __builtin_amdgcn_sched_barrier(0);
#pragma unroll
            for (int m = 0; m < 4; ++m)
#pragma unroll
                for (int bj = 0; bj < 2; ++bj) { const int row = u.pm * BM + ai * HALF + wr * 64 + m * 16 + fr; const int ct = bj * HALF + wc * 32 + 8 * fq;
                    const size_t off = (size_t)row * 1024 + u.pn * BM + ct;
                    *(u32x4*)(xo + off) = pack8(xa[m][bj] + acc[ai][bj][m][0], xb[m][bj] + acc[ai][bj][m][1]); }
        } } };
__device__ __forceinline__ u32x2 pack8_fp8(f32x4 v0, f32x4 v1) {
    _Pragma("unroll") for (int i = 0; i < 4; ++i) { v0[i] = fminf(fmaxf(v0[i], -448.f), 448.f); v1[i] = fminf(fmaxf(v1[i], -448.f), 448.f); }
    int a = 0, b = 0; a = __builtin_amdgcn_cvt_pk_fp8_f32(v0[0], v0[1], a, false); a = __builtin_amdgcn_cvt_pk_fp8_f32(v0[2], v0[3], a, true);
    b = __builtin_amdgcn_cvt_pk_fp8_f32(v1[0], v1[1], b, false); b = __builtin_amdgcn_cvt_pk_fp8_f32(v1[2], v1[3], b, true); u32x2 w; w.x = (unsigned)a; w.y = (unsigned)b; return w; }
struct EpiSwiglu { static constexpr bool PERM = true, AFTER_DRAIN = false, SEG3 = false; unsigned char* hid; float iscale, oscale;
    __device__ __forceinline__ void operator()(const f32x4 (&acc)[2][2][4][2], const Unit& u, int wr, int wc, int fr, int fq) const {
#pragma unroll
        for (int ai = 0; ai < 2; ++ai)
#pragma unroll
            for (int m = 0; m < 4; ++m) { const int row = u.pm * BM + ai * HALF + wr * 64 + m * 16 + fr; const int col = u.pn * 128 + wc * 32 + 8 * fq;
                f32x4 o0, o1;
#pragma unroll
                for (int i = 0; i < 4; ++i) { const float g0 = acc[ai][0][m][0][i] * iscale, g1 = acc[ai][0][m][1][i] * iscale;
                    o0[i] = g0 * __builtin_amdgcn_rcpf(1.0f + __builtin_amdgcn_exp2f(-1.4426950408889634f * g0)) * (acc[ai][1][m][0][i] * iscale);
                    o1[i] = g1 * __builtin_amdgcn_rcpf(1.0f + __builtin_amdgcn_exp2f(-1.4426950408889634f * g1)) * (acc[ai][1][m][1][i] * iscale); }
                *(u32x2*)(hid + (size_t)row * 1024 + col) = pack8_fp8(o0 * oscale, o1 * oscale); } } };
struct EpiDown { static constexpr bool PERM = true, AFTER_DRAIN = false, SEG3 = false; unsigned char* Y; const float* aff; float iscale;
    __device__ __forceinline__ void operator()(const f32x4 (&acc)[2][2][4][2], const Unit& u, int wr, int wc, int fr, int fq) const {
        float a[2][4];
#pragma unroll
        for (int ai = 0; ai < 2; ++ai)
#pragma unroll
            for (int m = 0; m < 4; ++m) a[ai][m] = aff[u.pm * BM + ai * HALF + wr * 64 + m * 16 + fr] * iscale;
        __builtin_amdgcn_sched_barrier(0);
        PG8_EPI_LOOP({ v0 = v0 * a[ai][m]; v1 = v1 * a[ai][m]; *(u32x2*)(Y + (size_t)row * 1024 + u.pn * BM + ct) = pack8_fp8(v0, v1); }) } };

template <class Epi, class Sched, bool ALIGN_EPI = false, bool SP2 = false, bool F8 = false, bool AG = false>
__device__ __forceinline__ void gemm_phase(PG8_LAS unsigned char* lds, const Gemm g, const Sched& S, const Epi& E) {
    int tid_ = threadIdx.x; asm volatile("" : "+v"(tid_));
    const int tid = tid_, wid = __builtin_amdgcn_readfirstlane(tid >> 6), lane = tid & 63, wr = wid >> 2, wc = wid & 3, fr = lane & 15, fq = lane >> 4;
    const int K = g.K, nt = K / BK, lda = g.lda;
    unsigned voffA[2], voffB[2];
#pragma unroll
    for (int i = 0; i < 2; ++i) { int R, C; stage_rc(tid * 16 + i * 8192, R, C); const int Rb = Epi::PERM ? ((R & ~31) + perm32(R & 31)) : R;
        voffA[i] = (unsigned)(R * lda + C) * 2u; voffB[i] = (unsigned)(Rb * K + C) * 2u; }
    const size_t kstep = (size_t)(BK * 2);
    const size_t hstepA = (size_t)HALF * lda * 2, hstepB = (size_t)HALF * K * 2;
    const size_t tstepA = 2 * hstepA, tstepB = 2 * hstepB;
    const unsigned ldsw = (unsigned)wid * 1024u;
    const int aoff = lds_byte(wr * 64 + fr, fq * 8), boff = lds_byte(wc * 32 + fr, fq * 8);
#define PG8_SA(b, h) (((b) * 2 + (h)) * HTB)
#define PG8_SB(b, h) ((4 + (b) * 2 + (h)) * HTB)
#define PG8_STAGE(bufoff, gbase, voff) do { _Pragma("unroll") for (int _i = 0; _i < 2; ++_i) \
        __builtin_amdgcn_global_load_lds((const unsigned*)((const char*)(gbase) + (voff)[_i]), (PG8_LAS unsigned*)(lds + (bufoff) + ldsw + _i * 8192), 16, 0, 0); } while (0)
#define PG8_STAGE_A(bufoff, abase, hh, V) do { if constexpr (AG) { PG8_STAGE(bufoff, abase, (V)[hh]); } else { PG8_STAGE(bufoff, (abase) + (hh) * hstepA, voffA); } } while (0)
#define PG8_LDA(dst, b, h) do { _Pragma("unroll") for (int m = 0; m < 4; ++m) { if constexpr (F8) { dst##8[m] = cat8(*(const PG8_LAS bf16x8*)(lds + PG8_SA(b, h) + aoff + m * 2048), *(const PG8_LAS bf16x8*)(lds + PG8_SA(b, h) + aoff + m * 2048 + 1024)); } \
        else { _Pragma("unroll") for (int k = 0; k < 2; ++k) dst[m][k] = *(const PG8_LAS bf16x8*)(lds + PG8_SA(b, h) + aoff + m * 2048 + k * 1024); } } } while (0)
#define PG8_LDB(dst, b, h) do { _Pragma("unroll") for (int n = 0; n < 2; ++n) { if constexpr (F8) { dst##8[n] = cat8(*(const PG8_LAS bf16x8*)(lds + PG8_SB(b, h) + boff + n * 2048), *(const PG8_LAS bf16x8*)(lds + PG8_SB(b, h) + boff + n * 2048 + 1024)); } \
        else { _Pragma("unroll") for (int k = 0; k < 2; ++k) dst[n][k] = *(const PG8_LAS bf16x8*)(lds + PG8_SB(b, h) + boff + n * 2048 + k * 1024); } } } while (0)
#define PG8_MMA(ai, bj, At, Bt) do { __builtin_amdgcn_s_setprio(1); _Pragma("unroll") for (int m = 0; m < 4; ++m) _Pragma("unroll") for (int n = 0; n < 2; ++n) { \
        if constexpr (F8) { asm volatile("v_mfma_f32_16x16x128_f8f6f4 %0, %1, %2, %0" : "+v"(acc[ai][bj][m][n]) : "v"(Bt##8[n]), "v"(At##8[m])); }     \
        else { _Pragma("unroll") for (int k = 0; k < 2; ++k) acc[ai][bj][m][n] = __builtin_amdgcn_mfma_f32_16x16x32_bf16(Bt[n][k], At[m][k], acc[ai][bj][m][n], 0, 0, 0); } } \
        __builtin_amdgcn_s_setprio(0); } while (0)
#define PG8_WAIT_V(n) asm volatile("s_waitcnt vmcnt(" #n ")" ::: "memory")
#define PG8_WAIT_L(n) asm volatile("s_waitcnt lgkmcnt(" #n ")" ::: "memory")
#define PG8_BAR __builtin_amdgcn_s_barrier()
#define PG8_SCHED __builtin_amdgcn_sched_barrier(0)
    Unit cur, nxt; int ui = 0;
    if (!S.next(0, cur)) return;
    f32x4 acc[2][2][4][2];
#define PG8_Z z0_
    { float z0_ = 0.f; asm volatile("" : "+v"(z0_));
#pragma unroll
    for (int a = 0; a < 2; ++a)
#pragma unroll
        for (int b = 0; b < 2; ++b)
#pragma unroll
            for (int m = 0; m < 4; ++m)
#pragma unroll
                for (int n = 0; n < 2; ++n) acc[a][b][m][n] = (f32x4){PG8_Z, PG8_Z, PG8_Z, PG8_Z}; }
    bf16x8 At[4][2], B0[2][2], B1[2][2]; v8i_t At8[4], B08[2], B18[2]; (void)At; (void)B0; (void)B1; (void)At8; (void)B08; (void)B18;
    const char* cA = AG ? (const char*)g.A : (const char*)g.A + (size_t)cur.pm * tstepA + (Epi::SEG3 ? (size_t)(cur.pm >> 9) * g.a_extra : (size_t)0); const char* cB = (const char*)g.Bt + g.grp_off(cur.pm) + (size_t)cur.pn * tstepB;
    S.a_ready(cur);
    unsigned vgc[2][2], vgn[2][2], vsel[2][2]; (void)vgc; (void)vgn; (void)vsel;
#define PG8_AG_LOAD(dst, un) do { _Pragma("unroll") for (int hh = 0; hh < 2; ++hh) _Pragma("unroll") for (int i = 0; i < 2; ++i) { int R, C; stage_rc(tid * 16 + i * 8192, R, C); \
        const int r_ = (un).pm * BM + hh * HALF + R; const int tok_ = ((((un).pm >> 1) & 15) << 12) + g.rowmap[r_]; dst[hh][i] = (unsigned)(tok_ * lda + C) * 2u; } } while (0)
    if constexpr (AG) { PG8_AG_LOAD(vgc, cur); }
    if constexpr (SP2) {
        PG8_STAGE(PG8_SB(0, 0), cB, voffB); PG8_STAGE(PG8_SB(0, 1), cB + hstepB, voffB); PG8_STAGE_A(PG8_SA(0, 0), cA, 0, vgc); PG8_STAGE_A(PG8_SA(0, 1), cA, 1, vgc);
        if (wr == 1) PG8_BAR;
        PG8_WAIT_V(2); PG8_BAR;
        PG8_STAGE(PG8_SB(1, 0), cB + kstep, voffB); PG8_STAGE_A(PG8_SA(1, 0), cA + kstep, 0, vgc); PG8_STAGE(PG8_SB(1, 1), cB + hstepB + kstep, voffB);
        PG8_WAIT_V(6); PG8_BAR;
    } else {
        PG8_STAGE(PG8_SB(0, 0), cB, voffB); PG8_STAGE_A(PG8_SA(0, 0), cA, 0, vgc); PG8_STAGE(PG8_SB(0, 1), cB + hstepB, voffB); PG8_STAGE_A(PG8_SA(0, 1), cA, 1, vgc);
        if (wr == 1) PG8_BAR;
        PG8_WAIT_V(4); PG8_BAR;
        PG8_STAGE(PG8_SB(1, 0), cB + kstep, voffB); PG8_STAGE_A(PG8_SA(1, 0), cA + kstep, 0, vgc); PG8_STAGE(PG8_SB(1, 1), cB + hstepB + kstep, voffB);
        PG8_WAIT_V(6); PG8_BAR;
    }
    for (;;) {
        const bool has_next = S.next(ui + 1, nxt);
        if constexpr (AG) { if (has_next) { PG8_AG_LOAD(vgn, nxt); } }
        const char* nA = (has_next && !AG) ? (const char*)g.A + (size_t)nxt.pm * tstepA + (Epi::SEG3 ? (size_t)(nxt.pm >> 9) * g.a_extra : (size_t)0) : cA; const char* nB = has_next ? (const char*)g.Bt + g.grp_off(nxt.pm) + (size_t)nxt.pn * tstepB : cB;
#pragma unroll 1
        for (int t = 0; t < nt; t += 2) {
            const bool last = (t == nt - 2);
            const char* a1 = cA + (size_t)(t + 1) * kstep;
            const char* a2 = last ? nA : cA + (size_t)(t + 2) * kstep; const char* b2 = last ? nB : cB + (size_t)(t + 2) * kstep;
            const char* a3 = a2 + kstep; const char* b3 = b2 + kstep;
            if constexpr (AG) { _Pragma("unroll") for (int hh = 0; hh < 2; ++hh) _Pragma("unroll") for (int i = 0; i < 2; ++i) vsel[hh][i] = (last && has_next) ? vgn[hh][i] : vgc[hh][i]; }
            if (last && has_next) S.a_ready(nxt);
            if constexpr (SP2) {
            PG8_LDB(B0, 0, 0); PG8_LDB(B1, 0, 1); PG8_SCHED; PG8_LDA(At, 0, 0); PG8_STAGE_A(PG8_SA(1, 1), a1, 1, vgc);
            PG8_WAIT_V(8); PG8_WAIT_L(0); PG8_BAR; PG8_MMA(0, 0, At, B0); PG8_MMA(0, 1, At, B1); PG8_BAR; PG8_SCHED;
            PG8_LDA(At, 0, 1); PG8_STAGE(PG8_SB(0, 0), b2, voffB); PG8_STAGE(PG8_SB(0, 1), b2 + hstepB, voffB); PG8_STAGE_A(PG8_SA(0, 0), a2, 0, vsel);
            PG8_WAIT_V(8); PG8_WAIT_L(0); PG8_BAR; PG8_MMA(1, 0, At, B0); PG8_MMA(1, 1, At, B1); PG8_BAR; PG8_SCHED;
            PG8_LDB(B0, 1, 0); PG8_LDB(B1, 1, 1); PG8_SCHED; PG8_LDA(At, 1, 0); PG8_STAGE_A(PG8_SA(0, 1), a2, 1, vsel);
            PG8_WAIT_V(8); PG8_WAIT_L(0); PG8_BAR; PG8_MMA(0, 0, At, B0); PG8_MMA(0, 1, At, B1); PG8_BAR; PG8_SCHED;
            PG8_LDA(At, 1, 1); PG8_STAGE(PG8_SB(1, 0), b3, voffB); PG8_STAGE(PG8_SB(1, 1), b3 + hstepB, voffB); PG8_STAGE_A(PG8_SA(1, 0), a3, 0, vsel);
            PG8_WAIT_V(8); PG8_WAIT_L(0); PG8_BAR; PG8_MMA(1, 0, At, B0); PG8_MMA(1, 1, At, B1); PG8_BAR; PG8_SCHED;
            } else {
            PG8_LDB(B0, 0, 0); PG8_SCHED; PG8_LDA(At, 0, 0); PG8_STAGE_A(PG8_SA(1, 1), a1, 1, vgc);
            PG8_WAIT_L(8); PG8_BAR; PG8_WAIT_L(0); PG8_MMA(0, 0, At, B0); PG8_BAR; PG8_SCHED;
            PG8_LDB(B1, 0, 1); PG8_STAGE(PG8_SB(0, 0), b2, voffB);
            PG8_BAR; PG8_WAIT_L(0); PG8_MMA(0, 1, At, B1); PG8_BAR;
            PG8_LDA(At, 0, 1); PG8_STAGE_A(PG8_SA(0, 0), a2, 0, vsel);
            PG8_BAR; PG8_WAIT_L(0); PG8_MMA(1, 0, At, B0); PG8_BAR; PG8_SCHED;
            PG8_STAGE(PG8_SB(0, 1), b2 + hstepB, voffB);
            PG8_WAIT_V(6); PG8_BAR; PG8_MMA(1, 1, At, B1); PG8_BAR;
            PG8_LDB(B0, 1, 0); PG8_SCHED; PG8_LDA(At, 1, 0); PG8_STAGE_A(PG8_SA(0, 1), a2, 1, vsel);
            PG8_WAIT_L(8); PG8_BAR; PG8_WAIT_L(0); PG8_MMA(0, 0, At, B0); PG8_BAR; PG8_SCHED;
            PG8_LDB(B1, 1, 1); PG8_STAGE(PG8_SB(1, 0), b3, voffB);
            PG8_BAR; PG8_WAIT_L(0); PG8_MMA(0, 1, At, B1); PG8_BAR;
            PG8_LDA(At, 1, 1); PG8_STAGE_A(PG8_SA(1, 0), a3, 0, vsel);
            PG8_BAR; PG8_WAIT_L(0); PG8_MMA(1, 0, At, B0); PG8_BAR; PG8_SCHED;
            PG8_STAGE(PG8_SB(1, 1), b3 + hstepB, voffB);
            PG8_WAIT_V(6); PG8_BAR; PG8_MMA(1, 1, At, B1); PG8_BAR;
            }
        }
        if constexpr (F8) { asm volatile("s_nop 15\n\ts_nop 15" ::: "memory"); }
        if constexpr (ALIGN_EPI) { if (wr == 0) PG8_BAR; }
        if constexpr (!Epi::AFTER_DRAIN) { E(acc, cur, wr, wc, fr, fq); S.done(cur); }
        if (!has_next) break;
        if (!Epi::SEG3 || nxt.pm < 256) { float z0_ = 0.f; asm volatile("" : "+v"(z0_));
#pragma unroll
        for (int a = 0; a < 2; ++a)
#pragma unroll
            for (int b = 0; b < 2; ++b)
#pragma unroll
                for (int m = 0; m < 4; ++m)
#pragma unroll
                    for (int n = 0; n < 2; ++n) acc[a][b][m][n] = (f32x4){PG8_Z, PG8_Z, PG8_Z, PG8_Z}; }
        cur = nxt; cA = nA; cB = nB; ++ui;
        if constexpr (AG) { _Pragma("unroll") for (int hh = 0; hh < 2; ++hh) _Pragma("unroll") for (int i = 0; i < 2; ++i) vgc[hh][i] = vgn[hh][i]; }
        if constexpr (ALIGN_EPI) { if (wr == 1) PG8_BAR; }
    }
    PG8_WAIT_V(0);
    if constexpr (!ALIGN_EPI) { if (wr == 0) PG8_BAR; }
    PG8_BAR;
    if constexpr (Epi::AFTER_DRAIN) { E.fused(acc, cur, wr, wc, fr, fq, lds, wid, lane); S.done(cur); }
#undef PG8_Z
#undef PG8_SA
#undef PG8_SB
#undef PG8_STAGE
#undef PG8_STAGE_A
#undef PG8_AG_LOAD
#undef PG8_LDA
#undef PG8_LDB
#undef PG8_MMA
#undef PG8_WAIT_V
#undef PG8_WAIT_L
#undef PG8_BAR
#undef PG8_SCHED
}
}

constexpr int NB = 16, SEQ = 4096, DM = 1024, T = NB * SEQ, DEPTH = 2;
constexpr int NEXP = 16, CAP = 512, TE = NB * NEXP * CAP;
constexpr int IN_COLS = 6048;
constexpr float EPS = 1e-6f;
constexpr float LOG2E = 1.4426950408889634f;
constexpr int NWAVES = 8;
constexpr int PH_PER_LAYER = 16, NPHASE = DEPTH * PH_PER_LAYER;

constexpr size_t MiB = 1u << 20;
constexpr size_t WS_CTL = 0, CTL_ZERO_BYTES = 1 * MiB;
constexpr size_t WS_AFFT = 2 * MiB;
constexpr size_t WS_INV = 6 * MiB;
constexpr size_t WS_IDX = 10 * MiB;
constexpr size_t WS_AFFSEL = 10 * MiB + 512 * 1024;
constexpr size_t WS_TMM = 11 * MiB;
constexpr size_t WS_GT = 11 * MiB + 16 * 1024;
constexpr size_t WS_SSP = 2 * MiB;
constexpr size_t WS_WIN = 12 * MiB;
constexpr size_t WS_WUQ = 24 * MiB;
constexpr size_t WS_WUKV = 25 * MiB;
constexpr size_t WS_WBA = 26 * MiB, WS_WBC = 27 * MiB, WS_WBB = 28 * MiB;
constexpr size_t WS_WO = 29 * MiB;
constexpr size_t WS_WGU = 32 * MiB;
constexpr size_t WS_WD = 64 * MiB;
constexpr size_t WS_WG8 = 80 * MiB;
constexpr size_t WS_H8 = 864 * MiB;
constexpr float Y_SCALE = 64.0f;
constexpr float W8_SCALE = 64.0f, HID_SCALE = 4.0f;
constexpr int W8_E8M0 = 127 - 6, HID_E8M0 = 127 - 2, ONE_E8M0 = 127;
constexpr size_t WS_H = 128 * MiB;
constexpr size_t WS_QA = 256 * MiB, WS_QC = 320 * MiB, WS_KA = 384 * MiB, WS_VA = 448 * MiB, WS_CQKC = 512 * MiB;
constexpr size_t WS_CKV = 576 * MiB, WS_VCKR = 608 * MiB;
constexpr size_t WS_G0 = 384 * MiB;
constexpr size_t WS_QB = 640 * MiB;
constexpr size_t WS_KVR = 736 * MiB;
constexpr size_t WS_G1 = 448 * MiB, WS_G2 = 512 * MiB;
constexpr size_t WS_KB = 864 * MiB;
constexpr size_t WS_OB = 960 * MiB;
constexpr size_t WS_XG = 256 * MiB;
constexpr size_t WS_HID = 512 * MiB;
constexpr size_t WS_XB = 768 * MiB;
constexpr size_t H8_OUT_OFF = 128 * MiB;
constexpr size_t WS_END = 1024 * MiB;

constexpr int RING_OFF = 0, RING_BYTES = 131072;
constexpr int LDS_BYTES = 163840;
constexpr int LDSCTL_OFF = LDS_BYTES - 1024, MISC_OFF = LDSCTL_OFF + 320;
constexpr int ATT_NXT_OFF = LDSCTL_OFF - 64;
constexpr int ATT_STASH_OFF = 86528;

#define LAS __attribute__((address_space(3)))
typedef unsigned short bf16;
typedef unsigned v4u __attribute__((ext_vector_type(4)));
typedef unsigned v2u __attribute__((ext_vector_type(2)));
typedef float f32x4 __attribute__((ext_vector_type(4)));
typedef float f32x2 __attribute__((ext_vector_type(2)));
typedef float f32x16 __attribute__((ext_vector_type(16)));
typedef short bf16x8 __attribute__((ext_vector_type(8)));
typedef short s16x4 __attribute__((ext_vector_type(4)));
#define LDS_WAIT() asm volatile("s_waitcnt lgkmcnt(0)" ::: "memory")
#define VM_WAIT() asm volatile("s_waitcnt vmcnt(0)" ::: "memory")
__device__ __forceinline__ unsigned pk2(float lo, float hi) { return pg8::cvt_pk_bf16(lo, hi); }
__device__ __forceinline__ float bflo(unsigned w) { return __uint_as_float(w << 16); }
__device__ __forceinline__ float bfhi(unsigned w) { return __uint_as_float(w & 0xffff0000u); }
template <int M> __device__ __forceinline__ float xor_add(float v) {
    if constexpr (M < 32) return v + __int_as_float(__builtin_amdgcn_ds_swizzle(__float_as_int(v), (M << 10) | 0x1f));
    else { auto r = __builtin_amdgcn_permlane32_swap(__float_as_uint(v), __float_as_uint(v), false, false); return __uint_as_float(r[0]) + __uint_as_float(r[1]); } }
template <int M> __device__ __forceinline__ float xor_max(float v) {
    if constexpr (M < 32) return fmaxf(v, __int_as_float(__builtin_amdgcn_ds_swizzle(__float_as_int(v), (M << 10) | 0x1f)));
    else { auto r = __builtin_amdgcn_permlane32_swap(__float_as_uint(v), __float_as_uint(v), false, false); return fmaxf(__uint_as_float(r[0]), __uint_as_float(r[1])); } }
template <int M> __device__ __forceinline__ int xor_geti(int v) { static_assert(M < 32, "xor_geti: masks below 32"); return __builtin_amdgcn_ds_swizzle(v, (M << 10) | 0x1f); }
template <int M> __device__ __forceinline__ float xor_getf(float v) { return __int_as_float(xor_geti<M>(__float_as_int(v))); }
__device__ __forceinline__ unsigned wave_sum_u(unsigned c) {
    c += (unsigned)xor_geti<1>((int)c); c += (unsigned)xor_geti<2>((int)c); c += (unsigned)xor_geti<4>((int)c); c += (unsigned)xor_geti<8>((int)c); c += (unsigned)xor_geti<16>((int)c);
    auto r = __builtin_amdgcn_permlane32_swap(c, c, false, false); return r[0] + r[1]; }
__device__ __forceinline__ float wave_sum(float v) { v = xor_add<1>(v); v = xor_add<2>(v); v = xor_add<4>(v); v = xor_add<8>(v); v = xor_add<16>(v); return xor_add<32>(v); }

#define XB_TMO      128
#define XB_XCNT(j)  (256  + 64 * (j))
#define XB_XSUB(j)  (1280 + 64 * (j))
#define XB_XGEN(j)  (2304 + 64 * (j))
#define XB_TOP      3328
#define XB_TOPGEN   3392
#define XCD_BAR_WORDS 3456
#define XB_SPIN_CAP (1u << 23)

__device__ __forceinline__ unsigned xb_ld(unsigned* p)              { return __hip_atomic_load(p, __ATOMIC_RELAXED, __HIP_MEMORY_SCOPE_AGENT); }
__device__ __forceinline__ unsigned xb_add(unsigned* p, unsigned v) { return __hip_atomic_fetch_add(p, v, __ATOMIC_RELAXED, __HIP_MEMORY_SCOPE_AGENT); }
__device__ __forceinline__ unsigned xb_xcc_id() { return (unsigned)__builtin_amdgcn_s_getreg((3 << 11) | 20) & 0xFu; }
#define XB_SPIN(cond, bar) do { unsigned _sp = 0; while (cond) { __builtin_amdgcn_s_sleep(1); \
    if ((++_sp & 255u) == 0u) { if (xb_ld(&(bar)[XB_TMO])) break; if (_sp > XB_SPIN_CAP) { atomicAdd(&(bar)[XB_TMO], 1u); break; } } } } while (0)

struct XcdBarrier { unsigned* bar; unsigned x; volatile LAS unsigned* st; };

__device__ __forceinline__ XcdBarrier xcd_barrier_post(unsigned* bar, volatile LAS unsigned* st) {
    XcdBarrier b; b.bar = bar; b.x = xb_xcc_id(); b.st = st;
    if (threadIdx.x == 0) (void)xb_add(&bar[XB_XCNT(b.x)], 1u);
    return b;
}
__device__ __forceinline__ void xcd_barrier_complete(unsigned* bar, unsigned x, unsigned& nloc, unsigned& nx) {
    const unsigned G = gridDim.x * gridDim.y * gridDim.z;
    unsigned sum, cnt, mine, sp = 0u;
    for (;;) {
        sum = 0u; cnt = 0u; mine = 0u;
#pragma unroll
        for (unsigned j = 0; j < 16; ++j) { const unsigned c = xb_ld(&bar[XB_XCNT(j)]); sum += c; cnt += (c > 0u) ? 1u : 0u; mine = (j == x) ? c : mine; }
        if (sum == G) break;
        __builtin_amdgcn_s_sleep(1);
        if ((++sp & 255u) == 0u) { if (xb_ld(&bar[XB_TMO])) break; if (sp > XB_SPIN_CAP) { atomicAdd(&bar[XB_TMO], 1u); break; } }
    }
    nloc = mine > 0u ? mine : 1u; nx = cnt > 0u ? cnt : 1u;
}
__device__ __forceinline__ void xcd_barrier(const XcdBarrier& b) {
    asm volatile("s_waitcnt vmcnt(0)" ::: "memory");
    __syncthreads();
    if (threadIdx.x == 0) {
        unsigned* bar = b.bar;
        __builtin_amdgcn_s_waitcnt(0);
        unsigned nloc = b.st[0], nx = b.st[1];
        if (nloc == 0u) { xcd_barrier_complete(bar, b.x, nloc, nx); b.st[0] = nloc; b.st[1] = nx; }
        const unsigned old = xb_add(&bar[XB_XSUB(b.x)], 1u);
        const unsigned gen = old / nloc;
        if (old + 1u == (gen + 1u) * nloc) {
            __builtin_amdgcn_fence(__ATOMIC_RELEASE, "agent");
            asm volatile("s_waitcnt vmcnt(0)" ::: "memory");
            const unsigned og = xb_add(&bar[XB_TOP], 1u);
            const unsigned tg = og / nx;
            if (og + 1u == (tg + 1u) * nx) xb_add(&bar[XB_TOPGEN], 1u);
            else XB_SPIN(xb_ld(&bar[XB_TOPGEN]) == tg, bar);
            __builtin_amdgcn_fence(__ATOMIC_ACQUIRE, "agent");
            xb_add(&bar[XB_XGEN(b.x)], 1u);
            asm volatile("s_waitcnt vmcnt(0)" ::: "memory");
        } else {
            XB_SPIN(xb_ld(&bar[XB_XGEN(b.x)]) == gen, bar);
            __builtin_amdgcn_fence(__ATOMIC_ACQUIRE, "agent");
            asm volatile("s_waitcnt vmcnt(0)" ::: "memory");
        }
    }
    __syncthreads();
}

struct Frame {
    LAS unsigned char* lds;
    int wave, vcu, G;
};

__device__ __forceinline__ void cvt_block(const float* W, int K, int Nsrc, int k0, int n0, bf16* WT, int drow0, LAS float* scr, int lane, const float* kscale = nullptr) {
    float wv_[32];
#pragma unroll
    for (int i = 0; i < 32; ++i) wv_[i] = W[(size_t)(k0 + 2 * i + (lane >> 5)) * Nsrc + n0 + (lane & 31)];
    if (kscale) {
#pragma unroll
        for (int i = 0; i < 32; ++i) wv_[i] *= kscale[k0 + 2 * i + (lane >> 5)]; }
#pragma unroll
    for (int i = 0; i < 32; ++i) scr[(2 * i + (lane >> 5)) * 33 + (lane & 31)] = wv_[i];
    LDS_WAIT(); asm volatile("" ::: "memory");
    const int c = lane & 7;
#pragma unroll
    for (int j = 0; j < 4; ++j) { const int n = (lane >> 3) + 8 * j; const LAS float* s = scr + (8 * c) * 33 + n;
        v4u o; o.x = pk2(s[0 * 33], s[1 * 33]); o.y = pk2(s[2 * 33], s[3 * 33]); o.z = pk2(s[4 * 33], s[5 * 33]); o.w = pk2(s[6 * 33], s[7 * 33]);
        *(v4u*)(WT + (size_t)(drow0 + n) * K + k0 + 8 * c) = o; }
    LDS_WAIT(); asm volatile("" ::: "memory");
}
__device__ __forceinline__ void cvt_block8(const float* W, int K, int Nsrc, int k0, int n0, unsigned char* WT8, int drow0, float scale, LAS float* scr, int lane) {
    float wv_[32];
#pragma unroll
    for (int i = 0; i < 32; ++i) wv_[i] = W[(size_t)(k0 + 2 * i + (lane >> 5)) * Nsrc + n0 + (lane & 31)];
#pragma unroll
    for (int i = 0; i < 32; ++i) scr[(2 * i + (lane >> 5)) * 33 + (lane & 31)] = wv_[i];
    LDS_WAIT(); asm volatile("" ::: "memory");
    const int c = lane & 7;
#pragma unroll
    for (int j = 0; j < 4; ++j) { const int n = (lane >> 3) + 8 * j; const LAS float* s = scr + (8 * c) * 33 + n;
        const f32x4 a = {s[0 * 33] * scale, s[1 * 33] * scale, s[2 * 33] * scale, s[3 * 33] * scale}, b = {s[4 * 33] * scale, s[5 * 33] * scale, s[6 * 33] * scale, s[7 * 33] * scale};
        const pg8::u32x2 w = pg8::pack8_fp8(a, b); v2u o; o.x = w.x; o.y = w.y;
        *(v2u*)(WT8 + (size_t)(drow0 + n) * K + k0 + 8 * c) = o; }
    LDS_WAIT(); asm volatile("" ::: "memory");
}
__device__ __forceinline__ int win_row(int n0) {
    if (n0 < 512) { const int m = n0 >> 8, h = (n0 & 255) >> 6, d = n0 & 63; return h * 128 + m * 64 + d; }
    if (n0 < 1024) return 1024 + (n0 - 512);
    if (n0 < 1536) return 1536 + (n0 - 1024);
    if (n0 < 1920) return 2048 + (n0 - 1536);
    if (n0 < 2176) return 2560 + (n0 - 1920);
    if (n0 < 2208) return 2944 + (n0 - 2176);
    if (n0 < 2720) return 512 + (n0 - 2208);
    if (n0 < 2848) return 2432 + (n0 - 2720);
    if (n0 < 2976) return 2816 + (n0 - 2848);
    return 3072 + (n0 - 2976);
}
__device__ __forceinline__ int win_row_p(int n0) { const int r = win_row(n0), c = r & 255; return (r & ~255) + (((c >> 5) & 1) << 7) + ((c >> 6) << 5) + (c & 31); }
struct LayerW {
    const float *norm_mix_g, *w_in, *diff_qk_g, *diff_lambda, *diff_out_g, *mla_cq_g, *w_uq, *mla_ckv_g, *w_ukv, *mla_qk_g, *swa_qk_g, *swa_sink,
                *w_ba, *w_bb, *w_bc, *w_o, *norm_ffn_g, *w_router, *w_eg, *w_eu, *w_ed;
};
__device__ __forceinline__ void p_convert(const Frame& F, const LayerW& L, unsigned char* ws) {
    int tid_ = threadIdx.x; asm volatile("" : "+v"(tid_)); const int tid = tid_, lane = tid & 63; (void)tid; (void)lane;
    LAS float* scr = (LAS float*)(F.lds + RING_OFF + F.wave * 16384);
    const int gw = F.vcu * NWAVES + F.wave, NGW = F.G * NWAVES;
    constexpr int I_IN = 16 * 189, I_UQ = 6 * 24, I_UKV = 4 * 32, I_BR = 8 * 32, I_O = 16 * 32, I_E = 16 * 512;
    constexpr int NITEMS = I_IN + I_UQ + I_UKV + 3 * I_BR + I_O + 3 * I_E;
    bf16* win = (bf16*)(ws + WS_WIN);
    for (int it = gw; it < NITEMS; it += NGW) {
        int r = it;
        if (r < I_IN) { const int kb = r / 189, nb = r % 189;
            if (nb < 93) cvt_block(L.w_in, 1024, IN_COLS, kb * 64, nb * 32, win, win_row_p(nb * 32), scr, lane);
            else cvt_block8(L.w_in, 1024, IN_COLS, kb * 64, nb * 32, ws + WS_WG8, nb * 32 - 2976, W8_SCALE, scr, lane);
            continue; } r -= I_IN;
        if (r < I_UQ) { const int kb = r / 24, nb = r % 24; cvt_block(L.w_uq, 384, 768, kb * 64, nb * 32, (bf16*)(ws + WS_WUQ), nb * 32, scr, lane, L.mla_cq_g); continue; } r -= I_UQ;
        if (r < I_UKV) { const int kb = r / 32, nb = r % 32, n0 = nb * 32, h = n0 >> 7, jj = n0 & 127; const int dr = (h >> 1) * 256 + 128 * ((jj & 63) >> 5) + 32 * (jj < 64 ? (h & 1) : 2 + (h & 1));
            cvt_block(L.w_ukv, 256, 1024, kb * 64, n0, (bf16*)(ws + WS_WUKV), dr, scr, lane, L.mla_ckv_g); continue; } r -= I_UKV;
        if (r < I_BR) { const int kb = r / 32, nb = r % 32; cvt_block(L.w_ba, 512, 1024, kb * 64, nb * 32, (bf16*)(ws + WS_WBA), nb * 32, scr, lane); continue; } r -= I_BR;
        if (r < I_BR) { const int kb = r / 32, nb = r % 32; cvt_block(L.w_bb, 512, 1024, kb * 64, nb * 32, (bf16*)(ws + WS_WBB), nb * 32, scr, lane); continue; } r -= I_BR;
        if (r < I_BR) { const int kb = r / 32, nb = r % 32; cvt_block(L.w_bc, 512, 1024, kb * 64, nb * 32, (bf16*)(ws + WS_WBC), nb * 32, scr, lane); continue; } r -= I_BR;
        if (r < I_O) { const int kb = r / 32, nb = r % 32; cvt_block(L.w_o, 1024, 1024, kb * 64, nb * 32, (bf16*)(ws + WS_WO), nb * 32, scr, lane); continue; } r -= I_O;
        { const int w = r / I_E, q = r % I_E, e = q / 512, qq = q % 512, kb = qq / 32, nb = qq % 32, n0 = nb * 32;
          const int dr = (n0 >> 7) * 256 + (n0 & 127);
          if (w == 0) cvt_block8(L.w_eg + (size_t)e * 1024 * 1024, 1024, 1024, kb * 64, n0, ws + WS_WGU + (size_t)e * 2048 * 1024, dr, W8_SCALE, scr, lane);
          else if (w == 1) cvt_block8(L.w_eu + (size_t)e * 1024 * 1024, 1024, 1024, kb * 64, n0, ws + WS_WGU + (size_t)e * 2048 * 1024, dr + 128, W8_SCALE, scr, lane);
          else cvt_block8(L.w_ed + (size_t)e * 1024 * 1024, 1024, 1024, kb * 64, n0, ws + WS_WD + (size_t)e * 1024 * 1024, n0, W8_SCALE, scr, lane); }
    }
    { const int gt = (F.vcu * NWAVES + F.wave) * 64 + lane, NGT = NGW * 64;
      unsigned z_ = 0u; asm volatile("" : "+v"(z_));
      for (int i = gt; i < 96 * 1024 / 8; i += NGT) { const int blk = i / (32 * 1024 / 8), off = i % (32 * 1024 / 8); const int r0 = 2816 + (blk == 0 ? 192 : (blk == 1 ? 96 : 224));
          *(v4u*)(win + (size_t)r0 * 1024 + (size_t)off * 8) = (v4u){z_, z_, z_, z_}; }
      if (gt < 256) { const int gi = gt >> 6, d = gt & 63; const float QS_ = 0.125f * LOG2E;
          const float v = gi == 0 ? L.diff_qk_g[d] * QS_ : (gi == 1 ? L.swa_qk_g[d] * QS_ : (gi == 2 ? L.diff_qk_g[64 + d] : L.swa_qk_g[64 + d]));
          ((float*)(ws + WS_GT))[gt] = v; } }
}

__device__ __forceinline__ unsigned pk4_fp8(f32x4 y) {
    y.x = fminf(fmaxf(y.x, -448.f), 448.f); y.y = fminf(fmaxf(y.y, -448.f), 448.f); y.z = fminf(fmaxf(y.z, -448.f), 448.f); y.w = fminf(fmaxf(y.w, -448.f), 448.f);
    int w = 0; w = __builtin_amdgcn_cvt_pk_fp8_f32(y.x, y.y, w, false); w = __builtin_amdgcn_cvt_pk_fp8_f32(y.z, y.w, w, true); return (unsigned)w; }
__device__ __forceinline__ void p_norm1(const Frame& F, const float* x, const float* g, bf16* h, unsigned char* h8) {
    int tid_ = threadIdx.x; asm volatile("" : "+v"(tid_)); const int tid = tid_, lane = tid & 63; (void)tid; (void)lane;
    const int gw = F.vcu * NWAVES + F.wave, NGW = F.G * NWAVES;
    f32x4 gv[4];
#pragma unroll
    for (int j = 0; j < 4; ++j) gv[j] = *((const f32x4*)g + lane + 64 * j);
    for (int row0 = gw * 2; row0 < T; row0 += NGW * 2) {
        f32x4 v[2][4];
#pragma unroll
        for (int rr = 0; rr < 2; ++rr) { const f32x4* xr = (const f32x4*)(x + (size_t)(row0 + rr) * DM) + lane;
#pragma unroll
            for (int j = 0; j < 4; ++j) v[rr][j] = xr[64 * j]; }
#pragma unroll
        for (int rr = 0; rr < 2; ++rr) { float s = 0.f;
#pragma unroll
            for (int j = 0; j < 4; ++j) s += (v[rr][j].x * v[rr][j].x + v[rr][j].y * v[rr][j].y) + (v[rr][j].z * v[rr][j].z + v[rr][j].w * v[rr][j].w);
            const float rs = 1.0f / sqrtf(wave_sum(s) * (1.0f / DM) + EPS);
            v2u* o8 = (v2u*)(h + (size_t)(row0 + rr) * DM) + lane; unsigned* q8 = (unsigned*)(h8 + (size_t)(row0 + rr) * DM) + lane;
#pragma unroll
            for (int j = 0; j < 4; ++j) { const f32x4 y = {v[rr][j].x * rs * gv[j].x, v[rr][j].y * rs * gv[j].y, v[rr][j].z * rs * gv[j].z, v[rr][j].w * rs * gv[j].w};
                v2u o; o.x = pk2(y.x, y.y); o.y = pk2(y.z, y.w); o8[64 * j] = o; q8[64 * j] = pk4_fp8(y); } }
    }
}

__device__ __forceinline__ float grp8_sum(float v) { v = xor_add<1>(v); v = xor_add<2>(v); v = xor_add<4>(v); return v; }
struct U8 { float f[8]; };
__device__ __forceinline__ U8 ld8bf(const bf16* p) { const v4u w = *(const v4u*)p; U8 r; r.f[0] = bflo(w.x); r.f[1] = bfhi(w.x); r.f[2] = bflo(w.y); r.f[3] = bfhi(w.y); r.f[4] = bflo(w.z); r.f[5] = bfhi(w.z); r.f[6] = bflo(w.w); r.f[7] = bfhi(w.w); return r; }
__device__ __forceinline__ void st8bf(bf16* p, const U8& r) { v4u w; w.x = pk2(r.f[0], r.f[1]); w.y = pk2(r.f[2], r.f[3]); w.z = pk2(r.f[4], r.f[5]); w.w = pk2(r.f[6], r.f[7]); *(v4u*)p = w; }
__device__ __forceinline__ float ss8(const U8& r) { float s = 0.f;
#pragma unroll
    for (int i = 0; i < 8; ++i) s += r.f[i] * r.f[i];
    return s; }
__device__ __forceinline__ void p_prep1(const Frame& F, const LayerW& L, unsigned char* ws) {
    int tid_ = threadIdx.x; asm volatile("" : "+v"(tid_)); const int tid = tid_, lane = tid & 63; (void)tid; (void)lane;
    const int gw = F.vcu * NWAVES + F.wave, NGW = F.G * NWAVES;
    const float QS = 0.125f * LOG2E;
    float gqa[8], gka[8], gqc[8], gkc[8], gcq[8], gckv[8];
#pragma unroll
    for (int i = 0; i < 8; ++i) { const int d = (lane & 7) * 8 + i;
        gqa[i] = L.diff_qk_g[d] * QS; gka[i] = L.diff_qk_g[64 + d]; gqc[i] = L.swa_qk_g[d] * QS; gkc[i] = L.swa_qk_g[64 + d];
        gcq[i] = lane < 48 ? L.mla_cq_g[lane * 8 + i] : 0.f; gckv[i] = lane < 32 ? L.mla_ckv_g[lane * 8 + i] : 0.f; }
    bf16* QA = (bf16*)(ws + WS_QA); bf16* KA = (bf16*)(ws + WS_KA); bf16* QC = (bf16*)(ws + WS_QC); bf16* CQKC = (bf16*)(ws + WS_CQKC); bf16* CKV = (bf16*)(ws + WS_CKV);
    for (int row0 = gw * 2; row0 < T; row0 += NGW * 2) {
        U8 a[2], b[2], c[2], d[2], e[2];
#pragma unroll
        for (int rr = 0; rr < 2; ++rr) { const int row = row0 + rr; const size_t o512 = (size_t)row * 512 + lane * 8;
            a[rr] = ld8bf(QA + o512); b[rr] = ld8bf(KA + o512); c[rr] = ld8bf(QC + o512); d[rr] = ld8bf(CQKC + o512);
            if (lane < 32) e[rr] = ld8bf(CKV + (size_t)row * 256 + lane * 8); else {
#pragma unroll
                for (int i = 0; i < 8; ++i) e[rr].f[i] = 0.f; } }
#pragma unroll
        for (int rr = 0; rr < 2; ++rr) { const int row = row0 + rr; const size_t o512 = (size_t)row * 512 + lane * 8;
            const float ra = 1.0f / sqrtf(grp8_sum(ss8(a[rr])) * (1.0f / 64) + EPS);
            const float rb = 1.0f / sqrtf(grp8_sum(ss8(b[rr])) * (1.0f / 64) + EPS);
            const float rc = 1.0f / sqrtf(grp8_sum(ss8(c[rr])) * (1.0f / 64) + EPS);
            const float sd = grp8_sum(ss8(d[rr]));
            float tot = lane < 48 ? sd : 0.f; tot = xor_add<8>(tot); tot = xor_add<16>(tot); tot = xor_add<32>(tot);
            const float rd = lane < 48 ? 1.0f / sqrtf(tot * (1.0f / 384) + EPS) : 1.0f / sqrtf(sd * (1.0f / 64) + EPS);
            float se = grp8_sum(ss8(e[rr])); se = xor_add<8>(se); se = xor_add<16>(se);
            const float re = 1.0f / sqrtf(se * (1.0f / 256) + EPS);
#pragma unroll
            for (int i = 0; i < 8; ++i) { a[rr].f[i] *= ra * gqa[i]; b[rr].f[i] *= rb * gka[i]; c[rr].f[i] *= rc * gqc[i]; d[rr].f[i] *= rd * (lane < 48 ? gcq[i] : gkc[i]); e[rr].f[i] *= re * gckv[i]; }
            st8bf(QA + o512, a[rr]); st8bf(KA + o512, b[rr]); st8bf(QC + o512, c[rr]); st8bf(CQKC + o512, d[rr]);
            if (lane < 32) st8bf(CKV + (size_t)row * 256 + lane * 8, e[rr]); }
    }
}

__device__ __forceinline__ void p_prep2(const Frame& F, const LayerW& L, unsigned char* ws, const int* positions) {
    int tid_ = threadIdx.x; asm volatile("" : "+v"(tid_)); const int tid = tid_, lane = tid & 63; (void)tid; (void)lane;
    const int gw = F.vcu * NWAVES + F.wave, NGW = F.G * NWAVES, h = lane >> 3, j = lane & 7;
    float gkn[8], gkr[4], invf[4];
#pragma unroll
    for (int i = 0; i < 8; ++i) gkn[i] = L.mla_qk_g[96 + 8 * j + i];
#pragma unroll
    for (int i = 0; i < 4; ++i) { gkr[i] = L.mla_qk_g[96 + 64 + 4 * j + i];
        const int fi = 4 * (j & 3) + i; invf[i] = (float)(exp2(-(double)fi * (13.287712379549449 / 16.0)) * 0.15915494309189535); }
    const bf16* KVR = (const bf16*)(ws + WS_KVR); const bf16* VCKR = (const bf16*)(ws + WS_VCKR); bf16* KB = (bf16*)(ws + WS_KB);
    for (int row0 = gw * 2; row0 < T; row0 += NGW * 2) {
        float posf[2]; U8 kn[2]; v2u kw[2];
#pragma unroll
        for (int rr = 0; rr < 2; ++rr) { const int row = row0 + rr; posf[rr] = (float)positions[row];
            kn[rr] = ld8bf(KVR + (size_t)row * 1024 + h * 64 + 8 * j); kw[rr] = *(const v2u*)(VCKR + (size_t)row * 256 + 128 + 4 * j); }
#pragma unroll
        for (int rr = 0; rr < 2; ++rr) { const int row = row0 + rr;
            float cs[4], sn[4];
#pragma unroll
            for (int i = 0; i < 4; ++i) { const double tr = (double)posf[rr] * (double)invf[i]; const float fr = (float)(tr - floor(tr)); cs[i] = __builtin_amdgcn_cosf(fr); sn[i] = __builtin_amdgcn_sinf(fr); }
            float kr_[4] = {bflo(kw[rr].x), bfhi(kw[rr].x), bflo(kw[rr].y), bfhi(kw[rr].y)}, ko[4];
#pragma unroll
            for (int i = 0; i < 4; ++i) { const float other = xor_getf<4>(kr_[i]); ko[i] = (j < 4) ? (kr_[i] * cs[i] - other * sn[i]) : (other * sn[i] + kr_[i] * cs[i]); }
            const float sk = ss8(kn[rr]) + (ko[0] * ko[0] + ko[1] * ko[1]) + (ko[2] * ko[2] + ko[3] * ko[3]);
            const float rk = 1.0f / sqrtf(grp8_sum(sk) * (1.0f / 96) + EPS);
#pragma unroll
            for (int i = 0; i < 8; ++i) kn[rr].f[i] *= rk * gkn[i];
            bf16* krow = KB + (size_t)row * 768 + h * 96;
            st8bf(krow + 8 * j, kn[rr]);
            { v2u w; w.x = pk2(ko[0] * rk * gkr[0], ko[1] * rk * gkr[1]); w.y = pk2(ko[2] * rk * gkr[2], ko[3] * rk * gkr[3]); *(v2u*)(krow + 64 + 4 * j) = w; } }
    }
}

__device__ __forceinline__ void p_tile_minmax(const Frame& F, unsigned char* ws, const int* positions) {
    int tid_ = threadIdx.x; asm volatile("" : "+v"(tid_)); const int lane = tid_ & 63;
    const int gw = F.vcu * NWAVES + F.wave, NGW = F.G * NWAVES;
    float* tmm = (float*)(ws + WS_TMM);
    for (int tl = gw; tl < T / 64; tl += NGW) {
        const float p = (float)positions[tl * 64 + lane];
        float hi = p, lo = -p;
        hi = xor_max<1>(hi); hi = xor_max<2>(hi); hi = xor_max<4>(hi); hi = xor_max<8>(hi); hi = xor_max<16>(hi); hi = xor_max<32>(hi);
        lo = xor_max<1>(lo); lo = xor_max<2>(lo); lo = xor_max<4>(lo); lo = xor_max<8>(lo); lo = xor_max<16>(lo); lo = xor_max<32>(lo);
        if (lane == 0) { tmm[tl * 2] = -lo; tmm[tl * 2 + 1] = hi; }
    }
}

__device__ __forceinline__ void p_h_to_fp8(const Frame& F, unsigned char* ws) {
    int tid_ = threadIdx.x; asm volatile("" : "+v"(tid_));
    const size_t gt = (size_t)(F.vcu * NWAVES * 64) + tid_, NGT = (size_t)F.G * NWAVES * 64;
    const v4u* src = (const v4u*)(ws + WS_H); v2u* dst = (v2u*)(ws + WS_H8);
    for (size_t i = gt; i < (size_t)T * DM / 8; i += NGT * 4) {
        v4u x[4];
#pragma unroll
        for (int k = 0; k < 4; ++k) if (i + k * NGT < (size_t)T * DM / 8) x[k] = src[i + k * NGT];
#pragma unroll
        for (int k = 0; k < 4; ++k) if (i + k * NGT < (size_t)T * DM / 8) {
            const f32x4 a0 = {bflo(x[k].x), bfhi(x[k].x), bflo(x[k].y), bfhi(x[k].y)}, a1 = {bflo(x[k].z), bfhi(x[k].z), bflo(x[k].w), bfhi(x[k].w)};
            const pg8::u32x2 w = pg8::pack8_fp8(a0, a1); v2u o; o.x = w.x; o.y = w.y; dst[i + k * NGT] = o; }
    }
}

#ifndef ATT_PRIO
#define ATT_PRIO(stag) (!(stag))
#endif
namespace att {
__device__ __forceinline__ int crow(int r, int hi) { return (r & 3) + 8 * (r >> 2) + 4 * hi; }
#define ATT_SBAR() __builtin_amdgcn_sched_barrier(0)
typedef float f32x2_t __attribute__((ext_vector_type(2))); typedef __bf16 bf16x2_t __attribute__((ext_vector_type(2)));
__device__ __forceinline__ unsigned cvtpk(float lo, float hi) { f32x2_t v = {lo, hi}; bf16x2_t b = __builtin_convertvector(v, bf16x2_t); return __builtin_bit_cast(unsigned, b); }

struct Args {
    const bf16* Q; const bf16* K; const bf16* V;
    int pq, pk, pv;
    const int* pos;
    float slope2, sink2;
    float mfix;
    const float* qg;
};
typedef short v4i16_t __attribute__((ext_vector_type(4)));
__device__ __forceinline__ s16x4 vtr(const LAS unsigned char* p) { return __builtin_bit_cast(s16x4, __builtin_amdgcn_ds_read_tr16_b64_v4i16((LAS v4i16_t*)p)); }
__device__ __forceinline__ float max3f(float a, float b, float c) { return __builtin_fmaxf(__builtin_fmaxf(a, b), c); }
template <int DQK, int DV, int MODE, int ABL = 0>
__device__ __forceinline__ void attn_core(const Args& A, int q0, unsigned long long tmask, LAS unsigned char* lds, float (&res)[DV / 32][16]) {
    constexpr int KSTR = DQK * 2 + 16, KBYTES = 64 * KSTR, VBYTES = 64 * DV * 2, PBYTES = 256;
    constexpr int BUF = KBYTES + VBYTES + PBYTES;
    constexpr int CPR = DQK / 8, NKP = 64 * CPR, KP = (NKP + 511) / 512, VP = (64 * DV / 8) / 512, ND0 = DV / 32, NKS = DQK / 16;
    constexpr float THR = 6.0f;
    static_assert(2 * BUF + 8 * 256 <= ATT_STASH_OFF, "attention LDS");
    int tid_ = threadIdx.x; asm volatile("" : "+v"(tid_));
    const int tid = tid_, lane = tid & 63, wid = __builtin_amdgcn_readfirstlane(tid >> 6), r32 = lane & 31, hi = lane >> 5;
    LAS float* wsf = (LAS float*)(lds + 2 * BUF) + wid * 64;

    bf16x8 qr[NKS];
#pragma unroll
    for (int d0 = 0; d0 < NKS; ++d0) qr[d0] = *(const bf16x8*)(A.Q + (size_t)(q0 + wid * 32 + r32) * A.pq + d0 * 16 + hi * 8);
    float pqf = 0.f;
    if (MODE == 1) pqf = (float)A.pos[q0 + wid * 32 + r32];
    if (MODE == 2) pqf = (float)(q0 + wid * 32 + r32);

    f32x16 o[ND0];
#pragma unroll
    for (int d = 0; d < ND0; ++d)
#pragma unroll
        for (int r = 0; r < 16; ++r) o[d][r] = 0.f;
    float l_reg = (MODE == 2 && hi == 0) ? __builtin_amdgcn_exp2f(A.sink2 - A.mfix) : 0.f;
    f32x16 negm;
#pragma unroll
    for (int r = 0; r < 16; ++r) negm[r] = -A.mfix;

    bf16x8 sk[KP], sv[VP]; float spos = 0.f;
    unsigned gk_off[KP], lk_off[KP], gv_off[VP], lv_off[VP];
#pragma unroll
    for (int i = 0; i < KP; ++i) { const int p = tid + 512 * i, row = p / CPR, ch = p % CPR; gk_off[i] = (unsigned)(row * A.pk + ch * 8) * 2u; lk_off[i] = (unsigned)(row * KSTR + ch * 16); }
#pragma unroll
    for (int i = 0; i < VP; ++i) { const int p = tid + 512 * i, db = p >> 8, row = (p & 255) >> 2, c4 = p & 3; gv_off[i] = (unsigned)(row * A.pv + db * 32 + c4 * 8) * 2u;
        lv_off[i] = (unsigned)(KBYTES + db * 4096 + (row >> 4) * 1024 + (row & 15) * 64 + c4 * 16); }
#define ATT_SLOAD(t) do { const int k0_ = (t) * 64; const char* kb_ = (const char*)(A.K + (size_t)k0_ * A.pk); const char* vb_ = (const char*)(A.V + (size_t)k0_ * A.pv); \
    _Pragma("unroll") for (int i = 0; i < KP; ++i) { if (tid + 512 * i < NKP) sk[i] = *(const bf16x8*)(kb_ + gk_off[i]); } \
    _Pragma("unroll") for (int i = 0; i < VP; ++i) sv[i] = *(const bf16x8*)(vb_ + gv_off[i]); \
    if (MODE == 1) { if (tid < 64) spos = (float)A.pos[k0_ + tid]; } if (MODE == 2) { spos = (float)(k0_ + tid); } } while (0)
#define ATT_SWRITE(b) do { LAS unsigned char* base_ = lds + (b) * BUF; \
    _Pragma("unroll") for (int i = 0; i < KP; ++i) { if (tid + 512 * i < NKP) *(LAS bf16x8*)(base_ + lk_off[i]) = sk[i]; } \
    _Pragma("unroll") for (int i = 0; i < VP; ++i) *(LAS bf16x8*)(base_ + lv_off[i]) = sv[i]; \
    if (MODE != 0) { if (tid < 64) *(LAS float*)(base_ + KBYTES + VBYTES + tid * 4) = spos; } } while (0)
#define ATT_VRD(VF, d) do { const LAS unsigned char* vp_ = vbase + (d) * 4096; \
    _Pragma("unroll") for (int ks = 0; ks < 4; ++ks) { VF[2 * ks] = vtr(vp_ + ks * 1024); VF[2 * ks + 1] = vtr(vp_ + ks * 1024 + 512); } } while (0)
#define ATT_PK(L, H) (bf16x8){L[0], L[1], L[2], L[3], H[0], H[1], H[2], H[3]}
#define ATT_MMA(VF, d) do { _Pragma("unroll") for (int ks = 0; ks < 4; ++ks) { if (ABL == 2) o[d][ks] += __builtin_bit_cast(float, (int)pa[ks][0]) + __builtin_bit_cast(float, (int)VF[2 * ks][0] + (int)VF[2 * ks + 1][0]); else o[d] = __builtin_amdgcn_mfma_f32_32x32x16_bf16(pa[ks], ATT_PK(VF[2 * ks], VF[2 * ks + 1]), o[d], 0, 0, 0); } } while (0)

    int t = __builtin_ctzll(tmask); tmask &= tmask - 1;
    ATT_SLOAD(t); ATT_SWRITE(0); __syncthreads();
    for (int cur = 0;; cur ^= 1) {
        const bool more = tmask != 0ull; const int tn = more ? __builtin_ctzll(tmask) : 0; tmask &= tmask - 1;
        LAS unsigned char* bufp = lds + cur * BUF;
        if (more && ABL != 4) ATT_SLOAD(tn);
        f32x16 p0, p1;
        const LAS unsigned char* kb = bufp + r32 * KSTR + hi * 16;
#pragma unroll
        for (int d0 = 0; d0 < NKS; ++d0) {
            const bf16x8 b0 = *(const LAS bf16x8*)(kb + d0 * 32);
            const bf16x8 b1 = *(const LAS bf16x8*)(kb + 32 * KSTR + d0 * 32);
            if (ABL == 2) { if (d0 == 0) { p0 = negm; p1 = negm; } p0[d0] += __builtin_bit_cast(float, (int)b0[0]); p1[d0] += __builtin_bit_cast(float, (int)b1[0]); }
            else if (d0 == 0) { p0 = __builtin_amdgcn_mfma_f32_32x32x16_bf16(b0, qr[0], negm, 0, 0, 0); p1 = __builtin_amdgcn_mfma_f32_32x32x16_bf16(b1, qr[0], negm, 0, 0, 0); }
            else { p0 = __builtin_amdgcn_mfma_f32_32x32x16_bf16(b0, qr[d0], p0, 0, 0, 0); p1 = __builtin_amdgcn_mfma_f32_32x32x16_bf16(b1, qr[d0], p1, 0, 0, 0); }
        }
        const LAS unsigned char* vbase = bufp + KBYTES + ((lane >> 4) & 1) * 32 + (lane & 3) * 8 + (4 * hi + ((lane & 15) >> 2)) * 64;
        s16x4 vfa[8], vfb[8];
        ATT_VRD(vfa, 0);
        if (MODE != 0) {
            const LAS float* pk = (const LAS float*)(bufp + KBYTES + VBYTES);
#pragma unroll
            for (int g = 0; g < 4; ++g) {
                const f32x4 k0v = *(const LAS f32x4*)(pk + 8 * g + 4 * hi), k1v = *(const LAS f32x4*)(pk + 32 + 8 * g + 4 * hi);
#pragma unroll
                for (int i = 0; i < 4; ++i) {
                    const float d0f = fabsf(pqf - k0v[i]), d1f = fabsf(pqf - k1v[i]);
                    float s0 = fmaf(-A.slope2, d0f, p0[4 * g + i]), s1 = fmaf(-A.slope2, d1f, p1[4 * g + i]);
                    if (MODE == 2) { s0 = d0f <= 128.0f ? s0 : -1e30f; s1 = d1f <= 128.0f ? s1 : -1e30f; }
                    p0[4 * g + i] = s0; p1[4 * g + i] = s1;
                }
            }
        }
        float ps0 = 0.f, ps1 = 0.f, ps2 = 0.f, ps3 = 0.f;
#pragma unroll
        for (int r = 0; r < 16; r += 4) {
            if (ABL != 1) { p0[r] = __builtin_amdgcn_exp2f(p0[r]); p0[r + 1] = __builtin_amdgcn_exp2f(p0[r + 1]); p0[r + 2] = __builtin_amdgcn_exp2f(p0[r + 2]); p0[r + 3] = __builtin_amdgcn_exp2f(p0[r + 3]);
            p1[r] = __builtin_amdgcn_exp2f(p1[r]); p1[r + 1] = __builtin_amdgcn_exp2f(p1[r + 1]); p1[r + 2] = __builtin_amdgcn_exp2f(p1[r + 2]); p1[r + 3] = __builtin_amdgcn_exp2f(p1[r + 3]); }
            ps0 += p0[r] + p1[r]; ps1 += p0[r + 1] + p1[r + 1]; ps2 += p0[r + 2] + p1[r + 2]; ps3 += p0[r + 3] + p1[r + 3];
        }
        l_reg += (ps0 + ps1) + (ps2 + ps3);
        bf16x8 pa[4];
#pragma unroll
        for (int s = 0; s < 2; ++s) {
            v4u w0 = {cvtpk(p0[8 * s + 0], p0[8 * s + 1]), cvtpk(p0[8 * s + 2], p0[8 * s + 3]), cvtpk(p0[8 * s + 4], p0[8 * s + 5]), cvtpk(p0[8 * s + 6], p0[8 * s + 7])};
            v4u w1 = {cvtpk(p1[8 * s + 0], p1[8 * s + 1]), cvtpk(p1[8 * s + 2], p1[8 * s + 3]), cvtpk(p1[8 * s + 4], p1[8 * s + 5]), cvtpk(p1[8 * s + 6], p1[8 * s + 7])};
            pa[s] = __builtin_bit_cast(bf16x8, w0); pa[2 + s] = __builtin_bit_cast(bf16x8, w1);
        }
        if (ND0 == 2) { ATT_VRD(vfb, 1); ATT_MMA(vfa, 0); ATT_MMA(vfb, 1); }
        else { ATT_VRD(vfb, 1); ATT_MMA(vfa, 0); ATT_VRD(vfa, 2); ATT_MMA(vfb, 1); ATT_VRD(vfb, 3); ATT_MMA(vfa, 2); ATT_MMA(vfb, 3); }
        if (more && ABL != 4) ATT_SWRITE(cur ^ 1);
        if (ABL != 3) __syncthreads();
        if (!more) break;
        t = tn;
    }
#undef ATT_SLOAD
#undef ATT_SWRITE
#undef ATT_VRD
#undef ATT_PK
#undef ATT_MMA
    { const float lt = xor_add<32>(l_reg); if (hi == 0) wsf[32 + r32] = 1.0f / lt; }
    LDS_WAIT();
#pragma unroll
    for (int g = 0; g < 4; ++g) {
        const f32x4 l0 = *(const LAS f32x4*)(wsf + 32 + 8 * g + 4 * hi);
#pragma unroll
        for (int d = 0; d < ND0; ++d)
#pragma unroll
            for (int i = 0; i < 4; ++i) res[d][4 * g + i] = o[d][4 * g + i] * l0[i];
    }
    LDS_WAIT();
    __syncthreads();
}
template <int DQK, int DV, int ABL = 0>
__device__ __forceinline__ void attn_core_p(const Args& A, int q0, unsigned long long tmask, LAS unsigned char* lds, float (&res)[DV / 32][16]) {
    constexpr int KSTR = DQK * 2 + 16, KBYTES = 64 * KSTR, VBYTES = 64 * DV * 2;
    constexpr int CPR = DQK / 8, NKP = 64 * CPR, KP = (NKP + 511) / 512, VP = (64 * DV / 8) / 512, ND0 = DV / 32, NKS = DQK / 16;
    constexpr int KOFF = 0, VOFF = 2 * KBYTES, WOFF = VOFF + 3 * VBYTES;
    static_assert(WOFF + 8 * 256 <= ATT_STASH_OFF, "attention LDS");
    int tid_ = threadIdx.x; asm volatile("" : "+v"(tid_));
    const int tid = tid_, lane = tid & 63, wid = __builtin_amdgcn_readfirstlane(tid >> 6), r32 = lane & 31, hi = lane >> 5;
    LAS float* wsf = (LAS float*)(lds + WOFF) + wid * 64;
    bf16x8 qr[NKS];
#pragma unroll
    for (int d0 = 0; d0 < NKS; ++d0) qr[d0] = *(const bf16x8*)(A.Q + (size_t)(q0 + wid * 32 + r32) * A.pq + d0 * 16 + hi * 8);
    f32x16 o[ND0];
#pragma unroll
    for (int d = 0; d < ND0; ++d)
#pragma unroll
        for (int r = 0; r < 16; ++r) o[d][r] = 0.f;
    float l_reg = 0.f;
    f32x16 negm;
#pragma unroll
    for (int r = 0; r < 16; ++r) negm[r] = -A.mfix;
    bf16x8 sk[KP], sv[VP];
    unsigned gk_off[KP], lk_off[KP], gv_off[VP], lv_off[VP];
#pragma unroll
    for (int i = 0; i < KP; ++i) { const int p = tid + 512 * i, row = p / CPR, ch = p % CPR; gk_off[i] = (unsigned)(row * A.pk + ch * 8) * 2u; lk_off[i] = (unsigned)(row * KSTR + ch * 16); }
#pragma unroll
    for (int i = 0; i < VP; ++i) { const int p = tid + 512 * i, db = p >> 8, row = (p & 255) >> 2, c4 = p & 3; gv_off[i] = (unsigned)(row * A.pv + db * 32 + c4 * 8) * 2u;
        lv_off[i] = (unsigned)(db * 4096 + (row >> 4) * 1024 + (row & 15) * 64 + c4 * 16); }
#define ATP_SLOAD(t) do { const int k0_ = (t) * 64; const char* kb_ = (const char*)(A.K + (size_t)k0_ * A.pk); const char* vb_ = (const char*)(A.V + (size_t)k0_ * A.pv); \
    _Pragma("unroll") for (int i = 0; i < KP; ++i) { if (tid + 512 * i < NKP) sk[i] = *(const bf16x8*)(kb_ + gk_off[i]); } \
    _Pragma("unroll") for (int i = 0; i < VP; ++i) sv[i] = *(const bf16x8*)(vb_ + gv_off[i]); } while (0)
#define ATP_SWRITE(kslot, vslot) do { LAS unsigned char* kb_ = lds + KOFF + (kslot) * KBYTES; LAS unsigned char* vb_ = lds + VOFF + (vslot) * VBYTES; \
    _Pragma("unroll") for (int i = 0; i < KP; ++i) { if (tid + 512 * i < NKP) *(LAS bf16x8*)(kb_ + lk_off[i]) = sk[i]; } \
    _Pragma("unroll") for (int i = 0; i < VP; ++i) *(LAS bf16x8*)(vb_ + lv_off[i]) = sv[i]; } while (0)
#define ATP_QKT(P0, P1, kslot) do { const LAS unsigned char* kb_ = lds + KOFF + (kslot) * KBYTES + r32 * KSTR + hi * 16; \
    _Pragma("unroll") for (int d0 = 0; d0 < NKS; ++d0) { const bf16x8 b0_ = (ABL == 5 || ABL == 7) ? qr[d0] : *(const LAS bf16x8*)(kb_ + d0 * 32); const bf16x8 b1_ = (ABL == 5 || ABL == 7) ? qr[NKS - 1 - d0] : *(const LAS bf16x8*)(kb_ + 32 * KSTR + d0 * 32); \
        if (ABL == 2) { if (d0 == 0) { P0 = negm; P1 = negm; } P0[d0] += __builtin_bit_cast(float, (int)b0_[0]); P1[d0] += __builtin_bit_cast(float, (int)b1_[0]); } \
        else if (d0 == 0) { P0 = __builtin_amdgcn_mfma_f32_32x32x16_bf16(b0_, qr[0], negm, 0, 0, 0); P1 = __builtin_amdgcn_mfma_f32_32x32x16_bf16(b1_, qr[0], negm, 0, 0, 0); } \
        else { P0 = __builtin_amdgcn_mfma_f32_32x32x16_bf16(b0_, qr[d0], P0, 0, 0, 0); P1 = __builtin_amdgcn_mfma_f32_32x32x16_bf16(b1_, qr[d0], P1, 0, 0, 0); } } } while (0)
#define ATP_SOFT(P0, P1) do { \
    if (ABL != 1) { _Pragma("unroll") for (int r = 0; r < 16; ++r) { P0[r] = __builtin_amdgcn_exp2f(P0[r]); P1[r] = __builtin_amdgcn_exp2f(P1[r]); } } \
    _Pragma("unroll") for (int s_ = 0; s_ < 2; ++s_) { \
        v4u w0_ = {cvtpk(P0[8 * s_ + 0], P0[8 * s_ + 1]), cvtpk(P0[8 * s_ + 2], P0[8 * s_ + 3]), cvtpk(P0[8 * s_ + 4], P0[8 * s_ + 5]), cvtpk(P0[8 * s_ + 6], P0[8 * s_ + 7])}; \
        v4u w1_ = {cvtpk(P1[8 * s_ + 0], P1[8 * s_ + 1]), cvtpk(P1[8 * s_ + 2], P1[8 * s_ + 3]), cvtpk(P1[8 * s_ + 4], P1[8 * s_ + 5]), cvtpk(P1[8 * s_ + 6], P1[8 * s_ + 7])}; \
        pa[s_] = __builtin_bit_cast(bf16x8, w0_); pa[2 + s_] = __builtin_bit_cast(bf16x8, w1_); } } while (0)
#define ATP_SUM(P0, P1) do { float ps0 = 0.f, ps1 = 0.f, ps2 = 0.f, ps3 = 0.f; \
    _Pragma("unroll") for (int r = 0; r < 16; r += 4) { ps0 += P0[r] + P1[r]; ps1 += P0[r + 1] + P1[r + 1]; ps2 += P0[r + 2] + P1[r + 2]; ps3 += P0[r + 3] + P1[r + 3]; } \
    l_reg += (ps0 + ps1) + (ps2 + ps3); } while (0)
#define ATP_VRD(VF, vslot, d) do { const LAS unsigned char* vp_ = lds + VOFF + (vslot) * VBYTES + vlane + (d) * 4096; \
    _Pragma("unroll") for (int ks = 0; ks < 4; ++ks) { if (ABL == 6 || ABL == 7) { VF[2 * ks] = __builtin_bit_cast(s16x4, (unsigned long long)(uintptr_t)vp_ * (ks + 1)); VF[2 * ks + 1] = __builtin_bit_cast(s16x4, (unsigned long long)(uintptr_t)vp_ * (ks + 5)); } else { VF[2 * ks] = vtr(vp_ + ks * 1024); VF[2 * ks + 1] = vtr(vp_ + ks * 1024 + 512); } } } while (0)
#define ATP_PK(L, H) (bf16x8){L[0], L[1], L[2], L[3], H[0], H[1], H[2], H[3]}
#define ATP_MMA(VF, d) do { _Pragma("unroll") for (int ks = 0; ks < 4; ++ks) { if (ABL == 2) o[d][ks] += __builtin_bit_cast(float, (int)pa[ks][0]) + __builtin_bit_cast(float, (int)VF[2 * ks][0] + (int)VF[2 * ks + 1][0]); else o[d] = __builtin_amdgcn_mfma_f32_32x32x16_bf16(pa[ks], ATP_PK(VF[2 * ks], VF[2 * ks + 1]), o[d], 0, 0, 0); } } while (0)
#define ATP_STEP(PC0, PC1, PN0, PN1) do { \
    const bool more1_ = have_next; const int tn1_ = t_next; \
    const bool more2_ = tmask != 0ull; const int tn2_ = more2_ ? __builtin_ctzll(tmask) : 0; tmask &= tmask - 1; \
    if (more2_ && ABL != 4) ATP_SLOAD(tn2_); \
    s16x4 vfa[8], vfb[8]; ATP_VRD(vfa, vc, 0); \
    ATP_QKT(PN0, PN1, more1_ ? (kc ^ 1) : kc);     \
    ATP_SOFT(PC0, PC1); ATT_SBAR();        \
    static_assert(ND0 == 2, "pipelined core: DV = 64"); \
    ATP_VRD(vfb, vc, 1); ATP_SUM(PC0, PC1); ATP_MMA(vfa, 0); ATP_MMA(vfb, 1); ATT_SBAR();     \
    if (more2_ && ABL != 4) ATP_SWRITE(kc, vc == 0 ? 2 : vc - 1); \
    if (ABL != 3) __syncthreads(); \
    kc ^= 1; vc = (vc == 2) ? 0 : vc + 1; have_next = more2_; t_next = tn2_; (void)tn1_; \
    if (!more1_) goto atp_done; } while (0)

    const int vlane = ((lane >> 4) & 1) * 32 + (lane & 3) * 8 + (4 * hi + ((lane & 15) >> 2)) * 64;
    f32x16 pA0, pA1, pB0, pB1; bf16x8 pa[4];
    int kc = 0, vc = 0;
    { const int t_a = __builtin_ctzll(tmask); tmask &= tmask - 1; ATP_SLOAD(t_a); ATP_SWRITE(0, 0); }
    bool have_next = tmask != 0ull; int t_next = have_next ? __builtin_ctzll(tmask) : 0; tmask &= tmask - 1;
    __syncthreads();
    if (have_next) ATP_SLOAD(t_next);
    ATP_QKT(pA0, pA1, 0);
    if (have_next) ATP_SWRITE(1, 1);
    __syncthreads();
    for (;;) { ATP_STEP(pA0, pA1, pB0, pB1); ATP_STEP(pB0, pB1, pA0, pA1); }
atp_done:
#undef ATP_SLOAD
#undef ATP_SWRITE
#undef ATP_QKT
#undef ATP_SOFT
#undef ATP_SUM
#undef ATP_VRD
#undef ATP_PK
#undef ATP_MMA
#undef ATP_STEP
    { const float lt = xor_add<32>(l_reg); if (hi == 0) wsf[32 + r32] = 1.0f / lt; }
    LDS_WAIT();
#pragma unroll
    for (int g = 0; g < 4; ++g) {
        const f32x4 l0 = *(const LAS f32x4*)(wsf + 32 + 8 * g + 4 * hi);
#pragma unroll
        for (int d = 0; d < ND0; ++d)
#pragma unroll
            for (int i = 0; i < 4; ++i) res[d][4 * g + i] = o[d][4 * g + i] * l0[i];
    }
    LDS_WAIT();
    __syncthreads();
}
template <int DQK, int DV, int MODE, int RB, bool QL = false, bool QPREP = false, bool STAG = false>
__device__ __forceinline__ void attn_core_rb(const Args& A, int q0, unsigned long long tmask, LAS unsigned char* lds, float (&res)[RB][DV / 32][16]) {
    constexpr int KSTR = DQK * 2 + 16, KBYTES = 64 * KSTR, VBYTES = 64 * DV * 2, PBYTES = 256;
    constexpr int KPB = KBYTES + PBYTES, NVB = STAG ? 3 : 2, VOFF = 2 * KPB, BUF2 = 2 * KPB + NVB * VBYTES;
    static_assert(!STAG || MODE != 2, "the staggered loop has no per-wave tile skipping");
    constexpr int CPR = DQK / 8, NKP = 64 * CPR, KP = (NKP + 511) / 512, VP = (64 * DV / 8) / 512, ND0 = DV / 32, NKS = DQK / 16;
    static_assert(BUF2 + 8 * 256 + (QL ? 8 * RB * NKS * 1024 : 0) <= (QL ? ATT_NXT_OFF : ATT_STASH_OFF), "attention LDS");
    int tid_ = threadIdx.x; asm volatile("" : "+v"(tid_));
    const int tid = tid_, lane = tid & 63, wid = __builtin_amdgcn_readfirstlane(tid >> 6), r32 = lane & 31, hi = lane >> 5;
    LAS float* wsf = (LAS float*)(lds + BUF2) + wid * 64;
    LAS bf16x8* qlds = (LAS bf16x8*)(lds + BUF2 + 8 * 256) + wid * (RB * NKS * 64) + lane;
    const int wrow = q0 + wid * (32 * RB);

    bf16x8 sk[KP], sv[VP]; float spos = 0.f;
    unsigned gk_off[KP], lk_off[KP], gv_off[VP], lv_off[VP];
#pragma unroll
    for (int i = 0; i < KP; ++i) { const int p = tid + 512 * i, row = p / CPR, ch = p % CPR; gk_off[i] = (unsigned)(row * A.pk + ch * 8) * 2u; lk_off[i] = (unsigned)(row * KSTR + ch * 16); }
#pragma unroll
    for (int i = 0; i < VP; ++i) { const int p = tid + 512 * i, db = p >> 8, row = (p & 255) >> 2, c4 = p & 3; gv_off[i] = (unsigned)(row * A.pv + db * 32 + c4 * 8) * 2u;
        lv_off[i] = (unsigned)(db * 4096 + (row >> 4) * 1024 + (row & 15) * 64 + c4 * 16); }
#define ATR_SLOAD(t) do { const int k0_ = (t) * 64; const char* kb_ = (const char*)(A.K + (size_t)k0_ * A.pk); const char* vb_ = (const char*)(A.V + (size_t)k0_ * A.pv); \
    _Pragma("unroll") for (int i = 0; i < KP; ++i) { if (tid + 512 * i < NKP) sk[i] = *(const bf16x8*)(kb_ + gk_off[i]); } \
    _Pragma("unroll") for (int i = 0; i < VP; ++i) sv[i] = *(const bf16x8*)(vb_ + gv_off[i]); \
    if (MODE == 1) { if (tid < 64) spos = (float)A.pos[k0_ + tid]; } if (MODE == 2) { spos = (float)(k0_ + tid); } } while (0)
#define ATR_SWRITE(b, vb) do { LAS unsigned char* base_ = lds + (b) * KPB; LAS unsigned char* vbase_ = lds + VOFF + (vb) * VBYTES; \
    _Pragma("unroll") for (int i = 0; i < KP; ++i) { if (tid + 512 * i < NKP) *(LAS bf16x8*)(base_ + lk_off[i]) = sk[i]; } \
    _Pragma("unroll") for (int i = 0; i < VP; ++i) *(LAS bf16x8*)(vbase_ + lv_off[i]) = sv[i]; \
    if (MODE != 0) { if (tid < 64) *(LAS float*)(base_ + KBYTES + tid * 4) = spos; } } while (0)
#define ATR_VRD(VF, d) do { const LAS unsigned char* vp_ = vbase + (d) * 4096; \
    _Pragma("unroll") for (int ks = 0; ks < 4; ++ks) { VF[2 * ks] = vtr(vp_ + ks * 1024); VF[2 * ks + 1] = vtr(vp_ + ks * 1024 + 512); } } while (0)
#define ATR_PK(L, H) (bf16x8){L[0], L[1], L[2], L[3], H[0], H[1], H[2], H[3]}
#define ATR_MMA(VF, d) do { _Pragma("unroll") for (int rb = 0; rb < RB; ++rb) _Pragma("unroll") for (int ks = 0; ks < 4; ++ks) \
        o[rb][d] = __builtin_amdgcn_mfma_f32_32x32x16_bf16(pa[rb][ks], ATR_PK(VF[2 * ks], VF[2 * ks + 1]), o[rb][d], 0, 0, 0); } while (0)

    int t = __builtin_ctzll(tmask); tmask &= tmask - 1;
    ATR_SLOAD(t);
    bf16x8 qr[RB][NKS]; float pqf[RB];
#pragma unroll
    for (int rb = 0; rb < RB; ++rb) {
#pragma unroll
        for (int d0 = 0; d0 < NKS; ++d0) { qr[rb][d0] = *(const bf16x8*)(A.Q + (size_t)(wrow + rb * 32 + r32) * A.pq + d0 * 16 + hi * 8); if (QL && !QPREP) qlds[(rb * NKS + d0) * 64] = qr[rb][d0]; }
        if constexpr (QPREP) {
            static_assert(!QPREP || (DQK == 96 && QL), "QPREP is the latent attention's query path");
            float v[NKS][8];
#pragma unroll
            for (int d0 = 0; d0 < NKS; ++d0) { const v4u w = __builtin_bit_cast(v4u, qr[rb][d0]);
                v[d0][0] = bflo(w.x); v[d0][1] = bfhi(w.x); v[d0][2] = bflo(w.y); v[d0][3] = bfhi(w.y); v[d0][4] = bflo(w.z); v[d0][5] = bfhi(w.z); v[d0][6] = bflo(w.w); v[d0][7] = bfhi(w.w); }
            const float posf = (float)A.pos[wrow + rb * 32 + r32];
#pragma unroll
            for (int j = 0; j < 8; ++j) {
                const float fi = (float)(hi * 8 + j);
                const float invf = __builtin_amdgcn_exp2f(-fi * 0.83048202372184f) * 0.15915494309189535f;
                const float fr = __builtin_amdgcn_fractf(posf * invf);
                const float cs = __builtin_amdgcn_cosf(fr), sn = __builtin_amdgcn_sinf(fr);
                const float x = v[4][j], y = v[5][j]; v[4][j] = x * cs - y * sn; v[5][j] = x * sn + y * cs; }
            float ss = 0.f;
#pragma unroll
            for (int d0 = 0; d0 < NKS; ++d0)
#pragma unroll
                for (int j = 0; j < 8; ++j) ss = fmaf(v[d0][j], v[d0][j], ss);
            ss = xor_add<32>(ss);
            const float rq = (1.0f / sqrtf(ss * (1.0f / 96) + EPS)) * (0.10206207261596575f * LOG2E);
#pragma unroll
            for (int d0 = 0; d0 < NKS; ++d0) { const float* gp = A.qg + d0 * 16 + hi * 8; const f32x4 g0 = *(const f32x4*)gp, g1 = *(const f32x4*)(gp + 4);
                v4u w; w.x = cvtpk(v[d0][0] * rq * g0[0], v[d0][1] * rq * g0[1]); w.y = cvtpk(v[d0][2] * rq * g0[2], v[d0][3] * rq * g0[3]);
                w.z = cvtpk(v[d0][4] * rq * g1[0], v[d0][5] * rq * g1[1]); w.w = cvtpk(v[d0][6] * rq * g1[2], v[d0][7] * rq * g1[3]);
                qr[rb][d0] = __builtin_bit_cast(bf16x8, w); qlds[(rb * NKS + d0) * 64] = qr[rb][d0]; }
        }
        pqf[rb] = 0.f;
        if (MODE == 1) pqf[rb] = (float)A.pos[wrow + rb * 32 + r32];
        if (MODE == 2) pqf[rb] = (float)(wrow + rb * 32 + r32);
    }
    f32x16 o[RB][ND0]; float l_reg[RB];
#pragma unroll
    for (int rb = 0; rb < RB; ++rb) { l_reg[rb] = (MODE == 2 && hi == 0) ? __builtin_amdgcn_exp2f(A.sink2) : 0.f;
#pragma unroll
        for (int d = 0; d < ND0; ++d)
#pragma unroll
            for (int r = 0; r < 16; ++r) o[rb][d][r] = 0.f; }

    ATR_SWRITE(0, 0); __syncthreads();
    const bool late = STAG && wid >= 4; int vc = 0;
    if (ATT_PRIO(STAG) && wid >= 4) __builtin_amdgcn_s_setprio(1);
    for (int cur = 0;; cur ^= 1) {
        const bool more = tmask != 0ull; const int tn = more ? __builtin_ctzll(tmask) : 0; tmask &= tmask - 1;
        LAS unsigned char* bufp = lds + cur * KPB; const int vn = (vc + 1 == NVB) ? 0 : vc + 1;
        if (more) ATR_SLOAD(tn);
        const bool active = (MODE != 2) || (t * 64 + 63 >= wrow - 128 && t * 64 <= wrow + 32 * RB - 1 + 128);
        if (active) {
        const LAS unsigned char* vbase = lds + VOFF + vc * VBYTES + ((lane >> 4) & 1) * 32 + (lane & 3) * 8 + (4 * hi + ((lane & 15) >> 2)) * 64;
        s16x4 vfa[8], vfb[8];
        if (RB == 1) ATR_VRD(vfa, 0);
        bf16x8 pa[RB][4];
        f32x16 pp[RB][2];
        {
            const f32x16 zero = {0.f, 0.f, 0.f, 0.f, 0.f, 0.f, 0.f, 0.f, 0.f, 0.f, 0.f, 0.f, 0.f, 0.f, 0.f, 0.f};
            const LAS unsigned char* kb = bufp + r32 * KSTR + hi * 16;
#pragma unroll
            for (int d0 = 0; d0 < NKS; ++d0) {
                const bf16x8 b0 = *(const LAS bf16x8*)(kb + d0 * 32);
                const bf16x8 b1 = *(const LAS bf16x8*)(kb + 32 * KSTR + d0 * 32);
#pragma unroll
                for (int rb = 0; rb < RB; ++rb) {
                    const bf16x8 qf = QL ? qlds[(rb * NKS + d0) * 64] : qr[rb][d0];
                    if (d0 == 0) { pp[rb][0] = __builtin_amdgcn_mfma_f32_32x32x16_bf16(b0, qf, zero, 0, 0, 0); pp[rb][1] = __builtin_amdgcn_mfma_f32_32x32x16_bf16(b1, qf, zero, 0, 0, 0); }
                    else { pp[rb][0] = __builtin_amdgcn_mfma_f32_32x32x16_bf16(b0, qf, pp[rb][0], 0, 0, 0); pp[rb][1] = __builtin_amdgcn_mfma_f32_32x32x16_bf16(b1, qf, pp[rb][1], 0, 0, 0); }
                }
            }
        }
#pragma unroll
        for (int rb = 0; rb < RB; ++rb) {
            f32x16 p0 = pp[rb][0], p1 = pp[rb][1];
            if (MODE != 0) {
                const LAS float* pk = (const LAS float*)(bufp + KBYTES);
#pragma unroll
                for (int g = 0; g < 4; ++g) {
                    const f32x4 k0v = *(const LAS f32x4*)(pk + 8 * g + 4 * hi), k1v = *(const LAS f32x4*)(pk + 32 + 8 * g + 4 * hi);
#pragma unroll
                    for (int i = 0; i < 4; ++i) {
                        const float d0f = fabsf(pqf[rb] - k0v[i]), d1f = fabsf(pqf[rb] - k1v[i]);
                        float s0 = fmaf(-A.slope2, d0f, p0[4 * g + i]), s1 = fmaf(-A.slope2, d1f, p1[4 * g + i]);
                        if (MODE == 2) { s0 = d0f <= 128.0f ? s0 : -1e30f; s1 = d1f <= 128.0f ? s1 : -1e30f; }
                        p0[4 * g + i] = s0; p1[4 * g + i] = s1;
                    }
                }
            }
#pragma unroll
            for (int r = 0; r < 16; ++r) { p0[r] = __builtin_amdgcn_exp2f(p0[r]); p1[r] = __builtin_amdgcn_exp2f(p1[r]); }
            float ps0 = p0[0] + p1[0], ps1 = p0[1] + p1[1], ps2 = p0[2] + p1[2], ps3 = p0[3] + p1[3];
#pragma unroll
            for (int r = 4; r < 16; r += 4) { ps0 += p0[r] + p1[r]; ps1 += p0[r + 1] + p1[r + 1]; ps2 += p0[r + 2] + p1[r + 2]; ps3 += p0[r + 3] + p1[r + 3]; }
            l_reg[rb] += (ps0 + ps1) + (ps2 + ps3);
#pragma unroll
            for (int s = 0; s < 2; ++s) {
                v4u w0 = {cvtpk(p0[8 * s + 0], p0[8 * s + 1]), cvtpk(p0[8 * s + 2], p0[8 * s + 3]), cvtpk(p0[8 * s + 4], p0[8 * s + 5]), cvtpk(p0[8 * s + 6], p0[8 * s + 7])};
                v4u w1 = {cvtpk(p1[8 * s + 0], p1[8 * s + 1]), cvtpk(p1[8 * s + 2], p1[8 * s + 3]), cvtpk(p1[8 * s + 4], p1[8 * s + 5]), cvtpk(p1[8 * s + 6], p1[8 * s + 7])};
                pa[rb][s] = __builtin_bit_cast(bf16x8, w0); pa[rb][2 + s] = __builtin_bit_cast(bf16x8, w1);
            }
        }
        if (STAG) { if (late) { if (more) ATR_SWRITE(cur ^ 1, vn); __syncthreads(); } }
        if (RB == 2) { _Pragma("unroll") for (int d = 0; d < ND0; ++d) { ATR_VRD(vfa, d); ATR_MMA(vfa, d); } (void)vfb; }
        else if (ND0 == 2) { ATR_VRD(vfb, 1); ATR_MMA(vfa, 0); ATR_MMA(vfb, 1); }
        else { ATR_VRD(vfb, 1); ATR_MMA(vfa, 0); ATR_VRD(vfa, 2); ATR_MMA(vfb, 1); ATR_VRD(vfb, 3); ATR_MMA(vfa, 2); ATR_MMA(vfb, 3); }
        }
        if (!late) { if (more) ATR_SWRITE(cur ^ 1, vn); __syncthreads(); }
        if (!more) break;
        t = tn; vc = vn;
    }
    __builtin_amdgcn_s_setprio(0);
#undef ATR_SLOAD
#undef ATR_SWRITE
#undef ATR_VRD
#undef ATR_PK
#undef ATR_MMA
#pragma unroll
    for (int rb = 0; rb < RB; ++rb) { const float lt = xor_add<32>(l_reg[rb]); if (hi == 0) wsf[rb * 32 + r32] = 1.0f / lt; }
    LDS_WAIT();
#pragma unroll
    for (int rb = 0; rb < RB; ++rb)
#pragma unroll
        for (int g = 0; g < 4; ++g) {
            const f32x4 l0 = *(const LAS f32x4*)(wsf + rb * 32 + 8 * g + 4 * hi);
#pragma unroll
            for (int d = 0; d < ND0; ++d)
#pragma unroll
                for (int i = 0; i < 4; ++i) res[rb][d][4 * g + i] = o[rb][d][4 * g + i] * l0[i];
        }
    LDS_WAIT();
    __syncthreads();
}
template <int DQK, int DV, int MODE, int RB, bool QL = false>
__device__ __forceinline__ void attn_core_pd2(const Args& A, int q0, unsigned long long tmask, LAS unsigned char* lds, float (&res)[RB][DV / 32][16]) {
    constexpr int KSTR = DQK * 2 + 16, KBYTES = 64 * KSTR, VBYTES = 64 * DV * 2, PBYTES = 256;
    constexpr int BUF = KBYTES + VBYTES + PBYTES;
    constexpr int CPR = DQK / 8, NKP = 64 * CPR, KP = (NKP + 511) / 512, VP = (64 * DV / 8) / 512, ND0 = DV / 32, NKS = DQK / 16;
    static_assert(2 * BUF + 8 * 256 + (QL ? 8 * RB * NKS * 1024 : 0) <= (QL ? ATT_NXT_OFF : ATT_STASH_OFF), "attention LDS");
    int tid_ = threadIdx.x; asm volatile("" : "+v"(tid_));
    const int tid = tid_, lane = tid & 63, wid = __builtin_amdgcn_readfirstlane(tid >> 6), r32 = lane & 31, hi = lane >> 5;
    LAS float* wsf = (LAS float*)(lds + 2 * BUF) + wid * 64;
    LAS bf16x8* qlds = (LAS bf16x8*)(lds + 2 * BUF + 8 * 256) + wid * (RB * NKS * 64) + lane;
    const int wrow = q0 + wid * (32 * RB);

    bf16x8 qr[RB][NKS]; float pqf[RB];
#pragma unroll
    for (int rb = 0; rb < RB; ++rb) {
#pragma unroll
        for (int d0 = 0; d0 < NKS; ++d0) { qr[rb][d0] = *(const bf16x8*)(A.Q + (size_t)(wrow + rb * 32 + r32) * A.pq + d0 * 16 + hi * 8); if (QL) qlds[(rb * NKS + d0) * 64] = qr[rb][d0]; }
        pqf[rb] = 0.f;
        if (MODE == 1) pqf[rb] = (float)A.pos[wrow + rb * 32 + r32];
        if (MODE == 2) pqf[rb] = (float)(wrow + rb * 32 + r32);
    }
    f32x16 o[RB][ND0]; float l_reg[RB];
#pragma unroll
    for (int rb = 0; rb < RB; ++rb) { l_reg[rb] = (MODE == 2 && hi == 0) ? __builtin_amdgcn_exp2f(A.sink2) : 0.f;
#pragma unroll
        for (int d = 0; d < ND0; ++d)
#pragma unroll
            for (int r = 0; r < 16; ++r) o[rb][d][r] = 0.f; }

    bf16x8 skA[KP], svA[VP], skB[KP], svB[VP]; float sposA = 0.f, sposB = 0.f;
    unsigned gk_off[KP], lk_off[KP], gv_off[VP], lv_off[VP];
#pragma unroll
    for (int i = 0; i < KP; ++i) { const int p = tid + 512 * i, row = p / CPR, ch = p % CPR; gk_off[i] = (unsigned)(row * A.pk + ch * 8) * 2u; lk_off[i] = (unsigned)(row * KSTR + ch * 16); }
#pragma unroll
    for (int i = 0; i < VP; ++i) { const int p = tid + 512 * i, db = p >> 8, row = (p & 255) >> 2, c4 = p & 3; gv_off[i] = (unsigned)(row * A.pv + db * 32 + c4 * 8) * 2u;
        lv_off[i] = (unsigned)(KBYTES + db * 4096 + (row >> 4) * 1024 + (row & 15) * 64 + c4 * 16); }
#define ATR_SLOAD(t, sk, sv, spos) do { const int k0_ = (t) * 64; const char* kb_ = (const char*)(A.K + (size_t)k0_ * A.pk); const char* vb_ = (const char*)(A.V + (size_t)k0_ * A.pv); \
    _Pragma("unroll") for (int i = 0; i < KP; ++i) { if (tid + 512 * i < NKP) sk[i] = *(const bf16x8*)(kb_ + gk_off[i]); } \
    _Pragma("unroll") for (int i = 0; i < VP; ++i) sv[i] = *(const bf16x8*)(vb_ + gv_off[i]); \
    if (MODE == 1) { if (tid < 64) spos = (float)A.pos[k0_ + tid]; } if (MODE == 2) { spos = (float)(k0_ + tid); } } while (0)
#define ATR_SWRITE(b, sk, sv, spos) do { LAS unsigned char* base_ = lds + (b) * BUF; \
    _Pragma("unroll") for (int i = 0; i < KP; ++i) { if (tid + 512 * i < NKP) *(LAS bf16x8*)(base_ + lk_off[i]) = sk[i]; } \
    _Pragma("unroll") for (int i = 0; i < VP; ++i) *(LAS bf16x8*)(base_ + lv_off[i]) = sv[i]; \
    if (MODE != 0) { if (tid < 64) *(LAS float*)(base_ + KBYTES + VBYTES + tid * 4) = spos; } } while (0)
#define ATR_VRD(VF, d) do { const LAS unsigned char* vp_ = vbase + (d) * 4096; \
    _Pragma("unroll") for (int ks = 0; ks < 4; ++ks) { VF[2 * ks] = vtr(vp_ + ks * 1024); VF[2 * ks + 1] = vtr(vp_ + ks * 1024 + 512); } } while (0)
#define ATR_PK(L, H) (bf16x8){L[0], L[1], L[2], L[3], H[0], H[1], H[2], H[3]}
#define ATR_MMA(VF, d) do { _Pragma("unroll") for (int rb = 0; rb < RB; ++rb) _Pragma("unroll") for (int ks = 0; ks < 4; ++ks) \
        o[rb][d] = __builtin_amdgcn_mfma_f32_32x32x16_bf16(pa[rb][ks], ATR_PK(VF[2 * ks], VF[2 * ks + 1]), o[rb][d], 0, 0, 0); } while (0)

    int cur = 0;
    const int t0 = __builtin_ctzll(tmask); tmask &= tmask - 1;
    bool more1 = tmask != 0ull; const int t1 = more1 ? __builtin_ctzll(tmask) : 0; tmask &= tmask - 1;
    bool more2 = tmask != 0ull; int t2 = more2 ? __builtin_ctzll(tmask) : 0; tmask &= tmask - 1;
    ATR_SLOAD(t0, skA, svA, sposA); ATR_SWRITE(0, skA, svA, sposA);
    if (more1) ATR_SLOAD(t1, skB, svB, sposB);
    __syncthreads();
    for (;;) {
        {
        LAS unsigned char* bufp = lds + cur * BUF;
        if (more2) ATR_SLOAD(t2, skA, svA, sposA);
        const LAS unsigned char* vbase = bufp + KBYTES + ((lane >> 4) & 1) * 32 + (lane & 3) * 8 + (4 * hi + ((lane & 15) >> 2)) * 64;
        s16x4 vfa[8], vfb[8];
        if (RB == 1) ATR_VRD(vfa, 0);
        bf16x8 pa[RB][4];
        f32x16 pp[RB][2];
        {
            const f32x16 zero = {0.f, 0.f, 0.f, 0.f, 0.f, 0.f, 0.f, 0.f, 0.f, 0.f, 0.f, 0.f, 0.f, 0.f, 0.f, 0.f};
            const LAS unsigned char* kb = bufp + r32 * KSTR + hi * 16;
#pragma unroll
            for (int d0 = 0; d0 < NKS; ++d0) {
                const bf16x8 b0 = *(const LAS bf16x8*)(kb + d0 * 32);
                const bf16x8 b1 = *(const LAS bf16x8*)(kb + 32 * KSTR + d0 * 32);
#pragma unroll
                for (int rb = 0; rb < RB; ++rb) {
                    const bf16x8 qf = QL ? qlds[(rb * NKS + d0) * 64] : qr[rb][d0];
                    if (d0 == 0) { pp[rb][0] = __builtin_amdgcn_mfma_f32_32x32x16_bf16(b0, qf, zero, 0, 0, 0); pp[rb][1] = __builtin_amdgcn_mfma_f32_32x32x16_bf16(b1, qf, zero, 0, 0, 0); }
                    else { pp[rb][0] = __builtin_amdgcn_mfma_f32_32x32x16_bf16(b0, qf, pp[rb][0], 0, 0, 0); pp[rb][1] = __builtin_amdgcn_mfma_f32_32x32x16_bf16(b1, qf, pp[rb][1], 0, 0, 0); }
                }
            }
        }
#pragma unroll
        for (int rb = 0; rb < RB; ++rb) {
            f32x16 p0 = pp[rb][0], p1 = pp[rb][1];
            if (MODE != 0) {
                const LAS float* pk = (const LAS float*)(bufp + KBYTES + VBYTES);
#pragma unroll
                for (int g = 0; g < 4; ++g) {
                    const f32x4 k0v = *(const LAS f32x4*)(pk + 8 * g + 4 * hi), k1v = *(const LAS f32x4*)(pk + 32 + 8 * g + 4 * hi);
#pragma unroll
                    for (int i = 0; i < 4; ++i) {
                        const float d0f = fabsf(pqf[rb] - k0v[i]), d1f = fabsf(pqf[rb] - k1v[i]);
                        float s0 = fmaf(-A.slope2, d0f, p0[4 * g + i]), s1 = fmaf(-A.slope2, d1f, p1[4 * g + i]);
                        if (MODE == 2) { s0 = d0f <= 128.0f ? s0 : -1e30f; s1 = d1f <= 128.0f ? s1 : -1e30f; }
                        p0[4 * g + i] = s0; p1[4 * g + i] = s1;
                    }
                }
            }
#pragma unroll
            for (int r = 0; r < 16; ++r) { p0[r] = __builtin_amdgcn_exp2f(p0[r]); p1[r] = __builtin_amdgcn_exp2f(p1[r]); }
            float ps0 = p0[0] + p1[0], ps1 = p0[1] + p1[1], ps2 = p0[2] + p1[2], ps3 = p0[3] + p1[3];
#pragma unroll
            for (int r = 4; r < 16; r += 4) { ps0 += p0[r] + p1[r]; ps1 += p0[r + 1] + p1[r + 1]; ps2 += p0[r + 2] + p1[r + 2]; ps3 += p0[r + 3] + p1[r + 3]; }
            l_reg[rb] += (ps0 + ps1) + (ps2 + ps3);
#pragma unroll
            for (int s = 0; s < 2; ++s) {
                v4u w0 = {cvtpk(p0[8 * s + 0], p0[8 * s + 1]), cvtpk(p0[8 * s + 2], p0[8 * s + 3]), cvtpk(p0[8 * s + 4], p0[8 * s + 5]), cvtpk(p0[8 * s + 6], p0[8 * s + 7])};
                v4u w1 = {cvtpk(p1[8 * s + 0], p1[8 * s + 1]), cvtpk(p1[8 * s + 2], p1[8 * s + 3]), cvtpk(p1[8 * s + 4], p1[8 * s + 5]), cvtpk(p1[8 * s + 6], p1[8 * s + 7])};
                pa[rb][s] = __builtin_bit_cast(bf16x8, w0); pa[rb][2 + s] = __builtin_bit_cast(bf16x8, w1);
            }
        }
        if (RB == 2) { _Pragma("unroll") for (int d = 0; d < ND0; ++d) { ATR_VRD(vfa, d); ATR_MMA(vfa, d); } (void)vfb; }
        else if (ND0 == 2) { ATR_VRD(vfb, 1); ATR_MMA(vfa, 0); ATR_MMA(vfb, 1); }
        else { ATR_VRD(vfb, 1); ATR_MMA(vfa, 0); ATR_VRD(vfa, 2); ATR_MMA(vfb, 1); ATR_VRD(vfb, 3); ATR_MMA(vfa, 2); ATR_MMA(vfb, 3); }
        if (more1) ATR_SWRITE(cur ^ 1, skB, svB, sposB);
        __syncthreads();
        if (!more1) break;
        cur ^= 1; more1 = more2; more2 = tmask != 0ull; t2 = more2 ? __builtin_ctzll(tmask) : 0; tmask &= tmask - 1;
        }
        {
        LAS unsigned char* bufp = lds + cur * BUF;
        if (more2) ATR_SLOAD(t2, skB, svB, sposB);
        const LAS unsigned char* vbase = bufp + KBYTES + ((lane >> 4) & 1) * 32 + (lane & 3) * 8 + (4 * hi + ((lane & 15) >> 2)) * 64;
        s16x4 vfa[8], vfb[8];
        if (RB == 1) ATR_VRD(vfa, 0);
        bf16x8 pa[RB][4];
        f32x16 pp[RB][2];
        {
            const f32x16 zero = {0.f, 0.f, 0.f, 0.f, 0.f, 0.f, 0.f, 0.f, 0.f, 0.f, 0.f, 0.f, 0.f, 0.f, 0.f, 0.f};
            const LAS unsigned char* kb = bufp + r32 * KSTR + hi * 16;
#pragma unroll
            for (int d0 = 0; d0 < NKS; ++d0) {
                const bf16x8 b0 = *(const LAS bf16x8*)(kb + d0 * 32);
                const bf16x8 b1 = *(const LAS bf16x8*)(kb + 32 * KSTR + d0 * 32);
#pragma unroll
                for (int rb = 0; rb < RB; ++rb) {
                    const bf16x8 qf = QL ? qlds[(rb * NKS + d0) * 64] : qr[rb][d0];
                    if (d0 == 0) { pp[rb][0] = __builtin_amdgcn_mfma_f32_32x32x16_bf16(b0, qf, zero, 0, 0, 0); pp[rb][1] = __builtin_amdgcn_mfma_f32_32x32x16_bf16(b1, qf, zero, 0, 0, 0); }
                    else { pp[rb][0] = __builtin_amdgcn_mfma_f32_32x32x16_bf16(b0, qf, pp[rb][0], 0, 0, 0); pp[rb][1] = __builtin_amdgcn_mfma_f32_32x32x16_bf16(b1, qf, pp[rb][1], 0, 0, 0); }
                }
            }
        }
#pragma unroll
        for (int rb = 0; rb < RB; ++rb) {
            f32x16 p0 = pp[rb][0], p1 = pp[rb][1];
            if (MODE != 0) {
                const LAS float* pk = (const LAS float*)(bufp + KBYTES + VBYTES);
#pragma unroll
                for (int g = 0; g < 4; ++g) {
                    const f32x4 k0v = *(const LAS f32x4*)(pk + 8 * g + 4 * hi), k1v = *(const LAS f32x4*)(pk + 32 + 8 * g + 4 * hi);
#pragma unroll
                    for (int i = 0; i < 4; ++i) {
                        const float d0f = fabsf(pqf[rb] - k0v[i]), d1f = fabsf(pqf[rb] - k1v[i]);
                        float s0 = fmaf(-A.slope2, d0f, p0[4 * g + i]), s1 = fmaf(-A.slope2, d1f, p1[4 * g + i]);
                        if (MODE == 2) { s0 = d0f <= 128.0f ? s0 : -1e30f; s1 = d1f <= 128.0f ? s1 : -1e30f; }
                        p0[4 * g + i] = s0; p1[4 * g + i] = s1;
                    }
                }
            }
#pragma unroll
            for (int r = 0; r < 16; ++r) { p0[r] = __builtin_amdgcn_exp2f(p0[r]); p1[r] = __builtin_amdgcn_exp2f(p1[r]); }
            float ps0 = p0[0] + p1[0], ps1 = p0[1] + p1[1], ps2 = p0[2] + p1[2], ps3 = p0[3] + p1[3];
#pragma unroll
            for (int r = 4; r < 16; r += 4) { ps0 += p0[r] + p1[r]; ps1 += p0[r + 1] + p1[r + 1]; ps2 += p0[r + 2] + p1[r + 2]; ps3 += p0[r + 3] + p1[r + 3]; }
            l_reg[rb] += (ps0 + ps1) + (ps2 + ps3);
#pragma unroll
            for (int s = 0; s < 2; ++s) {
                v4u w0 = {cvtpk(p0[8 * s + 0], p0[8 * s + 1]), cvtpk(p0[8 * s + 2], p0[8 * s + 3]), cvtpk(p0[8 * s + 4], p0[8 * s + 5]), cvtpk(p0[8 * s + 6], p0[8 * s + 7])};
                v4u w1 = {cvtpk(p1[8 * s + 0], p1[8 * s + 1]), cvtpk(p1[8 * s + 2], p1[8 * s + 3]), cvtpk(p1[8 * s + 4], p1[8 * s + 5]), cvtpk(p1[8 * s + 6], p1[8 * s + 7])};
                pa[rb][s] = __builtin_bit_cast(bf16x8, w0); pa[rb][2 + s] = __builtin_bit_cast(bf16x8, w1);
            }
        }
        if (RB == 2) { _Pragma("unroll") for (int d = 0; d < ND0; ++d) { ATR_VRD(vfa, d); ATR_MMA(vfa, d); } (void)vfb; }
        else if (ND0 == 2) { ATR_VRD(vfb, 1); ATR_MMA(vfa, 0); ATR_MMA(vfb, 1); }
        else { ATR_VRD(vfb, 1); ATR_MMA(vfa, 0); ATR_VRD(vfa, 2); ATR_MMA(vfb, 1); ATR_VRD(vfb, 3); ATR_MMA(vfa, 2); ATR_MMA(vfb, 3); }
        if (more1) ATR_SWRITE(cur ^ 1, skA, svA, sposA);
        __syncthreads();
        if (!more1) break;
        cur ^= 1; more1 = more2; more2 = tmask != 0ull; t2 = more2 ? __builtin_ctzll(tmask) : 0; tmask &= tmask - 1;
        }
    }
#undef ATR_SLOAD
#undef ATR_SWRITE
#undef ATR_VRD
#undef ATR_PK
#undef ATR_MMA
#pragma unroll
    for (int rb = 0; rb < RB; ++rb) { const float lt = xor_add<32>(l_reg[rb]); if (hi == 0) wsf[rb * 32 + r32] = 1.0f / lt; }
    LDS_WAIT();
#pragma unroll
    for (int rb = 0; rb < RB; ++rb)
#pragma unroll
        for (int g = 0; g < 4; ++g) {
            const f32x4 l0 = *(const LAS f32x4*)(wsf + rb * 32 + 8 * g + 4 * hi);
#pragma unroll
            for (int d = 0; d < ND0; ++d)
#pragma unroll
                for (int i = 0; i < 4; ++i) res[rb][d][4 * g + i] = o[rb][d][4 * g + i] * l0[i];
        }
    LDS_WAIT();
    __syncthreads();
}
template <int DQK, int DV, int MODE, int RB, bool QL = false>
__device__ __forceinline__ void attn_core_pp(const Args& A, int q0, unsigned long long tmask, LAS unsigned char* lds, float (&res)[RB][DV / 32][16]) {
    constexpr int KSTR = DQK * 2 + 16, KBYTES = 64 * KSTR, VBYTES = 64 * DV * 2;
    constexpr int OFF_V = 2 * KBYTES, OFF_PK = OFF_V + 2 * VBYTES, OFF_WS = OFF_PK + 4 * 256, OFF_Q = OFF_WS + 8 * 256;
    constexpr int CPR = DQK / 8, NKP = 64 * CPR, KP = (NKP + 511) / 512, VP = (64 * DV / 8) / 512, ND0 = DV / 32, NKS = DQK / 16;
    static_assert(OFF_Q + (QL ? 8 * RB * NKS * 1024 : 0) <= (QL ? ATT_NXT_OFF : ATT_STASH_OFF), "attention LDS");
    int tid_ = threadIdx.x; asm volatile("" : "+v"(tid_));
    const int tid = tid_, lane = tid & 63, wid = __builtin_amdgcn_readfirstlane(tid >> 6), r32 = lane & 31, hi = lane >> 5;
    LAS float* wsf = (LAS float*)(lds + OFF_WS) + wid * 64;
    LAS bf16x8* qlds = (LAS bf16x8*)(lds + OFF_Q) + wid * (RB * NKS * 64) + lane;
    const int wrow = q0 + wid * (32 * RB);

    bf16x8 qr[RB][NKS]; float pqf[RB];
#pragma unroll
    for (int rb = 0; rb < RB; ++rb) {
#pragma unroll
        for (int d0 = 0; d0 < NKS; ++d0) { qr[rb][d0] = *(const bf16x8*)(A.Q + (size_t)(wrow + rb * 32 + r32) * A.pq + d0 * 16 + hi * 8); if (QL) qlds[(rb * NKS + d0) * 64] = qr[rb][d0]; }
        pqf[rb] = 0.f;
        if (MODE == 1) pqf[rb] = (float)A.pos[wrow + rb * 32 + r32];
        if (MODE == 2) pqf[rb] = (float)(wrow + rb * 32 + r32);
    }
    f32x16 o[RB][ND0]; float l_reg[RB];
#pragma unroll
    for (int rb = 0; rb < RB; ++rb) { l_reg[rb] = (MODE == 2 && hi == 0) ? __builtin_amdgcn_exp2f(A.sink2) : 0.f;
#pragma unroll
        for (int d = 0; d < ND0; ++d)
#pragma unroll
            for (int r = 0; r < 16; ++r) o[rb][d][r] = 0.f; }

    bf16x8 sk[KP], sv[VP]; float spos = 0.f;
    unsigned gk_off[KP], lk_off[KP], gv_off[VP], lv_off[VP];
#pragma unroll
    for (int i = 0; i < KP; ++i) { const int p = tid + 512 * i, row = p / CPR, ch = p % CPR; gk_off[i] = (unsigned)(row * A.pk + ch * 8) * 2u; lk_off[i] = (unsigned)(row * KSTR + ch * 16); }
#pragma unroll
    for (int i = 0; i < VP; ++i) { const int p = tid + 512 * i, db = p >> 8, row = (p & 255) >> 2, c4 = p & 3; gv_off[i] = (unsigned)(row * A.pv + db * 32 + c4 * 8) * 2u;
        lv_off[i] = (unsigned)(OFF_V + db * 4096 + (row >> 4) * 1024 + (row & 15) * 64 + c4 * 16); }
#define APP_LOADK(t) do { const int k0_ = (t) * 64; const char* kb_ = (const char*)(A.K + (size_t)k0_ * A.pk); \
    _Pragma("unroll") for (int i = 0; i < KP; ++i) { if (tid + 512 * i < NKP) sk[i] = *(const bf16x8*)(kb_ + gk_off[i]); } \
    if (MODE == 1) { if (tid < 64) spos = (float)A.pos[k0_ + tid]; } if (MODE == 2) { spos = (float)(k0_ + tid); } } while (0)
#define APP_LOADV(t) do { const char* vb_ = (const char*)(A.V + (size_t)((t) * 64) * A.pv); \
    _Pragma("unroll") for (int i = 0; i < VP; ++i) sv[i] = *(const bf16x8*)(vb_ + gv_off[i]); } while (0)
#define APP_WRITEK(kb, pr) do { LAS unsigned char* base_ = lds + (kb) * KBYTES; \
    _Pragma("unroll") for (int i = 0; i < KP; ++i) { if (tid + 512 * i < NKP) *(LAS bf16x8*)(base_ + lk_off[i]) = sk[i]; } \
    if (MODE != 0) { if (tid < 64) *(LAS float*)(lds + OFF_PK + (pr) * 256 + tid * 4) = spos; } } while (0)
#define APP_WRITEV(vb) do { LAS unsigned char* base_ = lds + (vb) * VBYTES; \
    _Pragma("unroll") for (int i = 0; i < VP; ++i) *(LAS bf16x8*)(base_ + lv_off[i]) = sv[i]; } while (0)
#define APP_BAR() do { ATT_SBAR(); __builtin_amdgcn_s_barrier(); ATT_SBAR(); } while (0)
#define APP_VRD(VF, d) do { const LAS unsigned char* vp_ = vbase + (d) * 4096; \
    _Pragma("unroll") for (int ks = 0; ks < 4; ++ks) { VF[2 * ks] = vtr(vp_ + ks * 1024); VF[2 * ks + 1] = vtr(vp_ + ks * 1024 + 512); } } while (0)
#define APP_PK(L, H) (bf16x8){L[0], L[1], L[2], L[3], H[0], H[1], H[2], H[3]}
#define APP_MMA(VF, d) do { _Pragma("unroll") for (int rb = 0; rb < RB; ++rb) _Pragma("unroll") for (int ks = 0; ks < 4; ++ks) \
        o[rb][d] = __builtin_amdgcn_mfma_f32_32x32x16_bf16(pa[rb][ks], APP_PK(VF[2 * ks], VF[2 * ks + 1]), o[rb][d], 0, 0, 0); } while (0)
#define APP_QKT(kbuf) do { const f32x16 zero = {0.f, 0.f, 0.f, 0.f, 0.f, 0.f, 0.f, 0.f, 0.f, 0.f, 0.f, 0.f, 0.f, 0.f, 0.f, 0.f}; \
    const LAS unsigned char* kb = lds + (kbuf) * KBYTES + r32 * KSTR + hi * 16; \
    _Pragma("unroll") for (int d0 = 0; d0 < NKS; ++d0) { \
        const bf16x8 b0 = *(const LAS bf16x8*)(kb + d0 * 32); const bf16x8 b1 = *(const LAS bf16x8*)(kb + 32 * KSTR + d0 * 32); \
        _Pragma("unroll") for (int rb = 0; rb < RB; ++rb) { const bf16x8 qf = QL ? qlds[(rb * NKS + d0) * 64] : qr[rb][d0]; \
            if (d0 == 0) { pp[rb][0] = __builtin_amdgcn_mfma_f32_32x32x16_bf16(b0, qf, zero, 0, 0, 0); pp[rb][1] = __builtin_amdgcn_mfma_f32_32x32x16_bf16(b1, qf, zero, 0, 0, 0); } \
            else { pp[rb][0] = __builtin_amdgcn_mfma_f32_32x32x16_bf16(b0, qf, pp[rb][0], 0, 0, 0); pp[rb][1] = __builtin_amdgcn_mfma_f32_32x32x16_bf16(b1, qf, pp[rb][1], 0, 0, 0); } } } } while (0)
#define APP_POP(tv, hv) do { hv = tmask != 0ull; tv = hv ? __builtin_ctzll(tmask) : 0; tmask &= tmask - 1ull; } while (0)

    int ta, tb, tc; bool ha, hb, hc;
    APP_POP(ta, ha); APP_POP(tb, hb); APP_POP(tc, hc); (void)ha;
    APP_LOADK(ta); APP_WRITEK(0, 0);
    if (hb) APP_LOADK(tb);
    APP_LOADV(ta);
    LDS_WAIT();
    if (wid >= 4) APP_BAR();
    APP_BAR();
    f32x16 pp[RB][2]; bf16x8 pa[RB][4];
    __builtin_amdgcn_s_setprio(1);
    APP_QKT(0);
    if (hb) APP_WRITEK(1, 1);
    APP_WRITEV(0);
    __builtin_amdgcn_s_setprio(0);
    for (int j = 0;; ++j) {
        LDS_WAIT(); APP_BAR();
        if (hc) APP_LOADK(tc);
        if (hb) APP_LOADV(tb);
#pragma unroll
        for (int rb = 0; rb < RB; ++rb) {
            f32x16 p0 = pp[rb][0], p1 = pp[rb][1];
            if (MODE != 0) {
                const LAS float* pk = (const LAS float*)(lds + OFF_PK + (j & 3) * 256);
#pragma unroll
                for (int g = 0; g < 4; ++g) {
                    const f32x4 k0v = *(const LAS f32x4*)(pk + 8 * g + 4 * hi), k1v = *(const LAS f32x4*)(pk + 32 + 8 * g + 4 * hi);
#pragma unroll
                    for (int i = 0; i < 4; ++i) {
                        const float d0f = fabsf(pqf[rb] - k0v[i]), d1f = fabsf(pqf[rb] - k1v[i]);
                        float s0 = fmaf(-A.slope2, d0f, p0[4 * g + i]), s1 = fmaf(-A.slope2, d1f, p1[4 * g + i]);
                        if (MODE == 2) { s0 = d0f <= 128.0f ? s0 : -1e30f; s1 = d1f <= 128.0f ? s1 : -1e30f; }
                        p0[4 * g + i] = s0; p1[4 * g + i] = s1;
                    }
                }
            }
#pragma unroll
            for (int r = 0; r < 16; ++r) { p0[r] = __builtin_amdgcn_exp2f(p0[r]); p1[r] = __builtin_amdgcn_exp2f(p1[r]); }
            float ps0 = p0[0] + p1[0], ps1 = p0[1] + p1[1], ps2 = p0[2] + p1[2], ps3 = p0[3] + p1[3];
#pragma unroll
            for (int r = 4; r < 16; r += 4) { ps0 += p0[r] + p1[r]; ps1 += p0[r + 1] + p1[r + 1]; ps2 += p0[r + 2] + p1[r + 2]; ps3 += p0[r + 3] + p1[r + 3]; }
            l_reg[rb] += (ps0 + ps1) + (ps2 + ps3);
#pragma unroll
            for (int s = 0; s < 2; ++s) {
                v4u w0 = {cvtpk(p0[8 * s + 0], p0[8 * s + 1]), cvtpk(p0[8 * s + 2], p0[8 * s + 3]), cvtpk(p0[8 * s + 4], p0[8 * s + 5]), cvtpk(p0[8 * s + 6], p0[8 * s + 7])};
                v4u w1 = {cvtpk(p1[8 * s + 0], p1[8 * s + 1]), cvtpk(p1[8 * s + 2], p1[8 * s + 3]), cvtpk(p1[8 * s + 4], p1[8 * s + 5]), cvtpk(p1[8 * s + 6], p1[8 * s + 7])};
                pa[rb][s] = __builtin_bit_cast(bf16x8, w0); pa[rb][2 + s] = __builtin_bit_cast(bf16x8, w1);
            }
        }
        asm volatile("" ::: "memory"); APP_BAR();
        __builtin_amdgcn_s_setprio(1);
        {
            const LAS unsigned char* vbase = lds + OFF_V + (j & 1) * VBYTES + ((lane >> 4) & 1) * 32 + (lane & 3) * 8 + (4 * hi + ((lane & 15) >> 2)) * 64;
            s16x4 vfa[8], vfb[8];
            if (RB == 2) { _Pragma("unroll") for (int d = 0; d < ND0; ++d) { APP_VRD(vfa, d); APP_MMA(vfa, d); } (void)vfb; }
            else if (ND0 == 2) { APP_VRD(vfa, 0); APP_VRD(vfb, 1); APP_MMA(vfa, 0); APP_MMA(vfb, 1); }
            else { APP_VRD(vfa, 0); APP_VRD(vfb, 1); APP_MMA(vfa, 0); APP_VRD(vfa, 2); APP_MMA(vfb, 1); APP_VRD(vfb, 3); APP_MMA(vfa, 2); APP_MMA(vfb, 3); }
        }
        if (!hb) break;
        APP_QKT((j + 1) & 1);
        if (hc) APP_WRITEK(j & 1, (j + 2) & 3);
        APP_WRITEV((j + 1) & 1);
        __builtin_amdgcn_s_setprio(0);
        hb = hc; tb = tc; APP_POP(tc, hc);
    }
    __builtin_amdgcn_s_setprio(0);
    if (wid < 4) APP_BAR();
#undef APP_LOADK
#undef APP_LOADV
#undef APP_WRITEK
#undef APP_WRITEV
#undef APP_BAR
#undef APP_VRD
#undef APP_PK
#undef APP_MMA
#undef APP_QKT
#undef APP_POP
#pragma unroll
    for (int rb = 0; rb < RB; ++rb) { const float lt = xor_add<32>(l_reg[rb]); if (hi == 0) wsf[rb * 32 + r32] = 1.0f / lt; }
    LDS_WAIT();
#pragma unroll
    for (int rb = 0; rb < RB; ++rb)
#pragma unroll
        for (int g = 0; g < 4; ++g) {
            const f32x4 l0 = *(const LAS f32x4*)(wsf + rb * 32 + 8 * g + 4 * hi);
#pragma unroll
            for (int d = 0; d < ND0; ++d)
#pragma unroll
                for (int i = 0; i < 4; ++i) res[rb][d][4 * g + i] = o[rb][d][4 * g + i] * l0[i];
        }
    LDS_WAIT();
    __syncthreads();
}
template <int ND0> __device__ __forceinline__ void store_rows(const float (&res)[ND0][16], bf16* O, int po, int row0, int lane) {
    asm volatile("" : "+v"(lane));
    const int r32 = lane & 31, hi = lane >> 5;
    bf16* Ow = O + (size_t)row0 * po + r32;
#pragma unroll
    for (int r = 0; r < 16; ++r) { const int orow = crow(r, hi);
#pragma unroll
        for (int d = 0; d < ND0; ++d) Ow[(size_t)orow * po + d * 32] = (bf16)(cvtpk(res[d][r], 0.f) & 0xffffu); }
}
template <int ND0> __device__ __forceinline__ void store_res(const float (&res)[ND0][16], bf16* O, int po, int q0) {
    const int tid = threadIdx.x, lane = tid & 63, wid = __builtin_amdgcn_readfirstlane(tid >> 6), r32 = lane & 31, hi = lane >> 5;
    bf16* Ow = O + (size_t)(q0 + wid * 32) * po + r32;
#pragma unroll
    for (int r = 0; r < 16; ++r) { const int orow = crow(r, hi);
#pragma unroll
        for (int d = 0; d < ND0; ++d) Ow[(size_t)orow * po + d * 32] = (bf16)(cvtpk(res[d][r], 0.f) & 0xffffu); }
}
}

#ifndef STAG_A
#define STAG_A true
#endif
#ifndef STAG_B
#define STAG_B false
#endif
#ifndef ATT_CORE
#define ATT_CORE attn_core_rb
#endif
#ifndef ATT_CORE_A
#define ATT_CORE_A attn_core_rb
#endif

__device__ __forceinline__ float lam_init_of(int layer) { return layer == 0 ? 0.2f : 0.35550906759096184f; }
template <bool DRY> __device__ __forceinline__ void att_sec_A(const Frame& F, const float* diff_qk_g, const float* diff_lambda, const float* diff_out_g, unsigned char* ws, const int* positions, int layer) {
    int tid_ = threadIdx.x; asm volatile("" : "+v"(tid_)); const int lane = tid_ & 63, r32 = lane & 31;
    LAS unsigned char* lds = F.lds + RING_OFF;
    const float* lp = diff_lambda;
    const float s1 = wave_sum(lp[lane] * lp[64 + lane]), s2 = wave_sum(lp[128 + lane] * lp[192 + lane]);
    const float li = lam_init_of(layer);
    const float lam = __expf(s1) - __expf(s2) + li;
    const float osc = 1.0f - li;
    float gq = fabsf(diff_qk_g[lane]), gk = fabsf(diff_qk_g[64 + lane]);
    gq = xor_max<1>(gq); gq = xor_max<2>(gq); gq = xor_max<4>(gq); gq = xor_max<8>(gq); gq = xor_max<16>(gq); gq = xor_max<32>(gq);
    gk = xor_max<1>(gk); gk = xor_max<2>(gk); gk = xor_max<4>(gk); gk = xor_max<8>(gk); gk = xor_max<16>(gk); gk = xor_max<32>(gk);
    const float reach = 2.0f * (8.0f * gq * gk * 1.01f) + 30.0f;
    const float* tmm = (const float*)(ws + WS_TMM);
    constexpr int NU = NB * 16 * 4; const int per = (NU + F.G - 1) / F.G;
    for (int u = F.vcu * per; u < (F.vcu + 1) * per && u < NU; ++u) {
        const int h = u & 3, bq = u >> 2, b = bq >> 4, qb = bq & 15;
        const size_t rb = (size_t)b * SEQ;
        const float slope = exp2f(-2.0f * (float)(h + 1));
        unsigned long long tmask;
        { const float* tq = tmm + (size_t)(b * 64 + qb * 4) * 2;
          const float qlo = fminf(fminf(tq[0], tq[2]), fminf(tq[4], tq[6])), qhi = fmaxf(fmaxf(tq[1], tq[3]), fmaxf(tq[5], tq[7]));
          const float klo = tmm[(size_t)(b * 64 + lane) * 2], khi = tmm[(size_t)(b * 64 + lane) * 2 + 1];
          const float gap = fmaxf(fmaxf(klo - qhi, qlo - khi), 0.f);
          tmask = __ballot(gap * slope <= reach); }
        att::Args A;
        A.pq = 512; A.pk = 512; A.pv = 512; A.pos = positions + rb; A.slope2 = slope * LOG2E; A.sink2 = 0.f;
        A.V = (const bf16*)(ws + WS_VA) + rb * 512 + h * 128;
        LAS unsigned* stash = (LAS unsigned*)(lds + ATT_STASH_OFF) + F.wave * 2048 + lane;
        {
            A.Q = (const bf16*)(ws + WS_QA) + rb * 512 + h * 128; A.K = (const bf16*)(ws + WS_KA) + rb * 512 + h * 64;
            float r0[1][4][16];
            att::ATT_CORE_A<64, 128, 1, 1, false, false, STAG_A>(A, qb * 256, tmask, lds, r0);
#pragma unroll
            for (int d = 0; d < 4; ++d)
#pragma unroll
                for (int r = 0; r < 8; ++r) stash[(d * 8 + r) * 64] = att::cvtpk(r0[0][d][2 * r], r0[0][d][2 * r + 1]);
        }
        float res[1][4][16];
        A.Q = (const bf16*)(ws + WS_QA) + rb * 512 + h * 128 + 64; A.K = (const bf16*)(ws + WS_KA) + rb * 512 + (4 + h) * 64;
        att::ATT_CORE_A<64, 128, 1, 1, false, false, STAG_A>(A, qb * 256, tmask, lds, res);
        float gcol[4];
#pragma unroll
        for (int d = 0; d < 4; ++d) gcol[d] = diff_out_g[d * 32 + r32] * osc;
#pragma unroll
        for (int r = 0; r < 16; ++r) {
            float s = 0.f;
#pragma unroll
            for (int d = 0; d < 4; ++d) { const unsigned w = stash[(d * 8 + (r >> 1)) * 64]; const float a0 = (r & 1) ? bfhi(w) : bflo(w); const float v = a0 - lam * res[0][d][r]; res[0][d][r] = v; s += v * v; }
            s = xor_add<1>(s); s = xor_add<2>(s); s = xor_add<4>(s); s = xor_add<8>(s); s = xor_add<16>(s);
            const float rs = 1.0f / sqrtf(s * (1.0f / 128) + EPS);
#pragma unroll
            for (int d = 0; d < 4; ++d) res[0][d][r] *= rs * gcol[d];
        }
        att::store_rows<4>(res[0], (bf16*)(ws + (DRY ? WS_OB : WS_QA)) + rb * 512 + h * 128, 512, qb * 256 + F.wave * 32, lane);
    }
}
template <bool DRY> __device__ __forceinline__ void att_sec_C(const Frame& F, const float* swa_sink, unsigned char* ws) {
    int tid_ = threadIdx.x; asm volatile("" : "+v"(tid_)); const int lane = tid_ & 63;
    LAS unsigned char* lds = F.lds + RING_OFF;
    constexpr int NU = NB * 8 * 8; const int per = (NU + F.G - 1) / F.G;
    for (int u = F.vcu * per; u < (F.vcu + 1) * per && u < NU; ++u) {
        const int b = u >> 6, hh = (u >> 3) & 7, qb = u & 7, g = hh >> 2;
        const size_t rb = (size_t)b * SEQ;
        att::Args A;
        A.Q = (const bf16*)(ws + WS_QC) + rb * 512 + hh * 64; A.pq = 512;
        A.K = (const bf16*)(ws + WS_CQKC) + rb * 512 + 384 + g * 64; A.pk = 512;
        A.V = (const bf16*)(ws + WS_VCKR) + rb * 256 + g * 64; A.pv = 256;
        A.pos = nullptr; A.slope2 = exp2f(-(float)(hh + 1)) * LOG2E; A.sink2 = swa_sink[hh] * LOG2E;
        const int q0 = qb * 512; const int k_lo = q0 - 128 < 0 ? 0 : q0 - 128, k_hi = q0 + 512 + 128 > SEQ ? SEQ : q0 + 512 + 128;
        const int tl = k_lo / 64, th = k_hi / 64;
        const unsigned long long tmask = (th >= 64 ? ~0ull : ((1ull << th) - 1ull)) & ~((1ull << tl) - 1ull);
        float res[2][2][16];
        att::ATT_CORE<64, 64, 2, 2, true>(A, q0, tmask, lds, res);
        bf16* O = (bf16*)(ws + (DRY ? WS_OB : WS_QC)) + rb * 512 + hh * 64;
        att::store_rows<2>(res[0], O, 512, q0 + F.wave * 64, lane); att::store_rows<2>(res[1], O, 512, q0 + F.wave * 64 + 32, lane);
    }
}
template <bool DRY> __device__ __forceinline__ void att_sec_B(const Frame& F, unsigned char* ws, int layer, const int* positions, const float* mla_qk_g) {
    int tid_ = threadIdx.x; asm volatile("" : "+v"(tid_)); const int tid = tid_, lane = tid & 63;
    LAS unsigned char* lds = F.lds + RING_OFF;
    constexpr int NU = NB * 8 * 8;
    unsigned* qbase = (unsigned*)(ws + WS_CTL) + 65536 + (layer * 2 + (DRY ? 1 : 0)) * 8 * 64;
    LAS int* nxt = (LAS int*)(F.lds + ATT_NXT_OFF);
    const int ngrp = 8, per_grp = NU / 8, myq = (F.vcu * 8) / F.G;
    int qi = 0;
    for (;;) {
        if (tid == 0) { int u_ = -1;
            while (qi < ngrp) { const int q = (myq + qi) % ngrp; const unsigned v = __hip_atomic_fetch_add(qbase + q * 64, 1u, __ATOMIC_RELAXED, __HIP_MEMORY_SCOPE_AGENT);
                if (v < (unsigned)per_grp) { u_ = q * per_grp + (int)v; break; } ++qi; }
            nxt[0] = u_; nxt[1] = qi; }
        __syncthreads();
        const int u = __builtin_amdgcn_readfirstlane(nxt[0]); qi = __builtin_amdgcn_readfirstlane(nxt[1]);
        __syncthreads();
        if (u < 0) break;
        const int b = u >> 6, h = (u >> 3) & 7, qb = u & 7;
        const size_t rb = (size_t)b * SEQ;
        att::Args A;
        A.Q = (const bf16*)(ws + WS_QB) + rb * 768 + h * 96; A.pq = 768;
        A.K = (const bf16*)(ws + WS_KB) + rb * 768 + h * 96; A.pk = 768;
        A.V = (const bf16*)(ws + WS_KVR) + rb * 1024 + 512 + h * 64; A.pv = 1024;
        A.pos = positions + rb; A.qg = mla_qk_g; A.slope2 = 0.f; A.sink2 = 0.f;
        float res[2][2][16];
        att::ATT_CORE<96, 64, 0, 2, true, true, STAG_B>(A, qb * 512, ~0ull, lds, res);
        bf16* O = (bf16*)(ws + WS_OB) + rb * 512 + h * 64;
        att::store_rows<2>(res[0], O, 512, qb * 512 + F.wave * 64, lane); att::store_rows<2>(res[1], O, 512, qb * 512 + F.wave * 64 + 32, lane);
    }
}
__device__ __forceinline__ void p_attention(const Frame& F, const float* diff_qk_g, const float* diff_lambda, const float* diff_out_g, const float* swa_sink, unsigned char* ws, const int* positions, int layer, const float* mla_qk_g) {
#if defined(PROBE_SEC_A)
    att_sec_A<true>(F, diff_qk_g, diff_lambda, diff_out_g, ws, positions, layer);
#elif defined(PROBE_SEC_B)
    att_sec_B<true>(F, ws, layer, positions, mla_qk_g);
#elif defined(PROBE_SEC_C)
    att_sec_C<true>(F, swa_sink, ws);
#endif
#ifndef SKIP_A
    att_sec_A<false>(F, diff_qk_g, diff_lambda, diff_out_g, ws, positions, layer);
#endif
#ifndef SKIP_C
    att_sec_C<false>(F, swa_sink, ws);
#endif
#ifndef SKIP_B
    att_sec_B<false>(F, ws, layer, positions, mla_qk_g);
#endif
}

#ifdef NAIVE_ATTN
template <int DQK, int DV, int MODE>
__device__ __forceinline__ void naive_row(const bf16* Q, const bf16* K, int pk, const bf16* V, int pv, const int* pos, int t, float slope2, float sink2, int lane, float (&out)[DV / 64]) {
    float m = -1e30f, l = 0.f, acc[DV];
#pragma unroll
    for (int d = 0; d < DV; ++d) acc[d] = 0.f;
    if (MODE == 2 && lane == 0) { m = sink2; l = 1.f; }
    const float pqf = MODE == 1 ? (float)pos[t] : (float)t;
    int k_lo = 0, k_hi = SEQ;
    if (MODE == 2) { k_lo = t - 128 < 0 ? 0 : t - 128; k_hi = t + 129 > SEQ ? SEQ : t + 129; }
    for (int k = k_lo + lane; k < k_hi; k += 64) {
        const bf16* kr = K + (size_t)k * pk; float s = 0.f;
#pragma unroll
        for (int d = 0; d < DQK; d += 2) { const unsigned w = *(const unsigned*)(kr + d); const unsigned qw = *(const volatile unsigned*)(Q + d); s = fmaf(bflo(qw), bflo(w), s); s = fmaf(bfhi(qw), bfhi(w), s); }
        if (MODE == 1) s -= slope2 * fabsf(pqf - (float)pos[k]);
        if (MODE == 2) s -= slope2 * fabsf(pqf - (float)k);
        const float mn = fmaxf(m, s), a = exp2f(m - mn), p = exp2f(s - mn);
        l = l * a + p; m = mn;
        const bf16* vr = V + (size_t)k * pv;
#pragma unroll
        for (int d = 0; d < DV; d += 2) { const unsigned w = *(const unsigned*)(vr + d); acc[d] = fmaf(p, bflo(w), acc[d] * a); acc[d + 1] = fmaf(p, bfhi(w), acc[d + 1] * a); }
    }
    float M = m;
#pragma unroll
    for (int o = 1; o < 64; o <<= 1) M = fmaxf(M, __shfl_xor(M, o));
    const float sc = exp2f(m - M);
    const float L = wave_sum(l * sc);
#pragma unroll
    for (int d = 0; d < DV; ++d) { const float v = wave_sum(acc[d] * sc) / L; if ((d & 63) == lane) out[d >> 6] = v; }
}
__device__ __forceinline__ void p_attention_naive(int vcu, int wave, int G, const float* diff_lambda, const float* diff_out_g, const float* swa_sink, unsigned char* ws, const int* positions, int layer) {
    int tid_ = threadIdx.x; asm volatile("" : "+v"(tid_)); const int lane = tid_ & 63;
    const int gw = vcu * NWAVES + wave, NGW = G * NWAVES;
    const float* lp = diff_lambda;
    const float s1 = wave_sum(lp[lane] * lp[64 + lane]), s2 = wave_sum(lp[128 + lane] * lp[192 + lane]);
    const float li = layer == 0 ? 0.2f : 0.35550906759096184f;
    const float lam = __expf(s1) - __expf(s2) + li, osc = 1.0f - li;
    for (int it = gw; it < T * 4; it += NGW) {
        const int row = it >> 2, h = it & 3, b = row >> 12, t = row & 4095; const size_t rb = (size_t)b * SEQ;
        bf16* Qr = (bf16*)(ws + WS_QA) + (size_t)row * 512 + h * 128;
        float o0[2], o1[2];
        naive_row<64, 128, 1>(Qr, (const bf16*)(ws + WS_KA) + rb * 512 + h * 64, 512, (const bf16*)(ws + WS_VA) + rb * 512 + h * 128, 512, positions + rb, t, exp2f(-2.0f * (float)(h + 1)) * LOG2E, 0.f, lane, o0);
        naive_row<64, 128, 1>(Qr + 64, (const bf16*)(ws + WS_KA) + rb * 512 + (4 + h) * 64, 512, (const bf16*)(ws + WS_VA) + rb * 512 + h * 128, 512, positions + rb, t, exp2f(-2.0f * (float)(h + 1)) * LOG2E, 0.f, lane, o1);
        const float v0 = o0[0] - lam * o1[0], v1 = o0[1] - lam * o1[1];
        const float rs = 1.0f / sqrtf(wave_sum(v0 * v0 + v1 * v1) * (1.0f / 128) + EPS);
        Qr[lane] = (bf16)(pk2(v0 * rs * diff_out_g[lane] * osc, 0.f) & 0xffffu); Qr[64 + lane] = (bf16)(pk2(v1 * rs * diff_out_g[64 + lane] * osc, 0.f) & 0xffffu);
    }
    for (int it = gw; it < T * 8; it += NGW) {
        const int row = it >> 3, h = it & 7, b = row >> 12, t = row & 4095; const size_t rb = (size_t)b * SEQ;
        float o[1];
        naive_row<96, 64, 0>((const bf16*)(ws + WS_QB) + (size_t)row * 768 + h * 96, (const bf16*)(ws + WS_KB) + rb * 768 + h * 96, 768, (const bf16*)(ws + WS_KVR) + rb * 1024 + 512 + h * 64, 1024, nullptr, t, 0.f, 0.f, lane, o);
        ((bf16*)(ws + WS_OB))[(size_t)row * 512 + h * 64 + lane] = (bf16)(pk2(o[0], 0.f) & 0xffffu);
    }
    for (int it = gw; it < T * 8; it += NGW) {
        const int row = it >> 3, hh = it & 7, g = hh >> 2, b = row >> 12, t = row & 4095; const size_t rb = (size_t)b * SEQ;
        bf16* Qr = (bf16*)(ws + WS_QC) + (size_t)row * 512 + hh * 64;
        float o[1];
        naive_row<64, 64, 2>(Qr, (const bf16*)(ws + WS_CQKC) + rb * 512 + 384 + g * 64, 512, (const bf16*)(ws + WS_VCKR) + rb * 256 + g * 64, 256, nullptr, t, exp2f(-(float)(hh + 1)) * LOG2E, swa_sink[hh] * LOG2E, lane, o);
        Qr[lane] = (bf16)(pk2(o[0], 0.f) & 0xffffu);
    }
}
#endif

__device__ __forceinline__ void p_norm2_router(const Frame& F, const bf16* x, const float* g, const float* w_router, unsigned char* h2, float* affT) {
    int tid_ = threadIdx.x; asm volatile("" : "+v"(tid_)); const int tid = tid_, lane = tid & 63;
    LAS bf16x8* wtab = (LAS bf16x8*)(F.lds + RING_OFF);
    LAS float* gtab = (LAS float*)(F.lds + RING_OFF + 32768);
    LAS float* rsl = (LAS float*)(F.lds + RING_OFF + 32768 + 4096) + F.wave * 16;
    for (int i = tid; i < 2048; i += NWAVES * 64) { const int kk = i >> 6, l = i & 63, e = l & 15, k0 = kk * 32 + (l >> 4) * 8;
        v4u w; w.x = pk2(w_router[(k0 + 0) * 16 + e] * g[k0 + 0], w_router[(k0 + 1) * 16 + e] * g[k0 + 1]); w.y = pk2(w_router[(k0 + 2) * 16 + e] * g[k0 + 2], w_router[(k0 + 3) * 16 + e] * g[k0 + 3]);
        w.z = pk2(w_router[(k0 + 4) * 16 + e] * g[k0 + 4], w_router[(k0 + 5) * 16 + e] * g[k0 + 5]); w.w = pk2(w_router[(k0 + 6) * 16 + e] * g[k0 + 6], w_router[(k0 + 7) * 16 + e] * g[k0 + 7]);
        wtab[i] = __builtin_bit_cast(bf16x8, w); }
    for (int i = tid; i < 1024; i += NWAVES * 64) gtab[i] = g[i];
    __syncthreads();
    const int gw = F.vcu * NWAVES + F.wave, NGW = F.G * NWAVES, r = lane & 15, kq = lane >> 4;
    for (int row0 = gw * 16; row0 < T; row0 += NGW * 16) {
        bf16x8 a[32];
        const bf16* xr = x + (size_t)(row0 + r) * DM + kq * 8;
#pragma unroll
        for (int kk = 0; kk < 32; ++kk) a[kk] = *(const bf16x8*)(xr + kk * 32);
        f32x4 acc = {0.f, 0.f, 0.f, 0.f}; float ss = 0.f;
#pragma unroll
        for (int kk = 0; kk < 32; ++kk) {
            acc = __builtin_amdgcn_mfma_f32_16x16x32_bf16(a[kk], wtab[kk * 64 + lane], acc, 0, 0, 0);
            const v4u w = __builtin_bit_cast(v4u, a[kk]);
            ss += (bflo(w.x) * bflo(w.x) + bfhi(w.x) * bfhi(w.x)) + (bflo(w.y) * bflo(w.y) + bfhi(w.y) * bfhi(w.y)) + (bflo(w.z) * bflo(w.z) + bfhi(w.z) * bfhi(w.z)) + (bflo(w.w) * bflo(w.w) + bfhi(w.w) * bfhi(w.w)); __builtin_amdgcn_sched_barrier(0); }
        ss = xor_add<16>(ss); ss = xor_add<32>(ss);
        const float rs = 1.0f / sqrtf(ss * (1.0f / DM) + EPS);
        if (kq == 0) rsl[r] = rs;
        LDS_WAIT(); asm volatile("" ::: "memory");
        const f32x4 rs4 = *(const LAS f32x4*)(rsl + 4 * kq);
        LDS_WAIT(); asm volatile("" ::: "memory");
        float af[4];
#pragma unroll
        for (int v = 0; v < 4; ++v) { const float lg = acc[v] * rs4[v];
            float mx = lg; mx = xor_max<1>(mx); mx = xor_max<2>(mx); mx = xor_max<4>(mx); mx = xor_max<8>(mx);
            const float ex = __expf(lg - mx); float den = ex; den = xor_add<1>(den); den = xor_add<2>(den); den = xor_add<4>(den); den = xor_add<8>(den);
            af[v] = ex / den; }
        { const int b = row0 >> 12, t0 = (row0 & 4095) + 4 * kq;
          *(f32x4*)(affT + ((size_t)(b * NEXP + r) << 12) + t0) = (f32x4){af[0], af[1], af[2], af[3]}; }
        unsigned char* hr = h2 + (size_t)(row0 + r) * DM + kq * 8;
#pragma unroll
        for (int kk = 0; kk < 32; ++kk) {
            v4u w = __builtin_bit_cast(v4u, a[kk]); asm volatile("" : "+v"(w));
            const f32x4 g0 = *(const LAS f32x4*)(gtab + kk * 32 + kq * 8), g1 = *(const LAS f32x4*)(gtab + kk * 32 + kq * 8 + 4);
            const f32x4 y0 = {bflo(w.x) * rs * g0[0], bfhi(w.x) * rs * g0[1], bflo(w.y) * rs * g0[2], bfhi(w.y) * rs * g0[3]}, y1 = {bflo(w.z) * rs * g1[0], bfhi(w.z) * rs * g1[1], bflo(w.w) * rs * g1[2], bfhi(w.w) * rs * g1[3]};
            const pg8::u32x2 o = pg8::pack8_fp8(y0, y1); v2u ov; ov.x = o.x; ov.y = o.y; *(v2u*)(hr + kk * 32) = ov; __builtin_amdgcn_sched_barrier(0); }
    }
    __syncthreads();
}

__device__ __forceinline__ void p_topk_gather(const Frame& F, unsigned char* ws) {
    int tid_ = threadIdx.x; asm volatile("" : "+v"(tid_)); const int tid = tid_, lane = tid & 63; (void)tid; (void)lane;
    LAS unsigned* red = (LAS unsigned*)(F.lds + RING_OFF);
    LAS unsigned* wtot = red + 16;
    LAS int* lidx = (LAS int*)(F.lds + RING_OFF + 256);
    const float* affT = (const float*)(ws + WS_AFFT); int* inv = (int*)(ws + WS_INV); int* idx = (int*)(ws + WS_IDX); float* affsel = (float*)(ws + WS_AFFSEL);
    const unsigned char* h2 = ws + WS_H; unsigned char* xg = ws + WS_XG;
    const int wid = F.wave;
    for (int u = F.vcu; u < NB * NEXP; u += F.G) {
        const int e = u >> 4, b = u & 15;
        const float* src = affT + ((size_t)(b * NEXP + e) << 12) + tid * 8;
        const f32x4 a0 = *(const f32x4*)src, a1 = *(const f32x4*)(src + 4);
        float v[8] = {a0.x, a0.y, a0.z, a0.w, a1.x, a1.y, a1.z, a1.w};
        unsigned long long key[8];
#pragma unroll
        for (int i = 0; i < 8; ++i) key[i] = ((unsigned long long)__float_as_uint(v[i]) << 12) | (unsigned long long)(4095 - (tid * 8 + i));
        unsigned long long Kth = 0ull; unsigned remaining = (unsigned)CAP;
        LAS unsigned* hist = (LAS unsigned*)(F.lds + RING_OFF + 4096);
        LAS unsigned* rres = hist + 256;
#pragma unroll 1
        for (int pass = 0; pass < 6; ++pass) {
            const int bits = pass < 5 ? 8 : 4, shift = pass < 5 ? 36 - 8 * pass : 0; const unsigned bmask = (1u << bits) - 1u;
            if (tid < 256) hist[tid] = 0u;
            __syncthreads();
#pragma unroll
            for (int i = 0; i < 8; ++i) if ((key[i] >> (shift + bits)) == (Kth >> (shift + bits))) __hip_atomic_fetch_add(hist + ((unsigned)(key[i] >> shift) & bmask), 1u, __ATOMIC_RELAXED, __HIP_MEMORY_SCOPE_WORKGROUP);
            __syncthreads();
            if (wid == 0) {
                const int b0 = 255 - 4 * lane; const unsigned c0 = hist[b0], c1 = hist[b0 - 1], c2 = hist[b0 - 2], c3 = hist[b0 - 3];
                unsigned incl = (c0 + c1) + (c2 + c3);
#pragma unroll
                for (int o = 1; o < 64; o <<= 1) { const unsigned y = (unsigned)__builtin_amdgcn_ds_bpermute(((lane - o) & 63) << 2, (int)incl); if (lane >= o) incl += y; }
                unsigned above = incl - ((c0 + c1) + (c2 + c3));
                const unsigned cc[4] = {c0, c1, c2, c3};
#pragma unroll
                for (int j = 0; j < 4; ++j) { if (above < remaining && remaining <= above + cc[j]) { rres[0] = (unsigned)(b0 - j); rres[1] = remaining - above; } above += cc[j]; }
            }
            __syncthreads();
            Kth |= (unsigned long long)rres[0] << shift; remaining = rres[1];
        }
        unsigned cnt = 0;
#pragma unroll
        for (int i = 0; i < 8; ++i) cnt += (key[i] >= Kth) ? 1u : 0u;
        unsigned incl = cnt;
#pragma unroll
        for (int o = 1; o < 64; o <<= 1) { const unsigned y = (unsigned)__builtin_amdgcn_ds_bpermute(((lane - o) & 63) << 2, (int)incl); if (lane >= o) incl += y; }
        __syncthreads();
        if (lane == 63) wtot[wid] = incl;
        __syncthreads();
        unsigned base = 0;
#pragma unroll
        for (int w = 0; w < 8; ++w) base += (w < wid) ? wtot[w] : 0u;
        unsigned slot = base + incl - cnt;
#pragma unroll
        for (int i = 0; i < 8; ++i) {
            const int t = tid * 8 + i; const bool sel = key[i] >= Kth;
            inv[((size_t)(b * SEQ + t) << 4) + e] = sel ? (int)slot : -1;
            if (sel) { if (slot < (unsigned)CAP) { lidx[slot] = t; idx[u * CAP + slot] = t; affsel[u * CAP + slot] = v[i]; } ++slot; }
        }
        __syncthreads();
        __syncthreads();
    }
}

template <bool NORM> __device__ __forceinline__ void p_combine(const Frame& F, unsigned char* ws, const bf16* xin, void* xout, const float* g, bf16* hout, unsigned char* h8out) {
    int tid_ = threadIdx.x; asm volatile("" : "+v"(tid_)); const int tid = tid_, lane = tid & 63; (void)tid; (void)lane;
    const int gw = F.vcu * NWAVES + F.wave, NGW = F.G * NWAVES;
    const int* inv = (const int*)(ws + WS_INV); const unsigned char* Y = ws + WS_XG;
    f32x4 gv[4];
#pragma unroll
    for (int j = 0; j < 4; ++j) { if (NORM) gv[j] = *((const f32x4*)g + lane + 64 * j); else gv[j] = (f32x4){0.f, 0.f, 0.f, 0.f}; }
    for (int row0 = gw * 2; row0 < T; row0 += NGW * 2) {
        int sl[2]; f32x4 v[2][4];
#pragma unroll
        for (int rr = 0; rr < 2; ++rr) { sl[rr] = (lane < 16) ? inv[((size_t)(row0 + rr) << 4) + lane] : -1;
            const v2u* xr = (const v2u*)(xin + (size_t)(row0 + rr) * DM) + lane;
#pragma unroll
            for (int j = 0; j < 4; ++j) { const v2u w = xr[64 * j]; v[rr][j] = (f32x4){bflo(w.x), bfhi(w.x), bflo(w.y), bfhi(w.y)}; } }
        unsigned long long mk0 = __ballot(sl[0] >= 0), mk1 = __ballot(sl[1] >= 0);
        while (mk0 | mk1) {
            unsigned yw[2][4][4]; bool val[2][4];
#pragma unroll
            for (int rr = 0; rr < 2; ++rr)
#pragma unroll
                for (int i = 0; i < 4; ++i) { unsigned long long& mk = rr ? mk1 : mk0; val[rr][i] = mk != 0ull;
                    if (val[rr][i]) { const int e = __builtin_ctzll(mk); mk &= mk - 1; const int s = __builtin_amdgcn_readlane(sl[rr], e); const int b = (row0 + rr) >> 12;
                        const unsigned* yr = (const unsigned*)(Y + ((size_t)(((e << 4) + b) * CAP + s) << 10)) + lane;
#pragma unroll
                        for (int j = 0; j < 4; ++j) yw[rr][i][j] = yr[64 * j]; }
                    else {
#pragma unroll
                        for (int j = 0; j < 4; ++j) yw[rr][i][j] = 0u; } }
#pragma unroll
            for (int rr = 0; rr < 2; ++rr)
#pragma unroll
                for (int i = 0; i < 4; ++i) if (val[rr][i]) {
#pragma unroll
                    for (int j = 0; j < 4; ++j) { const unsigned w = yw[rr][i][j]; const auto lo_ = __builtin_amdgcn_cvt_pk_f32_fp8((int)w, false), hi_ = __builtin_amdgcn_cvt_pk_f32_fp8((int)w, true);
                        v[rr][j].x += lo_[0] * (1.0f / Y_SCALE); v[rr][j].y += lo_[1] * (1.0f / Y_SCALE); v[rr][j].z += hi_[0] * (1.0f / Y_SCALE); v[rr][j].w += hi_[1] * (1.0f / Y_SCALE); } }
        }
#pragma unroll
        for (int rr = 0; rr < 2; ++rr) {
            if (NORM) { v2u* xw = (v2u*)((bf16*)xout + (size_t)(row0 + rr) * DM) + lane;
#pragma unroll
                for (int j = 0; j < 4; ++j) { v2u o; o.x = pk2(v[rr][j].x, v[rr][j].y); o.y = pk2(v[rr][j].z, v[rr][j].w); xw[64 * j] = o; } }
            else { f32x4* xw = (f32x4*)((float*)xout + (size_t)(row0 + rr) * DM) + lane;
#pragma unroll
                for (int j = 0; j < 4; ++j) xw[64 * j] = v[rr][j]; }
            if (NORM) { float s = 0.f;
#pragma unroll
                for (int j = 0; j < 4; ++j) s += (v[rr][j].x * v[rr][j].x + v[rr][j].y * v[rr][j].y) + (v[rr][j].z * v[rr][j].z + v[rr][j].w * v[rr][j].w);
                const float rs = 1.0f / sqrtf(wave_sum(s) * (1.0f / DM) + EPS);
                v2u* o8 = (v2u*)(hout + (size_t)(row0 + rr) * DM) + lane; unsigned* q8 = (unsigned*)(h8out + (size_t)(row0 + rr) * DM) + lane;
#pragma unroll
                for (int j = 0; j < 4; ++j) { const f32x4 y = {v[rr][j].x * rs * gv[j].x, v[rr][j].y * rs * gv[j].y, v[rr][j].z * rs * gv[j].z, v[rr][j].w * rs * gv[j].w};
                    v2u o; o.x = pk2(y.x, y.y); o.y = pk2(y.z, y.w); o8[64 * j] = o; q8[64 * j] = pk4_fp8(y); } } }
    }
}

struct KArgs { const float* in[23]; const int* positions; float* out; unsigned char* ws; int ph_lo, ph_hi; };
static_assert(sizeof(KArgs) == 23 * 8 + 8 + 8 + 8 + 8, "KArgs has no padding");
__device__ __forceinline__ unsigned long long karg_u64(int off) {
    unsigned long long v; auto kp = __builtin_amdgcn_kernarg_segment_ptr();
    asm volatile("s_load_dwordx2 %0, %1, %2\n\ts_waitcnt lgkmcnt(0)" : "=&s"(v) : "s"(kp), "i"(off) : "memory"); return v; }
#define GASP __attribute__((address_space(1)))
#define KIN(k) ((const float*)(const GASP float*)karg_u64(8 * (k)))
#define KPOS() ((const int*)(const GASP int*)karg_u64(184))
#define KOUT() ((float*)(GASP float*)karg_u64(192))
#define KWS() ((unsigned char*)(GASP unsigned char*)karg_u64(200))
__device__ __forceinline__ LayerW layer_w(int layer) {
    LayerW L;
    L.norm_mix_g = KIN(2) + (size_t)layer * 1024; L.w_in = KIN(3) + (size_t)layer * 1024 * IN_COLS; L.diff_qk_g = KIN(4) + layer * 128; L.diff_lambda = KIN(5) + layer * 256;
    L.diff_out_g = KIN(6) + layer * 128; L.mla_cq_g = KIN(7) + layer * 384; L.w_uq = KIN(8) + (size_t)layer * 384 * 768; L.mla_ckv_g = KIN(9) + layer * 256;
    L.w_ukv = KIN(10) + (size_t)layer * 256 * 1024; L.mla_qk_g = KIN(11) + layer * 192; L.swa_qk_g = KIN(12) + layer * 128; L.swa_sink = KIN(13) + layer * 8;
    L.w_ba = KIN(14) + (size_t)layer * 512 * 1024; L.w_bb = KIN(15) + (size_t)layer * 512 * 1024; L.w_bc = KIN(16) + (size_t)layer * 512 * 1024; L.w_o = KIN(17) + (size_t)layer * 1024 * 1024;
    L.norm_ffn_g = KIN(18) + (size_t)layer * 1024; L.w_router = KIN(19) + (size_t)layer * 1024 * 16;
    L.w_eg = KIN(20) + (size_t)layer * 16 * 1024 * 1024; L.w_eu = KIN(21) + (size_t)layer * 16 * 1024 * 1024; L.w_ed = KIN(22) + (size_t)layer * 16 * 1024 * 1024;
    return L;
}


#ifdef DBG_CHECK
__device__ __forceinline__ unsigned hash_u(unsigned x) { x ^= x >> 16; x *= 0x7feb352du; x ^= x >> 15; x *= 0x846ca68bu; x ^= x >> 16; return x; }
__device__ __forceinline__ float bf2f(bf16 v) { return __uint_as_float((unsigned)v << 16); }
__device__ __forceinline__ void chk_report(unsigned* word, float a, float b, int lane) {
    const float err = fabsf(a - b) / (fabsf(b) + 0.1f);
    if (lane == 0) atomicMax(word, __float_as_uint(err));
}
__device__ __forceinline__ const bf16* proj_loc(unsigned char* ws, int row, int col) {
    const int r = win_row(col), pn = r >> 8, c = r & 255;
    if (pn < 10) return (const bf16*)(ws + WS_QA + (size_t)(pn >> 1) * 64 * MiB) + (size_t)row * 512 + (pn & 1) * 256 + c;
    return (const bf16*)(ws + WS_CKV + (size_t)(pn - 10) * 32 * MiB) + (size_t)row * 256 + c;
}
__device__ __forceinline__ float naive_proj(const bf16* h, const float* w_in, int row, int col, int lane) {
    float s = 0.f;
    for (int k = lane; k < 1024; k += 64) s = fmaf(bf2f(h[(size_t)row * 1024 + k]), w_in[(size_t)k * IN_COLS + col], s);
    return wave_sum(s);
}
__device__ __forceinline__ void p_check(int which, int gw, int NGW, int lane, unsigned char* ws, const float* const* dummy, const float* x_in, const float* xout, const LayerW& L, const int* positions) {
    unsigned* word = (unsigned*)(ws + WS_CTL) + 32768 + which * 64;
    const bf16* h = (const bf16*)(ws + WS_H);
    if (which == 0) {
        for (int s = gw; s < 2048; s += NGW) { const int row = hash_u(s * 2 + 1) % T, col = hash_u(s * 2 + 2) % 2976;
            chk_report(word, bf2f(*proj_loc(ws, row, col)), naive_proj(h, L.w_in, row, col, lane), lane); }
    } else if (which == 1) {
        for (int s = gw; s < 1536; s += NGW) { const int row = hash_u(s * 3 + 5) % T, type = s % 6; const unsigned hg = hash_u(s * 3 + 7);
            if (type < 4) { int c0; const float* g; float qs = 1.f;
                if (type == 0) { c0 = (hg % 8) * 64; g = L.diff_qk_g; qs = 0.125f * LOG2E; } else if (type == 1) { c0 = 512 + (hg % 8) * 64; g = L.diff_qk_g + 64; }
                else if (type == 2) { c0 = 2208 + (hg % 8) * 64; g = L.swa_qk_g; qs = 0.125f * LOG2E; } else { c0 = 2720 + (hg % 2) * 64; g = L.swa_qk_g + 64; }
                float v = 0.f; for (int k = 0; k < 1024; ++k) v = fmaf(bf2f(h[(size_t)row * 1024 + k]), L.w_in[(size_t)k * IN_COLS + c0 + lane], v);
                v = bf2f((bf16)(pk2(v, 0.f) & 0xffffu));
                const float rs = 1.0f / sqrtf(wave_sum(v * v) * (1.0f / 64) + EPS);
                chk_report(word, bf2f(*proj_loc(ws, row, c0 + lane)), v * rs * g[lane] * qs, lane);
                const float e2 = fabsf(bf2f(*proj_loc(ws, row, c0 + lane)) - v * rs * g[lane] * qs) / (fabsf(v * rs * g[lane] * qs) + 0.1f); float m = e2;
                for (int o = 1; o < 64; o <<= 1) m = fmaxf(m, __shfl_xor(m, o)); if (lane == 0) atomicMax(word, __float_as_uint(m));
            } else { const int ng = type == 4 ? 6 : 4, cb = type == 4 ? 1536 : 1920; const float* g = type == 4 ? L.mla_cq_g : L.mla_ckv_g;
                float v[6]; float ss = 0.f;
                _Pragma("unroll") for (int q = 0; q < 6; ++q) { float a = 0.f; if (q < ng) { for (int k = 0; k < 1024; ++k) a = fmaf(bf2f(h[(size_t)row * 1024 + k]), L.w_in[(size_t)k * IN_COLS + cb + q * 64 + lane], a); }
                    a = bf2f((bf16)(pk2(a, 0.f) & 0xffffu)); v[q] = a; ss += a * a; }
                const float rs = 1.0f / sqrtf(wave_sum(ss) / (float)(ng * 64) + EPS); float m = 0.f;
                _Pragma("unroll") for (int q = 0; q < 6; ++q) { if (q < ng) { const float want = v[q] * rs * g[q * 64 + lane]; m = fmaxf(m, fabsf(bf2f(*proj_loc(ws, row, cb + q * 64 + lane)) - want) / (fabsf(want) + 0.1f)); } }
                for (int o = 1; o < 64; o <<= 1) m = fmaxf(m, __shfl_xor(m, o)); if (lane == 0) atomicMax(word, __float_as_uint(m));
            } }
    } else if (which == 2) {
        const bf16* CQ = (const bf16*)(ws + WS_CQKC); const bf16* CKVn = (const bf16*)(ws + WS_CKV); const bf16* VCKR = (const bf16*)(ws + WS_VCKR);
        const bf16* QB = (const bf16*)(ws + WS_QB); const bf16* KB = (const bf16*)(ws + WS_KB);
        for (int s = gw; s < 1024; s += NGW) { const int row = hash_u(s * 5 + 11) % T, hd = hash_u(s * 5 + 13) % 8; const bool isq = s & 1;
            float nope = 0.f, rp = 0.f;
            if (isq) { for (int k = 0; k < 384; ++k) { const float a = bf2f(CQ[(size_t)row * 512 + k]); nope = fmaf(a, L.w_uq[(size_t)k * 768 + hd * 96 + lane], nope); rp = fmaf(a, L.w_uq[(size_t)k * 768 + hd * 96 + 64 + (lane & 31)], rp); } }
            else { for (int k = 0; k < 256; ++k) nope = fmaf(bf2f(CKVn[(size_t)row * 256 + k]), L.w_ukv[(size_t)k * 1024 + hd * 128 + lane], nope); rp = bf2f(VCKR[(size_t)row * 256 + 128 + (lane & 31)]); }
            nope = bf2f((bf16)(pk2(nope, 0.f) & 0xffffu)); if (isq) rp = bf2f((bf16)(pk2(rp, 0.f) & 0xffffu));
            const int i = lane & 15; const float ang = (float)positions[row] * (1.0f / powf(10000.0f, (float)i / 16.0f));
            const float cs = cosf(ang), sn = sinf(ang), other = __shfl_xor(rp, 16);
            float ro = (lane & 16) ? (other * sn + rp * cs) : (rp * cs - other * sn); if (lane >= 32) ro = 0.f;
            const float rs = 1.0f / sqrtf(wave_sum(nope * nope + ro * ro) * (1.0f / 96) + EPS);
            const float* g = L.mla_qk_g + (isq ? 0 : 96); const float qs = isq ? 0.10206207261596575f * LOG2E : 1.f;
            const bf16* dst = (isq ? QB : KB) + (size_t)row * 768 + hd * 96;
            const float w1 = nope * rs * g[lane] * qs; float m = fabsf(bf2f(dst[lane]) - w1) / (fabsf(w1) + 0.1f);
            if (lane < 32) { const float w2 = ro * rs * g[64 + lane] * qs; m = fmaxf(m, fabsf(bf2f(dst[64 + lane]) - w2) / (fabsf(w2) + 0.1f)); }
            for (int o = 1; o < 64; o <<= 1) m = fmaxf(m, __shfl_xor(m, o)); if (lane == 0) atomicMax(word, __float_as_uint(m)); }
    } else if (which == 3) {
        for (int s = gw; s < 2048; s += NGW) { const int row = hash_u(s * 2 + 21) % T, col = hash_u(s * 2 + 22) % 3072;
            const float z = naive_proj(h, L.w_in, row, 2976 + col, lane); const float want = 1.0f / (1.0f + __expf(-z));
            const int gi = col >> 10; const bf16* G = (const bf16*)(ws + (gi == 0 ? WS_G0 : (gi == 1 ? WS_G1 : WS_G2)));
            const float got = bf2f(G[(size_t)row * 1024 + (col & 1023)]);
            chk_report(word, got, want, lane);
            if (lane == 0) { atomicAdd(word + 1024 + gi * 64, 1u); if (fabsf(got - want) / (fabsf(want) + 0.1f) > 0.06f) atomicAdd(word + 2048 + gi * 64, 1u); } }
    } else if (which == 4) {
        for (int s = gw; s < 2048; s += NGW) { const int row = hash_u(s * 2 + 31) % T, c = hash_u(s * 2 + 32) % 1024; float want = 0.f;
            for (int i = 0; i < 3; ++i) { const bf16* O = (const bf16*)(ws + (i == 0 ? WS_QA : (i == 1 ? WS_OB : WS_QC))); const float* Wb = i == 0 ? L.w_ba : (i == 1 ? L.w_bb : L.w_bc);
                const bf16* G = (const bf16*)(ws + (i == 0 ? WS_G0 : (i == 1 ? WS_G1 : WS_G2)));
                float a = 0.f; for (int k = lane; k < 512; k += 64) a = fmaf(bf2f(O[(size_t)row * 512 + k]), Wb[(size_t)k * 1024 + c], a);
                want += bf2f(G[(size_t)row * 1024 + c]) * wave_sum(a); }
            chk_report(word, bf2f(h[(size_t)row * 1024 + c]), want, lane); }
    } else if (which == 6) {
        for (int s = gw; s < 2048; s += NGW) { const int row = hash_u(s * 2 + 51) % T; float ss = 0.f;
            for (int k = lane; k < 1024; k += 64) { const float v = x_in[(size_t)row * 1024 + k]; ss += v * v; }
            const float rs = 1.0f / sqrtf(wave_sum(ss) * (1.0f / 1024) + EPS); float m = 0.f;
            for (int k = lane; k < 1024; k += 64) { const float want = x_in[(size_t)row * 1024 + k] * rs * L.norm_mix_g[k]; m = fmaxf(m, fabsf(bf2f(h[(size_t)row * 1024 + k]) - want) / (fabsf(want) + 0.1f)); }
            for (int o = 1; o < 64; o <<= 1) m = fmaxf(m, __shfl_xor(m, o)); if (lane == 0) atomicMax(word, __float_as_uint(m)); }
    } else if (which == 7 || which == 8) {
        const bf16* wt = (const bf16*)(ws + WS_WIN);
        for (int s = gw; s < 4096; s += NGW) { const int col = which == 7 ? 2976 + (int)(hash_u(s * 2 + 61) % 3072) : (int)(hash_u(s * 2 + 61) % 2976); const int r = win_row(col); float m = 0.f;
            for (int k = lane; k < 1024; k += 64) { const float want = L.w_in[(size_t)k * IN_COLS + col]; m = fmaxf(m, fabsf(bf2f(wt[(size_t)r * 1024 + k]) - want) / (fabsf(want) + 0.01f)); }
            for (int o = 1; o < 64; o <<= 1) m = fmaxf(m, __shfl_xor(m, o)); if (lane == 0) atomicMax(word, __float_as_uint(m)); }
    } else if (which == 9) {
        const bf16* wt = (const bf16*)(ws + WS_WIN);
        for (int s = gw; s < 2048; s += NGW) { const int row = hash_u(s * 2 + 21) % T, col = hash_u(s * 2 + 22) % 3072; float a = 0.f;
            for (int k = lane; k < 1024; k += 64) a = fmaf(bf2f(h[(size_t)row * 1024 + k]), bf2f(wt[(size_t)(3072 + col) * 1024 + k]), a);
            const float z = wave_sum(a), want = 1.0f / (1.0f + __expf(-z));
            const int gi = col >> 10; const bf16* G = (const bf16*)(ws + (gi == 0 ? WS_G0 : (gi == 1 ? WS_G1 : WS_G2)));
            chk_report(word, bf2f(G[(size_t)row * 1024 + (col & 1023)]), want, lane); }
    } else {
        for (int s = gw; s < 2048; s += NGW) { const int row = hash_u(s * 2 + 41) % T, c = hash_u(s * 2 + 42) % 1024;
            float a = 0.f; for (int k = lane; k < 1024; k += 64) a = fmaf(bf2f(h[(size_t)row * 1024 + k]), L.w_o[(size_t)k * 1024 + c], a);
            const float d = wave_sum(a), got = xout[(size_t)row * 1024 + c] - x_in[(size_t)row * 1024 + c];
            chk_report(word, got, d, lane); }
    }
}
__device__ __forceinline__ void p_check_emit(int vcu, int G, unsigned char* ws, float* out) {
    int t_ = threadIdx.x; asm volatile("" : "+v"(t_));
    const unsigned* words = (const unsigned*)(ws + WS_CTL) + 32768;
    int code = 0;
#ifdef DBG_CHECK2
    { const int map_[5] = {6, 7, 8, 9, 3};
      if (__uint_as_float(words[6 * 64]) > 0.06f) code |= 1; if (__uint_as_float(words[7 * 64]) > 0.06f) code |= 2; if (__uint_as_float(words[8 * 64]) > 0.06f) code |= 4;
      if (__uint_as_float(words[9 * 64]) > 0.06f) code |= 8; if (__uint_as_float(words[3 * 64]) > 0.06f) code |= 16; (void)map_; }
#elif defined(DBG_GATEFRAC)
    { const unsigned* w3 = words + 3 * 64;
      for (int gi = 0; gi < 3; ++gi) { const unsigned n = w3[1024 + gi * 64], bad = w3[2048 + gi * 64]; const int f = bad == 0 ? 0 : (bad * 10 < n ? 1 : (bad * 2 < n ? 2 : 3)); code |= f << (2 * gi); } }
#else
    for (int i = 0; i < 6; ++i) if (__uint_as_float(words[i * 64]) > 0.06f) code |= 1 << i;
#endif
    for (size_t i = (size_t)vcu * 512 + t_; i < (size_t)T * DM; i += (size_t)G * 512) out[i] = 0.f;
    __syncthreads();
    if (vcu == 0 && t_ == 0) out[0] = exp2f((float)(code + 20));
}
#endif

__global__ void __launch_bounds__(NWAVES * 64, 2) fwd_kernel(KArgs args) {
    extern __shared__ __attribute__((aligned(16))) unsigned char lds_raw[];
    Frame F;
    F.lds = (LAS unsigned char*)lds_raw;
    F.wave = __builtin_amdgcn_readfirstlane((int)threadIdx.x >> 6);
    F.G = gridDim.x; { const int bx = blockIdx.x; F.vcu = (F.G % 8 == 0) ? (bx % 8) * (F.G / 8) + bx / 8 : bx; }
    volatile LAS unsigned* MISC = (volatile LAS unsigned*)(F.lds + MISC_OFF);
    for (int u = threadIdx.x; u < (LDS_BYTES - LDSCTL_OFF) / 4; u += NWAVES * 64) ((LAS unsigned*)(F.lds + LDSCTL_OFF))[u] = 0u;
    __syncthreads();
#define GRID_BARRIER() do { XcdBarrier b_; b_.bar = (unsigned*)(KWS() + WS_CTL) + 4096; b_.x = xb_xcc_id(); b_.st = (volatile LAS unsigned*)(F.lds + MISC_OFF) + 8; xcd_barrier(b_); } while (0)
#if !MK_MULTI
    (void)xcd_barrier_post((unsigned*)(KWS() + WS_CTL) + 4096, MISC + 8);
#endif
    const int lo = args.ph_lo, hi = args.ph_hi;
#ifdef DBG_CHECK
    if (lo >= 2000) { p_check_emit(F.vcu, F.G, KWS(), KOUT()); return; }
#ifdef DBG_CHECK2
    if (lo >= 1000 && lo < 2000) { const int ph = lo - 1000;
        for (int which = 6; which <= 9; ++which) { const bool run = (ph == 5 && which <= 8) || (ph == 6 && which == 9);
            if (run) { int t_ = threadIdx.x; asm volatile("" : "+v"(t_)); unsigned char* ws = KWS(); const LayerW L = layer_w(0);
                p_check(which, F.vcu * NWAVES + F.wave, F.G * NWAVES, t_ & 63, ws, nullptr, KIN(0), KOUT(), L, KPOS()); } }
    }
#endif
    if (lo >= 1000) { const int ph = lo - 1000; const int which = ph == 1 ? 0 : ph == 2 ? 1 : ph == 4 ? 2 : ph == 6 ? 3 : ph == 9 ? 4 : ph == 10 ? 5 : -1;
        if (which >= 0) { int t_ = threadIdx.x; asm volatile("" : "+v"(t_)); unsigned char* ws = KWS(); const LayerW L = layer_w(0);
            p_check(which, F.vcu * NWAVES + F.wave, F.G * NWAVES, t_ & 63, ws, nullptr, KIN(0), KOUT(), L, KPOS()); }
        return; }
#endif
#ifdef ONLY_PHASE
#define IN(k) ((((k) % PH_PER_LAYER) == ONLY_PHASE) && lo <= (k) && (k) < hi)
#else
#ifdef SKIP_FFN
#define IN(k) ((((k) % PH_PER_LAYER) < 11) && lo <= (k) && (k) < hi)
#else
#define IN(k) (lo <= (k) && (k) < hi)
#endif
#endif
#if MK_MULTI
#define SEAM(k) do { } while (0)
#else
#define SEAM(k) do { if (IN((k) + 1)) { GRID_BARRIER(); } } while (0)
#endif
#define CHK(ph, which) do { } while (0)
#ifndef ST_MERGE
#define ST_MERGE 1400
#endif
#ifndef ST_WO
#define ST_WO 2000
#endif
#ifdef STAGGER_ON
#define STAGGER(ticks) do { if (F.vcu & 1) { const unsigned long long t0_ = __builtin_amdgcn_s_memrealtime(); while (__builtin_amdgcn_s_memrealtime() - t0_ < (unsigned long long)(ticks)) __builtin_amdgcn_s_sleep(8); } } while (0)
#else
#define STAGGER(ticks) do { } while (0)
#endif
#define GEMM_RUN(EPI, g, E) do { pg8::StaticOrder S_; S_.init((g).M, (g).N, F.G, (int)blockIdx.x); pg8::gemm_phase<EPI, pg8::StaticOrder, true, true>(F.lds + RING_OFF, g, S_, E); } while (0)
#define GEMM_RUN_F8(EPI, g, E) do { pg8::StaticOrder S_; S_.init((g).M, (g).N, F.G, (int)blockIdx.x); pg8::gemm_phase<EPI, pg8::StaticOrder, true, true, true>(F.lds + RING_OFF, g, S_, E); } while (0)
#ifdef DUP_SMALL
#define GEMM_RUN3(EPI, g, E) do { GEMM_RUN(EPI, g, E); GRID_BARRIER(); GEMM_RUN(EPI, g, E); } while (0)
#else
#define GEMM_RUN3(EPI, g, E) GEMM_RUN(EPI, g, E)
#endif
#ifdef DUP_GEMM_PLAIN
#define GEMM_RUN2(EPI, g, E) do { { pg8::EpiPlain EN_{(bf16*)(KWS() + WS_QB), 3072}; GEMM_RUN(pg8::EpiPlain, g, EN_); } GRID_BARRIER(); GEMM_RUN(EPI, g, E); } while (0)
#elif defined(DUP_GEMM_NULL)
#define GEMM_RUN2(EPI, g, E) do { { pg8::EpiNull EN_; GEMM_RUN(pg8::EpiNull, g, EN_); } GRID_BARRIER(); GEMM_RUN(EPI, g, E); } while (0)
#elif defined(DUP_GEMM)
#define GEMM_RUN2(EPI, g, E) do { GEMM_RUN(EPI, g, E); GRID_BARRIER(); GEMM_RUN(EPI, g, E); } while (0)
#else
#define GEMM_RUN2(EPI, g, E) GEMM_RUN(EPI, g, E)
#endif
    for (int layer = 0; layer < DEPTH; ++layer) {
        const int P = layer * PH_PER_LAYER;
#ifdef DUP_P0
        if (IN(P + 0)) { unsigned char* ws = KWS(); const LayerW L = layer_w(layer); p_convert(F, L, ws); p_tile_minmax(F, ws, KPOS()); if (layer == 0) p_norm1(F, KIN(0), L.norm_mix_g, (bf16*)(ws + WS_H), (unsigned char*)KOUT() + H8_OUT_OFF);     GRID_BARRIER(); }
#endif
        if (IN(P + 0)) { unsigned char* ws = KWS(); const LayerW L = layer_w(layer); p_convert(F, L, ws); p_tile_minmax(F, ws, KPOS()); if (layer == 0) p_norm1(F, KIN(0), L.norm_mix_g, (bf16*)(ws + WS_H), (unsigned char*)KOUT() + H8_OUT_OFF);     SEAM(P + 0); }
        if (IN(P + 1)) {
            unsigned char* ws = KWS();
            pg8::Gemm g{(const bf16*)(ws + WS_H), (const bf16*)(ws + WS_WIN), T, 3072, 1024, 1024, 1, 1, 0};
            pg8::EpiRouteNorm E{(bf16*)(ws + WS_QA), (size_t)(64 * MiB / 2), (bf16*)(ws + WS_CKV), (size_t)(32 * MiB / 2), (const float*)(ws + WS_GT), (float*)(ws + WS_SSP), EPS, KPOS(), KIN(11) + layer * 192 + 160};
            GEMM_RUN2(pg8::EpiRouteNorm, g, E); SEAM(P + 1); }
        CHK(1, 0);
#ifdef DUP_BAR
        if (IN(P + 2)) { for (int i_ = 0; i_ < 10; ++i_) GRID_BARRIER(); }
#endif
        CHK(2, 1);
        if (IN(P + 3)) {
            unsigned char* ws = KWS();
            pg8::Gemm g{(const bf16*)(ws + WS_CQKC), (const bf16*)(ws + WS_WUQ), T, 768, 384, 512, 1, 1, 0};
            pg8::EpiPlainRS E{(bf16*)(ws + WS_QB), 768, (const float*)(ws + WS_SSP), 0, 6, 1.0f / 384, EPS}; GEMM_RUN3(pg8::EpiPlainRS, g, E); }
        if (IN(P + 3)) {
            unsigned char* ws = KWS();
            pg8::Gemm g{(const bf16*)(ws + WS_CKV), (const bf16*)(ws + WS_WUKV), T, 1024, 256, 256, 1, 1, 0};
            pg8::EpiKV E{(bf16*)(ws + WS_KB), (bf16*)(ws + WS_KVR), (const bf16*)(ws + WS_VCKR) + 128, (const float*)(ws + WS_SSP), KIN(11) + layer * 192 + 96, EPS}; GEMM_RUN(pg8::EpiKV, g, E); SEAM(P + 4); }
        CHK(4, 2);
#ifdef NAIVE_ATTN
        if (IN(P + 5)) { unsigned char* ws = KWS(); p_attention_naive(F.vcu, F.wave, F.G, KIN(5) + layer * 256, KIN(6) + layer * 128, KIN(13) + layer * 8, ws, KPOS(), layer); SEAM(P + 5); }
#else
        if (IN(P + 5)) { unsigned char* ws = KWS(); p_attention(F, KIN(4) + layer * 128, KIN(5) + layer * 256, KIN(6) + layer * 128, KIN(13) + layer * 8, ws, KPOS(), layer, KIN(11) + layer * 192); SEAM(P + 5); }
#endif
        if (IN(P + 6)) {
            unsigned char* ws = KWS();
            pg8::Gemm g{(const bf16*)((unsigned char*)KOUT() + H8_OUT_OFF), (const bf16*)(ws + WS_WG8), T, 3072, 512, 512, 1, 1, 0, 0, 0};
            pg8::EpiGate E{ws + WS_G0, (size_t)(64 * MiB), (size_t)0, -LOG2E / W8_SCALE};
            GEMM_RUN_F8(pg8::EpiGate, g, E); SEAM(P + 6); }
#define MERGE3_RUN() do { unsigned char* ws = KWS(); \
            pg8::Gemm g{(const bf16*)(ws + WS_QA), (const bf16*)(ws + WS_WBA), 3 * T, 1024, 512, 512, 256, 3, (size_t)(1 * MiB), 0, 0, (size_t)(WS_OB - WS_QA - 128 * MiB)}; \
            pg8::EpiMerge3 E{ws + WS_G0, (bf16*)(ws + WS_H)}; \
            pg8::MergeOrder S_; S_.S.init(T, 1024, F.G, (int)blockIdx.x); pg8::gemm_phase<pg8::EpiMerge3, pg8::MergeOrder, true, true>(F.lds + RING_OFF, g, S_, E); } while (0)
        if (IN(P + 7)) {
            MERGE3_RUN(); SEAM(P + 9); }
#ifdef DUP_MERGE
        if (IN(P + 7)) { GRID_BARRIER(); MERGE3_RUN(); GRID_BARRIER(); }
#endif
        CHK(9, 4);
        if (IN(P + 10)) {
            unsigned char* ws = KWS(); float* xo = KOUT();
            pg8::Gemm g{(const bf16*)(ws + WS_H), (const bf16*)(ws + WS_WO), T, 1024, 1024, 1024, 1, 1, 0};
            pg8::EpiResid E{layer == 0 ? (const void*)KIN(0) : (const void*)xo, layer != 0, (bf16*)(ws + WS_XB)}; STAGGER(ST_WO); GEMM_RUN(pg8::EpiResid, g, E); SEAM(P + 10); }
        CHK(10, 5);
#ifdef DUP_P11
        if (IN(P + 11)) { unsigned char* ws = KWS(); p_norm2_router(F, (const bf16*)(ws + WS_XB), KIN(18) + (size_t)layer * 1024, KIN(19) + (size_t)layer * 1024 * 16, ws + WS_H, (float*)(ws + WS_AFFT)); GRID_BARRIER(); }
#endif
        if (IN(P + 11)) { unsigned char* ws = KWS(); p_norm2_router(F, (const bf16*)(ws + WS_XB), KIN(18) + (size_t)layer * 1024, KIN(19) + (size_t)layer * 1024 * 16, ws + WS_H, (float*)(ws + WS_AFFT)); SEAM(P + 11); }
#ifdef DUP_P12
        if (IN(P + 12)) { unsigned char* ws = KWS(); p_topk_gather(F, ws); GRID_BARRIER(); }
#endif
        if (IN(P + 12)) { unsigned char* ws = KWS(); p_topk_gather(F, ws); SEAM(P + 12); }
        if (IN(P + 13)) {
            unsigned char* ws = KWS();
            pg8::Gemm g{(const bf16*)(ws + WS_H), (const bf16*)(ws + WS_WGU), TE, 2048, 512, 512, 32, 16, (size_t)2048 * 1024, W8_E8M0, ONE_E8M0, (size_t)0, (const int*)(ws + WS_IDX)};
            pg8::EpiSwiglu E{ws + WS_HID, 1.0f / W8_SCALE, HID_SCALE};
            { pg8::StaticOrder S_; S_.init(g.M, g.N, F.G, (int)blockIdx.x); pg8::gemm_phase<pg8::EpiSwiglu, pg8::StaticOrder, true, true, true, true>(F.lds + RING_OFF, g, S_, E); }
            SEAM(P + 13); }
        if (IN(P + 14)) {
            unsigned char* ws = KWS();
            pg8::Gemm g{(const bf16*)(ws + WS_HID), (const bf16*)(ws + WS_WD), TE, 1024, 512, 512, 32, 16, (size_t)1024 * 1024, W8_E8M0, HID_E8M0};
            pg8::EpiDown E{ws + WS_XG, (const float*)(ws + WS_AFFSEL), Y_SCALE / (W8_SCALE * HID_SCALE)}; GEMM_RUN_F8(pg8::EpiDown, g, E); SEAM(P + 14); }
#ifdef DUP_P15
        if (IN(P + 15)) { unsigned char* ws = KWS(); if (layer + 1 < DEPTH) p_combine<true>(F, ws, (const bf16*)(ws + WS_XB), KOUT(), KIN(2) + (size_t)(layer + 1) * 1024, (bf16*)(ws + WS_H), (unsigned char*)KOUT() + H8_OUT_OFF); else p_combine<false>(F, ws, (const bf16*)(ws + WS_XB), KOUT(), nullptr, nullptr, nullptr); GRID_BARRIER(); }
#endif
        if (IN(P + 15)) { unsigned char* ws = KWS(); if (layer + 1 < DEPTH) p_combine<true>(F, ws, (const bf16*)(ws + WS_XB), KOUT(), KIN(2) + (size_t)(layer + 1) * 1024, (bf16*)(ws + WS_H), (unsigned char*)KOUT() + H8_OUT_OFF); else p_combine<false>(F, ws, (const bf16*)(ws + WS_XB), KOUT(), nullptr, nullptr, nullptr); SEAM(P + 15); }
    }
#undef IN
#undef SEAM
}

extern "C" void kernel_launch(void* const* d_in, const int* in_sizes, int n_in, void* d_out, int out_size, void* d_ws, size_t ws_size, hipStream_t stream) {
    static int grid = 0;
    if (grid == 0) {
        if (n_in != 23 || in_sizes[0] != T * DM || out_size != T * DM || ws_size < WS_END) { fprintf(stderr, "kernel_launch: shape/workspace mismatch (n_in %d, ws %zu < %zu)\n", n_in, ws_size, (size_t)WS_END); grid = -1; return; }
        int dev = 0, cus = 0, per_cu = 0;
        if (hipGetDevice(&dev) != hipSuccess || hipDeviceGetAttribute(&cus, hipDeviceAttributeMultiprocessorCount, dev) != hipSuccess) { grid = -1; return; }
        if (hipFuncSetAttribute((const void*)fwd_kernel, hipFuncAttributeMaxDynamicSharedMemorySize, LDS_BYTES) != hipSuccess) { fprintf(stderr, "kernel_launch: hipFuncSetAttribute failed\n"); grid = -1; return; }
        if (hipOccupancyMaxActiveBlocksPerMultiprocessor(&per_cu, (const void*)fwd_kernel, NWAVES * 64, LDS_BYTES) != hipSuccess || per_cu < 1) { fprintf(stderr, "kernel_launch: occupancy query reports %d\n", per_cu); }
        (void)hipGetLastError();
        grid = cus;
    }
    if (grid < 0) return;
    if (hipMemsetAsync((char*)d_ws + WS_CTL, 0, CTL_ZERO_BYTES, stream) != hipSuccess) return;
    KArgs a{};
    for (int i = 0; i < 23; ++i) a.in[i] = (const float*)d_in[i];
    a.positions = (const int*)d_in[1]; a.out = (float*)d_out; a.ws = (unsigned char*)d_ws;
#if MK_MULTI
#ifdef DBG_CHECK
    for (int p = 0; p <= 10; ++p) { a.ph_lo = p; a.ph_hi = p + 1; hipLaunchKernelGGL(fwd_kernel, dim3(grid), dim3(NWAVES * 64), LDS_BYTES, stream, a);
        a.ph_lo = 1000 + p; a.ph_hi = 1001 + p; hipLaunchKernelGGL(fwd_kernel, dim3(grid), dim3(NWAVES * 64), LDS_BYTES, stream, a); }
    a.ph_lo = 2000; a.ph_hi = 2001; hipLaunchKernelGGL(fwd_kernel, dim3(grid), dim3(NWAVES * 64), LDS_BYTES, stream, a);
#else
    for (int p = 0; p < NPHASE; ++p) { a.ph_lo = p; a.ph_hi = p + 1; hipLaunchKernelGGL(fwd_kernel, dim3(grid), dim3(NWAVES * 64), LDS_BYTES, stream, a); }
#endif
#else
    a.ph_lo = 0; a.ph_hi = NPHASE;
    hipLaunchKernelGGL(fwd_kernel, dim3(grid), dim3(NWAVES * 64), LDS_BYTES, stream, a);
#endif
    const hipError_t le = hipPeekAtLastError();
    if (le != hipSuccess) fprintf(stderr, "kernel_launch: launch failed: %s\n", hipGetErrorName(le));
}
```

```cpp
#include <hip/hip_runtime.h>
#include <cstdio>
#include <cstdint>

#ifndef MK_MULTI
#define MK_MULTI 0
#endif

namespace pg8 {
#define PG8_LAS __attribute__((address_space(3)))
typedef unsigned short bf16_t;
typedef short bf16x8 __attribute__((ext_vector_type(8)));
typedef float f32x4 __attribute__((ext_vector_type(4)));
typedef unsigned u32x4 __attribute__((ext_vector_type(4)));
typedef unsigned u32x2 __attribute__((ext_vector_type(2)));
typedef float f32x2 __attribute__((ext_vector_type(2)));
constexpr int BM = 256, BK = 64, HALF = 128, HTB = HALF * BK * 2  , STAGE_BYTES = 8 * HTB, NXCD = 8, WGM = 8;

__host__ __device__ __forceinline__ int lds_byte(int r, int c) { const int st = (r >> 4) * 2 + (c >> 5), rr = r & 15, cc = c & 31, ob = rr * 64 + cc * 2; return st * 1024 + (ob ^ (((ob >> 9) & 1) << 5)); }
__host__ __device__ __forceinline__ void stage_rc(int b, int& R, int& C) { const int st = b / 1024, sb = b % 1024, swz = sb ^ (((sb >> 9) & 1) << 5); R = (st >> 1) * 16 + swz / 64; C = (st & 1) * 32 + (swz % 64) / 2; }
__host__ __device__ __forceinline__ int perm32(int rho) { const int n = rho >> 4, i = rho & 15; return 8 * (i >> 2) + 4 * n + (i & 3); }

struct Unit { int pm, pn; };
struct Gemm { const bf16_t* A; const bf16_t* Bt; int M, N, K, lda; int pm_per_grp, ngrp; size_t grp_bytes; int sc_w, sc_x; size_t a_extra; const int* rowmap;
    __device__ __forceinline__ size_t grp_off(int pm) const { return ngrp > 1 ? (size_t)((pm / pm_per_grp) % ngrp) * grp_bytes : (size_t)0; } };

typedef int v8i_t __attribute__((ext_vector_type(8))); typedef int v4i_t __attribute__((ext_vector_type(4)));
__device__ __forceinline__ v8i_t cat8(bf16x8 lo, bf16x8 hi) { return __builtin_shufflevector(__builtin_bit_cast(v4i_t, lo), __builtin_bit_cast(v4i_t, hi), 0, 1, 2, 3, 4, 5, 6, 7); }
struct StaticOrder {
    int nM, nN, nwg, G, c;
    __host__ __device__ void init(int M, int N, int G_, int c_) { nM = M / BM; nN = N / BM; nwg = nM * nN; G = G_; c = c_; }
    __host__ __device__ bool next(int i, Unit& u) const {
        const long L = (long)i * G + c; if (L >= nwg) return false;
        int wgid = (int)L; { const int q = nwg / NXCD, r = nwg % NXCD, xcd = wgid % NXCD, off = wgid / NXCD; wgid = (xcd < r ? xcd * (q + 1) : r * (q + 1) + (xcd - r) * q) + off; }
        const int nig = WGM * nN, gid = wgid / nig, fm = gid * WGM, gsz = (nM - fm) < WGM ? (nM - fm) : WGM;
        u.pm = fm + ((wgid % nig) % gsz); u.pn = (wgid % nig) / gsz; return true;
    }
    __device__ __forceinline__ void a_ready(const Unit&) const {}
    __device__ __forceinline__ void done(const Unit&) const {}
};

struct MergeOrder { StaticOrder S;
    __device__ __forceinline__ bool next(int i, Unit& u) const { const int t = i / 3, seg = i - 3 * t; if (!S.next(t, u)) return false; u.pm += seg * 256; return true; }
    __device__ __forceinline__ void a_ready(const Unit&) const {}
    __device__ __forceinline__ void done(const Unit&) const {}
};

typedef float f32x2_t __attribute__((ext_vector_type(2))); typedef __bf16 bf16x2_t __attribute__((ext_vector_type(2)));
__device__ __forceinline__ unsigned cvt_pk_bf16(float lo, float hi) { f32x2_t v = {lo, hi}; bf16x2_t b = __builtin_convertvector(v, bf16x2_t); return __builtin_bit_cast(unsigned, b); }
__device__ __forceinline__ float bf_lo(unsigned w) { return __uint_as_float(w << 16); }
__device__ __forceinline__ float bf_hi(unsigned w) { return __uint_as_float(w & 0xffff0000u); }

__device__ __forceinline__ float lane_xor32(float v) { const unsigned b_ = __float_as_uint(v); auto r_ = __builtin_amdgcn_permlane32_swap(b_, b_, false, false); return __uint_as_float(r_[0] ^ r_[1] ^ b_); }
#define PG8_EPI_LOOP(...) \
    _Pragma("unroll") for (int ai = 0; ai < 2; ++ai) _Pragma("unroll") for (int m = 0; m < 4; ++m) _Pragma("unroll") for (int bj = 0; bj < 2; ++bj) { \
        const int row = u.pm * BM + ai * HALF + wr * 64 + m * 16 + fr; const int ct = bj * HALF + wc * 32 + 8 * fq;   \
        f32x4 v0 = acc[ai][bj][m][0], v1 = acc[ai][bj][m][1]; __VA_ARGS__ }
__device__ __forceinline__ u32x4 pack8(f32x4 v0, f32x4 v1) { u32x4 w; w.x = cvt_pk_bf16(v0[0], v0[1]); w.y = cvt_pk_bf16(v0[2], v0[3]); w.z = cvt_pk_bf16(v1[0], v1[1]); w.w = cvt_pk_bf16(v1[2], v1[3]); return w; }

struct EpiPlain { static constexpr bool PERM = true, AFTER_DRAIN = false, SEG3 = false; bf16_t* O; int ldc;
    __device__ __forceinline__ void operator()(const f32x4 (&acc)[2][2][4][2], const Unit& u, int wr, int wc, int fr, int fq) const {
        PG8_EPI_LOOP({ *(u32x4*)(O + (size_t)row * ldc + u.pn * BM + ct) = pack8(v0, v1); }) } };
struct EpiRoute { static constexpr bool PERM = true, AFTER_DRAIN = false, SEG3 = false; bf16_t* five; size_t five_stride; bf16_t* tail; size_t tail_stride;
    __device__ __forceinline__ void operator()(const f32x4 (&acc)[2][2][4][2], const Unit& u, int wr, int wc, int fr, int fq) const {
        bf16_t* base; int ldc, c0;
        if (u.pn < 10) { base = five + (size_t)(u.pn >> 1) * five_stride; ldc = 512; c0 = (u.pn & 1) * 256; } else { base = tail + (size_t)(u.pn - 10) * tail_stride; ldc = 256; c0 = 0; }
        PG8_EPI_LOOP({ *(u32x4*)(base + (size_t)row * ldc + c0 + ct) = pack8(v0, v1); }) } };
struct EpiRouteNorm { static constexpr bool PERM = true, AFTER_DRAIN = false, SEG3 = false; bf16_t* five; size_t five_stride; bf16_t* tail; size_t tail_stride; const float* gt; float* ssp; float eps; const int* pos; const float* gkr;
    __device__ __forceinline__ void operator()(const f32x4 (&acc)[2][2][4][2], const Unit& u, int wr, int wc, int fr, int fq) const {
        bf16_t* base; int ldc, c0;
        if (u.pn < 10) { base = five + (size_t)(u.pn >> 1) * five_stride; ldc = 512; c0 = (u.pn & 1) * 256; } else { base = tail + (size_t)(u.pn - 10) * tail_stride; ldc = 256; c0 = 0; }
        const bool nrm = (u.pn < 6) || (u.pn == 9 && wc >= 2);
        const bool krw = (u.pn == 11 && wc == 2);
        const bool part = (u.pn == 8) || (u.pn == 9 && wc < 2) || (u.pn == 10) || krw;
        const int gi = u.pn < 2 ? 0 : (u.pn < 4 ? 1 : (u.pn < 6 ? 2 : 3));
        const int slot = u.pn == 8 ? wc : (u.pn == 9 ? 4 + wc : (u.pn == 10 ? 8 + wc : 12));
        float kc_[8], kg_[8];
        if (krw) {
#pragma unroll
            for (int j = 0; j < 8; ++j) { kc_[j] = __builtin_amdgcn_exp2f(-(float)(8 * (fq & 1) + j) * 0.83048202372184f) * 0.15915494309189535f; kg_[j] = gkr[8 * fq + j]; } }
        f32x4 g00 = {1.f, 1.f, 1.f, 1.f}, g01 = g00, g10 = g00, g11 = g00;
        if (nrm) { const float* gp = gt + gi * 64 + 8 * fq; g00 = *(const f32x4*)gp; g01 = *(const f32x4*)(gp + 4); g10 = *(const f32x4*)(gp + 32); g11 = *(const f32x4*)(gp + 36); }
#pragma unroll
        for (int ai = 0; ai < 2; ++ai)
#pragma unroll
            for (int m = 0; m < 4; ++m) { const int row = u.pm * BM + ai * HALF + wr * 64 + m * 16 + fr;
                f32x4 v00 = acc[ai][0][m][0], v01 = acc[ai][0][m][1], v10 = acc[ai][1][m][0], v11 = acc[ai][1][m][1];
                if (nrm || part) {
                    float ss = 0.f;
#pragma unroll
                    for (int i = 0; i < 4; ++i) ss += (v00[i] * v00[i] + v01[i] * v01[i]) + (v10[i] * v10[i] + v11[i] * v11[i]);
                    { auto r_ = __builtin_amdgcn_permlane16_swap(__float_as_uint(ss), __float_as_uint(ss), false, false); ss = __uint_as_float(r_[0]) + __uint_as_float(r_[1]); }
                    { auto r_ = __builtin_amdgcn_permlane32_swap(__float_as_uint(ss), __float_as_uint(ss), false, false); ss = __uint_as_float(r_[0]) + __uint_as_float(r_[1]); }
                    if (nrm) { const float rs = __builtin_amdgcn_rsqf(ss * (1.0f / 64) + eps); v00 = v00 * rs * g00; v01 = v01 * rs * g01; v10 = v10 * rs * g10; v11 = v11 * rs * g11; }
                    if (part && fq == 0) ssp[(size_t)row * 16 + slot] = ss;
                }
                if (krw) {
                    const float posf = (float)pos[row];
#pragma unroll
                    for (int j = 0; j < 8; ++j) { const float own = j < 4 ? v00[j & 3] : v01[j & 3]; const float other = lane_xor32(own);
                        const float fr_ = __builtin_amdgcn_fractf(posf * kc_[j]); const float cs = __builtin_amdgcn_cosf(fr_), sn = __builtin_amdgcn_sinf(fr_);
                        const float o_ = (fq < 2 ? (own * cs - other * sn) : (other * sn + own * cs)) * kg_[j];
                        if (j < 4) v00[j & 3] = o_; else v01[j & 3] = o_; }
                }
                bf16_t* rp = base + (size_t)row * ldc + c0 + wc * 64 + 8 * fq;
                *(u32x4*)rp = pack8(v00, v01); *(u32x4*)(rp + 32) = pack8(v10, v11); } } };
struct EpiPlainRS { static constexpr bool PERM = true, AFTER_DRAIN = false, SEG3 = false; bf16_t* O; int ldc; const float* ssp; int s0, ns; float inv_n, eps;
    __device__ __forceinline__ void operator()(const f32x4 (&acc)[2][2][4][2], const Unit& u, int wr, int wc, int fr, int fq) const {
        float rs[2][4];
#pragma unroll
        for (int ai = 0; ai < 2; ++ai)
#pragma unroll
            for (int m = 0; m < 4; ++m) { const int row = u.pm * BM + ai * HALF + wr * 64 + m * 16 + fr;
                const float* sp = ssp + (size_t)row * 16 + s0; const f32x4 a = *(const f32x4*)sp; float ss = (a[0] + a[1]) + (a[2] + a[3]);
                if (ns > 4) { const f32x2 b = *(const f32x2*)(sp + 4); ss += b[0] + b[1]; }
                rs[ai][m] = __builtin_amdgcn_rsqf(ss * inv_n + eps); }
        __builtin_amdgcn_sched_barrier(0);
#pragma unroll
        for (int ai = 0; ai < 2; ++ai)
#pragma unroll
            for (int m = 0; m < 4; ++m) { const int row = u.pm * BM + ai * HALF + wr * 64 + m * 16 + fr;
#pragma unroll
                for (int bj = 0; bj < 2; ++bj) { const int ct = bj * HALF + wc * 32 + 8 * fq;
                    *(u32x4*)(O + (size_t)row * ldc + u.pn * BM + ct) = pack8(acc[ai][bj][m][0] * rs[ai][m], acc[ai][bj][m][1] * rs[ai][m]); } } } };
struct EpiKV { static constexpr bool PERM = true, AFTER_DRAIN = false, SEG3 = false; bf16_t* KB; bf16_t* KVR; const bf16_t* KR; const float* ssp; const float* gkn; float eps;
    __device__ __forceinline__ void operator()(const f32x4 (&acc)[2][2][4][2], const Unit& u, int wr, int wc, int fr, int fq) const {
        const bool kw = wc < 2; const int hd = 2 * u.pn + (wc & 1);
        f32x4 g00 = {1.f, 1.f, 1.f, 1.f}, g01 = g00, g10 = g00, g11 = g00;
        if (kw) { const float* gp = gkn + 8 * fq; g00 = *(const f32x4*)gp; g01 = *(const f32x4*)(gp + 4); g10 = *(const f32x4*)(gp + 32); g11 = *(const f32x4*)(gp + 36); }
#pragma unroll
        for (int ai = 0; ai < 2; ++ai) {
            float rs[4], ssr[4]; u32x4 krv[4];
#pragma unroll
            for (int m = 0; m < 4; ++m) { const int row = u.pm * BM + ai * HALF + wr * 64 + m * 16 + fr; const float* sp = ssp + (size_t)row * 16;
                const f32x4 a = *(const f32x4*)(sp + 8); rs[m] = __builtin_amdgcn_rsqf(((a[0] + a[1]) + (a[2] + a[3])) * (1.0f / 256) + eps); ssr[m] = sp[12];
                if (kw) krv[m] = *(const u32x4*)(KR + (size_t)row * 256 + 8 * fq); else krv[m] = (u32x4){0u, 0u, 0u, 0u}; }
            __builtin_amdgcn_sched_barrier(0);
#pragma unroll
            for (int m = 0; m < 4; ++m) { const int row = u.pm * BM + ai * HALF + wr * 64 + m * 16 + fr; const float r_ = rs[m];
                f32x4 v00 = acc[ai][0][m][0] * r_, v01 = acc[ai][0][m][1] * r_, v10 = acc[ai][1][m][0] * r_, v11 = acc[ai][1][m][1] * r_;
                if (kw) {
                    float ss = 0.f;
#pragma unroll
                    for (int i = 0; i < 4; ++i) ss += (v00[i] * v00[i] + v01[i] * v01[i]) + (v10[i] * v10[i] + v11[i] * v11[i]);
                    { auto q_ = __builtin_amdgcn_permlane16_swap(__float_as_uint(ss), __float_as_uint(ss), false, false); ss = __uint_as_float(q_[0]) + __uint_as_float(q_[1]); }
                    { auto q_ = __builtin_amdgcn_permlane32_swap(__float_as_uint(ss), __float_as_uint(ss), false, false); ss = __uint_as_float(q_[0]) + __uint_as_float(q_[1]); }
                    const float rk = __builtin_amdgcn_rsqf((ss + ssr[m]) * (1.0f / 96) + eps);
                    bf16_t* kp = KB + (size_t)row * 768 + hd * 96 + 8 * fq;
                    *(u32x4*)kp = pack8(v00 * rk * g00, v01 * rk * g01); *(u32x4*)(kp + 32) = pack8(v10 * rk * g10, v11 * rk * g11);
                    const u32x4 w = krv[m];
                    const f32x4 r0 = {bf_lo(w.x) * rk, bf_hi(w.x) * rk, bf_lo(w.y) * rk, bf_hi(w.y) * rk}, r1 = {bf_lo(w.z) * rk, bf_hi(w.z) * rk, bf_lo(w.w) * rk, bf_hi(w.w) * rk};
                    *(u32x4*)(kp + 64) = pack8(r0, r1);
                } else {
                    bf16_t* vp = KVR + (size_t)row * 1024 + 512 + hd * 64 + 8 * fq;
                    *(u32x4*)vp = pack8(v00, v01); *(u32x4*)(vp + 32) = pack8(v10, v11);
                } }
            __builtin_amdgcn_sched_barrier(0);
        } } };
struct EpiGate { static constexpr bool PERM = true, AFTER_DRAIN = false, SEG3 = false; unsigned char* g0; size_t gstride, gextra; float zs;
    __device__ __forceinline__ void operator()(const f32x4 (&acc)[2][2][4][2], const Unit& u, int wr, int wc, int fr, int fq) const {
        const int gi = u.pn >> 2; unsigned char* base = g0 + (size_t)((gi * 2) % 3) * gstride; const int c0 = (u.pn & 3) * 256;
        PG8_EPI_LOOP({
            _Pragma("unroll") for (int i = 0; i < 4; ++i) { v0[i] = 255.0f * __builtin_amdgcn_rcpf(1.0f + __builtin_amdgcn_exp2f(zs * v0[i])); v1[i] = 255.0f * __builtin_amdgcn_rcpf(1.0f + __builtin_amdgcn_exp2f(zs * v1[i])); }
            u32x2 w; w.x = 0u; w.y = 0u;
            w.x = __builtin_amdgcn_cvt_pk_u8_f32(v0[0], 0, w.x); w.x = __builtin_amdgcn_cvt_pk_u8_f32(v0[1], 1, w.x); w.x = __builtin_amdgcn_cvt_pk_u8_f32(v0[2], 2, w.x); w.x = __builtin_amdgcn_cvt_pk_u8_f32(v0[3], 3, w.x);
            w.y = __builtin_amdgcn_cvt_pk_u8_f32(v1[0], 0, w.y); w.y = __builtin_amdgcn_cvt_pk_u8_f32(v1[1], 1, w.y); w.y = __builtin_amdgcn_cvt_pk_u8_f32(v1[2], 2, w.y); w.y = __builtin_amdgcn_cvt_pk_u8_f32(v1[3], 3, w.y);
            *(u32x2*)(base + (size_t)row * 1024 + c0 + ct) = w; }) } };
struct EpiMerge { static constexpr bool PERM = true, AFTER_DRAIN = false, SEG3 = false; const unsigned char* gate; bf16_t* mg; int first;
    __device__ __forceinline__ void operator()(const f32x4 (&acc)[2][2][4][2], const Unit& u, int wr, int wc, int fr, int fq) const {
#pragma unroll
        for (int ai = 0; ai < 2; ++ai) {
            u32x2 gw[4][2]; u32x4 pw[4][2];
#pragma unroll
            for (int m = 0; m < 4; ++m)
#pragma unroll
                for (int bj = 0; bj < 2; ++bj) { const int row = u.pm * BM + ai * HALF + wr * 64 + m * 16 + fr; const int ct = bj * HALF + wc * 32 + 8 * fq;
                    const size_t off = (size_t)row * 1024 + u.pn * BM + ct;
                    gw[m][bj] = *(const u32x2*)(gate + off);
                    if (!first) pw[m][bj] = *(const u32x4*)(mg + off); else pw[m][bj] = (u32x4){0u, 0u, 0u, 0u}; }
            __builtin_amdgcn_sched_barrier(0);
#pragma unroll
            for (int m = 0; m < 4; ++m)
#pragma unroll
                for (int bj = 0; bj < 2; ++bj) { const int row = u.pm * BM + ai * HALF + wr * 64 + m * 16 + fr; const int ct = bj * HALF + wc * 32 + 8 * fq;
                    const size_t off = (size_t)row * 1024 + u.pn * BM + ct;
                    const u32x2 g = gw[m][bj]; const u32x4 p = pw[m][bj];
                    const f32x4 p0 = (f32x4){bf_lo(p.x), bf_hi(p.x), bf_lo(p.y), bf_hi(p.y)}, p1 = (f32x4){bf_lo(p.z), bf_hi(p.z), bf_lo(p.w), bf_hi(p.w)};
                    const float q8 = 1.0f / 255.0f;
                    const f32x4 g0v = (f32x4){(float)(g.x & 0xffu) * q8, (float)((g.x >> 8) & 0xffu) * q8, (float)((g.x >> 16) & 0xffu) * q8, (float)(g.x >> 24) * q8};
                    const f32x4 g1v = (f32x4){(float)(g.y & 0xffu) * q8, (float)((g.y >> 8) & 0xffu) * q8, (float)((g.y >> 16) & 0xffu) * q8, (float)(g.y >> 24) * q8};
                    *(u32x4*)(mg + off) = pack8(p0 + g0v * acc[ai][bj][m][0], p1 + g1v * acc[ai][bj][m][1]); }
        } } };
struct EpiMerge3 { static constexpr bool PERM = true, AFTER_DRAIN = false, SEG3 = true; const unsigned char* g; bf16_t* mg;
    static __device__ __forceinline__ f32x4 lo4(unsigned w) { return (f32x4){fmaxf((float)(w & 0xffu), 0.5f), fmaxf((float)((w >> 8) & 0xffu), 0.5f), fmaxf((float)((w >> 16) & 0xffu), 0.5f), fmaxf((float)(w >> 24), 0.5f)}; }
    __device__ __forceinline__ void operator()(f32x4 (&acc)[2][2][4][2], const Unit& u, int wr, int wc, int fr, int fq) const {
        const int seg = u.pm >> 8, pm = u.pm & 255;
        const unsigned char* gc = g + ((size_t)seg << 26);
        if (seg < 2) {
#pragma unroll
            for (int ai = 0; ai < 2; ++ai) {
                u32x2 ga[4][2], gb[4][2];
#pragma unroll
                for (int m = 0; m < 4; ++m)
#pragma unroll
                    for (int bj = 0; bj < 2; ++bj) { const int row = pm * BM + ai * HALF + wr * 64 + m * 16 + fr; const int ct = bj * HALF + wc * 32 + 8 * fq;
                        const size_t off = (size_t)row * 1024 + u.pn * BM + ct;
                        ga[m][bj] = *(const u32x2*)(gc + off); gb[m][bj] = *(const u32x2*)(gc + ((size_t)1 << 26) + off); }
                __builtin_amdgcn_sched_barrier(0);
#pragma unroll
                for (int m = 0; m < 4; ++m)
#pragma unroll
                    for (int bj = 0; bj < 2; ++bj) {
                        const f32x4 a0 = lo4(ga[m][bj].x), a1 = lo4(ga[m][bj].y), b0 = lo4(gb[m][bj].x), b1 = lo4(gb[m][bj].y);
#pragma unroll
                        for (int i = 0; i < 4; ++i) { acc[ai][bj][m][0][i] *= a0[i] * __builtin_amdgcn_rcpf(b0[i]); acc[ai][bj][m][1][i] *= a1[i] * __builtin_amdgcn_rcpf(b1[i]); } }
            }
        } else {
#pragma unroll
            for (int ai = 0; ai < 2; ++ai) {
                u32x2 ga[4][2];
#pragma unroll
                for (int m = 0; m < 4; ++m)
#pragma unroll
                    for (int bj = 0; bj < 2; ++bj) { const int row = pm * BM + ai * HALF + wr * 64 + m * 16 + fr; const int ct = bj * HALF + wc * 32 + 8 * fq;
                        ga[m][bj] = *(const u32x2*)(gc + (size_t)row * 1024 + u.pn * BM + ct); }
                __builtin_amdgcn_sched_barrier(0);
#pragma unroll
                for (int m = 0; m < 4; ++m)
#pragma unroll
                    for (int bj = 0; bj < 2; ++bj) { const int row = pm * BM + ai * HALF + wr * 64 + m * 16 + fr; const int ct = bj * HALF + wc * 32 + 8 * fq;
                        const float q8 = 1.0f / 255.0f;
                        const f32x4 a0 = lo4(ga[m][bj].x) * q8, a1 = lo4(ga[m][bj].y) * q8;
                        *(u32x4*)(mg + (size_t)row * 1024 + u.pn * BM + ct) = pack8(acc[ai][bj][m][0] * a0, acc[ai][bj][m][1] * a1); }
            }
        } } };
struct EpiResid { static constexpr bool PERM = true, AFTER_DRAIN = false, SEG3 = false; const void* xi; int in_bf16; bf16_t* xo;
    __device__ __forceinline__ void operator()(const f32x4 (&acc)[2][2][4][2], const Unit& u, int wr, int wc, int fr, int fq) const {
#pragma unroll
        for (int ai = 0; ai < 2; ++ai) {
            f32x4 xa[4][2], xb[4][2];
#pragma unroll
            for (int m = 0; m < 4; ++m)
#pragma unroll
                for (int bj = 0; bj < 2; ++bj) { const int row = u.pm * BM + ai * HALF + wr * 64 + m * 16 + fr; const int ct = bj * HALF + wc * 32 + 8 * fq;
                    const size_t off = (size_t)row * 1024 + u.pn * BM + ct;
                    if (in_bf16) { const u32x4 w = *(const u32x4*)((const bf16_t*)xi + off);
                        xa[m][bj] = (f32x4){__uint_as_float(w.x << 16), __uint_as_float(w.x & 0xffff0000u), __uint_as_float(w.y << 16), __uint_as_float(w.y & 0xffff0000u)};
                        xb[m][bj] = (f32x4){__uint_as_float(w.z << 16), __uint_as_float(w.z & 0xffff0000u), __uint_as_float(w.w << 16), __uint_as_float(w.w & 0xffff0000u)}; }
                    else { xa[m][bj] = *(const f32x4*)((const float*)xi + off); xb[m][bj] = *(const f32x4*)((const float*)xi + off + 4); } }
            __builtin_amdgcn_sched_barrier(0);
#pragma unroll
            for (int m = 0; m < 4; ++m)
#pragma unroll
                for (int bj = 0; bj < 2; ++bj) { const int row = u.pm * BM + ai * HALF + wr * 64 + m * 16 + fr; const int ct = bj * HALF + wc * 32 + 8 * fq;
                    const size_t off = (size_t)row * 1024 + u.pn * BM + ct;
                    *(u32x4*)(xo + off) = pack8(xa[m][bj] + acc[ai][bj][m][0], xb[m][bj] + acc[ai][bj][m][1]); }
        } } };
__device__ __forceinline__ u32x2 pack8_fp8(f32x4 v0, f32x4 v1) {
    _Pragma("unroll") for (int i = 0; i < 4; ++i) { v0[i] = fminf(fmaxf(v0[i], -448.f), 448.f); v1[i] = fminf(fmaxf(v1[i], -448.f), 448.f); }
    int a = 0, b = 0; a = __builtin_amdgcn_cvt_pk_fp8_f32(v0[0], v0[1], a, false); a = __builtin_amdgcn_cvt_pk_fp8_f32(v0[2], v0[3], a, true);
    b = __builtin_amdgcn_cvt_pk_fp8_f32(v1[0], v1[1], b, false); b = __builtin_amdgcn_cvt_pk_fp8_f32(v1[2], v1[3], b, true); u32x2 w; w.x = (unsigned)a; w.y = (unsigned)b; return w; }
struct EpiSwiglu { static constexpr bool PERM = true, AFTER_DRAIN = false, SEG3 = false; unsigned char* hid; float iscale, oscale;
    __device__ __forceinline__ void operator()(const f32x4 (&acc)[2][2][4][2], const Unit& u, int wr, int wc, int fr, int fq) const {
#pragma unroll
        for (int ai = 0; ai < 2; ++ai)
#pragma unroll
            for (int m = 0; m < 4; ++m) { const int row = u.pm * BM + ai * HALF + wr * 64 + m * 16 + fr; const int col = u.pn * 128 + wc * 32 + 8 * fq;
                f32x4 o0, o1;
#pragma unroll
                for (int i = 0; i < 4; ++i) { const float g0 = acc[ai][0][m][0][i] * iscale, g1 = acc[ai][0][m][1][i] * iscale;
                    o0[i] = g0 * __builtin_amdgcn_rcpf(1.0f + __builtin_amdgcn_exp2f(-1.4426950408889634f * g0)) * (acc[ai][1][m][0][i] * iscale);
                    o1[i] = g1 * __builtin_amdgcn_rcpf(1.0f + __builtin_amdgcn_exp2f(-1.4426950408889634f * g1)) * (acc[ai][1][m][1][i] * iscale); }
                *(u32x2*)(hid + (size_t)row * 1024 + col) = pack8_fp8(o0 * oscale, o1 * oscale); } } };
struct EpiDown { static constexpr bool PERM = true, AFTER_DRAIN = false, SEG3 = false; unsigned char* Y; const float* aff; float iscale;
    __device__ __forceinline__ void operator()(const f32x4 (&acc)[2][2][4][2], const Unit& u, int wr, int wc, int fr, int fq) const {
        float a[2][4];
#pragma unroll
        for (int ai = 0; ai < 2; ++ai)
#pragma unroll
            for (int m = 0; m < 4; ++m) a[ai][m] = aff[u.pm * BM + ai * HALF + wr * 64 + m * 16 + fr] * iscale;
        __builtin_amdgcn_sched_barrier(0);
        PG8_EPI_LOOP({ v0 = v0 * a[ai][m]; v1 = v1 * a[ai][m]; *(u32x2*)(Y + (size_t)row * 1024 + u.pn * BM + ct) = pack8_fp8(v0, v1); }) } };

template <class Epi, class Sched, bool ALIGN_EPI = false, bool SP2 = false, bool F8 = false, bool AG = false>
__device__ __forceinline__ void gemm_phase(PG8_LAS unsigned char* lds, const Gemm g, const Sched& S, const Epi& E) {
    int tid_ = threadIdx.x; asm volatile("" : "+v"(tid_));
    const int tid = tid_, wid = __builtin_amdgcn_readfirstlane(tid >> 6), lane = tid & 63, wr = wid >> 2, wc = wid & 3, fr = lane & 15, fq = lane >> 4;
    const int K = g.K, nt = K / BK, lda = g.lda;
    unsigned voffA[2], voffB[2];
#pragma unroll
    for (int i = 0; i < 2; ++i) { int R, C; stage_rc(tid * 16 + i * 8192, R, C); const int Rb = Epi::PERM ? ((R & ~31) + perm32(R & 31)) : R;
        voffA[i] = (unsigned)(R * lda + C) * 2u; voffB[i] = (unsigned)(Rb * K + C) * 2u; }
    const size_t kstep = (size_t)(BK * 2);
    const size_t hstepA = (size_t)HALF * lda * 2, hstepB = (size_t)HALF * K * 2;
    const size_t tstepA = 2 * hstepA, tstepB = 2 * hstepB;
    const unsigned ldsw = (unsigned)wid * 1024u;
    const int aoff = lds_byte(wr * 64 + fr, fq * 8), boff = lds_byte(wc * 32 + fr, fq * 8);
#define PG8_SA(b, h) (((b) * 2 + (h)) * HTB)
#define PG8_SB(b, h) ((4 + (b) * 2 + (h)) * HTB)
#define PG8_STAGE(bufoff, gbase, voff) do { _Pragma("unroll") for (int _i = 0; _i < 2; ++_i) \
        __builtin_amdgcn_global_load_lds((const unsigned*)((const char*)(gbase) + (voff)[_i]), (PG8_LAS unsigned*)(lds + (bufoff) + ldsw + _i * 8192), 16, 0, 0); } while (0)
#define PG8_STAGE_A(bufoff, abase, hh, V) do { if constexpr (AG) { PG8_STAGE(bufoff, abase, (V)[hh]); } else { PG8_STAGE(bufoff, (abase) + (hh) * hstepA, voffA); } } while (0)
#define PG8_LDA(dst, b, h) do { _Pragma("unroll") for (int m = 0; m < 4; ++m) { if constexpr (F8) { dst##8[m] = cat8(*(const PG8_LAS bf16x8*)(lds + PG8_SA(b, h) + aoff + m * 2048), *(const PG8_LAS bf16x8*)(lds + PG8_SA(b, h) + aoff + m * 2048 + 1024)); } \
        else { _Pragma("unroll") for (int k = 0; k < 2; ++k) dst[m][k] = *(const PG8_LAS bf16x8*)(lds + PG8_SA(b, h) + aoff + m * 2048 + k * 1024); } } } while (0)
#define PG8_LDB(dst, b, h) do { _Pragma("unroll") for (int n = 0; n < 2; ++n) { if constexpr (F8) { dst##8[n] = cat8(*(const PG8_LAS bf16x8*)(lds + PG8_SB(b, h) + boff + n * 2048), *(const PG8_LAS bf16x8*)(lds + PG8_SB(b, h) + boff + n * 2048 + 1024)); } \
        else { _Pragma("unroll") for (int k = 0; k < 2; ++k) dst[n][k] = *(const PG8_LAS bf16x8*)(lds + PG8_SB(b, h) + boff + n * 2048 + k * 1024); } } } while (0)
#define PG8_MMA(ai, bj, At, Bt) do { __builtin_amdgcn_s_setprio(1); _Pragma("unroll") for (int m = 0; m < 4; ++m) _Pragma("unroll") for (int n = 0; n < 2; ++n) { \
        if constexpr (F8) { asm volatile("v_mfma_f32_16x16x128_f8f6f4 %0, %1, %2, %0" : "+v"(acc[ai][bj][m][n]) : "v"(Bt##8[n]), "v"(At##8[m])); }     \
        else { _Pragma("unroll") for (int k = 0; k < 2; ++k) acc[ai][bj][m][n] = __builtin_amdgcn_mfma_f32_16x16x32_bf16(Bt[n][k], At[m][k], acc[ai][bj][m][n], 0, 0, 0); } } \
        __builtin_amdgcn_s_setprio(0); } while (0)
#define PG8_WAIT_V(n) asm volatile("s_waitcnt vmcnt(" #n ")" ::: "memory")
#define PG8_WAIT_L(n) asm volatile("s_waitcnt lgkmcnt(" #n ")" ::: "memory")
#define PG8_BAR __builtin_amdgcn_s_barrier()
#define PG8_SCHED __builtin_amdgcn_sched_barrier(0)
    Unit cur, nxt; int ui = 0;
    if (!S.next(0, cur)) return;
    f32x4 acc[2][2][4][2];
#define PG8_Z z0_
    { float z0_ = 0.f; asm volatile("" : "+v"(z0_));
#pragma unroll
    for (int a = 0; a < 2; ++a)
#pragma unroll
        for (int b = 0; b < 2; ++b)
#pragma unroll
            for (int m = 0; m < 4; ++m)
#pragma unroll
                for (int n = 0; n < 2; ++n) acc[a][b][m][n] = (f32x4){PG8_Z, PG8_Z, PG8_Z, PG8_Z}; }
    bf16x8 At[4][2], B0[2][2], B1[2][2]; v8i_t At8[4], B08[2], B18[2]; (void)At; (void)B0; (void)B1; (void)At8; (void)B08; (void)B18;
    const char* cA = AG ? (const char*)g.A : (const char*)g.A + (size_t)cur.pm * tstepA + (Epi::SEG3 ? (size_t)(cur.pm >> 9) * g.a_extra : (size_t)0); const char* cB = (const char*)g.Bt + g.grp_off(cur.pm) + (size_t)cur.pn * tstepB;
    S.a_ready(cur);
    unsigned vgc[2][2], vgn[2][2], vsel[2][2]; (void)vgc; (void)vgn; (void)vsel;
#define PG8_AG_LOAD(dst, un) do { _Pragma("unroll") for (int hh = 0; hh < 2; ++hh) _Pragma("unroll") for (int i = 0; i < 2; ++i) { int R, C; stage_rc(tid * 16 + i * 8192, R, C); \
        const int r_ = (un).pm * BM + hh * HALF + R; const int tok_ = ((((un).pm >> 1) & 15) << 12) + g.rowmap[r_]; dst[hh][i] = (unsigned)(tok_ * lda + C) * 2u; } } while (0)
    if constexpr (AG) { PG8_AG_LOAD(vgc, cur); }
    if constexpr (SP2) {
        PG8_STAGE(PG8_SB(0, 0), cB, voffB); PG8_STAGE(PG8_SB(0, 1), cB + hstepB, voffB); PG8_STAGE_A(PG8_SA(0, 0), cA, 0, vgc); PG8_STAGE_A(PG8_SA(0, 1), cA, 1, vgc);
        if (wr == 1) PG8_BAR;
        PG8_WAIT_V(2); PG8_BAR;
        PG8_STAGE(PG8_SB(1, 0), cB + kstep, voffB); PG8_STAGE_A(PG8_SA(1, 0), cA + kstep, 0, vgc); PG8_STAGE(PG8_SB(1, 1), cB + hstepB + kstep, voffB);
        PG8_WAIT_V(6); PG8_BAR;
    } else {
        PG8_STAGE(PG8_SB(0, 0), cB, voffB); PG8_STAGE_A(PG8_SA(0, 0), cA, 0, vgc); PG8_STAGE(PG8_SB(0, 1), cB + hstepB, voffB); PG8_STAGE_A(PG8_SA(0, 1), cA, 1, vgc);
        if (wr == 1) PG8_BAR;
        PG8_WAIT_V(4); PG8_BAR;
        PG8_STAGE(PG8_SB(1, 0), cB + kstep, voffB); PG8_STAGE_A(PG8_SA(1, 0), cA + kstep, 0, vgc); PG8_STAGE(PG8_SB(1, 1), cB + hstepB + kstep, voffB);
        PG8_WAIT_V(6); PG8_BAR;
    }
    for (;;) {
        const bool has_next = S.next(ui + 1, nxt);
        if constexpr (AG) { if (has_next) { PG8_AG_LOAD(vgn, nxt); } }
        const char* nA = (has_next && !AG) ? (const char*)g.A + (size_t)nxt.pm * tstepA + (Epi::SEG3 ? (size_t)(nxt.pm >> 9) * g.a_extra : (size_t)0) : cA; const char* nB = has_next ? (const char*)g.Bt + g.grp_off(nxt.pm) + (size_t)nxt.pn * tstepB : cB;
#pragma unroll 1
        for (int t = 0; t < nt; t += 2) {
            const bool last = (t == nt - 2);
            const char* a1 = cA + (size_t)(t + 1) * kstep;
            const char* a2 = last ? nA : cA + (size_t)(t + 2) * kstep; const char* b2 = last ? nB : cB + (size_t)(t + 2) * kstep;
            const char* a3 = a2 + kstep; const char* b3 = b2 + kstep;
            if constexpr (AG) { _Pragma("unroll") for (int hh = 0; hh < 2; ++hh) _Pragma("unroll") for (int i = 0; i < 2; ++i) vsel[hh][i] = (last && has_next) ? vgn[hh][i] : vgc[hh][i]; }
            if (last && has_next) S.a_ready(nxt);
            if constexpr (SP2) {
            PG8_LDB(B0, 0, 0); PG8_LDB(B1, 0, 1); PG8_SCHED; PG8_LDA(At, 0, 0); PG8_STAGE_A(PG8_SA(1, 1), a1, 1, vgc);
            PG8_WAIT_V(8); PG8_WAIT_L(0); PG8_BAR; PG8_MMA(0, 0, At, B0); PG8_MMA(0, 1, At, B1); PG8_BAR; PG8_SCHED;
            PG8_LDA(At, 0, 1); PG8_STAGE(PG8_SB(0, 0), b2, voffB); PG8_STAGE(PG8_SB(0, 1), b2 + hstepB, voffB); PG8_STAGE_A(PG8_SA(0, 0), a2, 0, vsel);
            PG8_WAIT_V(8); PG8_WAIT_L(0); PG8_BAR; PG8_MMA(1, 0, At, B0); PG8_MMA(1, 1, At, B1); PG8_BAR; PG8_SCHED;
            PG8_LDB(B0, 1, 0); PG8_LDB(B1, 1, 1); PG8_SCHED; PG8_LDA(At, 1, 0); PG8_STAGE_A(PG8_SA(0, 1), a2, 1, vsel);
            PG8_WAIT_V(8); PG8_WAIT_L(0); PG8_BAR; PG8_MMA(0, 0, At, B0); PG8_MMA(0, 1, At, B1); PG8_BAR; PG8_SCHED;
            PG8_LDA(At, 1, 1); PG8_STAGE(PG8_SB(1, 0), b3, voffB); PG8_STAGE(PG8_SB(1, 1), b3 + hstepB, voffB); PG8_STAGE_A(PG8_SA(1, 0), a3, 0, vsel);
            PG8_WAIT_V(8); PG8_WAIT_L(0); PG8_BAR; PG8_MMA(1, 0, At, B0); PG8_MMA(1, 1, At, B1); PG8_BAR; PG8_SCHED;
            } else {
            PG8_LDB(B0, 0, 0); PG8_SCHED; PG8_LDA(At, 0, 0); PG8_STAGE_A(PG8_SA(1, 1), a1, 1, vgc);
            PG8_WAIT_L(8); PG8_BAR; PG8_WAIT_L(0); PG8_MMA(0, 0, At, B0); PG8_BAR; PG8_SCHED;
            PG8_LDB(B1, 0, 1); PG8_STAGE(PG8_SB(0, 0), b2, voffB);
            PG8_BAR; PG8_WAIT_L(0); PG8_MMA(0, 1, At, B1); PG8_BAR;
            PG8_LDA(At, 0, 1); PG8_STAGE_A(PG8_SA(0, 0), a2, 0, vsel);
            PG8_BAR; PG8_WAIT_L(0); PG8_MMA(1, 0, At, B0); PG8_BAR; PG8_SCHED;
            PG8_STAGE(PG8_SB(0, 1), b2 + hstepB, voffB);
            PG8_WAIT_V(6); PG8_BAR; PG8_MMA(1, 1, At, B1); PG8_BAR;
            PG8_LDB(B0, 1, 0); PG8_SCHED; PG8_LDA(At, 1, 0); PG8_STAGE_A(PG8_SA(0, 1), a2, 1, vsel);
            PG8_WAIT_L(8); PG8_BAR; PG8_WAIT_L(0); PG8_MMA(0, 0, At, B0); PG8_BAR; PG8_SCHED;
            PG8_LDB(B1, 1, 1); PG8_STAGE(PG8_SB(1, 0), b3, voffB);
            PG8_BAR; PG8_WAIT_L(0); PG8_MMA(0, 1, At, B1); PG8_BAR;
            PG8_LDA(At, 1, 1); PG8_STAGE_A(PG8_SA(1, 0), a3, 0, vsel);
            PG8_BAR; PG8_WAIT_L(0); PG8_MMA(1, 0, At, B0); PG8_BAR; PG8_SCHED;
            PG8_STAGE(PG8_SB(1, 1), b3 + hstepB, voffB);
            PG8_WAIT_V(6); PG8_BAR; PG8_MMA(1, 1, At, B1); PG8_BAR;
            }
        }
        if constexpr (F8) { asm volatile("s_nop 15\n\ts_nop 15" ::: "memory"); }
        if constexpr (ALIGN_EPI) { if (wr == 0) PG8_BAR; }
        if constexpr (!Epi::AFTER_DRAIN) { E(acc, cur, wr, wc, fr, fq); S.done(cur); }
        if (!has_next) break;
        if (!Epi::SEG3 || nxt.pm < 256) { float z0_ = 0.f; asm volatile("" : "+v"(z0_));
#pragma unroll
        for (int a = 0; a < 2; ++a)
#pragma unroll
            for (int b = 0; b < 2; ++b)
#pragma unroll
                for (int m = 0; m < 4; ++m)
#pragma unroll
                    for (int n = 0; n < 2; ++n) acc[a][b][m][n] = (f32x4){PG8_Z, PG8_Z, PG8_Z, PG8_Z}; }
        cur = nxt; cA = nA; cB = nB; ++ui;
        if constexpr (AG) { _Pragma("unroll") for (int hh = 0; hh < 2; ++hh) _Pragma("unroll") for (int i = 0; i < 2; ++i) vgc[hh][i] = vgn[hh][i]; }
        if constexpr (ALIGN_EPI) { if (wr == 1) PG8_BAR; }
    }
    PG8_WAIT_V(0);
    if constexpr (!ALIGN_EPI) { if (wr == 0) PG8_BAR; }
    PG8_BAR;
    if constexpr (Epi::AFTER_DRAIN) { E.fused(acc, cur, wr, wc, fr, fq, lds, wid, lane); S.done(cur); }
#undef PG8_Z
#undef PG8_SA
#undef PG8_SB
#undef PG8_STAGE
#undef PG8_STAGE_A
#undef PG8_AG_LOAD
#undef PG8_LDA
#undef PG8_LDB
#undef PG8_MMA
#undef PG8_WAIT_V
#undef PG8_WAIT_L
#undef PG8_BAR
#undef PG8_SCHED
}
}

constexpr int NB = 16, SEQ = 4096, DM = 1024, T = NB * SEQ, DEPTH = 2;
constexpr int NEXP = 16, CAP = 512, TE = NB * NEXP * CAP;
constexpr int IN_COLS = 6048;
constexpr float EPS = 1e-6f;
constexpr float LOG2E = 1.4426950408889634f;
constexpr int NWAVES = 8;
constexpr int PH_PER_LAYER = 16, NPHASE = DEPTH * PH_PER_LAYER;

constexpr size_t MiB = 1u << 20;
constexpr size_t WS_CTL = 0, CTL_ZERO_BYTES = 1 * MiB;
constexpr size_t WS_AFFT = 2 * MiB;
constexpr size_t WS_INV = 6 * MiB;
constexpr size_t WS_IDX = 10 * MiB;
constexpr size_t WS_AFFSEL = 10 * MiB + 512 * 1024;
constexpr size_t WS_TMM = 11 * MiB;
constexpr size_t WS_GT = 11 * MiB + 16 * 1024;
constexpr size_t WS_SSP = 2 * MiB;
constexpr size_t WS_WIN = 12 * MiB;
constexpr size_t WS_WUQ = 24 * MiB;
constexpr size_t WS_WUKV = 25 * MiB;
constexpr size_t WS_WBA = 26 * MiB, WS_WBC = 27 * MiB, WS_WBB = 28 * MiB;
constexpr size_t WS_WO = 29 * MiB;
constexpr size_t WS_WGU = 32 * MiB;
constexpr size_t WS_WD = 64 * MiB;
constexpr size_t WS_WG8 = 80 * MiB;
constexpr size_t WS_H8 = 864 * MiB;
constexpr float Y_SCALE = 64.0f;
constexpr float W8_SCALE = 64.0f, HID_SCALE = 4.0f;
constexpr int W8_E8M0 = 127 - 6, HID_E8M0 = 127 - 2, ONE_E8M0 = 127;
constexpr size_t WS_H = 128 * MiB;
constexpr size_t WS_QA = 256 * MiB, WS_QC = 320 * MiB, WS_KA = 384 * MiB, WS_VA = 448 * MiB, WS_CQKC = 512 * MiB;
constexpr size_t WS_CKV = 576 * MiB, WS_VCKR = 608 * MiB;
constexpr size_t WS_G0 = 384 * MiB;
constexpr size_t WS_QB = 640 * MiB;
constexpr size_t WS_KVR = 736 * MiB;
constexpr size_t WS_G1 = 448 * MiB, WS_G2 = 512 * MiB;
constexpr size_t WS_KB = 864 * MiB;
constexpr size_t WS_OB = 960 * MiB;
constexpr size_t WS_XG = 256 * MiB;
constexpr size_t WS_HID = 512 * MiB;
constexpr size_t WS_XB = 768 * MiB;
constexpr size_t H8_OUT_OFF = 128 * MiB;
constexpr size_t WS_END = 1024 * MiB;

constexpr int RING_OFF = 0, RING_BYTES = 131072;
constexpr int LDS_BYTES = 163840;
constexpr int LDSCTL_OFF = LDS_BYTES - 1024, MISC_OFF = LDSCTL_OFF + 320;
constexpr int ATT_NXT_OFF = LDSCTL_OFF - 64;
constexpr int ATT_STASH_OFF = 86528;

#define LAS __attribute__((address_space(3)))
typedef unsigned short bf16;
typedef unsigned v4u __attribute__((ext_vector_type(4)));
typedef unsigned v2u __attribute__((ext_vector_type(2)));
typedef float f32x4 __attribute__((ext_vector_type(4)));
typedef float f32x2 __attribute__((ext_vector_type(2)));
typedef float f32x16 __attribute__((ext_vector_type(16)));
typedef short bf16x8 __attribute__((ext_vector_type(8)));
typedef short s16x4 __attribute__((ext_vector_type(4)));
#define LDS_WAIT() asm volatile("s_waitcnt lgkmcnt(0)" ::: "memory")
#define VM_WAIT() asm volatile("s_waitcnt vmcnt(0)" ::: "memory")
__device__ __forceinline__ unsigned pk2(float lo, float hi) { return pg8::cvt_pk_bf16(lo, hi); }
__device__ __forceinline__ float bflo(unsigned w) { return __uint_as_float(w << 16); }
__device__ __forceinline__ float bfhi(unsigned w) { return __uint_as_float(w & 0xffff0000u); }
template <int M> __device__ __forceinline__ float xor_add(float v) {
    if constexpr (M < 32) return v + __int_as_float(__builtin_amdgcn_ds_swizzle(__float_as_int(v), (M << 10) | 0x1f));
    else { auto r = __builtin_amdgcn_permlane32_swap(__float_as_uint(v), __float_as_uint(v), false, false); return __uint_as_float(r[0]) + __uint_as_float(r[1]); } }
template <int M> __device__ __forceinline__ float xor_max(float v) {
    if constexpr (M < 32) return fmaxf(v, __int_as_float(__builtin_amdgcn_ds_swizzle(__float_as_int(v), (M << 10) | 0x1f)));
    else { auto r = __builtin_amdgcn_permlane32_swap(__float_as_uint(v), __float_as_uint(v), false, false); return fmaxf(__uint_as_float(r[0]), __uint_as_float(r[1])); } }
template <int M> __device__ __forceinline__ int xor_geti(int v) { static_assert(M < 32, "xor_geti: masks below 32"); return __builtin_amdgcn_ds_swizzle(v, (M << 10) | 0x1f); }
template <int M> __device__ __forceinline__ float xor_getf(float v) { return __int_as_float(xor_geti<M>(__float_as_int(v))); }
__device__ __forceinline__ unsigned wave_sum_u(unsigned c) {
    c += (unsigned)xor_geti<1>((int)c); c += (unsigned)xor_geti<2>((int)c); c += (unsigned)xor_geti<4>((int)c); c += (unsigned)xor_geti<8>((int)c); c += (unsigned)xor_geti<16>((int)c);
    auto r = __builtin_amdgcn_permlane32_swap(c, c, false, false); return r[0] + r[1]; }
__device__ __forceinline__ float wave_sum(float v) { v = xor_add<1>(v); v = xor_add<2>(v); v = xor_add<4>(v); v = xor_add<8>(v); v = xor_add<16>(v); return xor_add<32>(v); }

#define XB_TMO      128
#define XB_XCNT(j)  (256  + 64 * (j))
#define XB_XSUB(j)  (1280 + 64 * (j))
#define XB_XGEN(j)  (2304 + 64 * (j))
#define XB_TOP      3328
#define XB_TOPGEN   3392
#define XCD_BAR_WORDS 3456
#define XB_SPIN_CAP (1u << 23)

__device__ __forceinline__ unsigned xb_ld(unsigned* p)              { return __hip_atomic_load(p, __ATOMIC_RELAXED, __HIP_MEMORY_SCOPE_AGENT); }
__device__ __forceinline__ unsigned xb_add(unsigned* p, unsigned v) { return __hip_atomic_fetch_add(p, v, __ATOMIC_RELAXED, __HIP_MEMORY_SCOPE_AGENT); }
__device__ __forceinline__ unsigned xb_xcc_id() { return (unsigned)__builtin_amdgcn_s_getreg((3 << 11) | 20) & 0xFu; }
#define XB_SPIN(cond, bar) do { unsigned _sp = 0; while (cond) { __builtin_amdgcn_s_sleep(1); \
    if ((++_sp & 255u) == 0u) { if (xb_ld(&(bar)[XB_TMO])) break; if (_sp > XB_SPIN_CAP) { atomicAdd(&(bar)[XB_TMO], 1u); break; } } } } while (0)

struct XcdBarrier { unsigned* bar; unsigned x; volatile LAS unsigned* st; };

__device__ __forceinline__ XcdBarrier xcd_barrier_post(unsigned* bar, volatile LAS unsigned* st) {
    XcdBarrier b; b.bar = bar; b.x = xb_xcc_id(); b.st = st;
    if (threadIdx.x == 0) (void)xb_add(&bar[XB_XCNT(b.x)], 1u);
    return b;
}
__device__ __forceinline__ void xcd_barrier_complete(unsigned* bar, unsigned x, unsigned& nloc, unsigned& nx) {
    const unsigned G = gridDim.x * gridDim.y * gridDim.z;
    unsigned sum, cnt, mine, sp = 0u;
    for (;;) {
        sum = 0u; cnt = 0u; mine = 0u;
#pragma unroll
        for (unsigned j = 0; j < 16; ++j) { const unsigned c = xb_ld(&bar[XB_XCNT(j)]); sum += c; cnt += (c > 0u) ? 1u : 0u; mine = (j == x) ? c : mine; }
        if (sum == G) break;
        __builtin_amdgcn_s_sleep(1);
        if ((++sp & 255u) == 0u) { if (xb_ld(&bar[XB_TMO])) break; if (sp > XB_SPIN_CAP) { atomicAdd(&bar[XB_TMO], 1u); break; } }
    }
    nloc = mine > 0u ? mine : 1u; nx = cnt > 0u ? cnt : 1u;
}
__device__ __forceinline__ void xcd_barrier(const XcdBarrier& b) {
    asm volatile("s_waitcnt vmcnt(0)" ::: "memory");
    __syncthreads();
    if (threadIdx.x == 0) {
        unsigned* bar = b.bar;
        __builtin_amdgcn_s_waitcnt(0);
        unsigned nloc = b.st[0], nx = b.st[1];
        if (nloc == 0u) { xcd_barrier_complete(bar, b.x, nloc, nx); b.st[0] = nloc; b.st[1] = nx; }
        const unsigned old = xb_add(&bar[XB_XSUB(b.x)], 1u);
        const unsigned gen = old / nloc;
        if (old + 1u == (gen + 1u) * nloc) {
            __builtin_amdgcn_fence(__ATOMIC_RELEASE, "agent");
            asm volatile("s_waitcnt vmcnt(0)" ::: "memory");
            const unsigned og = xb_add(&bar[XB_TOP], 1u);
            const unsigned tg = og / nx;
            if (og + 1u == (tg + 1u) * nx) xb_add(&bar[XB_TOPGEN], 1u);
            else XB_SPIN(xb_ld(&bar[XB_TOPGEN]) == tg, bar);
            __builtin_amdgcn_fence(__ATOMIC_ACQUIRE, "agent");
            xb_add(&bar[XB_XGEN(b.x)], 1u);
            asm volatile("s_waitcnt vmcnt(0)" ::: "memory");
        } else {
            XB_SPIN(xb_ld(&bar[XB_XGEN(b.x)]) == gen, bar);
            __builtin_amdgcn_fence(__ATOMIC_ACQUIRE, "agent");
            asm volatile("s_waitcnt vmcnt(0)" ::: "memory");
        }
    }
    __syncthreads();
}

struct Frame {
    LAS unsigned char* lds;
    int wave, vcu, G;
};

__device__ __forceinline__ void cvt_block(const float* W, int K, int Nsrc, int k0, int n0, bf16* WT, int drow0, LAS float* scr, int lane, const float* kscale = nullptr) {
    float wv_[32];
#pragma unroll
    for (int i = 0; i < 32; ++i) wv_[i] = W[(size_t)(k0 + 2 * i + (lane >> 5)) * Nsrc + n0 + (lane & 31)];
    if (kscale) {
#pragma unroll
        for (int i = 0; i < 32; ++i) wv_[i] *= kscale[k0 + 2 * i + (lane >> 5)]; }
#pragma unroll
    for (int i = 0; i < 32; ++i) scr[(2 * i + (lane >> 5)) * 33 + (lane & 31)] = wv_[i];
    LDS_WAIT(); asm volatile("" ::: "memory");
    const int c = lane & 7;
#pragma unroll
    for (int j = 0; j < 4; ++j) { const int n = (lane >> 3) + 8 * j; const LAS float* s = scr + (8 * c) * 33 + n;
        v4u o; o.x = pk2(s[0 * 33], s[1 * 33]); o.y = pk2(s[2 * 33], s[3 * 33]); o.z = pk2(s[4 * 33], s[5 * 33]); o.w = pk2(s[6 * 33], s[7 * 33]);
        *(v4u*)(WT + (size_t)(drow0 + n) * K + k0 + 8 * c) = o; }
    LDS_WAIT(); asm volatile("" ::: "memory");
}
__device__ __forceinline__ void cvt_block8(const float* W, int K, int Nsrc, int k0, int n0, unsigned char* WT8, int drow0, float scale, LAS float* scr, int lane) {
    float wv_[32];
#pragma unroll
    for (int i = 0; i < 32; ++i) wv_[i] = W[(size_t)(k0 + 2 * i + (lane >> 5)) * Nsrc + n0 + (lane & 31)];
#pragma unroll
    for (int i = 0; i < 32; ++i) scr[(2 * i + (lane >> 5)) * 33 + (lane & 31)] = wv_[i];
    LDS_WAIT(); asm volatile("" ::: "memory");
    const int c = lane & 7;
#pragma unroll
    for (int j = 0; j < 4; ++j) { const int n = (lane >> 3) + 8 * j; const LAS float* s = scr + (8 * c) * 33 + n;
        const f32x4 a = {s[0 * 33] * scale, s[1 * 33] * scale, s[2 * 33] * scale, s[3 * 33] * scale}, b = {s[4 * 33] * scale, s[5 * 33] * scale, s[6 * 33] * scale, s[7 * 33] * scale};
        const pg8::u32x2 w = pg8::pack8_fp8(a, b); v2u o; o.x = w.x; o.y = w.y;
        *(v2u*)(WT8 + (size_t)(drow0 + n) * K + k0 + 8 * c) = o; }
    LDS_WAIT(); asm volatile("" ::: "memory");
}
__device__ __forceinline__ int win_row(int n0) {
    if (n0 < 512) { const int m = n0 >> 8, h = (n0 & 255) >> 6, d = n0 & 63; return h * 128 + m * 64 + d; }
    if (n0 < 1024) return 1024 + (n0 - 512);
    if (n0 < 1536) return 1536 + (n0 - 1024);
    if (n0 < 1920) return 2048 + (n0 - 1536);
    if (n0 < 2176) return 2560 + (n0 - 1920);
    if (n0 < 2208) return 2944 + (n0 - 2176);
    if (n0 < 2720) return 512 + (n0 - 2208);
    if (n0 < 2848) return 2432 + (n0 - 2720);
    if (n0 < 2976) return 2816 + (n0 - 2848);
    return 3072 + (n0 - 2976);
}
__device__ __forceinline__ int win_row_p(int n0) { const int r = win_row(n0), c = r & 255; return (r & ~255) + (((c >> 5) & 1) << 7) + ((c >> 6) << 5) + (c & 31); }
struct LayerW {
    const float *norm_mix_g, *w_in, *diff_qk_g, *diff_lambda, *diff_out_g, *mla_cq_g, *w_uq, *mla_ckv_g, *w_ukv, *mla_qk_g, *swa_qk_g, *swa_sink,
                *w_ba, *w_bb, *w_bc, *w_o, *norm_ffn_g, *w_router, *w_eg, *w_eu, *w_ed;
};
__device__ __forceinline__ void p_convert(const Frame& F, const LayerW& L, unsigned char* ws) {
    int tid_ = threadIdx.x; asm volatile("" : "+v"(tid_)); const int tid = tid_, lane = tid & 63; (void)tid; (void)lane;
    LAS float* scr = (LAS float*)(F.lds + RING_OFF + F.wave * 16384);
    const int gw = F.vcu * NWAVES + F.wave, NGW = F.G * NWAVES;
    constexpr int I_IN = 16 * 189, I_UQ = 6 * 24, I_UKV = 4 * 32, I_BR = 8 * 32, I_O = 16 * 32, I_E = 16 * 512;
    constexpr int NITEMS = I_IN + I_UQ + I_UKV + 3 * I_BR + I_O + 3 * I_E;
    bf16* win = (bf16*)(ws + WS_WIN);
    for (int it = gw; it < NITEMS; it += NGW) {
        int r = it;
        if (r < I_IN) { const int kb = r / 189, nb = r % 189;
            if (nb < 93) cvt_block(L.w_in, 1024, IN_COLS, kb * 64, nb * 32, win, win_row_p(nb * 32), scr, lane);
            else cvt_block8(L.w_in, 1024, IN_COLS, kb * 64, nb * 32, ws + WS_WG8, nb * 32 - 2976, W8_SCALE, scr, lane);
            continue; } r -= I_IN;
        if (r < I_UQ) { const int kb = r / 24, nb = r % 24; cvt_block(L.w_uq, 384, 768, kb * 64, nb * 32, (bf16*)(ws + WS_WUQ), nb * 32, scr, lane, L.mla_cq_g); continue; } r -= I_UQ;
        if (r < I_UKV) { const int kb = r / 32, nb = r % 32, n0 = nb * 32, h = n0 >> 7, jj = n0 & 127; const int dr = (h >> 1) * 256 + 128 * ((jj & 63) >> 5) + 32 * (jj < 64 ? (h & 1) : 2 + (h & 1));
            cvt_block(L.w_ukv, 256, 1024, kb * 64, n0, (bf16*)(ws + WS_WUKV), dr, scr, lane, L.mla_ckv_g); continue; } r -= I_UKV;
        if (r < I_BR) { const int kb = r / 32, nb = r % 32; cvt_block(L.w_ba, 512, 1024, kb * 64, nb * 32, (bf16*)(ws + WS_WBA), nb * 32, scr, lane); continue; } r -= I_BR;
        if (r < I_BR) { const int kb = r / 32, nb = r % 32; cvt_block(L.w_bb, 512, 1024, kb * 64, nb * 32, (bf16*)(ws + WS_WBB), nb * 32, scr, lane); continue; } r -= I_BR;
        if (r < I_BR) { const int kb = r / 32, nb = r % 32; cvt_block(L.w_bc, 512, 1024, kb * 64, nb * 32, (bf16*)(ws + WS_WBC), nb * 32, scr, lane); continue; } r -= I_BR;
        if (r < I_O) { const int kb = r / 32, nb = r % 32; cvt_block(L.w_o, 1024, 1024, kb * 64, nb * 32, (bf16*)(ws + WS_WO), nb * 32, scr, lane); continue; } r -= I_O;
        { const int w = r / I_E, q = r % I_E, e = q / 512, qq = q % 512, kb = qq / 32, nb = qq % 32, n0 = nb * 32;
          const int dr = (n0 >> 7) * 256 + (n0 & 127);
          if (w == 0) cvt_block8(L.w_eg + (size_t)e * 1024 * 1024, 1024, 1024, kb * 64, n0, ws + WS_WGU + (size_t)e * 2048 * 1024, dr, W8_SCALE, scr, lane);
          else if (w == 1) cvt_block8(L.w_eu + (size_t)e * 1024 * 1024, 1024, 1024, kb * 64, n0, ws + WS_WGU + (size_t)e * 2048 * 1024, dr + 128, W8_SCALE, scr, lane);
          else cvt_block8(L.w_ed + (size_t)e * 1024 * 1024, 1024, 1024, kb * 64, n0, ws + WS_WD + (size_t)e * 1024 * 1024, n0, W8_SCALE, scr, lane); }
    }
    { const int gt = (F.vcu * NWAVES + F.wave) * 64 + lane, NGT = NGW * 64;
      unsigned z_ = 0u; asm volatile("" : "+v"(z_));
      for (int i = gt; i < 96 * 1024 / 8; i += NGT) { const int blk = i / (32 * 1024 / 8), off = i % (32 * 1024 / 8); const int r0 = 2816 + (blk == 0 ? 192 : (blk == 1 ? 96 : 224));
          *(v4u*)(win + (size_t)r0 * 1024 + (size_t)off * 8) = (v4u){z_, z_, z_, z_}; }
      if (gt < 256) { const int gi = gt >> 6, d = gt & 63; const float QS_ = 0.125f * LOG2E;
          const float v = gi == 0 ? L.diff_qk_g[d] * QS_ : (gi == 1 ? L.swa_qk_g[d] * QS_ : (gi == 2 ? L.diff_qk_g[64 + d] : L.swa_qk_g[64 + d]));
          ((float*)(ws + WS_GT))[gt] = v; } }
}

__device__ __forceinline__ unsigned pk4_fp8(f32x4 y) {
    y.x = fminf(fmaxf(y.x, -448.f), 448.f); y.y = fminf(fmaxf(y.y, -448.f), 448.f); y.z = fminf(fmaxf(y.z, -448.f), 448.f); y.w = fminf(fmaxf(y.w, -448.f), 448.f);
    int w = 0; w = __builtin_amdgcn_cvt_pk_fp8_f32(y.x, y.y, w, false); w = __builtin_amdgcn_cvt_pk_fp8_f32(y.z, y.w, w, true); return (unsigned)w; }
__device__ __forceinline__ void p_norm1(const Frame& F, const float* x, const float* g, bf16* h, unsigned char* h8) {
    int tid_ = threadIdx.x; asm volatile("" : "+v"(tid_)); const int tid = tid_, lane = tid & 63; (void)tid; (void)lane;
    const int gw = F.vcu * NWAVES + F.wave, NGW = F.G * NWAVES;
    f32x4 gv[4];
#pragma unroll
    for (int j = 0; j < 4; ++j) gv[j] = *((const f32x4*)g + lane + 64 * j);
    f32x4 v[2][4];
#pragma unroll
    for (int rr = 0; rr < 2; ++rr) { const f32x4* xr = (const f32x4*)(x + (size_t)(gw * 2 + rr) * DM) + lane;
#pragma unroll
        for (int j = 0; j < 4; ++j) v[rr][j] = xr[64 * j]; }
    for (int row0 = gw * 2; row0 < T; row0 += NGW * 2) {
        f32x4 nv[2][4];
        { const int rn = (row0 + NGW * 2 < T) ? row0 + NGW * 2 : row0;
#pragma unroll
        for (int rr = 0; rr < 2; ++rr) { const f32x4* xr = (const f32x4*)(x + (size_t)(rn + rr) * DM) + lane;
#pragma unroll
            for (int j = 0; j < 4; ++j) nv[rr][j] = xr[64 * j]; } }
#pragma unroll
        for (int rr = 0; rr < 2; ++rr) { float s = 0.f;
#pragma unroll
            for (int j = 0; j < 4; ++j) s += (v[rr][j].x * v[rr][j].x + v[rr][j].y * v[rr][j].y) + (v[rr][j].z * v[rr][j].z + v[rr][j].w * v[rr][j].w);
            const float rs = 1.0f / sqrtf(wave_sum(s) * (1.0f / DM) + EPS);
            v2u* o8 = (v2u*)(h + (size_t)(row0 + rr) * DM) + lane; unsigned* q8 = (unsigned*)(h8 + (size_t)(row0 + rr) * DM) + lane;
#pragma unroll
            for (int j = 0; j < 4; ++j) { const f32x4 y = {v[rr][j].x * rs * gv[j].x, v[rr][j].y * rs * gv[j].y, v[rr][j].z * rs * gv[j].z, v[rr][j].w * rs * gv[j].w};
                v2u o; o.x = pk2(y.x, y.y); o.y = pk2(y.z, y.w); o8[64 * j] = o; q8[64 * j] = pk4_fp8(y); } }
#pragma unroll
        for (int rr = 0; rr < 2; ++rr)
#pragma unroll
            for (int j = 0; j < 4; ++j) v[rr][j] = nv[rr][j];
    }
}

__device__ __forceinline__ float grp8_sum(float v) { v = xor_add<1>(v); v = xor_add<2>(v); v = xor_add<4>(v); return v; }
struct U8 { float f[8]; };
__device__ __forceinline__ U8 ld8bf(const bf16* p) { const v4u w = *(const v4u*)p; U8 r; r.f[0] = bflo(w.x); r.f[1] = bfhi(w.x); r.f[2] = bflo(w.y); r.f[3] = bfhi(w.y); r.f[4] = bflo(w.z); r.f[5] = bfhi(w.z); r.f[6] = bflo(w.w); r.f[7] = bfhi(w.w); return r; }
__device__ __forceinline__ void st8bf(bf16* p, const U8& r) { v4u w; w.x = pk2(r.f[0], r.f[1]); w.y = pk2(r.f[2], r.f[3]); w.z = pk2(r.f[4], r.f[5]); w.w = pk2(r.f[6], r.f[7]); *(v4u*)p = w; }
__device__ __forceinline__ float ss8(const U8& r) { float s = 0.f;
#pragma unroll
    for (int i = 0; i < 8; ++i) s += r.f[i] * r.f[i];
    return s; }
__device__ __forceinline__ void p_prep1(const Frame& F, const LayerW& L, unsigned char* ws) {
    int tid_ = threadIdx.x; asm volatile("" : "+v"(tid_)); const int tid = tid_, lane = tid & 63; (void)tid; (void)lane;
    const int gw = F.vcu * NWAVES + F.wave, NGW = F.G * NWAVES;
    const float QS = 0.125f * LOG2E;
    float gqa[8], gka[8], gqc[8], gkc[8], gcq[8], gckv[8];
#pragma unroll
    for (int i = 0; i < 8; ++i) { const int d = (lane & 7) * 8 + i;
        gqa[i] = L.diff_qk_g[d] * QS; gka[i] = L.diff_qk_g[64 + d]; gqc[i] = L.swa_qk_g[d] * QS; gkc[i] = L.swa_qk_g[64 + d];
        gcq[i] = lane < 48 ? L.mla_cq_g[lane * 8 + i] : 0.f; gckv[i] = lane < 32 ? L.mla_ckv_g[lane * 8 + i] : 0.f; }
    bf16* QA = (bf16*)(ws + WS_QA); bf16* KA = (bf16*)(ws + WS_KA); bf16* QC = (bf16*)(ws + WS_QC); bf16* CQKC = (bf16*)(ws + WS_CQKC); bf16* CKV = (bf16*)(ws + WS_CKV);
    for (int row0 = gw * 2; row0 < T; row0 += NGW * 2) {
        U8 a[2], b[2], c[2], d[2], e[2];
#pragma unroll
        for (int rr = 0; rr < 2; ++rr) { const int row = row0 + rr; const size_t o512 = (size_t)row * 512 + lane * 8;
            a[rr] = ld8bf(QA + o512); b[rr] = ld8bf(KA + o512); c[rr] = ld8bf(QC + o512); d[rr] = ld8bf(CQKC + o512);
            if (lane < 32) e[rr] = ld8bf(CKV + (size_t)row * 256 + lane * 8); else {
#pragma unroll
                for (int i = 0; i < 8; ++i) e[rr].f[i] = 0.f; } }
#pragma unroll
        for (int rr = 0; rr < 2; ++rr) { const int row = row0 + rr; const size_t o512 = (size_t)row * 512 + lane * 8;
            const float ra = 1.0f / sqrtf(grp8_sum(ss8(a[rr])) * (1.0f / 64) + EPS);
            const float rb = 1.0f / sqrtf(grp8_sum(ss8(b[rr])) * (1.0f / 64) + EPS);
            const float rc = 1.0f / sqrtf(grp8_sum(ss8(c[rr])) * (1.0f / 64) + EPS);
            const float sd = grp8_sum(ss8(d[rr]));
            float tot = lane < 48 ? sd : 0.f; tot = xor_add<8>(tot); tot = xor_add<16>(tot); tot = xor_add<32>(tot);
            const float rd = lane < 48 ? 1.0f / sqrtf(tot * (1.0f / 384) + EPS) : 1.0f / sqrtf(sd * (1.0f / 64) + EPS);
            float se = grp8_sum(ss8(e[rr])); se = xor_add<8>(se); se = xor_add<16>(se);
            const float re = 1.0f / sqrtf(se * (1.0f / 256) + EPS);
#pragma unroll
            for (int i = 0; i < 8; ++i) { a[rr].f[i] *= ra * gqa[i]; b[rr].f[i] *= rb * gka[i]; c[rr].f[i] *= rc * gqc[i]; d[rr].f[i] *= rd * (lane < 48 ? gcq[i] : gkc[i]); e[rr].f[i] *= re * gckv[i]; }
            st8bf(QA + o512, a[rr]); st8bf(KA + o512, b[rr]); st8bf(QC + o512, c[rr]); st8bf(CQKC + o512, d[rr]);
            if (lane < 32) st8bf(CKV + (size_t)row * 256 + lane * 8, e[rr]); }
    }
}

__device__ __forceinline__ void p_prep2(const Frame& F, const LayerW& L, unsigned char* ws, const int* positions) {
    int tid_ = threadIdx.x; asm volatile("" : "+v"(tid_)); const int tid = tid_, lane = tid & 63; (void)tid; (void)lane;
    const int gw = F.vcu * NWAVES + F.wave, NGW = F.G * NWAVES, h = lane >> 3, j = lane & 7;
    float gkn[8], gkr[4], invf[4];
#pragma unroll
    for (int i = 0; i < 8; ++i) gkn[i] = L.mla_qk_g[96 + 8 * j + i];
#pragma unroll
    for (int i = 0; i < 4; ++i) { gkr[i] = L.mla_qk_g[96 + 64 + 4 * j + i];
        const int fi = 4 * (j & 3) + i; invf[i] = (float)(exp2(-(double)fi * (13.287712379549449 / 16.0)) * 0.15915494309189535); }
    const bf16* KVR = (const bf16*)(ws + WS_KVR); const bf16* VCKR = (const bf16*)(ws + WS_VCKR); bf16* KB = (bf16*)(ws + WS_KB);
    for (int row0 = gw * 2; row0 < T; row0 += NGW * 2) {
        float posf[2]; U8 kn[2]; v2u kw[2];
#pragma unroll
        for (int rr = 0; rr < 2; ++rr) { const int row = row0 + rr; posf[rr] = (float)positions[row];
            kn[rr] = ld8bf(KVR + (size_t)row * 1024 + h * 64 + 8 * j); kw[rr] = *(const v2u*)(VCKR + (size_t)row * 256 + 128 + 4 * j); }
#pragma unroll
        for (int rr = 0; rr < 2; ++rr) { const int row = row0 + rr;
            float cs[4], sn[4];
#pragma unroll
            for (int i = 0; i < 4; ++i) { const double tr = (double)posf[rr] * (double)invf[i]; const float fr = (float)(tr - floor(tr)); cs[i] = __builtin_amdgcn_cosf(fr); sn[i] = __builtin_amdgcn_sinf(fr); }
            float kr_[4] = {bflo(kw[rr].x), bfhi(kw[rr].x), bflo(kw[rr].y), bfhi(kw[rr].y)}, ko[4];
#pragma unroll
            for (int i = 0; i < 4; ++i) { const float other = xor_getf<4>(kr_[i]); ko[i] = (j < 4) ? (kr_[i] * cs[i] - other * sn[i]) : (other * sn[i] + kr_[i] * cs[i]); }
            const float sk = ss8(kn[rr]) + (ko[0] * ko[0] + ko[1] * ko[1]) + (ko[2] * ko[2] + ko[3] * ko[3]);
            const float rk = 1.0f / sqrtf(grp8_sum(sk) * (1.0f / 96) + EPS);
#pragma unroll
            for (int i = 0; i < 8; ++i) kn[rr].f[i] *= rk * gkn[i];
            bf16* krow = KB + (size_t)row * 768 + h * 96;
            st8bf(krow + 8 * j, kn[rr]);
            { v2u w; w.x = pk2(ko[0] * rk * gkr[0], ko[1] * rk * gkr[1]); w.y = pk2(ko[2] * rk * gkr[2], ko[3] * rk * gkr[3]); *(v2u*)(krow + 64 + 4 * j) = w; } }
    }
}

__device__ __forceinline__ void p_tile_minmax(const Frame& F, unsigned char* ws, const int* positions) {
    int tid_ = threadIdx.x; asm volatile("" : "+v"(tid_)); const int lane = tid_ & 63;
    const int gw = F.vcu * NWAVES + F.wave, NGW = F.G * NWAVES;
    float* tmm = (float*)(ws + WS_TMM);
    for (int tl = gw; tl < T / 64; tl += NGW) {
        const float p = (float)positions[tl * 64 + lane];
        float hi = p, lo = -p;
        hi = xor_max<1>(hi); hi = xor_max<2>(hi); hi = xor_max<4>(hi); hi = xor_max<8>(hi); hi = xor_max<16>(hi); hi = xor_max<32>(hi);
        lo = xor_max<1>(lo); lo = xor_max<2>(lo); lo = xor_max<4>(lo); lo = xor_max<8>(lo); lo = xor_max<16>(lo); lo = xor_max<32>(lo);
        if (lane == 0) { tmm[tl * 2] = -lo; tmm[tl * 2 + 1] = hi; }
    }
}

__device__ __forceinline__ void p_h_to_fp8(const Frame& F, unsigned char* ws) {
    int tid_ = threadIdx.x; asm volatile("" : "+v"(tid_));
    const size_t gt = (size_t)(F.vcu * NWAVES * 64) + tid_, NGT = (size_t)F.G * NWAVES * 64;
    const v4u* src = (const v4u*)(ws + WS_H); v2u* dst = (v2u*)(ws + WS_H8);
    for (size_t i = gt; i < (size_t)T * DM / 8; i += NGT * 4) {
        v4u x[4];
#pragma unroll
        for (int k = 0; k < 4; ++k) if (i + k * NGT < (size_t)T * DM / 8) x[k] = src[i + k * NGT];
#pragma unroll
        for (int k = 0; k < 4; ++k) if (i + k * NGT < (size_t)T * DM / 8) {
            const f32x4 a0 = {bflo(x[k].x), bfhi(x[k].x), bflo(x[k].y), bfhi(x[k].y)}, a1 = {bflo(x[k].z), bfhi(x[k].z), bflo(x[k].w), bfhi(x[k].w)};
            const pg8::u32x2 w = pg8::pack8_fp8(a0, a1); v2u o; o.x = w.x; o.y = w.y; dst[i + k * NGT] = o; }
    }
}

namespace att {
__device__ __forceinline__ int crow(int r, int hi) { return (r & 3) + 8 * (r >> 2) + 4 * hi; }
#define ATT_SBAR() __builtin_amdgcn_sched_barrier(0)
typedef float f32x2_t __attribute__((ext_vector_type(2))); typedef __bf16 bf16x2_t __attribute__((ext_vector_type(2)));
__device__ __forceinline__ unsigned cvtpk(float lo, float hi) { f32x2_t v = {lo, hi}; bf16x2_t b = __builtin_convertvector(v, bf16x2_t); return __builtin_bit_cast(unsigned, b); }

struct Args {
    const bf16* Q; const bf16* K; const bf16* V;
    int pq, pk, pv;
    const int* pos;
    float slope2, sink2;
    float mfix;
    const float* qg;
};
typedef short v4i16_t __attribute__((ext_vector_type(4)));
__device__ __forceinline__ s16x4 vtr(const LAS unsigned char* p) { return __builtin_bit_cast(s16x4, __builtin_amdgcn_ds_read_tr16_b64_v4i16((LAS v4i16_t*)p)); }
__device__ __forceinline__ float max3f(float a, float b, float c) { return __builtin_fmaxf(__builtin_fmaxf(a, b), c); }
template <int DQK, int DV, int MODE, int ABL = 0>
__device__ __forceinline__ void attn_core(const Args& A, int q0, unsigned long long tmask, LAS unsigned char* lds, float (&res)[DV / 32][16]) {
    constexpr int KSTR = DQK * 2 + 16, KBYTES = 64 * KSTR, VBYTES = 64 * DV * 2, PBYTES = 256;
    constexpr int BUF = KBYTES + VBYTES + PBYTES;
    constexpr int CPR = DQK / 8, NKP = 64 * CPR, KP = (NKP + 511) / 512, VP = (64 * DV / 8) / 512, ND0 = DV / 32, NKS = DQK / 16;
    constexpr float THR = 6.0f;
    static_assert(2 * BUF + 8 * 256 <= ATT_STASH_OFF, "attention LDS");
    int tid_ = threadIdx.x; asm volatile("" : "+v"(tid_));
    const int tid = tid_, lane = tid & 63, wid = __builtin_amdgcn_readfirstlane(tid >> 6), r32 = lane & 31, hi = lane >> 5;
    LAS float* wsf = (LAS float*)(lds + 2 * BUF) + wid * 64;

    bf16x8 qr[NKS];
#pragma unroll
    for (int d0 = 0; d0 < NKS; ++d0) qr[d0] = *(const bf16x8*)(A.Q + (size_t)(q0 + wid * 32 + r32) * A.pq + d0 * 16 + hi * 8);
    float pqf = 0.f;
    if (MODE == 1) pqf = (float)A.pos[q0 + wid * 32 + r32];
    if (MODE == 2) pqf = (float)(q0 + wid * 32 + r32);

    f32x16 o[ND0];
#pragma unroll
    for (int d = 0; d < ND0; ++d)
#pragma unroll
        for (int r = 0; r < 16; ++r) o[d][r] = 0.f;
    float l_reg = (MODE == 2 && hi == 0) ? __builtin_amdgcn_exp2f(A.sink2 - A.mfix) : 0.f;
    f32x16 negm;
#pragma unroll
    for (int r = 0; r < 16; ++r) negm[r] = -A.mfix;

    bf16x8 sk[KP], sv[VP]; float spos = 0.f;
    unsigned gk_off[KP], lk_off[KP], gv_off[VP], lv_off[VP];
#pragma unroll
    for (int i = 0; i < KP; ++i) { const int p = tid + 512 * i, row = p / CPR, ch = p % CPR; gk_off[i] = (unsigned)(row * A.pk + ch * 8) * 2u; lk_off[i] = (unsigned)(row * KSTR + ch * 16); }
#pragma unroll
    for (int i = 0; i < VP; ++i) { const int p = tid + 512 * i, db = p >> 8, row = (p & 255) >> 2, c4 = p & 3; gv_off[i] = (unsigned)(row * A.pv + db * 32 + c4 * 8) * 2u;
        lv_off[i] = (unsigned)(KBYTES + db * 4096 + (row >> 4) * 1024 + (row & 15) * 64 + c4 * 16); }
#define ATT_SLOAD(t) do { const int k0_ = (t) * 64; const char* kb_ = (const char*)(A.K + (size_t)k0_ * A.pk); const char* vb_ = (const char*)(A.V + (size_t)k0_ * A.pv); \
    _Pragma("unroll") for (int i = 0; i < KP; ++i) { if (tid + 512 * i < NKP) sk[i] = *(const bf16x8*)(kb_ + gk_off[i]); } \
    _Pragma("unroll") for (int i = 0; i < VP; ++i) sv[i] = *(const bf16x8*)(vb_ + gv_off[i]); \
    if (MODE == 1) { if (tid < 64) spos = (float)A.pos[k0_ + tid]; } if (MODE == 2) { spos = (float)(k0_ + tid); } } while (0)
#define ATT_SWRITE(b) do { LAS unsigned char* base_ = lds + (b) * BUF; \
    _Pragma("unroll") for (int i = 0; i < KP; ++i) { if (tid + 512 * i < NKP) *(LAS bf16x8*)(base_ + lk_off[i]) = sk[i]; } \
    _Pragma("unroll") for (int i = 0; i < VP; ++i) *(LAS bf16x8*)(base_ + lv_off[i]) = sv[i]; \
    if (MODE != 0) { if (tid < 64) *(LAS float*)(base_ + KBYTES + VBYTES + tid * 4) = spos; } } while (0)
#define ATT_VRD(VF, d) do { const LAS unsigned char* vp_ = vbase + (d) * 4096; \
    _Pragma("unroll") for (int ks = 0; ks < 4; ++ks) { VF[2 * ks] = vtr(vp_ + ks * 1024); VF[2 * ks + 1] = vtr(vp_ + ks * 1024 + 512); } } while (0)
#define ATT_PK(L, H) (bf16x8){L[0], L[1], L[2], L[3], H[0], H[1], H[2], H[3]}
#define ATT_MMA(VF, d) do { _Pragma("unroll") for (int ks = 0; ks < 4; ++ks) { if (ABL == 2) o[d][ks] += __builtin_bit_cast(float, (int)pa[ks][0]) + __builtin_bit_cast(float, (int)VF[2 * ks][0] + (int)VF[2 * ks + 1][0]); else o[d] = __builtin_amdgcn_mfma_f32_32x32x16_bf16(pa[ks], ATT_PK(VF[2 * ks], VF[2 * ks + 1]), o[d], 0, 0, 0); } } while (0)

    int t = __builtin_ctzll(tmask); tmask &= tmask - 1;
    ATT_SLOAD(t); ATT_SWRITE(0); __syncthreads();
    for (int cur = 0;; cur ^= 1) {
        const bool more = tmask != 0ull; const int tn = more ? __builtin_ctzll(tmask) : 0; tmask &= tmask - 1;
        LAS unsigned char* bufp = lds + cur * BUF;
        if (more && ABL != 4) ATT_SLOAD(tn);
        f32x16 p0, p1;
        const LAS unsigned char* kb = bufp + r32 * KSTR + hi * 16;
#pragma unroll
        for (int d0 = 0; d0 < NKS; ++d0) {
            const bf16x8 b0 = *(const LAS bf16x8*)(kb + d0 * 32);
            const bf16x8 b1 = *(const LAS bf16x8*)(kb + 32 * KSTR + d0 * 32);
            if (ABL == 2) { if (d0 == 0) { p0 = negm; p1 = negm; } p0[d0] += __builtin_bit_cast(float, (int)b0[0]); p1[d0] += __builtin_bit_cast(float, (int)b1[0]); }
            else if (d0 == 0) { p0 = __builtin_amdgcn_mfma_f32_32x32x16_bf16(b0, qr[0], negm, 0, 0, 0); p1 = __builtin_amdgcn_mfma_f32_32x32x16_bf16(b1, qr[0], negm, 0, 0, 0); }
            else { p0 = __builtin_amdgcn_mfma_f32_32x32x16_bf16(b0, qr[d0], p0, 0, 0, 0); p1 = __builtin_amdgcn_mfma_f32_32x32x16_bf16(b1, qr[d0], p1, 0, 0, 0); }
        }
        const LAS unsigned char* vbase = bufp + KBYTES + ((lane >> 4) & 1) * 32 + (lane & 3) * 8 + (4 * hi + ((lane & 15) >> 2)) * 64;
        s16x4 vfa[8], vfb[8];
        ATT_VRD(vfa, 0);
        if (MODE != 0) {
            const LAS float* pk = (const LAS float*)(bufp + KBYTES + VBYTES);
#pragma unroll
            for (int g = 0; g < 4; ++g) {
                const f32x4 k0v = *(const LAS f32x4*)(pk + 8 * g + 4 * hi), k1v = *(const LAS f32x4*)(pk + 32 + 8 * g + 4 * hi);
#pragma unroll
                for (int i = 0; i < 4; ++i) {
                    const float d0f = fabsf(pqf - k0v[i]), d1f = fabsf(pqf - k1v[i]);
                    float s0 = fmaf(-A.slope2, d0f, p0[4 * g + i]), s1 = fmaf(-A.slope2, d1f, p1[4 * g + i]);
                    if (MODE == 2) { s0 = d0f <= 128.0f ? s0 : -1e30f; s1 = d1f <= 128.0f ? s1 : -1e30f; }
                    p0[4 * g + i] = s0; p1[4 * g + i] = s1;
                }
            }
        }
        float ps0 = 0.f, ps1 = 0.f, ps2 = 0.f, ps3 = 0.f;
#pragma unroll
        for (int r = 0; r < 16; r += 4) {
            if (ABL != 1) { p0[r] = __builtin_amdgcn_exp2f(p0[r]); p0[r + 1] = __builtin_amdgcn_exp2f(p0[r + 1]); p0[r + 2] = __builtin_amdgcn_exp2f(p0[r + 2]); p0[r + 3] = __builtin_amdgcn_exp2f(p0[r + 3]);
            p1[r] = __builtin_amdgcn_exp2f(p1[r]); p1[r + 1] = __builtin_amdgcn_exp2f(p1[r + 1]); p1[r + 2] = __builtin_amdgcn_exp2f(p1[r + 2]); p1[r + 3] = __builtin_amdgcn_exp2f(p1[r + 3]); }
            ps0 += p0[r] + p1[r]; ps1 += p0[r + 1] + p1[r + 1]; ps2 += p0[r + 2] + p1[r + 2]; ps3 += p0[r + 3] + p1[r + 3];
        }
        l_reg += (ps0 + ps1) + (ps2 + ps3);
        bf16x8 pa[4];
#pragma unroll
        for (int s = 0; s < 2; ++s) {
            v4u w0 = {cvtpk(p0[8 * s + 0], p0[8 * s + 1]), cvtpk(p0[8 * s + 2], p0[8 * s + 3]), cvtpk(p0[8 * s + 4], p0[8 * s + 5]), cvtpk(p0[8 * s + 6], p0[8 * s + 7])};
            v4u w1 = {cvtpk(p1[8 * s + 0], p1[8 * s + 1]), cvtpk(p1[8 * s + 2], p1[8 * s + 3]), cvtpk(p1[8 * s + 4], p1[8 * s + 5]), cvtpk(p1[8 * s + 6], p1[8 * s + 7])};
            pa[s] = __builtin_bit_cast(bf16x8, w0); pa[2 + s] = __builtin_bit_cast(bf16x8, w1);
        }
        if (ND0 == 2) { ATT_VRD(vfb, 1); ATT_MMA(vfa, 0); ATT_MMA(vfb, 1); }
        else { ATT_VRD(vfb, 1); ATT_MMA(vfa, 0); ATT_VRD(vfa, 2); ATT_MMA(vfb, 1); ATT_VRD(vfb, 3); ATT_MMA(vfa, 2); ATT_MMA(vfb, 3); }
        if (more && ABL != 4) ATT_SWRITE(cur ^ 1);
        if (ABL != 3) __syncthreads();
        if (!more) break;
        t = tn;
    }
#undef ATT_SLOAD
#undef ATT_SWRITE
#undef ATT_VRD
#undef ATT_PK
#undef ATT_MMA
    { const float lt = xor_add<32>(l_reg); if (hi == 0) wsf[32 + r32] = 1.0f / lt; }
    LDS_WAIT();
#pragma unroll
    for (int g = 0; g < 4; ++g) {
        const f32x4 l0 = *(const LAS f32x4*)(wsf + 32 + 8 * g + 4 * hi);
#pragma unroll
        for (int d = 0; d < ND0; ++d)
#pragma unroll
            for (int i = 0; i < 4; ++i) res[d][4 * g + i] = o[d][4 * g + i] * l0[i];
    }
    LDS_WAIT();
    __syncthreads();
}
template <int DQK, int DV, int ABL = 0>
__device__ __forceinline__ void attn_core_p(const Args& A, int q0, unsigned long long tmask, LAS unsigned char* lds, float (&res)[DV / 32][16]) {
    constexpr int KSTR = DQK * 2 + 16, KBYTES = 64 * KSTR, VBYTES = 64 * DV * 2;
    constexpr int CPR = DQK / 8, NKP = 64 * CPR, KP = (NKP + 511) / 512, VP = (64 * DV / 8) / 512, ND0 = DV / 32, NKS = DQK / 16;
    constexpr int KOFF = 0, VOFF = 2 * KBYTES, WOFF = VOFF + 3 * VBYTES;
    static_assert(WOFF + 8 * 256 <= ATT_STASH_OFF, "attention LDS");
    int tid_ = threadIdx.x; asm volatile("" : "+v"(tid_));
    const int tid = tid_, lane = tid & 63, wid = __builtin_amdgcn_readfirstlane(tid >> 6), r32 = lane & 31, hi = lane >> 5;
    LAS float* wsf = (LAS float*)(lds + WOFF) + wid * 64;
    bf16x8 qr[NKS];
#pragma unroll
    for (int d0 = 0; d0 < NKS; ++d0) qr[d0] = *(const bf16x8*)(A.Q + (size_t)(q0 + wid * 32 + r32) * A.pq + d0 * 16 + hi * 8);
    f32x16 o[ND0];
#pragma unroll
    for (int d = 0; d < ND0; ++d)
#pragma unroll
        for (int r = 0; r < 16; ++r) o[d][r] = 0.f;
    float l_reg = 0.f;
    f32x16 negm;
#pragma unroll
    for (int r = 0; r < 16; ++r) negm[r] = -A.mfix;
    bf16x8 sk[KP], sv[VP];
    unsigned gk_off[KP], lk_off[KP], gv_off[VP], lv_off[VP];
#pragma unroll
    for (int i = 0; i < KP; ++i) { const int p = tid + 512 * i, row = p / CPR, ch = p % CPR; gk_off[i] = (unsigned)(row * A.pk + ch * 8) * 2u; lk_off[i] = (unsigned)(row * KSTR + ch * 16); }
#pragma unroll
    for (int i = 0; i < VP; ++i) { const int p = tid + 512 * i, db = p >> 8, row = (p & 255) >> 2, c4 = p & 3; gv_off[i] = (unsigned)(row * A.pv + db * 32 + c4 * 8) * 2u;
        lv_off[i] = (unsigned)(db * 4096 + (row >> 4) * 1024 + (row & 15) * 64 + c4 * 16); }
#define ATP_SLOAD(t) do { const int k0_ = (t) * 64; const char* kb_ = (const char*)(A.K + (size_t)k0_ * A.pk); const char* vb_ = (const char*)(A.V + (size_t)k0_ * A.pv); \
    _Pragma("unroll") for (int i = 0; i < KP; ++i) { if (tid + 512 * i < NKP) sk[i] = *(const bf16x8*)(kb_ + gk_off[i]); } \
    _Pragma("unroll") for (int i = 0; i < VP; ++i) sv[i] = *(const bf16x8*)(vb_ + gv_off[i]); } while (0)
#define ATP_SWRITE(kslot, vslot) do { LAS unsigned char* kb_ = lds + KOFF + (kslot) * KBYTES; LAS unsigned char* vb_ = lds + VOFF + (vslot) * VBYTES; \
    _Pragma("unroll") for (int i = 0; i < KP; ++i) { if (tid + 512 * i < NKP) *(LAS bf16x8*)(kb_ + lk_off[i]) = sk[i]; } \
    _Pragma("unroll") for (int i = 0; i < VP; ++i) *(LAS bf16x8*)(vb_ + lv_off[i]) = sv[i]; } while (0)
#define ATP_QKT(P0, P1, kslot) do { const LAS unsigned char* kb_ = lds + KOFF + (kslot) * KBYTES + r32 * KSTR + hi * 16; \
    _Pragma("unroll") for (int d0 = 0; d0 < NKS; ++d0) { const bf16x8 b0_ = (ABL == 5 || ABL == 7) ? qr[d0] : *(const LAS bf16x8*)(kb_ + d0 * 32); const bf16x8 b1_ = (ABL == 5 || ABL == 7) ? qr[NKS - 1 - d0] : *(const LAS bf16x8*)(kb_ + 32 * KSTR + d0 * 32); \
        if (ABL == 2) { if (d0 == 0) { P0 = negm; P1 = negm; } P0[d0] += __builtin_bit_cast(float, (int)b0_[0]); P1[d0] += __builtin_bit_cast(float, (int)b1_[0]); } \
        else if (d0 == 0) { P0 = __builtin_amdgcn_mfma_f32_32x32x16_bf16(b0_, qr[0], negm, 0, 0, 0); P1 = __builtin_amdgcn_mfma_f32_32x32x16_bf16(b1_, qr[0], negm, 0, 0, 0); } \
        else { P0 = __builtin_amdgcn_mfma_f32_32x32x16_bf16(b0_, qr[d0], P0, 0, 0, 0); P1 = __builtin_amdgcn_mfma_f32_32x32x16_bf16(b1_, qr[d0], P1, 0, 0, 0); } } } while (0)
#define ATP_SOFT(P0, P1) do { \
    if (ABL != 1) { _Pragma("unroll") for (int r = 0; r < 16; ++r) { P0[r] = __builtin_amdgcn_exp2f(P0[r]); P1[r] = __builtin_amdgcn_exp2f(P1[r]); } } \
    _Pragma("unroll") for (int s_ = 0; s_ < 2; ++s_) { \
        v4u w0_ = {cvtpk(P0[8 * s_ + 0], P0[8 * s_ + 1]), cvtpk(P0[8 * s_ + 2], P0[8 * s_ + 3]), cvtpk(P0[8 * s_ + 4], P0[8 * s_ + 5]), cvtpk(P0[8 * s_ + 6], P0[8 * s_ + 7])}; \
        v4u w1_ = {cvtpk(P1[8 * s_ + 0], P1[8 * s_ + 1]), cvtpk(P1[8 * s_ + 2], P1[8 * s_ + 3]), cvtpk(P1[8 * s_ + 4], P1[8 * s_ + 5]), cvtpk(P1[8 * s_ + 6], P1[8 * s_ + 7])}; \
        pa[s_] = __builtin_bit_cast(bf16x8, w0_); pa[2 + s_] = __builtin_bit_cast(bf16x8, w1_); } } while (0)
#define ATP_SUM(P0, P1) do { float ps0 = 0.f, ps1 = 0.f, ps2 = 0.f, ps3 = 0.f; \
    _Pragma("unroll") for (int r = 0; r < 16; r += 4) { ps0 += P0[r] + P1[r]; ps1 += P0[r + 1] + P1[r + 1]; ps2 += P0[r + 2] + P1[r + 2]; ps3 += P0[r + 3] + P1[r + 3]; } \
    l_reg += (ps0 + ps1) + (ps2 + ps3); } while (0)
#define ATP_VRD(VF, vslot, d) do { const LAS unsigned char* vp_ = lds + VOFF + (vslot) * VBYTES + vlane + (d) * 4096; \
    _Pragma("unroll") for (int ks = 0; ks < 4; ++ks) { if (ABL == 6 || ABL == 7) { VF[2 * ks] = __builtin_bit_cast(s16x4, (unsigned long long)(uintptr_t)vp_ * (ks + 1)); VF[2 * ks + 1] = __builtin_bit_cast(s16x4, (unsigned long long)(uintptr_t)vp_ * (ks + 5)); } else { VF[2 * ks] = vtr(vp_ + ks * 1024); VF[2 * ks + 1] = vtr(vp_ + ks * 1024 + 512); } } } while (0)
#define ATP_PK(L, H) (bf16x8){L[0], L[1], L[2], L[3], H[0], H[1], H[2], H[3]}
#define ATP_MMA(VF, d) do { _Pragma("unroll") for (int ks = 0; ks < 4; ++ks) { if (ABL == 2) o[d][ks] += __builtin_bit_cast(float, (int)pa[ks][0]) + __builtin_bit_cast(float, (int)VF[2 * ks][0] + (int)VF[2 * ks + 1][0]); else o[d] = __builtin_amdgcn_mfma_f32_32x32x16_bf16(pa[ks], ATP_PK(VF[2 * ks], VF[2 * ks + 1]), o[d], 0, 0, 0); } } while (0)
#define ATP_STEP(PC0, PC1, PN0, PN1) do { \
    const bool more1_ = have_next; const int tn1_ = t_next; \
    const bool more2_ = tmask != 0ull; const int tn2_ = more2_ ? __builtin_ctzll(tmask) : 0; tmask &= tmask - 1; \
    if (more2_ && ABL != 4) ATP_SLOAD(tn2_); \
    s16x4 vfa[8], vfb[8]; ATP_VRD(vfa, vc, 0); \
    ATP_QKT(PN0, PN1, more1_ ? (kc ^ 1) : kc);     \
    ATP_SOFT(PC0, PC1); ATT_SBAR();        \
    static_assert(ND0 == 2, "pipelined core: DV = 64"); \
    ATP_VRD(vfb, vc, 1); ATP_SUM(PC0, PC1); ATP_MMA(vfa, 0); ATP_MMA(vfb, 1); ATT_SBAR();     \
    if (more2_ && ABL != 4) ATP_SWRITE(kc, vc == 0 ? 2 : vc - 1); \
    if (ABL != 3) __syncthreads(); \
    kc ^= 1; vc = (vc == 2) ? 0 : vc + 1; have_next = more2_; t_next = tn2_; (void)tn1_; \
    if (!more1_) goto atp_done; } while (0)

    const int vlane = ((lane >> 4) & 1) * 32 + (lane & 3) * 8 + (4 * hi + ((lane & 15) >> 2)) * 64;
    f32x16 pA0, pA1, pB0, pB1; bf16x8 pa[4];
    int kc = 0, vc = 0;
    { const int t_a = __builtin_ctzll(tmask); tmask &= tmask - 1; ATP_SLOAD(t_a); ATP_SWRITE(0, 0); }
    bool have_next = tmask != 0ull; int t_next = have_next ? __builtin_ctzll(tmask) : 0; tmask &= tmask - 1;
    __syncthreads();
    if (have_next) ATP_SLOAD(t_next);
    ATP_QKT(pA0, pA1, 0);
    if (have_next) ATP_SWRITE(1, 1);
    __syncthreads();
    for (;;) { ATP_STEP(pA0, pA1, pB0, pB1); ATP_STEP(pB0, pB1, pA0, pA1); }
atp_done:
#undef ATP_SLOAD
#undef ATP_SWRITE
#undef ATP_QKT
#undef ATP_SOFT
#undef ATP_SUM
#undef ATP_VRD
#undef ATP_PK
#undef ATP_MMA
#undef ATP_STEP
    { const float lt = xor_add<32>(l_reg); if (hi == 0) wsf[32 + r32] = 1.0f / lt; }
    LDS_WAIT();
#pragma unroll
    for (int g = 0; g < 4; ++g) {
        const f32x4 l0 = *(const LAS f32x4*)(wsf + 32 + 8 * g + 4 * hi);
#pragma unroll
        for (int d = 0; d < ND0; ++d)
#pragma unroll
            for (int i = 0; i < 4; ++i) res[d][4 * g + i] = o[d][4 * g + i] * l0[i];
    }
    LDS_WAIT();
    __syncthreads();
}
template <int DQK, int DV, int MODE, int RB, bool QL = false, bool QPREP = false>
__device__ __forceinline__ void attn_core_rb(const Args& A, int q0, unsigned long long tmask, LAS unsigned char* lds, float (&res)[RB][DV / 32][16]) {
    constexpr int KSTR = DQK * 2 + 16, KBYTES = 64 * KSTR, VBYTES = 64 * DV * 2, PBYTES = 256;
    constexpr int BUF = KBYTES + VBYTES + PBYTES;
    constexpr int CPR = DQK / 8, NKP = 64 * CPR, KP = (NKP + 511) / 512, VP = (64 * DV / 8) / 512, ND0 = DV / 32, NKS = DQK / 16;
    static_assert(2 * BUF + 8 * 256 + (QL ? 8 * RB * NKS * 1024 : 0) <= (QL ? ATT_NXT_OFF : ATT_STASH_OFF), "attention LDS");
    int tid_ = threadIdx.x; asm volatile("" : "+v"(tid_));
    const int tid = tid_, lane = tid & 63, wid = __builtin_amdgcn_readfirstlane(tid >> 6), r32 = lane & 31, hi = lane >> 5;
    LAS float* wsf = (LAS float*)(lds + 2 * BUF) + wid * 64;
    LAS bf16x8* qlds = (LAS bf16x8*)(lds + 2 * BUF + 8 * 256) + wid * (RB * NKS * 64) + lane;
    const int wrow = q0 + wid * (32 * RB);

    bf16x8 sk[KP], sv[VP]; float spos = 0.f;
    unsigned gk_off[KP], lk_off[KP], gv_off[VP], lv_off[VP];
#pragma unroll
    for (int i = 0; i < KP; ++i) { const int p = tid + 512 * i, row = p / CPR, ch = p % CPR; gk_off[i] = (unsigned)(row * A.pk + ch * 8) * 2u; lk_off[i] = (unsigned)(row * KSTR + ch * 16); }
#pragma unroll
    for (int i = 0; i < VP; ++i) { const int p = tid + 512 * i, db = p >> 8, row = (p & 255) >> 2, c4 = p & 3; gv_off[i] = (unsigned)(row * A.pv + db * 32 + c4 * 8) * 2u;
        lv_off[i] = (unsigned)(KBYTES + db * 4096 + (row >> 4) * 1024 + (row & 15) * 64 + c4 * 16); }
#define ATR_SLOAD(t) do { const int k0_ = (t) * 64; const char* kb_ = (const char*)(A.K + (size_t)k0_ * A.pk); const char* vb_ = (const char*)(A.V + (size_t)k0_ * A.pv); \
    _Pragma("unroll") for (int i = 0; i < KP; ++i) { if (tid + 512 * i < NKP) sk[i] = *(const bf16x8*)(kb_ + gk_off[i]); } \
    _Pragma("unroll") for (int i = 0; i < VP; ++i) sv[i] = *(const bf16x8*)(vb_ + gv_off[i]); \
    if (MODE == 1) { if (tid < 64) spos = (float)A.pos[k0_ + tid]; } if (MODE == 2) { spos = (float)(k0_ + tid); } } while (0)
#define ATR_SWRITE(b) do { LAS unsigned char* base_ = lds + (b) * BUF; \
    _Pragma("unroll") for (int i = 0; i < KP; ++i) { if (tid + 512 * i < NKP) *(LAS bf16x8*)(base_ + lk_off[i]) = sk[i]; } \
    _Pragma("unroll") for (int i = 0; i < VP; ++i) *(LAS bf16x8*)(base_ + lv_off[i]) = sv[i]; \
    if (MODE != 0) { if (tid < 64) *(LAS float*)(base_ + KBYTES + VBYTES + tid * 4) = spos; } } while (0)
#define ATR_VRD(VF, d) do { const LAS unsigned char* vp_ = vbase + (d) * 4096; \
    _Pragma("unroll") for (int ks = 0; ks < 4; ++ks) { VF[2 * ks] = vtr(vp_ + ks * 1024); VF[2 * ks + 1] = vtr(vp_ + ks * 1024 + 512); } } while (0)
#define ATR_PK(L, H) (bf16x8){L[0], L[1], L[2], L[3], H[0], H[1], H[2], H[3]}
#define ATR_MMA(VF, d) do { _Pragma("unroll") for (int rb = 0; rb < RB; ++rb) _Pragma("unroll") for (int ks = 0; ks < 4; ++ks) \
        o[rb][d] = __builtin_amdgcn_mfma_f32_32x32x16_bf16(pa[rb][ks], ATR_PK(VF[2 * ks], VF[2 * ks + 1]), o[rb][d], 0, 0, 0); } while (0)

    int t = __builtin_ctzll(tmask); tmask &= tmask - 1;
    ATR_SLOAD(t);
    bf16x8 qr[RB][NKS]; float pqf[RB];
#pragma unroll
    for (int rb = 0; rb < RB; ++rb) {
#pragma unroll
        for (int d0 = 0; d0 < NKS; ++d0) { qr[rb][d0] = *(const bf16x8*)(A.Q + (size_t)(wrow + rb * 32 + r32) * A.pq + d0 * 16 + hi * 8); if (QL && !QPREP) qlds[(rb * NKS + d0) * 64] = qr[rb][d0]; }
        if constexpr (QPREP) {
            static_assert(!QPREP || (DQK == 96 && QL), "QPREP is the latent attention's query path");
            float v[NKS][8];
#pragma unroll
            for (int d0 = 0; d0 < NKS; ++d0) { const v4u w = __builtin_bit_cast(v4u, qr[rb][d0]);
                v[d0][0] = bflo(w.x); v[d0][1] = bfhi(w.x); v[d0][2] = bflo(w.y); v[d0][3] = bfhi(w.y); v[d0][4] = bflo(w.z); v[d0][5] = bfhi(w.z); v[d0][6] = bflo(w.w); v[d0][7] = bfhi(w.w); }
            const float posf = (float)A.pos[wrow + rb * 32 + r32];
#pragma unroll
            for (int j = 0; j < 8; ++j) {
                const float fi = (float)(hi * 8 + j);
                const float invf = __builtin_amdgcn_exp2f(-fi * 0.83048202372184f) * 0.15915494309189535f;
                const float fr = __builtin_amdgcn_fractf(posf * invf);
                const float cs = __builtin_amdgcn_cosf(fr), sn = __builtin_amdgcn_sinf(fr);
                const float x = v[4][j], y = v[5][j]; v[4][j] = x * cs - y * sn; v[5][j] = x * sn + y * cs; }
            float ss = 0.f;
#pragma unroll
            for (int d0 = 0; d0 < NKS; ++d0)
#pragma unroll
                for (int j = 0; j < 8; ++j) ss = fmaf(v[d0][j], v[d0][j], ss);
            ss = xor_add<32>(ss);
            const float rq = (1.0f / sqrtf(ss * (1.0f / 96) + EPS)) * (0.10206207261596575f * LOG2E);
#pragma unroll
            for (int d0 = 0; d0 < NKS; ++d0) { const float* gp = A.qg + d0 * 16 + hi * 8; const f32x4 g0 = *(const f32x4*)gp, g1 = *(const f32x4*)(gp + 4);
                v4u w; w.x = cvtpk(v[d0][0] * rq * g0[0], v[d0][1] * rq * g0[1]); w.y = cvtpk(v[d0][2] * rq * g0[2], v[d0][3] * rq * g0[3]);
                w.z = cvtpk(v[d0][4] * rq * g1[0], v[d0][5] * rq * g1[1]); w.w = cvtpk(v[d0][6] * rq * g1[2], v[d0][7] * rq * g1[3]);
                qr[rb][d0] = __builtin_bit_cast(bf16x8, w); qlds[(rb * NKS + d0) * 64] = qr[rb][d0]; }
        }
        pqf[rb] = 0.f;
        if (MODE == 1) pqf[rb] = (float)A.pos[wrow + rb * 32 + r32];
        if (MODE == 2) pqf[rb] = (float)(wrow + rb * 32 + r32);
    }
    f32x16 o[RB][ND0]; float l_reg[RB];
#pragma unroll
    for (int rb = 0; rb < RB; ++rb) { l_reg[rb] = (MODE == 2 && hi == 0) ? __builtin_amdgcn_exp2f(A.sink2) : 0.f;
#pragma unroll
        for (int d = 0; d < ND0; ++d)
#pragma unroll
            for (int r = 0; r < 16; ++r) o[rb][d][r] = 0.f; }

    ATR_SWRITE(0); __syncthreads();
    if (wid >= 4) __builtin_amdgcn_s_setprio(1);
    for (int cur = 0;; cur ^= 1) {
        const bool more = tmask != 0ull; const int tn = more ? __builtin_ctzll(tmask) : 0; tmask &= tmask - 1;
        LAS unsigned char* bufp = lds + cur * BUF;
        if (more) ATR_SLOAD(tn);
        const bool active = (MODE != 2) || (t * 64 + 63 >= wrow - 128 && t * 64 <= wrow + 32 * RB - 1 + 128);
        if (active) {
        const LAS unsigned char* vbase = bufp + KBYTES + ((lane >> 4) & 1) * 32 + (lane & 3) * 8 + (4 * hi + ((lane & 15) >> 2)) * 64;
        s16x4 vfa[8], vfb[8];
        if (RB == 1) ATR_VRD(vfa, 0);
        bf16x8 pa[RB][4];
        f32x16 pp[RB][2];
        {
            const f32x16 zero = {0.f, 0.f, 0.f, 0.f, 0.f, 0.f, 0.f, 0.f, 0.f, 0.f, 0.f, 0.f, 0.f, 0.f, 0.f, 0.f};
            const LAS unsigned char* kb = bufp + r32 * KSTR + hi * 16;
#pragma unroll
            for (int d0 = 0; d0 < NKS; ++d0) {
                const bf16x8 b0 = *(const LAS bf16x8*)(kb + d0 * 32);
                const bf16x8 b1 = *(const LAS bf16x8*)(kb + 32 * KSTR + d0 * 32);
#pragma unroll
                for (int rb = 0; rb < RB; ++rb) {
                    const bf16x8 qf = QL ? qlds[(rb * NKS + d0) * 64] : qr[rb][d0];
                    if (d0 == 0) { pp[rb][0] = __builtin_amdgcn_mfma_f32_32x32x16_bf16(b0, qf, zero, 0, 0, 0); pp[rb][1] = __builtin_amdgcn_mfma_f32_32x32x16_bf16(b1, qf, zero, 0, 0, 0); }
                    else { pp[rb][0] = __builtin_amdgcn_mfma_f32_32x32x16_bf16(b0, qf, pp[rb][0], 0, 0, 0); pp[rb][1] = __builtin_amdgcn_mfma_f32_32x32x16_bf16(b1, qf, pp[rb][1], 0, 0, 0); }
                }
            }
        }
#pragma unroll
        for (int rb = 0; rb < RB; ++rb) {
            f32x16 p0 = pp[rb][0], p1 = pp[rb][1];
            if (MODE != 0) {
                const LAS float* pk = (const LAS float*)(bufp + KBYTES + VBYTES);
#pragma unroll
                for (int g = 0; g < 4; ++g) {
                    const f32x4 k0v = *(const LAS f32x4*)(pk + 8 * g + 4 * hi), k1v = *(const LAS f32x4*)(pk + 32 + 8 * g + 4 * hi);
#pragma unroll
                    for (int i = 0; i < 4; ++i) {
                        const float d0f = fabsf(pqf[rb] - k0v[i]), d1f = fabsf(pqf[rb] - k1v[i]);
                        float s0 = fmaf(-A.slope2, d0f, p0[4 * g + i]), s1 = fmaf(-A.slope2, d1f, p1[4 * g + i]);
                        if (MODE == 2) { s0 = d0f <= 128.0f ? s0 : -1e30f; s1 = d1f <= 128.0f ? s1 : -1e30f; }
                        p0[4 * g + i] = s0; p1[4 * g + i] = s1;
                    }
                }
            }
#pragma unroll
            for (int r = 0; r < 16; ++r) { p0[r] = __builtin_amdgcn_exp2f(p0[r]); p1[r] = __builtin_amdgcn_exp2f(p1[r]); }
            float ps0 = p0[0] + p1[0], ps1 = p0[1] + p1[1], ps2 = p0[2] + p1[2], ps3 = p0[3] + p1[3];
#pragma unroll
            for (int r = 4; r < 16; r += 4) { ps0 += p0[r] + p1[r]; ps1 += p0[r + 1] + p1[r + 1]; ps2 += p0[r + 2] + p1[r + 2]; ps3 += p0[r + 3] + p1[r + 3]; }
            l_reg[rb] += (ps0 + ps1) + (ps2 + ps3);
#pragma unroll
            for (int s = 0; s < 2; ++s) {
                v4u w0 = {cvtpk(p0[8 * s + 0], p0[8 * s + 1]), cvtpk(p0[8 * s + 2], p0[8 * s + 3]), cvtpk(p0[8 * s + 4], p0[8 * s + 5]), cvtpk(p0[8 * s + 6], p0[8 * s + 7])};
                v4u w1 = {cvtpk(p1[8 * s + 0], p1[8 * s + 1]), cvtpk(p1[8 * s + 2], p1[8 * s + 3]), cvtpk(p1[8 * s + 4], p1[8 * s + 5]), cvtpk(p1[8 * s + 6], p1[8 * s + 7])};
                pa[rb][s] = __builtin_bit_cast(bf16x8, w0); pa[rb][2 + s] = __builtin_bit_cast(bf16x8, w1);
            }
        }
        if (RB == 2) { _Pragma("unroll") for (int d = 0; d < ND0; ++d) { ATR_VRD(vfa, d); ATR_MMA(vfa, d); } (void)vfb; }
        else if (ND0 == 2) { ATR_VRD(vfb, 1); ATR_MMA(vfa, 0); ATR_MMA(vfb, 1); }
        else { ATR_VRD(vfb, 1); ATR_MMA(vfa, 0); ATR_VRD(vfa, 2); ATR_MMA(vfb, 1); ATR_VRD(vfb, 3); ATR_MMA(vfa, 2); ATR_MMA(vfb, 3); }
        }
        if (more) ATR_SWRITE(cur ^ 1);
        __syncthreads();
        if (!more) break;
        t = tn;
    }
    __builtin_amdgcn_s_setprio(0);
#undef ATR_SLOAD
#undef ATR_SWRITE
#undef ATR_VRD
#undef ATR_PK
#undef ATR_MMA
#pragma unroll
    for (int rb = 0; rb < RB; ++rb) { const float lt = xor_add<32>(l_reg[rb]); if (hi == 0) wsf[rb * 32 + r32] = 1.0f / lt; }
    LDS_WAIT();
#pragma unroll
    for (int rb = 0; rb < RB; ++rb)
#pragma unroll
        for (int g = 0; g < 4; ++g) {
            const f32x4 l0 = *(const LAS f32x4*)(wsf + rb * 32 + 8 * g + 4 * hi);
#pragma unroll
            for (int d = 0; d < ND0; ++d)
#pragma unroll
                for (int i = 0; i < 4; ++i) res[rb][d][4 * g + i] = o[rb][d][4 * g + i] * l0[i];
        }
    LDS_WAIT();
    __syncthreads();
}
template <int DQK, int DV, int MODE, int RB, bool QL = false>
__device__ __forceinline__ void attn_core_pd2(const Args& A, int q0, unsigned long long tmask, LAS unsigned char* lds, float (&res)[RB][DV / 32][16]) {
    constexpr int KSTR = DQK * 2 + 16, KBYTES = 64 * KSTR, VBYTES = 64 * DV * 2, PBYTES = 256;
    constexpr int BUF = KBYTES + VBYTES + PBYTES;
    constexpr int CPR = DQK / 8, NKP = 64 * CPR, KP = (NKP + 511) / 512, VP = (64 * DV / 8) / 512, ND0 = DV / 32, NKS = DQK / 16;
    static_assert(2 * BUF + 8 * 256 + (QL ? 8 * RB * NKS * 1024 : 0) <= (QL ? ATT_NXT_OFF : ATT_STASH_OFF), "attention LDS");
    int tid_ = threadIdx.x; asm volatile("" : "+v"(tid_));
    const int tid = tid_, lane = tid & 63, wid = __builtin_amdgcn_readfirstlane(tid >> 6), r32 = lane & 31, hi = lane >> 5;
    LAS float* wsf = (LAS float*)(lds + 2 * BUF) + wid * 64;
    LAS bf16x8* qlds = (LAS bf16x8*)(lds + 2 * BUF + 8 * 256) + wid * (RB * NKS * 64) + lane;
    const int wrow = q0 + wid * (32 * RB);

    bf16x8 qr[RB][NKS]; float pqf[RB];
#pragma unroll
    for (int rb = 0; rb < RB; ++rb) {
#pragma unroll
        for (int d0 = 0; d0 < NKS; ++d0) { qr[rb][d0] = *(const bf16x8*)(A.Q + (size_t)(wrow + rb * 32 + r32) * A.pq + d0 * 16 + hi * 8); if (QL) qlds[(rb * NKS + d0) * 64] = qr[rb][d0]; }
        pqf[rb] = 0.f;
        if (MODE == 1) pqf[rb] = (float)A.pos[wrow + rb * 32 + r32];
        if (MODE == 2) pqf[rb] = (float)(wrow + rb * 32 + r32);
    }
    f32x16 o[RB][ND0]; float l_reg[RB];
#pragma unroll
    for (int rb = 0; rb < RB; ++rb) { l_reg[rb] = (MODE == 2 && hi == 0) ? __builtin_amdgcn_exp2f(A.sink2) : 0.f;
#pragma unroll
        for (int d = 0; d < ND0; ++d)
#pragma unroll
            for (int r = 0; r < 16; ++r) o[rb][d][r] = 0.f; }

    bf16x8 skA[KP], svA[VP], skB[KP], svB[VP]; float sposA = 0.f, sposB = 0.f;
    unsigned gk_off[KP], lk_off[KP], gv_off[VP], lv_off[VP];
#pragma unroll
    for (int i = 0; i < KP; ++i) { const int p = tid + 512 * i, row = p / CPR, ch = p % CPR; gk_off[i] = (unsigned)(row * A.pk + ch * 8) * 2u; lk_off[i] = (unsigned)(row * KSTR + ch * 16); }
#pragma unroll
    for (int i = 0; i < VP; ++i) { const int p = tid + 512 * i, db = p >> 8, row = (p & 255) >> 2, c4 = p & 3; gv_off[i] = (unsigned)(row * A.pv + db * 32 + c4 * 8) * 2u;
        lv_off[i] = (unsigned)(KBYTES + db * 4096 + (row >> 4) * 1024 + (row & 15) * 64 + c4 * 16); }
#define ATR_SLOAD(t, sk, sv, spos) do { const int k0_ = (t) * 64; const char* kb_ = (const char*)(A.K + (size_t)k0_ * A.pk); const char* vb_ = (const char*)(A.V + (size_t)k0_ * A.pv); \
    _Pragma("unroll") for (int i = 0; i < KP; ++i) { if (tid + 512 * i < NKP) sk[i] = *(const bf16x8*)(kb_ + gk_off[i]); } \
    _Pragma("unroll") for (int i = 0; i < VP; ++i) sv[i] = *(const bf16x8*)(vb_ + gv_off[i]); \
    if (MODE == 1) { if (tid < 64) spos = (float)A.pos[k0_ + tid]; } if (MODE == 2) { spos = (float)(k0_ + tid); } } while (0)
#define ATR_SWRITE(b, sk, sv, spos) do { LAS unsigned char* base_ = lds + (b) * BUF; \
    _Pragma("unroll") for (int i = 0; i < KP; ++i) { if (tid + 512 * i < NKP) *(LAS bf16x8*)(base_ + lk_off[i]) = sk[i]; } \
    _Pragma("unroll") for (int i = 0; i < VP; ++i) *(LAS bf16x8*)(base_ + lv_off[i]) = sv[i]; \
    if (MODE != 0) { if (tid < 64) *(LAS float*)(base_ + KBYTES + VBYTES + tid * 4) = spos; } } while (0)
#define ATR_VRD(VF, d) do { const LAS unsigned char* vp_ = vbase + (d) * 4096; \
    _Pragma("unroll") for (int ks = 0; ks < 4; ++ks) { VF[2 * ks] = vtr(vp_ + ks * 1024); VF[2 * ks + 1] = vtr(vp_ + ks * 1024 + 512); } } while (0)
#define ATR_PK(L, H) (bf16x8){L[0], L[1], L[2], L[3], H[0], H[1], H[2], H[3]}
#define ATR_MMA(VF, d) do { _Pragma("unroll") for (int rb = 0; rb < RB; ++rb) _Pragma("unroll") for (int ks = 0; ks < 4; ++ks) \
        o[rb][d] = __builtin_amdgcn_mfma_f32_32x32x16_bf16(pa[rb][ks], ATR_PK(VF[2 * ks], VF[2 * ks + 1]), o[rb][d], 0, 0, 0); } while (0)

    int cur = 0;
    const int t0 = __builtin_ctzll(tmask); tmask &= tmask - 1;
    bool more1 = tmask != 0ull; const int t1 = more1 ? __builtin_ctzll(tmask) : 0; tmask &= tmask - 1;
    bool more2 = tmask != 0ull; int t2 = more2 ? __builtin_ctzll(tmask) : 0; tmask &= tmask - 1;
    ATR_SLOAD(t0, skA, svA, sposA); ATR_SWRITE(0, skA, svA, sposA);
    if (more1) ATR_SLOAD(t1, skB, svB, sposB);
    __syncthreads();
    for (;;) {
        {
        LAS unsigned char* bufp = lds + cur * BUF;
        if (more2) ATR_SLOAD(t2, skA, svA, sposA);
        const LAS unsigned char* vbase = bufp + KBYTES + ((lane >> 4) & 1) * 32 + (lane & 3) * 8 + (4 * hi + ((lane & 15) >> 2)) * 64;
        s16x4 vfa[8], vfb[8];
        if (RB == 1) ATR_VRD(vfa, 0);
        bf16x8 pa[RB][4];
        f32x16 pp[RB][2];
        {
            const f32x16 zero = {0.f, 0.f, 0.f, 0.f, 0.f, 0.f, 0.f, 0.f, 0.f, 0.f, 0.f, 0.f, 0.f, 0.f, 0.f, 0.f};
            const LAS unsigned char* kb = bufp + r32 * KSTR + hi * 16;
#pragma unroll
            for (int d0 = 0; d0 < NKS; ++d0) {
                const bf16x8 b0 = *(const LAS bf16x8*)(kb + d0 * 32);
                const bf16x8 b1 = *(const LAS bf16x8*)(kb + 32 * KSTR + d0 * 32);
#pragma unroll
                for (int rb = 0; rb < RB; ++rb) {
                    const bf16x8 qf = QL ? qlds[(rb * NKS + d0) * 64] : qr[rb][d0];
                    if (d0 == 0) { pp[rb][0] = __builtin_amdgcn_mfma_f32_32x32x16_bf16(b0, qf, zero, 0, 0, 0); pp[rb][1] = __builtin_amdgcn_mfma_f32_32x32x16_bf16(b1, qf, zero, 0, 0, 0); }
                    else { pp[rb][0] = __builtin_amdgcn_mfma_f32_32x32x16_bf16(b0, qf, pp[rb][0], 0, 0, 0); pp[rb][1] = __builtin_amdgcn_mfma_f32_32x32x16_bf16(b1, qf, pp[rb][1], 0, 0, 0); }
                }
            }
        }
#pragma unroll
        for (int rb = 0; rb < RB; ++rb) {
            f32x16 p0 = pp[rb][0], p1 = pp[rb][1];
            if (MODE != 0) {
                const LAS float* pk = (const LAS float*)(bufp + KBYTES + VBYTES);
#pragma unroll
                for (int g = 0; g < 4; ++g) {
                    const f32x4 k0v = *(const LAS f32x4*)(pk + 8 * g + 4 * hi), k1v = *(const LAS f32x4*)(pk + 32 + 8 * g + 4 * hi);
#pragma unroll
                    for (int i = 0; i < 4; ++i) {
                        const float d0f = fabsf(pqf[rb] - k0v[i]), d1f = fabsf(pqf[rb] - k1v[i]);
                        float s0 = fmaf(-A.slope2, d0f, p0[4 * g + i]), s1 = fmaf(-A.slope2, d1f, p1[4 * g + i]);
                        if (MODE == 2) { s0 = d0f <= 128.0f ? s0 : -1e30f; s1 = d1f <= 128.0f ? s1 : -1e30f; }
                        p0[4 * g + i] = s0; p1[4 * g + i] = s1;
                    }
                }
            }
#pragma unroll
            for (int r = 0; r < 16; ++r) { p0[r] = __builtin_amdgcn_exp2f(p0[r]); p1[r] = __builtin_amdgcn_exp2f(p1[r]); }
            float ps0 = p0[0] + p1[0], ps1 = p0[1] + p1[1], ps2 = p0[2] + p1[2], ps3 = p0[3] + p1[3];
#pragma unroll
            for (int r = 4; r < 16; r += 4) { ps0 += p0[r] + p1[r]; ps1 += p0[r + 1] + p1[r + 1]; ps2 += p0[r + 2] + p1[r + 2]; ps3 += p0[r + 3] + p1[r + 3]; }
            l_reg[rb] += (ps0 + ps1) + (ps2 + ps3);
#pragma unroll
            for (int s = 0; s < 2; ++s) {
                v4u w0 = {cvtpk(p0[8 * s + 0], p0[8 * s + 1]), cvtpk(p0[8 * s + 2], p0[8 * s + 3]), cvtpk(p0[8 * s + 4], p0[8 * s + 5]), cvtpk(p0[8 * s + 6], p0[8 * s + 7])};
                v4u w1 = {cvtpk(p1[8 * s + 0], p1[8 * s + 1]), cvtpk(p1[8 * s + 2], p1[8 * s + 3]), cvtpk(p1[8 * s + 4], p1[8 * s + 5]), cvtpk(p1[8 * s + 6], p1[8 * s + 7])};
                pa[rb][s] = __builtin_bit_cast(bf16x8, w0); pa[rb][2 + s] = __builtin_bit_cast(bf16x8, w1);
            }
        }
        if (RB == 2) { _Pragma("unroll") for (int d = 0; d < ND0; ++d) { ATR_VRD(vfa, d); ATR_MMA(vfa, d); } (void)vfb; }
        else if (ND0 == 2) { ATR_VRD(vfb, 1); ATR_MMA(vfa, 0); ATR_MMA(vfb, 1); }
        else { ATR_VRD(vfb, 1); ATR_MMA(vfa, 0); ATR_VRD(vfa, 2); ATR_MMA(vfb, 1); ATR_VRD(vfb, 3); ATR_MMA(vfa, 2); ATR_MMA(vfb, 3); }
        if (more1) ATR_SWRITE(cur ^ 1, skB, svB, sposB);
        __syncthreads();
        if (!more1) break;
        cur ^= 1; more1 = more2; more2 = tmask != 0ull; t2 = more2 ? __builtin_ctzll(tmask) : 0; tmask &= tmask - 1;
        }
        {
        LAS unsigned char* bufp = lds + cur * BUF;
        if (more2) ATR_SLOAD(t2, skB, svB, sposB);
        const LAS unsigned char* vbase = bufp + KBYTES + ((lane >> 4) & 1) * 32 + (lane & 3) * 8 + (4 * hi + ((lane & 15) >> 2)) * 64;
        s16x4 vfa[8], vfb[8];
        if (RB == 1) ATR_VRD(vfa, 0);
        bf16x8 pa[RB][4];
        f32x16 pp[RB][2];
        {
            const f32x16 zero = {0.f, 0.f, 0.f, 0.f, 0.f, 0.f, 0.f, 0.f, 0.f, 0.f, 0.f, 0.f, 0.f, 0.f, 0.f, 0.f};
            const LAS unsigned char* kb = bufp + r32 * KSTR + hi * 16;
#pragma unroll
            for (int d0 = 0; d0 < NKS; ++d0) {
                const bf16x8 b0 = *(const LAS bf16x8*)(kb + d0 * 32);
                const bf16x8 b1 = *(const LAS bf16x8*)(kb + 32 * KSTR + d0 * 32);
#pragma unroll
                for (int rb = 0; rb < RB; ++rb) {
                    const bf16x8 qf = QL ? qlds[(rb * NKS + d0) * 64] : qr[rb][d0];
                    if (d0 == 0) { pp[rb][0] = __builtin_amdgcn_mfma_f32_32x32x16_bf16(b0, qf, zero, 0, 0, 0); pp[rb][1] = __builtin_amdgcn_mfma_f32_32x32x16_bf16(b1, qf, zero, 0, 0, 0); }
                    else { pp[rb][0] = __builtin_amdgcn_mfma_f32_32x32x16_bf16(b0, qf, pp[rb][0], 0, 0, 0); pp[rb][1] = __builtin_amdgcn_mfma_f32_32x32x16_bf16(b1, qf, pp[rb][1], 0, 0, 0); }
                }
            }
        }
#pragma unroll
        for (int rb = 0; rb < RB; ++rb) {
            f32x16 p0 = pp[rb][0], p1 = pp[rb][1];
            if (MODE != 0) {
                const LAS float* pk = (const LAS float*)(bufp + KBYTES + VBYTES);
#pragma unroll
                for (int g = 0; g < 4; ++g) {
                    const f32x4 k0v = *(const LAS f32x4*)(pk + 8 * g + 4 * hi), k1v = *(const LAS f32x4*)(pk + 32 + 8 * g + 4 * hi);
#pragma unroll
                    for (int i = 0; i < 4; ++i) {
                        const float d0f = fabsf(pqf[rb] - k0v[i]), d1f = fabsf(pqf[rb] - k1v[i]);
                        float s0 = fmaf(-A.slope2, d0f, p0[4 * g + i]), s1 = fmaf(-A.slope2, d1f, p1[4 * g + i]);
                        if (MODE == 2) { s0 = d0f <= 128.0f ? s0 : -1e30f; s1 = d1f <= 128.0f ? s1 : -1e30f; }
                        p0[4 * g + i] = s0; p1[4 * g + i] = s1;
                    }
                }
            }
#pragma unroll
            for (int r = 0; r < 16; ++r) { p0[r] = __builtin_amdgcn_exp2f(p0[r]); p1[r] = __builtin_amdgcn_exp2f(p1[r]); }
            float ps0 = p0[0] + p1[0], ps1 = p0[1] + p1[1], ps2 = p0[2] + p1[2], ps3 = p0[3] + p1[3];
#pragma unroll
            for (int r = 4; r < 16; r += 4) { ps0 += p0[r] + p1[r]; ps1 += p0[r + 1] + p1[r + 1]; ps2 += p0[r + 2] + p1[r + 2]; ps3 += p0[r + 3] + p1[r + 3]; }
            l_reg[rb] += (ps0 + ps1) + (ps2 + ps3);
#pragma unroll
            for (int s = 0; s < 2; ++s) {
                v4u w0 = {cvtpk(p0[8 * s + 0], p0[8 * s + 1]), cvtpk(p0[8 * s + 2], p0[8 * s + 3]), cvtpk(p0[8 * s + 4], p0[8 * s + 5]), cvtpk(p0[8 * s + 6], p0[8 * s + 7])};
                v4u w1 = {cvtpk(p1[8 * s + 0], p1[8 * s + 1]), cvtpk(p1[8 * s + 2], p1[8 * s + 3]), cvtpk(p1[8 * s + 4], p1[8 * s + 5]), cvtpk(p1[8 * s + 6], p1[8 * s + 7])};
                pa[rb][s] = __builtin_bit_cast(bf16x8, w0); pa[rb][2 + s] = __builtin_bit_cast(bf16x8, w1);
            }
        }
        if (RB == 2) { _Pragma("unroll") for (int d = 0; d < ND0; ++d) { ATR_VRD(vfa, d); ATR_MMA(vfa, d); } (void)vfb; }
        else if (ND0 == 2) { ATR_VRD(vfb, 1); ATR_MMA(vfa, 0); ATR_MMA(vfb, 1); }
        else { ATR_VRD(vfb, 1); ATR_MMA(vfa, 0); ATR_VRD(vfa, 2); ATR_MMA(vfb, 1); ATR_VRD(vfb, 3); ATR_MMA(vfa, 2); ATR_MMA(vfb, 3); }
        if (more1) ATR_SWRITE(cur ^ 1, skA, svA, sposA);
        __syncthreads();
        if (!more1) break;
        cur ^= 1; more1 = more2; more2 = tmask != 0ull; t2 = more2 ? __builtin_ctzll(tmask) : 0; tmask &= tmask - 1;
        }
    }
#undef ATR_SLOAD
#undef ATR_SWRITE
#undef ATR_VRD
#undef ATR_PK
#undef ATR_MMA
#pragma unroll
    for (int rb = 0; rb < RB; ++rb) { const float lt = xor_add<32>(l_reg[rb]); if (hi == 0) wsf[rb * 32 + r32] = 1.0f / lt; }
    LDS_WAIT();
#pragma unroll
    for (int rb = 0; rb < RB; ++rb)
#pragma unroll
        for (int g = 0; g < 4; ++g) {
            const f32x4 l0 = *(const LAS f32x4*)(wsf + rb * 32 + 8 * g + 4 * hi);
#pragma unroll
            for (int d = 0; d < ND0; ++d)
#pragma unroll
                for (int i = 0; i < 4; ++i) res[rb][d][4 * g + i] = o[rb][d][4 * g + i] * l0[i];
        }
    LDS_WAIT();
    __syncthreads();
}
template <int DQK, int DV, int MODE, int RB, bool QL = false>
__device__ __forceinline__ void attn_core_pp(const Args& A, int q0, unsigned long long tmask, LAS unsigned char* lds, float (&res)[RB][DV / 32][16]) {
    constexpr int KSTR = DQK * 2 + 16, KBYTES = 64 * KSTR, VBYTES = 64 * DV * 2;
    constexpr int OFF_V = 2 * KBYTES, OFF_PK = OFF_V + 2 * VBYTES, OFF_WS = OFF_PK + 4 * 256, OFF_Q = OFF_WS + 8 * 256;
    constexpr int CPR = DQK / 8, NKP = 64 * CPR, KP = (NKP + 511) / 512, VP = (64 * DV / 8) / 512, ND0 = DV / 32, NKS = DQK / 16;
    static_assert(OFF_Q + (QL ? 8 * RB * NKS * 1024 : 0) <= (QL ? ATT_NXT_OFF : ATT_STASH_OFF), "attention LDS");
    int tid_ = threadIdx.x; asm volatile("" : "+v"(tid_));
    const int tid = tid_, lane = tid & 63, wid = __builtin_amdgcn_readfirstlane(tid >> 6), r32 = lane & 31, hi = lane >> 5;
    LAS float* wsf = (LAS float*)(lds + OFF_WS) + wid * 64;
    LAS bf16x8* qlds = (LAS bf16x8*)(lds + OFF_Q) + wid * (RB * NKS * 64) + lane;
    const int wrow = q0 + wid * (32 * RB);

    bf16x8 qr[RB][NKS]; float pqf[RB];
#pragma unroll
    for (int rb = 0; rb < RB; ++rb) {
#pragma unroll
        for (int d0 = 0; d0 < NKS; ++d0) { qr[rb][d0] = *(const bf16x8*)(A.Q + (size_t)(wrow + rb * 32 + r32) * A.pq + d0 * 16 + hi * 8); if (QL) qlds[(rb * NKS + d0) * 64] = qr[rb][d0]; }
        pqf[rb] = 0.f;
        if (MODE == 1) pqf[rb] = (float)A.pos[wrow + rb * 32 + r32];
        if (MODE == 2) pqf[rb] = (float)(wrow + rb * 32 + r32);
    }
    f32x16 o[RB][ND0]; float l_reg[RB];
#pragma unroll
    for (int rb = 0; rb < RB; ++rb) { l_reg[rb] = (MODE == 2 && hi == 0) ? __builtin_amdgcn_exp2f(A.sink2) : 0.f;
#pragma unroll
        for (int d = 0; d < ND0; ++d)
#pragma unroll
            for (int r = 0; r < 16; ++r) o[rb][d][r] = 0.f; }

    bf16x8 sk[KP], sv[VP]; float spos = 0.f;
    unsigned gk_off[KP], lk_off[KP], gv_off[VP], lv_off[VP];
#pragma unroll
    for (int i = 0; i < KP; ++i) { const int p = tid + 512 * i, row = p / CPR, ch = p % CPR; gk_off[i] = (unsigned)(row * A.pk + ch * 8) * 2u; lk_off[i] = (unsigned)(row * KSTR + ch * 16); }
#pragma unroll
    for (int i = 0; i < VP; ++i) { const int p = tid + 512 * i, db = p >> 8, row = (p & 255) >> 2, c4 = p & 3; gv_off[i] = (unsigned)(row * A.pv + db * 32 + c4 * 8) * 2u;
        lv_off[i] = (unsigned)(OFF_V + db * 4096 + (row >> 4) * 1024 + (row & 15) * 64 + c4 * 16); }
#define APP_LOADK(t) do { const int k0_ = (t) * 64; const char* kb_ = (const char*)(A.K + (size_t)k0_ * A.pk); \
    _Pragma("unroll") for (int i = 0; i < KP; ++i) { if (tid + 512 * i < NKP) sk[i] = *(const bf16x8*)(kb_ + gk_off[i]); } \
    if (MODE == 1) { if (tid < 64) spos = (float)A.pos[k0_ + tid]; } if (MODE == 2) { spos = (float)(k0_ + tid); } } while (0)
#define APP_LOADV(t) do { const char* vb_ = (const char*)(A.V + (size_t)((t) * 64) * A.pv); \
    _Pragma("unroll") for (int i = 0; i < VP; ++i) sv[i] = *(const bf16x8*)(vb_ + gv_off[i]); } while (0)
#define APP_WRITEK(kb, pr) do { LAS unsigned char* base_ = lds + (kb) * KBYTES; \
    _Pragma("unroll") for (int i = 0; i < KP; ++i) { if (tid + 512 * i < NKP) *(LAS bf16x8*)(base_ + lk_off[i]) = sk[i]; } \
    if (MODE != 0) { if (tid < 64) *(LAS float*)(lds + OFF_PK + (pr) * 256 + tid * 4) = spos; } } while (0)
#define APP_WRITEV(vb) do { LAS unsigned char* base_ = lds + (vb) * VBYTES; \
    _Pragma("unroll") for (int i = 0; i < VP; ++i) *(LAS bf16x8*)(base_ + lv_off[i]) = sv[i]; } while (0)
#define APP_BAR() do { ATT_SBAR(); __builtin_amdgcn_s_barrier(); ATT_SBAR(); } while (0)
#define APP_VRD(VF, d) do { const LAS unsigned char* vp_ = vbase + (d) * 4096; \
    _Pragma("unroll") for (int ks = 0; ks < 4; ++ks) { VF[2 * ks] = vtr(vp_ + ks * 1024); VF[2 * ks + 1] = vtr(vp_ + ks * 1024 + 512); } } while (0)
#define APP_PK(L, H) (bf16x8){L[0], L[1], L[2], L[3], H[0], H[1], H[2], H[3]}
#define APP_MMA(VF, d) do { _Pragma("unroll") for (int rb = 0; rb < RB; ++rb) _Pragma("unroll") for (int ks = 0; ks < 4; ++ks) \
        o[rb][d] = __builtin_amdgcn_mfma_f32_32x32x16_bf16(pa[rb][ks], APP_PK(VF[2 * ks], VF[2 * ks + 1]), o[rb][d], 0, 0, 0); } while (0)
#define APP_QKT(kbuf) do { const f32x16 zero = {0.f, 0.f, 0.f, 0.f, 0.f, 0.f, 0.f, 0.f, 0.f, 0.f, 0.f, 0.f, 0.f, 0.f, 0.f, 0.f}; \
    const LAS unsigned char* kb = lds + (kbuf) * KBYTES + r32 * KSTR + hi * 16; \
    _Pragma("unroll") for (int d0 = 0; d0 < NKS; ++d0) { \
        const bf16x8 b0 = *(const LAS bf16x8*)(kb + d0 * 32); const bf16x8 b1 = *(const LAS bf16x8*)(kb + 32 * KSTR + d0 * 32); \
        _Pragma("unroll") for (int rb = 0; rb < RB; ++rb) { const bf16x8 qf = QL ? qlds[(rb * NKS + d0) * 64] : qr[rb][d0]; \
            if (d0 == 0) { pp[rb][0] = __builtin_amdgcn_mfma_f32_32x32x16_bf16(b0, qf, zero, 0, 0, 0); pp[rb][1] = __builtin_amdgcn_mfma_f32_32x32x16_bf16(b1, qf, zero, 0, 0, 0); } \
            else { pp[rb][0] = __builtin_amdgcn_mfma_f32_32x32x16_bf16(b0, qf, pp[rb][0], 0, 0, 0); pp[rb][1] = __builtin_amdgcn_mfma_f32_32x32x16_bf16(b1, qf, pp[rb][1], 0, 0, 0); } } } } while (0)
#define APP_POP(tv, hv) do { hv = tmask != 0ull; tv = hv ? __builtin_ctzll(tmask) : 0; tmask &= tmask - 1ull; } while (0)

    int ta, tb, tc; bool ha, hb, hc;
    APP_POP(ta, ha); APP_POP(tb, hb); APP_POP(tc, hc); (void)ha;
    APP_LOADK(ta); APP_WRITEK(0, 0);
    if (hb) APP_LOADK(tb);
    APP_LOADV(ta);
    LDS_WAIT();
    if (wid >= 4) APP_BAR();
    APP_BAR();
    f32x16 pp[RB][2]; bf16x8 pa[RB][4];
    __builtin_amdgcn_s_setprio(1);
    APP_QKT(0);
    if (hb) APP_WRITEK(1, 1);
    APP_WRITEV(0);
    __builtin_amdgcn_s_setprio(0);
    for (int j = 0;; ++j) {
        LDS_WAIT(); APP_BAR();
        if (hc) APP_LOADK(tc);
        if (hb) APP_LOADV(tb);
#pragma unroll
        for (int rb = 0; rb < RB; ++rb) {
            f32x16 p0 = pp[rb][0], p1 = pp[rb][1];
            if (MODE != 0) {
                const LAS float* pk = (const LAS float*)(lds + OFF_PK + (j & 3) * 256);
#pragma unroll
                for (int g = 0; g < 4; ++g) {
                    const f32x4 k0v = *(const LAS f32x4*)(pk + 8 * g + 4 * hi), k1v = *(const LAS f32x4*)(pk + 32 + 8 * g + 4 * hi);
#pragma unroll
                    for (int i = 0; i < 4; ++i) {
                        const float d0f = fabsf(pqf[rb] - k0v[i]), d1f = fabsf(pqf[rb] - k1v[i]);
                        float s0 = fmaf(-A.slope2, d0f, p0[4 * g + i]), s1 = fmaf(-A.slope2, d1f, p1[4 * g + i]);
                        if (MODE == 2) { s0 = d0f <= 128.0f ? s0 : -1e30f; s1 = d1f <= 128.0f ? s1 : -1e30f; }
                        p0[4 * g + i] = s0; p1[4 * g + i] = s1;
                    }
                }
            }
#pragma unroll
            for (int r = 0; r < 16; ++r) { p0[r] = __builtin_amdgcn_exp2f(p0[r]); p1[r] = __builtin_amdgcn_exp2f(p1[r]); }
            float ps0 = p0[0] + p1[0], ps1 = p0[1] + p1[1], ps2 = p0[2] + p1[2], ps3 = p0[3] + p1[3];
#pragma unroll
            for (int r = 4; r < 16; r += 4) { ps0 += p0[r] + p1[r]; ps1 += p0[r + 1] + p1[r + 1]; ps2 += p0[r + 2] + p1[r + 2]; ps3 += p0[r + 3] + p1[r + 3]; }
            l_reg[rb] += (ps0 + ps1) + (ps2 + ps3);
#pragma unroll
            for (int s = 0; s < 2; ++s) {
                v4u w0 = {cvtpk(p0[8 * s + 0], p0[8 * s + 1]), cvtpk(p0[8 * s + 2], p0[8 * s + 3]), cvtpk(p0[8 * s + 4], p0[8 * s + 5]), cvtpk(p0[8 * s + 6], p0[8 * s + 7])};
                v4u w1 = {cvtpk(p1[8 * s + 0], p1[8 * s + 1]), cvtpk(p1[8 * s + 2], p1[8 * s + 3]), cvtpk(p1[8 * s + 4], p1[8 * s + 5]), cvtpk(p1[8 * s + 6], p1[8 * s + 7])};
                pa[rb][s] = __builtin_bit_cast(bf16x8, w0); pa[rb][2 + s] = __builtin_bit_cast(bf16x8, w1);
            }
        }
        asm volatile("" ::: "memory"); APP_BAR();
        __builtin_amdgcn_s_setprio(1);
        {
            const LAS unsigned char* vbase = lds + OFF_V + (j & 1) * VBYTES + ((lane >> 4) & 1) * 32 + (lane & 3) * 8 + (4 * hi + ((lane & 15) >> 2)) * 64;
            s16x4 vfa[8], vfb[8];
            if (RB == 2) { _Pragma("unroll") for (int d = 0; d < ND0; ++d) { APP_VRD(vfa, d); APP_MMA(vfa, d); } (void)vfb; }
            else if (ND0 == 2) { APP_VRD(vfa, 0); APP_VRD(vfb, 1); APP_MMA(vfa, 0); APP_MMA(vfb, 1); }
            else { APP_VRD(vfa, 0); APP_VRD(vfb, 1); APP_MMA(vfa, 0); APP_VRD(vfa, 2); APP_MMA(vfb, 1); APP_VRD(vfb, 3); APP_MMA(vfa, 2); APP_MMA(vfb, 3); }
        }
        if (!hb) break;
        APP_QKT((j + 1) & 1);
        if (hc) APP_WRITEK(j & 1, (j + 2) & 3);
        APP_WRITEV((j + 1) & 1);
        __builtin_amdgcn_s_setprio(0);
        hb = hc; tb = tc; APP_POP(tc, hc);
    }
    __builtin_amdgcn_s_setprio(0);
    if (wid < 4) APP_BAR();
#undef APP_LOADK
#undef APP_LOADV
#undef APP_WRITEK
#undef APP_WRITEV
#undef APP_BAR
#undef APP_VRD
#undef APP_PK
#undef APP_MMA
#undef APP_QKT
#undef APP_POP
#pragma unroll
    for (int rb = 0; rb < RB; ++rb) { const float lt = xor_add<32>(l_reg[rb]); if (hi == 0) wsf[rb * 32 + r32] = 1.0f / lt; }
    LDS_WAIT();
#pragma unroll
    for (int rb = 0; rb < RB; ++rb)
#pragma unroll
        for (int g = 0; g < 4; ++g) {
            const f32x4 l0 = *(const LAS f32x4*)(wsf + rb * 32 + 8 * g + 4 * hi);
#pragma unroll
            for (int d = 0; d < ND0; ++d)
#pragma unroll
                for (int i = 0; i < 4; ++i) res[rb][d][4 * g + i] = o[rb][d][4 * g + i] * l0[i];
        }
    LDS_WAIT();
    __syncthreads();
}
template <int ND0> __device__ __forceinline__ void store_rows(const float (&res)[ND0][16], bf16* O, int po, int row0, int lane) {
    asm volatile("" : "+v"(lane));
    const int r32 = lane & 31, hi = lane >> 5;
    bf16* Ow = O + (size_t)row0 * po + r32;
#pragma unroll
    for (int r = 0; r < 16; ++r) { const int orow = crow(r, hi);
#pragma unroll
        for (int d = 0; d < ND0; ++d) Ow[(size_t)orow * po + d * 32] = (bf16)(cvtpk(res[d][r], 0.f) & 0xffffu); }
}
template <int ND0> __device__ __forceinline__ void store_res(const float (&res)[ND0][16], bf16* O, int po, int q0) {
    const int tid = threadIdx.x, lane = tid & 63, wid = __builtin_amdgcn_readfirstlane(tid >> 6), r32 = lane & 31, hi = lane >> 5;
    bf16* Ow = O + (size_t)(q0 + wid * 32) * po + r32;
#pragma unroll
    for (int r = 0; r < 16; ++r) { const int orow = crow(r, hi);
#pragma unroll
        for (int d = 0; d < ND0; ++d) Ow[(size_t)orow * po + d * 32] = (bf16)(cvtpk(res[d][r], 0.f) & 0xffffu); }
}
}

#ifndef ATT_CORE
#define ATT_CORE attn_core_rb
#endif
#ifndef ATT_CORE_A
#define ATT_CORE_A attn_core_rb
#endif

__device__ __forceinline__ float lam_init_of(int layer) { return layer == 0 ? 0.2f : 0.35550906759096184f; }
template <bool DRY> __device__ __forceinline__ void att_sec_A(const Frame& F, const float* diff_qk_g, const float* diff_lambda, const float* diff_out_g, unsigned char* ws, const int* positions, int layer) {
    int tid_ = threadIdx.x; asm volatile("" : "+v"(tid_)); const int lane = tid_ & 63, r32 = lane & 31;
    LAS unsigned char* lds = F.lds + RING_OFF;
    const float* lp = diff_lambda;
    const float s1 = wave_sum(lp[lane] * lp[64 + lane]), s2 = wave_sum(lp[128 + lane] * lp[192 + lane]);
    const float li = lam_init_of(layer);
    const float lam = __expf(s1) - __expf(s2) + li;
    const float osc = 1.0f - li;
    float gq = fabsf(diff_qk_g[lane]), gk = fabsf(diff_qk_g[64 + lane]);
    gq = xor_max<1>(gq); gq = xor_max<2>(gq); gq = xor_max<4>(gq); gq = xor_max<8>(gq); gq = xor_max<16>(gq); gq = xor_max<32>(gq);
    gk = xor_max<1>(gk); gk = xor_max<2>(gk); gk = xor_max<4>(gk); gk = xor_max<8>(gk); gk = xor_max<16>(gk); gk = xor_max<32>(gk);
    const float reach = 2.0f * (8.0f * gq * gk * 1.01f) + 30.0f;
    const float* tmm = (const float*)(ws + WS_TMM);
    constexpr int NU = NB * 16 * 4; const int per = (NU + F.G - 1) / F.G;
    for (int u = F.vcu * per; u < (F.vcu + 1) * per && u < NU; ++u) {
        const int h = u & 3, bq = u >> 2, b = bq >> 4, qb = bq & 15;
        const size_t rb = (size_t)b * SEQ;
        const float slope = exp2f(-2.0f * (float)(h + 1));
        unsigned long long tmask;
        { const float* tq = tmm + (size_t)(b * 64 + qb * 4) * 2;
          const float qlo = fminf(fminf(tq[0], tq[2]), fminf(tq[4], tq[6])), qhi = fmaxf(fmaxf(tq[1], tq[3]), fmaxf(tq[5], tq[7]));
          const float klo = tmm[(size_t)(b * 64 + lane) * 2], khi = tmm[(size_t)(b * 64 + lane) * 2 + 1];
          const float gap = fmaxf(fmaxf(klo - qhi, qlo - khi), 0.f);
          tmask = __ballot(gap * slope <= reach); }
        att::Args A;
        A.pq = 512; A.pk = 512; A.pv = 512; A.pos = positions + rb; A.slope2 = slope * LOG2E; A.sink2 = 0.f;
        A.V = (const bf16*)(ws + WS_VA) + rb * 512 + h * 128;
        LAS unsigned* stash = (LAS unsigned*)(lds + ATT_STASH_OFF) + F.wave * 2048 + lane;
        {
            A.Q = (const bf16*)(ws + WS_QA) + rb * 512 + h * 128; A.K = (const bf16*)(ws + WS_KA) + rb * 512 + h * 64;
            float r0[1][4][16];
            att::ATT_CORE_A<64, 128, 1, 1>(A, qb * 256, tmask, lds, r0);
#pragma unroll
            for (int d = 0; d < 4; ++d)
#pragma unroll
                for (int r = 0; r < 8; ++r) stash[(d * 8 + r) * 64] = att::cvtpk(r0[0][d][2 * r], r0[0][d][2 * r + 1]);
        }
        float res[1][4][16];
        A.Q = (const bf16*)(ws + WS_QA) + rb * 512 + h * 128 + 64; A.K = (const bf16*)(ws + WS_KA) + rb * 512 + (4 + h) * 64;
        att::ATT_CORE_A<64, 128, 1, 1>(A, qb * 256, tmask, lds, res);
        float gcol[4];
#pragma unroll
        for (int d = 0; d < 4; ++d) gcol[d] = diff_out_g[d * 32 + r32] * osc;
#pragma unroll
        for (int r = 0; r < 16; ++r) {
            float s = 0.f;
#pragma unroll
            for (int d = 0; d < 4; ++d) { const unsigned w = stash[(d * 8 + (r >> 1)) * 64]; const float a0 = (r & 1) ? bfhi(w) : bflo(w); const float v = a0 - lam * res[0][d][r]; res[0][d][r] = v; s += v * v; }
            s = xor_add<1>(s); s = xor_add<2>(s); s = xor_add<4>(s); s = xor_add<8>(s); s = xor_add<16>(s);
            const float rs = 1.0f / sqrtf(s * (1.0f / 128) + EPS);
#pragma unroll
            for (int d = 0; d < 4; ++d) res[0][d][r] *= rs * gcol[d];
        }
        att::store_rows<4>(res[0], (bf16*)(ws + (DRY ? WS_OB : WS_QA)) + rb * 512 + h * 128, 512, qb * 256 + F.wave * 32, lane);
    }
}
template <bool DRY> __device__ __forceinline__ void att_sec_C(const Frame& F, const float* swa_sink, unsigned char* ws) {
    int tid_ = threadIdx.x; asm volatile("" : "+v"(tid_)); const int lane = tid_ & 63;
    LAS unsigned char* lds = F.lds + RING_OFF;
    constexpr int NU = NB * 8 * 8; const int per = (NU + F.G - 1) / F.G;
    for (int u = F.vcu * per; u < (F.vcu + 1) * per && u < NU; ++u) {
        const int b = u >> 6, hh = (u >> 3) & 7, qb = u & 7, g = hh >> 2;
        const size_t rb = (size_t)b * SEQ;
        att::Args A;
        A.Q = (const bf16*)(ws + WS_QC) + rb * 512 + hh * 64; A.pq = 512;
        A.K = (const bf16*)(ws + WS_CQKC) + rb * 512 + 384 + g * 64; A.pk = 512;
        A.V = (const bf16*)(ws + WS_VCKR) + rb * 256 + g * 64; A.pv = 256;
        A.pos = nullptr; A.slope2 = exp2f(-(float)(hh + 1)) * LOG2E; A.sink2 = swa_sink[hh] * LOG2E;
        const int q0 = qb * 512; const int k_lo = q0 - 128 < 0 ? 0 : q0 - 128, k_hi = q0 + 512 + 128 > SEQ ? SEQ : q0 + 512 + 128;
        const int tl = k_lo / 64, th = k_hi / 64;
        const unsigned long long tmask = (th >= 64 ? ~0ull : ((1ull << th) - 1ull)) & ~((1ull << tl) - 1ull);
        float res[2][2][16];
        att::ATT_CORE<64, 64, 2, 2, true>(A, q0, tmask, lds, res);
        bf16* O = (bf16*)(ws + (DRY ? WS_OB : WS_QC)) + rb * 512 + hh * 64;
        att::store_rows<2>(res[0], O, 512, q0 + F.wave * 64, lane); att::store_rows<2>(res[1], O, 512, q0 + F.wave * 64 + 32, lane);
    }
}
template <bool DRY> __device__ __forceinline__ void att_sec_B(const Frame& F, unsigned char* ws, int layer, const int* positions, const float* mla_qk_g) {
    int tid_ = threadIdx.x; asm volatile("" : "+v"(tid_)); const int tid = tid_, lane = tid & 63;
    LAS unsigned char* lds = F.lds + RING_OFF;
    constexpr int NU = NB * 8 * 8;
    unsigned* qbase = (unsigned*)(ws + WS_CTL) + 65536 + (layer * 2 + (DRY ? 1 : 0)) * 8 * 64;
    LAS int* nxt = (LAS int*)(F.lds + ATT_NXT_OFF);
    const int ngrp = 8, per_grp = NU / 8, myq = (F.vcu * 8) / F.G;
    int qi = 0;
    for (;;) {
        if (tid == 0) { int u_ = -1;
            while (qi < ngrp) { const int q = (myq + qi) % ngrp; const unsigned v = __hip_atomic_fetch_add(qbase + q * 64, 1u, __ATOMIC_RELAXED, __HIP_MEMORY_SCOPE_AGENT);
                if (v < (unsigned)per_grp) { u_ = q * per_grp + (int)v; break; } ++qi; }
            nxt[0] = u_; nxt[1] = qi; }
        __syncthreads();
        const int u = __builtin_amdgcn_readfirstlane(nxt[0]); qi = __builtin_amdgcn_readfirstlane(nxt[1]);
        __syncthreads();
        if (u < 0) break;
        const int b = u >> 6, h = (u >> 3) & 7, qb = u & 7;
        const size_t rb = (size_t)b * SEQ;
        att::Args A;
        A.Q = (const bf16*)(ws + WS_QB) + rb * 768 + h * 96; A.pq = 768;
        A.K = (const bf16*)(ws + WS_KB) + rb * 768 + h * 96; A.pk = 768;
        A.V = (const bf16*)(ws + WS_KVR) + rb * 1024 + 512 + h * 64; A.pv = 1024;
        A.pos = positions + rb; A.qg = mla_qk_g; A.slope2 = 0.f; A.sink2 = 0.f;
        float res[2][2][16];
        att::ATT_CORE<96, 64, 0, 2, true, true>(A, qb * 512, ~0ull, lds, res);
        bf16* O = (bf16*)(ws + WS_OB) + rb * 512 + h * 64;
        att::store_rows<2>(res[0], O, 512, qb * 512 + F.wave * 64, lane); att::store_rows<2>(res[1], O, 512, qb * 512 + F.wave * 64 + 32, lane);
    }
}
__device__ __forceinline__ void p_attention(const Frame& F, const float* diff_qk_g, const float* diff_lambda, const float* diff_out_g, const float* swa_sink, unsigned char* ws, const int* positions, int layer, const float* mla_qk_g) {
#if defined(PROBE_SEC_A)
    att_sec_A<true>(F, diff_qk_g, diff_lambda, diff_out_g, ws, positions, layer);
#elif defined(PROBE_SEC_B)
    att_sec_B<true>(F, ws, layer, positions, mla_qk_g);
#elif defined(PROBE_SEC_C)
    att_sec_C<true>(F, swa_sink, ws);
#endif
#ifndef SKIP_A
    att_sec_A<false>(F, diff_qk_g, diff_lambda, diff_out_g, ws, positions, layer);
#endif
#ifndef SKIP_C
    att_sec_C<false>(F, swa_sink, ws);
#endif
#ifndef SKIP_B
    att_sec_B<false>(F, ws, layer, positions, mla_qk_g);
#endif
}

#ifdef NAIVE_ATTN
template <int DQK, int DV, int MODE>
__device__ __forceinline__ void naive_row(const bf16* Q, const bf16* K, int pk, const bf16* V, int pv, const int* pos, int t, float slope2, float sink2, int lane, float (&out)[DV / 64]) {
    float m = -1e30f, l = 0.f, acc[DV];
#pragma unroll
    for (int d = 0; d < DV; ++d) acc[d] = 0.f;
    if (MODE == 2 && lane == 0) { m = sink2; l = 1.f; }
    const float pqf = MODE == 1 ? (float)pos[t] : (float)t;
    int k_lo = 0, k_hi = SEQ;
    if (MODE == 2) { k_lo = t - 128 < 0 ? 0 : t - 128; k_hi = t + 129 > SEQ ? SEQ : t + 129; }
    for (int k = k_lo + lane; k < k_hi; k += 64) {
        const bf16* kr = K + (size_t)k * pk; float s = 0.f;
#pragma unroll
        for (int d = 0; d < DQK; d += 2) { const unsigned w = *(const unsigned*)(kr + d); const unsigned qw = *(const volatile unsigned*)(Q + d); s = fmaf(bflo(qw), bflo(w), s); s = fmaf(bfhi(qw), bfhi(w), s); }
        if (MODE == 1) s -= slope2 * fabsf(pqf - (float)pos[k]);
        if (MODE == 2) s -= slope2 * fabsf(pqf - (float)k);
        const float mn = fmaxf(m, s), a = exp2f(m - mn), p = exp2f(s - mn);
        l = l * a + p; m = mn;
        const bf16* vr = V + (size_t)k * pv;
#pragma unroll
        for (int d = 0; d < DV; d += 2) { const unsigned w = *(const unsigned*)(vr + d); acc[d] = fmaf(p, bflo(w), acc[d] * a); acc[d + 1] = fmaf(p, bfhi(w), acc[d + 1] * a); }
    }
    float M = m;
#pragma unroll
    for (int o = 1; o < 64; o <<= 1) M = fmaxf(M, __shfl_xor(M, o));
    const float sc = exp2f(m - M);
    const float L = wave_sum(l * sc);
#pragma unroll
    for (int d = 0; d < DV; ++d) { const float v = wave_sum(acc[d] * sc) / L; if ((d & 63) == lane) out[d >> 6] = v; }
}
__device__ __forceinline__ void p_attention_naive(int vcu, int wave, int G, const float* diff_lambda, const float* diff_out_g, const float* swa_sink, unsigned char* ws, const int* positions, int layer) {
    int tid_ = threadIdx.x; asm volatile("" : "+v"(tid_)); const int lane = tid_ & 63;
    const int gw = vcu * NWAVES + wave, NGW = G * NWAVES;
    const float* lp = diff_lambda;
    const float s1 = wave_sum(lp[lane] * lp[64 + lane]), s2 = wave_sum(lp[128 + lane] * lp[192 + lane]);
    const float li = layer == 0 ? 0.2f : 0.35550906759096184f;
    const float lam = __expf(s1) - __expf(s2) + li, osc = 1.0f - li;
    for (int it = gw; it < T * 4; it += NGW) {
        const int row = it >> 2, h = it & 3, b = row >> 12, t = row & 4095; const size_t rb = (size_t)b * SEQ;
        bf16* Qr = (bf16*)(ws + WS_QA) + (size_t)row * 512 + h * 128;
        float o0[2], o1[2];
        naive_row<64, 128, 1>(Qr, (const bf16*)(ws + WS_KA) + rb * 512 + h * 64, 512, (const bf16*)(ws + WS_VA) + rb * 512 + h * 128, 512, positions + rb, t, exp2f(-2.0f * (float)(h + 1)) * LOG2E, 0.f, lane, o0);
        naive_row<64, 128, 1>(Qr + 64, (const bf16*)(ws + WS_KA) + rb * 512 + (4 + h) * 64, 512, (const bf16*)(ws + WS_VA) + rb * 512 + h * 128, 512, positions + rb, t, exp2f(-2.0f * (float)(h + 1)) * LOG2E, 0.f, lane, o1);
        const float v0 = o0[0] - lam * o1[0], v1 = o0[1] - lam * o1[1];
        const float rs = 1.0f / sqrtf(wave_sum(v0 * v0 + v1 * v1) * (1.0f / 128) + EPS);
        Qr[lane] = (bf16)(pk2(v0 * rs * diff_out_g[lane] * osc, 0.f) & 0xffffu); Qr[64 + lane] = (bf16)(pk2(v1 * rs * diff_out_g[64 + lane] * osc, 0.f) & 0xffffu);
    }
    for (int it = gw; it < T * 8; it += NGW) {
        const int row = it >> 3, h = it & 7, b = row >> 12, t = row & 4095; const size_t rb = (size_t)b * SEQ;
        float o[1];
        naive_row<96, 64, 0>((const bf16*)(ws + WS_QB) + (size_t)row * 768 + h * 96, (const bf16*)(ws + WS_KB) + rb * 768 + h * 96, 768, (const bf16*)(ws + WS_KVR) + rb * 1024 + 512 + h * 64, 1024, nullptr, t, 0.f, 0.f, lane, o);
        ((bf16*)(ws + WS_OB))[(size_t)row * 512 + h * 64 + lane] = (bf16)(pk2(o[0], 0.f) & 0xffffu);
    }
    for (int it = gw; it < T * 8; it += NGW) {
        const int row = it >> 3, hh = it & 7, g = hh >> 2, b = row >> 12, t = row & 4095; const size_t rb = (size_t)b * SEQ;
        bf16* Qr = (bf16*)(ws + WS_QC) + (size_t)row * 512 + hh * 64;
        float o[1];
        naive_row<64, 64, 2>(Qr, (const bf16*)(ws + WS_CQKC) + rb * 512 + 384 + g * 64, 512, (const bf16*)(ws + WS_VCKR) + rb * 256 + g * 64, 256, nullptr, t, exp2f(-(float)(hh + 1)) * LOG2E, swa_sink[hh] * LOG2E, lane, o);
        Qr[lane] = (bf16)(pk2(o[0], 0.f) & 0xffffu);
    }
}
#endif

__device__ __forceinline__ void p_norm2_router(const Frame& F, const bf16* x, const float* g, const float* w_router, unsigned char* h2, float* affT) {
    int tid_ = threadIdx.x; asm volatile("" : "+v"(tid_)); const int tid = tid_, lane = tid & 63;
    LAS bf16x8* wtab = (LAS bf16x8*)(F.lds + RING_OFF);
    LAS float* gtab = (LAS float*)(F.lds + RING_OFF + 32768);
    LAS float* rsl = (LAS float*)(F.lds + RING_OFF + 32768 + 4096) + F.wave * 16;
    for (int i = tid; i < 2048; i += NWAVES * 64) { const int kk = i >> 6, l = i & 63, e = l & 15, k0 = kk * 32 + (l >> 4) * 8;
        v4u w; w.x = pk2(w_router[(k0 + 0) * 16 + e] * g[k0 + 0], w_router[(k0 + 1) * 16 + e] * g[k0 + 1]); w.y = pk2(w_router[(k0 + 2) * 16 + e] * g[k0 + 2], w_router[(k0 + 3) * 16 + e] * g[k0 + 3]);
        w.z = pk2(w_router[(k0 + 4) * 16 + e] * g[k0 + 4], w_router[(k0 + 5) * 16 + e] * g[k0 + 5]); w.w = pk2(w_router[(k0 + 6) * 16 + e] * g[k0 + 6], w_router[(k0 + 7) * 16 + e] * g[k0 + 7]);
        wtab[i] = __builtin_bit_cast(bf16x8, w); }
    for (int i = tid; i < 1024; i += NWAVES * 64) gtab[i] = g[i];
    __syncthreads();
    const int gw = F.vcu * NWAVES + F.wave, NGW = F.G * NWAVES, r = lane & 15, kq = lane >> 4;
    for (int row0 = gw * 16; row0 < T; row0 += NGW * 16) {
        bf16x8 a[32];
        const bf16* xr = x + (size_t)(row0 + r) * DM + kq * 8;
#pragma unroll
        for (int kk = 0; kk < 32; ++kk) a[kk] = *(const bf16x8*)(xr + kk * 32);
        f32x4 acc = {0.f, 0.f, 0.f, 0.f}; float ss = 0.f;
#pragma unroll
        for (int kk = 0; kk < 32; ++kk) {
            acc = __builtin_amdgcn_mfma_f32_16x16x32_bf16(a[kk], wtab[kk * 64 + lane], acc, 0, 0, 0);
            const v4u w = __builtin_bit_cast(v4u, a[kk]);
            ss += (bflo(w.x) * bflo(w.x) + bfhi(w.x) * bfhi(w.x)) + (bflo(w.y) * bflo(w.y) + bfhi(w.y) * bfhi(w.y)) + (bflo(w.z) * bflo(w.z) + bfhi(w.z) * bfhi(w.z)) + (bflo(w.w) * bflo(w.w) + bfhi(w.w) * bfhi(w.w)); __builtin_amdgcn_sched_barrier(0); }
        ss = xor_add<16>(ss); ss = xor_add<32>(ss);
        const float rs = 1.0f / sqrtf(ss * (1.0f / DM) + EPS);
        if (kq == 0) rsl[r] = rs;
        LDS_WAIT(); asm volatile("" ::: "memory");
        const f32x4 rs4 = *(const LAS f32x4*)(rsl + 4 * kq);
        LDS_WAIT(); asm volatile("" ::: "memory");
        float af[4];
#pragma unroll
        for (int v = 0; v < 4; ++v) { const float lg = acc[v] * rs4[v];
            float mx = lg; mx = xor_max<1>(mx); mx = xor_max<2>(mx); mx = xor_max<4>(mx); mx = xor_max<8>(mx);
            const float ex = __expf(lg - mx); float den = ex; den = xor_add<1>(den); den = xor_add<2>(den); den = xor_add<4>(den); den = xor_add<8>(den);
            af[v] = ex / den; }
        { const int b = row0 >> 12, t0 = (row0 & 4095) + 4 * kq;
          *(f32x4*)(affT + ((size_t)(b * NEXP + r) << 12) + t0) = (f32x4){af[0], af[1], af[2], af[3]}; }
        unsigned char* hr = h2 + (size_t)(row0 + r) * DM + kq * 8;
#pragma unroll
        for (int kk = 0; kk < 32; ++kk) {
            v4u w = __builtin_bit_cast(v4u, a[kk]); asm volatile("" : "+v"(w));
            const f32x4 g0 = *(const LAS f32x4*)(gtab + kk * 32 + kq * 8), g1 = *(const LAS f32x4*)(gtab + kk * 32 + kq * 8 + 4);
            const f32x4 y0 = {bflo(w.x) * rs * g0[0], bfhi(w.x) * rs * g0[1], bflo(w.y) * rs * g0[2], bfhi(w.y) * rs * g0[3]}, y1 = {bflo(w.z) * rs * g1[0], bfhi(w.z) * rs * g1[1], bflo(w.w) * rs * g1[2], bfhi(w.w) * rs * g1[3]};
            const pg8::u32x2 o = pg8::pack8_fp8(y0, y1); v2u ov; ov.x = o.x; ov.y = o.y; *(v2u*)(hr + kk * 32) = ov; __builtin_amdgcn_sched_barrier(0); }
    }
    __syncthreads();
}

__device__ __forceinline__ void p_topk_gather(const Frame& F, unsigned char* ws) {
    int tid_ = threadIdx.x; asm volatile("" : "+v"(tid_)); const int tid = tid_, lane = tid & 63; (void)tid; (void)lane;
    LAS unsigned* red = (LAS unsigned*)(F.lds + RING_OFF);
    LAS unsigned* wtot = red + 16;
    LAS int* lidx = (LAS int*)(F.lds + RING_OFF + 256);
    const float* affT = (const float*)(ws + WS_AFFT); int* inv = (int*)(ws + WS_INV); int* idx = (int*)(ws + WS_IDX); float* affsel = (float*)(ws + WS_AFFSEL);
    const unsigned char* h2 = ws + WS_H; unsigned char* xg = ws + WS_XG;
    const int wid = F.wave;
    for (int u = F.vcu; u < NB * NEXP; u += F.G) {
        const int e = u >> 4, b = u & 15;
        const float* src = affT + ((size_t)(b * NEXP + e) << 12) + tid * 8;
        const f32x4 a0 = *(const f32x4*)src, a1 = *(const f32x4*)(src + 4);
        float v[8] = {a0.x, a0.y, a0.z, a0.w, a1.x, a1.y, a1.z, a1.w};
        unsigned long long key[8];
#pragma unroll
        for (int i = 0; i < 8; ++i) key[i] = ((unsigned long long)__float_as_uint(v[i]) << 12) | (unsigned long long)(4095 - (tid * 8 + i));
        unsigned long long Kth = 0ull; unsigned remaining = (unsigned)CAP;
        LAS unsigned* hist = (LAS unsigned*)(F.lds + RING_OFF + 4096);
        LAS unsigned* rres = hist + 256;
#pragma unroll 1
        for (int pass = 0; pass < 6; ++pass) {
            const int bits = pass < 5 ? 8 : 4, shift = pass < 5 ? 36 - 8 * pass : 0; const unsigned bmask = (1u << bits) - 1u;
            if (tid < 256) hist[tid] = 0u;
            __syncthreads();
#pragma unroll
            for (int i = 0; i < 8; ++i) if ((key[i] >> (shift + bits)) == (Kth >> (shift + bits))) __hip_atomic_fetch_add(hist + ((unsigned)(key[i] >> shift) & bmask), 1u, __ATOMIC_RELAXED, __HIP_MEMORY_SCOPE_WORKGROUP);
            __syncthreads();
            if (wid == 0) {
                const int b0 = 255 - 4 * lane; const unsigned c0 = hist[b0], c1 = hist[b0 - 1], c2 = hist[b0 - 2], c3 = hist[b0 - 3];
                unsigned incl = (c0 + c1) + (c2 + c3);
#pragma unroll
                for (int o = 1; o < 64; o <<= 1) { const unsigned y = (unsigned)__builtin_amdgcn_ds_bpermute(((lane - o) & 63) << 2, (int)incl); if (lane >= o) incl += y; }
                unsigned above = incl - ((c0 + c1) + (c2 + c3));
                const unsigned cc[4] = {c0, c1, c2, c3};
#pragma unroll
                for (int j = 0; j < 4; ++j) { if (above < remaining && remaining <= above + cc[j]) { rres[0] = (unsigned)(b0 - j); rres[1] = remaining - above; } above += cc[j]; }
            }
            __syncthreads();
            Kth |= (unsigned long long)rres[0] << shift; remaining = rres[1];
        }
        unsigned cnt = 0;
#pragma unroll
        for (int i = 0; i < 8; ++i) cnt += (key[i] >= Kth) ? 1u : 0u;
        unsigned incl = cnt;
#pragma unroll
        for (int o = 1; o < 64; o <<= 1) { const unsigned y = (unsigned)__builtin_amdgcn_ds_bpermute(((lane - o) & 63) << 2, (int)incl); if (lane >= o) incl += y; }
        __syncthreads();
        if (lane == 63) wtot[wid] = incl;
        __syncthreads();
        unsigned base = 0;
#pragma unroll
        for (int w = 0; w < 8; ++w) base += (w < wid) ? wtot[w] : 0u;
        unsigned slot = base + incl - cnt;
#pragma unroll
        for (int i = 0; i < 8; ++i) {
            const int t = tid * 8 + i; const bool sel = key[i] >= Kth;
            inv[((size_t)(b * SEQ + t) << 4) + e] = sel ? (int)slot : -1;
            if (sel) { if (slot < (unsigned)CAP) { lidx[slot] = t; idx[u * CAP + slot] = t; affsel[u * CAP + slot] = v[i]; } ++slot; }
        }
        __syncthreads();
        __syncthreads();
    }
}

template <bool NORM> __device__ __forceinline__ void p_combine(const Frame& F, unsigned char* ws, const bf16* xin, void* xout, const float* g, bf16* hout, unsigned char* h8out) {
    int tid_ = threadIdx.x; asm volatile("" : "+v"(tid_)); const int tid = tid_, lane = tid & 63; (void)tid; (void)lane;
    const int gw = F.vcu * NWAVES + F.wave, NGW = F.G * NWAVES;
    const int* inv = (const int*)(ws + WS_INV); const unsigned char* Y = ws + WS_XG;
    f32x4 gv[4];
#pragma unroll
    for (int j = 0; j < 4; ++j) { if (NORM) gv[j] = *((const f32x4*)g + lane + 64 * j); else gv[j] = (f32x4){0.f, 0.f, 0.f, 0.f}; }
    int sl[2]; v2u xw0[2][4];
#pragma unroll
    for (int rr = 0; rr < 2; ++rr) { sl[rr] = (lane < 16) ? inv[((size_t)(gw * 2 + rr) << 4) + lane] : -1;
        const v2u* xr = (const v2u*)(xin + (size_t)(gw * 2 + rr) * DM) + lane;
#pragma unroll
        for (int j = 0; j < 4; ++j) xw0[rr][j] = xr[64 * j]; }
    for (int row0 = gw * 2; row0 < T; row0 += NGW * 2) {
        int nsl[2]; v2u nxw[2][4]; f32x4 v[2][4];
        { const int rn = (row0 + NGW * 2 < T) ? row0 + NGW * 2 : row0;
#pragma unroll
        for (int rr = 0; rr < 2; ++rr) { nsl[rr] = (lane < 16) ? inv[((size_t)(rn + rr) << 4) + lane] : -1;
            const v2u* xr = (const v2u*)(xin + (size_t)(rn + rr) * DM) + lane;
#pragma unroll
            for (int j = 0; j < 4; ++j) nxw[rr][j] = xr[64 * j]; } }
#pragma unroll
        for (int rr = 0; rr < 2; ++rr)
#pragma unroll
            for (int j = 0; j < 4; ++j) { const v2u w = xw0[rr][j]; v[rr][j] = (f32x4){bflo(w.x), bfhi(w.x), bflo(w.y), bfhi(w.y)}; }
        unsigned long long mk0 = __ballot(sl[0] >= 0), mk1 = __ballot(sl[1] >= 0);
        while (mk0 | mk1) {
            unsigned yw[2][4][4]; bool val[2][4];
#pragma unroll
            for (int rr = 0; rr < 2; ++rr)
#pragma unroll
                for (int i = 0; i < 4; ++i) { unsigned long long& mk = rr ? mk1 : mk0; val[rr][i] = mk != 0ull;
                    if (val[rr][i]) { const int e = __builtin_ctzll(mk); mk &= mk - 1; const int s = __builtin_amdgcn_readlane(sl[rr], e); const int b = (row0 + rr) >> 12;
                        const unsigned* yr = (const unsigned*)(Y + ((size_t)(((e << 4) + b) * CAP + s) << 10)) + lane;
#pragma unroll
                        for (int j = 0; j < 4; ++j) yw[rr][i][j] = yr[64 * j]; }
                    else {
#pragma unroll
                        for (int j = 0; j < 4; ++j) yw[rr][i][j] = 0u; } }
#pragma unroll
            for (int rr = 0; rr < 2; ++rr)
#pragma unroll
                for (int i = 0; i < 4; ++i) if (val[rr][i]) {
#pragma unroll
                    for (int j = 0; j < 4; ++j) { const unsigned w = yw[rr][i][j]; const auto lo_ = __builtin_amdgcn_cvt_pk_f32_fp8((int)w, false), hi_ = __builtin_amdgcn_cvt_pk_f32_fp8((int)w, true);
                        v[rr][j].x += lo_[0] * (1.0f / Y_SCALE); v[rr][j].y += lo_[1] * (1.0f / Y_SCALE); v[rr][j].z += hi_[0] * (1.0f / Y_SCALE); v[rr][j].w += hi_[1] * (1.0f / Y_SCALE); } }
        }
#pragma unroll
        for (int rr = 0; rr < 2; ++rr) {
            if (NORM) { v2u* xw = (v2u*)((bf16*)xout + (size_t)(row0 + rr) * DM) + lane;
#pragma unroll
                for (int j = 0; j < 4; ++j) { v2u o; o.x = pk2(v[rr][j].x, v[rr][j].y); o.y = pk2(v[rr][j].z, v[rr][j].w); xw[64 * j] = o; } }
            else { f32x4* xw = (f32x4*)((float*)xout + (size_t)(row0 + rr) * DM) + lane;
#pragma unroll
                for (int j = 0; j < 4; ++j) xw[64 * j] = v[rr][j]; }
            if (NORM) { float s = 0.f;
#pragma unroll
                for (int j = 0; j < 4; ++j) s += (v[rr][j].x * v[rr][j].x + v[rr][j].y * v[rr][j].y) + (v[rr][j].z * v[rr][j].z + v[rr][j].w * v[rr][j].w);
                const float rs = 1.0f / sqrtf(wave_sum(s) * (1.0f / DM) + EPS);
                v2u* o8 = (v2u*)(hout + (size_t)(row0 + rr) * DM) + lane; unsigned* q8 = (unsigned*)(h8out + (size_t)(row0 + rr) * DM) + lane;
#pragma unroll
                for (int j = 0; j < 4; ++j) { const f32x4 y = {v[rr][j].x * rs * gv[j].x, v[rr][j].y * rs * gv[j].y, v[rr][j].z * rs * gv[j].z, v[rr][j].w * rs * gv[j].w};
                    v2u o; o.x = pk2(y.x, y.y); o.y = pk2(y.z, y.w); o8[64 * j] = o; q8[64 * j] = pk4_fp8(y); } } }
#pragma unroll
        for (int rr = 0; rr < 2; ++rr) { sl[rr] = nsl[rr];
#pragma unroll
            for (int j = 0; j < 4; ++j) xw0[rr][j] = nxw[rr][j]; }
    }
}

struct KArgs { const float* in[23]; const int* positions; float* out; unsigned char* ws; int ph_lo, ph_hi; };
static_assert(sizeof(KArgs) == 23 * 8 + 8 + 8 + 8 + 8, "KArgs has no padding");
__device__ __forceinline__ unsigned long long karg_u64(int off) {
    unsigned long long v; auto kp = __builtin_amdgcn_kernarg_segment_ptr();
    asm volatile("s_load_dwordx2 %0, %1, %2\n\ts_waitcnt lgkmcnt(0)" : "=&s"(v) : "s"(kp), "i"(off) : "memory"); return v; }
#define GASP __attribute__((address_space(1)))
#define KIN(k) ((const float*)(const GASP float*)karg_u64(8 * (k)))
#define KPOS() ((const int*)(const GASP int*)karg_u64(184))
#define KOUT() ((float*)(GASP float*)karg_u64(192))
#define KWS() ((unsigned char*)(GASP unsigned char*)karg_u64(200))
__device__ __forceinline__ LayerW layer_w(int layer) {
    LayerW L;
    L.norm_mix_g = KIN(2) + (size_t)layer * 1024; L.w_in = KIN(3) + (size_t)layer * 1024 * IN_COLS; L.diff_qk_g = KIN(4) + layer * 128; L.diff_lambda = KIN(5) + layer * 256;
    L.diff_out_g = KIN(6) + layer * 128; L.mla_cq_g = KIN(7) + layer * 384; L.w_uq = KIN(8) + (size_t)layer * 384 * 768; L.mla_ckv_g = KIN(9) + layer * 256;
    L.w_ukv = KIN(10) + (size_t)layer * 256 * 1024; L.mla_qk_g = KIN(11) + layer * 192; L.swa_qk_g = KIN(12) + layer * 128; L.swa_sink = KIN(13) + layer * 8;
    L.w_ba = KIN(14) + (size_t)layer * 512 * 1024; L.w_bb = KIN(15) + (size_t)layer * 512 * 1024; L.w_bc = KIN(16) + (size_t)layer * 512 * 1024; L.w_o = KIN(17) + (size_t)layer * 1024 * 1024;
    L.norm_ffn_g = KIN(18) + (size_t)layer * 1024; L.w_router = KIN(19) + (size_t)layer * 1024 * 16;
    L.w_eg = KIN(20) + (size_t)layer * 16 * 1024 * 1024; L.w_eu = KIN(21) + (size_t)layer * 16 * 1024 * 1024; L.w_ed = KIN(22) + (size_t)layer * 16 * 1024 * 1024;
    return L;
}


#ifdef DBG_CHECK
__device__ __forceinline__ unsigned hash_u(unsigned x) { x ^= x >> 16; x *= 0x7feb352du; x ^= x >> 15; x *= 0x846ca68bu; x ^= x >> 16; return x; }
__device__ __forceinline__ float bf2f(bf16 v) { return __uint_as_float((unsigned)v << 16); }
__device__ __forceinline__ void chk_report(unsigned* word, float a, float b, int lane) {
    const float err = fabsf(a - b) / (fabsf(b) + 0.1f);
    if (lane == 0) atomicMax(word, __float_as_uint(err));
}
__device__ __forceinline__ const bf16* proj_loc(unsigned char* ws, int row, int col) {
    const int r = win_row(col), pn = r >> 8, c = r & 255;
    if (pn < 10) return (const bf16*)(ws + WS_QA + (size_t)(pn >> 1) * 64 * MiB) + (size_t)row * 512 + (pn & 1) * 256 + c;
    return (const bf16*)(ws + WS_CKV + (size_t)(pn - 10) * 32 * MiB) + (size_t)row * 256 + c;
}
__device__ __forceinline__ float naive_proj(const bf16* h, const float* w_in, int row, int col, int lane) {
    float s = 0.f;
    for (int k = lane; k < 1024; k += 64) s = fmaf(bf2f(h[(size_t)row * 1024 + k]), w_in[(size_t)k * IN_COLS + col], s);
    return wave_sum(s);
}
__device__ __forceinline__ void p_check(int which, int gw, int NGW, int lane, unsigned char* ws, const float* const* dummy, const float* x_in, const float* xout, const LayerW& L, const int* positions) {
    unsigned* word = (unsigned*)(ws + WS_CTL) + 32768 + which * 64;
    const bf16* h = (const bf16*)(ws + WS_H);
    if (which == 0) {
        for (int s = gw; s < 2048; s += NGW) { const int row = hash_u(s * 2 + 1) % T, col = hash_u(s * 2 + 2) % 2976;
            chk_report(word, bf2f(*proj_loc(ws, row, col)), naive_proj(h, L.w_in, row, col, lane), lane); }
    } else if (which == 1) {
        for (int s = gw; s < 1536; s += NGW) { const int row = hash_u(s * 3 + 5) % T, type = s % 6; const unsigned hg = hash_u(s * 3 + 7);
            if (type < 4) { int c0; const float* g; float qs = 1.f;
                if (type == 0) { c0 = (hg % 8) * 64; g = L.diff_qk_g; qs = 0.125f * LOG2E; } else if (type == 1) { c0 = 512 + (hg % 8) * 64; g = L.diff_qk_g + 64; }
                else if (type == 2) { c0 = 2208 + (hg % 8) * 64; g = L.swa_qk_g; qs = 0.125f * LOG2E; } else { c0 = 2720 + (hg % 2) * 64; g = L.swa_qk_g + 64; }
                float v = 0.f; for (int k = 0; k < 1024; ++k) v = fmaf(bf2f(h[(size_t)row * 1024 + k]), L.w_in[(size_t)k * IN_COLS + c0 + lane], v);
                v = bf2f((bf16)(pk2(v, 0.f) & 0xffffu));
                const float rs = 1.0f / sqrtf(wave_sum(v * v) * (1.0f / 64) + EPS);
                chk_report(word, bf2f(*proj_loc(ws, row, c0 + lane)), v * rs * g[lane] * qs, lane);
                const float e2 = fabsf(bf2f(*proj_loc(ws, row, c0 + lane)) - v * rs * g[lane] * qs) / (fabsf(v * rs * g[lane] * qs) + 0.1f); float m = e2;
                for (int o = 1; o < 64; o <<= 1) m = fmaxf(m, __shfl_xor(m, o)); if (lane == 0) atomicMax(word, __float_as_uint(m));
            } else { const int ng = type == 4 ? 6 : 4, cb = type == 4 ? 1536 : 1920; const float* g = type == 4 ? L.mla_cq_g : L.mla_ckv_g;
                float v[6]; float ss = 0.f;
                _Pragma("unroll") for (int q = 0; q < 6; ++q) { float a = 0.f; if (q < ng) { for (int k = 0; k < 1024; ++k) a = fmaf(bf2f(h[(size_t)row * 1024 + k]), L.w_in[(size_t)k * IN_COLS + cb + q * 64 + lane], a); }
                    a = bf2f((bf16)(pk2(a, 0.f) & 0xffffu)); v[q] = a; ss += a * a; }
                const float rs = 1.0f / sqrtf(wave_sum(ss) / (float)(ng * 64) + EPS); float m = 0.f;
                _Pragma("unroll") for (int q = 0; q < 6; ++q) { if (q < ng) { const float want = v[q] * rs * g[q * 64 + lane]; m = fmaxf(m, fabsf(bf2f(*proj_loc(ws, row, cb + q * 64 + lane)) - want) / (fabsf(want) + 0.1f)); } }
                for (int o = 1; o < 64; o <<= 1) m = fmaxf(m, __shfl_xor(m, o)); if (lane == 0) atomicMax(word, __float_as_uint(m));
            } }
    } else if (which == 2) {
        const bf16* CQ = (const bf16*)(ws + WS_CQKC); const bf16* CKVn = (const bf16*)(ws + WS_CKV); const bf16* VCKR = (const bf16*)(ws + WS_VCKR);
        const bf16* QB = (const bf16*)(ws + WS_QB); const bf16* KB = (const bf16*)(ws + WS_KB);
        for (int s = gw; s < 1024; s += NGW) { const int row = hash_u(s * 5 + 11) % T, hd = hash_u(s * 5 + 13) % 8; const bool isq = s & 1;
            float nope = 0.f, rp = 0.f;
            if (isq) { for (int k = 0; k < 384; ++k) { const float a = bf2f(CQ[(size_t)row * 512 + k]); nope = fmaf(a, L.w_uq[(size_t)k * 768 + hd * 96 + lane], nope); rp = fmaf(a, L.w_uq[(size_t)k * 768 + hd * 96 + 64 + (lane & 31)], rp); } }
            else { for (int k = 0; k < 256; ++k) nope = fmaf(bf2f(CKVn[(size_t)row * 256 + k]), L.w_ukv[(size_t)k * 1024 + hd * 128 + lane], nope); rp = bf2f(VCKR[(size_t)row * 256 + 128 + (lane & 31)]); }
            nope = bf2f((bf16)(pk2(nope, 0.f) & 0xffffu)); if (isq) rp = bf2f((bf16)(pk2(rp, 0.f) & 0xffffu));
            const int i = lane & 15; const float ang = (float)positions[row] * (1.0f / powf(10000.0f, (float)i / 16.0f));
            const float cs = cosf(ang), sn = sinf(ang), other = __shfl_xor(rp, 16);
            float ro = (lane & 16) ? (other * sn + rp * cs) : (rp * cs - other * sn); if (lane >= 32) ro = 0.f;
            const float rs = 1.0f / sqrtf(wave_sum(nope * nope + ro * ro) * (1.0f / 96) + EPS);
            const float* g = L.mla_qk_g + (isq ? 0 : 96); const float qs = isq ? 0.10206207261596575f * LOG2E : 1.f;
            const bf16* dst = (isq ? QB : KB) + (size_t)row * 768 + hd * 96;
            const float w1 = nope * rs * g[lane] * qs; float m = fabsf(bf2f(dst[lane]) - w1) / (fabsf(w1) + 0.1f);
            if (lane < 32) { const float w2 = ro * rs * g[64 + lane] * qs; m = fmaxf(m, fabsf(bf2f(dst[64 + lane]) - w2) / (fabsf(w2) + 0.1f)); }
            for (int o = 1; o < 64; o <<= 1) m = fmaxf(m, __shfl_xor(m, o)); if (lane == 0) atomicMax(word, __float_as_uint(m)); }
    } else if (which == 3) {
        for (int s = gw; s < 2048; s += NGW) { const int row = hash_u(s * 2 + 21) % T, col = hash_u(s * 2 + 22) % 3072;
            const float z = naive_proj(h, L.w_in, row, 2976 + col, lane); const float want = 1.0f / (1.0f + __expf(-z));
            const int gi = col >> 10; const bf16* G = (const bf16*)(ws + (gi == 0 ? WS_G0 : (gi == 1 ? WS_G1 : WS_G2)));
            const float got = bf2f(G[(size_t)row * 1024 + (col & 1023)]);
            chk_report(word, got, want, lane);
            if (lane == 0) { atomicAdd(word + 1024 + gi * 64, 1u); if (fabsf(got - want) / (fabsf(want) + 0.1f) > 0.06f) atomicAdd(word + 2048 + gi * 64, 1u); } }
    } else if (which == 4) {
        for (int s = gw; s < 2048; s += NGW) { const int row = hash_u(s * 2 + 31) % T, c = hash_u(s * 2 + 32) % 1024; float want = 0.f;
            for (int i = 0; i < 3; ++i) { const bf16* O = (const bf16*)(ws + (i == 0 ? WS_QA : (i == 1 ? WS_OB : WS_QC))); const float* Wb = i == 0 ? L.w_ba : (i == 1 ? L.w_bb : L.w_bc);
                const bf16* G = (const bf16*)(ws + (i == 0 ? WS_G0 : (i == 1 ? WS_G1 : WS_G2)));
                float a = 0.f; for (int k = lane; k < 512; k += 64) a = fmaf(bf2f(O[(size_t)row * 512 + k]), Wb[(size_t)k * 1024 + c], a);
                want += bf2f(G[(size_t)row * 1024 + c]) * wave_sum(a); }
            chk_report(word, bf2f(h[(size_t)row * 1024 + c]), want, lane); }
    } else if (which == 6) {
        for (int s = gw; s < 2048; s += NGW) { const int row = hash_u(s * 2 + 51) % T; float ss = 0.f;
            for (int k = lane; k < 1024; k += 64) { const float v = x_in[(size_t)row * 1024 + k]; ss += v * v; }
            const float rs = 1.0f / sqrtf(wave_sum(ss) * (1.0f / 1024) + EPS); float m = 0.f;
            for (int k = lane; k < 1024; k += 64) { const float want = x_in[(size_t)row * 1024 + k] * rs * L.norm_mix_g[k]; m = fmaxf(m, fabsf(bf2f(h[(size_t)row * 1024 + k]) - want) / (fabsf(want) + 0.1f)); }
            for (int o = 1; o < 64; o <<= 1) m = fmaxf(m, __shfl_xor(m, o)); if (lane == 0) atomicMax(word, __float_as_uint(m)); }
    } else if (which == 7 || which == 8) {
        const bf16* wt = (const bf16*)(ws + WS_WIN);
        for (int s = gw; s < 4096; s += NGW) { const int col = which == 7 ? 2976 + (int)(hash_u(s * 2 + 61) % 3072) : (int)(hash_u(s * 2 + 61) % 2976); const int r = win_row(col); float m = 0.f;
            for (int k = lane; k < 1024; k += 64) { const float want = L.w_in[(size_t)k * IN_COLS + col]; m = fmaxf(m, fabsf(bf2f(wt[(size_t)r * 1024 + k]) - want) / (fabsf(want) + 0.01f)); }
            for (int o = 1; o < 64; o <<= 1) m = fmaxf(m, __shfl_xor(m, o)); if (lane == 0) atomicMax(word, __float_as_uint(m)); }
    } else if (which == 9) {
        const bf16* wt = (const bf16*)(ws + WS_WIN);
        for (int s = gw; s < 2048; s += NGW) { const int row = hash_u(s * 2 + 21) % T, col = hash_u(s * 2 + 22) % 3072; float a = 0.f;
            for (int k = lane; k < 1024; k += 64) a = fmaf(bf2f(h[(size_t)row * 1024 + k]), bf2f(wt[(size_t)(3072 + col) * 1024 + k]), a);
            const float z = wave_sum(a), want = 1.0f / (1.0f + __expf(-z));
            const int gi = col >> 10; const bf16* G = (const bf16*)(ws + (gi == 0 ? WS_G0 : (gi == 1 ? WS_G1 : WS_G2)));
            chk_report(word, bf2f(G[(size_t)row * 1024 + (col & 1023)]), want, lane); }
    } else {
        for (int s = gw; s < 2048; s += NGW) { const int row = hash_u(s * 2 + 41) % T, c = hash_u(s * 2 + 42) % 1024;
            float a = 0.f; for (int k = lane; k < 1024; k += 64) a = fmaf(bf2f(h[(size_t)row * 1024 + k]), L.w_o[(size_t)k * 1024 + c], a);
            const float d = wave_sum(a), got = xout[(size_t)row * 1024 + c] - x_in[(size_t)row * 1024 + c];
            chk_report(word, got, d, lane); }
    }
}
__device__ __forceinline__ void p_check_emit(int vcu, int G, unsigned char* ws, float* out) {
    int t_ = threadIdx.x; asm volatile("" : "+v"(t_));
    const unsigned* words = (const unsigned*)(ws + WS_CTL) + 32768;
    int code = 0;
#ifdef DBG_CHECK2
    { const int map_[5] = {6, 7, 8, 9, 3};
      if (__uint_as_float(words[6 * 64]) > 0.06f) code |= 1; if (__uint_as_float(words[7 * 64]) > 0.06f) code |= 2; if (__uint_as_float(words[8 * 64]) > 0.06f) code |= 4;
      if (__uint_as_float(words[9 * 64]) > 0.06f) code |= 8; if (__uint_as_float(words[3 * 64]) > 0.06f) code |= 16; (void)map_; }
#elif defined(DBG_GATEFRAC)
    { const unsigned* w3 = words + 3 * 64;
      for (int gi = 0; gi < 3; ++gi) { const unsigned n = w3[1024 + gi * 64], bad = w3[2048 + gi * 64]; const int f = bad == 0 ? 0 : (bad * 10 < n ? 1 : (bad * 2 < n ? 2 : 3)); code |= f << (2 * gi); } }
#else
    for (int i = 0; i < 6; ++i) if (__uint_as_float(words[i * 64]) > 0.06f) code |= 1 << i;
#endif
    for (size_t i = (size_t)vcu * 512 + t_; i < (size_t)T * DM; i += (size_t)G * 512) out[i] = 0.f;
    __syncthreads();
    if (vcu == 0 && t_ == 0) out[0] = exp2f((float)(code + 20));
}
#endif

__global__ void __launch_bounds__(NWAVES * 64, 2) fwd_kernel(KArgs args) {
    extern __shared__ __attribute__((aligned(16))) unsigned char lds_raw[];
    Frame F;
    F.lds = (LAS unsigned char*)lds_raw;
    F.wave = __builtin_amdgcn_readfirstlane((int)threadIdx.x >> 6);
    F.G = gridDim.x; { const int bx = blockIdx.x; F.vcu = (F.G % 8 == 0) ? (bx % 8) * (F.G / 8) + bx / 8 : bx; }
    volatile LAS unsigned* MISC = (volatile LAS unsigned*)(F.lds + MISC_OFF);
    for (int u = threadIdx.x; u < (LDS_BYTES - LDSCTL_OFF) / 4; u += NWAVES * 64) ((LAS unsigned*)(F.lds + LDSCTL_OFF))[u] = 0u;
    __syncthreads();
#define GRID_BARRIER() do { XcdBarrier b_; b_.bar = (unsigned*)(KWS() + WS_CTL) + 4096; b_.x = xb_xcc_id(); b_.st = (volatile LAS unsigned*)(F.lds + MISC_OFF) + 8; xcd_barrier(b_); } while (0)
#if !MK_MULTI
    (void)xcd_barrier_post((unsigned*)(KWS() + WS_CTL) + 4096, MISC + 8);
#endif
    const int lo = args.ph_lo, hi = args.ph_hi;
#ifdef DBG_CHECK
    if (lo >= 2000) { p_check_emit(F.vcu, F.G, KWS(), KOUT()); return; }
#ifdef DBG_CHECK2
    if (lo >= 1000 && lo < 2000) { const int ph = lo - 1000;
        for (int which = 6; which <= 9; ++which) { const bool run = (ph == 5 && which <= 8) || (ph == 6 && which == 9);
            if (run) { int t_ = threadIdx.x; asm volatile("" : "+v"(t_)); unsigned char* ws = KWS(); const LayerW L = layer_w(0);
                p_check(which, F.vcu * NWAVES + F.wave, F.G * NWAVES, t_ & 63, ws, nullptr, KIN(0), KOUT(), L, KPOS()); } }
    }
#endif
    if (lo >= 1000) { const int ph = lo - 1000; const int which = ph == 1 ? 0 : ph == 2 ? 1 : ph == 4 ? 2 : ph == 6 ? 3 : ph == 9 ? 4 : ph == 10 ? 5 : -1;
        if (which >= 0) { int t_ = threadIdx.x; asm volatile("" : "+v"(t_)); unsigned char* ws = KWS(); const LayerW L = layer_w(0);
            p_check(which, F.vcu * NWAVES + F.wave, F.G * NWAVES, t_ & 63, ws, nullptr, KIN(0), KOUT(), L, KPOS()); }
        return; }
#endif
#ifdef ONLY_PHASE
#define IN(k) ((((k) % PH_PER_LAYER) == ONLY_PHASE) && lo <= (k) && (k) < hi)
#else
#ifdef SKIP_FFN
#define IN(k) ((((k) % PH_PER_LAYER) < 11) && lo <= (k) && (k) < hi)
#else
#define IN(k) (lo <= (k) && (k) < hi)
#endif
#endif
#if MK_MULTI
#define SEAM(k) do { } while (0)
#else
#define SEAM(k) do { if (IN((k) + 1)) { GRID_BARRIER(); } } while (0)
#endif
#define CHK(ph, which) do { } while (0)
#ifndef ST_MERGE
#define ST_MERGE 1400
#endif
#ifndef ST_WO
#define ST_WO 2000
#endif
#ifdef STAGGER_ON
#define STAGGER(ticks) do { if (F.vcu & 1) { const unsigned long long t0_ = __builtin_amdgcn_s_memrealtime(); while (__builtin_amdgcn_s_memrealtime() - t0_ < (unsigned long long)(ticks)) __builtin_amdgcn_s_sleep(8); } } while (0)
#else
#define STAGGER(ticks) do { } while (0)
#endif
#define GEMM_RUN(EPI, g, E) do { pg8::StaticOrder S_; S_.init((g).M, (g).N, F.G, (int)blockIdx.x); pg8::gemm_phase<EPI, pg8::StaticOrder, true, true>(F.lds + RING_OFF, g, S_, E); } while (0)
#define GEMM_RUN_F8(EPI, g, E) do { pg8::StaticOrder S_; S_.init((g).M, (g).N, F.G, (int)blockIdx.x); pg8::gemm_phase<EPI, pg8::StaticOrder, true, true, true>(F.lds + RING_OFF, g, S_, E); } while (0)
#ifdef DUP_SMALL
#define GEMM_RUN3(EPI, g, E) do { GEMM_RUN(EPI, g, E); GRID_BARRIER(); GEMM_RUN(EPI, g, E); } while (0)
#else
#define GEMM_RUN3(EPI, g, E) GEMM_RUN(EPI, g, E)
#endif
#ifdef DUP_GEMM_PLAIN
#define GEMM_RUN2(EPI, g, E) do { { pg8::EpiPlain EN_{(bf16*)(KWS() + WS_QB), 3072}; GEMM_RUN(pg8::EpiPlain, g, EN_); } GRID_BARRIER(); GEMM_RUN(EPI, g, E); } while (0)
#elif defined(DUP_GEMM_NULL)
#define GEMM_RUN2(EPI, g, E) do { { pg8::EpiNull EN_; GEMM_RUN(pg8::EpiNull, g, EN_); } GRID_BARRIER(); GEMM_RUN(EPI, g, E); } while (0)
#elif defined(DUP_GEMM)
#define GEMM_RUN2(EPI, g, E) do { GEMM_RUN(EPI, g, E); GRID_BARRIER(); GEMM_RUN(EPI, g, E); } while (0)
#else
#define GEMM_RUN2(EPI, g, E) GEMM_RUN(EPI, g, E)
#endif
    for (int layer = 0; layer < DEPTH; ++layer) {
        const int P = layer * PH_PER_LAYER;
#ifdef DUP_P0
        if (IN(P + 0)) { unsigned char* ws = KWS(); const LayerW L = layer_w(layer); p_convert(F, L, ws); p_tile_minmax(F, ws, KPOS()); if (layer == 0) p_norm1(F, KIN(0), L.norm_mix_g, (bf16*)(ws + WS_H), (unsigned char*)KOUT() + H8_OUT_OFF);     GRID_BARRIER(); }
#endif
        if (IN(P + 0)) { unsigned char* ws = KWS(); const LayerW L = layer_w(layer); p_convert(F, L, ws); p_tile_minmax(F, ws, KPOS()); if (layer == 0) p_norm1(F, KIN(0), L.norm_mix_g, (bf16*)(ws + WS_H), (unsigned char*)KOUT() + H8_OUT_OFF);     SEAM(P + 0); }
        if (IN(P + 1)) {
            unsigned char* ws = KWS();
            pg8::Gemm g{(const bf16*)(ws + WS_H), (const bf16*)(ws + WS_WIN), T, 3072, 1024, 1024, 1, 1, 0};
            pg8::EpiRouteNorm E{(bf16*)(ws + WS_QA), (size_t)(64 * MiB / 2), (bf16*)(ws + WS_CKV), (size_t)(32 * MiB / 2), (const float*)(ws + WS_GT), (float*)(ws + WS_SSP), EPS, KPOS(), KIN(11) + layer * 192 + 160};
            GEMM_RUN2(pg8::EpiRouteNorm, g, E); SEAM(P + 1); }
        CHK(1, 0);
#ifdef DUP_BAR
        if (IN(P + 2)) { for (int i_ = 0; i_ < 10; ++i_) GRID_BARRIER(); }
#endif
        CHK(2, 1);
        if (IN(P + 3)) {
            unsigned char* ws = KWS();
            pg8::Gemm g{(const bf16*)(ws + WS_CQKC), (const bf16*)(ws + WS_WUQ), T, 768, 384, 512, 1, 1, 0};
            pg8::EpiPlainRS E{(bf16*)(ws + WS_QB), 768, (const float*)(ws + WS_SSP), 0, 6, 1.0f / 384, EPS}; GEMM_RUN3(pg8::EpiPlainRS, g, E); }
        if (IN(P + 3)) {
            unsigned char* ws = KWS();
            pg8::Gemm g{(const bf16*)(ws + WS_CKV), (const bf16*)(ws + WS_WUKV), T, 1024, 256, 256, 1, 1, 0};
            pg8::EpiKV E{(bf16*)(ws + WS_KB), (bf16*)(ws + WS_KVR), (const bf16*)(ws + WS_VCKR) + 128, (const float*)(ws + WS_SSP), KIN(11) + layer * 192 + 96, EPS}; GEMM_RUN(pg8::EpiKV, g, E); SEAM(P + 4); }
        CHK(4, 2);
#ifdef NAIVE_ATTN
        if (IN(P + 5)) { unsigned char* ws = KWS(); p_attention_naive(F.vcu, F.wave, F.G, KIN(5) + layer * 256, KIN(6) + layer * 128, KIN(13) + layer * 8, ws, KPOS(), layer); SEAM(P + 5); }
#else
        if (IN(P + 5)) { unsigned char* ws = KWS(); p_attention(F, KIN(4) + layer * 128, KIN(5) + layer * 256, KIN(6) + layer * 128, KIN(13) + layer * 8, ws, KPOS(), layer, KIN(11) + layer * 192); SEAM(P + 5); }
#endif
        if (IN(P + 6)) {
            unsigned char* ws = KWS();
            pg8::Gemm g{(const bf16*)((unsigned char*)KOUT() + H8_OUT_OFF), (const bf16*)(ws + WS_WG8), T, 3072, 512, 512, 1, 1, 0, 0, 0};
            pg8::EpiGate E{ws + WS_G0, (size_t)(64 * MiB), (size_t)0, -LOG2E / W8_SCALE};
            GEMM_RUN_F8(pg8::EpiGate, g, E); SEAM(P + 6); }
#define MERGE3_RUN() do { unsigned char* ws = KWS(); \
            pg8::Gemm g{(const bf16*)(ws + WS_QA), (const bf16*)(ws + WS_WBA), 3 * T, 1024, 512, 512, 256, 3, (size_t)(1 * MiB), 0, 0, (size_t)(WS_OB - WS_QA - 128 * MiB)}; \
            pg8::EpiMerge3 E{ws + WS_G0, (bf16*)(ws + WS_H)}; \
            pg8::MergeOrder S_; S_.S.init(T, 1024, F.G, (int)blockIdx.x); pg8::gemm_phase<pg8::EpiMerge3, pg8::MergeOrder, true, true>(F.lds + RING_OFF, g, S_, E); } while (0)
        if (IN(P + 7)) {
            MERGE3_RUN(); SEAM(P + 9); }
#ifdef DUP_MERGE
        if (IN(P + 7)) { GRID_BARRIER(); MERGE3_RUN(); GRID_BARRIER(); }
#endif
        CHK(9, 4);
        if (IN(P + 10)) {
            unsigned char* ws = KWS(); float* xo = KOUT();
            pg8::Gemm g{(const bf16*)(ws + WS_H), (const bf16*)(ws + WS_WO), T, 1024, 1024, 1024, 1, 1, 0};
            pg8::EpiResid E{layer == 0 ? (const void*)KIN(0) : (const void*)xo, layer != 0, (bf16*)(ws + WS_XB)}; STAGGER(ST_WO); GEMM_RUN(pg8::EpiResid, g, E); SEAM(P + 10); }
        CHK(10, 5);
#ifdef DUP_P11
        if (IN(P + 11)) { unsigned char* ws = KWS(); p_norm2_router(F, (const bf16*)(ws + WS_XB), KIN(18) + (size_t)layer * 1024, KIN(19) + (size_t)layer * 1024 * 16, ws + WS_H, (float*)(ws + WS_AFFT)); GRID_BARRIER(); }
#endif
        if (IN(P + 11)) { unsigned char* ws = KWS(); p_norm2_router(F, (const bf16*)(ws + WS_XB), KIN(18) + (size_t)layer * 1024, KIN(19) + (size_t)layer * 1024 * 16, ws + WS_H, (float*)(ws + WS_AFFT)); SEAM(P + 11); }
#ifdef DUP_P12
        if (IN(P + 12)) { unsigned char* ws = KWS(); p_topk_gather(F, ws); GRID_BARRIER(); }
#endif
        if (IN(P + 12)) { unsigned char* ws = KWS(); p_topk_gather(F, ws); SEAM(P + 12); }
        if (IN(P + 13)) {
            unsigned char* ws = KWS();
            pg8::Gemm g{(const bf16*)(ws + WS_H), (const bf16*)(ws + WS_WGU), TE, 2048, 512, 512, 32, 16, (size_t)2048 * 1024, W8_E8M0, ONE_E8M0, (size_t)0, (const int*)(ws + WS_IDX)};
            pg8::EpiSwiglu E{ws + WS_HID, 1.0f / W8_SCALE, HID_SCALE};
            { pg8::StaticOrder S_; S_.init(g.M, g.N, F.G, (int)blockIdx.x); pg8::gemm_phase<pg8::EpiSwiglu, pg8::StaticOrder, true, true, true, true>(F.lds + RING_OFF, g, S_, E); }
            SEAM(P + 13); }
        if (IN(P + 14)) {
            unsigned char* ws = KWS();
            pg8::Gemm g{(const bf16*)(ws + WS_HID), (const bf16*)(ws + WS_WD), TE, 1024, 512, 512, 32, 16, (size_t)1024 * 1024, W8_E8M0, HID_E8M0};
            pg8::EpiDown E{ws + WS_XG, (const float*)(ws + WS_AFFSEL), Y_SCALE / (W8_SCALE * HID_SCALE)}; GEMM_RUN_F8(pg8::EpiDown, g, E); SEAM(P + 14); }
#ifdef DUP_P15
        if (IN(P + 15)) { unsigned char* ws = KWS(); if (layer + 1 < DEPTH) p_combine<true>(F, ws, (const bf16*)(ws + WS_XB), KOUT(), KIN(2) + (size_t)(layer + 1) * 1024, (bf16*)(ws + WS_H), (unsigned char*)KOUT() + H8_OUT_OFF); else p_combine<false>(F, ws, (const bf16*)(ws + WS_XB), KOUT(), nullptr, nullptr, nullptr); GRID_BARRIER(); }
#endif
        if (IN(P + 15)) { unsigned char* ws = KWS(); if (layer + 1 < DEPTH) p_combine<true>(F, ws, (const bf16*)(ws + WS_XB), KOUT(), KIN(2) + (size_t)(layer + 1) * 1024, (bf16*)(ws + WS_H), (unsigned char*)KOUT() + H8_OUT_OFF); else p_combine<false>(F, ws, (const bf16*)(ws + WS_XB), KOUT(), nullptr, nullptr, nullptr); SEAM(P + 15); }
    }
#undef IN
#undef SEAM
}

extern "C" void kernel_launch(void* const* d_in, const int* in_sizes, int n_in, void* d_out, int out_size, void* d_ws, size_t ws_size, hipStream_t stream) {
    static int grid = 0;
    if (grid == 0) {
        if (n_in != 23 || in_sizes[0] != T * DM || out_size != T * DM || ws_size < WS_END) { fprintf(stderr, "kernel_launch: shape/workspace mismatch (n_in %d, ws %zu < %zu)\n", n_in, ws_size, (size_t)WS_END); grid = -1; return; }
        int dev = 0, cus = 0, per_cu = 0;
        if (hipGetDevice(&dev) != hipSuccess || hipDeviceGetAttribute(&cus, hipDeviceAttributeMultiprocessorCount, dev) != hipSuccess) { grid = -1; return; }
        if (hipFuncSetAttribute((const void*)fwd_kernel, hipFuncAttributeMaxDynamicSharedMemorySize, LDS_BYTES) != hipSuccess) { fprintf(stderr, "kernel_launch: hipFuncSetAttribute failed\n"); grid = -1; return; }
        if (hipOccupancyMaxActiveBlocksPerMultiprocessor(&per_cu, (const void*)fwd_kernel, NWAVES * 64, LDS_BYTES) != hipSuccess || per_cu < 1) { fprintf(stderr, "kernel_launch: occupancy query reports %d\n", per_cu); }
        (void)hipGetLastError();
        grid = cus;
    }
    if (grid < 0) return;
    if (hipMemsetAsync((char*)d_ws + WS_CTL, 0, CTL_ZERO_BYTES, stream) != hipSuccess) return;
    KArgs a{};
    for (int i = 0; i < 23; ++i) a.in[i] = (const float*)d_in[i];
    a.positions = (const int*)d_in[1]; a.out = (float*)d_out; a.ws = (unsigned char*)d_ws;
#if MK_MULTI
#ifdef DBG_CHECK
    for (int p = 0; p <= 10; ++p) { a.ph_lo = p; a.ph_hi = p + 1; hipLaunchKernelGGL(fwd_kernel, dim3(grid), dim3(NWAVES * 64), LDS_BYTES, stream, a);
        a.ph_lo = 1000 + p; a.ph_hi = 1001 + p; hipLaunchKernelGGL(fwd_kernel, dim3(grid), dim3(NWAVES * 64), LDS_BYTES, stream, a); }
    a.ph_lo = 2000; a.ph_hi = 2001; hipLaunchKernelGGL(fwd_kernel, dim3(grid), dim3(NWAVES * 64), LDS_BYTES, stream, a);
#else
    for (int p = 0; p < NPHASE; ++p) { a.ph_lo = p; a.ph_hi = p + 1; hipLaunchKernelGGL(fwd_kernel, dim3(grid), dim3(NWAVES * 64), LDS_BYTES, stream, a); }
#endif
#else
    a.ph_lo = 0; a.ph_hi = NPHASE;
    hipLaunchKernelGGL(fwd_kernel, dim3(grid), dim3(NWAVES * 64), LDS_BYTES, stream, a);
#endif
    const hipError_t le = hipPeekAtLastError();
    if (le != hipSuccess) fprintf(stderr, "kernel_launch: launch failed: %s\n", hipGetErrorName(le));
}
```

```cpp
#include <hip/hip_runtime.h>
#include <cstdio>
#include <cstdint>

#ifndef MK_MULTI
#define MK_MULTI 0
#endif

namespace pg8 {
#define PG8_LAS __attribute__((address_space(3)))
typedef unsigned short bf16_t;
typedef short bf16x8 __attribute__((ext_vector_type(8)));
typedef float f32x4 __attribute__((ext_vector_type(4)));
typedef unsigned u32x4 __attribute__((ext_vector_type(4)));
typedef unsigned u32x2 __attribute__((ext_vector_type(2)));
typedef float f32x2 __attribute__((ext_vector_type(2)));
constexpr int BM = 256, BK = 64, HALF = 128, HTB = HALF * BK * 2  , STAGE_BYTES = 8 * HTB, NXCD = 8, WGM = 8;

__host__ __device__ __forceinline__ int lds_byte(int r, int c) { const int st = (r >> 4) * 2 + (c >> 5), rr = r & 15, cc = c & 31, ob = rr * 64 + cc * 2; return st * 1024 + (ob ^ (((ob >> 9) & 1) << 5)); }
__host__ __device__ __forceinline__ void stage_rc(int b, int& R, int& C) { const int st = b / 1024, sb = b % 1024, swz = sb ^ (((sb >> 9) & 1) << 5); R = (st >> 1) * 16 + swz / 64; C = (st & 1) * 32 + (swz % 64) / 2; }
__host__ __device__ __forceinline__ int perm32(int rho) { const int n = rho >> 4, i = rho & 15; return 8 * (i >> 2) + 4 * n + (i & 3); }

struct Unit { int pm, pn; };
struct Gemm { const bf16_t* A; const bf16_t* Bt; int M, N, K, lda; int pm_per_grp, ngrp; size_t grp_bytes; int sc_w, sc_x; size_t a_extra; const int* rowmap;
    __device__ __forceinline__ size_t grp_off(int pm) const { return ngrp > 1 ? (size_t)((pm / pm_per_grp) % ngrp) * grp_bytes : (size_t)0; } };

typedef int v8i_t __attribute__((ext_vector_type(8))); typedef int v4i_t __attribute__((ext_vector_type(4)));
__device__ __forceinline__ v8i_t cat8(bf16x8 lo, bf16x8 hi) { return __builtin_shufflevector(__builtin_bit_cast(v4i_t, lo), __builtin_bit_cast(v4i_t, hi), 0, 1, 2, 3, 4, 5, 6, 7); }
struct StaticOrder {
    int nM, nN, nwg, G, c;
    __host__ __device__ void init(int M, int N, int G_, int c_) { nM = M / BM; nN = N / BM; nwg = nM * nN; G = G_; c = c_; }
    __host__ __device__ bool next(int i, Unit& u) const {
        const long L = (long)i * G + c; if (L >= nwg) return false;
        int wgid = (int)L; { const int q = nwg / NXCD, r = nwg % NXCD, xcd = wgid % NXCD, off = wgid / NXCD; wgid = (xcd < r ? xcd * (q + 1) : r * (q + 1) + (xcd - r) * q) + off; }
        const int nig = WGM * nN, gid = wgid / nig, fm = gid * WGM, gsz = (nM - fm) < WGM ? (nM - fm) : WGM;
        u.pm = fm + ((wgid % nig) % gsz); u.pn = (wgid % nig) / gsz; return true;
    }
    __device__ __forceinline__ void a_ready(const Unit&) const {}
    __device__ __forceinline__ void done(const Unit&) const {}
};

struct MergeOrder { StaticOrder S;
    __device__ __forceinline__ bool next(int i, Unit& u) const { const int t = i / 3, seg = i - 3 * t; if (!S.next(t, u)) return false; u.pm += seg * 256; return true; }
    __device__ __forceinline__ void a_ready(const Unit&) const {}
    __device__ __forceinline__ void done(const Unit&) const {}
};

typedef float f32x2_t __attribute__((ext_vector_type(2))); typedef __bf16 bf16x2_t __attribute__((ext_vector_type(2)));
__device__ __forceinline__ unsigned cvt_pk_bf16(float lo, float hi) { f32x2_t v = {lo, hi}; bf16x2_t b = __builtin_convertvector(v, bf16x2_t); return __builtin_bit_cast(unsigned, b); }
__device__ __forceinline__ float bf_lo(unsigned w) { return __uint_as_float(w << 16); }
__device__ __forceinline__ float bf_hi(unsigned w) { return __uint_as_float(w & 0xffff0000u); }

__device__ __forceinline__ float lane_xor32(float v) { const unsigned b_ = __float_as_uint(v); auto r_ = __builtin_amdgcn_permlane32_swap(b_, b_, false, false); return __uint_as_float(r_[0] ^ r_[1] ^ b_); }
#define PG8_EPI_LOOP(...) \
    _Pragma("unroll") for (int ai = 0; ai < 2; ++ai) _Pragma("unroll") for (int m = 0; m < 4; ++m) _Pragma("unroll") for (int bj = 0; bj < 2; ++bj) { \
        const int row = u.pm * BM + ai * HALF + wr * 64 + m * 16 + fr; const int ct = bj * HALF + wc * 32 + 8 * fq;   \
        f32x4 v0 = acc[ai][bj][m][0], v1 = acc[ai][bj][m][1]; __VA_ARGS__ }
__device__ __forceinline__ u32x4 pack8(f32x4 v0, f32x4 v1) { u32x4 w; w.x = cvt_pk_bf16(v0[0], v0[1]); w.y = cvt_pk_bf16(v0[2], v0[3]); w.z = cvt_pk_bf16(v1[0], v1[1]); w.w = cvt_pk_bf16(v1[2], v1[3]); return w; }

struct EpiPlain { static constexpr bool PERM = true, AFTER_DRAIN = false, SEG3 = false; bf16_t* O; int ldc;
    __device__ __forceinline__ void operator()(const f32x4 (&acc)[2][2][4][2], const Unit& u, int wr, int wc, int fr, int fq) const {
        PG8_EPI_LOOP({ *(u32x4*)(O + (size_t)row * ldc + u.pn * BM + ct) = pack8(v0, v1); }) } };
struct EpiRoute { static constexpr bool PERM = true, AFTER_DRAIN = false, SEG3 = false; bf16_t* five; size_t five_stride; bf16_t* tail; size_t tail_stride;
    __device__ __forceinline__ void operator()(const f32x4 (&acc)[2][2][4][2], const Unit& u, int wr, int wc, int fr, int fq) const {
        bf16_t* base; int ldc, c0;
        if (u.pn < 10) { base = five + (size_t)(u.pn >> 1) * five_stride; ldc = 512; c0 = (u.pn & 1) * 256; } else { base = tail + (size_t)(u.pn - 10) * tail_stride; ldc = 256; c0 = 0; }
        PG8_EPI_LOOP({ *(u32x4*)(base + (size_t)row * ldc + c0 + ct) = pack8(v0, v1); }) } };
struct EpiRouteNorm { static constexpr bool PERM = true, AFTER_DRAIN = false, SEG3 = false; bf16_t* five; size_t five_stride; bf16_t* tail; size_t tail_stride; const float* gt; float* ssp; float eps; const int* pos; const float* gkr;
    __device__ __forceinline__ void operator()(const f32x4 (&acc)[2][2][4][2], const Unit& u, int wr, int wc, int fr, int fq) const {
        bf16_t* base; int ldc, c0;
        if (u.pn < 10) { base = five + (size_t)(u.pn >> 1) * five_stride; ldc = 512; c0 = (u.pn & 1) * 256; } else { base = tail + (size_t)(u.pn - 10) * tail_stride; ldc = 256; c0 = 0; }
        const bool nrm = (u.pn < 6) || (u.pn == 9 && wc >= 2);
        const bool krw = (u.pn == 11 && wc == 2);
        const bool part = (u.pn == 8) || (u.pn == 9 && wc < 2) || (u.pn == 10) || krw;
        const int gi = u.pn < 2 ? 0 : (u.pn < 4 ? 1 : (u.pn < 6 ? 2 : 3));
        const int slot = u.pn == 8 ? wc : (u.pn == 9 ? 4 + wc : (u.pn == 10 ? 8 + wc : 12));
        float kc_[8], kg_[8];
        if (krw) {
#pragma unroll
            for (int j = 0; j < 8; ++j) { kc_[j] = __builtin_amdgcn_exp2f(-(float)(8 * (fq & 1) + j) * 0.83048202372184f) * 0.15915494309189535f; kg_[j] = gkr[8 * fq + j]; } }
        f32x4 g00 = {1.f, 1.f, 1.f, 1.f}, g01 = g00, g10 = g00, g11 = g00;
        if (nrm) { const float* gp = gt + gi * 64 + 8 * fq; g00 = *(const f32x4*)gp; g01 = *(const f32x4*)(gp + 4); g10 = *(const f32x4*)(gp + 32); g11 = *(const f32x4*)(gp + 36); }
#pragma unroll
        for (int ai = 0; ai < 2; ++ai)
#pragma unroll
            for (int m = 0; m < 4; ++m) { const int row = u.pm * BM + ai * HALF + wr * 64 + m * 16 + fr;
                f32x4 v00 = acc[ai][0][m][0], v01 = acc[ai][0][m][1], v10 = acc[ai][1][m][0], v11 = acc[ai][1][m][1];
                if (nrm || part) {
                    float ss = 0.f;
#pragma unroll
                    for (int i = 0; i < 4; ++i) ss += (v00[i] * v00[i] + v01[i] * v01[i]) + (v10[i] * v10[i] + v11[i] * v11[i]);
                    { auto r_ = __builtin_amdgcn_permlane16_swap(__float_as_uint(ss), __float_as_uint(ss), false, false); ss = __uint_as_float(r_[0]) + __uint_as_float(r_[1]); }
                    { auto r_ = __builtin_amdgcn_permlane32_swap(__float_as_uint(ss), __float_as_uint(ss), false, false); ss = __uint_as_float(r_[0]) + __uint_as_float(r_[1]); }
                    if (nrm) { const float rs = __builtin_amdgcn_rsqf(ss * (1.0f / 64) + eps); v00 = v00 * rs * g00; v01 = v01 * rs * g01; v10 = v10 * rs * g10; v11 = v11 * rs * g11; }
                    if (part && fq == 0) ssp[(size_t)row * 16 + slot] = ss;
                }
                if (krw) {
                    const float posf = (float)pos[row];
#pragma unroll
                    for (int j = 0; j < 8; ++j) { const float own = j < 4 ? v00[j & 3] : v01[j & 3]; const float other = lane_xor32(own);
                        const float fr_ = __builtin_amdgcn_fractf(posf * kc_[j]); const float cs = __builtin_amdgcn_cosf(fr_), sn = __builtin_amdgcn_sinf(fr_);
                        const float o_ = (fq < 2 ? (own * cs - other * sn) : (other * sn + own * cs)) * kg_[j];
                        if (j < 4) v00[j & 3] = o_; else v01[j & 3] = o_; }
                }
                bf16_t* rp = base + (size_t)row * ldc + c0 + wc * 64 + 8 * fq;
                *(u32x4*)rp = pack8(v00, v01); *(u32x4*)(rp + 32) = pack8(v10, v11); } } };
struct EpiPlainRS { static constexpr bool PERM = true, AFTER_DRAIN = false, SEG3 = false; bf16_t* O; int ldc; const float* ssp; int s0, ns; float inv_n, eps;
    __device__ __forceinline__ void operator()(const f32x4 (&acc)[2][2][4][2], const Unit& u, int wr, int wc, int fr, int fq) const {
        float rs[2][4];
#pragma unroll
        for (int ai = 0; ai < 2; ++ai)
#pragma unroll
            for (int m = 0; m < 4; ++m) { const int row = u.pm * BM + ai * HALF + wr * 64 + m * 16 + fr;
                const float* sp = ssp + (size_t)row * 16 + s0; const f32x4 a = *(const f32x4*)sp; float ss = (a[0] + a[1]) + (a[2] + a[3]);
                if (ns > 4) { const f32x2 b = *(const f32x2*)(sp + 4); ss += b[0] + b[1]; }
                rs[ai][m] = __builtin_amdgcn_rsqf(ss * inv_n + eps); }
        __builtin_amdgcn_sched_barrier(0);
#pragma unroll
        for (int ai = 0; ai < 2; ++ai)
#pragma unroll
            for (int m = 0; m < 4; ++m) { const int row = u.pm * BM + ai * HALF + wr * 64 + m * 16 + fr;
#pragma unroll
                for (int bj = 0; bj < 2; ++bj) { const int ct = bj * HALF + wc * 32 + 8 * fq;
                    *(u32x4*)(O + (size_t)row * ldc + u.pn * BM + ct) = pack8(acc[ai][bj][m][0] * rs[ai][m], acc[ai][bj][m][1] * rs[ai][m]); } } } };
struct EpiKV { static constexpr bool PERM = true, AFTER_DRAIN = false, SEG3 = false; bf16_t* KB; bf16_t* KVR; const bf16_t* KR; const float* ssp; const float* gkn; float eps;
    __device__ __forceinline__ void operator()(const f32x4 (&acc)[2][2][4][2], const Unit& u, int wr, int wc, int fr, int fq) const {
        const bool kw = wc < 2; const int hd = 2 * u.pn + (wc & 1);
        f32x4 g00 = {1.f, 1.f, 1.f, 1.f}, g01 = g00, g10 = g00, g11 = g00;
        if (kw) { const float* gp = gkn + 8 * fq; g00 = *(const f32x4*)gp; g01 = *(const f32x4*)(gp + 4); g10 = *(const f32x4*)(gp + 32); g11 = *(const f32x4*)(gp + 36); }
#pragma unroll
        for (int ai = 0; ai < 2; ++ai) {
            float rs[4], ssr[4]; u32x4 krv[4];
#pragma unroll
            for (int m = 0; m < 4; ++m) { const int row = u.pm * BM + ai * HALF + wr * 64 + m * 16 + fr; const float* sp = ssp + (size_t)row * 16;
                const f32x4 a = *(const f32x4*)(sp + 8); rs[m] = __builtin_amdgcn_rsqf(((a[0] + a[1]) + (a[2] + a[3])) * (1.0f / 256) + eps); ssr[m] = sp[12];
                if (kw) krv[m] = *(const u32x4*)(KR + (size_t)row * 256 + 8 * fq); else krv[m] = (u32x4){0u, 0u, 0u, 0u}; }
            __builtin_amdgcn_sched_barrier(0);
#pragma unroll
            for (int m = 0; m < 4; ++m) { const int row = u.pm * BM + ai * HALF + wr * 64 + m * 16 + fr; const float r_ = rs[m];
                f32x4 v00 = acc[ai][0][m][0] * r_, v01 = acc[ai][0][m][1] * r_, v10 = acc[ai][1][m][0] * r_, v11 = acc[ai][1][m][1] * r_;
                if (kw) {
                    float ss = 0.f;
#pragma unroll
                    for (int i = 0; i < 4; ++i) ss += (v00[i] * v00[i] + v01[i] * v01[i]) + (v10[i] * v10[i] + v11[i] * v11[i]);
                    { auto q_ = __builtin_amdgcn_permlane16_swap(__float_as_uint(ss), __float_as_uint(ss), false, false); ss = __uint_as_float(q_[0]) + __uint_as_float(q_[1]); }
                    { auto q_ = __builtin_amdgcn_permlane32_swap(__float_as_uint(ss), __float_as_uint(ss), false, false); ss = __uint_as_float(q_[0]) + __uint_as_float(q_[1]); }
                    const float rk = __builtin_amdgcn_rsqf((ss + ssr[m]) * (1.0f / 96) + eps);
                    bf16_t* kp = KB + (size_t)row * 768 + hd * 96 + 8 * fq;
                    *(u32x4*)kp = pack8(v00 * rk * g00, v01 * rk * g01); *(u32x4*)(kp + 32) = pack8(v10 * rk * g10, v11 * rk * g11);
                    const u32x4 w = krv[m];
                    const f32x4 r0 = {bf_lo(w.x) * rk, bf_hi(w.x) * rk, bf_lo(w.y) * rk, bf_hi(w.y) * rk}, r1 = {bf_lo(w.z) * rk, bf_hi(w.z) * rk, bf_lo(w.w) * rk, bf_hi(w.w) * rk};
                    *(u32x4*)(kp + 64) = pack8(r0, r1);
                } else {
                    bf16_t* vp = KVR + (size_t)row * 1024 + 512 + hd * 64 + 8 * fq;
                    *(u32x4*)vp = pack8(v00, v01); *(u32x4*)(vp + 32) = pack8(v10, v11);
                } }
            __builtin_amdgcn_sched_barrier(0);
        } } };
struct EpiGate { static constexpr bool PERM = true, AFTER_DRAIN = false, SEG3 = false; unsigned char* g0; size_t gstride, gextra; float zs;
    __device__ __forceinline__ void operator()(const f32x4 (&acc)[2][2][4][2], const Unit& u, int wr, int wc, int fr, int fq) const {
        const int gi = u.pn >> 2; unsigned char* base = g0 + (size_t)((gi * 2) % 3) * gstride; const int c0 = (u.pn & 3) * 256;
        PG8_EPI_LOOP({
            _Pragma("unroll") for (int i = 0; i < 4; ++i) { v0[i] = 255.0f * __builtin_amdgcn_rcpf(1.0f + __builtin_amdgcn_exp2f(zs * v0[i])); v1[i] = 255.0f * __builtin_amdgcn_rcpf(1.0f + __builtin_amdgcn_exp2f(zs * v1[i])); }
            u32x2 w; w.x = 0u; w.y = 0u;
            w.x = __builtin_amdgcn_cvt_pk_u8_f32(v0[0], 0, w.x); w.x = __builtin_amdgcn_cvt_pk_u8_f32(v0[1], 1, w.x); w.x = __builtin_amdgcn_cvt_pk_u8_f32(v0[2], 2, w.x); w.x = __builtin_amdgcn_cvt_pk_u8_f32(v0[3], 3, w.x);
            w.y = __builtin_amdgcn_cvt_pk_u8_f32(v1[0], 0, w.y); w.y = __builtin_amdgcn_cvt_pk_u8_f32(v1[1], 1, w.y); w.y = __builtin_amdgcn_cvt_pk_u8_f32(v1[2], 2, w.y); w.y = __builtin_amdgcn_cvt_pk_u8_f32(v1[3], 3, w.y);
            *(u32x2*)(base + (size_t)row * 1024 + c0 + ct) = w; }) } };
struct EpiMerge { static constexpr bool PERM = true, AFTER_DRAIN = false, SEG3 = false; const unsigned char* gate; bf16_t* mg; int first;
    __device__ __forceinline__ void operator()(const f32x4 (&acc)[2][2][4][2], const Unit& u, int wr, int wc, int fr, int fq) const {
#pragma unroll
        for (int ai = 0; ai < 2; ++ai) {
            u32x2 gw[4][2]; u32x4 pw[4][2];
#pragma unroll
            for (int m = 0; m < 4; ++m)
#pragma unroll
                for (int bj = 0; bj < 2; ++bj) { const int row = u.pm * BM + ai * HALF + wr * 64 + m * 16 + fr; const int ct = bj * HALF + wc * 32 + 8 * fq;
                    const size_t off = (size_t)row * 1024 + u.pn * BM + ct;
                    gw[m][bj] = *(const u32x2*)(gate + off);
                    if (!first) pw[m][bj] = *(const u32x4*)(mg + off); else pw[m][bj] = (u32x4){0u, 0u, 0u, 0u}; }
            __builtin_amdgcn_sched_barrier(0);
#pragma unroll
            for (int m = 0; m < 4; ++m)
#pragma unroll
                for (int bj = 0; bj < 2; ++bj) { const int row = u.pm * BM + ai * HALF + wr * 64 + m * 16 + fr; const int ct = bj * HALF + wc * 32 + 8 * fq;
                    const size_t off = (size_t)row * 1024 + u.pn * BM + ct;
                    const u32x2 g = gw[m][bj]; const u32x4 p = pw[m][bj];
                    const f32x4 p0 = (f32x4){bf_lo(p.x), bf_hi(p.x), bf_lo(p.y), bf_hi(p.y)}, p1 = (f32x4){bf_lo(p.z), bf_hi(p.z), bf_lo(p.w), bf_hi(p.w)};
                    const float q8 = 1.0f / 255.0f;
                    const f32x4 g0v = (f32x4){(float)(g.x & 0xffu) * q8, (float)((g.x >> 8) & 0xffu) * q8, (float)((g.x >> 16) & 0xffu) * q8, (float)(g.x >> 24) * q8};
                    const f32x4 g1v = (f32x4){(float)(g.y & 0xffu) * q8, (float)((g.y >> 8) & 0xffu) * q8, (float)((g.y >> 16) & 0xffu) * q8, (float)(g.y >> 24) * q8};
                    *(u32x4*)(mg + off) = pack8(p0 + g0v * acc[ai][bj][m][0], p1 + g1v * acc[ai][bj][m][1]); }
        } } };
struct EpiMerge3 { static constexpr bool PERM = true, AFTER_DRAIN = false, SEG3 = true; const unsigned char* g; bf16_t* mg;
    static __device__ __forceinline__ f32x4 lo4(unsigned w) { return (f32x4){fmaxf((float)(w & 0xffu), 0.5f), fmaxf((float)((w >> 8) & 0xffu), 0.5f), fmaxf((float)((w >> 16) & 0xffu), 0.5f), fmaxf((float)(w >> 24), 0.5f)}; }
    __device__ __forceinline__ void operator()(f32x4 (&acc)[2][2][4][2], const Unit& u, int wr, int wc, int fr, int fq) const {
        const int seg = u.pm >> 8, pm = u.pm & 255;
        const unsigned char* gc = g + ((size_t)seg << 26);
        if (seg < 2) {
#pragma unroll
            for (int ai = 0; ai < 2; ++ai) {
                u32x2 ga[4][2], gb[4][2];
#pragma unroll
                for (int m = 0; m < 4; ++m)
#pragma unroll
                    for (int bj = 0; bj < 2; ++bj) { const int row = pm * BM + ai * HALF + wr * 64 + m * 16 + fr; const int ct = bj * HALF + wc * 32 + 8 * fq;
                        const size_t off = (size_t)row * 1024 + u.pn * BM + ct;
                        ga[m][bj] = *(const u32x2*)(gc + off); gb[m][bj] = *(const u32x2*)(gc + ((size_t)1 << 26) + off); }
                __builtin_amdgcn_sched_barrier(0);
#pragma unroll
                for (int m = 0; m < 4; ++m)
#pragma unroll
                    for (int bj = 0; bj < 2; ++bj) {
                        const f32x4 a0 = lo4(ga[m][bj].x), a1 = lo4(ga[m][bj].y), b0 = lo4(gb[m][bj].x), b1 = lo4(gb[m][bj].y);
#pragma unroll
                        for (int i = 0; i < 4; ++i) { acc[ai][bj][m][0][i] *= a0[i] * __builtin_amdgcn_rcpf(b0[i]); acc[ai][bj][m][1][i] *= a1[i] * __builtin_amdgcn_rcpf(b1[i]); } }
            }
        } else {
#pragma unroll
            for (int ai = 0; ai < 2; ++ai) {
                u32x2 ga[4][2];
#pragma unroll
                for (int m = 0; m < 4; ++m)
#pragma unroll
                    for (int bj = 0; bj < 2; ++bj) { const int row = pm * BM + ai * HALF + wr * 64 + m * 16 + fr; const int ct = bj * HALF + wc * 32 + 8 * fq;
                        ga[m][bj] = *(const u32x2*)(gc + (size_t)row * 1024 + u.pn * BM + ct); }
                __builtin_amdgcn_sched_barrier(0);
#pragma unroll
                for (int m = 0; m < 4; ++m)
#pragma unroll
                    for (int bj = 0; bj < 2; ++bj) { const int row = pm * BM + ai * HALF + wr * 64 + m * 16 + fr; const int ct = bj * HALF + wc * 32 + 8 * fq;
                        const float q8 = 1.0f / 255.0f;
                        const f32x4 a0 = lo4(ga[m][bj].x) * q8, a1 = lo4(ga[m][bj].y) * q8;
                        *(u32x4*)(mg + (size_t)row * 1024 + u.pn * BM + ct) = pack8(acc[ai][bj][m][0] * a0, acc[ai][bj][m][1] * a1); }
            }
        } } };
struct EpiResid { static constexpr bool PERM = true, AFTER_DRAIN = false, SEG3 = false; const void* xi; int in_bf16; bf16_t* xo;
    __device__ __forceinline__ void operator()(const f32x4 (&acc)[2][2][4][2], const Unit& u, int wr, int wc, int fr, int fq) const {
#pragma unroll
        for (int ai = 0; ai < 2; ++ai) {
            f32x4 xa[4][2], xb[4][2];
#pragma unroll
            for (int m = 0; m < 4; ++m)
#pragma unroll
                for (int bj = 0; bj < 2; ++bj) { const int row = u.pm * BM + ai * HALF + wr * 64 + m * 16 + fr; const int ct = bj * HALF + wc * 32 + 8 * fq;
                    const size_t off = (size_t)row * 1024 + u.pn * BM + ct;
                    if (in_bf16) { const u32x4 w = *(const u32x4*)((const bf16_t*)xi + off);
                        xa[m][bj] = (f32x4){__uint_as_float(w.x << 16), __uint_as_float(w.x & 0xffff0000u), __uint_as_float(w.y << 16), __uint_as_float(w.y & 0xffff0000u)};
                        xb[m][bj] = (f32x4){__uint_as_float(w.z << 16), __uint_as_float(w.z & 0xffff0000u), __uint_as_float(w.w << 16), __uint_as_float(w.w & 0xffff0000u)}; }
                    else { xa[m][bj] = *(const f32x4*)((const float*)xi + off); xb[m][bj] = *(const f32x4*)((const float*)xi + off + 4); } }
            __builtin_amdgcn_sched_barrier(0);
#pragma unroll
            for (int m = 0; m < 4; ++m)
#pragma unroll
                for (int bj = 0; bj < 2; ++bj) { const int row = u.pm * BM + ai * HALF + wr * 64 + m * 16 + fr; const int ct = bj * HALF + wc * 32 + 8 * fq;
                    const size_t off = (size_t)row * 1024 + u.pn * BM + ct;
                    *(u32x4*)(xo + off) = pack8(xa[m][bj] + acc[ai][bj][m][0], xb[m][bj] + acc[ai][bj][m][1]); }
        } } };
__device__ __forceinline__ u32x2 pack8_fp8(f32x4 v0, f32x4 v1) {
    _Pragma("unroll") for (int i = 0; i < 4; ++i) { v0[i] = fminf(fmaxf(v0[i], -448.f), 448.f); v1[i] = fminf(fmaxf(v1[i], -448.f), 448.f); }
    int a = 0, b = 0; a = __builtin_amdgcn_cvt_pk_fp8_f32(v0[0], v0[1], a, false); a = __builtin_amdgcn_cvt_pk_fp8_f32(v0[2], v0[3], a, true);
    b = __builtin_amdgcn_cvt_pk_fp8_f32(v1[0], v1[1], b, false); b = __builtin_amdgcn_cvt_pk_fp8_f32(v1[2], v1[3], b, true); u32x2 w; w.x = (unsigned)a; w.y = (unsigned)b; return w; }
struct EpiSwiglu { static constexpr bool PERM = true, AFTER_DRAIN = false, SEG3 = false; unsigned char* hid; float iscale, oscale;
    __device__ __forceinline__ void operator()(const f32x4 (&acc)[2][2][4][2], const Unit& u, int wr, int wc, int fr, int fq) const {
#pragma unroll
        for (int ai = 0; ai < 2; ++ai)
#pragma unroll
            for (int m = 0; m < 4; ++m) { const int row = u.pm * BM + ai * HALF + wr * 64 + m * 16 + fr; const int col = u.pn * 128 + wc * 32 + 8 * fq;
                f32x4 o0, o1;
#pragma unroll
                for (int i = 0; i < 4; ++i) { const float g0 = acc[ai][0][m][0][i] * iscale, g1 = acc[ai][0][m][1][i] * iscale;
                    o0[i] = g0 * __builtin_amdgcn_rcpf(1.0f + __builtin_amdgcn_exp2f(-1.4426950408889634f * g0)) * (acc[ai][1][m][0][i] * iscale);
                    o1[i] = g1 * __builtin_amdgcn_rcpf(1.0f + __builtin_amdgcn_exp2f(-1.4426950408889634f * g1)) * (acc[ai][1][m][1][i] * iscale); }
                *(u32x2*)(hid + (size_t)row * 1024 + col) = pack8_fp8(o0 * oscale, o1 * oscale); } } };
struct EpiDown { static constexpr bool PERM = true, AFTER_DRAIN = false, SEG3 = false; unsigned char* Y; const float* aff; float iscale;
    __device__ __forceinline__ void operator()(const f32x4 (&acc)[2][2][4][2], const Unit& u, int wr, int wc, int fr, int fq) const {
        float a[2][4];
#pragma unroll
        for (int ai = 0; ai < 2; ++ai)
#pragma unroll
            for (int m = 0; m < 4; ++m) a[ai][m] = aff[u.pm * BM + ai * HALF + wr * 64 + m * 16 + fr] * iscale;
        __builtin_amdgcn_sched_barrier(0);
        PG8_EPI_LOOP({ v0 = v0 * a[ai][m]; v1 = v1 * a[ai][m]; *(u32x2*)(Y + (size_t)row * 1024 + u.pn * BM + ct) = pack8_fp8(v0, v1); }) } };

template <class Epi, class Sched, bool ALIGN_EPI = false, bool SP2 = false, bool F8 = false, bool AG = false>
__device__ __forceinline__ void gemm_phase(PG8_LAS unsigned char* lds, const Gemm g, const Sched& S, const Epi& E) {
    int tid_ = threadIdx.x; asm volatile("" : "+v"(tid_));
    const int tid = tid_, wid = __builtin_amdgcn_readfirstlane(tid >> 6), lane = tid & 63, wr = wid >> 2, wc = wid & 3, fr = lane & 15, fq = lane >> 4;
    const int K = g.K, nt = K / BK, lda = g.lda;
    unsigned voffA[2], voffB[2];
#pragma unroll
    for (int i = 0; i < 2; ++i) { int R, C; stage_rc(tid * 16 + i * 8192, R, C); const int Rb = Epi::PERM ? ((R & ~31) + perm32(R & 31)) : R;
        voffA[i] = (unsigned)(R * lda + C) * 2u; voffB[i] = (unsigned)(Rb * K + C) * 2u; }
    const size_t kstep = (size_t)(BK * 2);
    const size_t hstepA = (size_t)HALF * lda * 2, hstepB = (size_t)HALF * K * 2;
    const size_t tstepA = 2 * hstepA, tstepB = 2 * hstepB;
    const unsigned ldsw = (unsigned)wid * 1024u;
    const int aoff = lds_byte(wr * 64 + fr, fq * 8), boff = lds_byte(wc * 32 + fr, fq * 8);
#define PG8_SA(b, h) (((b) * 2 + (h)) * HTB)
#define PG8_SB(b, h) ((4 + (b) * 2 + (h)) * HTB)
#define PG8_STAGE(bufoff, gbase, voff) do { _Pragma("unroll") for (int _i = 0; _i < 2; ++_i) \
        __builtin_amdgcn_global_load_lds((const unsigned*)((const char*)(gbase) + (voff)[_i]), (PG8_LAS unsigned*)(lds + (bufoff) + ldsw + _i * 8192), 16, 0, 0); } while (0)
#define PG8_STAGE_A(bufoff, abase, hh, V) do { if constexpr (AG) { PG8_STAGE(bufoff, abase, (V)[hh]); } else { PG8_STAGE(bufoff, (abase) + (hh) * hstepA, voffA); } } while (0)
#define PG8_LDA(dst, b, h) do { _Pragma("unroll") for (int m = 0; m < 4; ++m) { if constexpr (F8) { dst##8[m] = cat8(*(const PG8_LAS bf16x8*)(lds + PG8_SA(b, h) + aoff + m * 2048), *(const PG8_LAS bf16x8*)(lds + PG8_SA(b, h) + aoff + m * 2048 + 1024)); } \
        else { _Pragma("unroll") for (int k = 0; k < 2; ++k) dst[m][k] = *(const PG8_LAS bf16x8*)(lds + PG8_SA(b, h) + aoff + m * 2048 + k * 1024); } } } while (0)
#define PG8_LDB(dst, b, h) do { _Pragma("unroll") for (int n = 0; n < 2; ++n) { if constexpr (F8) { dst##8[n] = cat8(*(const PG8_LAS bf16x8*)(lds + PG8_SB(b, h) + boff + n * 2048), *(const PG8_LAS bf16x8*)(lds + PG8_SB(b, h) + boff + n * 2048 + 1024)); } \
        else { _Pragma("unroll") for (int k = 0; k < 2; ++k) dst[n][k] = *(const PG8_LAS bf16x8*)(lds + PG8_SB(b, h) + boff + n * 2048 + k * 1024); } } } while (0)
#define PG8_MMA(ai, bj, At, Bt) do { __builtin_amdgcn_s_setprio(1); _Pragma("unroll") for (int m = 0; m < 4; ++m) _Pragma("unroll") for (int n = 0; n < 2; ++n) { \
        if constexpr (F8) { asm volatile("v_mfma_f32_16x16x128_f8f6f4 %0, %1, %2, %0" : "+v"(acc[ai][bj][m][n]) : "v"(Bt##8[n]), "v"(At##8[m])); }     \
        else { _Pragma("unroll") for (int k = 0; k < 2; ++k) acc[ai][bj][m][n] = __builtin_amdgcn_mfma_f32_16x16x32_bf16(Bt[n][k], At[m][k], acc[ai][bj][m][n], 0, 0, 0); } } \
        __builtin_amdgcn_s_setprio(0); } while (0)
#define PG8_WAIT_V(n) asm volatile("s_waitcnt vmcnt(" #n ")" ::: "memory")
#define PG8_WAIT_L(n) asm volatile("s_waitcnt lgkmcnt(" #n ")" ::: "memory")
#define PG8_BAR __builtin_amdgcn_s_barrier()
#define PG8_SCHED __builtin_amdgcn_sched_barrier(0)
    Unit cur, nxt; int ui = 0;
    if (!S.next(0, cur)) return;
    f32x4 acc[2][2][4][2];
#define PG8_Z z0_
    { float z0_ = 0.f; asm volatile("" : "+v"(z0_));
#pragma unroll
    for (int a = 0; a < 2; ++a)
#pragma unroll
        for (int b = 0; b < 2; ++b)
#pragma unroll
            for (int m = 0; m < 4; ++m)
#pragma unroll
                for (int n = 0; n < 2; ++n) acc[a][b][m][n] = (f32x4){PG8_Z, PG8_Z, PG8_Z, PG8_Z}; }
    bf16x8 At[4][2], B0[2][2], B1[2][2]; v8i_t At8[4], B08[2], B18[2]; (void)At; (void)B0; (void)B1; (void)At8; (void)B08; (void)B18;
    const char* cA = AG ? (const char*)g.A : (const char*)g.A + (size_t)cur.pm * tstepA + (Epi::SEG3 ? (size_t)(cur.pm >> 9) * g.a_extra : (size_t)0); const char* cB = (const char*)g.Bt + g.grp_off(cur.pm) + (size_t)cur.pn * tstepB;
    S.a_ready(cur);
    unsigned vgc[2][2], vgn[2][2], vsel[2][2]; (void)vgc; (void)vgn; (void)vsel;
#define PG8_AG_LOAD(dst, un) do { _Pragma("unroll") for (int hh = 0; hh < 2; ++hh) _Pragma("unroll") for (int i = 0; i < 2; ++i) { int R, C; stage_rc(tid * 16 + i * 8192, R, C); \
        const int r_ = (un).pm * BM + hh * HALF + R; const int tok_ = ((((un).pm >> 1) & 15) << 12) + g.rowmap[r_]; dst[hh][i] = (unsigned)(tok_ * lda + C) * 2u; } } while (0)
    if constexpr (AG) { PG8_AG_LOAD(vgc, cur); }
    if constexpr (SP2) {
        PG8_STAGE(PG8_SB(0, 0), cB, voffB); PG8_STAGE(PG8_SB(0, 1), cB + hstepB, voffB); PG8_STAGE_A(PG8_SA(0, 0), cA, 0, vgc); PG8_STAGE_A(PG8_SA(0, 1), cA, 1, vgc);
        if (wr == 1) PG8_BAR;
        PG8_WAIT_V(2); PG8_BAR;
        PG8_STAGE(PG8_SB(1, 0), cB + kstep, voffB); PG8_STAGE_A(PG8_SA(1, 0), cA + kstep, 0, vgc); PG8_STAGE(PG8_SB(1, 1), cB + hstepB + kstep, voffB);
        PG8_WAIT_V(6); PG8_BAR;
    } else {
        PG8_STAGE(PG8_SB(0, 0), cB, voffB); PG8_STAGE_A(PG8_SA(0, 0), cA, 0, vgc); PG8_STAGE(PG8_SB(0, 1), cB + hstepB, voffB); PG8_STAGE_A(PG8_SA(0, 1), cA, 1, vgc);
        if (wr == 1) PG8_BAR;
        PG8_WAIT_V(4); PG8_BAR;
        PG8_STAGE(PG8_SB(1, 0), cB + kstep, voffB); PG8_STAGE_A(PG8_SA(1, 0), cA + kstep, 0, vgc); PG8_STAGE(PG8_SB(1, 1), cB + hstepB + kstep, voffB);
        PG8_WAIT_V(6); PG8_BAR;
    }
    for (;;) {
        const bool has_next = S.next(ui + 1, nxt);
        if constexpr (AG) { if (has_next) { PG8_AG_LOAD(vgn, nxt); } }
        const char* nA = (has_next && !AG) ? (const char*)g.A + (size_t)nxt.pm * tstepA + (Epi::SEG3 ? (size_t)(nxt.pm >> 9) * g.a_extra : (size_t)0) : cA; const char* nB = has_next ? (const char*)g.Bt + g.grp_off(nxt.pm) + (size_t)nxt.pn * tstepB : cB;
#pragma unroll 1
        for (int t = 0; t < nt; t += 2) {
            const bool last = (t == nt - 2);
            const char* a1 = cA + (size_t)(t + 1) * kstep;
            const char* a2 = last ? nA : cA + (size_t)(t + 2) * kstep; const char* b2 = last ? nB : cB + (size_t)(t + 2) * kstep;
            const char* a3 = a2 + kstep; const char* b3 = b2 + kstep;
            if constexpr (AG) { _Pragma("unroll") for (int hh = 0; hh < 2; ++hh) _Pragma("unroll") for (int i = 0; i < 2; ++i) vsel[hh][i] = (last && has_next) ? vgn[hh][i] : vgc[hh][i]; }
            if (last && has_next) S.a_ready(nxt);
            if constexpr (SP2) {
            PG8_LDB(B0, 0, 0); PG8_LDB(B1, 0, 1); PG8_SCHED; PG8_LDA(At, 0, 0); PG8_STAGE_A(PG8_SA(1, 1), a1, 1, vgc);
            PG8_WAIT_V(8); PG8_WAIT_L(0); PG8_BAR; PG8_MMA(0, 0, At, B0); PG8_MMA(0, 1, At, B1); PG8_BAR; PG8_SCHED;
            PG8_LDA(At, 0, 1); PG8_STAGE(PG8_SB(0, 0), b2, voffB); PG8_STAGE(PG8_SB(0, 1), b2 + hstepB, voffB); PG8_STAGE_A(PG8_SA(0, 0), a2, 0, vsel);
            PG8_WAIT_V(8); PG8_WAIT_L(0); PG8_BAR; PG8_MMA(1, 0, At, B0); PG8_MMA(1, 1, At, B1); PG8_BAR; PG8_SCHED;
            PG8_LDB(B0, 1, 0); PG8_LDB(B1, 1, 1); PG8_SCHED; PG8_LDA(At, 1, 0); PG8_STAGE_A(PG8_SA(0, 1), a2, 1, vsel);
            PG8_WAIT_V(8); PG8_WAIT_L(0); PG8_BAR; PG8_MMA(0, 0, At, B0); PG8_MMA(0, 1, At, B1); PG8_BAR; PG8_SCHED;
            PG8_LDA(At, 1, 1); PG8_STAGE(PG8_SB(1, 0), b3, voffB); PG8_STAGE(PG8_SB(1, 1), b3 + hstepB, voffB); PG8_STAGE_A(PG8_SA(1, 0), a3, 0, vsel);
            PG8_WAIT_V(8); PG8_WAIT_L(0); PG8_BAR; PG8_MMA(1, 0, At, B0); PG8_MMA(1, 1, At, B1); PG8_BAR; PG8_SCHED;
            } else {
            PG8_LDB(B0, 0, 0); PG8_SCHED; PG8_LDA(At, 0, 0); PG8_STAGE_A(PG8_SA(1, 1), a1, 1, vgc);
            PG8_WAIT_L(8); PG8_BAR; PG8_WAIT_L(0); PG8_MMA(0, 0, At, B0); PG8_BAR; PG8_SCHED;
            PG8_LDB(B1, 0, 1); PG8_STAGE(PG8_SB(0, 0), b2, voffB);
            PG8_BAR; PG8_WAIT_L(0); PG8_MMA(0, 1, At, B1); PG8_BAR;
            PG8_LDA(At, 0, 1); PG8_STAGE_A(PG8_SA(0, 0), a2, 0, vsel);
            PG8_BAR; PG8_WAIT_L(0); PG8_MMA(1, 0, At, B0); PG8_BAR; PG8_SCHED;
            PG8_STAGE(PG8_SB(0, 1), b2 + hstepB, voffB);
            PG8_WAIT_V(6); PG8_BAR; PG8_MMA(1, 1, At, B1); PG8_BAR;
            PG8_LDB(B0, 1, 0); PG8_SCHED; PG8_LDA(At, 1, 0); PG8_STAGE_A(PG8_SA(0, 1), a2, 1, vsel);
            PG8_WAIT_L(8); PG8_BAR; PG8_WAIT_L(0); PG8_MMA(0, 0, At, B0); PG8_BAR; PG8_SCHED;
            PG8_LDB(B1, 1, 1); PG8_STAGE(PG8_SB(1, 0), b3, voffB);
            PG8_BAR; PG8_WAIT_L(0); PG8_MMA(0, 1, At, B1); PG8_BAR;
            PG8_LDA(At, 1, 1); PG8_STAGE_A(PG8_SA(1, 0), a3, 0, vsel);
            PG8_BAR; PG8_WAIT_L(0); PG8_MMA(1, 0, At, B0); PG8_BAR; PG8_SCHED;
            PG8_STAGE(PG8_SB(1, 1), b3 + hstepB, voffB);
            PG8_WAIT_V(6); PG8_BAR; PG8_MMA(1, 1, At, B1); PG8_BAR;
            }
        }
        if constexpr (F8) { asm volatile("s_nop 15\n\ts_nop 15" ::: "memory"); }
        if constexpr (ALIGN_EPI) { if (wr == 0) PG8_BAR; }
        if constexpr (!Epi::AFTER_DRAIN) { E(acc, cur, wr, wc, fr, fq); S.done(cur); }
        if (!has_next) break;
        if (!Epi::SEG3 || nxt.pm < 256) { float z0_ = 0.f; asm volatile("" : "+v"(z0_));
#pragma unroll
        for (int a = 0; a < 2; ++a)
#pragma unroll
            for (int b = 0; b < 2; ++b)
#pragma unroll
                for (int m = 0; m < 4; ++m)
#pragma unroll
                    for (int n = 0; n < 2; ++n) acc[a][b][m][n] = (f32x4){PG8_Z, PG8_Z, PG8_Z, PG8_Z}; }
        cur = nxt; cA = nA; cB = nB; ++ui;
        if constexpr (AG) { _Pragma("unroll") for (int hh = 0; hh < 2; ++hh) _Pragma("unroll") for (int i = 0; i < 2; ++i) vgc[hh][i] = vgn[hh][i]; }
        if constexpr (ALIGN_EPI) { if (wr == 1) PG8_BAR; }
    }
    PG8_WAIT_V(0);
    if constexpr (!ALIGN_EPI) { if (wr == 0) PG8_BAR; }
    PG8_BAR;
    if constexpr (Epi::AFTER_DRAIN) { E.fused(acc, cur, wr, wc, fr, fq, lds, wid, lane); S.done(cur); }
#undef PG8_Z
#undef PG8_SA
#undef PG8_SB
#undef PG8_STAGE
#undef PG8_STAGE_A
#undef PG8_AG_LOAD
#undef PG8_LDA
#undef PG8_LDB
#undef PG8_MMA
#undef PG8_WAIT_V
#undef PG8_WAIT_L
#undef PG8_BAR
#undef PG8_SCHED
}
}

constexpr int NB = 16, SEQ = 4096, DM = 1024, T = NB * SEQ, DEPTH = 2;
constexpr int NEXP = 16, CAP = 512, TE = NB * NEXP * CAP;
constexpr int IN_COLS = 6048;
constexpr float EPS = 1e-6f;
constexpr float LOG2E = 1.4426950408889634f;
constexpr int NWAVES = 8;
constexpr int PH_PER_LAYER = 16, NPHASE = DEPTH * PH_PER_LAYER;

constexpr size_t MiB = 1u << 20;
constexpr size_t WS_CTL = 0, CTL_ZERO_BYTES = 1 * MiB;
constexpr size_t WS_AFFT = 2 * MiB;
constexpr size_t WS_INV = 6 * MiB;
constexpr size_t WS_IDX = 10 * MiB;
constexpr size_t WS_AFFSEL = 10 * MiB + 512 * 1024;
constexpr size_t WS_TMM = 11 * MiB;
constexpr size_t WS_GT = 11 * MiB + 16 * 1024;
constexpr size_t WS_SSP = 2 * MiB;
constexpr size_t WS_WIN = 12 * MiB;
constexpr size_t WS_WUQ = 24 * MiB;
constexpr size_t WS_WUKV = 25 * MiB;
constexpr size_t WS_WBA = 26 * MiB, WS_WBC = 27 * MiB, WS_WBB = 28 * MiB;
constexpr size_t WS_WO = 29 * MiB;
constexpr size_t WS_WGU = 32 * MiB;
constexpr size_t WS_WD = 64 * MiB;
constexpr size_t WS_WG8 = 80 * MiB;
constexpr size_t WS_H8 = 864 * MiB;
constexpr float Y_SCALE = 64.0f;
constexpr float W8_SCALE = 64.0f, HID_SCALE = 4.0f;
constexpr int W8_E8M0 = 127 - 6, HID_E8M0 = 127 - 2, ONE_E8M0 = 127;
constexpr size_t WS_H = 128 * MiB;
constexpr size_t WS_QA = 256 * MiB, WS_QC = 320 * MiB, WS_KA = 384 * MiB, WS_VA = 448 * MiB, WS_CQKC = 512 * MiB;
constexpr size_t WS_CKV = 576 * MiB, WS_VCKR = 608 * MiB;
constexpr size_t WS_G0 = 384 * MiB;
constexpr size_t WS_QB = 640 * MiB;
constexpr size_t WS_KVR = 736 * MiB;
constexpr size_t WS_G1 = 448 * MiB, WS_G2 = 512 * MiB;
constexpr size_t WS_KB = 864 * MiB;
constexpr size_t WS_OB = 960 * MiB;
constexpr size_t WS_XG = 256 * MiB;
constexpr size_t WS_HID = 512 * MiB;
constexpr size_t WS_XB = 768 * MiB;
constexpr size_t H8_OUT_OFF = 128 * MiB;
constexpr size_t WS_H2 = 256 * MiB;
constexpr size_t WS_END = 1024 * MiB;

constexpr int RING_OFF = 0, RING_BYTES = 131072;
constexpr int LDS_BYTES = 163840;
constexpr int LDSCTL_OFF = LDS_BYTES - 1024, MISC_OFF = LDSCTL_OFF + 320;
constexpr int ATT_NXT_OFF = LDSCTL_OFF - 64;
constexpr int ATT_STASH_OFF = 86528;

#define LAS __attribute__((address_space(3)))
typedef unsigned short bf16;
typedef unsigned v4u __attribute__((ext_vector_type(4)));
typedef unsigned v2u __attribute__((ext_vector_type(2)));
typedef float f32x4 __attribute__((ext_vector_type(4)));
typedef float f32x2 __attribute__((ext_vector_type(2)));
typedef float f32x16 __attribute__((ext_vector_type(16)));
typedef short bf16x8 __attribute__((ext_vector_type(8)));
typedef short s16x4 __attribute__((ext_vector_type(4)));
#define LDS_WAIT() asm volatile("s_waitcnt lgkmcnt(0)" ::: "memory")
#define VM_WAIT() asm volatile("s_waitcnt vmcnt(0)" ::: "memory")
__device__ __forceinline__ unsigned pk2(float lo, float hi) { return pg8::cvt_pk_bf16(lo, hi); }
__device__ __forceinline__ float bflo(unsigned w) { return __uint_as_float(w << 16); }
__device__ __forceinline__ float bfhi(unsigned w) { return __uint_as_float(w & 0xffff0000u); }
template <int M> __device__ __forceinline__ float xor_add(float v) {
    if constexpr (M < 32) return v + __int_as_float(__builtin_amdgcn_ds_swizzle(__float_as_int(v), (M << 10) | 0x1f));
    else { auto r = __builtin_amdgcn_permlane32_swap(__float_as_uint(v), __float_as_uint(v), false, false); return __uint_as_float(r[0]) + __uint_as_float(r[1]); } }
template <int M> __device__ __forceinline__ float xor_max(float v) {
    if constexpr (M < 32) return fmaxf(v, __int_as_float(__builtin_amdgcn_ds_swizzle(__float_as_int(v), (M << 10) | 0x1f)));
    else { auto r = __builtin_amdgcn_permlane32_swap(__float_as_uint(v), __float_as_uint(v), false, false); return fmaxf(__uint_as_float(r[0]), __uint_as_float(r[1])); } }
template <int M> __device__ __forceinline__ int xor_geti(int v) { static_assert(M < 32, "xor_geti: masks below 32"); return __builtin_amdgcn_ds_swizzle(v, (M << 10) | 0x1f); }
template <int M> __device__ __forceinline__ float xor_getf(float v) { return __int_as_float(xor_geti<M>(__float_as_int(v))); }
__device__ __forceinline__ unsigned wave_sum_u(unsigned c) {
    c += (unsigned)xor_geti<1>((int)c); c += (unsigned)xor_geti<2>((int)c); c += (unsigned)xor_geti<4>((int)c); c += (unsigned)xor_geti<8>((int)c); c += (unsigned)xor_geti<16>((int)c);
    auto r = __builtin_amdgcn_permlane32_swap(c, c, false, false); return r[0] + r[1]; }
__device__ __forceinline__ float wave_sum(float v) { v = xor_add<1>(v); v = xor_add<2>(v); v = xor_add<4>(v); v = xor_add<8>(v); v = xor_add<16>(v); return xor_add<32>(v); }

#define XB_TMO      128
#define XB_XCNT(j)  (256  + 64 * (j))
#define XB_XSUB(j)  (1280 + 64 * (j))
#define XB_XGEN(j)  (2304 + 64 * (j))
#define XB_TOP      3328
#define XB_TOPGEN   3392
#define XCD_BAR_WORDS 3456
#define XB_SPIN_CAP (1u << 23)

__device__ __forceinline__ unsigned xb_ld(unsigned* p)              { return __hip_atomic_load(p, __ATOMIC_RELAXED, __HIP_MEMORY_SCOPE_AGENT); }
__device__ __forceinline__ unsigned xb_add(unsigned* p, unsigned v) { return __hip_atomic_fetch_add(p, v, __ATOMIC_RELAXED, __HIP_MEMORY_SCOPE_AGENT); }
__device__ __forceinline__ unsigned xb_xcc_id() { return (unsigned)__builtin_amdgcn_s_getreg((3 << 11) | 20) & 0xFu; }
#define XB_SPIN(cond, bar) do { unsigned _sp = 0; while (cond) { __builtin_amdgcn_s_sleep(1); \
    if ((++_sp & 255u) == 0u) { if (xb_ld(&(bar)[XB_TMO])) break; if (_sp > XB_SPIN_CAP) { atomicAdd(&(bar)[XB_TMO], 1u); break; } } } } while (0)

struct XcdBarrier { unsigned* bar; unsigned x; volatile LAS unsigned* st; };

__device__ __forceinline__ XcdBarrier xcd_barrier_post(unsigned* bar, volatile LAS unsigned* st) {
    XcdBarrier b; b.bar = bar; b.x = xb_xcc_id(); b.st = st;
    if (threadIdx.x == 0) (void)xb_add(&bar[XB_XCNT(b.x)], 1u);
    return b;
}
__device__ __forceinline__ void xcd_barrier_complete(unsigned* bar, unsigned x, unsigned& nloc, unsigned& nx) {
    const unsigned G = gridDim.x * gridDim.y * gridDim.z;
    unsigned sum, cnt, mine, sp = 0u;
    for (;;) {
        sum = 0u; cnt = 0u; mine = 0u;
#pragma unroll
        for (unsigned j = 0; j < 16; ++j) { const unsigned c = xb_ld(&bar[XB_XCNT(j)]); sum += c; cnt += (c > 0u) ? 1u : 0u; mine = (j == x) ? c : mine; }
        if (sum == G) break;
        __builtin_amdgcn_s_sleep(1);
        if ((++sp & 255u) == 0u) { if (xb_ld(&bar[XB_TMO])) break; if (sp > XB_SPIN_CAP) { atomicAdd(&bar[XB_TMO], 1u); break; } }
    }
    nloc = mine > 0u ? mine : 1u; nx = cnt > 0u ? cnt : 1u;
}
__device__ __forceinline__ void xcd_barrier(const XcdBarrier& b) {
    asm volatile("s_waitcnt vmcnt(0)" ::: "memory");
    __syncthreads();
    if (threadIdx.x == 0) {
        unsigned* bar = b.bar;
        __builtin_amdgcn_s_waitcnt(0);
        unsigned nloc = b.st[0], nx = b.st[1];
        if (nloc == 0u) { xcd_barrier_complete(bar, b.x, nloc, nx); b.st[0] = nloc; b.st[1] = nx; }
        const unsigned old = xb_add(&bar[XB_XSUB(b.x)], 1u);
        const unsigned gen = old / nloc;
        if (old + 1u == (gen + 1u) * nloc) {
            __builtin_amdgcn_fence(__ATOMIC_RELEASE, "agent");
            asm volatile("s_waitcnt vmcnt(0)" ::: "memory");
            const unsigned og = xb_add(&bar[XB_TOP], 1u);
            const unsigned tg = og / nx;
            if (og + 1u == (tg + 1u) * nx) xb_add(&bar[XB_TOPGEN], 1u);
            else XB_SPIN(xb_ld(&bar[XB_TOPGEN]) == tg, bar);
            __builtin_amdgcn_fence(__ATOMIC_ACQUIRE, "agent");
            xb_add(&bar[XB_XGEN(b.x)], 1u);
            asm volatile("s_waitcnt vmcnt(0)" ::: "memory");
        } else {
            XB_SPIN(xb_ld(&bar[XB_XGEN(b.x)]) == gen, bar);
            __builtin_amdgcn_fence(__ATOMIC_ACQUIRE, "agent");
            asm volatile("s_waitcnt vmcnt(0)" ::: "memory");
        }
    }
    __syncthreads();
}

#define XB_GRP(g)   (3584 + 128 * (g))
__device__ __forceinline__ void group_post(unsigned* bar, int grp) {
    if (threadIdx.x == 0) (void)__hip_atomic_fetch_or(&bar[XB_GRP(grp) + 32], 1u << xb_xcc_id(), __ATOMIC_RELAXED, __HIP_MEMORY_SCOPE_AGENT);
}
__device__ __forceinline__ void group_barrier(unsigned* bar, int grp, unsigned nmem) {
    unsigned xm = 0u;
    if (threadIdx.x == 0) xm = xb_ld(&bar[XB_GRP(grp) + 32]);
    asm volatile("s_waitcnt vmcnt(0)" ::: "memory");
    __syncthreads();
    if (threadIdx.x == 0) {
        unsigned* gbp = bar + XB_GRP(grp);
        if ((xm & (xm - 1u)) != 0u || xm == 0u) { __builtin_amdgcn_fence(__ATOMIC_RELEASE, "agent"); asm volatile("s_waitcnt vmcnt(0)" ::: "memory"); }
        const unsigned old = xb_add(&gbp[0], 1u); const unsigned gen = old / nmem;
        if (old + 1u == (gen + 1u) * nmem) (void)xb_add(&gbp[64], 1u);
        else XB_SPIN(xb_ld(&gbp[64]) == gen, bar);
        __builtin_amdgcn_fence(__ATOMIC_ACQUIRE, "agent");
        asm volatile("s_waitcnt vmcnt(0)" ::: "memory");
    }
    __syncthreads();
}

struct Frame {
    LAS unsigned char* lds;
    int wave, vcu, G;
};

__device__ __forceinline__ void cvt_block(const float* W, int K, int Nsrc, int k0, int n0, bf16* WT, int drow0, LAS float* scr, int lane, const float* kscale = nullptr) {
    float wv_[32];
#pragma unroll
    for (int i = 0; i < 32; ++i) wv_[i] = W[(size_t)(k0 + 2 * i + (lane >> 5)) * Nsrc + n0 + (lane & 31)];
    if (kscale) {
#pragma unroll
        for (int i = 0; i < 32; ++i) wv_[i] *= kscale[k0 + 2 * i + (lane >> 5)]; }
#pragma unroll
    for (int i = 0; i < 32; ++i) scr[(2 * i + (lane >> 5)) * 33 + (lane & 31)] = wv_[i];
    LDS_WAIT(); asm volatile("" ::: "memory");
    const int c = lane & 7;
#pragma unroll
    for (int j = 0; j < 4; ++j) { const int n = (lane >> 3) + 8 * j; const LAS float* s = scr + (8 * c) * 33 + n;
        v4u o; o.x = pk2(s[0 * 33], s[1 * 33]); o.y = pk2(s[2 * 33], s[3 * 33]); o.z = pk2(s[4 * 33], s[5 * 33]); o.w = pk2(s[6 * 33], s[7 * 33]);
        *(v4u*)(WT + (size_t)(drow0 + n) * K + k0 + 8 * c) = o; }
    LDS_WAIT(); asm volatile("" ::: "memory");
}
__device__ __forceinline__ void cvt_block8(const float* W, int K, int Nsrc, int k0, int n0, unsigned char* WT8, int drow0, float scale, LAS float* scr, int lane) {
    float wv_[32];
#pragma unroll
    for (int i = 0; i < 32; ++i) wv_[i] = W[(size_t)(k0 + 2 * i + (lane >> 5)) * Nsrc + n0 + (lane & 31)];
#pragma unroll
    for (int i = 0; i < 32; ++i) scr[(2 * i + (lane >> 5)) * 33 + (lane & 31)] = wv_[i];
    LDS_WAIT(); asm volatile("" ::: "memory");
    const int c = lane & 7;
#pragma unroll
    for (int j = 0; j < 4; ++j) { const int n = (lane >> 3) + 8 * j; const LAS float* s = scr + (8 * c) * 33 + n;
        const f32x4 a = {s[0 * 33] * scale, s[1 * 33] * scale, s[2 * 33] * scale, s[3 * 33] * scale}, b = {s[4 * 33] * scale, s[5 * 33] * scale, s[6 * 33] * scale, s[7 * 33] * scale};
        const pg8::u32x2 w = pg8::pack8_fp8(a, b); v2u o; o.x = w.x; o.y = w.y;
        *(v2u*)(WT8 + (size_t)(drow0 + n) * K + k0 + 8 * c) = o; }
    LDS_WAIT(); asm volatile("" ::: "memory");
}
__device__ __forceinline__ int win_row(int n0) {
    if (n0 < 512) { const int m = n0 >> 8, h = (n0 & 255) >> 6, d = n0 & 63; return h * 128 + m * 64 + d; }
    if (n0 < 1024) return 1024 + (n0 - 512);
    if (n0 < 1536) return 1536 + (n0 - 1024);
    if (n0 < 1920) return 2048 + (n0 - 1536);
    if (n0 < 2176) return 2560 + (n0 - 1920);
    if (n0 < 2208) return 2944 + (n0 - 2176);
    if (n0 < 2720) return 512 + (n0 - 2208);
    if (n0 < 2848) return 2432 + (n0 - 2720);
    if (n0 < 2976) return 2816 + (n0 - 2848);
    return 3072 + (n0 - 2976);
}
__device__ __forceinline__ int win_row_p(int n0) { const int r = win_row(n0), c = r & 255; return (r & ~255) + (((c >> 5) & 1) << 7) + ((c >> 6) << 5) + (c & 31); }
struct LayerW {
    const float *norm_mix_g, *w_in, *diff_qk_g, *diff_lambda, *diff_out_g, *mla_cq_g, *w_uq, *mla_ckv_g, *w_ukv, *mla_qk_g, *swa_qk_g, *swa_sink,
                *w_ba, *w_bb, *w_bc, *w_o, *norm_ffn_g, *w_router, *w_eg, *w_eu, *w_ed;
};
__device__ __forceinline__ void p_convert(const Frame& F, const LayerW& L, unsigned char* ws) {
    int tid_ = threadIdx.x; asm volatile("" : "+v"(tid_)); const int tid = tid_, lane = tid & 63; (void)tid; (void)lane;
    LAS float* scr = (LAS float*)(F.lds + RING_OFF + F.wave * 16384);
    const int gw = F.vcu * NWAVES + F.wave, NGW = F.G * NWAVES;
    constexpr int I_IN = 16 * 189, I_UQ = 6 * 24, I_UKV = 4 * 32, I_BR = 8 * 32, I_O = 16 * 32, I_E = 16 * 512;
    constexpr int NITEMS = I_IN + I_UQ + I_UKV + 3 * I_BR + I_O + 3 * I_E;
    bf16* win = (bf16*)(ws + WS_WIN);
    for (int it = gw; it < NITEMS; it += NGW) {
        int r = it;
        if (r < I_IN) { const int kb = r / 189, nb = r % 189;
            if (nb < 93) cvt_block(L.w_in, 1024, IN_COLS, kb * 64, nb * 32, win, win_row_p(nb * 32), scr, lane);
            else cvt_block8(L.w_in, 1024, IN_COLS, kb * 64, nb * 32, ws + WS_WG8, nb * 32 - 2976, W8_SCALE, scr, lane);
            continue; } r -= I_IN;
        if (r < I_UQ) { const int kb = r / 24, nb = r % 24; cvt_block(L.w_uq, 384, 768, kb * 64, nb * 32, (bf16*)(ws + WS_WUQ), nb * 32, scr, lane, L.mla_cq_g); continue; } r -= I_UQ;
        if (r < I_UKV) { const int kb = r / 32, nb = r % 32, n0 = nb * 32, h = n0 >> 7, jj = n0 & 127; const int dr = (h >> 1) * 256 + 128 * ((jj & 63) >> 5) + 32 * (jj < 64 ? (h & 1) : 2 + (h & 1));
            cvt_block(L.w_ukv, 256, 1024, kb * 64, n0, (bf16*)(ws + WS_WUKV), dr, scr, lane, L.mla_ckv_g); continue; } r -= I_UKV;
        if (r < I_BR) { const int kb = r / 32, nb = r % 32; cvt_block(L.w_ba, 512, 1024, kb * 64, nb * 32, (bf16*)(ws + WS_WBA), nb * 32, scr, lane); continue; } r -= I_BR;
        if (r < I_BR) { const int kb = r / 32, nb = r % 32; cvt_block(L.w_bb, 512, 1024, kb * 64, nb * 32, (bf16*)(ws + WS_WBB), nb * 32, scr, lane); continue; } r -= I_BR;
        if (r < I_BR) { const int kb = r / 32, nb = r % 32; cvt_block(L.w_bc, 512, 1024, kb * 64, nb * 32, (bf16*)(ws + WS_WBC), nb * 32, scr, lane); continue; } r -= I_BR;
        if (r < I_O) { const int kb = r / 32, nb = r % 32; cvt_block(L.w_o, 1024, 1024, kb * 64, nb * 32, (bf16*)(ws + WS_WO), nb * 32, scr, lane); continue; } r -= I_O;
        { const int w = r / I_E, q = r % I_E, e = q / 512, qq = q % 512, kb = qq / 32, nb = qq % 32, n0 = nb * 32;
          const int dr = (n0 >> 7) * 256 + (n0 & 127);
          if (w == 0) cvt_block8(L.w_eg + (size_t)e * 1024 * 1024, 1024, 1024, kb * 64, n0, ws + WS_WGU + (size_t)e * 2048 * 1024, dr, W8_SCALE, scr, lane);
          else if (w == 1) cvt_block8(L.w_eu + (size_t)e * 1024 * 1024, 1024, 1024, kb * 64, n0, ws + WS_WGU + (size_t)e * 2048 * 1024, dr + 128, W8_SCALE, scr, lane);
          else cvt_block8(L.w_ed + (size_t)e * 1024 * 1024, 1024, 1024, kb * 64, n0, ws + WS_WD + (size_t)e * 1024 * 1024, n0, W8_SCALE, scr, lane); }
    }
    { const int gt = (F.vcu * NWAVES + F.wave) * 64 + lane, NGT = NGW * 64;
      unsigned z_ = 0u; asm volatile("" : "+v"(z_));
      for (int i = gt; i < 96 * 1024 / 8; i += NGT) { const int blk = i / (32 * 1024 / 8), off = i % (32 * 1024 / 8); const int r0 = 2816 + (blk == 0 ? 192 : (blk == 1 ? 96 : 224));
          *(v4u*)(win + (size_t)r0 * 1024 + (size_t)off * 8) = (v4u){z_, z_, z_, z_}; }
      if (gt < 256) { const int gi = gt >> 6, d = gt & 63; const float QS_ = 0.125f * LOG2E;
          const float v = gi == 0 ? L.diff_qk_g[d] * QS_ : (gi == 1 ? L.swa_qk_g[d] * QS_ : (gi == 2 ? L.diff_qk_g[64 + d] : L.swa_qk_g[64 + d]));
          ((float*)(ws + WS_GT))[gt] = v; } }
}

__device__ __forceinline__ unsigned pk4_fp8(f32x4 y) {
    y.x = fminf(fmaxf(y.x, -448.f), 448.f); y.y = fminf(fmaxf(y.y, -448.f), 448.f); y.z = fminf(fmaxf(y.z, -448.f), 448.f); y.w = fminf(fmaxf(y.w, -448.f), 448.f);
    int w = 0; w = __builtin_amdgcn_cvt_pk_fp8_f32(y.x, y.y, w, false); w = __builtin_amdgcn_cvt_pk_fp8_f32(y.z, y.w, w, true); return (unsigned)w; }
__device__ __forceinline__ void p_norm1(const Frame& F, const float* x, const float* g, bf16* h, unsigned char* h8) {
    int tid_ = threadIdx.x; asm volatile("" : "+v"(tid_)); const int tid = tid_, lane = tid & 63; (void)tid; (void)lane;
    const int gw = F.vcu * NWAVES + F.wave, NGW = F.G * NWAVES;
    f32x4 gv[4];
#pragma unroll
    for (int j = 0; j < 4; ++j) gv[j] = *((const f32x4*)g + lane + 64 * j);
    for (int row0 = gw * 2; row0 < T; row0 += NGW * 2) {
        f32x4 v[2][4];
#pragma unroll
        for (int rr = 0; rr < 2; ++rr) { const f32x4* xr = (const f32x4*)(x + (size_t)(row0 + rr) * DM) + lane;
#pragma unroll
            for (int j = 0; j < 4; ++j) v[rr][j] = xr[64 * j]; }
#pragma unroll
        for (int rr = 0; rr < 2; ++rr) { float s = 0.f;
#pragma unroll
            for (int j = 0; j < 4; ++j) s += (v[rr][j].x * v[rr][j].x + v[rr][j].y * v[rr][j].y) + (v[rr][j].z * v[rr][j].z + v[rr][j].w * v[rr][j].w);
            const float rs = 1.0f / sqrtf(wave_sum(s) * (1.0f / DM) + EPS);
            v2u* o8 = (v2u*)(h + (size_t)(row0 + rr) * DM) + lane; unsigned* q8 = (unsigned*)(h8 + (size_t)(row0 + rr) * DM) + lane;
#pragma unroll
            for (int j = 0; j < 4; ++j) { const f32x4 y = {v[rr][j].x * rs * gv[j].x, v[rr][j].y * rs * gv[j].y, v[rr][j].z * rs * gv[j].z, v[rr][j].w * rs * gv[j].w};
                v2u o; o.x = pk2(y.x, y.y); o.y = pk2(y.z, y.w); o8[64 * j] = o; q8[64 * j] = pk4_fp8(y); } }
    }
}

__device__ __forceinline__ float grp8_sum(float v) { v = xor_add<1>(v); v = xor_add<2>(v); v = xor_add<4>(v); return v; }
struct U8 { float f[8]; };
__device__ __forceinline__ U8 ld8bf(const bf16* p) { const v4u w = *(const v4u*)p; U8 r; r.f[0] = bflo(w.x); r.f[1] = bfhi(w.x); r.f[2] = bflo(w.y); r.f[3] = bfhi(w.y); r.f[4] = bflo(w.z); r.f[5] = bfhi(w.z); r.f[6] = bflo(w.w); r.f[7] = bfhi(w.w); return r; }
__device__ __forceinline__ void st8bf(bf16* p, const U8& r) { v4u w; w.x = pk2(r.f[0], r.f[1]); w.y = pk2(r.f[2], r.f[3]); w.z = pk2(r.f[4], r.f[5]); w.w = pk2(r.f[6], r.f[7]); *(v4u*)p = w; }
__device__ __forceinline__ float ss8(const U8& r) { float s = 0.f;
#pragma unroll
    for (int i = 0; i < 8; ++i) s += r.f[i] * r.f[i];
    return s; }
__device__ __forceinline__ void p_prep1(const Frame& F, const LayerW& L, unsigned char* ws) {
    int tid_ = threadIdx.x; asm volatile("" : "+v"(tid_)); const int tid = tid_, lane = tid & 63; (void)tid; (void)lane;
    const int gw = F.vcu * NWAVES + F.wave, NGW = F.G * NWAVES;
    const float QS = 0.125f * LOG2E;
    float gqa[8], gka[8], gqc[8], gkc[8], gcq[8], gckv[8];
#pragma unroll
    for (int i = 0; i < 8; ++i) { const int d = (lane & 7) * 8 + i;
        gqa[i] = L.diff_qk_g[d] * QS; gka[i] = L.diff_qk_g[64 + d]; gqc[i] = L.swa_qk_g[d] * QS; gkc[i] = L.swa_qk_g[64 + d];
        gcq[i] = lane < 48 ? L.mla_cq_g[lane * 8 + i] : 0.f; gckv[i] = lane < 32 ? L.mla_ckv_g[lane * 8 + i] : 0.f; }
    bf16* QA = (bf16*)(ws + WS_QA); bf16* KA = (bf16*)(ws + WS_KA); bf16* QC = (bf16*)(ws + WS_QC); bf16* CQKC = (bf16*)(ws + WS_CQKC); bf16* CKV = (bf16*)(ws + WS_CKV);
    for (int row0 = gw * 2; row0 < T; row0 += NGW * 2) {
        U8 a[2], b[2], c[2], d[2], e[2];
#pragma unroll
        for (int rr = 0; rr < 2; ++rr) { const int row = row0 + rr; const size_t o512 = (size_t)row * 512 + lane * 8;
            a[rr] = ld8bf(QA + o512); b[rr] = ld8bf(KA + o512); c[rr] = ld8bf(QC + o512); d[rr] = ld8bf(CQKC + o512);
            if (lane < 32) e[rr] = ld8bf(CKV + (size_t)row * 256 + lane * 8); else {
#pragma unroll
                for (int i = 0; i < 8; ++i) e[rr].f[i] = 0.f; } }
#pragma unroll
        for (int rr = 0; rr < 2; ++rr) { const int row = row0 + rr; const size_t o512 = (size_t)row * 512 + lane * 8;
            const float ra = 1.0f / sqrtf(grp8_sum(ss8(a[rr])) * (1.0f / 64) + EPS);
            const float rb = 1.0f / sqrtf(grp8_sum(ss8(b[rr])) * (1.0f / 64) + EPS);
            const float rc = 1.0f / sqrtf(grp8_sum(ss8(c[rr])) * (1.0f / 64) + EPS);
            const float sd = grp8_sum(ss8(d[rr]));
            float tot = lane < 48 ? sd : 0.f; tot = xor_add<8>(tot); tot = xor_add<16>(tot); tot = xor_add<32>(tot);
            const float rd = lane < 48 ? 1.0f / sqrtf(tot * (1.0f / 384) + EPS) : 1.0f / sqrtf(sd * (1.0f / 64) + EPS);
            float se = grp8_sum(ss8(e[rr])); se = xor_add<8>(se); se = xor_add<16>(se);
            const float re = 1.0f / sqrtf(se * (1.0f / 256) + EPS);
#pragma unroll
            for (int i = 0; i < 8; ++i) { a[rr].f[i] *= ra * gqa[i]; b[rr].f[i] *= rb * gka[i]; c[rr].f[i] *= rc * gqc[i]; d[rr].f[i] *= rd * (lane < 48 ? gcq[i] : gkc[i]); e[rr].f[i] *= re * gckv[i]; }
            st8bf(QA + o512, a[rr]); st8bf(KA + o512, b[rr]); st8bf(QC + o512, c[rr]); st8bf(CQKC + o512, d[rr]);
            if (lane < 32) st8bf(CKV + (size_t)row * 256 + lane * 8, e[rr]); }
    }
}

__device__ __forceinline__ void p_prep2(const Frame& F, const LayerW& L, unsigned char* ws, const int* positions) {
    int tid_ = threadIdx.x; asm volatile("" : "+v"(tid_)); const int tid = tid_, lane = tid & 63; (void)tid; (void)lane;
    const int gw = F.vcu * NWAVES + F.wave, NGW = F.G * NWAVES, h = lane >> 3, j = lane & 7;
    float gkn[8], gkr[4], invf[4];
#pragma unroll
    for (int i = 0; i < 8; ++i) gkn[i] = L.mla_qk_g[96 + 8 * j + i];
#pragma unroll
    for (int i = 0; i < 4; ++i) { gkr[i] = L.mla_qk_g[96 + 64 + 4 * j + i];
        const int fi = 4 * (j & 3) + i; invf[i] = (float)(exp2(-(double)fi * (13.287712379549449 / 16.0)) * 0.15915494309189535); }
    const bf16* KVR = (const bf16*)(ws + WS_KVR); const bf16* VCKR = (const bf16*)(ws + WS_VCKR); bf16* KB = (bf16*)(ws + WS_KB);
    for (int row0 = gw * 2; row0 < T; row0 += NGW * 2) {
        float posf[2]; U8 kn[2]; v2u kw[2];
#pragma unroll
        for (int rr = 0; rr < 2; ++rr) { const int row = row0 + rr; posf[rr] = (float)positions[row];
            kn[rr] = ld8bf(KVR + (size_t)row * 1024 + h * 64 + 8 * j); kw[rr] = *(const v2u*)(VCKR + (size_t)row * 256 + 128 + 4 * j); }
#pragma unroll
        for (int rr = 0; rr < 2; ++rr) { const int row = row0 + rr;
            float cs[4], sn[4];
#pragma unroll
            for (int i = 0; i < 4; ++i) { const double tr = (double)posf[rr] * (double)invf[i]; const float fr = (float)(tr - floor(tr)); cs[i] = __builtin_amdgcn_cosf(fr); sn[i] = __builtin_amdgcn_sinf(fr); }
            float kr_[4] = {bflo(kw[rr].x), bfhi(kw[rr].x), bflo(kw[rr].y), bfhi(kw[rr].y)}, ko[4];
#pragma unroll
            for (int i = 0; i < 4; ++i) { const float other = xor_getf<4>(kr_[i]); ko[i] = (j < 4) ? (kr_[i] * cs[i] - other * sn[i]) : (other * sn[i] + kr_[i] * cs[i]); }
            const float sk = ss8(kn[rr]) + (ko[0] * ko[0] + ko[1] * ko[1]) + (ko[2] * ko[2] + ko[3] * ko[3]);
            const float rk = 1.0f / sqrtf(grp8_sum(sk) * (1.0f / 96) + EPS);
#pragma unroll
            for (int i = 0; i < 8; ++i) kn[rr].f[i] *= rk * gkn[i];
            bf16* krow = KB + (size_t)row * 768 + h * 96;
            st8bf(krow + 8 * j, kn[rr]);
            { v2u w; w.x = pk2(ko[0] * rk * gkr[0], ko[1] * rk * gkr[1]); w.y = pk2(ko[2] * rk * gkr[2], ko[3] * rk * gkr[3]); *(v2u*)(krow + 64 + 4 * j) = w; } }
    }
}

__device__ __forceinline__ void p_tile_minmax(const Frame& F, unsigned char* ws, const int* positions) {
    int tid_ = threadIdx.x; asm volatile("" : "+v"(tid_)); const int lane = tid_ & 63;
    const int gw = F.vcu * NWAVES + F.wave, NGW = F.G * NWAVES;
    float* tmm = (float*)(ws + WS_TMM);
    for (int tl = gw; tl < T / 64; tl += NGW) {
        const float p = (float)positions[tl * 64 + lane];
        float hi = p, lo = -p;
        hi = xor_max<1>(hi); hi = xor_max<2>(hi); hi = xor_max<4>(hi); hi = xor_max<8>(hi); hi = xor_max<16>(hi); hi = xor_max<32>(hi);
        lo = xor_max<1>(lo); lo = xor_max<2>(lo); lo = xor_max<4>(lo); lo = xor_max<8>(lo); lo = xor_max<16>(lo); lo = xor_max<32>(lo);
        if (lane == 0) { tmm[tl * 2] = -lo; tmm[tl * 2 + 1] = hi; }
    }
}

__device__ __forceinline__ void p_h_to_fp8(const Frame& F, unsigned char* ws) {
    int tid_ = threadIdx.x; asm volatile("" : "+v"(tid_));
    const size_t gt = (size_t)(F.vcu * NWAVES * 64) + tid_, NGT = (size_t)F.G * NWAVES * 64;
    const v4u* src = (const v4u*)(ws + WS_H); v2u* dst = (v2u*)(ws + WS_H8);
    for (size_t i = gt; i < (size_t)T * DM / 8; i += NGT * 4) {
        v4u x[4];
#pragma unroll
        for (int k = 0; k < 4; ++k) if (i + k * NGT < (size_t)T * DM / 8) x[k] = src[i + k * NGT];
#pragma unroll
        for (int k = 0; k < 4; ++k) if (i + k * NGT < (size_t)T * DM / 8) {
            const f32x4 a0 = {bflo(x[k].x), bfhi(x[k].x), bflo(x[k].y), bfhi(x[k].y)}, a1 = {bflo(x[k].z), bfhi(x[k].z), bflo(x[k].w), bfhi(x[k].w)};
            const pg8::u32x2 w = pg8::pack8_fp8(a0, a1); v2u o; o.x = w.x; o.y = w.y; dst[i + k * NGT] = o; }
    }
}

namespace att {
__device__ __forceinline__ int crow(int r, int hi) { return (r & 3) + 8 * (r >> 2) + 4 * hi; }
#define ATT_SBAR() __builtin_amdgcn_sched_barrier(0)
typedef float f32x2_t __attribute__((ext_vector_type(2))); typedef __bf16 bf16x2_t __attribute__((ext_vector_type(2)));
__device__ __forceinline__ unsigned cvtpk(float lo, float hi) { f32x2_t v = {lo, hi}; bf16x2_t b = __builtin_convertvector(v, bf16x2_t); return __builtin_bit_cast(unsigned, b); }

struct Args {
    const bf16* Q; const bf16* K; const bf16* V;
    int pq, pk, pv;
    const int* pos;
    float slope2, sink2;
    float mfix;
    const float* qg;
};
typedef short v4i16_t __attribute__((ext_vector_type(4)));
__device__ __forceinline__ s16x4 vtr(const LAS unsigned char* p) { return __builtin_bit_cast(s16x4, __builtin_amdgcn_ds_read_tr16_b64_v4i16((LAS v4i16_t*)p)); }
__device__ __forceinline__ float max3f(float a, float b, float c) { return __builtin_fmaxf(__builtin_fmaxf(a, b), c); }
template <int DQK, int DV, int MODE, int ABL = 0>
__device__ __forceinline__ void attn_core(const Args& A, int q0, unsigned long long tmask, LAS unsigned char* lds, float (&res)[DV / 32][16]) {
    constexpr int KSTR = DQK * 2 + 16, KBYTES = 64 * KSTR, VBYTES = 64 * DV * 2, PBYTES = 256;
    constexpr int BUF = KBYTES + VBYTES + PBYTES;
    constexpr int CPR = DQK / 8, NKP = 64 * CPR, KP = (NKP + 511) / 512, VP = (64 * DV / 8) / 512, ND0 = DV / 32, NKS = DQK / 16;
    constexpr float THR = 6.0f;
    static_assert(2 * BUF + 8 * 256 <= ATT_STASH_OFF, "attention LDS");
    int tid_ = threadIdx.x; asm volatile("" : "+v"(tid_));
    const int tid = tid_, lane = tid & 63, wid = __builtin_amdgcn_readfirstlane(tid >> 6), r32 = lane & 31, hi = lane >> 5;
    LAS float* wsf = (LAS float*)(lds + 2 * BUF) + wid * 64;

    bf16x8 qr[NKS];
#pragma unroll
    for (int d0 = 0; d0 < NKS; ++d0) qr[d0] = *(const bf16x8*)(A.Q + (size_t)(q0 + wid * 32 + r32) * A.pq + d0 * 16 + hi * 8);
    float pqf = 0.f;
    if (MODE == 1) pqf = (float)A.pos[q0 + wid * 32 + r32];
    if (MODE == 2) pqf = (float)(q0 + wid * 32 + r32);

    f32x16 o[ND0];
#pragma unroll
    for (int d = 0; d < ND0; ++d)
#pragma unroll
        for (int r = 0; r < 16; ++r) o[d][r] = 0.f;
    float l_reg = (MODE == 2 && hi == 0) ? __builtin_amdgcn_exp2f(A.sink2 - A.mfix) : 0.f;
    f32x16 negm;
#pragma unroll
    for (int r = 0; r < 16; ++r) negm[r] = -A.mfix;

    bf16x8 sk[KP], sv[VP]; float spos = 0.f;
    unsigned gk_off[KP], lk_off[KP], gv_off[VP], lv_off[VP];
#pragma unroll
    for (int i = 0; i < KP; ++i) { const int p = tid + 512 * i, row = p / CPR, ch = p % CPR; gk_off[i] = (unsigned)(row * A.pk + ch * 8) * 2u; lk_off[i] = (unsigned)(row * KSTR + ch * 16); }
#pragma unroll
    for (int i = 0; i < VP; ++i) { const int p = tid + 512 * i, db = p >> 8, row = (p & 255) >> 2, c4 = p & 3; gv_off[i] = (unsigned)(row * A.pv + db * 32 + c4 * 8) * 2u;
        lv_off[i] = (unsigned)(KBYTES + db * 4096 + (row >> 4) * 1024 + (row & 15) * 64 + c4 * 16); }
#define ATT_SLOAD(t) do { const int k0_ = (t) * 64; const char* kb_ = (const char*)(A.K + (size_t)k0_ * A.pk); const char* vb_ = (const char*)(A.V + (size_t)k0_ * A.pv); \
    _Pragma("unroll") for (int i = 0; i < KP; ++i) { if (tid + 512 * i < NKP) sk[i] = *(const bf16x8*)(kb_ + gk_off[i]); } \
    _Pragma("unroll") for (int i = 0; i < VP; ++i) sv[i] = *(const bf16x8*)(vb_ + gv_off[i]); \
    if (MODE == 1) { if (tid < 64) spos = (float)A.pos[k0_ + tid]; } if (MODE == 2) { spos = (float)(k0_ + tid); } } while (0)
#define ATT_SWRITE(b) do { LAS unsigned char* base_ = lds + (b) * BUF; \
    _Pragma("unroll") for (int i = 0; i < KP; ++i) { if (tid + 512 * i < NKP) *(LAS bf16x8*)(base_ + lk_off[i]) = sk[i]; } \
    _Pragma("unroll") for (int i = 0; i < VP; ++i) *(LAS bf16x8*)(base_ + lv_off[i]) = sv[i]; \
    if (MODE != 0) { if (tid < 64) *(LAS float*)(base_ + KBYTES + VBYTES + tid * 4) = spos; } } while (0)
#define ATT_VRD(VF, d) do { const LAS unsigned char* vp_ = vbase + (d) * 4096; \
    _Pragma("unroll") for (int ks = 0; ks < 4; ++ks) { VF[2 * ks] = vtr(vp_ + ks * 1024); VF[2 * ks + 1] = vtr(vp_ + ks * 1024 + 512); } } while (0)
#define ATT_PK(L, H) (bf16x8){L[0], L[1], L[2], L[3], H[0], H[1], H[2], H[3]}
#define ATT_MMA(VF, d) do { _Pragma("unroll") for (int ks = 0; ks < 4; ++ks) { if (ABL == 2) o[d][ks] += __builtin_bit_cast(float, (int)pa[ks][0]) + __builtin_bit_cast(float, (int)VF[2 * ks][0] + (int)VF[2 * ks + 1][0]); else o[d] = __builtin_amdgcn_mfma_f32_32x32x16_bf16(pa[ks], ATT_PK(VF[2 * ks], VF[2 * ks + 1]), o[d], 0, 0, 0); } } while (0)

    int t = __builtin_ctzll(tmask); tmask &= tmask - 1;
    ATT_SLOAD(t); ATT_SWRITE(0); __syncthreads();
    for (int cur = 0;; cur ^= 1) {
        const bool more = tmask != 0ull; const int tn = more ? __builtin_ctzll(tmask) : 0; tmask &= tmask - 1;
        LAS unsigned char* bufp = lds + cur * BUF;
        if (more && ABL != 4) ATT_SLOAD(tn);
        f32x16 p0, p1;
        const LAS unsigned char* kb = bufp + r32 * KSTR + hi * 16;
#pragma unroll
        for (int d0 = 0; d0 < NKS; ++d0) {
            const bf16x8 b0 = *(const LAS bf16x8*)(kb + d0 * 32);
            const bf16x8 b1 = *(const LAS bf16x8*)(kb + 32 * KSTR + d0 * 32);
            if (ABL == 2) { if (d0 == 0) { p0 = negm; p1 = negm; } p0[d0] += __builtin_bit_cast(float, (int)b0[0]); p1[d0] += __builtin_bit_cast(float, (int)b1[0]); }
            else if (d0 == 0) { p0 = __builtin_amdgcn_mfma_f32_32x32x16_bf16(b0, qr[0], negm, 0, 0, 0); p1 = __builtin_amdgcn_mfma_f32_32x32x16_bf16(b1, qr[0], negm, 0, 0, 0); }
            else { p0 = __builtin_amdgcn_mfma_f32_32x32x16_bf16(b0, qr[d0], p0, 0, 0, 0); p1 = __builtin_amdgcn_mfma_f32_32x32x16_bf16(b1, qr[d0], p1, 0, 0, 0); }
        }
        const LAS unsigned char* vbase = bufp + KBYTES + ((lane >> 4) & 1) * 32 + (lane & 3) * 8 + (4 * hi + ((lane & 15) >> 2)) * 64;
        s16x4 vfa[8], vfb[8];
        ATT_VRD(vfa, 0);
        if (MODE != 0) {
            const LAS float* pk = (const LAS float*)(bufp + KBYTES + VBYTES);
#pragma unroll
            for (int g = 0; g < 4; ++g) {
                const f32x4 k0v = *(const LAS f32x4*)(pk + 8 * g + 4 * hi), k1v = *(const LAS f32x4*)(pk + 32 + 8 * g + 4 * hi);
#pragma unroll
                for (int i = 0; i < 4; ++i) {
                    const float d0f = fabsf(pqf - k0v[i]), d1f = fabsf(pqf - k1v[i]);
                    float s0 = fmaf(-A.slope2, d0f, p0[4 * g + i]), s1 = fmaf(-A.slope2, d1f, p1[4 * g + i]);
                    if (MODE == 2) { s0 = d0f <= 128.0f ? s0 : -1e30f; s1 = d1f <= 128.0f ? s1 : -1e30f; }
                    p0[4 * g + i] = s0; p1[4 * g + i] = s1;
                }
            }
        }
        float ps0 = 0.f, ps1 = 0.f, ps2 = 0.f, ps3 = 0.f;
#pragma unroll
        for (int r = 0; r < 16; r += 4) {
            if (ABL != 1) { p0[r] = __builtin_amdgcn_exp2f(p0[r]); p0[r + 1] = __builtin_amdgcn_exp2f(p0[r + 1]); p0[r + 2] = __builtin_amdgcn_exp2f(p0[r + 2]); p0[r + 3] = __builtin_amdgcn_exp2f(p0[r + 3]);
            p1[r] = __builtin_amdgcn_exp2f(p1[r]); p1[r + 1] = __builtin_amdgcn_exp2f(p1[r + 1]); p1[r + 2] = __builtin_amdgcn_exp2f(p1[r + 2]); p1[r + 3] = __builtin_amdgcn_exp2f(p1[r + 3]); }
            ps0 += p0[r] + p1[r]; ps1 += p0[r + 1] + p1[r + 1]; ps2 += p0[r + 2] + p1[r + 2]; ps3 += p0[r + 3] + p1[r + 3];
        }
        l_reg += (ps0 + ps1) + (ps2 + ps3);
        bf16x8 pa[4];
#pragma unroll
        for (int s = 0; s < 2; ++s) {
            v4u w0 = {cvtpk(p0[8 * s + 0], p0[8 * s + 1]), cvtpk(p0[8 * s + 2], p0[8 * s + 3]), cvtpk(p0[8 * s + 4], p0[8 * s + 5]), cvtpk(p0[8 * s + 6], p0[8 * s + 7])};
            v4u w1 = {cvtpk(p1[8 * s + 0], p1[8 * s + 1]), cvtpk(p1[8 * s + 2], p1[8 * s + 3]), cvtpk(p1[8 * s + 4], p1[8 * s + 5]), cvtpk(p1[8 * s + 6], p1[8 * s + 7])};
            pa[s] = __builtin_bit_cast(bf16x8, w0); pa[2 + s] = __builtin_bit_cast(bf16x8, w1);
        }
        if (ND0 == 2) { ATT_VRD(vfb, 1); ATT_MMA(vfa, 0); ATT_MMA(vfb, 1); }
        else { ATT_VRD(vfb, 1); ATT_MMA(vfa, 0); ATT_VRD(vfa, 2); ATT_MMA(vfb, 1); ATT_VRD(vfb, 3); ATT_MMA(vfa, 2); ATT_MMA(vfb, 3); }
        if (more && ABL != 4) ATT_SWRITE(cur ^ 1);
        if (ABL != 3) __syncthreads();
        if (!more) break;
        t = tn;
    }
#undef ATT_SLOAD
#undef ATT_SWRITE
#undef ATT_VRD
#undef ATT_PK
#undef ATT_MMA
    { const float lt = xor_add<32>(l_reg); if (hi == 0) wsf[32 + r32] = 1.0f / lt; }
    LDS_WAIT();
#pragma unroll
    for (int g = 0; g < 4; ++g) {
        const f32x4 l0 = *(const LAS f32x4*)(wsf + 32 + 8 * g + 4 * hi);
#pragma unroll
        for (int d = 0; d < ND0; ++d)
#pragma unroll
            for (int i = 0; i < 4; ++i) res[d][4 * g + i] = o[d][4 * g + i] * l0[i];
    }
    LDS_WAIT();
    __syncthreads();
}
template <int DQK, int DV, int ABL = 0>
__device__ __forceinline__ void attn_core_p(const Args& A, int q0, unsigned long long tmask, LAS unsigned char* lds, float (&res)[DV / 32][16]) {
    constexpr int KSTR = DQK * 2 + 16, KBYTES = 64 * KSTR, VBYTES = 64 * DV * 2;
    constexpr int CPR = DQK / 8, NKP = 64 * CPR, KP = (NKP + 511) / 512, VP = (64 * DV / 8) / 512, ND0 = DV / 32, NKS = DQK / 16;
    constexpr int KOFF = 0, VOFF = 2 * KBYTES, WOFF = VOFF + 3 * VBYTES;
    static_assert(WOFF + 8 * 256 <= ATT_STASH_OFF, "attention LDS");
    int tid_ = threadIdx.x; asm volatile("" : "+v"(tid_));
    const int tid = tid_, lane = tid & 63, wid = __builtin_amdgcn_readfirstlane(tid >> 6), r32 = lane & 31, hi = lane >> 5;
    LAS float* wsf = (LAS float*)(lds + WOFF) + wid * 64;
    bf16x8 qr[NKS];
#pragma unroll
    for (int d0 = 0; d0 < NKS; ++d0) qr[d0] = *(const bf16x8*)(A.Q + (size_t)(q0 + wid * 32 + r32) * A.pq + d0 * 16 + hi * 8);
    f32x16 o[ND0];
#pragma unroll
    for (int d = 0; d < ND0; ++d)
#pragma unroll
        for (int r = 0; r < 16; ++r) o[d][r] = 0.f;
    float l_reg = 0.f;
    f32x16 negm;
#pragma unroll
    for (int r = 0; r < 16; ++r) negm[r] = -A.mfix;
    bf16x8 sk[KP], sv[VP];
    unsigned gk_off[KP], lk_off[KP], gv_off[VP], lv_off[VP];
#pragma unroll
    for (int i = 0; i < KP; ++i) { const int p = tid + 512 * i, row = p / CPR, ch = p % CPR; gk_off[i] = (unsigned)(row * A.pk + ch * 8) * 2u; lk_off[i] = (unsigned)(row * KSTR + ch * 16); }
#pragma unroll
    for (int i = 0; i < VP; ++i) { const int p = tid + 512 * i, db = p >> 8, row = (p & 255) >> 2, c4 = p & 3; gv_off[i] = (unsigned)(row * A.pv + db * 32 + c4 * 8) * 2u;
        lv_off[i] = (unsigned)(db * 4096 + (row >> 4) * 1024 + (row & 15) * 64 + c4 * 16); }
#define ATP_SLOAD(t) do { const int k0_ = (t) * 64; const char* kb_ = (const char*)(A.K + (size_t)k0_ * A.pk); const char* vb_ = (const char*)(A.V + (size_t)k0_ * A.pv); \
    _Pragma("unroll") for (int i = 0; i < KP; ++i) { if (tid + 512 * i < NKP) sk[i] = *(const bf16x8*)(kb_ + gk_off[i]); } \
    _Pragma("unroll") for (int i = 0; i < VP; ++i) sv[i] = *(const bf16x8*)(vb_ + gv_off[i]); } while (0)
#define ATP_SWRITE(kslot, vslot) do { LAS unsigned char* kb_ = lds + KOFF + (kslot) * KBYTES; LAS unsigned char* vb_ = lds + VOFF + (vslot) * VBYTES; \
    _Pragma("unroll") for (int i = 0; i < KP; ++i) { if (tid + 512 * i < NKP) *(LAS bf16x8*)(kb_ + lk_off[i]) = sk[i]; } \
    _Pragma("unroll") for (int i = 0; i < VP; ++i) *(LAS bf16x8*)(vb_ + lv_off[i]) = sv[i]; } while (0)
#define ATP_QKT(P0, P1, kslot) do { const LAS unsigned char* kb_ = lds + KOFF + (kslot) * KBYTES + r32 * KSTR + hi * 16; \
    _Pragma("unroll") for (int d0 = 0; d0 < NKS; ++d0) { const bf16x8 b0_ = (ABL == 5 || ABL == 7) ? qr[d0] : *(const LAS bf16x8*)(kb_ + d0 * 32); const bf16x8 b1_ = (ABL == 5 || ABL == 7) ? qr[NKS - 1 - d0] : *(const LAS bf16x8*)(kb_ + 32 * KSTR + d0 * 32); \
        if (ABL == 2) { if (d0 == 0) { P0 = negm; P1 = negm; } P0[d0] += __builtin_bit_cast(float, (int)b0_[0]); P1[d0] += __builtin_bit_cast(float, (int)b1_[0]); } \
        else if (d0 == 0) { P0 = __builtin_amdgcn_mfma_f32_32x32x16_bf16(b0_, qr[0], negm, 0, 0, 0); P1 = __builtin_amdgcn_mfma_f32_32x32x16_bf16(b1_, qr[0], negm, 0, 0, 0); } \
        else { P0 = __builtin_amdgcn_mfma_f32_32x32x16_bf16(b0_, qr[d0], P0, 0, 0, 0); P1 = __builtin_amdgcn_mfma_f32_32x32x16_bf16(b1_, qr[d0], P1, 0, 0, 0); } } } while (0)
#define ATP_SOFT(P0, P1) do { \
    if (ABL != 1) { _Pragma("unroll") for (int r = 0; r < 16; ++r) { P0[r] = __builtin_amdgcn_exp2f(P0[r]); P1[r] = __builtin_amdgcn_exp2f(P1[r]); } } \
    _Pragma("unroll") for (int s_ = 0; s_ < 2; ++s_) { \
        v4u w0_ = {cvtpk(P0[8 * s_ + 0], P0[8 * s_ + 1]), cvtpk(P0[8 * s_ + 2], P0[8 * s_ + 3]), cvtpk(P0[8 * s_ + 4], P0[8 * s_ + 5]), cvtpk(P0[8 * s_ + 6], P0[8 * s_ + 7])}; \
        v4u w1_ = {cvtpk(P1[8 * s_ + 0], P1[8 * s_ + 1]), cvtpk(P1[8 * s_ + 2], P1[8 * s_ + 3]), cvtpk(P1[8 * s_ + 4], P1[8 * s_ + 5]), cvtpk(P1[8 * s_ + 6], P1[8 * s_ + 7])}; \
        pa[s_] = __builtin_bit_cast(bf16x8, w0_); pa[2 + s_] = __builtin_bit_cast(bf16x8, w1_); } } while (0)
#define ATP_SUM(P0, P1) do { float ps0 = 0.f, ps1 = 0.f, ps2 = 0.f, ps3 = 0.f; \
    _Pragma("unroll") for (int r = 0; r < 16; r += 4) { ps0 += P0[r] + P1[r]; ps1 += P0[r + 1] + P1[r + 1]; ps2 += P0[r + 2] + P1[r + 2]; ps3 += P0[r + 3] + P1[r + 3]; } \
    l_reg += (ps0 + ps1) + (ps2 + ps3); } while (0)
#define ATP_VRD(VF, vslot, d) do { const LAS unsigned char* vp_ = lds + VOFF + (vslot) * VBYTES + vlane + (d) * 4096; \
    _Pragma("unroll") for (int ks = 0; ks < 4; ++ks) { if (ABL == 6 || ABL == 7) { VF[2 * ks] = __builtin_bit_cast(s16x4, (unsigned long long)(uintptr_t)vp_ * (ks + 1)); VF[2 * ks + 1] = __builtin_bit_cast(s16x4, (unsigned long long)(uintptr_t)vp_ * (ks + 5)); } else { VF[2 * ks] = vtr(vp_ + ks * 1024); VF[2 * ks + 1] = vtr(vp_ + ks * 1024 + 512); } } } while (0)
#define ATP_PK(L, H) (bf16x8){L[0], L[1], L[2], L[3], H[0], H[1], H[2], H[3]}
#define ATP_MMA(VF, d) do { _Pragma("unroll") for (int ks = 0; ks < 4; ++ks) { if (ABL == 2) o[d][ks] += __builtin_bit_cast(float, (int)pa[ks][0]) + __builtin_bit_cast(float, (int)VF[2 * ks][0] + (int)VF[2 * ks + 1][0]); else o[d] = __builtin_amdgcn_mfma_f32_32x32x16_bf16(pa[ks], ATP_PK(VF[2 * ks], VF[2 * ks + 1]), o[d], 0, 0, 0); } } while (0)
#define ATP_STEP(PC0, PC1, PN0, PN1) do { \
    const bool more1_ = have_next; const int tn1_ = t_next; \
    const bool more2_ = tmask != 0ull; const int tn2_ = more2_ ? __builtin_ctzll(tmask) : 0; tmask &= tmask - 1; \
    if (more2_ && ABL != 4) ATP_SLOAD(tn2_); \
    s16x4 vfa[8], vfb[8]; ATP_VRD(vfa, vc, 0); \
    ATP_QKT(PN0, PN1, more1_ ? (kc ^ 1) : kc);     \
    ATP_SOFT(PC0, PC1); ATT_SBAR();        \
    static_assert(ND0 == 2, "pipelined core: DV = 64"); \
    ATP_VRD(vfb, vc, 1); ATP_SUM(PC0, PC1); ATP_MMA(vfa, 0); ATP_MMA(vfb, 1); ATT_SBAR();     \
    if (more2_ && ABL != 4) ATP_SWRITE(kc, vc == 0 ? 2 : vc - 1); \
    if (ABL != 3) __syncthreads(); \
    kc ^= 1; vc = (vc == 2) ? 0 : vc + 1; have_next = more2_; t_next = tn2_; (void)tn1_; \
    if (!more1_) goto atp_done; } while (0)

    const int vlane = ((lane >> 4) & 1) * 32 + (lane & 3) * 8 + (4 * hi + ((lane & 15) >> 2)) * 64;
    f32x16 pA0, pA1, pB0, pB1; bf16x8 pa[4];
    int kc = 0, vc = 0;
    { const int t_a = __builtin_ctzll(tmask); tmask &= tmask - 1; ATP_SLOAD(t_a); ATP_SWRITE(0, 0); }
    bool have_next = tmask != 0ull; int t_next = have_next ? __builtin_ctzll(tmask) : 0; tmask &= tmask - 1;
    __syncthreads();
    if (have_next) ATP_SLOAD(t_next);
    ATP_QKT(pA0, pA1, 0);
    if (have_next) ATP_SWRITE(1, 1);
    __syncthreads();
    for (;;) { ATP_STEP(pA0, pA1, pB0, pB1); ATP_STEP(pB0, pB1, pA0, pA1); }
atp_done:
#undef ATP_SLOAD
#undef ATP_SWRITE
#undef ATP_QKT
#undef ATP_SOFT
#undef ATP_SUM
#undef ATP_VRD
#undef ATP_PK
#undef ATP_MMA
#undef ATP_STEP
    { const float lt = xor_add<32>(l_reg); if (hi == 0) wsf[32 + r32] = 1.0f / lt; }
    LDS_WAIT();
#pragma unroll
    for (int g = 0; g < 4; ++g) {
        const f32x4 l0 = *(const LAS f32x4*)(wsf + 32 + 8 * g + 4 * hi);
#pragma unroll
        for (int d = 0; d < ND0; ++d)
#pragma unroll
            for (int i = 0; i < 4; ++i) res[d][4 * g + i] = o[d][4 * g + i] * l0[i];
    }
    LDS_WAIT();
    __syncthreads();
}
template <int DQK, int DV, int MODE, int RB, bool QL = false, bool QPREP = false>
__device__ __forceinline__ void attn_core_rb(const Args& A, int q0, unsigned long long tmask, LAS unsigned char* lds, float (&res)[RB][DV / 32][16]) {
    constexpr int KSTR = DQK * 2 + 16, KBYTES = 64 * KSTR, VBYTES = 64 * DV * 2, PBYTES = 256;
    constexpr int BUF = KBYTES + VBYTES + PBYTES;
    constexpr int CPR = DQK / 8, NKP = 64 * CPR, KP = (NKP + 511) / 512, VP = (64 * DV / 8) / 512, ND0 = DV / 32, NKS = DQK / 16;
    static_assert(2 * BUF + 8 * 256 + (QL ? 8 * RB * NKS * 1024 : 0) <= (QL ? ATT_NXT_OFF : ATT_STASH_OFF), "attention LDS");
    int tid_ = threadIdx.x; asm volatile("" : "+v"(tid_));
    const int tid = tid_, lane = tid & 63, wid = __builtin_amdgcn_readfirstlane(tid >> 6), r32 = lane & 31, hi = lane >> 5;
    LAS float* wsf = (LAS float*)(lds + 2 * BUF) + wid * 64;
    LAS bf16x8* qlds = (LAS bf16x8*)(lds + 2 * BUF + 8 * 256) + wid * (RB * NKS * 64) + lane;
    const int wrow = q0 + wid * (32 * RB);

    bf16x8 sk[KP], sv[VP]; float spos = 0.f;
    unsigned gk_off[KP], lk_off[KP], gv_off[VP], lv_off[VP];
#pragma unroll
    for (int i = 0; i < KP; ++i) { const int p = tid + 512 * i, row = p / CPR, ch = p % CPR; gk_off[i] = (unsigned)(row * A.pk + ch * 8) * 2u; lk_off[i] = (unsigned)(row * KSTR + ch * 16); }
#pragma unroll
    for (int i = 0; i < VP; ++i) { const int p = tid + 512 * i, db = p >> 8, row = (p & 255) >> 2, c4 = p & 3; gv_off[i] = (unsigned)(row * A.pv + db * 32 + c4 * 8) * 2u;
        lv_off[i] = (unsigned)(KBYTES + db * 4096 + (row >> 4) * 1024 + (row & 15) * 64 + c4 * 16); }
#define ATR_SLOAD(t) do { const int k0_ = (t) * 64; const char* kb_ = (const char*)(A.K + (size_t)k0_ * A.pk); const char* vb_ = (const char*)(A.V + (size_t)k0_ * A.pv); \
    _Pragma("unroll") for (int i = 0; i < KP; ++i) { if (tid + 512 * i < NKP) sk[i] = *(const bf16x8*)(kb_ + gk_off[i]); } \
    _Pragma("unroll") for (int i = 0; i < VP; ++i) sv[i] = *(const bf16x8*)(vb_ + gv_off[i]); \
    if (MODE == 1) { if (tid < 64) spos = (float)A.pos[k0_ + tid]; } if (MODE == 2) { spos = (float)(k0_ + tid); } } while (0)
#define ATR_SWRITE(b) do { LAS unsigned char* base_ = lds + (b) * BUF; \
    _Pragma("unroll") for (int i = 0; i < KP; ++i) { if (tid + 512 * i < NKP) *(LAS bf16x8*)(base_ + lk_off[i]) = sk[i]; } \
    _Pragma("unroll") for (int i = 0; i < VP; ++i) *(LAS bf16x8*)(base_ + lv_off[i]) = sv[i]; \
    if (MODE != 0) { if (tid < 64) *(LAS float*)(base_ + KBYTES + VBYTES + tid * 4) = spos; } } while (0)
#define ATR_VRD(VF, d) do { const LAS unsigned char* vp_ = vbase + (d) * 4096; \
    _Pragma("unroll") for (int ks = 0; ks < 4; ++ks) { VF[2 * ks] = vtr(vp_ + ks * 1024); VF[2 * ks + 1] = vtr(vp_ + ks * 1024 + 512); } } while (0)
#define ATR_PK(L, H) (bf16x8){L[0], L[1], L[2], L[3], H[0], H[1], H[2], H[3]}
#define ATR_MMA(VF, d) do { _Pragma("unroll") for (int rb = 0; rb < RB; ++rb) _Pragma("unroll") for (int ks = 0; ks < 4; ++ks) \
        o[rb][d] = __builtin_amdgcn_mfma_f32_32x32x16_bf16(pa[rb][ks], ATR_PK(VF[2 * ks], VF[2 * ks + 1]), o[rb][d], 0, 0, 0); } while (0)

    int t = __builtin_ctzll(tmask); tmask &= tmask - 1;
    ATR_SLOAD(t);
    bf16x8 qr[RB][NKS]; float pqf[RB];
#pragma unroll
    for (int rb = 0; rb < RB; ++rb) {
#pragma unroll
        for (int d0 = 0; d0 < NKS; ++d0) { qr[rb][d0] = *(const bf16x8*)(A.Q + (size_t)(wrow + rb * 32 + r32) * A.pq + d0 * 16 + hi * 8); if (QL && !QPREP) qlds[(rb * NKS + d0) * 64] = qr[rb][d0]; }
        if constexpr (QPREP) {
            static_assert(!QPREP || (DQK == 96 && QL), "QPREP is the latent attention's query path");
            float v[NKS][8];
#pragma unroll
            for (int d0 = 0; d0 < NKS; ++d0) { const v4u w = __builtin_bit_cast(v4u, qr[rb][d0]);
                v[d0][0] = bflo(w.x); v[d0][1] = bfhi(w.x); v[d0][2] = bflo(w.y); v[d0][3] = bfhi(w.y); v[d0][4] = bflo(w.z); v[d0][5] = bfhi(w.z); v[d0][6] = bflo(w.w); v[d0][7] = bfhi(w.w); }
            const float posf = (float)A.pos[wrow + rb * 32 + r32];
#pragma unroll
            for (int j = 0; j < 8; ++j) {
                const float fi = (float)(hi * 8 + j);
                const float invf = __builtin_amdgcn_exp2f(-fi * 0.83048202372184f) * 0.15915494309189535f;
                const float fr = __builtin_amdgcn_fractf(posf * invf);
                const float cs = __builtin_amdgcn_cosf(fr), sn = __builtin_amdgcn_sinf(fr);
                const float x = v[4][j], y = v[5][j]; v[4][j] = x * cs - y * sn; v[5][j] = x * sn + y * cs; }
            float ss = 0.f;
#pragma unroll
            for (int d0 = 0; d0 < NKS; ++d0)
#pragma unroll
                for (int j = 0; j < 8; ++j) ss = fmaf(v[d0][j], v[d0][j], ss);
            ss = xor_add<32>(ss);
            const float rq = (1.0f / sqrtf(ss * (1.0f / 96) + EPS)) * (0.10206207261596575f * LOG2E);
#pragma unroll
            for (int d0 = 0; d0 < NKS; ++d0) { const float* gp = A.qg + d0 * 16 + hi * 8; const f32x4 g0 = *(const f32x4*)gp, g1 = *(const f32x4*)(gp + 4);
                v4u w; w.x = cvtpk(v[d0][0] * rq * g0[0], v[d0][1] * rq * g0[1]); w.y = cvtpk(v[d0][2] * rq * g0[2], v[d0][3] * rq * g0[3]);
                w.z = cvtpk(v[d0][4] * rq * g1[0], v[d0][5] * rq * g1[1]); w.w = cvtpk(v[d0][6] * rq * g1[2], v[d0][7] * rq * g1[3]);
                qr[rb][d0] = __builtin_bit_cast(bf16x8, w); qlds[(rb * NKS + d0) * 64] = qr[rb][d0]; }
        }
        pqf[rb] = 0.f;
        if (MODE == 1) pqf[rb] = (float)A.pos[wrow + rb * 32 + r32];
        if (MODE == 2) pqf[rb] = (float)(wrow + rb * 32 + r32);
    }
    f32x16 o[RB][ND0]; float l_reg[RB];
#pragma unroll
    for (int rb = 0; rb < RB; ++rb) { l_reg[rb] = (MODE == 2 && hi == 0) ? __builtin_amdgcn_exp2f(A.sink2) : 0.f;
#pragma unroll
        for (int d = 0; d < ND0; ++d)
#pragma unroll
            for (int r = 0; r < 16; ++r) o[rb][d][r] = 0.f; }

    ATR_SWRITE(0); __syncthreads();
    if (wid >= 4) __builtin_amdgcn_s_setprio(1);
    for (int cur = 0;; cur ^= 1) {
        const bool more = tmask != 0ull; const int tn = more ? __builtin_ctzll(tmask) : 0; tmask &= tmask - 1;
        LAS unsigned char* bufp = lds + cur * BUF;
        if (more) ATR_SLOAD(tn);
        const bool active = (MODE != 2) || (t * 64 + 63 >= wrow - 128 && t * 64 <= wrow + 32 * RB - 1 + 128);
        if (active) {
        const LAS unsigned char* vbase = bufp + KBYTES + ((lane >> 4) & 1) * 32 + (lane & 3) * 8 + (4 * hi + ((lane & 15) >> 2)) * 64;
        s16x4 vfa[8], vfb[8];
        if (RB == 1) ATR_VRD(vfa, 0);
        bf16x8 pa[RB][4];
        f32x16 pp[RB][2];
        {
            const f32x16 zero = {0.f, 0.f, 0.f, 0.f, 0.f, 0.f, 0.f, 0.f, 0.f, 0.f, 0.f, 0.f, 0.f, 0.f, 0.f, 0.f};
            const LAS unsigned char* kb = bufp + r32 * KSTR + hi * 16;
#pragma unroll
            for (int d0 = 0; d0 < NKS; ++d0) {
                const bf16x8 b0 = *(const LAS bf16x8*)(kb + d0 * 32);
                const bf16x8 b1 = *(const LAS bf16x8*)(kb + 32 * KSTR + d0 * 32);
#pragma unroll
                for (int rb = 0; rb < RB; ++rb) {
                    const bf16x8 qf = QL ? qlds[(rb * NKS + d0) * 64] : qr[rb][d0];
                    if (d0 == 0) { pp[rb][0] = __builtin_amdgcn_mfma_f32_32x32x16_bf16(b0, qf, zero, 0, 0, 0); pp[rb][1] = __builtin_amdgcn_mfma_f32_32x32x16_bf16(b1, qf, zero, 0, 0, 0); }
                    else { pp[rb][0] = __builtin_amdgcn_mfma_f32_32x32x16_bf16(b0, qf, pp[rb][0], 0, 0, 0); pp[rb][1] = __builtin_amdgcn_mfma_f32_32x32x16_bf16(b1, qf, pp[rb][1], 0, 0, 0); }
                }
            }
        }
#pragma unroll
        for (int rb = 0; rb < RB; ++rb) {
            f32x16 p0 = pp[rb][0], p1 = pp[rb][1];
            if (MODE != 0) {
                const LAS float* pk = (const LAS float*)(bufp + KBYTES + VBYTES);
#pragma unroll
                for (int g = 0; g < 4; ++g) {
                    const f32x4 k0v = *(const LAS f32x4*)(pk + 8 * g + 4 * hi), k1v = *(const LAS f32x4*)(pk + 32 + 8 * g + 4 * hi);
#pragma unroll
                    for (int i = 0; i < 4; ++i) {
                        const float d0f = fabsf(pqf[rb] - k0v[i]), d1f = fabsf(pqf[rb] - k1v[i]);
                        float s0 = fmaf(-A.slope2, d0f, p0[4 * g + i]), s1 = fmaf(-A.slope2, d1f, p1[4 * g + i]);
                        if (MODE == 2) { s0 = d0f <= 128.0f ? s0 : -1e30f; s1 = d1f <= 128.0f ? s1 : -1e30f; }
                        p0[4 * g + i] = s0; p1[4 * g + i] = s1;
                    }
                }
            }
#pragma unroll
            for (int r = 0; r < 16; ++r) { p0[r] = __builtin_amdgcn_exp2f(p0[r]); p1[r] = __builtin_amdgcn_exp2f(p1[r]); }
            float ps0 = p0[0] + p1[0], ps1 = p0[1] + p1[1], ps2 = p0[2] + p1[2], ps3 = p0[3] + p1[3];
#pragma unroll
            for (int r = 4; r < 16; r += 4) { ps0 += p0[r] + p1[r]; ps1 += p0[r + 1] + p1[r + 1]; ps2 += p0[r + 2] + p1[r + 2]; ps3 += p0[r + 3] + p1[r + 3]; }
            l_reg[rb] += (ps0 + ps1) + (ps2 + ps3);
#pragma unroll
            for (int s = 0; s < 2; ++s) {
                v4u w0 = {cvtpk(p0[8 * s + 0], p0[8 * s + 1]), cvtpk(p0[8 * s + 2], p0[8 * s + 3]), cvtpk(p0[8 * s + 4], p0[8 * s + 5]), cvtpk(p0[8 * s + 6], p0[8 * s + 7])};
                v4u w1 = {cvtpk(p1[8 * s + 0], p1[8 * s + 1]), cvtpk(p1[8 * s + 2], p1[8 * s + 3]), cvtpk(p1[8 * s + 4], p1[8 * s + 5]), cvtpk(p1[8 * s + 6], p1[8 * s + 7])};
                pa[rb][s] = __builtin_bit_cast(bf16x8, w0); pa[rb][2 + s] = __builtin_bit_cast(bf16x8, w1);
            }
        }
        if (RB == 2) { _Pragma("unroll") for (int d = 0; d < ND0; ++d) { ATR_VRD(vfa, d); ATR_MMA(vfa, d); } (void)vfb; }
        else if (ND0 == 2) { ATR_VRD(vfb, 1); ATR_MMA(vfa, 0); ATR_MMA(vfb, 1); }
        else { ATR_VRD(vfb, 1); ATR_MMA(vfa, 0); ATR_VRD(vfa, 2); ATR_MMA(vfb, 1); ATR_VRD(vfb, 3); ATR_MMA(vfa, 2); ATR_MMA(vfb, 3); }
        }
        if (more) ATR_SWRITE(cur ^ 1);
        __syncthreads();
        if (!more) break;
        t = tn;
    }
    __builtin_amdgcn_s_setprio(0);
#undef ATR_SLOAD
#undef ATR_SWRITE
#undef ATR_VRD
#undef ATR_PK
#undef ATR_MMA
#pragma unroll
    for (int rb = 0; rb < RB; ++rb) { const float lt = xor_add<32>(l_reg[rb]); if (hi == 0) wsf[rb * 32 + r32] = 1.0f / lt; }
    LDS_WAIT();
#pragma unroll
    for (int rb = 0; rb < RB; ++rb)
#pragma unroll
        for (int g = 0; g < 4; ++g) {
            const f32x4 l0 = *(const LAS f32x4*)(wsf + rb * 32 + 8 * g + 4 * hi);
#pragma unroll
            for (int d = 0; d < ND0; ++d)
#pragma unroll
                for (int i = 0; i < 4; ++i) res[rb][d][4 * g + i] = o[rb][d][4 * g + i] * l0[i];
        }
    LDS_WAIT();
    __syncthreads();
}
template <int DQK, int DV, int MODE, int RB, bool QL = false>
__device__ __forceinline__ void attn_core_pd2(const Args& A, int q0, unsigned long long tmask, LAS unsigned char* lds, float (&res)[RB][DV / 32][16]) {
    constexpr int KSTR = DQK * 2 + 16, KBYTES = 64 * KSTR, VBYTES = 64 * DV * 2, PBYTES = 256;
    constexpr int BUF = KBYTES + VBYTES + PBYTES;
    constexpr int CPR = DQK / 8, NKP = 64 * CPR, KP = (NKP + 511) / 512, VP = (64 * DV / 8) / 512, ND0 = DV / 32, NKS = DQK / 16;
    static_assert(2 * BUF + 8 * 256 + (QL ? 8 * RB * NKS * 1024 : 0) <= (QL ? ATT_NXT_OFF : ATT_STASH_OFF), "attention LDS");
    int tid_ = threadIdx.x; asm volatile("" : "+v"(tid_));
    const int tid = tid_, lane = tid & 63, wid = __builtin_amdgcn_readfirstlane(tid >> 6), r32 = lane & 31, hi = lane >> 5;
    LAS float* wsf = (LAS float*)(lds + 2 * BUF) + wid * 64;
    LAS bf16x8* qlds = (LAS bf16x8*)(lds + 2 * BUF + 8 * 256) + wid * (RB * NKS * 64) + lane;
    const int wrow = q0 + wid * (32 * RB);

    bf16x8 qr[RB][NKS]; float pqf[RB];
#pragma unroll
    for (int rb = 0; rb < RB; ++rb) {
#pragma unroll
        for (int d0 = 0; d0 < NKS; ++d0) { qr[rb][d0] = *(const bf16x8*)(A.Q + (size_t)(wrow + rb * 32 + r32) * A.pq + d0 * 16 + hi * 8); if (QL) qlds[(rb * NKS + d0) * 64] = qr[rb][d0]; }
        pqf[rb] = 0.f;
        if (MODE == 1) pqf[rb] = (float)A.pos[wrow + rb * 32 + r32];
        if (MODE == 2) pqf[rb] = (float)(wrow + rb * 32 + r32);
    }
    f32x16 o[RB][ND0]; float l_reg[RB];
#pragma unroll
    for (int rb = 0; rb < RB; ++rb) { l_reg[rb] = (MODE == 2 && hi == 0) ? __builtin_amdgcn_exp2f(A.sink2) : 0.f;
#pragma unroll
        for (int d = 0; d < ND0; ++d)
#pragma unroll
            for (int r = 0; r < 16; ++r) o[rb][d][r] = 0.f; }

    bf16x8 skA[KP], svA[VP], skB[KP], svB[VP]; float sposA = 0.f, sposB = 0.f;
    unsigned gk_off[KP], lk_off[KP], gv_off[VP], lv_off[VP];
#pragma unroll
    for (int i = 0; i < KP; ++i) { const int p = tid + 512 * i, row = p / CPR, ch = p % CPR; gk_off[i] = (unsigned)(row * A.pk + ch * 8) * 2u; lk_off[i] = (unsigned)(row * KSTR + ch * 16); }
#pragma unroll
    for (int i = 0; i < VP; ++i) { const int p = tid + 512 * i, db = p >> 8, row = (p & 255) >> 2, c4 = p & 3; gv_off[i] = (unsigned)(row * A.pv + db * 32 + c4 * 8) * 2u;
        lv_off[i] = (unsigned)(KBYTES + db * 4096 + (row >> 4) * 1024 + (row & 15) * 64 + c4 * 16); }
#define ATR_SLOAD(t, sk, sv, spos) do { const int k0_ = (t) * 64; const char* kb_ = (const char*)(A.K + (size_t)k0_ * A.pk); const char* vb_ = (const char*)(A.V + (size_t)k0_ * A.pv); \
    _Pragma("unroll") for (int i = 0; i < KP; ++i) { if (tid + 512 * i < NKP) sk[i] = *(const bf16x8*)(kb_ + gk_off[i]); } \
    _Pragma("unroll") for (int i = 0; i < VP; ++i) sv[i] = *(const bf16x8*)(vb_ + gv_off[i]); \
    if (MODE == 1) { if (tid < 64) spos = (float)A.pos[k0_ + tid]; } if (MODE == 2) { spos = (float)(k0_ + tid); } } while (0)
#define ATR_SWRITE(b, sk, sv, spos) do { LAS unsigned char* base_ = lds + (b) * BUF; \
    _Pragma("unroll") for (int i = 0; i < KP; ++i) { if (tid + 512 * i < NKP) *(LAS bf16x8*)(base_ + lk_off[i]) = sk[i]; } \
    _Pragma("unroll") for (int i = 0; i < VP; ++i) *(LAS bf16x8*)(base_ + lv_off[i]) = sv[i]; \
    if (MODE != 0) { if (tid < 64) *(LAS float*)(base_ + KBYTES + VBYTES + tid * 4) = spos; } } while (0)
#define ATR_VRD(VF, d) do { const LAS unsigned char* vp_ = vbase + (d) * 4096; \
    _Pragma("unroll") for (int ks = 0; ks < 4; ++ks) { VF[2 * ks] = vtr(vp_ + ks * 1024); VF[2 * ks + 1] = vtr(vp_ + ks * 1024 + 512); } } while (0)
#define ATR_PK(L, H) (bf16x8){L[0], L[1], L[2], L[3], H[0], H[1], H[2], H[3]}
#define ATR_MMA(VF, d) do { _Pragma("unroll") for (int rb = 0; rb < RB; ++rb) _Pragma("unroll") for (int ks = 0; ks < 4; ++ks) \
        o[rb][d] = __builtin_amdgcn_mfma_f32_32x32x16_bf16(pa[rb][ks], ATR_PK(VF[2 * ks], VF[2 * ks + 1]), o[rb][d], 0, 0, 0); } while (0)

    int cur = 0;
    const int t0 = __builtin_ctzll(tmask); tmask &= tmask - 1;
    bool more1 = tmask != 0ull; const int t1 = more1 ? __builtin_ctzll(tmask) : 0; tmask &= tmask - 1;
    bool more2 = tmask != 0ull; int t2 = more2 ? __builtin_ctzll(tmask) : 0; tmask &= tmask - 1;
    ATR_SLOAD(t0, skA, svA, sposA); ATR_SWRITE(0, skA, svA, sposA);
    if (more1) ATR_SLOAD(t1, skB, svB, sposB);
    __syncthreads();
    for (;;) {
        {
        LAS unsigned char* bufp = lds + cur * BUF;
        if (more2) ATR_SLOAD(t2, skA, svA, sposA);
        const LAS unsigned char* vbase = bufp + KBYTES + ((lane >> 4) & 1) * 32 + (lane & 3) * 8 + (4 * hi + ((lane & 15) >> 2)) * 64;
        s16x4 vfa[8], vfb[8];
        if (RB == 1) ATR_VRD(vfa, 0);
        bf16x8 pa[RB][4];
        f32x16 pp[RB][2];
        {
            const f32x16 zero = {0.f, 0.f, 0.f, 0.f, 0.f, 0.f, 0.f, 0.f, 0.f, 0.f, 0.f, 0.f, 0.f, 0.f, 0.f, 0.f};
            const LAS unsigned char* kb = bufp + r32 * KSTR + hi * 16;
#pragma unroll
            for (int d0 = 0; d0 < NKS; ++d0) {
                const bf16x8 b0 = *(const LAS bf16x8*)(kb + d0 * 32);
                const bf16x8 b1 = *(const LAS bf16x8*)(kb + 32 * KSTR + d0 * 32);
#pragma unroll
                for (int rb = 0; rb < RB; ++rb) {
                    const bf16x8 qf = QL ? qlds[(rb * NKS + d0) * 64] : qr[rb][d0];
                    if (d0 == 0) { pp[rb][0] = __builtin_amdgcn_mfma_f32_32x32x16_bf16(b0, qf, zero, 0, 0, 0); pp[rb][1] = __builtin_amdgcn_mfma_f32_32x32x16_bf16(b1, qf, zero, 0, 0, 0); }
                    else { pp[rb][0] = __builtin_amdgcn_mfma_f32_32x32x16_bf16(b0, qf, pp[rb][0], 0, 0, 0); pp[rb][1] = __builtin_amdgcn_mfma_f32_32x32x16_bf16(b1, qf, pp[rb][1], 0, 0, 0); }
                }
            }
        }
#pragma unroll
        for (int rb = 0; rb < RB; ++rb) {
            f32x16 p0 = pp[rb][0], p1 = pp[rb][1];
            if (MODE != 0) {
                const LAS float* pk = (const LAS float*)(bufp + KBYTES + VBYTES);
#pragma unroll
                for (int g = 0; g < 4; ++g) {
                    const f32x4 k0v = *(const LAS f32x4*)(pk + 8 * g + 4 * hi), k1v = *(const LAS f32x4*)(pk + 32 + 8 * g + 4 * hi);
#pragma unroll
                    for (int i = 0; i < 4; ++i) {
                        const float d0f = fabsf(pqf[rb] - k0v[i]), d1f = fabsf(pqf[rb] - k1v[i]);
                        float s0 = fmaf(-A.slope2, d0f, p0[4 * g + i]), s1 = fmaf(-A.slope2, d1f, p1[4 * g + i]);
                        if (MODE == 2) { s0 = d0f <= 128.0f ? s0 : -1e30f; s1 = d1f <= 128.0f ? s1 : -1e30f; }
                        p0[4 * g + i] = s0; p1[4 * g + i] = s1;
                    }
                }
            }
#pragma unroll
            for (int r = 0; r < 16; ++r) { p0[r] = __builtin_amdgcn_exp2f(p0[r]); p1[r] = __builtin_amdgcn_exp2f(p1[r]); }
            float ps0 = p0[0] + p1[0], ps1 = p0[1] + p1[1], ps2 = p0[2] + p1[2], ps3 = p0[3] + p1[3];
#pragma unroll
            for (int r = 4; r < 16; r += 4) { ps0 += p0[r] + p1[r]; ps1 += p0[r + 1] + p1[r + 1]; ps2 += p0[r + 2] + p1[r + 2]; ps3 += p0[r + 3] + p1[r + 3]; }
            l_reg[rb] += (ps0 + ps1) + (ps2 + ps3);
#pragma unroll
            for (int s = 0; s < 2; ++s) {
                v4u w0 = {cvtpk(p0[8 * s + 0], p0[8 * s + 1]), cvtpk(p0[8 * s + 2], p0[8 * s + 3]), cvtpk(p0[8 * s + 4], p0[8 * s + 5]), cvtpk(p0[8 * s + 6], p0[8 * s + 7])};
                v4u w1 = {cvtpk(p1[8 * s + 0], p1[8 * s + 1]), cvtpk(p1[8 * s + 2], p1[8 * s + 3]), cvtpk(p1[8 * s + 4], p1[8 * s + 5]), cvtpk(p1[8 * s + 6], p1[8 * s + 7])};
                pa[rb][s] = __builtin_bit_cast(bf16x8, w0); pa[rb][2 + s] = __builtin_bit_cast(bf16x8, w1);
            }
        }
        if (RB == 2) { _Pragma("unroll") for (int d = 0; d < ND0; ++d) { ATR_VRD(vfa, d); ATR_MMA(vfa, d); } (void)vfb; }
        else if (ND0 == 2) { ATR_VRD(vfb, 1); ATR_MMA(vfa, 0); ATR_MMA(vfb, 1); }
        else { ATR_VRD(vfb, 1); ATR_MMA(vfa, 0); ATR_VRD(vfa, 2); ATR_MMA(vfb, 1); ATR_VRD(vfb, 3); ATR_MMA(vfa, 2); ATR_MMA(vfb, 3); }
        if (more1) ATR_SWRITE(cur ^ 1, skB, svB, sposB);
        __syncthreads();
        if (!more1) break;
        cur ^= 1; more1 = more2; more2 = tmask != 0ull; t2 = more2 ? __builtin_ctzll(tmask) : 0; tmask &= tmask - 1;
        }
        {
        LAS unsigned char* bufp = lds + cur * BUF;
        if (more2) ATR_SLOAD(t2, skB, svB, sposB);
        const LAS unsigned char* vbase = bufp + KBYTES + ((lane >> 4) & 1) * 32 + (lane & 3) * 8 + (4 * hi + ((lane & 15) >> 2)) * 64;
        s16x4 vfa[8], vfb[8];
        if (RB == 1) ATR_VRD(vfa, 0);
        bf16x8 pa[RB][4];
        f32x16 pp[RB][2];
        {
            const f32x16 zero = {0.f, 0.f, 0.f, 0.f, 0.f, 0.f, 0.f, 0.f, 0.f, 0.f, 0.f, 0.f, 0.f, 0.f, 0.f, 0.f};
            const LAS unsigned char* kb = bufp + r32 * KSTR + hi * 16;
#pragma unroll
            for (int d0 = 0; d0 < NKS; ++d0) {
                const bf16x8 b0 = *(const LAS bf16x8*)(kb + d0 * 32);
                const bf16x8 b1 = *(const LAS bf16x8*)(kb + 32 * KSTR + d0 * 32);
#pragma unroll
                for (int rb = 0; rb < RB; ++rb) {
                    const bf16x8 qf = QL ? qlds[(rb * NKS + d0) * 64] : qr[rb][d0];
                    if (d0 == 0) { pp[rb][0] = __builtin_amdgcn_mfma_f32_32x32x16_bf16(b0, qf, zero, 0, 0, 0); pp[rb][1] = __builtin_amdgcn_mfma_f32_32x32x16_bf16(b1, qf, zero, 0, 0, 0); }
                    else { pp[rb][0] = __builtin_amdgcn_mfma_f32_32x32x16_bf16(b0, qf, pp[rb][0], 0, 0, 0); pp[rb][1] = __builtin_amdgcn_mfma_f32_32x32x16_bf16(b1, qf, pp[rb][1], 0, 0, 0); }
                }
            }
        }
#pragma unroll
        for (int rb = 0; rb < RB; ++rb) {
            f32x16 p0 = pp[rb][0], p1 = pp[rb][1];
            if (MODE != 0) {
                const LAS float* pk = (const LAS float*)(bufp + KBYTES + VBYTES);
#pragma unroll
                for (int g = 0; g < 4; ++g) {
                    const f32x4 k0v = *(const LAS f32x4*)(pk + 8 * g + 4 * hi), k1v = *(const LAS f32x4*)(pk + 32 + 8 * g + 4 * hi);
#pragma unroll
                    for (int i = 0; i < 4; ++i) {
                        const float d0f = fabsf(pqf[rb] - k0v[i]), d1f = fabsf(pqf[rb] - k1v[i]);
                        float s0 = fmaf(-A.slope2, d0f, p0[4 * g + i]), s1 = fmaf(-A.slope2, d1f, p1[4 * g + i]);
                        if (MODE == 2) { s0 = d0f <= 128.0f ? s0 : -1e30f; s1 = d1f <= 128.0f ? s1 : -1e30f; }
                        p0[4 * g + i] = s0; p1[4 * g + i] = s1;
                    }
                }
            }
#pragma unroll
            for (int r = 0; r < 16; ++r) { p0[r] = __builtin_amdgcn_exp2f(p0[r]); p1[r] = __builtin_amdgcn_exp2f(p1[r]); }
            float ps0 = p0[0] + p1[0], ps1 = p0[1] + p1[1], ps2 = p0[2] + p1[2], ps3 = p0[3] + p1[3];
#pragma unroll
            for (int r = 4; r < 16; r += 4) { ps0 += p0[r] + p1[r]; ps1 += p0[r + 1] + p1[r + 1]; ps2 += p0[r + 2] + p1[r + 2]; ps3 += p0[r + 3] + p1[r + 3]; }
            l_reg[rb] += (ps0 + ps1) + (ps2 + ps3);
#pragma unroll
            for (int s = 0; s < 2; ++s) {
                v4u w0 = {cvtpk(p0[8 * s + 0], p0[8 * s + 1]), cvtpk(p0[8 * s + 2], p0[8 * s + 3]), cvtpk(p0[8 * s + 4], p0[8 * s + 5]), cvtpk(p0[8 * s + 6], p0[8 * s + 7])};
                v4u w1 = {cvtpk(p1[8 * s + 0], p1[8 * s + 1]), cvtpk(p1[8 * s + 2], p1[8 * s + 3]), cvtpk(p1[8 * s + 4], p1[8 * s + 5]), cvtpk(p1[8 * s + 6], p1[8 * s + 7])};
                pa[rb][s] = __builtin_bit_cast(bf16x8, w0); pa[rb][2 + s] = __builtin_bit_cast(bf16x8, w1);
            }
        }
        if (RB == 2) { _Pragma("unroll") for (int d = 0; d < ND0; ++d) { ATR_VRD(vfa, d); ATR_MMA(vfa, d); } (void)vfb; }
        else if (ND0 == 2) { ATR_VRD(vfb, 1); ATR_MMA(vfa, 0); ATR_MMA(vfb, 1); }
        else { ATR_VRD(vfb, 1); ATR_MMA(vfa, 0); ATR_VRD(vfa, 2); ATR_MMA(vfb, 1); ATR_VRD(vfb, 3); ATR_MMA(vfa, 2); ATR_MMA(vfb, 3); }
        if (more1) ATR_SWRITE(cur ^ 1, skA, svA, sposA);
        __syncthreads();
        if (!more1) break;
        cur ^= 1; more1 = more2; more2 = tmask != 0ull; t2 = more2 ? __builtin_ctzll(tmask) : 0; tmask &= tmask - 1;
        }
    }
#undef ATR_SLOAD
#undef ATR_SWRITE
#undef ATR_VRD
#undef ATR_PK
#undef ATR_MMA
#pragma unroll
    for (int rb = 0; rb < RB; ++rb) { const float lt = xor_add<32>(l_reg[rb]); if (hi == 0) wsf[rb * 32 + r32] = 1.0f / lt; }
    LDS_WAIT();
#pragma unroll
    for (int rb = 0; rb < RB; ++rb)
#pragma unroll
        for (int g = 0; g < 4; ++g) {
            const f32x4 l0 = *(const LAS f32x4*)(wsf + rb * 32 + 8 * g + 4 * hi);
#pragma unroll
            for (int d = 0; d < ND0; ++d)
#pragma unroll
                for (int i = 0; i < 4; ++i) res[rb][d][4 * g + i] = o[rb][d][4 * g + i] * l0[i];
        }
    LDS_WAIT();
    __syncthreads();
}
template <int DQK, int DV, int MODE, int RB, bool QL = false>
__device__ __forceinline__ void attn_core_pp(const Args& A, int q0, unsigned long long tmask, LAS unsigned char* lds, float (&res)[RB][DV / 32][16]) {
    constexpr int KSTR = DQK * 2 + 16, KBYTES = 64 * KSTR, VBYTES = 64 * DV * 2;
    constexpr int OFF_V = 2 * KBYTES, OFF_PK = OFF_V + 2 * VBYTES, OFF_WS = OFF_PK + 4 * 256, OFF_Q = OFF_WS + 8 * 256;
    constexpr int CPR = DQK / 8, NKP = 64 * CPR, KP = (NKP + 511) / 512, VP = (64 * DV / 8) / 512, ND0 = DV / 32, NKS = DQK / 16;
    static_assert(OFF_Q + (QL ? 8 * RB * NKS * 1024 : 0) <= (QL ? ATT_NXT_OFF : ATT_STASH_OFF), "attention LDS");
    int tid_ = threadIdx.x; asm volatile("" : "+v"(tid_));
    const int tid = tid_, lane = tid & 63, wid = __builtin_amdgcn_readfirstlane(tid >> 6), r32 = lane & 31, hi = lane >> 5;
    LAS float* wsf = (LAS float*)(lds + OFF_WS) + wid * 64;
    LAS bf16x8* qlds = (LAS bf16x8*)(lds + OFF_Q) + wid * (RB * NKS * 64) + lane;
    const int wrow = q0 + wid * (32 * RB);

    bf16x8 qr[RB][NKS]; float pqf[RB];
#pragma unroll
    for (int rb = 0; rb < RB; ++rb) {
#pragma unroll
        for (int d0 = 0; d0 < NKS; ++d0) { qr[rb][d0] = *(const bf16x8*)(A.Q + (size_t)(wrow + rb * 32 + r32) * A.pq + d0 * 16 + hi * 8); if (QL) qlds[(rb * NKS + d0) * 64] = qr[rb][d0]; }
        pqf[rb] = 0.f;
        if (MODE == 1) pqf[rb] = (float)A.pos[wrow + rb * 32 + r32];
        if (MODE == 2) pqf[rb] = (float)(wrow + rb * 32 + r32);
    }
    f32x16 o[RB][ND0]; float l_reg[RB];
#pragma unroll
    for (int rb = 0; rb < RB; ++rb) { l_reg[rb] = (MODE == 2 && hi == 0) ? __builtin_amdgcn_exp2f(A.sink2) : 0.f;
#pragma unroll
        for (int d = 0; d < ND0; ++d)
#pragma unroll
            for (int r = 0; r < 16; ++r) o[rb][d][r] = 0.f; }

    bf16x8 sk[KP], sv[VP]; float spos = 0.f;
    unsigned gk_off[KP], lk_off[KP], gv_off[VP], lv_off[VP];
#pragma unroll
    for (int i = 0; i < KP; ++i) { const int p = tid + 512 * i, row = p / CPR, ch = p % CPR; gk_off[i] = (unsigned)(row * A.pk + ch * 8) * 2u; lk_off[i] = (unsigned)(row * KSTR + ch * 16); }
#pragma unroll
    for (int i = 0; i < VP; ++i) { const int p = tid + 512 * i, db = p >> 8, row = (p & 255) >> 2, c4 = p & 3; gv_off[i] = (unsigned)(row * A.pv + db * 32 + c4 * 8) * 2u;
        lv_off[i] = (unsigned)(OFF_V + db * 4096 + (row >> 4) * 1024 + (row & 15) * 64 + c4 * 16); }
#define APP_LOADK(t) do { const int k0_ = (t) * 64; const char* kb_ = (const char*)(A.K + (size_t)k0_ * A.pk); \
    _Pragma("unroll") for (int i = 0; i < KP; ++i) { if (tid + 512 * i < NKP) sk[i] = *(const bf16x8*)(kb_ + gk_off[i]); } \
    if (MODE == 1) { if (tid < 64) spos = (float)A.pos[k0_ + tid]; } if (MODE == 2) { spos = (float)(k0_ + tid); } } while (0)
#define APP_LOADV(t) do { const char* vb_ = (const char*)(A.V + (size_t)((t) * 64) * A.pv); \
    _Pragma("unroll") for (int i = 0; i < VP; ++i) sv[i] = *(const bf16x8*)(vb_ + gv_off[i]); } while (0)
#define APP_WRITEK(kb, pr) do { LAS unsigned char* base_ = lds + (kb) * KBYTES; \
    _Pragma("unroll") for (int i = 0; i < KP; ++i) { if (tid + 512 * i < NKP) *(LAS bf16x8*)(base_ + lk_off[i]) = sk[i]; } \
    if (MODE != 0) { if (tid < 64) *(LAS float*)(lds + OFF_PK + (pr) * 256 + tid * 4) = spos; } } while (0)
#define APP_WRITEV(vb) do { LAS unsigned char* base_ = lds + (vb) * VBYTES; \
    _Pragma("unroll") for (int i = 0; i < VP; ++i) *(LAS bf16x8*)(base_ + lv_off[i]) = sv[i]; } while (0)
#define APP_BAR() do { ATT_SBAR(); __builtin_amdgcn_s_barrier(); ATT_SBAR(); } while (0)
#define APP_VRD(VF, d) do { const LAS unsigned char* vp_ = vbase + (d) * 4096; \
    _Pragma("unroll") for (int ks = 0; ks < 4; ++ks) { VF[2 * ks] = vtr(vp_ + ks * 1024); VF[2 * ks + 1] = vtr(vp_ + ks * 1024 + 512); } } while (0)
#define APP_PK(L, H) (bf16x8){L[0], L[1], L[2], L[3], H[0], H[1], H[2], H[3]}
#define APP_MMA(VF, d) do { _Pragma("unroll") for (int rb = 0; rb < RB; ++rb) _Pragma("unroll") for (int ks = 0; ks < 4; ++ks) \
        o[rb][d] = __builtin_amdgcn_mfma_f32_32x32x16_bf16(pa[rb][ks], APP_PK(VF[2 * ks], VF[2 * ks + 1]), o[rb][d], 0, 0, 0); } while (0)
#define APP_QKT(kbuf) do { const f32x16 zero = {0.f, 0.f, 0.f, 0.f, 0.f, 0.f, 0.f, 0.f, 0.f, 0.f, 0.f, 0.f, 0.f, 0.f, 0.f, 0.f}; \
    const LAS unsigned char* kb = lds + (kbuf) * KBYTES + r32 * KSTR + hi * 16; \
    _Pragma("unroll") for (int d0 = 0; d0 < NKS; ++d0) { \
        const bf16x8 b0 = *(const LAS bf16x8*)(kb + d0 * 32); const bf16x8 b1 = *(const LAS bf16x8*)(kb + 32 * KSTR + d0 * 32); \
        _Pragma("unroll") for (int rb = 0; rb < RB; ++rb) { const bf16x8 qf = QL ? qlds[(rb * NKS + d0) * 64] : qr[rb][d0]; \
            if (d0 == 0) { pp[rb][0] = __builtin_amdgcn_mfma_f32_32x32x16_bf16(b0, qf, zero, 0, 0, 0); pp[rb][1] = __builtin_amdgcn_mfma_f32_32x32x16_bf16(b1, qf, zero, 0, 0, 0); } \
            else { pp[rb][0] = __builtin_amdgcn_mfma_f32_32x32x16_bf16(b0, qf, pp[rb][0], 0, 0, 0); pp[rb][1] = __builtin_amdgcn_mfma_f32_32x32x16_bf16(b1, qf, pp[rb][1], 0, 0, 0); } } } } while (0)
#define APP_POP(tv, hv) do { hv = tmask != 0ull; tv = hv ? __builtin_ctzll(tmask) : 0; tmask &= tmask - 1ull; } while (0)

    int ta, tb, tc; bool ha, hb, hc;
    APP_POP(ta, ha); APP_POP(tb, hb); APP_POP(tc, hc); (void)ha;
    APP_LOADK(ta); APP_WRITEK(0, 0);
    if (hb) APP_LOADK(tb);
    APP_LOADV(ta);
    LDS_WAIT();
    if (wid >= 4) APP_BAR();
    APP_BAR();
    f32x16 pp[RB][2]; bf16x8 pa[RB][4];
    __builtin_amdgcn_s_setprio(1);
    APP_QKT(0);
    if (hb) APP_WRITEK(1, 1);
    APP_WRITEV(0);
    __builtin_amdgcn_s_setprio(0);
    for (int j = 0;; ++j) {
        LDS_WAIT(); APP_BAR();
        if (hc) APP_LOADK(tc);
        if (hb) APP_LOADV(tb);
#pragma unroll
        for (int rb = 0; rb < RB; ++rb) {
            f32x16 p0 = pp[rb][0], p1 = pp[rb][1];
            if (MODE != 0) {
                const LAS float* pk = (const LAS float*)(lds + OFF_PK + (j & 3) * 256);
#pragma unroll
                for (int g = 0; g < 4; ++g) {
                    const f32x4 k0v = *(const LAS f32x4*)(pk + 8 * g + 4 * hi), k1v = *(const LAS f32x4*)(pk + 32 + 8 * g + 4 * hi);
#pragma unroll
                    for (int i = 0; i < 4; ++i) {
                        const float d0f = fabsf(pqf[rb] - k0v[i]), d1f = fabsf(pqf[rb] - k1v[i]);
                        float s0 = fmaf(-A.slope2, d0f, p0[4 * g + i]), s1 = fmaf(-A.slope2, d1f, p1[4 * g + i]);
                        if (MODE == 2) { s0 = d0f <= 128.0f ? s0 : -1e30f; s1 = d1f <= 128.0f ? s1 : -1e30f; }
                        p0[4 * g + i] = s0; p1[4 * g + i] = s1;
                    }
                }
            }
#pragma unroll
            for (int r = 0; r < 16; ++r) { p0[r] = __builtin_amdgcn_exp2f(p0[r]); p1[r] = __builtin_amdgcn_exp2f(p1[r]); }
            float ps0 = p0[0] + p1[0], ps1 = p0[1] + p1[1], ps2 = p0[2] + p1[2], ps3 = p0[3] + p1[3];
#pragma unroll
            for (int r = 4; r < 16; r += 4) { ps0 += p0[r] + p1[r]; ps1 += p0[r + 1] + p1[r + 1]; ps2 += p0[r + 2] + p1[r + 2]; ps3 += p0[r + 3] + p1[r + 3]; }
            l_reg[rb] += (ps0 + ps1) + (ps2 + ps3);
#pragma unroll
            for (int s = 0; s < 2; ++s) {
                v4u w0 = {cvtpk(p0[8 * s + 0], p0[8 * s + 1]), cvtpk(p0[8 * s + 2], p0[8 * s + 3]), cvtpk(p0[8 * s + 4], p0[8 * s + 5]), cvtpk(p0[8 * s + 6], p0[8 * s + 7])};
                v4u w1 = {cvtpk(p1[8 * s + 0], p1[8 * s + 1]), cvtpk(p1[8 * s + 2], p1[8 * s + 3]), cvtpk(p1[8 * s + 4], p1[8 * s + 5]), cvtpk(p1[8 * s + 6], p1[8 * s + 7])};
                pa[rb][s] = __builtin_bit_cast(bf16x8, w0); pa[rb][2 + s] = __builtin_bit_cast(bf16x8, w1);
            }
        }
        asm volatile("" ::: "memory"); APP_BAR();
        __builtin_amdgcn_s_setprio(1);
        {
            const LAS unsigned char* vbase = lds + OFF_V + (j & 1) * VBYTES + ((lane >> 4) & 1) * 32 + (lane & 3) * 8 + (4 * hi + ((lane & 15) >> 2)) * 64;
            s16x4 vfa[8], vfb[8];
            if (RB == 2) { _Pragma("unroll") for (int d = 0; d < ND0; ++d) { APP_VRD(vfa, d); APP_MMA(vfa, d); } (void)vfb; }
            else if (ND0 == 2) { APP_VRD(vfa, 0); APP_VRD(vfb, 1); APP_MMA(vfa, 0); APP_MMA(vfb, 1); }
            else { APP_VRD(vfa, 0); APP_VRD(vfb, 1); APP_MMA(vfa, 0); APP_VRD(vfa, 2); APP_MMA(vfb, 1); APP_VRD(vfb, 3); APP_MMA(vfa, 2); APP_MMA(vfb, 3); }
        }
        if (!hb) break;
        APP_QKT((j + 1) & 1);
        if (hc) APP_WRITEK(j & 1, (j + 2) & 3);
        APP_WRITEV((j + 1) & 1);
        __builtin_amdgcn_s_setprio(0);
        hb = hc; tb = tc; APP_POP(tc, hc);
    }
    __builtin_amdgcn_s_setprio(0);
    if (wid < 4) APP_BAR();
#undef APP_LOADK
#undef APP_LOADV
#undef APP_WRITEK
#undef APP_WRITEV
#undef APP_BAR
#undef APP_VRD
#undef APP_PK
#undef APP_MMA
#undef APP_QKT
#undef APP_POP
#pragma unroll
    for (int rb = 0; rb < RB; ++rb) { const float lt = xor_add<32>(l_reg[rb]); if (hi == 0) wsf[rb * 32 + r32] = 1.0f / lt; }
    LDS_WAIT();
#pragma unroll
    for (int rb = 0; rb < RB; ++rb)
#pragma unroll
        for (int g = 0; g < 4; ++g) {
            const f32x4 l0 = *(const LAS f32x4*)(wsf + rb * 32 + 8 * g + 4 * hi);
#pragma unroll
            for (int d = 0; d < ND0; ++d)
#pragma unroll
                for (int i = 0; i < 4; ++i) res[rb][d][4 * g + i] = o[rb][d][4 * g + i] * l0[i];
        }
    LDS_WAIT();
    __syncthreads();
}
template <int ND0> __device__ __forceinline__ void store_rows(const float (&res)[ND0][16], bf16* O, int po, int row0, int lane) {
    asm volatile("" : "+v"(lane));
    const int r32 = lane & 31, hi = lane >> 5;
    bf16* Ow = O + (size_t)row0 * po + r32;
#pragma unroll
    for (int r = 0; r < 16; ++r) { const int orow = crow(r, hi);
#pragma unroll
        for (int d = 0; d < ND0; ++d) Ow[(size_t)orow * po + d * 32] = (bf16)(cvtpk(res[d][r], 0.f) & 0xffffu); }
}
template <int ND0> __device__ __forceinline__ void store_res(const float (&res)[ND0][16], bf16* O, int po, int q0) {
    const int tid = threadIdx.x, lane = tid & 63, wid = __builtin_amdgcn_readfirstlane(tid >> 6), r32 = lane & 31, hi = lane >> 5;
    bf16* Ow = O + (size_t)(q0 + wid * 32) * po + r32;
#pragma unroll
    for (int r = 0; r < 16; ++r) { const int orow = crow(r, hi);
#pragma unroll
        for (int d = 0; d < ND0; ++d) Ow[(size_t)orow * po + d * 32] = (bf16)(cvtpk(res[d][r], 0.f) & 0xffffu); }
}
}

#ifndef ATT_CORE
#define ATT_CORE attn_core_rb
#endif
#ifndef ATT_CORE_A
#define ATT_CORE_A attn_core_rb
#endif

__device__ __forceinline__ float lam_init_of(int layer) { return layer == 0 ? 0.2f : 0.35550906759096184f; }
template <bool DRY> __device__ __forceinline__ void att_sec_A(const Frame& F, const float* diff_qk_g, const float* diff_lambda, const float* diff_out_g, unsigned char* ws, const int* positions, int layer) {
    int tid_ = threadIdx.x; asm volatile("" : "+v"(tid_)); const int lane = tid_ & 63, r32 = lane & 31;
    LAS unsigned char* lds = F.lds + RING_OFF;
    const float* lp = diff_lambda;
    const float s1 = wave_sum(lp[lane] * lp[64 + lane]), s2 = wave_sum(lp[128 + lane] * lp[192 + lane]);
    const float li = lam_init_of(layer);
    const float lam = __expf(s1) - __expf(s2) + li;
    const float osc = 1.0f - li;
    float gq = fabsf(diff_qk_g[lane]), gk = fabsf(diff_qk_g[64 + lane]);
    gq = xor_max<1>(gq); gq = xor_max<2>(gq); gq = xor_max<4>(gq); gq = xor_max<8>(gq); gq = xor_max<16>(gq); gq = xor_max<32>(gq);
    gk = xor_max<1>(gk); gk = xor_max<2>(gk); gk = xor_max<4>(gk); gk = xor_max<8>(gk); gk = xor_max<16>(gk); gk = xor_max<32>(gk);
    const float reach = 2.0f * (8.0f * gq * gk * 1.01f) + 30.0f;
    const float* tmm = (const float*)(ws + WS_TMM);
    constexpr int NU = NB * 16 * 4; const int per = (NU + F.G - 1) / F.G;
    for (int u = F.vcu * per; u < (F.vcu + 1) * per && u < NU; ++u) {
        const int h = u & 3, bq = u >> 2, b = bq >> 4, qb = bq & 15;
        const size_t rb = (size_t)b * SEQ;
        const float slope = exp2f(-2.0f * (float)(h + 1));
        unsigned long long tmask;
        { const float* tq = tmm + (size_t)(b * 64 + qb * 4) * 2;
          const float qlo = fminf(fminf(tq[0], tq[2]), fminf(tq[4], tq[6])), qhi = fmaxf(fmaxf(tq[1], tq[3]), fmaxf(tq[5], tq[7]));
          const float klo = tmm[(size_t)(b * 64 + lane) * 2], khi = tmm[(size_t)(b * 64 + lane) * 2 + 1];
          const float gap = fmaxf(fmaxf(klo - qhi, qlo - khi), 0.f);
          tmask = __ballot(gap * slope <= reach); }
        att::Args A;
        A.pq = 512; A.pk = 512; A.pv = 512; A.pos = positions + rb; A.slope2 = slope * LOG2E; A.sink2 = 0.f;
        A.V = (const bf16*)(ws + WS_VA) + rb * 512 + h * 128;
        LAS unsigned* stash = (LAS unsigned*)(lds + ATT_STASH_OFF) + F.wave * 2048 + lane;
        {
            A.Q = (const bf16*)(ws + WS_QA) + rb * 512 + h * 128; A.K = (const bf16*)(ws + WS_KA) + rb * 512 + h * 64;
            float r0[1][4][16];
            att::ATT_CORE_A<64, 128, 1, 1>(A, qb * 256, tmask, lds, r0);
#pragma unroll
            for (int d = 0; d < 4; ++d)
#pragma unroll
                for (int r = 0; r < 8; ++r) stash[(d * 8 + r) * 64] = att::cvtpk(r0[0][d][2 * r], r0[0][d][2 * r + 1]);
        }
        float res[1][4][16];
        A.Q = (const bf16*)(ws + WS_QA) + rb * 512 + h * 128 + 64; A.K = (const bf16*)(ws + WS_KA) + rb * 512 + (4 + h) * 64;
        att::ATT_CORE_A<64, 128, 1, 1>(A, qb * 256, tmask, lds, res);
        float gcol[4];
#pragma unroll
        for (int d = 0; d < 4; ++d) gcol[d] = diff_out_g[d * 32 + r32] * osc;
#pragma unroll
        for (int r = 0; r < 16; ++r) {
            float s = 0.f;
#pragma unroll
            for (int d = 0; d < 4; ++d) { const unsigned w = stash[(d * 8 + (r >> 1)) * 64]; const float a0 = (r & 1) ? bfhi(w) : bflo(w); const float v = a0 - lam * res[0][d][r]; res[0][d][r] = v; s += v * v; }
            s = xor_add<1>(s); s = xor_add<2>(s); s = xor_add<4>(s); s = xor_add<8>(s); s = xor_add<16>(s);
            const float rs = 1.0f / sqrtf(s * (1.0f / 128) + EPS);
#pragma unroll
            for (int d = 0; d < 4; ++d) res[0][d][r] *= rs * gcol[d];
        }
        att::store_rows<4>(res[0], (bf16*)(ws + (DRY ? WS_OB : WS_QA)) + rb * 512 + h * 128, 512, qb * 256 + F.wave * 32, lane);
    }
}
template <bool DRY> __device__ __forceinline__ void att_sec_C(const Frame& F, const float* swa_sink, unsigned char* ws) {
    int tid_ = threadIdx.x; asm volatile("" : "+v"(tid_)); const int lane = tid_ & 63;
    LAS unsigned char* lds = F.lds + RING_OFF;
    constexpr int NU = NB * 8 * 8; const int per = (NU + F.G - 1) / F.G;
    for (int u = F.vcu * per; u < (F.vcu + 1) * per && u < NU; ++u) {
        const int b = u >> 6, hh = (u >> 3) & 7, qb = u & 7, g = hh >> 2;
        const size_t rb = (size_t)b * SEQ;
        att::Args A;
        A.Q = (const bf16*)(ws + WS_QC) + rb * 512 + hh * 64; A.pq = 512;
        A.K = (const bf16*)(ws + WS_CQKC) + rb * 512 + 384 + g * 64; A.pk = 512;
        A.V = (const bf16*)(ws + WS_VCKR) + rb * 256 + g * 64; A.pv = 256;
        A.pos = nullptr; A.slope2 = exp2f(-(float)(hh + 1)) * LOG2E; A.sink2 = swa_sink[hh] * LOG2E;
        const int q0 = qb * 512; const int k_lo = q0 - 128 < 0 ? 0 : q0 - 128, k_hi = q0 + 512 + 128 > SEQ ? SEQ : q0 + 512 + 128;
        const int tl = k_lo / 64, th = k_hi / 64;
        const unsigned long long tmask = (th >= 64 ? ~0ull : ((1ull << th) - 1ull)) & ~((1ull << tl) - 1ull);
        float res[2][2][16];
        att::ATT_CORE<64, 64, 2, 2, true>(A, q0, tmask, lds, res);
        bf16* O = (bf16*)(ws + (DRY ? WS_OB : WS_QC)) + rb * 512 + hh * 64;
        att::store_rows<2>(res[0], O, 512, q0 + F.wave * 64, lane); att::store_rows<2>(res[1], O, 512, q0 + F.wave * 64 + 32, lane);
    }
}
template <bool DRY> __device__ __forceinline__ void att_sec_B(const Frame& F, unsigned char* ws, int layer, const int* positions, const float* mla_qk_g) {
    int tid_ = threadIdx.x; asm volatile("" : "+v"(tid_)); const int tid = tid_, lane = tid & 63;
    LAS unsigned char* lds = F.lds + RING_OFF;
    constexpr int NU = NB * 8 * 8;
    unsigned* qbase = (unsigned*)(ws + WS_CTL) + 65536 + (layer * 2 + (DRY ? 1 : 0)) * 8 * 64;
    LAS int* nxt = (LAS int*)(F.lds + ATT_NXT_OFF);
    const int ngrp = 8, per_grp = NU / 8, myq = (F.vcu * 8) / F.G;
    int qi = 0;
    for (;;) {
        if (tid == 0) { int u_ = -1;
            while (qi < ngrp) { const int q = (myq + qi) % ngrp; const unsigned v = __hip_atomic_fetch_add(qbase + q * 64, 1u, __ATOMIC_RELAXED, __HIP_MEMORY_SCOPE_AGENT);
                if (v < (unsigned)per_grp) { u_ = q * per_grp + (int)v; break; } ++qi; }
            nxt[0] = u_; nxt[1] = qi; }
        __syncthreads();
        const int u = __builtin_amdgcn_readfirstlane(nxt[0]); qi = __builtin_amdgcn_readfirstlane(nxt[1]);
        __syncthreads();
        if (u < 0) break;
        const int b = u >> 6, h = (u >> 3) & 7, qb = u & 7;
        const size_t rb = (size_t)b * SEQ;
        att::Args A;
        A.Q = (const bf16*)(ws + WS_QB) + rb * 768 + h * 96; A.pq = 768;
        A.K = (const bf16*)(ws + WS_KB) + rb * 768 + h * 96; A.pk = 768;
        A.V = (const bf16*)(ws + WS_KVR) + rb * 1024 + 512 + h * 64; A.pv = 1024;
        A.pos = positions + rb; A.qg = mla_qk_g; A.slope2 = 0.f; A.sink2 = 0.f;
        float res[2][2][16];
        att::ATT_CORE<96, 64, 0, 2, true, true>(A, qb * 512, ~0ull, lds, res);
        bf16* O = (bf16*)(ws + WS_OB) + rb * 512 + h * 64;
        att::store_rows<2>(res[0], O, 512, qb * 512 + F.wave * 64, lane); att::store_rows<2>(res[1], O, 512, qb * 512 + F.wave * 64 + 32, lane);
    }
}
__device__ __forceinline__ void p_attention(const Frame& F, const float* diff_qk_g, const float* diff_lambda, const float* diff_out_g, const float* swa_sink, unsigned char* ws, const int* positions, int layer, const float* mla_qk_g) {
#if defined(PROBE_SEC_A)
    att_sec_A<true>(F, diff_qk_g, diff_lambda, diff_out_g, ws, positions, layer);
#elif defined(PROBE_SEC_B)
    att_sec_B<true>(F, ws, layer, positions, mla_qk_g);
#elif defined(PROBE_SEC_C)
    att_sec_C<true>(F, swa_sink, ws);
#endif
#ifndef SKIP_A
    att_sec_A<false>(F, diff_qk_g, diff_lambda, diff_out_g, ws, positions, layer);
#endif
#ifndef SKIP_C
    att_sec_C<false>(F, swa_sink, ws);
#endif
#ifndef SKIP_B
    att_sec_B<false>(F, ws, layer, positions, mla_qk_g);
#endif
}

#ifdef NAIVE_ATTN
template <int DQK, int DV, int MODE>
__device__ __forceinline__ void naive_row(const bf16* Q, const bf16* K, int pk, const bf16* V, int pv, const int* pos, int t, float slope2, float sink2, int lane, float (&out)[DV / 64]) {
    float m = -1e30f, l = 0.f, acc[DV];
#pragma unroll
    for (int d = 0; d < DV; ++d) acc[d] = 0.f;
    if (MODE == 2 && lane == 0) { m = sink2; l = 1.f; }
    const float pqf = MODE == 1 ? (float)pos[t] : (float)t;
    int k_lo = 0, k_hi = SEQ;
    if (MODE == 2) { k_lo = t - 128 < 0 ? 0 : t - 128; k_hi = t + 129 > SEQ ? SEQ : t + 129; }
    for (int k = k_lo + lane; k < k_hi; k += 64) {
        const bf16* kr = K + (size_t)k * pk; float s = 0.f;
#pragma unroll
        for (int d = 0; d < DQK; d += 2) { const unsigned w = *(const unsigned*)(kr + d); const unsigned qw = *(const volatile unsigned*)(Q + d); s = fmaf(bflo(qw), bflo(w), s); s = fmaf(bfhi(qw), bfhi(w), s); }
        if (MODE == 1) s -= slope2 * fabsf(pqf - (float)pos[k]);
        if (MODE == 2) s -= slope2 * fabsf(pqf - (float)k);
        const float mn = fmaxf(m, s), a = exp2f(m - mn), p = exp2f(s - mn);
        l = l * a + p; m = mn;
        const bf16* vr = V + (size_t)k * pv;
#pragma unroll
        for (int d = 0; d < DV; d += 2) { const unsigned w = *(const unsigned*)(vr + d); acc[d] = fmaf(p, bflo(w), acc[d] * a); acc[d + 1] = fmaf(p, bfhi(w), acc[d + 1] * a); }
    }
    float M = m;
#pragma unroll
    for (int o = 1; o < 64; o <<= 1) M = fmaxf(M, __shfl_xor(M, o));
    const float sc = exp2f(m - M);
    const float L = wave_sum(l * sc);
#pragma unroll
    for (int d = 0; d < DV; ++d) { const float v = wave_sum(acc[d] * sc) / L; if ((d & 63) == lane) out[d >> 6] = v; }
}
__device__ __forceinline__ void p_attention_naive(int vcu, int wave, int G, const float* diff_lambda, const float* diff_out_g, const float* swa_sink, unsigned char* ws, const int* positions, int layer) {
    int tid_ = threadIdx.x; asm volatile("" : "+v"(tid_)); const int lane = tid_ & 63;
    const int gw = vcu * NWAVES + wave, NGW = G * NWAVES;
    const float* lp = diff_lambda;
    const float s1 = wave_sum(lp[lane] * lp[64 + lane]), s2 = wave_sum(lp[128 + lane] * lp[192 + lane]);
    const float li = layer == 0 ? 0.2f : 0.35550906759096184f;
    const float lam = __expf(s1) - __expf(s2) + li, osc = 1.0f - li;
    for (int it = gw; it < T * 4; it += NGW) {
        const int row = it >> 2, h = it & 3, b = row >> 12, t = row & 4095; const size_t rb = (size_t)b * SEQ;
        bf16* Qr = (bf16*)(ws + WS_QA) + (size_t)row * 512 + h * 128;
        float o0[2], o1[2];
        naive_row<64, 128, 1>(Qr, (const bf16*)(ws + WS_KA) + rb * 512 + h * 64, 512, (const bf16*)(ws + WS_VA) + rb * 512 + h * 128, 512, positions + rb, t, exp2f(-2.0f * (float)(h + 1)) * LOG2E, 0.f, lane, o0);
        naive_row<64, 128, 1>(Qr + 64, (const bf16*)(ws + WS_KA) + rb * 512 + (4 + h) * 64, 512, (const bf16*)(ws + WS_VA) + rb * 512 + h * 128, 512, positions + rb, t, exp2f(-2.0f * (float)(h + 1)) * LOG2E, 0.f, lane, o1);
        const float v0 = o0[0] - lam * o1[0], v1 = o0[1] - lam * o1[1];
        const float rs = 1.0f / sqrtf(wave_sum(v0 * v0 + v1 * v1) * (1.0f / 128) + EPS);
        Qr[lane] = (bf16)(pk2(v0 * rs * diff_out_g[lane] * osc, 0.f) & 0xffffu); Qr[64 + lane] = (bf16)(pk2(v1 * rs * diff_out_g[64 + lane] * osc, 0.f) & 0xffffu);
    }
    for (int it = gw; it < T * 8; it += NGW) {
        const int row = it >> 3, h = it & 7, b = row >> 12, t = row & 4095; const size_t rb = (size_t)b * SEQ;
        float o[1];
        naive_row<96, 64, 0>((const bf16*)(ws + WS_QB) + (size_t)row * 768 + h * 96, (const bf16*)(ws + WS_KB) + rb * 768 + h * 96, 768, (const bf16*)(ws + WS_KVR) + rb * 1024 + 512 + h * 64, 1024, nullptr, t, 0.f, 0.f, lane, o);
        ((bf16*)(ws + WS_OB))[(size_t)row * 512 + h * 64 + lane] = (bf16)(pk2(o[0], 0.f) & 0xffffu);
    }
    for (int it = gw; it < T * 8; it += NGW) {
        const int row = it >> 3, hh = it & 7, g = hh >> 2, b = row >> 12, t = row & 4095; const size_t rb = (size_t)b * SEQ;
        bf16* Qr = (bf16*)(ws + WS_QC) + (size_t)row * 512 + hh * 64;
        float o[1];
        naive_row<64, 64, 2>(Qr, (const bf16*)(ws + WS_CQKC) + rb * 512 + 384 + g * 64, 512, (const bf16*)(ws + WS_VCKR) + rb * 256 + g * 64, 256, nullptr, t, exp2f(-(float)(hh + 1)) * LOG2E, swa_sink[hh] * LOG2E, lane, o);
        Qr[lane] = (bf16)(pk2(o[0], 0.f) & 0xffffu);
    }
}
#endif

__device__ __forceinline__ void p_norm2_router(const Frame& F, const bf16* x, const float* g, const float* w_router, unsigned char* h2, float* affT) {
    int tid_ = threadIdx.x; asm volatile("" : "+v"(tid_)); const int tid = tid_, lane = tid & 63;
    LAS bf16x8* wtab = (LAS bf16x8*)(F.lds + RING_OFF);
    LAS float* gtab = (LAS float*)(F.lds + RING_OFF + 32768);
    LAS float* rsl = (LAS float*)(F.lds + RING_OFF + 32768 + 4096) + F.wave * 16;
    for (int i = tid; i < 2048; i += NWAVES * 64) { const int kk = i >> 6, l = i & 63, e = l & 15, k0 = kk * 32 + (l >> 4) * 8;
        v4u w; w.x = pk2(w_router[(k0 + 0) * 16 + e] * g[k0 + 0], w_router[(k0 + 1) * 16 + e] * g[k0 + 1]); w.y = pk2(w_router[(k0 + 2) * 16 + e] * g[k0 + 2], w_router[(k0 + 3) * 16 + e] * g[k0 + 3]);
        w.z = pk2(w_router[(k0 + 4) * 16 + e] * g[k0 + 4], w_router[(k0 + 5) * 16 + e] * g[k0 + 5]); w.w = pk2(w_router[(k0 + 6) * 16 + e] * g[k0 + 6], w_router[(k0 + 7) * 16 + e] * g[k0 + 7]);
        wtab[i] = __builtin_bit_cast(bf16x8, w); }
    for (int i = tid; i < 1024; i += NWAVES * 64) gtab[i] = g[i];
    __syncthreads();
    const int gw = F.vcu * NWAVES + F.wave, NGW = F.G * NWAVES, r = lane & 15, kq = lane >> 4;
    (void)gw; (void)NGW;
    for (int kk_ = 0; kk_ < (T / 128) / F.G; ++kk_) { const int row0 = (T / F.G) * F.vcu + 128 * kk_ + 16 * F.wave;
        bf16x8 a[32];
        const bf16* xr = x + (size_t)(row0 + r) * DM + kq * 8;
#pragma unroll
        for (int kk = 0; kk < 32; ++kk) a[kk] = *(const bf16x8*)(xr + kk * 32);
        f32x4 acc = {0.f, 0.f, 0.f, 0.f}; float ss = 0.f;
#pragma unroll
        for (int kk = 0; kk < 32; ++kk) {
            acc = __builtin_amdgcn_mfma_f32_16x16x32_bf16(a[kk], wtab[kk * 64 + lane], acc, 0, 0, 0);
            const v4u w = __builtin_bit_cast(v4u, a[kk]);
            ss += (bflo(w.x) * bflo(w.x) + bfhi(w.x) * bfhi(w.x)) + (bflo(w.y) * bflo(w.y) + bfhi(w.y) * bfhi(w.y)) + (bflo(w.z) * bflo(w.z) + bfhi(w.z) * bfhi(w.z)) + (bflo(w.w) * bflo(w.w) + bfhi(w.w) * bfhi(w.w)); __builtin_amdgcn_sched_barrier(0); }
        ss = xor_add<16>(ss); ss = xor_add<32>(ss);
        const float rs = 1.0f / sqrtf(ss * (1.0f / DM) + EPS);
        if (kq == 0) rsl[r] = rs;
        LDS_WAIT(); asm volatile("" ::: "memory");
        const f32x4 rs4 = *(const LAS f32x4*)(rsl + 4 * kq);
        LDS_WAIT(); asm volatile("" ::: "memory");
        float af[4];
#pragma unroll
        for (int v = 0; v < 4; ++v) { const float lg = acc[v] * rs4[v];
            float mx = lg; mx = xor_max<1>(mx); mx = xor_max<2>(mx); mx = xor_max<4>(mx); mx = xor_max<8>(mx);
            const float ex = __expf(lg - mx); float den = ex; den = xor_add<1>(den); den = xor_add<2>(den); den = xor_add<4>(den); den = xor_add<8>(den);
            af[v] = ex / den; }
        { const int b = row0 >> 12, t0 = (row0 & 4095) + 4 * kq;
          *(f32x4*)(affT + ((size_t)(b * NEXP + r) << 12) + t0) = (f32x4){af[0], af[1], af[2], af[3]}; }
        unsigned char* hr = h2 + (size_t)(row0 + r) * DM + kq * 8;
#pragma unroll
        for (int kk = 0; kk < 32; ++kk) {
            v4u w = __builtin_bit_cast(v4u, a[kk]); asm volatile("" : "+v"(w));
            const f32x4 g0 = *(const LAS f32x4*)(gtab + kk * 32 + kq * 8), g1 = *(const LAS f32x4*)(gtab + kk * 32 + kq * 8 + 4);
            const f32x4 y0 = {bflo(w.x) * rs * g0[0], bfhi(w.x) * rs * g0[1], bflo(w.y) * rs * g0[2], bfhi(w.y) * rs * g0[3]}, y1 = {bflo(w.z) * rs * g1[0], bfhi(w.z) * rs * g1[1], bflo(w.w) * rs * g1[2], bfhi(w.w) * rs * g1[3]};
            const pg8::u32x2 o = pg8::pack8_fp8(y0, y1); v2u ov; ov.x = o.x; ov.y = o.y; *(v2u*)(hr + kk * 32) = ov; __builtin_amdgcn_sched_barrier(0); }
    }
    __syncthreads();
}

__device__ __forceinline__ void p_topk_gather(const Frame& F, unsigned char* ws) {
    int tid_ = threadIdx.x; asm volatile("" : "+v"(tid_)); const int tid = tid_, lane = tid & 63; (void)tid; (void)lane;
    LAS unsigned* red = (LAS unsigned*)(F.lds + RING_OFF);
    LAS unsigned* wtot = red + 16;
    LAS int* lidx = (LAS int*)(F.lds + RING_OFF + 256);
    const float* affT = (const float*)(ws + WS_AFFT); int* inv = (int*)(ws + WS_INV); int* idx = (int*)(ws + WS_IDX); float* affsel = (float*)(ws + WS_AFFSEL);
    const unsigned char* h2 = ws + WS_H2; unsigned char* xg = ws + WS_XG;
    const int wid = F.wave;
    for (int u_ = F.vcu; u_ < NB * NEXP; u_ += F.G) {
        const int u = (F.G == 256) ? ((u_ & 15) << 4) + 2 * (u_ >> 5) + ((u_ >> 4) & 1) : u_;
        const int e = u >> 4, b = u & 15;
        const float* src = affT + ((size_t)(b * NEXP + e) << 12) + tid * 8;
        const f32x4 a0 = *(const f32x4*)src, a1 = *(const f32x4*)(src + 4);
        float v[8] = {a0.x, a0.y, a0.z, a0.w, a1.x, a1.y, a1.z, a1.w};
        unsigned long long key[8];
#pragma unroll
        for (int i = 0; i < 8; ++i) key[i] = ((unsigned long long)__float_as_uint(v[i]) << 12) | (unsigned long long)(4095 - (tid * 8 + i));
        unsigned long long Kth = 0ull; unsigned remaining = (unsigned)CAP;
        LAS unsigned* hist = (LAS unsigned*)(F.lds + RING_OFF + 4096);
        LAS unsigned* rres = hist + 256;
#pragma unroll 1
        for (int pass = 0; pass < 6; ++pass) {
            const int bits = pass < 5 ? 8 : 4, shift = pass < 5 ? 36 - 8 * pass : 0; const unsigned bmask = (1u << bits) - 1u;
            if (tid < 256) hist[tid] = 0u;
            __syncthreads();
#pragma unroll
            for (int i = 0; i < 8; ++i) if ((key[i] >> (shift + bits)) == (Kth >> (shift + bits))) __hip_atomic_fetch_add(hist + ((unsigned)(key[i] >> shift) & bmask), 1u, __ATOMIC_RELAXED, __HIP_MEMORY_SCOPE_WORKGROUP);
            __syncthreads();
            if (wid == 0) {
                const int b0 = 255 - 4 * lane; const unsigned c0 = hist[b0], c1 = hist[b0 - 1], c2 = hist[b0 - 2], c3 = hist[b0 - 3];
                unsigned incl = (c0 + c1) + (c2 + c3);
#pragma unroll
                for (int o = 1; o < 64; o <<= 1) { const unsigned y = (unsigned)__builtin_amdgcn_ds_bpermute(((lane - o) & 63) << 2, (int)incl); if (lane >= o) incl += y; }
                unsigned above = incl - ((c0 + c1) + (c2 + c3));
                const unsigned cc[4] = {c0, c1, c2, c3};
#pragma unroll
                for (int j = 0; j < 4; ++j) { if (above < remaining && remaining <= above + cc[j]) { rres[0] = (unsigned)(b0 - j); rres[1] = remaining - above; } above += cc[j]; }
            }
            __syncthreads();
            Kth |= (unsigned long long)rres[0] << shift; remaining = rres[1];
        }
        unsigned cnt = 0;
#pragma unroll
        for (int i = 0; i < 8; ++i) cnt += (key[i] >= Kth) ? 1u : 0u;
        unsigned incl = cnt;
#pragma unroll
        for (int o = 1; o < 64; o <<= 1) { const unsigned y = (unsigned)__builtin_amdgcn_ds_bpermute(((lane - o) & 63) << 2, (int)incl); if (lane >= o) incl += y; }
        __syncthreads();
        if (lane == 63) wtot[wid] = incl;
        __syncthreads();
        unsigned base = 0;
#pragma unroll
        for (int w = 0; w < 8; ++w) base += (w < wid) ? wtot[w] : 0u;
        unsigned slot = base + incl - cnt;
#pragma unroll
        for (int i = 0; i < 8; ++i) {
            const int t = tid * 8 + i; const bool sel = key[i] >= Kth;
            inv[((size_t)(b * SEQ + t) << 4) + e] = sel ? (int)slot : -1;
            if (sel) { if (slot < (unsigned)CAP) { lidx[slot] = t; idx[u * CAP + slot] = t; affsel[u * CAP + slot] = v[i]; } ++slot; }
        }
        __syncthreads();
        __syncthreads();
    }
}

template <bool NORM> __device__ __forceinline__ void p_combine(const Frame& F, unsigned char* ws, const bf16* xin, void* xout, const float* g, bf16* hout, unsigned char* h8out) {
    int tid_ = threadIdx.x; asm volatile("" : "+v"(tid_)); const int tid = tid_, lane = tid & 63; (void)tid; (void)lane;
    const int gw = F.vcu * NWAVES + F.wave, NGW = F.G * NWAVES;
    const int* inv = (const int*)(ws + WS_INV); const unsigned char* Y = ws + WS_XG;
    f32x4 gv[4];
#pragma unroll
    for (int j = 0; j < 4; ++j) { if (NORM) gv[j] = *((const f32x4*)g + lane + 64 * j); else gv[j] = (f32x4){0.f, 0.f, 0.f, 0.f}; }
    for (int row0 = gw * 2; row0 < T; row0 += NGW * 2) {
        int sl[2]; f32x4 v[2][4];
#pragma unroll
        for (int rr = 0; rr < 2; ++rr) { sl[rr] = (lane < 16) ? inv[((size_t)(row0 + rr) << 4) + lane] : -1;
            const v2u* xr = (const v2u*)(xin + (size_t)(row0 + rr) * DM) + lane;
#pragma unroll
            for (int j = 0; j < 4; ++j) { const v2u w = xr[64 * j]; v[rr][j] = (f32x4){bflo(w.x), bfhi(w.x), bflo(w.y), bfhi(w.y)}; } }
        unsigned long long mk0 = __ballot(sl[0] >= 0), mk1 = __ballot(sl[1] >= 0);
        while (mk0 | mk1) {
            unsigned yw[2][4][4]; bool val[2][4];
#pragma unroll
            for (int rr = 0; rr < 2; ++rr)
#pragma unroll
                for (int i = 0; i < 4; ++i) { unsigned long long& mk = rr ? mk1 : mk0; val[rr][i] = mk != 0ull;
                    if (val[rr][i]) { const int e = __builtin_ctzll(mk); mk &= mk - 1; const int s = __builtin_amdgcn_readlane(sl[rr], e); const int b = (row0 + rr) >> 12;
                        const unsigned* yr = (const unsigned*)(Y + ((size_t)(((e << 4) + b) * CAP + s) << 10)) + lane;
#pragma unroll
                        for (int j = 0; j < 4; ++j) yw[rr][i][j] = yr[64 * j]; }
                    else {
#pragma unroll
                        for (int j = 0; j < 4; ++j) yw[rr][i][j] = 0u; } }
#pragma unroll
            for (int rr = 0; rr < 2; ++rr)
#pragma unroll
                for (int i = 0; i < 4; ++i) if (val[rr][i]) {
#pragma unroll
                    for (int j = 0; j < 4; ++j) { const unsigned w = yw[rr][i][j]; const auto lo_ = __builtin_amdgcn_cvt_pk_f32_fp8((int)w, false), hi_ = __builtin_amdgcn_cvt_pk_f32_fp8((int)w, true);
                        v[rr][j].x += lo_[0] * (1.0f / Y_SCALE); v[rr][j].y += lo_[1] * (1.0f / Y_SCALE); v[rr][j].z += hi_[0] * (1.0f / Y_SCALE); v[rr][j].w += hi_[1] * (1.0f / Y_SCALE); } }
        }
#pragma unroll
        for (int rr = 0; rr < 2; ++rr) {
            if (NORM) { v2u* xw = (v2u*)((bf16*)xout + (size_t)(row0 + rr) * DM) + lane;
#pragma unroll
                for (int j = 0; j < 4; ++j) { v2u o; o.x = pk2(v[rr][j].x, v[rr][j].y); o.y = pk2(v[rr][j].z, v[rr][j].w); xw[64 * j] = o; } }
            else { f32x4* xw = (f32x4*)((float*)xout + (size_t)(row0 + rr) * DM) + lane;
#pragma unroll
                for (int j = 0; j < 4; ++j) xw[64 * j] = v[rr][j]; }
            if (NORM) { float s = 0.f;
#pragma unroll
                for (int j = 0; j < 4; ++j) s += (v[rr][j].x * v[rr][j].x + v[rr][j].y * v[rr][j].y) + (v[rr][j].z * v[rr][j].z + v[rr][j].w * v[rr][j].w);
                const float rs = 1.0f / sqrtf(wave_sum(s) * (1.0f / DM) + EPS);
                v2u* o8 = (v2u*)(hout + (size_t)(row0 + rr) * DM) + lane; unsigned* q8 = (unsigned*)(h8out + (size_t)(row0 + rr) * DM) + lane;
#pragma unroll
                for (int j = 0; j < 4; ++j) { const f32x4 y = {v[rr][j].x * rs * gv[j].x, v[rr][j].y * rs * gv[j].y, v[rr][j].z * rs * gv[j].z, v[rr][j].w * rs * gv[j].w};
                    v2u o; o.x = pk2(y.x, y.y); o.y = pk2(y.z, y.w); o8[64 * j] = o; q8[64 * j] = pk4_fp8(y); } } }
    }
}

struct KArgs { const float* in[23]; const int* positions; float* out; unsigned char* ws; int ph_lo, ph_hi; };
static_assert(sizeof(KArgs) == 23 * 8 + 8 + 8 + 8 + 8, "KArgs has no padding");
__device__ __forceinline__ unsigned long long karg_u64(int off) {
    unsigned long long v; auto kp = __builtin_amdgcn_kernarg_segment_ptr();
    asm volatile("s_load_dwordx2 %0, %1, %2\n\ts_waitcnt lgkmcnt(0)" : "=&s"(v) : "s"(kp), "i"(off) : "memory"); return v; }
#define GASP __attribute__((address_space(1)))
#define KIN(k) ((const float*)(const GASP float*)karg_u64(8 * (k)))
#define KPOS() ((const int*)(const GASP int*)karg_u64(184))
#define KOUT() ((float*)(GASP float*)karg_u64(192))
#define KWS() ((unsigned char*)(GASP unsigned char*)karg_u64(200))
__device__ __forceinline__ LayerW layer_w(int layer) {
    LayerW L;
    L.norm_mix_g = KIN(2) + (size_t)layer * 1024; L.w_in = KIN(3) + (size_t)layer * 1024 * IN_COLS; L.diff_qk_g = KIN(4) + layer * 128; L.diff_lambda = KIN(5) + layer * 256;
    L.diff_out_g = KIN(6) + layer * 128; L.mla_cq_g = KIN(7) + layer * 384; L.w_uq = KIN(8) + (size_t)layer * 384 * 768; L.mla_ckv_g = KIN(9) + layer * 256;
    L.w_ukv = KIN(10) + (size_t)layer * 256 * 1024; L.mla_qk_g = KIN(11) + layer * 192; L.swa_qk_g = KIN(12) + layer * 128; L.swa_sink = KIN(13) + layer * 8;
    L.w_ba = KIN(14) + (size_t)layer * 512 * 1024; L.w_bb = KIN(15) + (size_t)layer * 512 * 1024; L.w_bc = KIN(16) + (size_t)layer * 512 * 1024; L.w_o = KIN(17) + (size_t)layer * 1024 * 1024;
    L.norm_ffn_g = KIN(18) + (size_t)layer * 1024; L.w_router = KIN(19) + (size_t)layer * 1024 * 16;
    L.w_eg = KIN(20) + (size_t)layer * 16 * 1024 * 1024; L.w_eu = KIN(21) + (size_t)layer * 16 * 1024 * 1024; L.w_ed = KIN(22) + (size_t)layer * 16 * 1024 * 1024;
    return L;
}


#ifdef DBG_CHECK
__device__ __forceinline__ unsigned hash_u(unsigned x) { x ^= x >> 16; x *= 0x7feb352du; x ^= x >> 15; x *= 0x846ca68bu; x ^= x >> 16; return x; }
__device__ __forceinline__ float bf2f(bf16 v) { return __uint_as_float((unsigned)v << 16); }
__device__ __forceinline__ void chk_report(unsigned* word, float a, float b, int lane) {
    const float err = fabsf(a - b) / (fabsf(b) + 0.1f);
    if (lane == 0) atomicMax(word, __float_as_uint(err));
}
__device__ __forceinline__ const bf16* proj_loc(unsigned char* ws, int row, int col) {
    const int r = win_row(col), pn = r >> 8, c = r & 255;
    if (pn < 10) return (const bf16*)(ws + WS_QA + (size_t)(pn >> 1) * 64 * MiB) + (size_t)row * 512 + (pn & 1) * 256 + c;
    return (const bf16*)(ws + WS_CKV + (size_t)(pn - 10) * 32 * MiB) + (size_t)row * 256 + c;
}
__device__ __forceinline__ float naive_proj(const bf16* h, const float* w_in, int row, int col, int lane) {
    float s = 0.f;
    for (int k = lane; k < 1024; k += 64) s = fmaf(bf2f(h[(size_t)row * 1024 + k]), w_in[(size_t)k * IN_COLS + col], s);
    return wave_sum(s);
}
__device__ __forceinline__ void p_check(int which, int gw, int NGW, int lane, unsigned char* ws, const float* const* dummy, const float* x_in, const float* xout, const LayerW& L, const int* positions) {
    unsigned* word = (unsigned*)(ws + WS_CTL) + 32768 + which * 64;
    const bf16* h = (const bf16*)(ws + WS_H);
    if (which == 0) {
        for (int s = gw; s < 2048; s += NGW) { const int row = hash_u(s * 2 + 1) % T, col = hash_u(s * 2 + 2) % 2976;
            chk_report(word, bf2f(*proj_loc(ws, row, col)), naive_proj(h, L.w_in, row, col, lane), lane); }
    } else if (which == 1) {
        for (int s = gw; s < 1536; s += NGW) { const int row = hash_u(s * 3 + 5) % T, type = s % 6; const unsigned hg = hash_u(s * 3 + 7);
            if (type < 4) { int c0; const float* g; float qs = 1.f;
                if (type == 0) { c0 = (hg % 8) * 64; g = L.diff_qk_g; qs = 0.125f * LOG2E; } else if (type == 1) { c0 = 512 + (hg % 8) * 64; g = L.diff_qk_g + 64; }
                else if (type == 2) { c0 = 2208 + (hg % 8) * 64; g = L.swa_qk_g; qs = 0.125f * LOG2E; } else { c0 = 2720 + (hg % 2) * 64; g = L.swa_qk_g + 64; }
                float v = 0.f; for (int k = 0; k < 1024; ++k) v = fmaf(bf2f(h[(size_t)row * 1024 + k]), L.w_in[(size_t)k * IN_COLS + c0 + lane], v);
                v = bf2f((bf16)(pk2(v, 0.f) & 0xffffu));
                const float rs = 1.0f / sqrtf(wave_sum(v * v) * (1.0f / 64) + EPS);
                chk_report(word, bf2f(*proj_loc(ws, row, c0 + lane)), v * rs * g[lane] * qs, lane);
                const float e2 = fabsf(bf2f(*proj_loc(ws, row, c0 + lane)) - v * rs * g[lane] * qs) / (fabsf(v * rs * g[lane] * qs) + 0.1f); float m = e2;
                for (int o = 1; o < 64; o <<= 1) m = fmaxf(m, __shfl_xor(m, o)); if (lane == 0) atomicMax(word, __float_as_uint(m));
            } else { const int ng = type == 4 ? 6 : 4, cb = type == 4 ? 1536 : 1920; const float* g = type == 4 ? L.mla_cq_g : L.mla_ckv_g;
                float v[6]; float ss = 0.f;
                _Pragma("unroll") for (int q = 0; q < 6; ++q) { float a = 0.f; if (q < ng) { for (int k = 0; k < 1024; ++k) a = fmaf(bf2f(h[(size_t)row * 1024 + k]), L.w_in[(size_t)k * IN_COLS + cb + q * 64 + lane], a); }
                    a = bf2f((bf16)(pk2(a, 0.f) & 0xffffu)); v[q] = a; ss += a * a; }
                const float rs = 1.0f / sqrtf(wave_sum(ss) / (float)(ng * 64) + EPS); float m = 0.f;
                _Pragma("unroll") for (int q = 0; q < 6; ++q) { if (q < ng) { const float want = v[q] * rs * g[q * 64 + lane]; m = fmaxf(m, fabsf(bf2f(*proj_loc(ws, row, cb + q * 64 + lane)) - want) / (fabsf(want) + 0.1f)); } }
                for (int o = 1; o < 64; o <<= 1) m = fmaxf(m, __shfl_xor(m, o)); if (lane == 0) atomicMax(word, __float_as_uint(m));
            } }
    } else if (which == 2) {
        const bf16* CQ = (const bf16*)(ws + WS_CQKC); const bf16* CKVn = (const bf16*)(ws + WS_CKV); const bf16* VCKR = (const bf16*)(ws + WS_VCKR);
        const bf16* QB = (const bf16*)(ws + WS_QB); const bf16* KB = (const bf16*)(ws + WS_KB);
        for (int s = gw; s < 1024; s += NGW) { const int row = hash_u(s * 5 + 11) % T, hd = hash_u(s * 5 + 13) % 8; const bool isq = s & 1;
            float nope = 0.f, rp = 0.f;
            if (isq) { for (int k = 0; k < 384; ++k) { const float a = bf2f(CQ[(size_t)row * 512 + k]); nope = fmaf(a, L.w_uq[(size_t)k * 768 + hd * 96 + lane], nope); rp = fmaf(a, L.w_uq[(size_t)k * 768 + hd * 96 + 64 + (lane & 31)], rp); } }
            else { for (int k = 0; k < 256; ++k) nope = fmaf(bf2f(CKVn[(size_t)row * 256 + k]), L.w_ukv[(size_t)k * 1024 + hd * 128 + lane], nope); rp = bf2f(VCKR[(size_t)row * 256 + 128 + (lane & 31)]); }
            nope = bf2f((bf16)(pk2(nope, 0.f) & 0xffffu)); if (isq) rp = bf2f((bf16)(pk2(rp, 0.f) & 0xffffu));
            const int i = lane & 15; const float ang = (float)positions[row] * (1.0f / powf(10000.0f, (float)i / 16.0f));
            const float cs = cosf(ang), sn = sinf(ang), other = __shfl_xor(rp, 16);
            float ro = (lane & 16) ? (other * sn + rp * cs) : (rp * cs - other * sn); if (lane >= 32) ro = 0.f;
            const float rs = 1.0f / sqrtf(wave_sum(nope * nope + ro * ro) * (1.0f / 96) + EPS);
            const float* g = L.mla_qk_g + (isq ? 0 : 96); const float qs = isq ? 0.10206207261596575f * LOG2E : 1.f;
            const bf16* dst = (isq ? QB : KB) + (size_t)row * 768 + hd * 96;
            const float w1 = nope * rs * g[lane] * qs; float m = fabsf(bf2f(dst[lane]) - w1) / (fabsf(w1) + 0.1f);
            if (lane < 32) { const float w2 = ro * rs * g[64 + lane] * qs; m = fmaxf(m, fabsf(bf2f(dst[64 + lane]) - w2) / (fabsf(w2) + 0.1f)); }
            for (int o = 1; o < 64; o <<= 1) m = fmaxf(m, __shfl_xor(m, o)); if (lane == 0) atomicMax(word, __float_as_uint(m)); }
    } else if (which == 3) {
        for (int s = gw; s < 2048; s += NGW) { const int row = hash_u(s * 2 + 21) % T, col = hash_u(s * 2 + 22) % 3072;
            const float z = naive_proj(h, L.w_in, row, 2976 + col, lane); const float want = 1.0f / (1.0f + __expf(-z));
            const int gi = col >> 10; const bf16* G = (const bf16*)(ws + (gi == 0 ? WS_G0 : (gi == 1 ? WS_G1 : WS_G2)));
            const float got = bf2f(G[(size_t)row * 1024 + (col & 1023)]);
            chk_report(word, got, want, lane);
            if (lane == 0) { atomicAdd(word + 1024 + gi * 64, 1u); if (fabsf(got - want) / (fabsf(want) + 0.1f) > 0.06f) atomicAdd(word + 2048 + gi * 64, 1u); } }
    } else if (which == 4) {
        for (int s = gw; s < 2048; s += NGW) { const int row = hash_u(s * 2 + 31) % T, c = hash_u(s * 2 + 32) % 1024; float want = 0.f;
            for (int i = 0; i < 3; ++i) { const bf16* O = (const bf16*)(ws + (i == 0 ? WS_QA : (i == 1 ? WS_OB : WS_QC))); const float* Wb = i == 0 ? L.w_ba : (i == 1 ? L.w_bb : L.w_bc);
                const bf16* G = (const bf16*)(ws + (i == 0 ? WS_G0 : (i == 1 ? WS_G1 : WS_G2)));
                float a = 0.f; for (int k = lane; k < 512; k += 64) a = fmaf(bf2f(O[(size_t)row * 512 + k]), Wb[(size_t)k * 1024 + c], a);
                want += bf2f(G[(size_t)row * 1024 + c]) * wave_sum(a); }
            chk_report(word, bf2f(h[(size_t)row * 1024 + c]), want, lane); }
    } else if (which == 6) {
        for (int s = gw; s < 2048; s += NGW) { const int row = hash_u(s * 2 + 51) % T; float ss = 0.f;
            for (int k = lane; k < 1024; k += 64) { const float v = x_in[(size_t)row * 1024 + k]; ss += v * v; }
            const float rs = 1.0f / sqrtf(wave_sum(ss) * (1.0f / 1024) + EPS); float m = 0.f;
            for (int k = lane; k < 1024; k += 64) { const float want = x_in[(size_t)row * 1024 + k] * rs * L.norm_mix_g[k]; m = fmaxf(m, fabsf(bf2f(h[(size_t)row * 1024 + k]) - want) / (fabsf(want) + 0.1f)); }
            for (int o = 1; o < 64; o <<= 1) m = fmaxf(m, __shfl_xor(m, o)); if (lane == 0) atomicMax(word, __float_as_uint(m)); }
    } else if (which == 7 || which == 8) {
        const bf16* wt = (const bf16*)(ws + WS_WIN);
        for (int s = gw; s < 4096; s += NGW) { const int col = which == 7 ? 2976 + (int)(hash_u(s * 2 + 61) % 3072) : (int)(hash_u(s * 2 + 61) % 2976); const int r = win_row(col); float m = 0.f;
            for (int k = lane; k < 1024; k += 64) { const float want = L.w_in[(size_t)k * IN_COLS + col]; m = fmaxf(m, fabsf(bf2f(wt[(size_t)r * 1024 + k]) - want) / (fabsf(want) + 0.01f)); }
            for (int o = 1; o < 64; o <<= 1) m = fmaxf(m, __shfl_xor(m, o)); if (lane == 0) atomicMax(word, __float_as_uint(m)); }
    } else if (which == 9) {
        const bf16* wt = (const bf16*)(ws + WS_WIN);
        for (int s = gw; s < 2048; s += NGW) { const int row = hash_u(s * 2 + 21) % T, col = hash_u(s * 2 + 22) % 3072; float a = 0.f;
            for (int k = lane; k < 1024; k += 64) a = fmaf(bf2f(h[(size_t)row * 1024 + k]), bf2f(wt[(size_t)(3072 + col) * 1024 + k]), a);
            const float z = wave_sum(a), want = 1.0f / (1.0f + __expf(-z));
            const int gi = col >> 10; const bf16* G = (const bf16*)(ws + (gi == 0 ? WS_G0 : (gi == 1 ? WS_G1 : WS_G2)));
            chk_report(word, bf2f(G[(size_t)row * 1024 + (col & 1023)]), want, lane); }
    } else {
        for (int s = gw; s < 2048; s += NGW) { const int row = hash_u(s * 2 + 41) % T, c = hash_u(s * 2 + 42) % 1024;
            float a = 0.f; for (int k = lane; k < 1024; k += 64) a = fmaf(bf2f(h[(size_t)row * 1024 + k]), L.w_o[(size_t)k * 1024 + c], a);
            const float d = wave_sum(a), got = xout[(size_t)row * 1024 + c] - x_in[(size_t)row * 1024 + c];
            chk_report(word, got, d, lane); }
    }
}
__device__ __forceinline__ void p_check_emit(int vcu, int G, unsigned char* ws, float* out) {
    int t_ = threadIdx.x; asm volatile("" : "+v"(t_));
    const unsigned* words = (const unsigned*)(ws + WS_CTL) + 32768;
    int code = 0;
#ifdef DBG_CHECK2
    { const int map_[5] = {6, 7, 8, 9, 3};
      if (__uint_as_float(words[6 * 64]) > 0.06f) code |= 1; if (__uint_as_float(words[7 * 64]) > 0.06f) code |= 2; if (__uint_as_float(words[8 * 64]) > 0.06f) code |= 4;
      if (__uint_as_float(words[9 * 64]) > 0.06f) code |= 8; if (__uint_as_float(words[3 * 64]) > 0.06f) code |= 16; (void)map_; }
#elif defined(DBG_GATEFRAC)
    { const unsigned* w3 = words + 3 * 64;
      for (int gi = 0; gi < 3; ++gi) { const unsigned n = w3[1024 + gi * 64], bad = w3[2048 + gi * 64]; const int f = bad == 0 ? 0 : (bad * 10 < n ? 1 : (bad * 2 < n ? 2 : 3)); code |= f << (2 * gi); } }
#else
    for (int i = 0; i < 6; ++i) if (__uint_as_float(words[i * 64]) > 0.06f) code |= 1 << i;
#endif
    for (size_t i = (size_t)vcu * 512 + t_; i < (size_t)T * DM; i += (size_t)G * 512) out[i] = 0.f;
    __syncthreads();
    if (vcu == 0 && t_ == 0) out[0] = exp2f((float)(code + 20));
}
#endif

__global__ void __launch_bounds__(NWAVES * 64, 2) fwd_kernel(KArgs args) {
    extern __shared__ __attribute__((aligned(16))) unsigned char lds_raw[];
    Frame F;
    F.lds = (LAS unsigned char*)lds_raw;
    F.wave = __builtin_amdgcn_readfirstlane((int)threadIdx.x >> 6);
    F.G = gridDim.x; { const int bx = blockIdx.x; F.vcu = (F.G % 8 == 0) ? (bx % 8) * (F.G / 8) + bx / 8 : bx; }
    volatile LAS unsigned* MISC = (volatile LAS unsigned*)(F.lds + MISC_OFF);
    for (int u = threadIdx.x; u < (LDS_BYTES - LDSCTL_OFF) / 4; u += NWAVES * 64) ((LAS unsigned*)(F.lds + LDSCTL_OFF))[u] = 0u;
    __syncthreads();
#define GRID_BARRIER() do { XcdBarrier b_; b_.bar = (unsigned*)(KWS() + WS_CTL) + 4096; b_.x = xb_xcc_id(); b_.st = (volatile LAS unsigned*)(F.lds + MISC_OFF) + 8; xcd_barrier(b_); } while (0)
#if !MK_MULTI
    (void)xcd_barrier_post((unsigned*)(KWS() + WS_CTL) + 4096, MISC + 8);
    if (F.G == 256) group_post((unsigned*)(KWS() + WS_CTL) + 4096, F.vcu >> 5);
#endif
    const int lo = args.ph_lo, hi = args.ph_hi;
#ifdef DBG_CHECK
    if (lo >= 2000) { p_check_emit(F.vcu, F.G, KWS(), KOUT()); return; }
#ifdef DBG_CHECK2
    if (lo >= 1000 && lo < 2000) { const int ph = lo - 1000;
        for (int which = 6; which <= 9; ++which) { const bool run = (ph == 5 && which <= 8) || (ph == 6 && which == 9);
            if (run) { int t_ = threadIdx.x; asm volatile("" : "+v"(t_)); unsigned char* ws = KWS(); const LayerW L = layer_w(0);
                p_check(which, F.vcu * NWAVES + F.wave, F.G * NWAVES, t_ & 63, ws, nullptr, KIN(0), KOUT(), L, KPOS()); } }
    }
#endif
    if (lo >= 1000) { const int ph = lo - 1000; const int which = ph == 1 ? 0 : ph == 2 ? 1 : ph == 4 ? 2 : ph == 6 ? 3 : ph == 9 ? 4 : ph == 10 ? 5 : -1;
        if (which >= 0) { int t_ = threadIdx.x; asm volatile("" : "+v"(t_)); unsigned char* ws = KWS(); const LayerW L = layer_w(0);
            p_check(which, F.vcu * NWAVES + F.wave, F.G * NWAVES, t_ & 63, ws, nullptr, KIN(0), KOUT(), L, KPOS()); }
        return; }
#endif
#ifdef ONLY_PHASE
#define IN(k) ((((k) % PH_PER_LAYER) == ONLY_PHASE) && lo <= (k) && (k) < hi)
#else
#ifdef SKIP_FFN
#define IN(k) ((((k) % PH_PER_LAYER) < 11) && lo <= (k) && (k) < hi)
#else
#define IN(k) (lo <= (k) && (k) < hi)
#endif
#endif
#if MK_MULTI
#define SEAM(k) do { } while (0)
#else
#define SEAM(k) do { if (IN((k) + 1)) { GRID_BARRIER(); } } while (0)
#endif
#if MK_MULTI
#define LSEAM(k) do { } while (0)
#else
#define LSEAM(k) do { if (IN((k) + 1)) { if (F.G == 256) group_barrier((unsigned*)(KWS() + WS_CTL) + 4096, F.vcu >> 5, 32u); else { GRID_BARRIER(); } } } while (0)
#endif
#define CHK(ph, which) do { } while (0)
#ifndef ST_MERGE
#define ST_MERGE 1400
#endif
#ifndef ST_WO
#define ST_WO 2000
#endif
#ifdef STAGGER_ON
#define STAGGER(ticks) do { if (F.vcu & 1) { const unsigned long long t0_ = __builtin_amdgcn_s_memrealtime(); while (__builtin_amdgcn_s_memrealtime() - t0_ < (unsigned long long)(ticks)) __builtin_amdgcn_s_sleep(8); } } while (0)
#else
#define STAGGER(ticks) do { } while (0)
#endif
#define GEMM_RUN(EPI, g, E) do { pg8::StaticOrder S_; S_.init((g).M, (g).N, F.G, (int)blockIdx.x); pg8::gemm_phase<EPI, pg8::StaticOrder, true, true>(F.lds + RING_OFF, g, S_, E); } while (0)
#define GEMM_RUN_F8(EPI, g, E) do { pg8::StaticOrder S_; S_.init((g).M, (g).N, F.G, (int)blockIdx.x); pg8::gemm_phase<EPI, pg8::StaticOrder, true, true, true>(F.lds + RING_OFF, g, S_, E); } while (0)
#ifdef DUP_SMALL
#define GEMM_RUN3(EPI, g, E) do { GEMM_RUN(EPI, g, E); GRID_BARRIER(); GEMM_RUN(EPI, g, E); } while (0)
#else
#define GEMM_RUN3(EPI, g, E) GEMM_RUN(EPI, g, E)
#endif
#ifdef DUP_GEMM_PLAIN
#define GEMM_RUN2(EPI, g, E) do { { pg8::EpiPlain EN_{(bf16*)(KWS() + WS_QB), 3072}; GEMM_RUN(pg8::EpiPlain, g, EN_); } GRID_BARRIER(); GEMM_RUN(EPI, g, E); } while (0)
#elif defined(DUP_GEMM_NULL)
#define GEMM_RUN2(EPI, g, E) do { { pg8::EpiNull EN_; GEMM_RUN(pg8::EpiNull, g, EN_); } GRID_BARRIER(); GEMM_RUN(EPI, g, E); } while (0)
#elif defined(DUP_GEMM)
#define GEMM_RUN2(EPI, g, E) do { GEMM_RUN(EPI, g, E); GRID_BARRIER(); GEMM_RUN(EPI, g, E); } while (0)
#else
#define GEMM_RUN2(EPI, g, E) GEMM_RUN(EPI, g, E)
#endif
    for (int layer = 0; layer < DEPTH; ++layer) {
        const int P = layer * PH_PER_LAYER;
#ifdef DUP_P0
        if (IN(P + 0)) { unsigned char* ws = KWS(); const LayerW L = layer_w(layer); p_convert(F, L, ws); p_tile_minmax(F, ws, KPOS()); if (layer == 0) p_norm1(F, KIN(0), L.norm_mix_g, (bf16*)(ws + WS_H), (unsigned char*)KOUT() + H8_OUT_OFF);     GRID_BARRIER(); }
#endif
        if (IN(P + 0)) { unsigned char* ws = KWS(); const LayerW L = layer_w(layer); p_convert(F, L, ws); p_tile_minmax(F, ws, KPOS()); if (layer == 0) p_norm1(F, KIN(0), L.norm_mix_g, (bf16*)(ws + WS_H), (unsigned char*)KOUT() + H8_OUT_OFF);     SEAM(P + 0); }
        if (IN(P + 1)) {
            unsigned char* ws = KWS();
            pg8::Gemm g{(const bf16*)(ws + WS_H), (const bf16*)(ws + WS_WIN), T, 3072, 1024, 1024, 1, 1, 0};
            pg8::EpiRouteNorm E{(bf16*)(ws + WS_QA), (size_t)(64 * MiB / 2), (bf16*)(ws + WS_CKV), (size_t)(32 * MiB / 2), (const float*)(ws + WS_GT), (float*)(ws + WS_SSP), EPS, KPOS(), KIN(11) + layer * 192 + 160};
            GEMM_RUN2(pg8::EpiRouteNorm, g, E); LSEAM(P + 1); }
        CHK(1, 0);
#ifdef DUP_BAR
        if (IN(P + 2)) { for (int i_ = 0; i_ < 10; ++i_) GRID_BARRIER(); }
#endif
        CHK(2, 1);
        if (IN(P + 3)) {
            unsigned char* ws = KWS();
            pg8::Gemm g{(const bf16*)(ws + WS_CQKC), (const bf16*)(ws + WS_WUQ), T, 768, 384, 512, 1, 1, 0};
            pg8::EpiPlainRS E{(bf16*)(ws + WS_QB), 768, (const float*)(ws + WS_SSP), 0, 6, 1.0f / 384, EPS}; GEMM_RUN3(pg8::EpiPlainRS, g, E); }
        if (IN(P + 3)) {
            unsigned char* ws = KWS();
            pg8::Gemm g{(const bf16*)(ws + WS_CKV), (const bf16*)(ws + WS_WUKV), T, 1024, 256, 256, 1, 1, 0};
            pg8::EpiKV E{(bf16*)(ws + WS_KB), (bf16*)(ws + WS_KVR), (const bf16*)(ws + WS_VCKR) + 128, (const float*)(ws + WS_SSP), KIN(11) + layer * 192 + 96, EPS}; GEMM_RUN(pg8::EpiKV, g, E); SEAM(P + 4); }
        CHK(4, 2);
#ifdef NAIVE_ATTN
        if (IN(P + 5)) { unsigned char* ws = KWS(); p_attention_naive(F.vcu, F.wave, F.G, KIN(5) + layer * 256, KIN(6) + layer * 128, KIN(13) + layer * 8, ws, KPOS(), layer); SEAM(P + 5); }
#else
        if (IN(P + 5)) { unsigned char* ws = KWS(); p_attention(F, KIN(4) + layer * 128, KIN(5) + layer * 256, KIN(6) + layer * 128, KIN(13) + layer * 8, ws, KPOS(), layer, KIN(11) + layer * 192); SEAM(P + 5); }
#endif
        if (IN(P + 6)) {
            unsigned char* ws = KWS();
            pg8::Gemm g{(const bf16*)((unsigned char*)KOUT() + H8_OUT_OFF), (const bf16*)(ws + WS_WG8), T, 3072, 512, 512, 1, 1, 0, 0, 0};
            pg8::EpiGate E{ws + WS_G0, (size_t)(64 * MiB), (size_t)0, -LOG2E / W8_SCALE};
            GEMM_RUN_F8(pg8::EpiGate, g, E); LSEAM(P + 6); }
#define MERGE3_RUN() do { unsigned char* ws = KWS(); \
            pg8::Gemm g{(const bf16*)(ws + WS_QA), (const bf16*)(ws + WS_WBA), 3 * T, 1024, 512, 512, 256, 3, (size_t)(1 * MiB), 0, 0, (size_t)(WS_OB - WS_QA - 128 * MiB)}; \
            pg8::EpiMerge3 E{ws + WS_G0, (bf16*)(ws + WS_H)}; \
            pg8::MergeOrder S_; S_.S.init(T, 1024, F.G, (int)blockIdx.x); pg8::gemm_phase<pg8::EpiMerge3, pg8::MergeOrder, true, true>(F.lds + RING_OFF, g, S_, E); } while (0)
        if (IN(P + 7)) {
            MERGE3_RUN(); LSEAM(P + 9); }
#ifdef DUP_MERGE
        if (IN(P + 7)) { GRID_BARRIER(); MERGE3_RUN(); GRID_BARRIER(); }
#endif
        CHK(9, 4);
        if (IN(P + 10)) {
            unsigned char* ws = KWS(); float* xo = KOUT();
            pg8::Gemm g{(const bf16*)(ws + WS_H), (const bf16*)(ws + WS_WO), T, 1024, 1024, 1024, 1, 1, 0};
            pg8::EpiResid E{layer == 0 ? (const void*)KIN(0) : (const void*)xo, layer != 0, (bf16*)(ws + WS_XB)}; STAGGER(ST_WO); GEMM_RUN(pg8::EpiResid, g, E); LSEAM(P + 10); }
        CHK(10, 5);
#ifdef DUP_P11
        if (IN(P + 11)) { unsigned char* ws = KWS(); p_norm2_router(F, (const bf16*)(ws + WS_XB), KIN(18) + (size_t)layer * 1024, KIN(19) + (size_t)layer * 1024 * 16, ws + WS_H2, (float*)(ws + WS_AFFT)); GRID_BARRIER(); }
#endif
        if (IN(P + 11)) { unsigned char* ws = KWS(); p_norm2_router(F, (const bf16*)(ws + WS_XB), KIN(18) + (size_t)layer * 1024, KIN(19) + (size_t)layer * 1024 * 16, ws + WS_H2, (float*)(ws + WS_AFFT)); LSEAM(P + 11); }
#ifdef DUP_P12
        if (IN(P + 12)) { unsigned char* ws = KWS(); p_topk_gather(F, ws); GRID_BARRIER(); }
#endif
        if (IN(P + 12)) { unsigned char* ws = KWS(); p_topk_gather(F, ws); SEAM(P + 12); }
        if (IN(P + 13)) {
            unsigned char* ws = KWS();
            pg8::Gemm g{(const bf16*)(ws + WS_H2), (const bf16*)(ws + WS_WGU), TE, 2048, 512, 512, 32, 16, (size_t)2048 * 1024, W8_E8M0, ONE_E8M0, (size_t)0, (const int*)(ws + WS_IDX)};
            pg8::EpiSwiglu E{ws + WS_HID, 1.0f / W8_SCALE, HID_SCALE};
            { pg8::StaticOrder S_; S_.init(g.M, g.N, F.G, (int)blockIdx.x); pg8::gemm_phase<pg8::EpiSwiglu, pg8::StaticOrder, true, true, true, true>(F.lds + RING_OFF, g, S_, E); }
            SEAM(P + 13); }
        if (IN(P + 14)) {
            unsigned char* ws = KWS();
            pg8::Gemm g{(const bf16*)(ws + WS_HID), (const bf16*)(ws + WS_WD), TE, 1024, 512, 512, 32, 16, (size_t)1024 * 1024, W8_E8M0, HID_E8M0};
            pg8::EpiDown E{ws + WS_XG, (const float*)(ws + WS_AFFSEL), Y_SCALE / (W8_SCALE * HID_SCALE)}; GEMM_RUN_F8(pg8::EpiDown, g, E); SEAM(P + 14); }
#ifdef DUP_P15
        if (IN(P + 15)) { unsigned char* ws = KWS(); if (layer + 1 < DEPTH) p_combine<true>(F, ws, (const bf16*)(ws + WS_XB), KOUT(), KIN(2) + (size_t)(layer + 1) * 1024, (bf16*)(ws + WS_H), (unsigned char*)KOUT() + H8_OUT_OFF); else p_combine<false>(F, ws, (const bf16*)(ws + WS_XB), KOUT(), nullptr, nullptr, nullptr); GRID_BARRIER(); }
#endif
        if (IN(P + 15)) { unsigned char* ws = KWS(); if (layer + 1 < DEPTH) p_combine<true>(F, ws, (const bf16*)(ws + WS_XB), KOUT(), KIN(2) + (size_t)(layer + 1) * 1024, (bf16*)(ws + WS_H), (unsigned char*)KOUT() + H8_OUT_OFF); else p_combine<false>(F, ws, (const bf16*)(ws + WS_XB), KOUT(), nullptr, nullptr, nullptr); SEAM(P + 15); }
    }
#undef IN
#undef SEAM
}

extern "C" void kernel_launch(void* const* d_in, const int* in_sizes, int n_in, void* d_out, int out_size, void* d_ws, size_t ws_size, hipStream_t stream) {
    static int grid = 0;
    if (grid == 0) {
        if (n_in != 23 || in_sizes[0] != T * DM || out_size != T * DM || ws_size < WS_END) { fprintf(stderr, "kernel_launch: shape/workspace mismatch (n_in %d, ws %zu < %zu)\n", n_in, ws_size, (size_t)WS_END); grid = -1; return; }
        int dev = 0, cus = 0, per_cu = 0;
        if (hipGetDevice(&dev) != hipSuccess || hipDeviceGetAttribute(&cus, hipDeviceAttributeMultiprocessorCount, dev) != hipSuccess) { grid = -1; return; }
        if (hipFuncSetAttribute((const void*)fwd_kernel, hipFuncAttributeMaxDynamicSharedMemorySize, LDS_BYTES) != hipSuccess) { fprintf(stderr, "kernel_launch: hipFuncSetAttribute failed\n"); grid = -1; return; }
        if (hipOccupancyMaxActiveBlocksPerMultiprocessor(&per_cu, (const void*)fwd_kernel, NWAVES * 64, LDS_BYTES) != hipSuccess || per_cu < 1) { fprintf(stderr, "kernel_launch: occupancy query reports %d\n", per_cu); }
        (void)hipGetLastError();
        grid = cus;
    }
    if (grid < 0) return;
    if (hipMemsetAsync((char*)d_ws + WS_CTL, 0, CTL_ZERO_BYTES, stream) != hipSuccess) return;
    KArgs a{};
    for (int i = 0; i < 23; ++i) a.in[i] = (const float*)d_in[i];
    a.positions = (const int*)d_in[1]; a.out = (float*)d_out; a.ws = (unsigned char*)d_ws;
#if MK_MULTI
#ifdef DBG_CHECK
    for (int p = 0; p <= 10; ++p) { a.ph_lo = p; a.ph_hi = p + 1; hipLaunchKernelGGL(fwd_kernel, dim3(grid), dim3(NWAVES * 64), LDS_BYTES, stream, a);
        a.ph_lo = 1000 + p; a.ph_hi = 1001 + p; hipLaunchKernelGGL(fwd_kernel, dim3(grid), dim3(NWAVES * 64), LDS_BYTES, stream, a); }
    a.ph_lo = 2000; a.ph_hi = 2001; hipLaunchKernelGGL(fwd_kernel, dim3(grid), dim3(NWAVES * 64), LDS_BYTES, stream, a);
#else
    for (int p = 0; p < NPHASE; ++p) { a.ph_lo = p; a.ph_hi = p + 1; hipLaunchKernelGGL(fwd_kernel, dim3(grid), dim3(NWAVES * 64), LDS_BYTES, stream, a); }
#endif
#else
    a.ph_lo = 0; a.ph_hi = NPHASE;
    hipLaunchKernelGGL(fwd_kernel, dim3(grid), dim3(NWAVES * 64), LDS_BYTES, stream, a);
#endif
    const hipError_t le = hipPeekAtLastError();
    if (le != hipSuccess) fprintf(stderr, "kernel_launch: launch failed: %s\n", hipGetErrorName(le));
}
```
